# Optimizing an MI355X kernel written in HIP

```python
import math
import jax
import jax.numpy as jnp
from jax import lax
import numpy as np

D_MODEL = 1024
BATCH = 8
SEQ = 4096
DEPTH = 1

GRID_W = 64
CTX_LEN = 256
EPS = 1e-6

M_HEADS = 8
M_DQK = 64
M_DV = 128
M_QK_W = M_HEADS * M_DQK
M_V_W = M_HEADS * M_DV
M_CHUNK = 128
CONV_K = 3

S5_WIDTH = 512
S5_GROUP = 16
S5_GROUPS = S5_WIDTH // S5_GROUP
S5_STATE = 64

N_EXPERTS = 32
TOP_K = 4
D_FF = D_MODEL
SWIGLU_LIMIT = 7.0
SWIGLU_ALPHA = 1.702

OFF_QK = 0
OFF_V = OFF_QK + 2 * M_QK_W
OFF_IF = OFF_V + M_V_W
N_IF = 2 * 2 * M_HEADS
OFF_U = OFF_IF + N_IF
STATE_COLS = OFF_U + S5_WIDTH
OFF_O = STATE_COLS
OFF_G = OFF_O + M_V_W
IN_COLS = OFF_G + 2 * D_MODEL
N_MOD = 6

kernel_name = 'hybrid_mlstm_s5_moe_diffusion_block'


def rmsnorm(x, g):
    xf = x.astype(jnp.float32)
    y = xf * lax.rsqrt(jnp.mean(xf * xf, axis=-1, keepdims=True) + EPS)
    return (y * g.astype(jnp.float32)).astype(x.dtype)


def modulate(h, shift, scale):
    return h * (1.0 + scale) + shift


def conv_ctx(x, w):
    length = x.shape[1]
    w = w.astype(x.dtype)
    xp = jnp.pad(x, ((0, 0), (1, 1), (0, 0)))
    return xp[:, 0:length] * w[1, 0] + xp[:, 1:length + 1] * w[1, 1] + xp[:, 2:length + 2] * w[1, 2]


def conv_lat(x, w):
    bsz, length, ch = x.shape
    rows = length // GRID_W
    xg = x.reshape(bsz, rows, GRID_W, ch)
    y = lax.conv_general_dilated(xg, w.astype(x.dtype).reshape(CONV_K, CONV_K, 1, ch), (1, 1), 'SAME',
                                 dimension_numbers=('NHWC', 'HWIO', 'NHWC'), feature_group_count=ch)
    return y.reshape(bsz, length, ch)


def split_heads(a, dh):
    bsz, length, _ = a.shape
    return a.reshape(bsz, length, -1, dh).transpose(0, 2, 1, 3)


def mlstm_chunkwise(q, k, v, li, lf, state, return_h):
    bsz, nh, length, _ = q.shape
    nc = length // M_CHUNK

    def chunks(a):
        return jnp.moveaxis(a.reshape(bsz, nh, nc, M_CHUNK, *a.shape[3:]), 2, 0)

    lower = jnp.tril(jnp.ones((M_CHUNK, M_CHUNK), dtype=bool))

    def step(carry, xs):
        cm, nv, m = carry
        qc, kc, vc, lic, lfc = xs
        b = jnp.cumsum(lfc, axis=-1)
        b_end = b[..., -1]
        w_end = b_end[..., None] - b + lic
        m_new = jnp.maximum(b_end + m, jnp.max(w_end, axis=-1))
        dec = jnp.exp(b_end + m - m_new)
        we = jnp.exp(w_end - m_new[..., None])
        c_new = dec[..., None, None] * cm + jnp.einsum('bhs,bhsv,bhsk->bhvk', we, vc, kc)
        n_new = dec[..., None] * nv + jnp.einsum('bhs,bhsk->bhk', we, kc)
        if not return_h:
            return (c_new, n_new, m_new), None
        logd = jnp.where(lower, b[..., :, None] - b[..., None, :] + lic[..., None, :], -jnp.inf)
        inter = b + m[..., None]
        mt = jnp.maximum(inter, jnp.max(logd, axis=-1))
        s = jnp.einsum('bhtk,bhsk->bhts', qc, kc) * jnp.exp(logd - mt[..., None])
        ie = jnp.exp(inter - mt)
        num = ie[..., None] * jnp.einsum('bhvk,bhtk->bhtv', cm, qc) + jnp.einsum('bhts,bhsv->bhtv', s, vc)
        den = ie * jnp.einsum('bhk,bhtk->bht', nv, qc) + jnp.sum(s, axis=-1)
        h = num / jnp.maximum(jnp.abs(den), jnp.exp(-mt))[..., None]
        return (c_new, n_new, m_new), h

    state, hs = lax.scan(step, state, (chunks(q), chunks(k), chunks(v), chunks(li), chunks(lf)))
    if not return_h:
        return state, None
    return state, jnp.moveaxis(hs, 0, 2).reshape(bsz, nh, length, -1)


def mlstm_dir(q, k, v, li, lf, state, reverse, return_h):
    if reverse:
        q, k, v, li, lf = (jnp.flip(a, axis=2) for a in (q, k, v, li, lf))
    state, h = mlstm_chunkwise(q, k, v, li, lf, state, return_h)
    if reverse and return_h:
        h = jnp.flip(h, axis=2)
    return state, h


def s5_discretise(a_re, a_im, log_dt, b_re, b_im):
    f32 = jnp.float32
    a_re, a_im, b_re, b_im = (t.astype(f32) for t in (a_re, a_im, b_re, b_im))
    dt = jnp.exp(log_dt.astype(f32))[:, None]
    mag = jnp.exp(dt * a_re)
    ang = dt * a_im
    ab_re = mag * jnp.cos(ang)
    ab_im = mag * jnp.sin(ang)
    den = a_re * a_re + a_im * a_im
    xr = ab_re - 1.0
    cf_re = (xr * a_re + ab_im * a_im) / den
    cf_im = (ab_im * a_re - xr * a_im) / den
    bb_re = cf_re[..., None] * b_re - cf_im[..., None] * b_im
    bb_im = cf_re[..., None] * b_im + cf_im[..., None] * b_re
    return ab_re, ab_im, bb_re, bb_im


def _complex_affine_combine(e1, e2):
    a1r, a1i, b1r, b1i = e1
    a2r, a2i, b2r, b2i = e2
    return (a2r * a1r - a2i * a1i,
            a2r * a1i + a2i * a1r,
            a2r * b1r - a2i * b1i + b2r,
            a2r * b1i + a2i * b1r + b2i)


def s5_scan(bu_re, bu_im, ab_re, ab_im, h0, reverse):
    h0_re, h0_im = h0
    first = -1 if reverse else 0
    bu_re = bu_re.at[:, first].add(ab_re * h0_re - ab_im * h0_im)
    bu_im = bu_im.at[:, first].add(ab_re * h0_im + ab_im * h0_re)
    shape = bu_re.shape
    elems = (jnp.broadcast_to(ab_re, shape), jnp.broadcast_to(ab_im, shape), bu_re, bu_im)
    _, _, hr, hi = lax.associative_scan(_complex_affine_combine, elems, reverse=reverse, axis=1)
    last = 0 if reverse else -1
    return hr, hi, (hr[:, last], hi[:, last])


def mixer_core(proj, conv_fn, conv_w, b_if, disc, c_re, c_im, d_skip, m_state, s_state, return_out):
    f32 = jnp.float32
    bsz, length, _ = proj.shape
    qk = jax.nn.silu(conv_fn(proj[..., OFF_QK:OFF_V], conv_w)).astype(f32)
    q = split_heads(qk[..., :M_QK_W], M_DQK) * (M_DQK ** -0.5)
    k = split_heads(qk[..., M_QK_W:], M_DQK)
    v = split_heads(proj[..., OFF_V:OFF_IF].astype(f32), M_DV)
    gif = (proj[..., OFF_IF:OFF_U].reshape(bsz, length, 2, 2, M_HEADS) + b_if).astype(f32)
    gif = jnp.transpose(gif, (2, 3, 0, 4, 1))
    u = proj[..., OFF_U:STATE_COLS].astype(f32).reshape(bsz, length, S5_GROUPS, S5_GROUP)
    m_final, s_final, h_dirs, y_dirs = [], [], [], []
    for d in range(2):
        rev = d == 1
        st, h = mlstm_dir(q, k, v, gif[d, 0], jax.nn.log_sigmoid(gif[d, 1]), m_state[d], rev, return_out)
        ab_re, ab_im, bb_re, bb_im = disc[d]
        bu_re = jnp.einsum('blgc,gpc->blgp', u, bb_re)
        bu_im = jnp.einsum('blgc,gpc->blgp', u, bb_im)
        hr, hi, fin = s5_scan(bu_re, bu_im, ab_re, ab_im, s_state[d], rev)
        m_final.append(st)
        s_final.append(fin)
        if return_out:
            h_dirs.append(h)
            y_dirs.append(jnp.einsum('blgp,gcp->blgc', hr, c_re[d].astype(f32))
                          - jnp.einsum('blgp,gcp->blgc', hi, c_im[d].astype(f32)))
    if not return_out:
        return m_final, s_final, None, None
    h_m = h_dirs[0] + h_dirs[1]
    y_s = y_dirs[0] + y_dirs[1] + d_skip.astype(f32).reshape(S5_GROUPS, S5_GROUP) * u
    return m_final, s_final, h_m, y_s.reshape(bsz, length, S5_WIDTH)


def mixer_out(proj, h_m, y_s, g_mh, w_glu, b_glu, w_a, w_b, b_gate, w_o):
    dt = proj.dtype
    f32 = jnp.float32
    bsz, length, _ = proj.shape
    hn = h_m * lax.rsqrt(jnp.mean(h_m * h_m, axis=-1, keepdims=True) + EPS)
    hn = hn.transpose(0, 2, 1, 3).reshape(bsz, length, M_V_W) * g_mh.astype(f32)
    o_gate = jax.nn.sigmoid(proj[..., OFF_O:OFF_G].astype(f32))
    y_a = (hn * o_gate).astype(dt) @ w_a
    ys = jax.nn.gelu(y_s).astype(dt)
    ys = ys * jax.nn.sigmoid(ys @ w_glu + b_glu)
    y_b = ys @ w_b
    gates = jax.nn.sigmoid(proj[..., OFF_G:IN_COLS] + b_gate)
    merged = gates[..., :D_MODEL] * y_a + gates[..., D_MODEL:] * y_b
    return merged @ w_o


def moe(h, w_router, b_router, w_e_in, b_e_in, w_e_out, b_e_out):
    logits = (h @ w_router + b_router).astype(jnp.float32)
    top_v, top_i = lax.top_k(logits, TOP_K)
    probs = jax.nn.softmax(top_v, axis=-1)
    gates = jnp.einsum('nk,nke->ne', probs, jax.nn.one_hot(top_i, N_EXPERTS, dtype=jnp.float32)).astype(h.dtype)
    out = jnp.zeros_like(h)
    for e in range(N_EXPERTS):
        z = h @ w_e_in[e] + b_e_in[e]
        glu = jnp.minimum(z[:, :D_FF], SWIGLU_LIMIT)
        lin = jnp.clip(z[:, D_FF:], -SWIGLU_LIMIT, SWIGLU_LIMIT)
        act = glu * jax.nn.sigmoid(SWIGLU_ALPHA * glu) * (lin + 1.0)
        out = out + gates[:, e:e + 1] * (act @ w_e_out[e] + b_e_out[e])
    return out


def setup_inputs(seed: int = 0) -> dict:
    key = jax.random.key(seed)
    ks = jax.random.split(key, 40)
    f32 = jnp.float32
    D = D_MODEL

    def nrm(k, shape, scale):
        return jax.random.normal(k, shape, f32) * scale

    x = nrm(ks[0], (BATCH, SEQ, D), 1.0)
    c = nrm(ks[1], (BATCH, D), 1.0)
    ctx = nrm(ks[2], (BATCH, CTX_LEN, D), 1.0)
    c_ctx = nrm(ks[3], (D,), 1.0)
    w_ada = nrm(ks[4], (DEPTH, D, N_MOD * D), 0.5 * D ** -0.5)
    b_ada = nrm(ks[5], (DEPTH, N_MOD * D), 0.02)
    g_norm1 = 1.0 + nrm(ks[6], (DEPTH, D), 0.02)
    g_norm2 = 1.0 + nrm(ks[7], (DEPTH, D), 0.02)
    w_in = nrm(ks[8], (DEPTH, D, IN_COLS), D ** -0.5)
    w_conv_qk = nrm(ks[9], (DEPTH, CONV_K, CONV_K, 2 * M_QK_W), 1.0 / CONV_K)
    b_i = nrm(ks[10], (DEPTH, 2, 1, M_HEADS), 0.1)
    b_f = jnp.linspace(3.0, 6.0, M_HEADS, dtype=f32) + nrm(ks[11], (DEPTH, 2, 1, M_HEADS), 0.1)
    b_ifgate = jnp.concatenate([b_i, b_f], axis=2)
    g_mh = 1.0 + nrm(ks[12], (DEPTH, M_V_W), 0.02)
    w_branch_m = nrm(ks[13], (DEPTH, M_V_W, D), M_V_W ** -0.5)
    s5_a_re = -0.5 * jnp.exp(nrm(ks[14], (DEPTH, 2, S5_GROUPS, S5_STATE), 0.02))
    s5_a_im = math.pi * jnp.arange(S5_STATE, dtype=f32) + nrm(ks[15], (DEPTH, 2, S5_GROUPS, S5_STATE), 0.01)
    s5_log_dt = jax.random.uniform(ks[16], (DEPTH, 2, S5_GROUPS), f32, math.log(1e-3), math.log(1e-1))
    s5_b_re = nrm(ks[17], (DEPTH, 2, S5_GROUPS, S5_STATE, S5_GROUP), (2 * S5_GROUP) ** -0.5)
    s5_b_im = nrm(ks[18], (DEPTH, 2, S5_GROUPS, S5_STATE, S5_GROUP), (2 * S5_GROUP) ** -0.5)
    s5_c_re = nrm(ks[19], (DEPTH, 2, S5_GROUPS, S5_GROUP, S5_STATE), 0.5)
    s5_c_im = nrm(ks[20], (DEPTH, 2, S5_GROUPS, S5_GROUP, S5_STATE), 0.5)
    s5_d = nrm(ks[21], (DEPTH, S5_WIDTH), 1.0)
    w_glu = nrm(ks[22], (DEPTH, S5_WIDTH, S5_WIDTH), S5_WIDTH ** -0.5)
    b_glu = nrm(ks[23], (DEPTH, S5_WIDTH), 0.02)
    w_branch_s = nrm(ks[24], (DEPTH, S5_WIDTH, D), S5_WIDTH ** -0.5)
    b_merge_gate = nrm(ks[25], (DEPTH, 2 * D), 0.02)
    w_o = nrm(ks[26], (DEPTH, D, D), D ** -0.5)
    w_router = nrm(ks[27], (DEPTH, D, N_EXPERTS), D ** -0.5)
    b_router = nrm(ks[28], (DEPTH, N_EXPERTS), 0.01)
    w_e_in = nrm(ks[29], (DEPTH, N_EXPERTS, D, 2 * D_FF), D ** -0.5)
    b_e_in = nrm(ks[30], (DEPTH, N_EXPERTS, 2 * D_FF), 0.01)
    w_e_out = nrm(ks[31], (DEPTH, N_EXPERTS, D_FF, D), D_FF ** -0.5)
    b_e_out = nrm(ks[32], (DEPTH, N_EXPERTS, D), 0.01)
    g_final = 1.0 + nrm(ks[33], (D,), 0.02)
    return {'x': x, 'c': c, 'ctx': ctx, 'c_ctx': c_ctx, 'w_ada': w_ada, 'b_ada': b_ada,
            'g_norm1': g_norm1, 'g_norm2': g_norm2, 'w_in': w_in, 'w_conv_qk': w_conv_qk,
            'b_ifgate': b_ifgate, 'g_mh': g_mh, 'w_branch_m': w_branch_m,
            's5_a_re': s5_a_re, 's5_a_im': s5_a_im, 's5_log_dt': s5_log_dt,
            's5_b_re': s5_b_re, 's5_b_im': s5_b_im, 's5_c_re': s5_c_re, 's5_c_im': s5_c_im,
            's5_d': s5_d, 'w_glu': w_glu, 'b_glu': b_glu, 'w_branch_s': w_branch_s,
            'b_merge_gate': b_merge_gate, 'w_o': w_o, 'w_router': w_router, 'b_router': b_router,
            'w_e_in': w_e_in, 'b_e_in': b_e_in, 'w_e_out': w_e_out, 'b_e_out': b_e_out,
            'g_final': g_final}


def reference(x, c, ctx, c_ctx, w_ada, b_ada, g_norm1, g_norm2, w_in, w_conv_qk, b_ifgate, g_mh,
              w_branch_m, s5_a_re, s5_a_im, s5_log_dt, s5_b_re, s5_b_im, s5_c_re, s5_c_im, s5_d,
              w_glu, b_glu, w_branch_s, b_merge_gate, w_o, w_router, b_router, w_e_in, b_e_in,
              w_e_out, b_e_out, g_final):
    f32 = jnp.float32
    D = D_MODEL
    bsz = x.shape[0]
    m_zero = (jnp.zeros((bsz, M_HEADS, M_DV, M_DQK), f32), jnp.zeros((bsz, M_HEADS, M_DQK), f32),
              jnp.zeros((bsz, M_HEADS), f32))
    s_zero = (jnp.zeros((bsz, S5_GROUPS, S5_STATE), f32), jnp.zeros((bsz, S5_GROUPS, S5_STATE), f32))
    for l in range(DEPTH):
        last = l == DEPTH - 1
        mod = jax.nn.silu(c) @ w_ada[l] + b_ada[l]
        sh1, sc1, gt1, sh2, sc2, gt2 = jnp.split(mod[:, None, :], N_MOD, axis=-1)
        n_mod_c = 2 if last else N_MOD
        mod_c = jnp.split(jax.nn.silu(c_ctx) @ w_ada[l][:, :n_mod_c * D] + b_ada[l][:n_mod_c * D], n_mod_c)
        h_l = modulate(rmsnorm(x, g_norm1[l]), sh1, sc1)
        h_c = modulate(rmsnorm(ctx, g_norm1[l]), mod_c[0], mod_c[1])
        n_cols_c = STATE_COLS if last else IN_COLS
        proj_c = h_c @ w_in[l][:, :n_cols_c]
        proj_l = h_l @ w_in[l]
        disc = [s5_discretise(s5_a_re[l, d], s5_a_im[l, d], s5_log_dt[l, d], s5_b_re[l, d], s5_b_im[l, d])
                for d in range(2)]
        m_ctx, s_ctx, hm_c, ys_c = mixer_core(proj_c, conv_ctx, w_conv_qk[l], b_ifgate[l], disc,
                                              s5_c_re[l], s5_c_im[l], s5_d[l],
                                              [m_zero, m_zero], [s_zero, s_zero], not last)
        _, _, hm_l, ys_l = mixer_core(proj_l, conv_lat, w_conv_qk[l], b_ifgate[l], disc,
                                      s5_c_re[l], s5_c_im[l], s5_d[l], m_ctx, s_ctx, True)
        x = x + gt1 * mixer_out(proj_l, hm_l, ys_l, g_mh[l], w_glu[l], b_glu[l], w_branch_m[l],
                                w_branch_s[l], b_merge_gate[l], w_o[l])
        h2 = modulate(rmsnorm(x, g_norm2[l]), sh2, sc2)
        x = x + gt2 * moe(h2.reshape(-1, D), w_router[l], b_router[l], w_e_in[l], b_e_in[l],
                          w_e_out[l], b_e_out[l]).reshape(x.shape)
        if not last:
            ctx = ctx + mod_c[2] * mixer_out(proj_c, hm_c, ys_c, g_mh[l], w_glu[l], b_glu[l], w_branch_m[l],
                                             w_branch_s[l], b_merge_gate[l], w_o[l])
            h2c = modulate(rmsnorm(ctx, g_norm2[l]), mod_c[3], mod_c[4])
            ctx = ctx + mod_c[5] * moe(h2c.reshape(-1, D), w_router[l], b_router[l], w_e_in[l], b_e_in[l],
                                       w_e_out[l], b_e_out[l]).reshape(ctx.shape)
    return rmsnorm(x, g_final)
```

```cpp
#include <hip/hip_runtime.h>
#include <cstdio>
#include <cstdint>

#ifndef MK_N_LAUNCHES
#define MK_N_LAUNCHES 1
#endif

namespace pg8 {
#define PG8_LAS __attribute__((address_space(3)))
typedef unsigned short bf16_t;
typedef short bf16x8 __attribute__((ext_vector_type(8)));
typedef float f32x4 __attribute__((ext_vector_type(4)));
typedef unsigned u32x4 __attribute__((ext_vector_type(4)));
constexpr int BM = 256, BK = 64, HALF = 128, HTB = HALF * BK * 2, STAGE_BYTES = 8 * HTB, NXCD = 8, WGM = 8;

__host__ __device__ __forceinline__ int lds_byte(int r, int c) { const int st = (r >> 4) * 2 + (c >> 5), rr = r & 15, cc = c & 31, ob = rr * 64 + cc * 2; return st * 1024 + (ob ^ (((ob >> 9) & 1) << 5)); }
__host__ __device__ __forceinline__ void stage_rc(int b, int& R, int& C) { const int st = b / 1024, sb = b % 1024, swz = sb ^ (((sb >> 9) & 1) << 5); R = (st >> 1) * 16 + swz / 64; C = (st & 1) * 32 + (swz % 64) / 2; }
__host__ __device__ __forceinline__ int perm32(int rho) { const int n = rho >> 4, i = rho & 15; return 8 * (i >> 2) + 4 * n + (i & 3); }

struct Unit { int pm, pn, lbase, nvalid; };
struct Gemm { const bf16_t* A; const bf16_t* Bt; int K; const int* rowlist; };

__device__ __forceinline__ int xcd_remap(int L, int nwg) { const int q = nwg / NXCD, r = nwg % NXCD, xcd = L % NXCD, off = L / NXCD; return (xcd < r ? xcd * (q + 1) : r * (q + 1) + (xcd - r) * q) + off; }

struct StaticOrder {
    int nM, nN, nwg, G, c;
    __device__ void init(int M, int N, int G_, int c_) { nM = M / BM; nN = N / BM; nwg = nM * nN; G = G_; c = c_; }
    __device__ __forceinline__ bool next(int i, Unit& u) const {
        const long L = (long)i * G + c; if (L >= nwg) return false;
        const int wgid = xcd_remap((int)L, nwg);
        const int nig = WGM * nN, gid = wgid / nig, fm = gid * WGM, gsz = (nM - fm) < WGM ? (nM - fm) : WGM;
        u.pm = fm + ((wgid % nig) % gsz); u.pn = (wgid % nig) / gsz; u.lbase = 0; u.nvalid = 0; return true;
    }
};

__device__ __forceinline__ unsigned cvt_pk_bf16(float lo, float hi) { unsigned r; asm volatile("v_cvt_pk_bf16_f32 %0, %1, %2" : "=v"(r) : "v"(lo), "v"(hi)); return r; }

template <class Epi, class Sched, bool GATHER>
__device__ __forceinline__ void gemm_phase(PG8_LAS unsigned char* lds, const Gemm g, const Sched& S, const Epi& E) {
    const int tid = threadIdx.x, wid = __builtin_amdgcn_readfirstlane(tid >> 6), lane = tid & 63, wr = wid >> 2, wc = wid & 3, fr = lane & 15, fq = lane >> 4;
    const int K = g.K, nt = K / BK;
    int Rr[2]; unsigned cby[2], voffB[2];
#pragma unroll
    for (int i = 0; i < 2; ++i) { int R, C; stage_rc(tid * 16 + i * 8192, R, C); const int Rb = Epi::PERM ? ((R & ~31) + perm32(R & 31)) : R;
        Rr[i] = R; cby[i] = (unsigned)C * 2u; voffB[i] = (unsigned)(Rb * K + C) * 2u; }
    const size_t kstep = (size_t)(BK * 2);
    const size_t hstep = (size_t)HALF * K * 2;
    const size_t tstep = 2 * hstep;
    const unsigned ldsw = (unsigned)wid * 1024u;
    const int aoff = lds_byte(wr * 64 + fr, fq * 8), boff = lds_byte(wc * 32 + fr, fq * 8);
#define PG8_SA(b, h) (((b) * 2 + (h)) * HTB)
#define PG8_SB(b, h) ((4 + (b) * 2 + (h)) * HTB)
#define PG8_STAGE(bufoff, gbase, voff) do { _Pragma("unroll") for (int _i = 0; _i < 2; ++_i) \
        __builtin_amdgcn_global_load_lds((const unsigned*)((const char*)(gbase) + (voff)[_i]), (PG8_LAS unsigned*)(lds + (bufoff) + ldsw + _i * 8192), 16, 0, 0); } while (0)
#define PG8_LDA(dst, b, h) do { _Pragma("unroll") for (int m = 0; m < 4; ++m) _Pragma("unroll") for (int k = 0; k < 2; ++k) dst[m][k] = *(const PG8_LAS bf16x8*)(lds + PG8_SA(b, h) + aoff + m * 2048 + k * 1024); } while (0)
#define PG8_LDB(dst, b, h) do { _Pragma("unroll") for (int n = 0; n < 2; ++n) _Pragma("unroll") for (int k = 0; k < 2; ++k) dst[n][k] = *(const PG8_LAS bf16x8*)(lds + PG8_SB(b, h) + boff + n * 2048 + k * 1024); } while (0)
#define PG8_MMA(ai, bj, At, Bt) do { __builtin_amdgcn_s_setprio(1); _Pragma("unroll") for (int m = 0; m < 4; ++m) _Pragma("unroll") for (int n = 0; n < 2; ++n) _Pragma("unroll") for (int k = 0; k < 2; ++k) \
        acc[ai][bj][m][n] = __builtin_amdgcn_mfma_f32_16x16x32_bf16(Bt[n][k], At[m][k], acc[ai][bj][m][n], 0, 0, 0); __builtin_amdgcn_s_setprio(0); } while (0)
#define PG8_WAIT_V(n) asm volatile("s_waitcnt vmcnt(" #n ")" ::: "memory")
#define PG8_WAIT_L(n) asm volatile("s_waitcnt lgkmcnt(" #n ")" ::: "memory")
#define PG8_BAR __builtin_amdgcn_s_barrier()
#define PG8_SCHED __builtin_amdgcn_sched_barrier(0)
#define PG8_AOFF(dst, u) do { _Pragma("unroll") for (int _h = 0; _h < 2; ++_h) _Pragma("unroll") for (int _i = 0; _i < 2; ++_i) { const int _r = _h * HALF + Rr[_i]; \
        if constexpr (GATHER) { const int _idx = (_r < (u).nvalid) ? g.rowlist[(u).lbase + _r] : 0; dst[_h][_i] = (unsigned)_idx * (unsigned)(K * 2) + cby[_i]; } \
        else { dst[_h][_i] = (unsigned)(_r * K * 2) + cby[_i]; } } } while (0)
    Unit cur, nxt; int ui = 0;
    if (!S.next(0, cur)) return;
    f32x4 acc[2][2][4][2];
#pragma unroll
    for (int a = 0; a < 2; ++a)
#pragma unroll
        for (int b = 0; b < 2; ++b)
#pragma unroll
            for (int m = 0; m < 4; ++m)
#pragma unroll
                for (int n = 0; n < 2; ++n) acc[a][b][m][n] = (f32x4){0.f, 0.f, 0.f, 0.f};
    bf16x8 At[4][2], B0[2][2], B1[2][2];
    unsigned vc[2][2], vn[2][2];
    PG8_AOFF(vc, cur);
    const char* cA = GATHER ? (const char*)g.A : (const char*)g.A + (size_t)cur.pm * tstep; const char* cB = (const char*)g.Bt + (size_t)cur.pn * tstep;
    PG8_STAGE(PG8_SB(0, 0), cB, voffB); PG8_STAGE(PG8_SB(0, 1), cB + hstep, voffB); PG8_STAGE(PG8_SA(0, 0), cA, vc[0]); PG8_STAGE(PG8_SA(0, 1), cA, vc[1]);
    if (wr == 1) PG8_BAR;
    PG8_WAIT_V(2); PG8_BAR;
    PG8_STAGE(PG8_SB(1, 0), cB + kstep, voffB); PG8_STAGE(PG8_SA(1, 0), cA + kstep, vc[0]); PG8_STAGE(PG8_SB(1, 1), cB + hstep + kstep, voffB);
    PG8_WAIT_V(6); PG8_BAR;
    for (;;) {
        const bool has_next = S.next(ui + 1, nxt);
        const char* nA = (has_next && !GATHER) ? (const char*)g.A + (size_t)nxt.pm * tstep : cA; const char* nB = has_next ? (const char*)g.Bt + (size_t)nxt.pn * tstep : cB;
        if constexpr (GATHER) { if (has_next) { PG8_AOFF(vn, nxt); } else {
#pragma unroll
            for (int h = 0; h < 2; ++h) { vn[h][0] = vc[h][0]; vn[h][1] = vc[h][1]; } } }
        for (int t = 0; t < nt; t += 2) {
            const bool last = (t == nt - 2);
            const char* a1 = cA + (size_t)(t + 1) * kstep;
            const char* a2 = last ? nA : cA + (size_t)(t + 2) * kstep; const char* b2 = last ? nB : cB + (size_t)(t + 2) * kstep;
            const char* a3 = a2 + kstep; const char* b3 = b2 + kstep;
            unsigned v2[2][2];
#pragma unroll
            for (int h = 0; h < 2; ++h)
#pragma unroll
                for (int i = 0; i < 2; ++i) v2[h][i] = GATHER ? (last ? vn[h][i] : vc[h][i]) : vc[h][i];
            PG8_LDB(B0, 0, 0); PG8_LDB(B1, 0, 1); PG8_SCHED; PG8_LDA(At, 0, 0); PG8_STAGE(PG8_SA(1, 1), a1, vc[1]);
            PG8_WAIT_V(8); PG8_WAIT_L(0); PG8_BAR; PG8_MMA(0, 0, At, B0); PG8_MMA(0, 1, At, B1); PG8_BAR; PG8_SCHED;
            PG8_LDA(At, 0, 1); PG8_STAGE(PG8_SB(0, 0), b2, voffB); PG8_STAGE(PG8_SB(0, 1), b2 + hstep, voffB); PG8_STAGE(PG8_SA(0, 0), a2, v2[0]);
            PG8_WAIT_V(8); PG8_WAIT_L(0); PG8_BAR; PG8_MMA(1, 0, At, B0); PG8_MMA(1, 1, At, B1); PG8_BAR; PG8_SCHED;
            PG8_LDB(B0, 1, 0); PG8_LDB(B1, 1, 1); PG8_SCHED; PG8_LDA(At, 1, 0); PG8_STAGE(PG8_SA(0, 1), a2, v2[1]);
            PG8_WAIT_V(8); PG8_WAIT_L(0); PG8_BAR; PG8_MMA(0, 0, At, B0); PG8_MMA(0, 1, At, B1); PG8_BAR; PG8_SCHED;
            PG8_LDA(At, 1, 1); PG8_STAGE(PG8_SB(1, 0), b3, voffB); PG8_STAGE(PG8_SB(1, 1), b3 + hstep, voffB); PG8_STAGE(PG8_SA(1, 0), a3, v2[0]);
            PG8_WAIT_V(8); PG8_WAIT_L(0); PG8_BAR; PG8_MMA(1, 0, At, B0); PG8_MMA(1, 1, At, B1); PG8_BAR; PG8_SCHED;
        }
        if (wr == 0) PG8_BAR;
        E(acc, cur, wr, wc, fr, fq);
        if (!has_next) break;
#pragma unroll
        for (int a = 0; a < 2; ++a)
#pragma unroll
            for (int b = 0; b < 2; ++b)
#pragma unroll
                for (int m = 0; m < 4; ++m)
#pragma unroll
                    for (int n = 0; n < 2; ++n) acc[a][b][m][n] = (f32x4){0.f, 0.f, 0.f, 0.f};
        cur = nxt; cA = nA; cB = nB; ++ui;
        if constexpr (GATHER) {
#pragma unroll
            for (int h = 0; h < 2; ++h) { vc[h][0] = vn[h][0]; vc[h][1] = vn[h][1]; } }
        if (wr == 1) PG8_BAR;
    }
    PG8_WAIT_V(0);
    PG8_BAR;
#undef PG8_SA
#undef PG8_SB
#undef PG8_STAGE
#undef PG8_LDA
#undef PG8_LDB
#undef PG8_MMA
#undef PG8_WAIT_V
#undef PG8_WAIT_L
#undef PG8_BAR
#undef PG8_SCHED
#undef PG8_AOFF
}
}

constexpr int NWAVES = 8;
constexpr int D = 1024, NB = 8, SEQ = 4096, CTXL = 256;
constexpr int ML = NB * SEQ, MC = NB * CTXL, MT = ML + MC;
constexpr int LDP = 5888;
constexpr int PC_QK = 0, PC_V = 1024, PC_U = 2048, PC_O = 2560, PC_G = 3584, PC_IF = 5632;
constexpr int NEXP = 32, TOPK = 4;
constexpr int MAXTILES = (ML * TOPK + NEXP * 256) / 256;
constexpr float EPS = 1e-6f;
constexpr int NPH = 14;
constexpr int N_LAUNCHES = MK_N_LAUNCHES;

constexpr size_t MiB = 1u << 20;
constexpr size_t WS_CTL = 0, CTL_ZERO_BYTES = 1 * MiB;
constexpr size_t WS_MOD = 1 * MiB;
constexpr size_t WS_TOPE = 2 * MiB, WS_POS = 2 * MiB + 512 * 1024, WS_TOPP = 3 * MiB, WS_LIST = 4 * MiB;
constexpr size_t WS_WIN = 8 * MiB, WS_WGLU = 20 * MiB, WS_WA = 21 * MiB, WS_WB = 23 * MiB, WS_WO = 24 * MiB, WS_WEIN = 26 * MiB, WS_WEOUT = 154 * MiB;
constexpr size_t WS_R0 = 218 * MiB;
constexpr size_t WS_PROJ = WS_R0, WS_H1 = 609 * MiB, WS_QKC = 677 * MiB, WS_HDIR = 745 * MiB, WS_YDIR = 873 * MiB, WS_END = 937 * MiB;
constexpr size_t WS_A1 = WS_H1, WS_A2 = WS_QKC, WS_A3 = WS_QKC + 32 * MiB, WS_YA = WS_HDIR, WS_MERGED = WS_HDIR + 64 * MiB;
constexpr size_t WS_H2 = WS_R0, WS_ACT = 282 * MiB, WS_Y = 554 * MiB;
static_assert(WS_PROJ + (size_t)MT * LDP * 2 <= WS_H1 && WS_Y + (size_t)MAXTILES * 256 * 1024 * 2 <= WS_END, "ws map");
constexpr int CW_BAR = 4096, CW_CNT = 16384;

constexpr int RING_BYTES = 131072;
constexpr int LDSCTL_OFF = RING_BYTES, MISC_OFF = LDSCTL_OFF + 320, TAB_OFF = LDSCTL_OFF + 512;
constexpr int LDS_BYTES = 147456;

#define GAS __attribute__((address_space(1)))
#define LAS __attribute__((address_space(3)))
typedef unsigned short bf16;
typedef unsigned v4u __attribute__((ext_vector_type(4)));
typedef unsigned v2u __attribute__((ext_vector_type(2)));
typedef float f32x4 __attribute__((ext_vector_type(4)));
typedef float f32x16 __attribute__((ext_vector_type(16)));
typedef short bf16x8 __attribute__((ext_vector_type(8)));
typedef GAS unsigned gu32;
#define RLX_AGENT __ATOMIC_RELAXED, __HIP_MEMORY_SCOPE_AGENT
#define LDS_WAIT() asm volatile("s_waitcnt lgkmcnt(0)" ::: "memory")
__device__ __forceinline__ unsigned f2bf(float f) { unsigned u = __builtin_bit_cast(unsigned, f); return (u + 0x7fffu + ((u >> 16) & 1u)) >> 16; }
__device__ __forceinline__ unsigned pk2(float lo, float hi) { return f2bf(lo) | (f2bf(hi) << 16); }
__device__ __forceinline__ float bf2f(unsigned b) { return __builtin_bit_cast(float, b << 16); }
__device__ __forceinline__ float bflo(unsigned w) { return __builtin_bit_cast(float, w << 16); }
__device__ __forceinline__ float bfhi(unsigned w) { return __builtin_bit_cast(float, w & 0xffff0000u); }
__device__ __forceinline__ float sigmoidf_(float x) { return 1.0f / (1.0f + __expf(-x)); }

#define XB_TMO      128
#define XB_XCNT(j)  (256  + 64 * (j))
#define XB_XSUB(j)  (1280 + 64 * (j))
#define XB_XGEN(j)  (2304 + 64 * (j))
#define XB_TOP      3328
#define XB_TOPGEN   3392
#define XCD_BAR_WORDS 3456
#define XB_SPIN_CAP (1u << 22)
__device__ __forceinline__ unsigned xb_ld(unsigned* p)              { return __hip_atomic_load(p, __ATOMIC_RELAXED, __HIP_MEMORY_SCOPE_AGENT); }
__device__ __forceinline__ unsigned xb_add(unsigned* p, unsigned v) { return __hip_atomic_fetch_add(p, v, __ATOMIC_RELAXED, __HIP_MEMORY_SCOPE_AGENT); }
__device__ __forceinline__ unsigned xb_xcc_id() { return (unsigned)__builtin_amdgcn_s_getreg((3 << 11) | 20) & 0xFu; }
#define XB_SPIN(cond, bar) do { unsigned _sp = 0; while (cond) { __builtin_amdgcn_s_sleep(1); \
    if ((++_sp & 255u) == 0u) { if (xb_ld(&(bar)[XB_TMO])) break; if (_sp > XB_SPIN_CAP) { atomicAdd(&(bar)[XB_TMO], 1u); break; } } } } while (0)
struct XcdBarrier { unsigned* bar; unsigned x; volatile LAS unsigned* st; };
__device__ __forceinline__ XcdBarrier xcd_barrier_post(unsigned* bar, volatile LAS unsigned* st) {
    XcdBarrier b; b.bar = bar; b.x = xb_xcc_id(); b.st = st;
    if (threadIdx.x == 0) (void)xb_add(&bar[XB_XCNT(b.x)], 1u);
    return b;
}
__device__ __forceinline__ void xcd_barrier_complete(unsigned* bar, unsigned x, unsigned& nloc, unsigned& nx) {
    const unsigned G = gridDim.x * gridDim.y * gridDim.z;
    unsigned sum, cnt, mine, sp = 0u;
    for (;;) {
        sum = 0u; cnt = 0u; mine = 0u;
#pragma unroll
        for (unsigned j = 0; j < 16; ++j) { const unsigned c = xb_ld(&bar[XB_XCNT(j)]); sum += c; cnt += (c > 0u) ? 1u : 0u; mine = (j == x) ? c : mine; }
        if (sum == G) break;
        __builtin_amdgcn_s_sleep(1);
        if ((++sp & 255u) == 0u) { if (xb_ld(&bar[XB_TMO])) break; if (sp > XB_SPIN_CAP) { atomicAdd(&bar[XB_TMO], 1u); break; } }
    }
    nloc = mine > 0u ? mine : 1u; nx = cnt > 0u ? cnt : 1u;
}
__device__ __forceinline__ void xcd_barrier(const XcdBarrier& b) {
    asm volatile("s_waitcnt vmcnt(0)" ::: "memory");
    __syncthreads();
    if (threadIdx.x == 0) {
        unsigned* bar = b.bar;
        __builtin_amdgcn_s_waitcnt(0);
        unsigned nloc = b.st[0], nx = b.st[1];
        if (nloc == 0u) { xcd_barrier_complete(bar, b.x, nloc, nx); b.st[0] = nloc; b.st[1] = nx; }
        const unsigned old = xb_add(&bar[XB_XSUB(b.x)], 1u);
        const unsigned gen = old / nloc;
        if (old + 1u == (gen + 1u) * nloc) {
            __builtin_amdgcn_fence(__ATOMIC_RELEASE, "agent");
            asm volatile("s_waitcnt vmcnt(0)" ::: "memory");
            const unsigned og = xb_add(&bar[XB_TOP], 1u);
            const unsigned tg = og / nx;
            if (og + 1u == (tg + 1u) * nx) xb_add(&bar[XB_TOPGEN], 1u);
            else XB_SPIN(xb_ld(&bar[XB_TOPGEN]) == tg, bar);
            __builtin_amdgcn_fence(__ATOMIC_ACQUIRE, "agent");
            xb_add(&bar[XB_XGEN(b.x)], 1u);
            asm volatile("s_waitcnt vmcnt(0)" ::: "memory");
        } else {
            XB_SPIN(xb_ld(&bar[XB_XGEN(b.x)]) == gen, bar);
            __builtin_amdgcn_fence(__ATOMIC_ACQUIRE, "agent");
            asm volatile("s_waitcnt vmcnt(0)" ::: "memory");
        }
    }
    __syncthreads();
}

struct Frame {
    LAS unsigned char* lds;
    gu32* ctl;
    int tid, lane, wave, vcu, G;
    float* out; unsigned char* ws;
};
__device__ __forceinline__ float wave_sum(float v) {
#pragma unroll
    for (int o = 1; o < 64; o <<= 1) v += __shfl_xor(v, o);
    return v;
}

struct InProjOrder {
    int G, c;
    __device__ __forceinline__ bool next(int i, pg8::Unit& u) const {
        const int NL = 128 * 23, NC = 8 * 11;
        const long L = (long)i * G + c; if (L >= NL + NC) return false;
        u.lbase = 0; u.nvalid = 0;
        if (L < NL) { const int wgid = pg8::xcd_remap((int)L, NL); const int nig = 8 * 23, gid = wgid / nig, fm = gid * 8; u.pm = fm + ((wgid % nig) % 8); u.pn = (wgid % nig) / 8; }
        else { const int r = (int)L - NL; u.pm = 128 + r / 11; const int q = r % 11; u.pn = q < 10 ? q : 22; }
        return true;
    }
};
struct MoeOrder {
    int G, c, npn; const LAS int* tab;
    __device__ __forceinline__ bool next(int i, pg8::Unit& u) const {
        const int nT = __builtin_amdgcn_readfirstlane(tab[32]); const int nU = nT * npn;
        const long L = (long)i * G + c; if (L >= nU) return false;
        const int wgid = pg8::xcd_remap((int)L, nU);
        const int tau = wgid / npn, pl = wgid % npn;
        int e = 0;
        for (int k = 1; k < 32; ++k) e += (__builtin_amdgcn_readfirstlane(tab[k]) <= tau) ? 1 : 0;
        const int il = tau - __builtin_amdgcn_readfirstlane(tab[e]);
        u.pm = tau; u.pn = e * npn + pl; u.lbase = e * ML + 256 * il; u.nvalid = __builtin_amdgcn_readfirstlane(tab[33 + e]) - 256 * il;
        return true;
    }
};
__device__ __forceinline__ void moe_tables(Frame& F) {
    LAS int* tab = (LAS int*)(F.lds + TAB_OFF);
    __syncthreads();
    if (F.tid == 0) {
        int acc = 0;
        for (int e = 0; e < 32; ++e) { const int n = (int)__hip_atomic_load(F.ctl + CW_CNT + 64 * e, RLX_AGENT); tab[e] = acc; tab[33 + e] = n; acc += (n + 255) >> 8; }
        tab[32] = acc;
    }
    __syncthreads();
}

using pg8::f32x4; using pg8::u32x4; using pg8::cvt_pk_bf16;
#define EPI_ROWS(u) const int row0 = (u).pm * 256 + wr * 64 + fr
#define EPI_LOOP _Pragma("unroll") for (int ai = 0; ai < 2; ++ai) _Pragma("unroll") for (int m = 0; m < 4; ++m)
__device__ __forceinline__ u32x4 pack8(const f32x4 a, const f32x4 b) { u32x4 w; w.x = cvt_pk_bf16(a[0], a[1]); w.y = cvt_pk_bf16(a[2], a[3]); w.z = cvt_pk_bf16(b[0], b[1]); w.w = cvt_pk_bf16(b[2], b[3]); return w; }
__device__ __forceinline__ void unpack8(const u32x4 w, f32x4& a, f32x4& b) { a = (f32x4){bflo(w.x), bfhi(w.x), bflo(w.y), bfhi(w.y)}; b = (f32x4){bflo(w.z), bfhi(w.z), bflo(w.w), bfhi(w.w)}; }
__device__ __forceinline__ f32x4 sig4(f32x4 x) { return (f32x4){sigmoidf_(x[0]), sigmoidf_(x[1]), sigmoidf_(x[2]), sigmoidf_(x[3])}; }

struct EpiStore {
    static constexpr bool PERM = true; bf16* O; int ldc;
    __device__ __forceinline__ void operator()(const f32x4 (&acc)[2][2][4][2], const pg8::Unit& u, int wr, int wc, int fr, int fq) const {
        EPI_ROWS(u); const int col0 = u.pn * 256 + wc * 32 + 8 * fq;
        EPI_LOOP { bf16* rowp = O + (size_t)(row0 + ai * 128 + m * 16) * ldc + col0;
#pragma unroll
            for (int bj = 0; bj < 2; ++bj) *(u32x4*)(rowp + bj * 128) = pack8(acc[ai][bj][m][0], acc[ai][bj][m][1]); }
    }
};
struct EpiGlu {
    static constexpr bool PERM = true; const bf16* A2; bf16* A3; const float* bias;
    __device__ __forceinline__ void operator()(const f32x4 (&acc)[2][2][4][2], const pg8::Unit& u, int wr, int wc, int fr, int fq) const {
        EPI_ROWS(u); const int col0 = u.pn * 256 + wc * 32 + 8 * fq;
        f32x4 bv[2][2];
#pragma unroll
        for (int bj = 0; bj < 2; ++bj)
#pragma unroll
            for (int n = 0; n < 2; ++n) bv[bj][n] = *(const f32x4*)(bias + col0 + bj * 128 + 4 * n);
        EPI_LOOP { const size_t off = (size_t)(row0 + ai * 128 + m * 16) * 512 + col0;
#pragma unroll
            for (int bj = 0; bj < 2; ++bj) { f32x4 a0, a1; unpack8(*(const u32x4*)(A2 + off + bj * 128), a0, a1);
                const f32x4 v0 = a0 * sig4(acc[ai][bj][m][0] + bv[bj][0]), v1 = a1 * sig4(acc[ai][bj][m][1] + bv[bj][1]);
                *(u32x4*)(A3 + off + bj * 128) = pack8(v0, v1); } }
    }
};
template <bool ADD> struct EpiGate {
    static constexpr bool PERM = true; const bf16* proj; int gc0; const float* bg; const bf16* Prev; bf16* O;
    __device__ __forceinline__ void operator()(const f32x4 (&acc)[2][2][4][2], const pg8::Unit& u, int wr, int wc, int fr, int fq) const {
        EPI_ROWS(u); const int col0 = u.pn * 256 + wc * 32 + 8 * fq;
        f32x4 bv[2][2];
#pragma unroll
        for (int bj = 0; bj < 2; ++bj)
#pragma unroll
            for (int n = 0; n < 2; ++n) bv[bj][n] = *(const f32x4*)(bg + col0 + bj * 128 + 4 * n);
        EPI_LOOP { const int row = row0 + ai * 128 + m * 16; const size_t off = (size_t)row * 1024 + col0; const size_t poff = (size_t)row * LDP + gc0 + col0;
#pragma unroll
            for (int bj = 0; bj < 2; ++bj) { f32x4 g0, g1; unpack8(*(const u32x4*)(proj + poff + bj * 128), g0, g1);
                f32x4 v0 = sig4(g0 + bv[bj][0]) * acc[ai][bj][m][0], v1 = sig4(g1 + bv[bj][1]) * acc[ai][bj][m][1];
                if (ADD) { f32x4 p0, p1; unpack8(*(const u32x4*)(Prev + off + bj * 128), p0, p1); v0 += p0; v1 += p1; }
                *(u32x4*)(O + off + bj * 128) = pack8(v0, v1); } }
    }
};
struct EpiX1 {
    static constexpr bool PERM = false; const float* x; const float* mod; float* X1;
    __device__ __forceinline__ void operator()(const f32x4 (&acc)[2][2][4][2], const pg8::Unit& u, int wr, int wc, int fr, int fq) const {
        EPI_ROWS(u); const int col0 = u.pn * 256 + wc * 32 + 4 * fq; const int b = (u.pm * 256) / SEQ;
        f32x4 gv[2][2];
#pragma unroll
        for (int bj = 0; bj < 2; ++bj)
#pragma unroll
            for (int n = 0; n < 2; ++n) gv[bj][n] = *(const f32x4*)(mod + b * 6144 + 2 * D + col0 + bj * 128 + n * 16);
        EPI_LOOP { const size_t off = (size_t)(row0 + ai * 128 + m * 16) * D + col0;
#pragma unroll
            for (int bj = 0; bj < 2; ++bj)
#pragma unroll
                for (int n = 0; n < 2; ++n) *(f32x4*)(X1 + off + bj * 128 + n * 16) = *(const f32x4*)(x + off + bj * 128 + n * 16) + gv[bj][n] * acc[ai][bj][m][n]; }
    }
};
struct EpiSwiglu {
    static constexpr bool PERM = true; const float* bin; bf16* ACT;
    __device__ __forceinline__ void operator()(const f32x4 (&acc)[2][2][4][2], const pg8::Unit& u, int wr, int wc, int fr, int fq) const {
        EPI_ROWS(u); const int e = u.pn >> 3, pl = u.pn & 7; const int f0 = pl * 128 + wc * 32 + 8 * fq;
        f32x4 bg[2], bl[2];
#pragma unroll
        for (int n = 0; n < 2; ++n) { bg[n] = *(const f32x4*)(bin + e * 2048 + f0 + 4 * n); bl[n] = *(const f32x4*)(bin + e * 2048 + 1024 + f0 + 4 * n); }
        EPI_LOOP { f32x4 o[2];
#pragma unroll
            for (int n = 0; n < 2; ++n) { const f32x4 zg = acc[ai][0][m][n] + bg[n], zl = acc[ai][1][m][n] + bl[n];
#pragma unroll
                for (int j = 0; j < 4; ++j) { const float gl = fminf(zg[j], 7.0f); const float li = fminf(fmaxf(zl[j], -7.0f), 7.0f); o[n][j] = gl * sigmoidf_(1.702f * gl) * (li + 1.0f); } }
            *(u32x4*)(ACT + (size_t)(row0 + ai * 128 + m * 16) * 1024 + f0) = pack8(o[0], o[1]); }
    }
};
struct EpiY {
    static constexpr bool PERM = true; const float* bout; bf16* Y;
    __device__ __forceinline__ void operator()(const f32x4 (&acc)[2][2][4][2], const pg8::Unit& u, int wr, int wc, int fr, int fq) const {
        EPI_ROWS(u); const int e = u.pn >> 2, pl = u.pn & 3; const int col0 = pl * 256 + wc * 32 + 8 * fq;
        f32x4 bv[2][2];
#pragma unroll
        for (int bj = 0; bj < 2; ++bj)
#pragma unroll
            for (int n = 0; n < 2; ++n) bv[bj][n] = *(const f32x4*)(bout + e * 1024 + col0 + bj * 128 + 4 * n);
        EPI_LOOP { bf16* rowp = Y + (size_t)(row0 + ai * 128 + m * 16) * 1024 + col0;
#pragma unroll
            for (int bj = 0; bj < 2; ++bj) *(u32x4*)(rowp + bj * 128) = pack8(acc[ai][bj][m][0] + bv[bj][0], acc[ai][bj][m][1] + bv[bj][1]); }
    }
};

__device__ __forceinline__ void transpose_item(const float* W, int ldsrc, int k0, int sc0, bf16* WT, int ldk, int dr0, LAS float* scr, int lane) {
#pragma unroll 8
    for (int i = 0; i < 32; ++i) { const int kk = 2 * i + (lane >> 5); scr[kk * 33 + (lane & 31)] = W[(size_t)(k0 + kk) * ldsrc + sc0 + (lane & 31)]; }
    LDS_WAIT(); asm volatile("" ::: "memory");
    const int c = lane & 7;
#pragma unroll
    for (int j = 0; j < 4; ++j) { const int n = (lane >> 3) + 8 * j; const LAS float* s = scr + (8 * c) * 33 + n;
        v4u o; o.x = pk2(s[0 * 33], s[1 * 33]); o.y = pk2(s[2 * 33], s[3 * 33]); o.z = pk2(s[4 * 33], s[5 * 33]); o.w = pk2(s[6 * 33], s[7 * 33]);
        *(GAS v4u*)(WT + (size_t)(dr0 + n) * ldk + k0 + 8 * c) = o; }
    LDS_WAIT(); asm volatile("" ::: "memory");
}
__device__ __forceinline__ void p0_prologue(Frame& F, const float* const* __restrict__ INP) {
    {
        LAS float* sc = (LAS float*)(F.lds);
        LAS float* red = (LAS float*)(F.lds + 9 * 1024 * 4);
        for (int i = F.tid; i < 9 * 1024; i += NWAVES * 64) { const int r = i >> 10, k = i & 1023; const float v = r < 8 ? INP[1][r * 1024 + k] : INP[3][k]; sc[i] = v / (1.0f + __expf(-v)); }
        __syncthreads();
        const float* wada = INP[4]; const float* bada = INP[5];
        float* mod = (float*)(F.ws + WS_MOD);
        for (int cg = blockIdx.x; cg < 256; cg += F.G) {
            const int j0 = cg * 24, col = F.lane & 31, kp = F.lane >> 5;
            float a[9];
#pragma unroll
            for (int r = 0; r < 9; ++r) a[r] = 0.f;
            if (col < 24) {
                for (int i = 0; i < 64; ++i) { const int k = F.wave * 128 + 2 * i + kp; const float wv = wada[(size_t)k * 6144 + j0 + col];
#pragma unroll
                    for (int r = 0; r < 9; ++r) a[r] += sc[r * 1024 + k] * wv; }
            }
#pragma unroll
            for (int r = 0; r < 9; ++r) red[((F.wave * 2 + kp) * 9 + r) * 32 + col] = a[r];
            __syncthreads();
            if (F.tid < 9 * 32) { const int r = F.tid >> 5, cc = F.tid & 31;
                if (cc < 24) { float s = 0.f; for (int p = 0; p < 16; ++p) s += red[(p * 9 + r) * 32 + cc]; const int j = j0 + cc; s += bada[j];
                    if (r < 8) mod[r * 6144 + j] = s; else if (j < 2048) mod[8 * 6144 + j] = s; } }
            __syncthreads();
        }
    }
    LAS float* scr = (LAS float*)(F.lds + F.wave * 16384);
    const int gw = F.vcu * NWAVES + F.wave, NGW = F.G * NWAVES;
    bf16* WIN = (bf16*)(F.ws + WS_WIN); bf16* WGLU = (bf16*)(F.ws + WS_WGLU); bf16* WA = (bf16*)(F.ws + WS_WA); bf16* WB = (bf16*)(F.ws + WS_WB); bf16* WO = (bf16*)(F.ws + WS_WO);
    bf16* WEIN = (bf16*)(F.ws + WS_WEIN); bf16* WEOUT = (bf16*)(F.ws + WS_WEOUT);
    constexpr int I_IN = 177 * 16, I_GLU = 16 * 8, I_A = 32 * 16, I_B = 32 * 8, I_O = 32 * 16, I_EIN = 32 * 64 * 16, I_EOUT = 32 * 32 * 16;
    constexpr int NITEMS = I_IN + I_GLU + I_A + I_B + I_O + I_EIN + I_EOUT;
    for (int it = gw; it < NITEMS; it += NGW) {
        int r = it;
        if (r < I_IN) { const int kb = r / 177, nb = r % 177, n0 = nb * 32; const int sc0 = n0 < 2048 ? n0 : (n0 < 5632 ? n0 + 32 : 2048);
            transpose_item(INP[8], 5664, kb * 64, sc0, WIN, 1024, n0, scr, F.lane); continue; } r -= I_IN;
        if (r < I_GLU) { const int kb = r / 16, nb = r % 16; transpose_item(INP[21], 512, kb * 64, nb * 32, WGLU, 512, nb * 32, scr, F.lane); continue; } r -= I_GLU;
        if (r < I_A) { const int kb = r / 32, nb = r % 32; transpose_item(INP[12], 1024, kb * 64, nb * 32, WA, 1024, nb * 32, scr, F.lane); continue; } r -= I_A;
        if (r < I_B) { const int kb = r / 32, nb = r % 32; transpose_item(INP[23], 1024, kb * 64, nb * 32, WB, 512, nb * 32, scr, F.lane); continue; } r -= I_B;
        if (r < I_O) { const int kb = r / 32, nb = r % 32; transpose_item(INP[25], 1024, kb * 64, nb * 32, WO, 1024, nb * 32, scr, F.lane); continue; } r -= I_O;
        if (r < I_EIN) { const int e = r / 1024, q = r % 1024, kb = q / 64, nb = q % 64; const int dr = nb * 32, pn = dr >> 8, bj = (dr >> 7) & 1, xx = dr & 127;
            transpose_item(INP[28] + (size_t)e * 1024 * 2048, 2048, kb * 64, bj * 1024 + pn * 128 + xx, WEIN + (size_t)e * 2048 * 1024, 1024, dr, scr, F.lane); continue; } r -= I_EIN;
        { const int e = r / 512, q = r % 512, kb = q / 32, nb = q % 32;
            transpose_item(INP[30] + (size_t)e * 1024 * 1024, 1024, kb * 64, nb * 32, WEOUT + (size_t)e * 1024 * 1024, 1024, nb * 32, scr, F.lane); }
    }
    { const int gt = blockIdx.x * (NWAVES * 64) + F.tid, NT = F.G * NWAVES * 64; GAS v4u* z = (GAS v4u*)(WIN + (size_t)5664 * 1024);
        for (int i = gt; i < 224 * 1024 / 8; i += NT) z[i] = (v4u){0u, 0u, 0u, 0u}; }
}

__device__ __forceinline__ void p1_norm1(Frame& F, const float* const* __restrict__ INP) {
    const int gw = F.vcu * NWAVES + F.wave, NGW = F.G * NWAVES;
    const float* mod = (const float*)(F.ws + WS_MOD); bf16* H1 = (bf16*)(F.ws + WS_H1);
    for (int m = gw; m < MT; m += NGW) {
        const float* xr; const float* sh; const float* scl;
        if (m < ML) { const int b = m / SEQ; xr = INP[0] + (size_t)m * D; sh = mod + b * 6144; scl = sh + D; }
        else { xr = INP[2] + (size_t)(m - ML) * D; sh = mod + 8 * 6144; scl = sh + D; }
        f32x4 v[4]; float s = 0.f;
#pragma unroll
        for (int j = 0; j < 4; ++j) { v[j] = *(const f32x4*)(xr + 256 * j + 4 * F.lane); s += (v[j][0] * v[j][0] + v[j][1] * v[j][1]) + (v[j][2] * v[j][2] + v[j][3] * v[j][3]); }
        const float rstd = 1.0f / sqrtf(wave_sum(s) * (1.0f / D) + EPS);
#pragma unroll
        for (int j = 0; j < 4; ++j) { const int c = 256 * j + 4 * F.lane; const f32x4 g = *(const f32x4*)(INP[6] + c), a = *(const f32x4*)(scl + c), bb = *(const f32x4*)(sh + c);
            const f32x4 y = v[j] * rstd * g * (a + 1.0f) + bb;
            *(v2u*)(H1 + (size_t)m * D + c) = (v2u){pk2(y[0], y[1]), pk2(y[2], y[3])}; }
    }
}

__device__ __forceinline__ void p3_conv(Frame& F, const float* const* __restrict__ INP) {
    const bf16* PROJ = (const bf16*)(F.ws + WS_PROJ); bf16* QKC = (bf16*)(F.ws + WS_QKC); const float* wc = INP[9];
    const int NT = F.G * NWAVES * 64;
    for (int w = F.vcu * (NWAVES * 64) + F.tid; w < MT * 128; w += NT) {
        const int row = w >> 7, ch0 = (w & 127) * 8;
        float a[8];
#pragma unroll
        for (int j = 0; j < 8; ++j) a[j] = 0.f;
        if (row < ML) {
            const int b = row / SEQ, t = row % SEQ, gr = t >> 6, gc = t & 63;
#pragma unroll
            for (int ky = 0; ky < 3; ++ky)
#pragma unroll
                for (int kx = 0; kx < 3; ++kx) { const int rr = gr + ky - 1, cc = gc + kx - 1;
                    if (rr >= 0 && rr < 64 && cc >= 0 && cc < 64) { const v4u x = *(const v4u*)(PROJ + (size_t)(b * SEQ + rr * 64 + cc) * LDP + ch0);
                        const f32x4 w0 = *(const f32x4*)(wc + (ky * 3 + kx) * 1024 + ch0), w1 = *(const f32x4*)(wc + (ky * 3 + kx) * 1024 + ch0 + 4);
                        a[0] += bflo(x.x) * w0[0]; a[1] += bfhi(x.x) * w0[1]; a[2] += bflo(x.y) * w0[2]; a[3] += bfhi(x.y) * w0[3];
                        a[4] += bflo(x.z) * w1[0]; a[5] += bfhi(x.z) * w1[1]; a[6] += bflo(x.w) * w1[2]; a[7] += bfhi(x.w) * w1[3]; } }
        } else {
            const int rc = row - ML, t = rc % CTXL;
#pragma unroll
            for (int kx = 0; kx < 3; ++kx) { const int tt = t + kx - 1;
                if (tt >= 0 && tt < CTXL) { const v4u x = *(const v4u*)(PROJ + (size_t)(row + kx - 1) * LDP + ch0);
                    const f32x4 w0 = *(const f32x4*)(wc + (3 + kx) * 1024 + ch0), w1 = *(const f32x4*)(wc + (3 + kx) * 1024 + ch0 + 4);
                    a[0] += bflo(x.x) * w0[0]; a[1] += bfhi(x.x) * w0[1]; a[2] += bflo(x.y) * w0[2]; a[3] += bfhi(x.y) * w0[3];
                    a[4] += bflo(x.z) * w1[0]; a[5] += bfhi(x.z) * w1[1]; a[6] += bflo(x.w) * w1[2]; a[7] += bfhi(x.w) * w1[3]; } }
        }
        const float scale = ch0 < 512 ? 0.125f : 1.0f;
#pragma unroll
        for (int j = 0; j < 8; ++j) a[j] = a[j] / (1.0f + __expf(-a[j])) * scale;
        *(v4u*)(QKC + (size_t)row * 1024 + ch0) = (v4u){pk2(a[0], a[1]), pk2(a[2], a[3]), pk2(a[4], a[5]), pk2(a[6], a[7])};
    }
}

__device__ __forceinline__ void mma32_nt(f32x16& acc, const LAS bf16* A, int lda, const LAS bf16* Bt, int ldb, int K, int lane) {
    const int r = lane & 31, h = lane >> 5;
    for (int k0 = 0; k0 < K; k0 += 16) {
        const bf16x8 a = *(const LAS bf16x8*)(A + r * lda + k0 + 8 * h);
        const bf16x8 b = *(const LAS bf16x8*)(Bt + r * ldb + k0 + 8 * h);
        acc = __builtin_amdgcn_mfma_f32_32x32x16_bf16(a, b, acc, 0, 0, 0);
    }
}
__device__ __forceinline__ void mma16_nt(f32x4& acc, const LAS bf16* A, int lda, const LAS bf16* Bt, int ldb, int K, int lane) {
    const int r = lane & 15, q = lane >> 4;
    for (int k0 = 0; k0 < K; k0 += 32) {
        const bf16x8 a = *(const LAS bf16x8*)(A + r * lda + k0 + 8 * q);
        const bf16x8 b = *(const LAS bf16x8*)(Bt + r * ldb + k0 + 8 * q);
        acc = __builtin_amdgcn_mfma_f32_16x16x32_bf16(a, b, acc, 0, 0, 0);
    }
}
__device__ __forceinline__ int row32(int reg, int lane) { return (reg & 3) + 8 * (reg >> 2) + 4 * (lane >> 5); }
__device__ __forceinline__ float logsigmoidf_(float x) { return fminf(x, 0.f) - log1pf(expf(-fabsf(x))); }

__device__ __forceinline__ void p4_mlstm(Frame& F, const float* const* __restrict__ INP, int unit) {
    const int vh = unit & 1, h = (unit >> 1) & 7, b = (unit >> 4) & 7, d = unit >> 7;
    LAS bf16* Qs = (LAS bf16*)(F.lds + 0);
    LAS bf16* Ks = (LAS bf16*)(F.lds + 18432);
    LAS bf16* KTw = (LAS bf16*)(F.lds + 36864);
    LAS bf16* VT = (LAS bf16*)(F.lds + 54272);
    LAS bf16* Ps = (LAS bf16*)(F.lds + 71680);
    LAS bf16* Cb = (LAS bf16*)(F.lds + 106496);
    LAS float* vec = (LAS float*)(F.lds + 115712);
    LAS float *li = vec, *bc = vec + 128, *rowt = vec + 256, *colt = vec + 384, *iev = vec + 512, *wev = vec + 640, *rden = vec + 768, *emt = vec + 896, *nv = vec + 1024, *scal = vec + 1088;
    const bf16* PROJ = (const bf16*)(F.ws + WS_PROJ); const bf16* QKC = (const bf16*)(F.ws + WS_QKC); bf16* HDIR = (bf16*)(F.ws + WS_HDIR) + (size_t)d * ML * 1024;
    const float bi_ = INP[10][d * 16 + h], bf_ = INP[10][d * 16 + 8 + h];
    const int tid = F.tid, lane = F.lane, w = F.wave;
    for (int i = tid; i < 64 * 72; i += 512) Cb[i] = 0;
    if (tid < 64) nv[tid] = 0.f;
    f32x4 accC[2] = {(f32x4){0.f, 0.f, 0.f, 0.f}, (f32x4){0.f, 0.f, 0.f, 0.f}};
    float m_old = 0.f;
    __syncthreads();
    for (int j = 0; j < 34; ++j) {
        const bool lat = j >= 2;
        const int p0 = lat ? 128 * (j - 2) : 128 * j, Lseq = lat ? SEQ : CTXL, rowbase = lat ? b * SEQ : ML + b * CTXL;
#pragma unroll
        for (int i = 0; i < 2; ++i) { const int id = tid + 512 * i, s = id >> 3, c = id & 7; const int tt = d ? (Lseq - 1 - (p0 + s)) : (p0 + s); const size_t row = (size_t)(rowbase + tt);
            *(LAS v4u*)(Qs + s * 72 + c * 8) = *(const v4u*)(QKC + row * 1024 + h * 64 + c * 8);
            *(LAS v4u*)(Ks + s * 72 + c * 8) = *(const v4u*)(QKC + row * 1024 + 512 + h * 64 + c * 8);
            const v4u v8 = *(const v4u*)(PROJ + row * LDP + PC_V + h * 128 + vh * 64 + c * 8);
            LAS bf16* vt = VT + (c * 8) * 136 + s;
            vt[0 * 136] = (bf16)(v8.x & 0xffffu); vt[1 * 136] = (bf16)(v8.x >> 16); vt[2 * 136] = (bf16)(v8.y & 0xffffu); vt[3 * 136] = (bf16)(v8.y >> 16);
            vt[4 * 136] = (bf16)(v8.z & 0xffffu); vt[5 * 136] = (bf16)(v8.z >> 16); vt[6 * 136] = (bf16)(v8.w & 0xffffu); vt[7 * 136] = (bf16)(v8.w >> 16); }
        if (tid < 128) { const int s = tid; const int tt = d ? (Lseq - 1 - (p0 + s)) : (p0 + s); const size_t row = (size_t)(rowbase + tt);
            li[s] = bf2f(PROJ[row * LDP + PC_IF + d * 16 + h]) + bi_;
            bc[s] = logsigmoidf_(bf2f(PROJ[row * LDP + PC_IF + d * 16 + 8 + h]) + bf_); }
        __syncthreads();
        if (w == 0) {
            const int s0 = 2 * lane, s1 = s0 + 1;
            const float l0 = bc[s0], l1 = bc[s1], i0 = li[s0], i1 = li[s1];
            const float c1 = l0 + l1; float inc = c1;
#pragma unroll
            for (int o = 1; o < 64; o <<= 1) { const float t = __shfl_up(inc, o); if (lane >= o) inc += t; }
            const float exc = inc - c1, b0 = exc + l0, b1 = exc + c1, g0 = i0 - b0, g1 = i1 - b1;
            float pmx = fmaxf(g0, g1);
#pragma unroll
            for (int o = 1; o < 64; o <<= 1) { const float t = __shfl_up(pmx, o); if (lane >= o) pmx = fmaxf(pmx, t); }
            float pex = __shfl_up(pmx, 1); if (lane == 0) pex = -INFINITY;
            const float pm0 = fmaxf(pex, g0), pm1 = pmx;
            const float bend = __shfl(b1, 63), gmax = __shfl(pmx, 63);
            const float mnew = fmaxf(bend + m_old, bend + gmax), dec = expf(bend + m_old - mnew);
            const float r0 = fmaxf(m_old, pm0), r1 = fmaxf(m_old, pm1);
            bc[s0] = b0; bc[s1] = b1; colt[s0] = g0; colt[s1] = g1; rowt[s0] = -r0; rowt[s1] = -r1;
            iev[s0] = expf(m_old - r0); iev[s1] = expf(m_old - r1); emt[s0] = expf(-b0 - r0); emt[s1] = expf(-b1 - r1);
            wev[s0] = expf(bend + g0 - mnew); wev[s1] = expf(bend + g1 - mnew);
            if (lane == 0) { scal[0] = dec; scal[1] = mnew; }
        }
        __syncthreads();
        const float dec = scal[0];
#pragma unroll
        for (int i = 0; i < 2; ++i) { const int id = tid + 512 * i, s = id >> 3, c = id & 7; const v4u k8 = *(const LAS v4u*)(Ks + s * 72 + c * 8); const float ww = wev[s];
            LAS bf16* kt = KTw + (c * 8) * 136 + s;
            kt[0 * 136] = (bf16)f2bf(ww * bflo(k8.x)); kt[1 * 136] = (bf16)f2bf(ww * bfhi(k8.x)); kt[2 * 136] = (bf16)f2bf(ww * bflo(k8.y)); kt[3 * 136] = (bf16)f2bf(ww * bfhi(k8.y));
            kt[4 * 136] = (bf16)f2bf(ww * bflo(k8.z)); kt[5 * 136] = (bf16)f2bf(ww * bfhi(k8.z)); kt[6 * 136] = (bf16)f2bf(ww * bflo(k8.w)); kt[7 * 136] = (bf16)f2bf(ww * bfhi(k8.w)); }
        if (lat) {
            const int tm = w >> 1;
#pragma unroll
            for (int jj = 0; jj < 2; ++jj) { const int tn = 2 * (w & 1) + jj; const int s = 32 * tn + (lane & 31);
                if (tn > tm) {
#pragma unroll
                    for (int reg = 0; reg < 16; ++reg) Ps[(32 * tm + row32(reg, lane)) * 136 + s] = 0;
                } else {
                    f32x16 acc;
#pragma unroll
                    for (int reg = 0; reg < 16; ++reg) acc[reg] = 0.f;
                    mma32_nt(acc, Qs + 32 * tm * 72, 72, Ks + 32 * tn * 72, 72, 64, lane);
                    const float ct = colt[s];
#pragma unroll
                    for (int reg = 0; reg < 16; ++reg) { const int t = 32 * tm + row32(reg, lane); const float val = (s <= t) ? acc[reg] * __expf(ct + rowt[t]) : 0.f; Ps[t * 136 + s] = (bf16)f2bf(val); }
                } }
        }
        __syncthreads();
        if (lat) { const int t = tid >> 2, part = tid & 3; float rs = 0.f, nq = 0.f;
#pragma unroll
            for (int q = 0; q < 4; ++q) { const v4u p8 = *(const LAS v4u*)(Ps + t * 136 + 32 * part + 8 * q); rs += (bflo(p8.x) + bfhi(p8.x)) + (bflo(p8.y) + bfhi(p8.y)) + (bflo(p8.z) + bfhi(p8.z)) + (bflo(p8.w) + bfhi(p8.w)); }
#pragma unroll
            for (int q = 0; q < 2; ++q) { const v4u q8 = *(const LAS v4u*)(Qs + t * 72 + 16 * part + 8 * q); const LAS float* nn = nv + 16 * part + 8 * q;
                nq += bflo(q8.x) * nn[0] + bfhi(q8.x) * nn[1] + bflo(q8.y) * nn[2] + bfhi(q8.y) * nn[3] + bflo(q8.z) * nn[4] + bfhi(q8.z) * nn[5] + bflo(q8.w) * nn[6] + bfhi(q8.w) * nn[7]; }
            rs += __shfl_xor(rs, 1); rs += __shfl_xor(rs, 2); nq += __shfl_xor(nq, 1); nq += __shfl_xor(nq, 2);
            if (part == 0) { const float den = iev[t] * nq + rs; rden[t] = 1.0f / fmaxf(fabsf(den), emt[t]); } }
        __syncthreads();
        if (lat) { const int tm = w >> 1, tn = w & 1; f32x16 acc;
#pragma unroll
            for (int reg = 0; reg < 16; ++reg) acc[reg] = 0.f;
            mma32_nt(acc, Qs + 32 * tm * 72, 72, Cb + 32 * tn * 72, 72, 64, lane);
#pragma unroll
            for (int reg = 0; reg < 16; ++reg) acc[reg] *= iev[32 * tm + row32(reg, lane)];
            mma32_nt(acc, Ps + 32 * tm * 136, 136, VT + 32 * tn * 136, 136, 128, lane);
#pragma unroll
            for (int reg = 0; reg < 16; ++reg) { const int t = 32 * tm + row32(reg, lane); const int tt = d ? (Lseq - 1 - (p0 + t)) : (p0 + t);
                HDIR[(size_t)(rowbase + tt) * 1024 + h * 128 + vh * 64 + 32 * tn + (lane & 31)] = (bf16)f2bf(acc[reg] * rden[t]); } }
        { const int vi = w >> 1;
#pragma unroll
            for (int jj = 0; jj < 2; ++jj) { const int ki = 2 * (w & 1) + jj; accC[jj] *= dec; mma16_nt(accC[jj], VT + 16 * vi * 136, 136, KTw + 16 * ki * 136, 136, 128, lane); } }
        if (tid < 64) { float s = 0.f; for (int q = 0; q < 128; ++q) s += wev[q] * bf2f(Ks[q * 72 + tid]); nv[tid] = dec * nv[tid] + s; }
        __syncthreads();
        { const int vi = w >> 1;
#pragma unroll
            for (int jj = 0; jj < 2; ++jj) { const int ki = 2 * (w & 1) + jj;
#pragma unroll
                for (int reg = 0; reg < 4; ++reg) Cb[(16 * vi + (lane >> 4) * 4 + reg) * 72 + 16 * ki + (lane & 15)] = (bf16)f2bf(accC[jj][reg]); } }
        m_old = scal[1];
        __syncthreads();
    }
}

__device__ __forceinline__ void s5_disc(const float* const* __restrict__ INP, int d, int g, int p, float& ar, float& ai, float& cfr, float& cfi) {
    const float dt = expf(INP[15][d * 32 + g]); const float are = INP[13][(d * 32 + g) * 64 + p], aim = INP[14][(d * 32 + g) * 64 + p];
    const float mag = expf(dt * are), ang = dt * aim; ar = mag * cosf(ang); ai = mag * sinf(ang);
    const float den = are * are + aim * aim, xr = ar - 1.0f; cfr = (xr * are + ai * aim) / den; cfi = (ai * are - xr * aim) / den;
}
__device__ __forceinline__ void p4_s5(Frame& F, const float* const* __restrict__ INP, int unit) {
    const int gp = unit & 15, b = (unit >> 4) & 7, d = unit >> 7;
    LAS float* BU = (LAS float*)(F.lds + 0);
    LAS bf16* Hb = (LAS bf16*)(F.lds + 66560);
    LAS bf16* Cm = (LAS bf16*)(F.lds + 100352);
    LAS float* Eb = (LAS float*)(F.lds + 109056);
    LAS bf16* Us = (LAS bf16*)(F.lds + 113152);
    LAS bf16* BBs = (LAS bf16*)(F.lds + 118272);
    const bf16* PROJ = (const bf16*)(F.ws + WS_PROJ); bf16* YDIR = (bf16*)(F.ws + WS_YDIR) + (size_t)d * ML * 512;
    const int tid = F.tid, lane = F.lane, w = F.wave;
    const int sg = tid & 127, seg = tid >> 7;
    float ar, ai, a16r, a16i;
    { float cfr, cfi; s5_disc(INP, d, 2 * gp + (sg >> 6), sg & 63, ar, ai, cfr, cfi); a16r = ar; a16i = ai;
#pragma unroll
        for (int q = 0; q < 4; ++q) { const float nr = a16r * a16r - a16i * a16i, ni = 2.0f * a16r * a16i; a16r = nr; a16i = ni; } }
    for (int idx = tid; idx < 4096; idx += 512) {
        { const int gg = idx >> 11, pp = (idx >> 4) & 127, c = idx & 15, g = 2 * gp + gg, p = pp & 63; float xr_, xi_, cfr, cfi; s5_disc(INP, d, g, p, xr_, xi_, cfr, cfi);
            const float bre = INP[16][((size_t)(d * 32 + g) * 64 + p) * 16 + c], bim = INP[17][((size_t)(d * 32 + g) * 64 + p) * 16 + c];
            BBs[(gg * 128 + pp) * 24 + c] = (bf16)f2bf(pp < 64 ? cfr * bre - cfi * bim : cfr * bim + cfi * bre); }
        { const int gg = idx >> 11, c = (idx >> 7) & 15, pp = idx & 127, g = 2 * gp + gg, p = pp & 63;
            const float v = pp < 64 ? INP[18][((size_t)(d * 32 + g) * 16 + c) * 64 + p] : -INP[19][((size_t)(d * 32 + g) * 16 + c) * 64 + p];
            Cm[(gg * 16 + c) * 136 + pp] = (bf16)f2bf(v); }
    }
    float h0r = 0.f, h0i = 0.f;
    const int cr = (sg >> 6) * 128 + (sg & 63), ci = cr + 64, t0 = 16 * seg;
    __syncthreads();
    for (int j = 0; j < 68; ++j) {
        const bool lat = j >= 4;
        const int p0 = lat ? 64 * (j - 4) : 64 * j, Lseq = lat ? SEQ : CTXL, rowbase = lat ? b * SEQ : ML + b * CTXL;
        if (tid < 256) { const int s = tid >> 2, c = tid & 3; const int tt = d ? (Lseq - 1 - (p0 + s)) : (p0 + s);
            *(LAS v4u*)(Us + s * 40 + c * 8) = *(const v4u*)(PROJ + (size_t)(rowbase + tt) * LDP + PC_U + gp * 32 + c * 8); }
        __syncthreads();
        { const int gg = w >> 2, tm = (w >> 1) & 1, r = lane & 31, hh = lane >> 5;
            const bf16x8 a = *(const LAS bf16x8*)(Us + (32 * tm + r) * 40 + gg * 16 + 8 * hh);
#pragma unroll
            for (int jj = 0; jj < 2; ++jj) { const int tn = 2 * (w & 1) + jj; f32x16 acc;
#pragma unroll
                for (int reg = 0; reg < 16; ++reg) acc[reg] = 0.f;
                const bf16x8 bb = *(const LAS bf16x8*)(BBs + (gg * 128 + 32 * tn + r) * 24 + 8 * hh);
                acc = __builtin_amdgcn_mfma_f32_32x32x16_bf16(a, bb, acc, 0, 0, 0);
#pragma unroll
                for (int reg = 0; reg < 16; ++reg) BU[(32 * tm + row32(reg, lane)) * 260 + gg * 128 + 32 * tn + r] = acc[reg]; } }
        __syncthreads();
        { float hr = 0.f, hi = 0.f;
#pragma unroll
            for (int q = 0; q < 16; ++q) { const float br = BU[(t0 + q) * 260 + cr], bi = BU[(t0 + q) * 260 + ci]; const float nr = ar * hr - ai * hi + br, ni = ar * hi + ai * hr + bi; hr = nr; hi = ni; }
            Eb[(seg * 128 + sg) * 2] = hr; Eb[(seg * 128 + sg) * 2 + 1] = hi; }
        __syncthreads();
        { float hcr = h0r, hci = h0i, hr = 0.f, hi = 0.f;
#pragma unroll
            for (int s2 = 0; s2 < 4; ++s2) { if (s2 == seg) { hr = hcr; hi = hci; } const float er = Eb[(s2 * 128 + sg) * 2], ei = Eb[(s2 * 128 + sg) * 2 + 1];
                const float nr = a16r * hcr - a16i * hci + er, ni = a16r * hci + a16i * hcr + ei; hcr = nr; hci = ni; }
            h0r = hcr; h0i = hci;
#pragma unroll
            for (int q = 0; q < 16; ++q) { const float br = BU[(t0 + q) * 260 + cr], bi = BU[(t0 + q) * 260 + ci]; const float nr = ar * hr - ai * hi + br, ni = ar * hi + ai * hr + bi; hr = nr; hi = ni;
                Hb[(t0 + q) * 264 + cr] = (bf16)f2bf(hr); Hb[(t0 + q) * 264 + ci] = (bf16)f2bf(hi); } }
        __syncthreads();
        if (lat) { const int gg = w >> 2, tm = w & 3; f32x4 acc = (f32x4){0.f, 0.f, 0.f, 0.f};
            mma16_nt(acc, Hb + 16 * tm * 264 + gg * 128, 264, Cm + gg * 16 * 136, 136, 128, lane);
#pragma unroll
            for (int reg = 0; reg < 4; ++reg) { const int t = 16 * tm + (lane >> 4) * 4 + reg; const int tt = d ? (Lseq - 1 - (p0 + t)) : (p0 + t);
                YDIR[(size_t)(rowbase + tt) * 512 + (2 * gp + gg) * 16 + (lane & 15)] = (bf16)f2bf(acc[reg]); } }
    }
    __syncthreads();
}

__device__ __forceinline__ float gelu_tanh(float x) { const float u = 0.7978845608028654f * (x + 0.044715f * x * x * x); const float e = __expf(2.0f * u); const float th = 1.0f - 2.0f / (e + 1.0f); return 0.5f * x * (1.0f + th); }
__device__ __forceinline__ void p5a_prep(Frame& F, const float* const* __restrict__ INP) {
    const int gw = F.vcu * NWAVES + F.wave, NGW = F.G * NWAVES, lane = F.lane;
    const bf16* PROJ = (const bf16*)(F.ws + WS_PROJ); const bf16* HD0 = (const bf16*)(F.ws + WS_HDIR); const bf16* HD1 = HD0 + (size_t)ML * 1024;
    const bf16* YD0 = (const bf16*)(F.ws + WS_YDIR); const bf16* YD1 = YD0 + (size_t)ML * 512;
    bf16* A1 = (bf16*)(F.ws + WS_A1); bf16* A2 = (bf16*)(F.ws + WS_A2);
    for (int m = gw; m < ML; m += NGW) {
        float hm[16]; float ss = 0.f;
#pragma unroll
        for (int q = 0; q < 2; ++q) { const v4u a = *(const v4u*)(HD0 + (size_t)m * 1024 + 16 * lane + 8 * q), bq = *(const v4u*)(HD1 + (size_t)m * 1024 + 16 * lane + 8 * q);
            hm[8 * q + 0] = bflo(a.x) + bflo(bq.x); hm[8 * q + 1] = bfhi(a.x) + bfhi(bq.x); hm[8 * q + 2] = bflo(a.y) + bflo(bq.y); hm[8 * q + 3] = bfhi(a.y) + bfhi(bq.y);
            hm[8 * q + 4] = bflo(a.z) + bflo(bq.z); hm[8 * q + 5] = bfhi(a.z) + bfhi(bq.z); hm[8 * q + 6] = bflo(a.w) + bflo(bq.w); hm[8 * q + 7] = bfhi(a.w) + bfhi(bq.w); }
#pragma unroll
        for (int q = 0; q < 16; ++q) ss += hm[q] * hm[q];
        ss += __shfl_xor(ss, 1); ss += __shfl_xor(ss, 2); ss += __shfl_xor(ss, 4);
        const float rs = 1.0f / sqrtf(ss * (1.0f / 128.0f) + EPS);
#pragma unroll
        for (int q = 0; q < 2; ++q) { const v4u o8 = *(const v4u*)(PROJ + (size_t)m * LDP + PC_O + 16 * lane + 8 * q); const float* gm = INP[11] + 16 * lane + 8 * q;
            float r[8]; const float og[8] = {bflo(o8.x), bfhi(o8.x), bflo(o8.y), bfhi(o8.y), bflo(o8.z), bfhi(o8.z), bflo(o8.w), bfhi(o8.w)};
#pragma unroll
            for (int e = 0; e < 8; ++e) r[e] = hm[8 * q + e] * rs * gm[e] * sigmoidf_(og[e]);
            *(v4u*)(A1 + (size_t)m * 1024 + 16 * lane + 8 * q) = (v4u){pk2(r[0], r[1]), pk2(r[2], r[3]), pk2(r[4], r[5]), pk2(r[6], r[7])}; }
        { const v4u a = *(const v4u*)(YD0 + (size_t)m * 512 + 8 * lane), bq = *(const v4u*)(YD1 + (size_t)m * 512 + 8 * lane), u8 = *(const v4u*)(PROJ + (size_t)m * LDP + PC_U + 8 * lane);
            const float* dd = INP[20] + 8 * lane;
            float r[8] = {bflo(a.x) + bflo(bq.x) + dd[0] * bflo(u8.x), bfhi(a.x) + bfhi(bq.x) + dd[1] * bfhi(u8.x), bflo(a.y) + bflo(bq.y) + dd[2] * bflo(u8.y), bfhi(a.y) + bfhi(bq.y) + dd[3] * bfhi(u8.y),
                          bflo(a.z) + bflo(bq.z) + dd[4] * bflo(u8.z), bfhi(a.z) + bfhi(bq.z) + dd[5] * bfhi(u8.z), bflo(a.w) + bflo(bq.w) + dd[6] * bflo(u8.w), bfhi(a.w) + bfhi(bq.w) + dd[7] * bfhi(u8.w)};
#pragma unroll
            for (int e = 0; e < 8; ++e) r[e] = gelu_tanh(r[e]);
            *(v4u*)(A2 + (size_t)m * 512 + 8 * lane) = (v4u){pk2(r[0], r[1]), pk2(r[2], r[3]), pk2(r[4], r[5]), pk2(r[6], r[7])}; }
    }
}

__device__ __forceinline__ void p6_route(Frame& F, const float* const* __restrict__ INP) {
    const float* X1 = F.out; const float* mod = (const float*)(F.ws + WS_MOD); bf16* H2 = (bf16*)(F.ws + WS_H2);
    int* TOPE = (int*)(F.ws + WS_TOPE); int* POS = (int*)(F.ws + WS_POS); float* TOPP = (float*)(F.ws + WS_TOPP); int* LIST = (int*)(F.ws + WS_LIST);
    LAS int* pe = (LAS int*)(F.lds); LAS int* hist = pe + 512; LAS int* base = hist + 32; LAS int* rank = base + 32;
    const float* wr = INP[26]; const float* br = INP[27];
    const int lane = F.lane, w = F.wave;
    for (int tg = blockIdx.x; tg < ML / 128; tg += F.G) {
        if (F.tid < 32) hist[F.tid] = 0;
        __syncthreads();
        for (int q = 0; q < 16; ++q) {
            const int tl = w * 16 + q, m = tg * 128 + tl, b = m / SEQ;
            const float* sh = mod + b * 6144 + 3 * D; const float* scl = sh + D;
            f32x4 v[4]; float s = 0.f;
#pragma unroll
            for (int j = 0; j < 4; ++j) { v[j] = *(const f32x4*)(X1 + (size_t)m * D + 256 * j + 4 * lane); s += (v[j][0] * v[j][0] + v[j][1] * v[j][1]) + (v[j][2] * v[j][2] + v[j][3] * v[j][3]); }
            const float rstd = 1.0f / sqrtf(wave_sum(s) * (1.0f / D) + EPS);
            float acc[32];
#pragma unroll
            for (int e = 0; e < 32; ++e) acc[e] = 0.f;
#pragma unroll
            for (int j = 0; j < 4; ++j) { const int c = 256 * j + 4 * lane; const f32x4 g = *(const f32x4*)(INP[7] + c), a = *(const f32x4*)(scl + c), bb = *(const f32x4*)(sh + c);
                const f32x4 y = v[j] * rstd * g * (a + 1.0f) + bb;
                *(v2u*)(H2 + (size_t)m * D + c) = (v2u){pk2(y[0], y[1]), pk2(y[2], y[3])};
#pragma unroll
                for (int qq = 0; qq < 4; ++qq) { const float* wrow = wr + (size_t)(c + qq) * 32; const float yv = y[qq];
#pragma unroll
                    for (int e4 = 0; e4 < 8; ++e4) { const f32x4 wv = *(const f32x4*)(wrow + 4 * e4); acc[4 * e4 + 0] += yv * wv[0]; acc[4 * e4 + 1] += yv * wv[1]; acc[4 * e4 + 2] += yv * wv[2]; acc[4 * e4 + 3] += yv * wv[3]; }
                    asm volatile("" ::: "memory"); } }
#pragma unroll
            for (int i = 0; i < 16; ++i) { const float send = (lane & 32) ? acc[i] : acc[i + 16]; const float keep = (lane & 32) ? acc[i + 16] : acc[i]; acc[i] = keep + __shfl_xor(send, 32); }
#pragma unroll
            for (int i = 0; i < 8; ++i) { const float send = (lane & 16) ? acc[i] : acc[i + 8]; const float keep = (lane & 16) ? acc[i + 8] : acc[i]; acc[i] = keep + __shfl_xor(send, 16); }
#pragma unroll
            for (int i = 0; i < 4; ++i) { const float send = (lane & 8) ? acc[i] : acc[i + 4]; const float keep = (lane & 8) ? acc[i + 4] : acc[i]; acc[i] = keep + __shfl_xor(send, 8); }
#pragma unroll
            for (int i = 0; i < 2; ++i) { const float send = (lane & 4) ? acc[i] : acc[i + 2]; const float keep = (lane & 4) ? acc[i + 2] : acc[i]; acc[i] = keep + __shfl_xor(send, 4); }
            { const float send = (lane & 2) ? acc[0] : acc[1]; const float keep = (lane & 2) ? acc[1] : acc[0]; acc[0] = keep + __shfl_xor(send, 2); }
            acc[0] += __shfl_xor(acc[0], 1);
            const int myexp = lane >> 1;
            float val = acc[0] + br[myexp];
            if (lane & 1) val = -INFINITY;
            float tv[4]; int ti[4];
#pragma unroll
            for (int r = 0; r < 4; ++r) { float mx = val;
#pragma unroll
                for (int o = 1; o < 64; o <<= 1) mx = fmaxf(mx, __shfl_xor(mx, o));
                const unsigned long long bal = __ballot(val == mx); const int wl = __ffsll((long long)bal) - 1;
                tv[r] = mx; ti[r] = wl >> 1; if (lane == wl) val = -INFINITY; }
            const float e1 = __expf(tv[1] - tv[0]), e2 = __expf(tv[2] - tv[0]), e3 = __expf(tv[3] - tv[0]); const float inv = 1.0f / (1.0f + e1 + e2 + e3);
            if (lane < 4) { const float p = lane == 0 ? inv : (lane == 1 ? e1 * inv : (lane == 2 ? e2 * inv : e3 * inv)); const int ee = lane == 0 ? ti[0] : (lane == 1 ? ti[1] : (lane == 2 ? ti[2] : ti[3]));
                TOPP[m * 4 + lane] = p; TOPE[m * 4 + lane] = ee; pe[tl * 4 + lane] = ee; }
        }
        __syncthreads();
        { const int e = pe[F.tid]; rank[F.tid] = __hip_atomic_fetch_add(&hist[e], 1, __ATOMIC_RELAXED, __HIP_MEMORY_SCOPE_WORKGROUP); }
        __syncthreads();
        if (F.tid < 32) base[F.tid] = (int)__hip_atomic_fetch_add(F.ctl + CW_CNT + 64 * F.tid, (unsigned)hist[F.tid], RLX_AGENT);
        __syncthreads();
        { const int e = pe[F.tid]; const int pos = base[e] + rank[F.tid]; const int m = tg * 128 + (F.tid >> 2); LIST[e * ML + pos] = m; POS[m * 4 + (F.tid & 3)] = pos; }
        __syncthreads();
    }
}

__device__ __forceinline__ void p10_combine(Frame& F, const float* const* __restrict__ INP) {
    moe_tables(F);
    const LAS int* tab = (const LAS int*)(F.lds + TAB_OFF);
    const float* X1 = F.out; float* OUT = F.out; const float* mod = (const float*)(F.ws + WS_MOD); const bf16* Y = (const bf16*)(F.ws + WS_Y);
    const int* TOPE = (const int*)(F.ws + WS_TOPE); const int* POS = (const int*)(F.ws + WS_POS); const float* TOPP = (const float*)(F.ws + WS_TOPP);
    const int gw = F.vcu * NWAVES + F.wave, NGW = F.G * NWAVES, lane = F.lane;
    for (int m = gw; m < ML; m += NGW) {
        const int b = m / SEQ; const float* gt2 = mod + b * 6144 + 5 * D;
        f32x4 mo[4];
#pragma unroll
        for (int j = 0; j < 4; ++j) mo[j] = (f32x4){0.f, 0.f, 0.f, 0.f};
#pragma unroll
        for (int k = 0; k < 4; ++k) { const int e = TOPE[m * 4 + k]; const float p = TOPP[m * 4 + k]; const size_t slot = (size_t)256 * tab[e] + POS[m * 4 + k];
#pragma unroll
            for (int j = 0; j < 4; ++j) { const v2u y = *(const v2u*)(Y + slot * 1024 + 256 * j + 4 * lane); mo[j] += (f32x4){bflo(y.x), bfhi(y.x), bflo(y.y), bfhi(y.y)} * p; } }
        f32x4 v[4]; float s = 0.f;
#pragma unroll
        for (int j = 0; j < 4; ++j) { const int c = 256 * j + 4 * lane; v[j] = *(const f32x4*)(X1 + (size_t)m * D + c) + *(const f32x4*)(gt2 + c) * mo[j]; s += (v[j][0] * v[j][0] + v[j][1] * v[j][1]) + (v[j][2] * v[j][2] + v[j][3] * v[j][3]); }
        const float rstd = 1.0f / sqrtf(wave_sum(s) * (1.0f / D) + EPS);
#pragma unroll
        for (int j = 0; j < 4; ++j) { const int c = 256 * j + 4 * lane; *(f32x4*)(OUT + (size_t)m * D + c) = v[j] * rstd * *(const f32x4*)(INP[32] + c); }
    }
}

struct Args { const float* in[33]; float* out; unsigned char* ws; int ph_lo, ph_hi, li, pad; };
__global__ void __launch_bounds__(NWAVES * 64, 2) fwd_kernel(Args args) {
    extern __shared__ __attribute__((aligned(16))) unsigned char lds[];
    Frame F;
    F.lds = (LAS unsigned char*)lds;
    F.tid = threadIdx.x; F.lane = F.tid & 63; F.wave = __builtin_amdgcn_readfirstlane(F.tid >> 6);
    F.G = gridDim.x; { const int bx = blockIdx.x; F.vcu = (F.G % 8 == 0) ? (bx % 8) * (F.G / 8) + bx / 8 : bx; }
    F.ws = args.ws; F.ctl = (gu32*)(args.ws + WS_CTL); F.out = args.out;
    for (int u = F.tid; u < (LDS_BYTES - LDSCTL_OFF) / 4; u += NWAVES * 64) ((LAS unsigned*)(F.lds + LDSCTL_OFF))[u] = 0u;
    __syncthreads();
    XcdBarrier bar; bar.bar = (unsigned*)(F.ctl + CW_BAR); bar.x = 0; bar.st = nullptr;
    if (N_LAUNCHES == 1) bar = xcd_barrier_post((unsigned*)(F.ctl + CW_BAR), (volatile LAS unsigned*)(F.lds + MISC_OFF) + 8);
    const int lo = args.ph_lo, hi = args.ph_hi;
    const float* const* __restrict__ INP = args.in;
#ifndef PH_MASK
#define PH_MASK 0x3fff
#endif
#define IN(k) ((((PH_MASK) >> (k)) & 1) && lo <= (k) && (k) < hi)
#define SEAM(k) do { if (IN(k) && IN((k) + 1)) xcd_barrier(bar); } while (0)
    const bf16* WIN = (const bf16*)(F.ws + WS_WIN);

    if (IN(0)) { p0_prologue(F, INP); } SEAM(0);
    if (IN(1)) { p1_norm1(F, INP); } SEAM(1);
    if (IN(2)) {
        pg8::Gemm g{(const bf16*)(F.ws + WS_H1), WIN, 1024, nullptr}; InProjOrder S{F.G, (int)blockIdx.x};
        EpiStore E{(bf16*)(F.ws + WS_PROJ), LDP};
        pg8::gemm_phase<EpiStore, InProjOrder, false>(F.lds, g, S, E);
    } SEAM(2);
    if (IN(3)) { p3_conv(F, INP); } SEAM(3);
    if (IN(4)) { for (int u = blockIdx.x; u < 256; u += F.G) { p4_mlstm(F, INP, u); p4_s5(F, INP, u); } } SEAM(4);
    if (IN(5)) { p5a_prep(F, INP); } SEAM(5);
    if (IN(6)) {
        pg8::Gemm g{(const bf16*)(F.ws + WS_A2), (const bf16*)(F.ws + WS_WGLU), 512, nullptr}; pg8::StaticOrder S; S.init(ML, 512, F.G, (int)blockIdx.x);
        EpiGlu E{(const bf16*)(F.ws + WS_A2), (bf16*)(F.ws + WS_A3), INP[22]};
        pg8::gemm_phase<EpiGlu, pg8::StaticOrder, false>(F.lds, g, S, E);
    } SEAM(6);
    if (IN(7)) {
        pg8::Gemm g{(const bf16*)(F.ws + WS_A1), (const bf16*)(F.ws + WS_WA), 1024, nullptr}; pg8::StaticOrder S; S.init(ML, 1024, F.G, (int)blockIdx.x);
        EpiGate<false> E{(const bf16*)(F.ws + WS_PROJ), PC_G, INP[24], nullptr, (bf16*)(F.ws + WS_YA)};
        pg8::gemm_phase<EpiGate<false>, pg8::StaticOrder, false>(F.lds, g, S, E);
    } SEAM(7);
    if (IN(8)) {
        pg8::Gemm g{(const bf16*)(F.ws + WS_A3), (const bf16*)(F.ws + WS_WB), 512, nullptr}; pg8::StaticOrder S; S.init(ML, 1024, F.G, (int)blockIdx.x);
        EpiGate<true> E{(const bf16*)(F.ws + WS_PROJ), PC_G + 1024, INP[24] + 1024, (const bf16*)(F.ws + WS_YA), (bf16*)(F.ws + WS_MERGED)};
        pg8::gemm_phase<EpiGate<true>, pg8::StaticOrder, false>(F.lds, g, S, E);
    } SEAM(8);
    if (IN(9)) {
        pg8::Gemm g{(const bf16*)(F.ws + WS_MERGED), (const bf16*)(F.ws + WS_WO), 1024, nullptr}; pg8::StaticOrder S; S.init(ML, 1024, F.G, (int)blockIdx.x);
        EpiX1 E{INP[0], (const float*)(F.ws + WS_MOD), F.out};
        pg8::gemm_phase<EpiX1, pg8::StaticOrder, false>(F.lds, g, S, E);
    } SEAM(9);
    if (IN(10)) { p6_route(F, INP); } SEAM(10);
    if (IN(11)) {
        moe_tables(F);
        pg8::Gemm g{(const bf16*)(F.ws + WS_H2), (const bf16*)(F.ws + WS_WEIN), 1024, (const int*)(F.ws + WS_LIST)}; MoeOrder S{F.G, (int)blockIdx.x, 8, (const LAS int*)(F.lds + TAB_OFF)};
        EpiSwiglu E{INP[29], (bf16*)(F.ws + WS_ACT)};
        pg8::gemm_phase<EpiSwiglu, MoeOrder, true>(F.lds, g, S, E);
    } SEAM(11);
    if (IN(12)) {
        moe_tables(F);
        pg8::Gemm g{(const bf16*)(F.ws + WS_ACT), (const bf16*)(F.ws + WS_WEOUT), 1024, nullptr}; MoeOrder S{F.G, (int)blockIdx.x, 4, (const LAS int*)(F.lds + TAB_OFF)};
        EpiY E{INP[31], (bf16*)(F.ws + WS_Y)};
        pg8::gemm_phase<EpiY, MoeOrder, false>(F.lds, g, S, E);
    } SEAM(12);
    if (IN(13)) { p10_combine(F, INP); }
#undef IN
#undef SEAM
}

extern "C" void kernel_launch(void* const* d_in, const int* in_sizes, int n_in, void* d_out, int out_size, void* d_ws, size_t ws_size, hipStream_t stream) {
    static int grid = 0;
    if (grid == 0) {
        if (n_in != 33 || out_size != ML * D || ws_size < WS_END) { fprintf(stderr, "kernel_launch: unexpected shapes (n_in %d, out %d, ws %zu)\n", n_in, out_size, ws_size); grid = -1; return; }
        int dev = 0, cus = 0, per_cu = 0;
        if (hipGetDevice(&dev) != hipSuccess || hipDeviceGetAttribute(&cus, hipDeviceAttributeMultiprocessorCount, dev) != hipSuccess) { grid = -1; return; }
        if (hipFuncSetAttribute((const void*)fwd_kernel, hipFuncAttributeMaxDynamicSharedMemorySize, LDS_BYTES) != hipSuccess) { fprintf(stderr, "kernel_launch: hipFuncSetAttribute failed\n"); grid = -1; return; }
        if (hipOccupancyMaxActiveBlocksPerMultiprocessor(&per_cu, (const void*)fwd_kernel, NWAVES * 64, LDS_BYTES) != hipSuccess || per_cu < 1) fprintf(stderr, "kernel_launch: occupancy query reports %d\n", per_cu);
        (void)hipGetLastError();
        grid = cus;
    }
    if (grid < 0) return;
    if (hipMemsetAsync((char*)d_ws + WS_CTL, 0, CTL_ZERO_BYTES, stream) != hipSuccess) return;
    Args a{};
    for (int i = 0; i < 33; ++i) a.in[i] = (const float*)d_in[i];
    a.out = (float*)d_out; a.ws = (unsigned char*)d_ws;
    for (int li = 0; li < N_LAUNCHES; ++li) {
        a.ph_lo = (N_LAUNCHES == 1) ? 0 : li; a.ph_hi = (N_LAUNCHES == 1) ? NPH : li + 1; a.li = li;
        hipLaunchKernelGGL(fwd_kernel, dim3(grid), dim3(NWAVES * 64), LDS_BYTES, stream, a);
    }
}
```

```cpp
#include <hip/hip_runtime.h>
#include <cstdio>
#include <cstdint>

#ifndef MK_N_LAUNCHES
#define MK_N_LAUNCHES 1
#endif
#ifndef PROBE_DUP_MASK
#define PROBE_DUP_MASK 0
#endif
#ifndef P4_REP_M
#define P4_REP_M 1
#endif
#ifndef P4_MODE
#define P4_MODE 0
#endif
#ifndef P4_REP_S
#define P4_REP_S 1
#endif

namespace pg8 {
#define PG8_LAS __attribute__((address_space(3)))
typedef unsigned short bf16_t;
typedef short bf16x8 __attribute__((ext_vector_type(8)));
typedef float f32x4 __attribute__((ext_vector_type(4)));
typedef unsigned u32x4 __attribute__((ext_vector_type(4)));
constexpr int BM = 256, BK = 64, HALF = 128, HTB = HALF * BK * 2, STAGE_BYTES = 8 * HTB, NXCD = 8, WGM = 8;

__host__ __device__ __forceinline__ int lds_byte(int r, int c) { const int st = (r >> 4) * 2 + (c >> 5), rr = r & 15, cc = c & 31, ob = rr * 64 + cc * 2; return st * 1024 + (ob ^ (((ob >> 9) & 1) << 5)); }
__host__ __device__ __forceinline__ void stage_rc(int b, int& R, int& C) { const int st = b / 1024, sb = b % 1024, swz = sb ^ (((sb >> 9) & 1) << 5); R = (st >> 1) * 16 + swz / 64; C = (st & 1) * 32 + (swz % 64) / 2; }
__host__ __device__ __forceinline__ int perm32(int rho) { const int n = rho >> 4, i = rho & 15; return 8 * (i >> 2) + 4 * n + (i & 3); }

struct Unit { int pm, pn, lbase, nvalid; };
struct Gemm { const bf16_t* A; const bf16_t* Bt; int K; const int* rowlist; };

__device__ __forceinline__ int xcd_remap(int L, int nwg) { const int q = nwg / NXCD, r = nwg % NXCD, xcd = L % NXCD, off = L / NXCD; return (xcd < r ? xcd * (q + 1) : r * (q + 1) + (xcd - r) * q) + off; }

struct StaticOrder {
    int nM, nN, nwg, G, c;
    __device__ void init(int M, int N, int G_, int c_) { nM = M / BM; nN = N / BM; nwg = nM * nN; G = G_; c = c_; }
    __device__ __forceinline__ bool next(int i, Unit& u) const {
        const long L = (long)i * G + c; if (L >= nwg) return false;
        const int wgid = xcd_remap((int)L, nwg);
        const int nig = WGM * nN, gid = wgid / nig, fm = gid * WGM, gsz = (nM - fm) < WGM ? (nM - fm) : WGM;
        u.pm = fm + ((wgid % nig) % gsz); u.pn = (wgid % nig) / gsz; u.lbase = 0; u.nvalid = 0; return true;
    }
};

__device__ __forceinline__ unsigned cvt_pk_bf16(float lo, float hi) { unsigned r; asm volatile("v_cvt_pk_bf16_f32 %0, %1, %2" : "=v"(r) : "v"(lo), "v"(hi)); return r; }

template <class Epi, class Sched, bool GATHER>
__device__ __forceinline__ void gemm_phase(PG8_LAS unsigned char* lds, const Gemm g, const Sched& S, const Epi& E) {
    const int tid = threadIdx.x, wid = __builtin_amdgcn_readfirstlane(tid >> 6), lane = tid & 63, wr = wid >> 2, wc = wid & 3, fr = lane & 15, fq = lane >> 4;
    const int K = g.K, nt = K / BK;
    int Rr[2]; unsigned cby[2], voffB[2];
#pragma unroll
    for (int i = 0; i < 2; ++i) { int R, C; stage_rc(tid * 16 + i * 8192, R, C); const int Rb = Epi::PERM ? ((R & ~31) + perm32(R & 31)) : R;
        Rr[i] = R; cby[i] = (unsigned)C * 2u; voffB[i] = (unsigned)(Rb * K + C) * 2u; }
    const size_t kstep = (size_t)(BK * 2);
    const size_t hstep = (size_t)HALF * K * 2;
    const size_t tstep = 2 * hstep;
    const unsigned ldsw = (unsigned)wid * 1024u;
    const int aoff = lds_byte(wr * 64 + fr, fq * 8), boff = lds_byte(wc * 32 + fr, fq * 8);
#define PG8_SA(b, h) (((b) * 2 + (h)) * HTB)
#define PG8_SB(b, h) ((4 + (b) * 2 + (h)) * HTB)
#define PG8_STAGE(bufoff, gbase, voff) do { _Pragma("unroll") for (int _i = 0; _i < 2; ++_i) \
        __builtin_amdgcn_global_load_lds((const unsigned*)((const char*)(gbase) + (voff)[_i]), (PG8_LAS unsigned*)(lds + (bufoff) + ldsw + _i * 8192), 16, 0, 0); } while (0)
#define PG8_LDA(dst, b, h) do { _Pragma("unroll") for (int m = 0; m < 4; ++m) _Pragma("unroll") for (int k = 0; k < 2; ++k) dst[m][k] = *(const PG8_LAS bf16x8*)(lds + PG8_SA(b, h) + aoff + m * 2048 + k * 1024); } while (0)
#define PG8_LDB(dst, b, h) do { _Pragma("unroll") for (int n = 0; n < 2; ++n) _Pragma("unroll") for (int k = 0; k < 2; ++k) dst[n][k] = *(const PG8_LAS bf16x8*)(lds + PG8_SB(b, h) + boff + n * 2048 + k * 1024); } while (0)
#define PG8_MMA(ai, bj, At, Bt) do { __builtin_amdgcn_s_setprio(1); _Pragma("unroll") for (int m = 0; m < 4; ++m) _Pragma("unroll") for (int n = 0; n < 2; ++n) _Pragma("unroll") for (int k = 0; k < 2; ++k) \
        acc[ai][bj][m][n] = __builtin_amdgcn_mfma_f32_16x16x32_bf16(Bt[n][k], At[m][k], acc[ai][bj][m][n], 0, 0, 0); __builtin_amdgcn_s_setprio(0); } while (0)
#define PG8_WAIT_V(n) asm volatile("s_waitcnt vmcnt(" #n ")" ::: "memory")
#define PG8_WAIT_L(n) asm volatile("s_waitcnt lgkmcnt(" #n ")" ::: "memory")
#define PG8_BAR __builtin_amdgcn_s_barrier()
#define PG8_SCHED __builtin_amdgcn_sched_barrier(0)
#define PG8_AOFF(dst, u) do { _Pragma("unroll") for (int _h = 0; _h < 2; ++_h) _Pragma("unroll") for (int _i = 0; _i < 2; ++_i) { const int _r = _h * HALF + Rr[_i]; \
        if constexpr (GATHER) { const int _rc = _r < (u).nvalid ? _r : (u).nvalid - 1; const int _idx = g.rowlist[(u).lbase + _rc]; dst[_h][_i] = (unsigned)_idx * (unsigned)(K * 2) + cby[_i]; } \
        else { dst[_h][_i] = (unsigned)(_r * K * 2) + cby[_i]; } } } while (0)
    Unit cur, nxt; int ui = 0;
    if (!S.next(0, cur)) return;
    f32x4 acc[2][2][4][2];
#pragma unroll
    for (int a = 0; a < 2; ++a)
#pragma unroll
        for (int b = 0; b < 2; ++b)
#pragma unroll
            for (int m = 0; m < 4; ++m)
#pragma unroll
                for (int n = 0; n < 2; ++n) acc[a][b][m][n] = (f32x4){0.f, 0.f, 0.f, 0.f};
    bf16x8 At[4][2], B0[2][2], B1[2][2];
    unsigned vc[2][2], vn[2][2];
    PG8_AOFF(vc, cur);
    const char* cA = GATHER ? (const char*)g.A : (const char*)g.A + (size_t)cur.pm * tstep; const char* cB = (const char*)g.Bt + (size_t)cur.pn * tstep;
    PG8_STAGE(PG8_SB(0, 0), cB, voffB); PG8_STAGE(PG8_SB(0, 1), cB + hstep, voffB); PG8_STAGE(PG8_SA(0, 0), cA, vc[0]); PG8_STAGE(PG8_SA(0, 1), cA, vc[1]);
    if (wr == 1) PG8_BAR;
    PG8_WAIT_V(2); PG8_BAR;
    PG8_STAGE(PG8_SB(1, 0), cB + kstep, voffB); PG8_STAGE(PG8_SA(1, 0), cA + kstep, vc[0]); PG8_STAGE(PG8_SB(1, 1), cB + hstep + kstep, voffB);
    PG8_WAIT_V(6); PG8_BAR;
    for (;;) {
        const bool has_next = S.next(ui + 1, nxt);
        const char* nA = (has_next && !GATHER) ? (const char*)g.A + (size_t)nxt.pm * tstep : cA; const char* nB = has_next ? (const char*)g.Bt + (size_t)nxt.pn * tstep : cB;
        if constexpr (GATHER) { if (has_next) { PG8_AOFF(vn, nxt); } else {
#pragma unroll
            for (int h = 0; h < 2; ++h) { vn[h][0] = vc[h][0]; vn[h][1] = vc[h][1]; } } }
        for (int t = 0; t < nt; t += 2) {
            const bool last = (t == nt - 2);
            const char* a1 = cA + (size_t)(t + 1) * kstep;
            const char* a2 = last ? nA : cA + (size_t)(t + 2) * kstep; const char* b2 = last ? nB : cB + (size_t)(t + 2) * kstep;
            const char* a3 = a2 + kstep; const char* b3 = b2 + kstep;
            unsigned v2[2][2];
#pragma unroll
            for (int h = 0; h < 2; ++h)
#pragma unroll
                for (int i = 0; i < 2; ++i) v2[h][i] = GATHER ? (last ? vn[h][i] : vc[h][i]) : vc[h][i];
            PG8_LDB(B0, 0, 0); PG8_LDB(B1, 0, 1); PG8_SCHED; PG8_LDA(At, 0, 0); PG8_STAGE(PG8_SA(1, 1), a1, vc[1]);
            PG8_WAIT_V(8); PG8_WAIT_L(0); PG8_BAR; PG8_MMA(0, 0, At, B0); PG8_MMA(0, 1, At, B1); PG8_BAR; PG8_SCHED;
            PG8_LDA(At, 0, 1); PG8_STAGE(PG8_SB(0, 0), b2, voffB); PG8_STAGE(PG8_SB(0, 1), b2 + hstep, voffB); PG8_STAGE(PG8_SA(0, 0), a2, v2[0]);
            PG8_WAIT_V(8); PG8_WAIT_L(0); PG8_BAR; PG8_MMA(1, 0, At, B0); PG8_MMA(1, 1, At, B1); PG8_BAR; PG8_SCHED;
            PG8_LDB(B0, 1, 0); PG8_LDB(B1, 1, 1); PG8_SCHED; PG8_LDA(At, 1, 0); PG8_STAGE(PG8_SA(0, 1), a2, v2[1]);
            PG8_WAIT_V(8); PG8_WAIT_L(0); PG8_BAR; PG8_MMA(0, 0, At, B0); PG8_MMA(0, 1, At, B1); PG8_BAR; PG8_SCHED;
            PG8_LDA(At, 1, 1); PG8_STAGE(PG8_SB(1, 0), b3, voffB); PG8_STAGE(PG8_SB(1, 1), b3 + hstep, voffB); PG8_STAGE(PG8_SA(1, 0), a3, v2[0]);
            PG8_WAIT_V(8); PG8_WAIT_L(0); PG8_BAR; PG8_MMA(1, 0, At, B0); PG8_MMA(1, 1, At, B1); PG8_BAR; PG8_SCHED;
        }
        if (wr == 0) PG8_BAR;
        E(acc, cur, wr, wc, fr, fq);
        if (!has_next) break;
#pragma unroll
        for (int a = 0; a < 2; ++a)
#pragma unroll
            for (int b = 0; b < 2; ++b)
#pragma unroll
                for (int m = 0; m < 4; ++m)
#pragma unroll
                    for (int n = 0; n < 2; ++n) acc[a][b][m][n] = (f32x4){0.f, 0.f, 0.f, 0.f};
        cur = nxt; cA = nA; cB = nB; ++ui;
        if constexpr (GATHER) {
#pragma unroll
            for (int h = 0; h < 2; ++h) { vc[h][0] = vn[h][0]; vc[h][1] = vn[h][1]; } }
        if (wr == 1) PG8_BAR;
    }
    PG8_WAIT_V(0);
    PG8_BAR;
#undef PG8_SA
#undef PG8_SB
#undef PG8_STAGE
#undef PG8_LDA
#undef PG8_LDB
#undef PG8_MMA
#undef PG8_WAIT_V
#undef PG8_WAIT_L
#undef PG8_BAR
#undef PG8_SCHED
#undef PG8_AOFF
}
}

constexpr int NWAVES = 8;
constexpr int D = 1024, NB = 8, SEQ = 4096, CTXL = 256;
constexpr int ML = NB * SEQ, MC = NB * CTXL, MT = ML + MC;
constexpr int LDP = 5888;
constexpr int PC_QK = 0, PC_V = 1024, PC_U = 2048, PC_O = 2560, PC_G = 3584, PC_IF = 5632;
constexpr int NEXP = 32, TOPK = 4;
constexpr int MAXTILES = (ML * TOPK + NEXP * 256) / 256;
constexpr float EPS = 1e-6f;
constexpr int NPH = 14;
constexpr int N_LAUNCHES = MK_N_LAUNCHES;

constexpr size_t MiB = 1u << 20;
constexpr size_t WS_CTL = 0, CTL_ZERO_BYTES = 1 * MiB;
constexpr size_t WS_MOD = 1 * MiB;
constexpr size_t WS_TOPE = 2 * MiB, WS_POS = 2 * MiB + 512 * 1024, WS_TOPP = 3 * MiB, WS_LIST = 4 * MiB;
constexpr size_t WS_WIN = 8 * MiB, WS_WGLU = 20 * MiB, WS_WA = 21 * MiB, WS_WB = 23 * MiB, WS_WO = 24 * MiB, WS_WEIN = 26 * MiB, WS_WEOUT = 154 * MiB;
constexpr size_t WS_R0 = 218 * MiB;
constexpr size_t WS_PROJ = WS_R0, WS_H1 = 609 * MiB, WS_QKC = 677 * MiB, WS_HDIR = 745 * MiB, WS_YDIR = 873 * MiB, WS_END = 937 * MiB;
constexpr size_t WS_A1 = WS_H1, WS_A2 = WS_QKC, WS_A3 = WS_QKC + 32 * MiB, WS_YA = WS_HDIR, WS_MERGED = WS_HDIR + 64 * MiB;
constexpr size_t WS_GS = 940 * MiB, WS_END2 = 948 * MiB;
constexpr size_t WS_H2 = WS_R0, WS_ACT = 282 * MiB, WS_Y = 554 * MiB;
static_assert(WS_PROJ + (size_t)MT * LDP * 2 <= WS_H1 && WS_Y + (size_t)MAXTILES * 256 * 1024 * 2 <= WS_END, "ws map");
constexpr int CW_BAR = 4096, CW_CNT = 16384;

constexpr int RING_BYTES = 131072;
constexpr int LDSCTL_OFF = RING_BYTES, MISC_OFF = LDSCTL_OFF + 320, TAB_OFF = LDSCTL_OFF + 512;
constexpr int LDS_BYTES = 147456;

#define GAS __attribute__((address_space(1)))
#define LAS __attribute__((address_space(3)))
typedef unsigned short bf16;
typedef unsigned v4u __attribute__((ext_vector_type(4)));
typedef unsigned v2u __attribute__((ext_vector_type(2)));
typedef float f32x4 __attribute__((ext_vector_type(4)));
typedef float f32x16 __attribute__((ext_vector_type(16)));
typedef short bf16x8 __attribute__((ext_vector_type(8)));
typedef GAS unsigned gu32;
#define RLX_AGENT __ATOMIC_RELAXED, __HIP_MEMORY_SCOPE_AGENT
#define LDS_WAIT() asm volatile("s_waitcnt lgkmcnt(0)" ::: "memory")
#define LBAR() do { asm volatile("s_waitcnt lgkmcnt(0)" ::: "memory"); __builtin_amdgcn_s_barrier(); asm volatile("" ::: "memory"); } while (0)
__device__ __forceinline__ unsigned f2bf(float f) { unsigned u = __builtin_bit_cast(unsigned, f); return (u + 0x7fffu + ((u >> 16) & 1u)) >> 16; }
__device__ __forceinline__ unsigned pk2(float lo, float hi) { return f2bf(lo) | (f2bf(hi) << 16); }
typedef __bf16 bf16x2_t __attribute__((ext_vector_type(2)));
__device__ __forceinline__ unsigned cvtpk(float lo, float hi) { const bf16x2_t v = {(__bf16)lo, (__bf16)hi}; return __builtin_bit_cast(unsigned, v); }
__device__ __forceinline__ float bf2f(unsigned b) { return __builtin_bit_cast(float, b << 16); }
__device__ __forceinline__ float bflo(unsigned w) { return __builtin_bit_cast(float, w << 16); }
__device__ __forceinline__ float bfhi(unsigned w) { return __builtin_bit_cast(float, w & 0xffff0000u); }
__device__ __forceinline__ float sigmoidf_(float x) { return 1.0f / (1.0f + __expf(-x)); }

#define XB_TMO      128
#define XB_XCNT(j)  (256  + 64 * (j))
#define XB_XSUB(j)  (1280 + 64 * (j))
#define XB_XGEN(j)  (2304 + 64 * (j))
#define XB_TOP      3328
#define XB_TOPGEN   3392
#define XCD_BAR_WORDS 3456
#define XB_SPIN_CAP (1u << 22)
__device__ __forceinline__ unsigned xb_ld(unsigned* p)              { return __hip_atomic_load(p, __ATOMIC_RELAXED, __HIP_MEMORY_SCOPE_AGENT); }
__device__ __forceinline__ unsigned xb_add(unsigned* p, unsigned v) { return __hip_atomic_fetch_add(p, v, __ATOMIC_RELAXED, __HIP_MEMORY_SCOPE_AGENT); }
__device__ __forceinline__ unsigned xb_xcc_id() { return (unsigned)__builtin_amdgcn_s_getreg((3 << 11) | 20) & 0xFu; }
#define XB_SPIN(cond, bar) do { unsigned _sp = 0; while (cond) { __builtin_amdgcn_s_sleep(1); \
    if ((++_sp & 255u) == 0u) { if (xb_ld(&(bar)[XB_TMO])) break; if (_sp > XB_SPIN_CAP) { atomicAdd(&(bar)[XB_TMO], 1u); break; } } } } while (0)
struct XcdBarrier { unsigned* bar; unsigned x; volatile LAS unsigned* st; };
__device__ __forceinline__ XcdBarrier xcd_barrier_post(unsigned* bar, volatile LAS unsigned* st) {
    XcdBarrier b; b.bar = bar; b.x = xb_xcc_id(); b.st = st;
    if (threadIdx.x == 0) (void)xb_add(&bar[XB_XCNT(b.x)], 1u);
    return b;
}
__device__ __forceinline__ void xcd_barrier_complete(unsigned* bar, unsigned x, unsigned& nloc, unsigned& nx) {
    const unsigned G = gridDim.x * gridDim.y * gridDim.z;
    unsigned sum, cnt, mine, sp = 0u;
    for (;;) {
        sum = 0u; cnt = 0u; mine = 0u;
#pragma unroll
        for (unsigned j = 0; j < 16; ++j) { const unsigned c = xb_ld(&bar[XB_XCNT(j)]); sum += c; cnt += (c > 0u) ? 1u : 0u; mine = (j == x) ? c : mine; }
        if (sum == G) break;
        __builtin_amdgcn_s_sleep(1);
        if ((++sp & 255u) == 0u) { if (xb_ld(&bar[XB_TMO])) break; if (sp > XB_SPIN_CAP) { atomicAdd(&bar[XB_TMO], 1u); break; } }
    }
    nloc = mine > 0u ? mine : 1u; nx = cnt > 0u ? cnt : 1u;
}
__device__ __forceinline__ void xcd_barrier(const XcdBarrier& b) {
    asm volatile("s_waitcnt vmcnt(0)" ::: "memory");
    __syncthreads();
    if (threadIdx.x == 0) {
        unsigned* bar = b.bar;
        __builtin_amdgcn_s_waitcnt(0);
        unsigned nloc = b.st[0], nx = b.st[1];
        if (nloc == 0u) { xcd_barrier_complete(bar, b.x, nloc, nx); b.st[0] = nloc; b.st[1] = nx; }
        const unsigned old = xb_add(&bar[XB_XSUB(b.x)], 1u);
        const unsigned gen = old / nloc;
        if (old + 1u == (gen + 1u) * nloc) {
            __builtin_amdgcn_fence(__ATOMIC_RELEASE, "agent");
            asm volatile("s_waitcnt vmcnt(0)" ::: "memory");
            const unsigned og = xb_add(&bar[XB_TOP], 1u);
            const unsigned tg = og / nx;
            if (og + 1u == (tg + 1u) * nx) xb_add(&bar[XB_TOPGEN], 1u);
            else XB_SPIN(xb_ld(&bar[XB_TOPGEN]) == tg, bar);
            __builtin_amdgcn_fence(__ATOMIC_ACQUIRE, "agent");
            xb_add(&bar[XB_XGEN(b.x)], 1u);
            asm volatile("s_waitcnt vmcnt(0)" ::: "memory");
        } else {
            XB_SPIN(xb_ld(&bar[XB_XGEN(b.x)]) == gen, bar);
            __builtin_amdgcn_fence(__ATOMIC_ACQUIRE, "agent");
            asm volatile("s_waitcnt vmcnt(0)" ::: "memory");
        }
    }
    __syncthreads();
}

struct Frame {
    LAS unsigned char* lds;
    gu32* ctl;
    int tid, lane, wave, vcu, G;
    float* out; unsigned char* ws;
};
__device__ __forceinline__ float wave_sum(float v) {
#pragma unroll
    for (int o = 1; o < 64; o <<= 1) v += __shfl_xor(v, o);
    return v;
}

struct InProjOrder {
    int G, c;
    __device__ __forceinline__ bool next(int i, pg8::Unit& u) const {
        const int NL = 128 * 23, NC = 8 * 11;
        const long L = (long)i * G + c; if (L >= NL + NC) return false;
        u.lbase = 0; u.nvalid = 0;
        if (L < NL) { const int wgid = pg8::xcd_remap((int)L, NL); const int nig = 8 * 23, gid = wgid / nig, fm = gid * 8; u.pm = fm + ((wgid % nig) % 8); u.pn = (wgid % nig) / 8; }
        else { const int r = (int)L - NL; u.pm = 128 + r / 11; const int q = r % 11; u.pn = q < 10 ? q : 22; }
        return true;
    }
};
struct MoeOrder {
    int G, c, npn; const LAS int* tab;
    __device__ __forceinline__ bool next(int i, pg8::Unit& u) const {
        const int nT = __builtin_amdgcn_readfirstlane(tab[32]); const int nU = nT * npn;
        const long L = (long)i * G + c; if (L >= nU) return false;
        const int wgid = pg8::xcd_remap((int)L, nU);
        const int tau = wgid / npn, pl = wgid % npn;
        int e = 0;
        for (int k = 1; k < 32; ++k) e += (__builtin_amdgcn_readfirstlane(tab[k]) <= tau) ? 1 : 0;
        const int il = tau - __builtin_amdgcn_readfirstlane(tab[e]);
        u.pm = tau; u.pn = e * npn + pl; u.lbase = e * ML + 256 * il; u.nvalid = __builtin_amdgcn_readfirstlane(tab[33 + e]) - 256 * il;
        return true;
    }
};
__device__ __forceinline__ void moe_tables(Frame& F) {
    LAS int* tab = (LAS int*)(F.lds + TAB_OFF);
    __syncthreads();
    if (F.tid < 32) tab[33 + F.tid] = (int)__hip_atomic_load(F.ctl + CW_CNT + 64 * F.tid, RLX_AGENT);
    __syncthreads();
    if (F.tid == 0) {
        int acc = 0;
        for (int e = 0; e < 32; ++e) { tab[e] = acc; acc += (tab[33 + e] + 255) >> 8; }
        tab[32] = acc;
    }
    __syncthreads();
}

using pg8::f32x4; using pg8::u32x4; using pg8::cvt_pk_bf16;
#define EPI_ROWS(u) const int row0 = (u).pm * 256 + wr * 64 + fr
#define EPI_LOOP _Pragma("unroll") for (int ai = 0; ai < 2; ++ai) _Pragma("unroll") for (int m = 0; m < 4; ++m)
__device__ __forceinline__ u32x4 pack8(const f32x4 a, const f32x4 b) { u32x4 w; w.x = cvt_pk_bf16(a[0], a[1]); w.y = cvt_pk_bf16(a[2], a[3]); w.z = cvt_pk_bf16(b[0], b[1]); w.w = cvt_pk_bf16(b[2], b[3]); return w; }
__device__ __forceinline__ void unpack8(const u32x4 w, f32x4& a, f32x4& b) { a = (f32x4){bflo(w.x), bfhi(w.x), bflo(w.y), bfhi(w.y)}; b = (f32x4){bflo(w.z), bfhi(w.z), bflo(w.w), bfhi(w.w)}; }
__device__ __forceinline__ f32x4 sig4(f32x4 x) { return (f32x4){sigmoidf_(x[0]), sigmoidf_(x[1]), sigmoidf_(x[2]), sigmoidf_(x[3])}; }

struct EpiStore {
    static constexpr bool PERM = true; bf16* O; int ldc;
    __device__ __forceinline__ void operator()(const f32x4 (&acc)[2][2][4][2], const pg8::Unit& u, int wr, int wc, int fr, int fq) const {
        EPI_ROWS(u); const int col0 = u.pn * 256 + wc * 32 + 8 * fq;
        EPI_LOOP { bf16* rowp = O + (size_t)(row0 + ai * 128 + m * 16) * ldc + col0;
#pragma unroll
            for (int bj = 0; bj < 2; ++bj) *(u32x4*)(rowp + bj * 128) = pack8(acc[ai][bj][m][0], acc[ai][bj][m][1]); }
    }
};
struct EpiGlu {
    static constexpr bool PERM = true; const bf16* A2; bf16* A3; const float* bias;
    __device__ __forceinline__ void operator()(const f32x4 (&acc)[2][2][4][2], const pg8::Unit& u, int wr, int wc, int fr, int fq) const {
        EPI_ROWS(u); const int col0 = u.pn * 256 + wc * 32 + 8 * fq;
        f32x4 bv[2][2];
#pragma unroll
        for (int bj = 0; bj < 2; ++bj)
#pragma unroll
            for (int n = 0; n < 2; ++n) bv[bj][n] = *(const f32x4*)(bias + col0 + bj * 128 + 4 * n);
        EPI_LOOP { const size_t off = (size_t)(row0 + ai * 128 + m * 16) * 512 + col0;
#pragma unroll
            for (int bj = 0; bj < 2; ++bj) { f32x4 a0, a1; unpack8(*(const u32x4*)(A2 + off + bj * 128), a0, a1);
                const f32x4 v0 = a0 * sig4(acc[ai][bj][m][0] + bv[bj][0]), v1 = a1 * sig4(acc[ai][bj][m][1] + bv[bj][1]);
                *(u32x4*)(A3 + off + bj * 128) = pack8(v0, v1); } }
    }
};
template <bool ADD> struct EpiGate {
    static constexpr bool PERM = true; const bf16* proj; int gc0; const float* bg; const bf16* Prev; bf16* O;
    __device__ __forceinline__ void operator()(const f32x4 (&acc)[2][2][4][2], const pg8::Unit& u, int wr, int wc, int fr, int fq) const {
        EPI_ROWS(u); const int col0 = u.pn * 256 + wc * 32 + 8 * fq;
        f32x4 bv[2][2];
#pragma unroll
        for (int bj = 0; bj < 2; ++bj)
#pragma unroll
            for (int n = 0; n < 2; ++n) bv[bj][n] = *(const f32x4*)(bg + col0 + bj * 128 + 4 * n);
        EPI_LOOP { const int row = row0 + ai * 128 + m * 16; const size_t off = (size_t)row * 1024 + col0; const size_t poff = (size_t)row * LDP + gc0 + col0;
#pragma unroll
            for (int bj = 0; bj < 2; ++bj) { f32x4 g0, g1; unpack8(*(const u32x4*)(proj + poff + bj * 128), g0, g1);
                f32x4 v0 = sig4(g0 + bv[bj][0]) * acc[ai][bj][m][0], v1 = sig4(g1 + bv[bj][1]) * acc[ai][bj][m][1];
                if (ADD) { f32x4 p0, p1; unpack8(*(const u32x4*)(Prev + off + bj * 128), p0, p1); v0 += p0; v1 += p1; }
                *(u32x4*)(O + off + bj * 128) = pack8(v0, v1); } }
    }
};
struct EpiX1 {
    static constexpr bool PERM = false; const float* x; const float* mod; float* X1;
    __device__ __forceinline__ void operator()(const f32x4 (&acc)[2][2][4][2], const pg8::Unit& u, int wr, int wc, int fr, int fq) const {
        EPI_ROWS(u); const int col0 = u.pn * 256 + wc * 32 + 4 * fq; const int b = (u.pm * 256) / SEQ;
        f32x4 gv[2][2];
#pragma unroll
        for (int bj = 0; bj < 2; ++bj)
#pragma unroll
            for (int n = 0; n < 2; ++n) gv[bj][n] = *(const f32x4*)(mod + b * 6144 + 2 * D + col0 + bj * 128 + n * 16);
        EPI_LOOP { const size_t off = (size_t)(row0 + ai * 128 + m * 16) * D + col0;
#pragma unroll
            for (int bj = 0; bj < 2; ++bj)
#pragma unroll
                for (int n = 0; n < 2; ++n) *(f32x4*)(X1 + off + bj * 128 + n * 16) = *(const f32x4*)(x + off + bj * 128 + n * 16) + gv[bj][n] * acc[ai][bj][m][n]; }
    }
};
struct EpiSwiglu {
    static constexpr bool PERM = true; const float* bin; bf16* ACT;
    __device__ __forceinline__ void operator()(const f32x4 (&acc)[2][2][4][2], const pg8::Unit& u, int wr, int wc, int fr, int fq) const {
        EPI_ROWS(u); const int e = u.pn >> 3, pl = u.pn & 7; const int f0 = pl * 128 + wc * 32 + 8 * fq;
        f32x4 bg[2], bl[2];
#pragma unroll
        for (int n = 0; n < 2; ++n) { bg[n] = *(const f32x4*)(bin + e * 2048 + f0 + 4 * n); bl[n] = *(const f32x4*)(bin + e * 2048 + 1024 + f0 + 4 * n); }
        EPI_LOOP { f32x4 o[2];
#pragma unroll
            for (int n = 0; n < 2; ++n) { const f32x4 zg = acc[ai][0][m][n] + bg[n], zl = acc[ai][1][m][n] + bl[n];
#pragma unroll
                for (int j = 0; j < 4; ++j) { const float gl = fminf(zg[j], 7.0f); const float li = fminf(fmaxf(zl[j], -7.0f), 7.0f); o[n][j] = gl * sigmoidf_(1.702f * gl) * (li + 1.0f); } }
            *(u32x4*)(ACT + (size_t)(row0 + ai * 128 + m * 16) * 1024 + f0) = pack8(o[0], o[1]); }
    }
};
struct EpiY {
    static constexpr bool PERM = true; const float* bout; bf16* Y;
    __device__ __forceinline__ void operator()(const f32x4 (&acc)[2][2][4][2], const pg8::Unit& u, int wr, int wc, int fr, int fq) const {
        EPI_ROWS(u); const int e = u.pn >> 2, pl = u.pn & 3; const int col0 = pl * 256 + wc * 32 + 8 * fq;
        f32x4 bv[2][2];
#pragma unroll
        for (int bj = 0; bj < 2; ++bj)
#pragma unroll
            for (int n = 0; n < 2; ++n) bv[bj][n] = *(const f32x4*)(bout + e * 1024 + col0 + bj * 128 + 4 * n);
        EPI_LOOP { bf16* rowp = Y + (size_t)(row0 + ai * 128 + m * 16) * 1024 + col0;
#pragma unroll
            for (int bj = 0; bj < 2; ++bj) *(u32x4*)(rowp + bj * 128) = pack8(acc[ai][bj][m][0] + bv[bj][0], acc[ai][bj][m][1] + bv[bj][1]); }
    }
};

struct TItem { const float* src; bf16* dst; int ld, ldk; };
__device__ __forceinline__ void titem_load(const TItem& t, int lane, f32x4 (&r)[8]) {
#pragma unroll
    for (int i = 0; i < 8; ++i) r[i] = *(const f32x4*)(t.src + (size_t)(8 * i + (lane >> 3)) * t.ld + 4 * (lane & 7));
}
__device__ __forceinline__ void titem_store(const TItem& t, int lane, const f32x4 (&r)[8], LAS float* scr) {
#pragma unroll
    for (int i = 0; i < 8; ++i) { LAS float* p = scr + (8 * i + (lane >> 3)) * 33 + 4 * (lane & 7); p[0] = r[i][0]; p[1] = r[i][1]; p[2] = r[i][2]; p[3] = r[i][3]; }
    LDS_WAIT(); asm volatile("" ::: "memory");
    const int c = lane & 7;
#pragma unroll
    for (int j = 0; j < 4; ++j) { const int n = (lane >> 3) + 8 * j; const LAS float* s = scr + (8 * c) * 33 + n;
        v4u o; o.x = pk2(s[0 * 33], s[1 * 33]); o.y = pk2(s[2 * 33], s[3 * 33]); o.z = pk2(s[4 * 33], s[5 * 33]); o.w = pk2(s[6 * 33], s[7 * 33]);
        *(GAS v4u*)(t.dst + (size_t)n * t.ldk + 8 * c) = o; }
    LDS_WAIT(); asm volatile("" ::: "memory");
}
__device__ __forceinline__ void p0_prologue(Frame& F, const float* const* __restrict__ INP) {
    {
        LAS float* sc = (LAS float*)(F.lds);
        LAS float* red = (LAS float*)(F.lds + 9 * 1024 * 4);
        for (int i = F.tid; i < 9 * 1024; i += NWAVES * 64) { const int r = i >> 10, k = i & 1023; const float v = r < 8 ? INP[1][r * 1024 + k] : INP[3][k]; sc[i] = v / (1.0f + __expf(-v)); }
        __syncthreads();
        const float* wada = INP[4]; const float* bada = INP[5];
        float* mod = (float*)(F.ws + WS_MOD);
        for (int cg = blockIdx.x; cg < 256; cg += F.G) {
            const int j0 = cg * 24, col = F.lane & 31, kp = F.lane >> 5;
            float a[9];
#pragma unroll
            for (int r = 0; r < 9; ++r) a[r] = 0.f;
            if (col < 24) {
                for (int i = 0; i < 64; ++i) { const int k = F.wave * 128 + 2 * i + kp; const float wv = wada[(size_t)k * 6144 + j0 + col];
#pragma unroll
                    for (int r = 0; r < 9; ++r) a[r] += sc[r * 1024 + k] * wv; }
            }
#pragma unroll
            for (int r = 0; r < 9; ++r) red[((F.wave * 2 + kp) * 9 + r) * 32 + col] = a[r];
            __syncthreads();
            if (F.tid < 9 * 32) { const int r = F.tid >> 5, cc = F.tid & 31;
                if (cc < 24) { float s = 0.f; for (int p = 0; p < 16; ++p) s += red[(p * 9 + r) * 32 + cc]; const int j = j0 + cc; s += bada[j];
                    if (r < 8) mod[r * 6144 + j] = s; else if (j < 2048) mod[8 * 6144 + j] = s; } }
            __syncthreads();
        }
    }
    LAS float* scr = (LAS float*)(F.lds + F.wave * 16384);
    const int gw = F.vcu * NWAVES + F.wave, NGW = F.G * NWAVES;
    bf16* WIN = (bf16*)(F.ws + WS_WIN); bf16* WGLU = (bf16*)(F.ws + WS_WGLU); bf16* WA = (bf16*)(F.ws + WS_WA); bf16* WB = (bf16*)(F.ws + WS_WB); bf16* WO = (bf16*)(F.ws + WS_WO);
    bf16* WEIN = (bf16*)(F.ws + WS_WEIN); bf16* WEOUT = (bf16*)(F.ws + WS_WEOUT);
    constexpr int I_IN = 177 * 16, I_GLU = 16 * 8, I_A = 32 * 16, I_B = 32 * 8, I_O = 32 * 16, I_EIN = 32 * 64 * 16, I_EOUT = 32 * 32 * 16;
    constexpr int NITEMS = I_IN + I_GLU + I_A + I_B + I_O + I_EIN + I_EOUT;
#define P0_DECODE(it_, T) do { int r = (it_); \
        if (r < I_IN) { const int kb = r / 177, nb = r % 177, n0 = nb * 32; const int sc0 = n0 < 2048 ? n0 : (n0 < 5632 ? n0 + 32 : 2048); \
            T.src = INP[8] + (size_t)kb * 64 * 5664 + sc0; T.ld = 5664; T.dst = WIN + (size_t)n0 * 1024 + kb * 64; T.ldk = 1024; break; } r -= I_IN; \
        if (r < I_GLU) { const int kb = r / 16, nb = r % 16; T.src = INP[21] + (size_t)kb * 64 * 512 + nb * 32; T.ld = 512; T.dst = WGLU + (size_t)nb * 32 * 512 + kb * 64; T.ldk = 512; break; } r -= I_GLU; \
        if (r < I_A) { const int kb = r / 32, nb = r % 32; T.src = INP[12] + (size_t)kb * 64 * 1024 + nb * 32; T.ld = 1024; T.dst = WA + (size_t)nb * 32 * 1024 + kb * 64; T.ldk = 1024; break; } r -= I_A; \
        if (r < I_B) { const int kb = r / 32, nb = r % 32; T.src = INP[23] + (size_t)kb * 64 * 1024 + nb * 32; T.ld = 1024; T.dst = WB + (size_t)nb * 32 * 512 + kb * 64; T.ldk = 512; break; } r -= I_B; \
        if (r < I_O) { const int kb = r / 32, nb = r % 32; T.src = INP[25] + (size_t)kb * 64 * 1024 + nb * 32; T.ld = 1024; T.dst = WO + (size_t)nb * 32 * 1024 + kb * 64; T.ldk = 1024; break; } r -= I_O; \
        if (r < I_EIN) { const int e = r / 1024, q = r % 1024, kb = q / 64, nb = q % 64; const int dr = nb * 32, pn = dr >> 8, bj = (dr >> 7) & 1, xx = dr & 127; \
            T.src = INP[28] + (size_t)e * 1024 * 2048 + (size_t)kb * 64 * 2048 + bj * 1024 + pn * 128 + xx; T.ld = 2048; T.dst = WEIN + (size_t)e * 2048 * 1024 + (size_t)dr * 1024 + kb * 64; T.ldk = 1024; break; } r -= I_EIN; \
        { const int e = r / 512, q = r % 512, kb = q / 32, nb = q % 32; \
            T.src = INP[30] + (size_t)e * 1024 * 1024 + (size_t)kb * 64 * 1024 + nb * 32; T.ld = 1024; T.dst = WEOUT + (size_t)e * 1024 * 1024 + (size_t)nb * 32 * 1024 + kb * 64; T.ldk = 1024; } } while (0)
    {
        TItem ta, tb; f32x4 ra[8], rb[8];
        int it = gw;
        if (it < NITEMS) { P0_DECODE(it, ta); titem_load(ta, F.lane, ra); }
        while (it < NITEMS) {
            const int nx = it + NGW;
            if (nx < NITEMS) { P0_DECODE(nx, tb); titem_load(tb, F.lane, rb); }
            titem_store(ta, F.lane, ra, scr);
            ta = tb;
#pragma unroll
            for (int i = 0; i < 8; ++i) ra[i] = rb[i];
            it = nx;
        }
    }
#undef P0_DECODE
    { const int gt = blockIdx.x * (NWAVES * 64) + F.tid, NT = F.G * NWAVES * 64; GAS v4u* z = (GAS v4u*)(WIN + (size_t)5664 * 1024);
        for (int i = gt; i < 224 * 1024 / 8; i += NT) z[i] = (v4u){0u, 0u, 0u, 0u}; }
}

__device__ __forceinline__ void p1_norm1(Frame& F, const float* const* __restrict__ INP) {
    const int gw = F.vcu * NWAVES + F.wave, NGW = F.G * NWAVES;
    const float* mod = (const float*)(F.ws + WS_MOD); bf16* H1 = (bf16*)(F.ws + WS_H1);
    for (int m = gw; m < MT; m += NGW) {
        const float* xr; const float* sh; const float* scl;
        if (m < ML) { const int b = m / SEQ; xr = INP[0] + (size_t)m * D; sh = mod + b * 6144; scl = sh + D; }
        else { xr = INP[2] + (size_t)(m - ML) * D; sh = mod + 8 * 6144; scl = sh + D; }
        f32x4 v[4]; float s = 0.f;
#pragma unroll
        for (int j = 0; j < 4; ++j) { v[j] = *(const f32x4*)(xr + 256 * j + 4 * F.lane); s += (v[j][0] * v[j][0] + v[j][1] * v[j][1]) + (v[j][2] * v[j][2] + v[j][3] * v[j][3]); }
        const float rstd = 1.0f / sqrtf(wave_sum(s) * (1.0f / D) + EPS);
#pragma unroll
        for (int j = 0; j < 4; ++j) { const int c = 256 * j + 4 * F.lane; const f32x4 g = *(const f32x4*)(INP[6] + c), a = *(const f32x4*)(scl + c), bb = *(const f32x4*)(sh + c);
            const f32x4 y = v[j] * rstd * g * (a + 1.0f) + bb;
            *(v2u*)(H1 + (size_t)m * D + c) = (v2u){pk2(y[0], y[1]), pk2(y[2], y[3])}; }
    }
}

__device__ __forceinline__ void p3_conv(Frame& F, const float* const* __restrict__ INP) {
    const bf16* PROJ = (const bf16*)(F.ws + WS_PROJ); bf16* QKC = (bf16*)(F.ws + WS_QKC); const float* wc = INP[9];
    const int NT = F.G * NWAVES * 64;
    for (int w = F.vcu * (NWAVES * 64) + F.tid; w < MT * 128; w += NT) {
        const int row = w >> 7, ch0 = (w & 127) * 8;
        float a[8];
#pragma unroll
        for (int j = 0; j < 8; ++j) a[j] = 0.f;
        if (row < ML) {
            const int b = row / SEQ, t = row % SEQ, gr = t >> 6, gc = t & 63;
#pragma unroll
            for (int ky = 0; ky < 3; ++ky)
#pragma unroll
                for (int kx = 0; kx < 3; ++kx) { const int rr = gr + ky - 1, cc = gc + kx - 1;
                    if (rr >= 0 && rr < 64 && cc >= 0 && cc < 64) { const v4u x = *(const v4u*)(PROJ + (size_t)(b * SEQ + rr * 64 + cc) * LDP + ch0);
                        const f32x4 w0 = *(const f32x4*)(wc + (ky * 3 + kx) * 1024 + ch0), w1 = *(const f32x4*)(wc + (ky * 3 + kx) * 1024 + ch0 + 4);
                        a[0] += bflo(x.x) * w0[0]; a[1] += bfhi(x.x) * w0[1]; a[2] += bflo(x.y) * w0[2]; a[3] += bfhi(x.y) * w0[3];
                        a[4] += bflo(x.z) * w1[0]; a[5] += bfhi(x.z) * w1[1]; a[6] += bflo(x.w) * w1[2]; a[7] += bfhi(x.w) * w1[3]; } }
        } else {
            const int rc = row - ML, t = rc % CTXL;
#pragma unroll
            for (int kx = 0; kx < 3; ++kx) { const int tt = t + kx - 1;
                if (tt >= 0 && tt < CTXL) { const v4u x = *(const v4u*)(PROJ + (size_t)(row + kx - 1) * LDP + ch0);
                    const f32x4 w0 = *(const f32x4*)(wc + (3 + kx) * 1024 + ch0), w1 = *(const f32x4*)(wc + (3 + kx) * 1024 + ch0 + 4);
                    a[0] += bflo(x.x) * w0[0]; a[1] += bfhi(x.x) * w0[1]; a[2] += bflo(x.y) * w0[2]; a[3] += bfhi(x.y) * w0[3];
                    a[4] += bflo(x.z) * w1[0]; a[5] += bfhi(x.z) * w1[1]; a[6] += bflo(x.w) * w1[2]; a[7] += bfhi(x.w) * w1[3]; } }
        }
        const float scale = ch0 < 512 ? 0.125f : 1.0f;
#pragma unroll
        for (int j = 0; j < 8; ++j) a[j] = a[j] / (1.0f + __expf(-a[j])) * scale;
        *(v4u*)(QKC + (size_t)row * 1024 + ch0) = (v4u){pk2(a[0], a[1]), pk2(a[2], a[3]), pk2(a[4], a[5]), pk2(a[6], a[7])};
    }
    {
        float* GB = (float*)(F.ws + WS_GS); float* GG = GB + 128 * 4352; float* GP = GG + 128 * 4352;
        const int gw = F.vcu * NWAVES + F.wave, NGW = F.G * NWAVES, lane = F.lane;
        for (int it = gw; it < 128 * 34; it += NGW) {
            const int jc = it % 34, dbh = it / 34, h = dbh & 7, b = (dbh >> 3) & 7, d = dbh >> 6;
            const bool lat = jc >= 2; const int p0 = lat ? 128 * (jc - 2) : 128 * jc, Lseq = lat ? SEQ : CTXL, rowbase = lat ? b * SEQ : ML + b * CTXL;
            const float bi_ = INP[10][d * 16 + h], bf_ = INP[10][d * 16 + 8 + h];
            float li2[2], lf2[2];
#pragma unroll
            for (int e = 0; e < 2; ++e) { const int sp = 2 * lane + e; const int tt = d ? (Lseq - 1 - (p0 + sp)) : (p0 + sp); const size_t row = (size_t)(rowbase + tt);
                li2[e] = bf2f(PROJ[row * LDP + PC_IF + d * 16 + h]) + bi_; const float xf = bf2f(PROJ[row * LDP + PC_IF + d * 16 + 8 + h]) + bf_;
                lf2[e] = fminf(xf, 0.f) - log1pf(expf(-fabsf(xf))); }
            const float c1 = lf2[0] + lf2[1]; float inc = c1;
#pragma unroll
            for (int o = 1; o < 64; o <<= 1) { const float t = __shfl_up(inc, o); if (lane >= o) inc += t; }
            const float exc = inc - c1, b0 = exc + lf2[0], b1 = exc + c1, g0 = li2[0] - b0, g1 = li2[1] - b1;
            float pmx = fmaxf(g0, g1);
#pragma unroll
            for (int o = 1; o < 64; o <<= 1) { const float t = __shfl_up(pmx, o); if (lane >= o) pmx = fmaxf(pmx, t); }
            float pex = __shfl_up(pmx, 1); if (lane == 0) pex = -INFINITY;
            const size_t o = (size_t)dbh * 4352 + 128 * jc + 2 * lane;
            *(float2*)(GB + o) = make_float2(b0, b1); *(float2*)(GG + o) = make_float2(g0, g1); *(float2*)(GP + o) = make_float2(fmaxf(pex, g0), pmx);
        }
    }
}

__device__ __forceinline__ void mma32_nt(f32x16& acc, const LAS bf16* A, int lda, const LAS bf16* Bt, int ldb, int K, int lane) {
    const int r = lane & 31, h = lane >> 5;
#pragma unroll
    for (int k0 = 0; k0 < K; k0 += 16) {
        const bf16x8 a = *(const LAS bf16x8*)(A + r * lda + k0 + 8 * h);
        const bf16x8 b = *(const LAS bf16x8*)(Bt + r * ldb + k0 + 8 * h);
        acc = __builtin_amdgcn_mfma_f32_32x32x16_bf16(a, b, acc, 0, 0, 0);
        if ((k0 & 63) == 48) __builtin_amdgcn_sched_barrier(0);
    }
}
__device__ __forceinline__ void mma16_nt(f32x4& acc, const LAS bf16* A, int lda, const LAS bf16* Bt, int ldb, int K, int lane) {
    const int r = lane & 15, q = lane >> 4;
    for (int k0 = 0; k0 < K; k0 += 32) {
        const bf16x8 a = *(const LAS bf16x8*)(A + r * lda + k0 + 8 * q);
        const bf16x8 b = *(const LAS bf16x8*)(Bt + r * ldb + k0 + 8 * q);
        acc = __builtin_amdgcn_mfma_f32_16x16x32_bf16(a, b, acc, 0, 0, 0);
    }
}
__device__ __forceinline__ int row32(int reg, int lane) { return (reg & 3) + 8 * (reg >> 2) + 4 * (lane >> 5); }
__device__ __forceinline__ float logsigmoidf_(float x) { return fminf(x, 0.f) - log1pf(expf(-fabsf(x))); }

typedef short s16x4 __attribute__((ext_vector_type(4)));
__device__ __forceinline__ s16x4 tr_read(const LAS bf16* p) { return __builtin_amdgcn_ds_read_tr16_b64_v4i16((LAS s16x4*)p); }
__device__ __forceinline__ bf16x8 tr_frag32_perm(const LAS bf16* T, int ld, int k0, int x0, int lane) {
    const int h = lane >> 5, i = lane & 15, q = i >> 2, p = i & 3, xb = 16 * ((lane >> 4) & 1);
    const LAS bf16* a = T + (k0 + 4 * h + q) * ld + x0 + xb + 4 * p;
    const s16x4 lo = tr_read(a), hi = tr_read(a + 8 * ld);
    return (bf16x8){lo[0], lo[1], lo[2], lo[3], hi[0], hi[1], hi[2], hi[3]};
}
__device__ __forceinline__ bf16x8 tr_frag16(const LAS bf16* T, int ld, int k0, int x0, int lane) {
    const int q4 = lane >> 4, i = lane & 15, q = i >> 2, p = i & 3;
    const LAS bf16* a = T + (k0 + 8 * q4 + q) * ld + x0 + 4 * p;
    const s16x4 lo = tr_read(a), hi = tr_read(a + 4 * ld);
    return (bf16x8){lo[0], lo[1], lo[2], lo[3], hi[0], hi[1], hi[2], hi[3]};
}
__device__ __forceinline__ v4u scale8(const v4u k8, float ww) {
    return (v4u){pk2(ww * bflo(k8.x), ww * bfhi(k8.x)), pk2(ww * bflo(k8.y), ww * bfhi(k8.y)), pk2(ww * bflo(k8.z), ww * bfhi(k8.z)), pk2(ww * bflo(k8.w), ww * bfhi(k8.w))};
}

template <int MODE>
__device__ __forceinline__ void p4_mlstm(Frame& F, const float* const* __restrict__ INP, int unit) {
    const int vh = unit & 1, h = (unit >> 1) & 7, b = (unit >> 4) & 7, d = unit >> 7;
    LAS bf16* Qs = (LAS bf16*)(F.lds + 0);
    LAS bf16* Ks = (LAS bf16*)(F.lds + 18432);
    LAS bf16* Kw = (LAS bf16*)(F.lds + 36864);
    LAS bf16* Vs = (LAS bf16*)(F.lds + 55296);
    LAS bf16* Cb = (LAS bf16*)(F.lds + 73728);
    LAS float* vec = (LAS float*)(F.lds + 82944);
    LAS float *rowt = vec, *colt = vec + 128, *iev = vec + 256, *emt = vec + 384, *nv = vec + 512, *npart = vec + 576;
    const bf16* PROJ = (const bf16*)(F.ws + WS_PROJ); const bf16* QKC = (const bf16*)(F.ws + WS_QKC); bf16* HDIR = (bf16*)(F.ws + WS_HDIR) + (size_t)d * ML * 1024;
    const float* GB = (const float*)(F.ws + WS_GS) + (size_t)((d * 8 + b) * 8 + h) * 4352; const float* GG = GB + 128 * 4352; const float* GP = GG + 128 * 4352;
    int tid = F.tid; asm volatile("" : "+v"(tid));
    const int lane = tid & 63, w = F.wave;
    for (int i = tid; i < 64 * 72; i += 512) Cb[i] = 0;
    if (tid < 64) nv[tid] = 0.f;
    f32x4 accC[2] = {(f32x4){0.f, 0.f, 0.f, 0.f}, (f32x4){0.f, 0.f, 0.f, 0.f}};
    float m_old = 0.f, dec_prev = 0.f;
    v4u pq[2], pk[2], pv[2]; float pgb = 0.f, pgp = 0.f, pgc = 0.f, pgg[2], pbend, pgmax; v2u hout[4]; bf16* hptr = nullptr; bool hpend = false;
    const int zl = tid >> 9;
#define ML_PREFETCH(jn) do { const bool lat_ = (jn) >= 2; const int p0_ = lat_ ? 128 * ((jn) - 2) : 128 * (jn), L_ = lat_ ? SEQ : CTXL, rb_ = lat_ ? b * SEQ : ML + b * CTXL; \
        _Pragma("unroll") for (int i = 0; i < 2; ++i) { const int id = tid + 512 * i, s_ = id >> 3, c_ = id & 7; const int tt = d ? (L_ - 1 - (p0_ + s_)) : (p0_ + s_); const size_t row = (size_t)(rb_ + tt); \
            pq[i] = *(const v4u*)(QKC + row * 1024 + h * 64 + c_ * 8); pk[i] = *(const v4u*)(QKC + row * 1024 + 512 + h * 64 + c_ * 8); pv[i] = *(const v4u*)(PROJ + row * LDP + PC_V + h * 128 + vh * 64 + c_ * 8); \
            pgg[i] = GG[128 * (jn) + s_]; } \
        if (tid < 128) { pgb = GB[128 * (jn) + tid]; pgp = GP[128 * (jn) + tid]; pgc = GG[128 * (jn) + tid]; } \
        pbend = GB[128 * (jn) + 127 + zl]; pgmax = GP[128 * (jn) + 127 + zl]; } while (0)
    ML_PREFETCH(0);
    __syncthreads();
    for (int j = 0; j < 34; ++j) {
        const bool lat = j >= 2;
        const int p0 = lat ? 128 * (j - 2) : 128 * j, Lseq = lat ? SEQ : CTXL, rowbase = lat ? b * SEQ : ML + b * CTXL;
        const float bend = pbend, gmax = pgmax;
        const float mnew = fmaxf(bend + m_old, bend + gmax), dec = __expf(bend + m_old - mnew);
#pragma unroll
        for (int i = 0; i < 2; ++i) { const int id = tid + 512 * i, s = id >> 3, c = id & 7;
            *(LAS v4u*)(Qs + s * 72 + c * 8) = pq[i]; *(LAS v4u*)(Ks + s * 72 + c * 8) = pk[i]; *(LAS v4u*)(Vs + s * 72 + c * 8) = pv[i];
            *(LAS v4u*)(Kw + s * 72 + c * 8) = scale8(pk[i], __expf(bend + pgg[i] - mnew)); }
        if (tid < 128) { const float r = fmaxf(m_old, pgp); rowt[tid] = -r; colt[tid] = pgc; iev[tid] = __expf(m_old - r); emt[tid] = __expf(-pgb - r); }
        if (j > 0) {
            const int vi = w >> 1;
#pragma unroll
            for (int jj = 0; jj < 2; ++jj) { const int ki = 2 * (w & 1) + jj;
#pragma unroll
                for (int reg = 0; reg < 4; ++reg) Cb[(16 * vi + (lane >> 4) * 4 + reg) * 72 + 16 * ki + (lane & 15)] = (bf16)f2bf(accC[jj][reg]); }
            if (tid < 64) { float sacc = 0.f;
#pragma unroll
                for (int p = 0; p < 8; ++p) sacc += npart[p * 64 + tid];
                nv[tid] = dec_prev * nv[tid] + sacc; }
        }
        LBAR();
        if (j + 1 < 34 && !(MODE & 4)) ML_PREFETCH(j + 1);
        if (hpend) {
#pragma unroll
            for (int rg = 0; rg < 4; ++rg) *(v2u*)(hptr + 8 * rg) = hout[rg];
            hpend = false; }
        if (lat && !(MODE & 1)) { const int tm = w >> 1, vt = w & 1, tl = lane & 31, t = 32 * tm + tl, hh = lane >> 5; f32x16 acc;
#pragma unroll
            for (int reg = 0; reg < 16; ++reg) acc[reg] = 0.f;
            mma32_nt(acc, Cb + 32 * vt * 72, 72, Qs + 32 * tm * 72, 72, 64, lane);
            const float ie = iev[t], rt = rowt[t];
#pragma unroll
            for (int reg = 0; reg < 16; ++reg) acc[reg] *= ie;
            float rs = 0.f;
            for (int st = 0; st <= tm; ++st) {
                f32x16 X;
#pragma unroll
                for (int reg = 0; reg < 16; ++reg) X[reg] = 0.f;
                mma32_nt(X, Ks + 32 * st * 72, 72, Qs + 32 * tm * 72, 72, 64, lane);
                const LAS float* cp = colt + 32 * st + 4 * hh; const int dlim = (st == tm) ? tl - 4 * hh : 64;
#pragma unroll
                for (int rg = 0; rg < 4; ++rg) { const f32x4 c4 = *(const LAS f32x4*)(cp + 8 * rg);
#pragma unroll
                    for (int e = 0; e < 4; ++e) { const float arg = (8 * rg + e <= dlim) ? c4[e] + rt : -INFINITY; const float pvv = X[4 * rg + e] * __expf(arg); X[4 * rg + e] = pvv; rs += pvv; } }
#pragma unroll
                for (int ks = 0; ks < 2; ++ks) {
                    const v4u bw = (v4u){cvtpk(X[8 * ks], X[8 * ks + 1]), cvtpk(X[8 * ks + 2], X[8 * ks + 3]), cvtpk(X[8 * ks + 4], X[8 * ks + 5]), cvtpk(X[8 * ks + 6], X[8 * ks + 7])};
                    const bf16x8 af = tr_frag32_perm(Vs, 72, 32 * st + 16 * ks, 32 * vt, lane);
                    acc = __builtin_amdgcn_mfma_f32_32x32x16_bf16(af, __builtin_bit_cast(bf16x8, bw), acc, 0, 0, 0); }
            }
            float nq = 0.f;
#pragma unroll
            for (int q = 0; q < 4; ++q) { const v4u q8 = *(const LAS v4u*)(Qs + t * 72 + 32 * hh + 8 * q); const LAS float* nn = nv + 32 * hh + 8 * q;
                nq += bflo(q8.x) * nn[0] + bfhi(q8.x) * nn[1] + bflo(q8.y) * nn[2] + bfhi(q8.y) * nn[3] + bflo(q8.z) * nn[4] + bfhi(q8.z) * nn[5] + bflo(q8.w) * nn[6] + bfhi(q8.w) * nn[7]; }
            rs += __shfl_xor(rs, 32); nq += __shfl_xor(nq, 32);
            const float rd = 1.0f / fmaxf(fabsf(ie * nq + rs), emt[t]);
            const int tt = d ? (Lseq - 1 - (p0 + t)) : (p0 + t);
            hptr = HDIR + (size_t)(rowbase + tt) * 1024 + h * 128 + vh * 64 + 32 * vt + 4 * hh;
#pragma unroll
            for (int rg = 0; rg < 4; ++rg) hout[rg] = (v2u){pk2(acc[4 * rg] * rd, acc[4 * rg + 1] * rd), pk2(acc[4 * rg + 2] * rd, acc[4 * rg + 3] * rd)};
            hpend = true; }
        if (!(MODE & 2)) { const int vi = w >> 1;
            accC[0] *= dec; accC[1] *= dec;
#pragma unroll
            for (int st4 = 0; st4 < 4; ++st4) { const bf16x8 af = tr_frag16(Vs, 72, 32 * st4, 16 * vi, lane);
#pragma unroll
                for (int jj = 0; jj < 2; ++jj) { const bf16x8 bfr = tr_frag16(Kw, 72, 32 * st4, 16 * (2 * (w & 1) + jj), lane); accC[jj] = __builtin_amdgcn_mfma_f32_16x16x32_bf16(af, bfr, accC[jj], 0, 0, 0); } } }
        { const int k = tid & 63, part = tid >> 6; float sacc = 0.f;
#pragma unroll
            for (int q = 0; q < 16; ++q) sacc += bf2f(Kw[(16 * part + q) * 72 + k]);
            npart[part * 64 + k] = sacc; }
        m_old = mnew; dec_prev = dec;
        LBAR();
    }
    if (hpend) {
#pragma unroll
        for (int rg = 0; rg < 4; ++rg) *(v2u*)(hptr + 8 * rg) = hout[rg]; }
#undef ML_PREFETCH
}

__device__ __forceinline__ void s5_disc(const float* const* __restrict__ INP, int d, int g, int p, float& ar, float& ai, float& cfr, float& cfi) {
    const float dt = expf(INP[15][d * 32 + g]); const float are = INP[13][(d * 32 + g) * 64 + p], aim = INP[14][(d * 32 + g) * 64 + p];
    const float mag = expf(dt * are), ang = dt * aim; ar = mag * cosf(ang); ai = mag * sinf(ang);
    const float den = are * are + aim * aim, xr = ar - 1.0f; cfr = (xr * are + ai * aim) / den; cfi = (ai * are - xr * aim) / den;
}
__device__ __forceinline__ void p4_s5(Frame& F, const float* const* __restrict__ INP, int unit) {
    const int gp = unit & 15, b = (unit >> 4) & 7, d = unit >> 7;
    LAS bf16* BHt = (LAS bf16*)(F.lds + 0);
    LAS bf16* Cm = (LAS bf16*)(F.lds + 69632);
    LAS float* Eb = (LAS float*)(F.lds + 78336);
    LAS bf16* Us = (LAS bf16*)(F.lds + 82432);
    LAS bf16* BBs = (LAS bf16*)(F.lds + 92672);
    const bf16* PROJ = (const bf16*)(F.ws + WS_PROJ); bf16* YDIR = (bf16*)(F.ws + WS_YDIR) + (size_t)d * ML * 512;
    int tid = F.tid; asm volatile("" : "+v"(tid));
    const int lane = tid & 63, w = F.wave;
    const int sg = tid & 127, seg = tid >> 7;
    float ar, ai, a32r, a32i;
    { float cfr, cfi; s5_disc(INP, d, 2 * gp + (sg >> 6), sg & 63, ar, ai, cfr, cfi); a32r = ar; a32i = ai;
#pragma unroll
        for (int q = 0; q < 5; ++q) { const float nr = a32r * a32r - a32i * a32i, ni = 2.0f * a32r * a32i; a32r = nr; a32i = ni; } }
    for (int idx = tid; idx < 4096; idx += 512) {
        { const int gg = idx >> 11, pp = (idx >> 4) & 127, c = idx & 15, g = 2 * gp + gg, p = pp & 63; float xr_, xi_, cfr, cfi; s5_disc(INP, d, g, p, xr_, xi_, cfr, cfi);
            const float bre = INP[16][((size_t)(d * 32 + g) * 64 + p) * 16 + c], bim = INP[17][((size_t)(d * 32 + g) * 64 + p) * 16 + c];
            BBs[(gg * 128 + pp) * 24 + c] = (bf16)f2bf(pp < 64 ? cfr * bre - cfi * bim : cfr * bim + cfi * bre); }
        { const int gg = idx >> 11, c = (idx >> 7) & 15, pp = idx & 127, g = 2 * gp + gg, p = pp & 63;
            const float v = pp < 64 ? INP[18][((size_t)(d * 32 + g) * 16 + c) * 64 + p] : -INP[19][((size_t)(d * 32 + g) * 16 + c) * 64 + p];
            Cm[(gg * 16 + c) * 136 + pp] = (bf16)f2bf(v); }
    }
    float h0r = 0.f, h0i = 0.f;
    LAS bf16* rowre = BHt + ((sg >> 6) * 128 + (sg & 63)) * 136 + 32 * seg;
    v4u pu; v2u yout[2]; bf16* yptr[2]; bool ypend = false;
#define S5_PREFETCH(jn) do { const bool lat_ = (jn) >= 2; const int p0_ = lat_ ? 128 * ((jn) - 2) : 128 * (jn), L_ = lat_ ? SEQ : CTXL, rb_ = lat_ ? b * SEQ : ML + b * CTXL; \
        const int s_ = tid >> 2, c_ = tid & 3; const int tt = d ? (L_ - 1 - (p0_ + s_)) : (p0_ + s_); pu = *(const v4u*)(PROJ + (size_t)(rb_ + tt) * LDP + PC_U + gp * 32 + c_ * 8); } while (0)
    S5_PREFETCH(0);
    __syncthreads();
    for (int j = 0; j < 34; ++j) {
        const bool lat = j >= 2;
        const int p0 = lat ? 128 * (j - 2) : 128 * j, Lseq = lat ? SEQ : CTXL, rowbase = lat ? b * SEQ : ML + b * CTXL;
        *(LAS v4u*)(Us + (tid >> 2) * 40 + (tid & 3) * 8) = pu;
        LBAR();
        if (j + 1 < 34) S5_PREFETCH(j + 1);
        if (ypend) { *(v2u*)yptr[0] = yout[0]; *(v2u*)yptr[1] = yout[1]; ypend = false; }
        { const int gg = w >> 2, tm = w & 3, r = lane & 31, hh = lane >> 5;
            const bf16x8 a = *(const LAS bf16x8*)(Us + (32 * tm + r) * 40 + gg * 16 + 8 * hh);
            LAS bf16* bp = BHt + (gg * 128 + r) * 136 + 32 * tm + 4 * hh;
#pragma unroll
            for (int tn = 0; tn < 4; ++tn) { f32x16 acc;
#pragma unroll
                for (int reg = 0; reg < 16; ++reg) acc[reg] = 0.f;
                const bf16x8 bb = *(const LAS bf16x8*)(BBs + (gg * 128 + 32 * tn + r) * 24 + 8 * hh);
                acc = __builtin_amdgcn_mfma_f32_32x32x16_bf16(a, bb, acc, 0, 0, 0);
#pragma unroll
                for (int rg = 0; rg < 4; ++rg) *(LAS v2u*)(bp + 32 * tn * 136 + 8 * rg) = (v2u){cvtpk(acc[4 * rg], acc[4 * rg + 1]), cvtpk(acc[4 * rg + 2], acc[4 * rg + 3])}; } }
        LBAR();
        v4u xr[4], xi[4];
#pragma unroll
        for (int q = 0; q < 4; ++q) { xr[q] = *(const LAS v4u*)(rowre + 8 * q); xi[q] = *(const LAS v4u*)(rowre + 64 * 136 + 8 * q); }
        { float hr = 0.f, hi = 0.f;
#pragma unroll
            for (int q = 0; q < 4; ++q)
#pragma unroll
                for (int e = 0; e < 4; ++e) { const unsigned wr_ = xr[q][e], wi_ = xi[q][e];
                    { const float br = bflo(wr_), bi = bflo(wi_); const float nr = ar * hr - ai * hi + br, ni = ar * hi + ai * hr + bi; hr = nr; hi = ni; }
                    { const float br = bfhi(wr_), bi = bfhi(wi_); const float nr = ar * hr - ai * hi + br, ni = ar * hi + ai * hr + bi; hr = nr; hi = ni; } }
            Eb[(seg * 128 + sg) * 2] = hr; Eb[(seg * 128 + sg) * 2 + 1] = hi; }
        LBAR();
        { float hcr = h0r, hci = h0i, hr = 0.f, hi = 0.f;
#pragma unroll
            for (int s2 = 0; s2 < 4; ++s2) { if (s2 == seg) { hr = hcr; hi = hci; } const float er = Eb[(s2 * 128 + sg) * 2], ei = Eb[(s2 * 128 + sg) * 2 + 1];
                const float nr = a32r * hcr - a32i * hci + er, ni = a32r * hci + a32i * hcr + ei; hcr = nr; hci = ni; }
            h0r = hcr; h0i = hci;
#pragma unroll
            for (int q = 0; q < 4; ++q) { v4u orr, oi;
#pragma unroll
                for (int e = 0; e < 4; ++e) { const unsigned wr_ = xr[q][e], wi_ = xi[q][e]; float r0, i0, r1, i1;
                    { const float br = bflo(wr_), bi = bflo(wi_); const float nr = ar * hr - ai * hi + br, ni = ar * hi + ai * hr + bi; hr = nr; hi = ni; r0 = hr; i0 = hi; }
                    { const float br = bfhi(wr_), bi = bfhi(wi_); const float nr = ar * hr - ai * hi + br, ni = ar * hi + ai * hr + bi; hr = nr; hi = ni; r1 = hr; i1 = hi; }
                    orr[e] = cvtpk(r0, r1); oi[e] = cvtpk(i0, i1); }
                *(LAS v4u*)(rowre + 8 * q) = orr; *(LAS v4u*)(rowre + 64 * 136 + 8 * q) = oi; } }
        LBAR();
        if (lat) { const int gg = w >> 2;
#pragma unroll
            for (int jj = 0; jj < 2; ++jj) { const int tm = 2 * (w & 3) + jj; f32x4 acc = (f32x4){0.f, 0.f, 0.f, 0.f};
#pragma unroll
                for (int st4 = 0; st4 < 4; ++st4) { const bf16x8 af = *(const LAS bf16x8*)(Cm + (gg * 16 + (lane & 15)) * 136 + 32 * st4 + 8 * (lane >> 4));
                    const bf16x8 bfr = tr_frag16(BHt + gg * 128 * 136, 136, 32 * st4, 16 * tm, lane);
                    acc = __builtin_amdgcn_mfma_f32_16x16x32_bf16(af, bfr, acc, 0, 0, 0); }
                const int t = 16 * tm + (lane & 15); const int tt = d ? (Lseq - 1 - (p0 + t)) : (p0 + t);
                yptr[jj] = YDIR + (size_t)(rowbase + tt) * 512 + (2 * gp + gg) * 16 + 4 * (lane >> 4); yout[jj] = (v2u){pk2(acc[0], acc[1]), pk2(acc[2], acc[3])}; }
            ypend = true; }
    }
    if (ypend) { *(v2u*)yptr[0] = yout[0]; *(v2u*)yptr[1] = yout[1]; }
#undef S5_PREFETCH
    __syncthreads();
}

__device__ __forceinline__ float gelu_tanh(float x) { const float u = 0.7978845608028654f * (x + 0.044715f * x * x * x); const float e = __expf(2.0f * u); const float th = 1.0f - 2.0f / (e + 1.0f); return 0.5f * x * (1.0f + th); }
__device__ __forceinline__ void p5a_prep(Frame& F, const float* const* __restrict__ INP) {
    const int gw = F.vcu * NWAVES + F.wave, NGW = F.G * NWAVES, lane = F.lane;
    const bf16* PROJ = (const bf16*)(F.ws + WS_PROJ); const bf16* HD0 = (const bf16*)(F.ws + WS_HDIR); const bf16* HD1 = HD0 + (size_t)ML * 1024;
    const bf16* YD0 = (const bf16*)(F.ws + WS_YDIR); const bf16* YD1 = YD0 + (size_t)ML * 512;
    bf16* A1 = (bf16*)(F.ws + WS_A1); bf16* A2 = (bf16*)(F.ws + WS_A2);
    for (int m = gw; m < ML; m += NGW) {
        float hm[16]; float ss = 0.f;
#pragma unroll
        for (int q = 0; q < 2; ++q) { const v4u a = *(const v4u*)(HD0 + (size_t)m * 1024 + 16 * lane + 8 * q), bq = *(const v4u*)(HD1 + (size_t)m * 1024 + 16 * lane + 8 * q);
            hm[8 * q + 0] = bflo(a.x) + bflo(bq.x); hm[8 * q + 1] = bfhi(a.x) + bfhi(bq.x); hm[8 * q + 2] = bflo(a.y) + bflo(bq.y); hm[8 * q + 3] = bfhi(a.y) + bfhi(bq.y);
            hm[8 * q + 4] = bflo(a.z) + bflo(bq.z); hm[8 * q + 5] = bfhi(a.z) + bfhi(bq.z); hm[8 * q + 6] = bflo(a.w) + bflo(bq.w); hm[8 * q + 7] = bfhi(a.w) + bfhi(bq.w); }
#pragma unroll
        for (int q = 0; q < 16; ++q) ss += hm[q] * hm[q];
        ss += __shfl_xor(ss, 1); ss += __shfl_xor(ss, 2); ss += __shfl_xor(ss, 4);
        const float rs = 1.0f / sqrtf(ss * (1.0f / 128.0f) + EPS);
#pragma unroll
        for (int q = 0; q < 2; ++q) { const v4u o8 = *(const v4u*)(PROJ + (size_t)m * LDP + PC_O + 16 * lane + 8 * q); const float* gm = INP[11] + 16 * lane + 8 * q;
            float r[8]; const float og[8] = {bflo(o8.x), bfhi(o8.x), bflo(o8.y), bfhi(o8.y), bflo(o8.z), bfhi(o8.z), bflo(o8.w), bfhi(o8.w)};
#pragma unroll
            for (int e = 0; e < 8; ++e) r[e] = hm[8 * q + e] * rs * gm[e] * sigmoidf_(og[e]);
            *(v4u*)(A1 + (size_t)m * 1024 + 16 * lane + 8 * q) = (v4u){pk2(r[0], r[1]), pk2(r[2], r[3]), pk2(r[4], r[5]), pk2(r[6], r[7])}; }
        { const v4u a = *(const v4u*)(YD0 + (size_t)m * 512 + 8 * lane), bq = *(const v4u*)(YD1 + (size_t)m * 512 + 8 * lane), u8 = *(const v4u*)(PROJ + (size_t)m * LDP + PC_U + 8 * lane);
            const float* dd = INP[20] + 8 * lane;
            float r[8] = {bflo(a.x) + bflo(bq.x) + dd[0] * bflo(u8.x), bfhi(a.x) + bfhi(bq.x) + dd[1] * bfhi(u8.x), bflo(a.y) + bflo(bq.y) + dd[2] * bflo(u8.y), bfhi(a.y) + bfhi(bq.y) + dd[3] * bfhi(u8.y),
                          bflo(a.z) + bflo(bq.z) + dd[4] * bflo(u8.z), bfhi(a.z) + bfhi(bq.z) + dd[5] * bfhi(u8.z), bflo(a.w) + bflo(bq.w) + dd[6] * bflo(u8.w), bfhi(a.w) + bfhi(bq.w) + dd[7] * bfhi(u8.w)};
#pragma unroll
            for (int e = 0; e < 8; ++e) r[e] = gelu_tanh(r[e]);
            *(v4u*)(A2 + (size_t)m * 512 + 8 * lane) = (v4u){pk2(r[0], r[1]), pk2(r[2], r[3]), pk2(r[4], r[5]), pk2(r[6], r[7])}; }
    }
}

__device__ __forceinline__ void route_reduce_top4(float (&acc)[32], const float* br, int lane, float (&tv)[4], int (&ti)[4]) {
#pragma unroll
    for (int i = 0; i < 16; ++i) { const float send = (lane & 32) ? acc[i] : acc[i + 16]; const float keep = (lane & 32) ? acc[i + 16] : acc[i]; acc[i] = keep + __shfl_xor(send, 32); }
#pragma unroll
    for (int i = 0; i < 8; ++i) { const float send = (lane & 16) ? acc[i] : acc[i + 8]; const float keep = (lane & 16) ? acc[i + 8] : acc[i]; acc[i] = keep + __shfl_xor(send, 16); }
#pragma unroll
    for (int i = 0; i < 4; ++i) { const float send = (lane & 8) ? acc[i] : acc[i + 4]; const float keep = (lane & 8) ? acc[i + 4] : acc[i]; acc[i] = keep + __shfl_xor(send, 8); }
#pragma unroll
    for (int i = 0; i < 2; ++i) { const float send = (lane & 4) ? acc[i] : acc[i + 2]; const float keep = (lane & 4) ? acc[i + 2] : acc[i]; acc[i] = keep + __shfl_xor(send, 4); }
    { const float send = (lane & 2) ? acc[0] : acc[1]; const float keep = (lane & 2) ? acc[1] : acc[0]; acc[0] = keep + __shfl_xor(send, 2); }
    acc[0] += __shfl_xor(acc[0], 1);
    float val = acc[0] + br[lane >> 1];
    if (lane & 1) val = -INFINITY;
#pragma unroll
    for (int r = 0; r < 4; ++r) { float mx = val;
#pragma unroll
        for (int o = 1; o < 64; o <<= 1) mx = fmaxf(mx, __shfl_xor(mx, o));
        const unsigned long long bal = __ballot(val == mx); const int wl = __ffsll((long long)bal) - 1;
        tv[r] = mx; ti[r] = wl >> 1; if (lane == wl) val = -INFINITY; }
}
__device__ __forceinline__ void p6_route(Frame& F, const float* const* __restrict__ INP) {
    const float* X1 = F.out; const float* mod = (const float*)(F.ws + WS_MOD); bf16* H2 = (bf16*)(F.ws + WS_H2);
    int* TOPE = (int*)(F.ws + WS_TOPE); int* POS = (int*)(F.ws + WS_POS); float* TOPP = (float*)(F.ws + WS_TOPP); int* LIST = (int*)(F.ws + WS_LIST);
    LAS float* Wt = (LAS float*)(F.lds);
    LAS int* pe = (LAS int*)(F.lds + LDSCTL_OFF + 1024); LAS int* hist = pe + 512; LAS int* base = hist + 32; LAS int* rank = base + 32;
    const float* wr = INP[26]; const float* br = INP[27];
    const int lane = F.lane, w = F.wave;
    for (int idx = F.tid; idx < 32768; idx += NWAVES * 64) { const int e = idx >> 10, k = idx & 1023; Wt[((((k >> 8) * 4 + (k & 3)) * 32 + e) << 6) + ((k >> 2) & 63)] = wr[k * 32 + e]; }
    __syncthreads();
    for (int tg = blockIdx.x; tg < ML / 128; tg += F.G) {
        if (F.tid < 32) hist[F.tid] = 0;
        __syncthreads();
#pragma unroll 1
        for (int q = 0; q < 16; q += 2) {
            const int tl = w * 16 + q, m = tg * 128 + tl, b = m / SEQ;
            const float* sh = mod + b * 6144 + 3 * D; const float* scl = sh + D;
            float s0 = 0.f, s1 = 0.f;
#pragma unroll
            for (int j = 0; j < 4; ++j) { const f32x4 x0 = *(const f32x4*)(X1 + (size_t)m * D + 256 * j + 4 * lane), x1 = *(const f32x4*)(X1 + (size_t)(m + 1) * D + 256 * j + 4 * lane);
                s0 += (x0[0] * x0[0] + x0[1] * x0[1]) + (x0[2] * x0[2] + x0[3] * x0[3]); s1 += (x1[0] * x1[0] + x1[1] * x1[1]) + (x1[2] * x1[2] + x1[3] * x1[3]); }
            const float r0 = 1.0f / sqrtf(wave_sum(s0) * (1.0f / D) + EPS), r1 = 1.0f / sqrtf(wave_sum(s1) * (1.0f / D) + EPS);
            float a0[32], a1[32];
#pragma unroll
            for (int e = 0; e < 32; ++e) { a0[e] = 0.f; a1[e] = 0.f; }
#pragma unroll 1
            for (int j = 0; j < 4; ++j) { const int c = 256 * j + 4 * lane; const f32x4 g = *(const f32x4*)(INP[7] + c), a = *(const f32x4*)(scl + c), bb = *(const f32x4*)(sh + c);
                const f32x4 x0 = *(const f32x4*)(X1 + (size_t)m * D + c), x1 = *(const f32x4*)(X1 + (size_t)(m + 1) * D + c);
                const f32x4 gs = g * (a + 1.0f); const f32x4 y0 = x0 * r0 * gs + bb, y1 = x1 * r1 * gs + bb;
                *(v2u*)(H2 + (size_t)m * D + c) = (v2u){pk2(y0[0], y0[1]), pk2(y0[2], y0[3])}; *(v2u*)(H2 + (size_t)(m + 1) * D + c) = (v2u){pk2(y1[0], y1[1]), pk2(y1[2], y1[3])};
                const LAS float* wj = Wt + j * 8192 + lane;
#pragma unroll
                for (int qq = 0; qq < 4; ++qq) { const LAS float* wp = wj + qq * 2048; const float ya = y0[qq], yb = y1[qq];
#pragma unroll
                    for (int e = 0; e < 32; ++e) { const float wv = wp[e * 64]; a0[e] += ya * wv; a1[e] += yb * wv; }
                    asm volatile("" ::: "memory"); } }
            float tv[4]; int ti[4];
#pragma unroll
            for (int tk = 0; tk < 2; ++tk) {
                if (tk == 0) route_reduce_top4(a0, br, lane, tv, ti); else route_reduce_top4(a1, br, lane, tv, ti);
                const float e1 = __expf(tv[1] - tv[0]), e2 = __expf(tv[2] - tv[0]), e3 = __expf(tv[3] - tv[0]); const float inv = 1.0f / (1.0f + e1 + e2 + e3);
                if (lane < 4) { const float p = lane == 0 ? inv : (lane == 1 ? e1 * inv : (lane == 2 ? e2 * inv : e3 * inv)); const int ee = lane == 0 ? ti[0] : (lane == 1 ? ti[1] : (lane == 2 ? ti[2] : ti[3]));
                    TOPP[(m + tk) * 4 + lane] = p; TOPE[(m + tk) * 4 + lane] = ee; pe[(tl + tk) * 4 + lane] = ee; }
            }
        }
        __syncthreads();
        { const int e = pe[F.tid]; rank[F.tid] = __hip_atomic_fetch_add(&hist[e], 1, __ATOMIC_RELAXED, __HIP_MEMORY_SCOPE_WORKGROUP); }
        __syncthreads();
        if (F.tid < 32) base[F.tid] = (int)__hip_atomic_fetch_add(F.ctl + CW_CNT + 64 * F.tid, (unsigned)hist[F.tid], RLX_AGENT);
        __syncthreads();
        { const int e = pe[F.tid]; const int pos = base[e] + rank[F.tid]; const int m = tg * 128 + (F.tid >> 2); LIST[e * ML + pos] = m; POS[m * 4 + (F.tid & 3)] = pos; }
        __syncthreads();
    }
}

__device__ __forceinline__ void p10_combine(Frame& F, const float* const* __restrict__ INP) {
    moe_tables(F);
    const LAS int* tab = (const LAS int*)(F.lds + TAB_OFF);
    const float* X1 = F.out; float* OUT = F.out; const float* mod = (const float*)(F.ws + WS_MOD); const bf16* Y = (const bf16*)(F.ws + WS_Y);
    const int* TOPE = (const int*)(F.ws + WS_TOPE); const int* POS = (const int*)(F.ws + WS_POS); const float* TOPP = (const float*)(F.ws + WS_TOPP);
    const int gw = F.vcu * NWAVES + F.wave, NGW = F.G * NWAVES, lane = F.lane;
    for (int m = gw; m < ML; m += NGW) {
        const int b = m / SEQ; const float* gt2 = mod + b * 6144 + 5 * D;
        f32x4 mo[4];
#pragma unroll
        for (int j = 0; j < 4; ++j) mo[j] = (f32x4){0.f, 0.f, 0.f, 0.f};
#pragma unroll
        for (int k = 0; k < 4; ++k) { const int e = TOPE[m * 4 + k]; const float p = TOPP[m * 4 + k]; const size_t slot = (size_t)256 * tab[e] + POS[m * 4 + k];
#pragma unroll
            for (int j = 0; j < 4; ++j) { const v2u y = *(const v2u*)(Y + slot * 1024 + 256 * j + 4 * lane); mo[j] += (f32x4){bflo(y.x), bfhi(y.x), bflo(y.y), bfhi(y.y)} * p; } }
        f32x4 v[4]; float s = 0.f;
#pragma unroll
        for (int j = 0; j < 4; ++j) { const int c = 256 * j + 4 * lane; v[j] = *(const f32x4*)(X1 + (size_t)m * D + c) + *(const f32x4*)(gt2 + c) * mo[j]; s += (v[j][0] * v[j][0] + v[j][1] * v[j][1]) + (v[j][2] * v[j][2] + v[j][3] * v[j][3]); }
        const float rstd = 1.0f / sqrtf(wave_sum(s) * (1.0f / D) + EPS);
#pragma unroll
        for (int j = 0; j < 4; ++j) { const int c = 256 * j + 4 * lane; *(f32x4*)(OUT + (size_t)m * D + c) = v[j] * rstd * *(const f32x4*)(INP[32] + c); }
    }
}

struct Args { const float* in[33]; float* out; unsigned char* ws; int ph_lo, ph_hi, li, pad; };
__global__ void __launch_bounds__(NWAVES * 64, 2) fwd_kernel(Args args) {
    extern __shared__ __attribute__((aligned(16))) unsigned char lds[];
    Frame F;
    F.lds = (LAS unsigned char*)lds;
    F.tid = threadIdx.x; F.lane = F.tid & 63; F.wave = __builtin_amdgcn_readfirstlane(F.tid >> 6);
    F.G = gridDim.x; { const int bx = blockIdx.x; F.vcu = (F.G % 8 == 0) ? (bx % 8) * (F.G / 8) + bx / 8 : bx; }
    F.ws = args.ws; F.ctl = (gu32*)(args.ws + WS_CTL); F.out = args.out;
    for (int u = F.tid; u < (LDS_BYTES - LDSCTL_OFF) / 4; u += NWAVES * 64) ((LAS unsigned*)(F.lds + LDSCTL_OFF))[u] = 0u;
    __syncthreads();
    XcdBarrier bar; bar.bar = (unsigned*)(F.ctl + CW_BAR); bar.x = 0; bar.st = nullptr;
    if (N_LAUNCHES == 1) bar = xcd_barrier_post((unsigned*)(F.ctl + CW_BAR), (volatile LAS unsigned*)(F.lds + MISC_OFF) + 8);
    const int lo = args.ph_lo, hi = args.ph_hi;
    const float* const* __restrict__ INP = args.in;
#ifndef PH_MASK
#define PH_MASK 0x3fff
#endif
#define IN(k) ((((PH_MASK) >> (k)) & 1) && lo <= (k) && (k) < hi)
#define SEAM(k) do { if (IN(k) && IN((k) + 1)) xcd_barrier(bar); } while (0)
    const bf16* WIN = (const bf16*)(F.ws + WS_WIN);

    if (IN(0)) { p0_prologue(F, INP); } SEAM(0);
    if (IN(1)) { p1_norm1(F, INP); } SEAM(1);
    if (IN(2)) {
        pg8::Gemm g{(const bf16*)(F.ws + WS_H1), WIN, 1024, nullptr}; InProjOrder S{F.G, (int)blockIdx.x};
        EpiStore E{(bf16*)(F.ws + WS_PROJ), LDP};
        pg8::gemm_phase<EpiStore, InProjOrder, false>(F.lds, g, S, E);
    } SEAM(2);
    if (IN(3)) { p3_conv(F, INP); } SEAM(3);
    if (IN(4)) { for (int u = blockIdx.x; u < 256; u += F.G) { p4_mlstm<0>(F, INP, u); if (P4_REP_M > 1) p4_mlstm<P4_MODE>(F, INP, u); for (int r_ = 0; r_ < P4_REP_S; ++r_) p4_s5(F, INP, u); } } SEAM(4);
    if (IN(5)) { p5a_prep(F, INP); } SEAM(5);
    if (IN(6)) {
        pg8::Gemm g{(const bf16*)(F.ws + WS_A2), (const bf16*)(F.ws + WS_WGLU), 512, nullptr}; pg8::StaticOrder S; S.init(ML, 512, F.G, (int)blockIdx.x);
        EpiGlu E{(const bf16*)(F.ws + WS_A2), (bf16*)(F.ws + WS_A3), INP[22]};
        pg8::gemm_phase<EpiGlu, pg8::StaticOrder, false>(F.lds, g, S, E);
    }
    if (IN(7)) {
        pg8::Gemm g{(const bf16*)(F.ws + WS_A1), (const bf16*)(F.ws + WS_WA), 1024, nullptr}; pg8::StaticOrder S; S.init(ML, 1024, F.G, (int)blockIdx.x);
        EpiGate<false> E{(const bf16*)(F.ws + WS_PROJ), PC_G, INP[24], nullptr, (bf16*)(F.ws + WS_YA)};
        pg8::gemm_phase<EpiGate<false>, pg8::StaticOrder, false>(F.lds, g, S, E);
    } SEAM(7);
    if (IN(8)) {
        pg8::Gemm g{(const bf16*)(F.ws + WS_A3), (const bf16*)(F.ws + WS_WB), 512, nullptr}; pg8::StaticOrder S; S.init(ML, 1024, F.G, (int)blockIdx.x);
        EpiGate<true> E{(const bf16*)(F.ws + WS_PROJ), PC_G + 1024, INP[24] + 1024, (const bf16*)(F.ws + WS_YA), (bf16*)(F.ws + WS_MERGED)};
        pg8::gemm_phase<EpiGate<true>, pg8::StaticOrder, false>(F.lds, g, S, E);
    } SEAM(8);
    if (IN(9)) {
        pg8::Gemm g{(const bf16*)(F.ws + WS_MERGED), (const bf16*)(F.ws + WS_WO), 1024, nullptr}; pg8::StaticOrder S; S.init(ML, 1024, F.G, (int)blockIdx.x);
        EpiX1 E{INP[0], (const float*)(F.ws + WS_MOD), F.out};
        pg8::gemm_phase<EpiX1, pg8::StaticOrder, false>(F.lds, g, S, E);
    } SEAM(9);
    if (IN(10)) { p6_route(F, INP); } SEAM(10);
    if (IN(11)) {
        moe_tables(F);
        pg8::Gemm g{(const bf16*)(F.ws + WS_H2), (const bf16*)(F.ws + WS_WEIN), 1024, (const int*)(F.ws + WS_LIST)}; MoeOrder S{F.G, (int)blockIdx.x, 8, (const LAS int*)(F.lds + TAB_OFF)};
        EpiSwiglu E{INP[29], (bf16*)(F.ws + WS_ACT)};
        pg8::gemm_phase<EpiSwiglu, MoeOrder, true>(F.lds, g, S, E);
    } SEAM(11);
    if (IN(12)) {
        moe_tables(F);
        pg8::Gemm g{(const bf16*)(F.ws + WS_ACT), (const bf16*)(F.ws + WS_WEOUT), 1024, nullptr}; MoeOrder S{F.G, (int)blockIdx.x, 4, (const LAS int*)(F.lds + TAB_OFF)};
        EpiY E{INP[31], (bf16*)(F.ws + WS_Y)};
        pg8::gemm_phase<EpiY, MoeOrder, false>(F.lds, g, S, E);
    } SEAM(12);
    if (IN(13)) { p10_combine(F, INP); }
#undef IN
#undef SEAM
}

extern "C" void kernel_launch(void* const* d_in, const int* in_sizes, int n_in, void* d_out, int out_size, void* d_ws, size_t ws_size, hipStream_t stream) {
    static int grid = 0;
    if (grid == 0) {
        if (n_in != 33 || out_size != ML * D || ws_size < WS_END2) { fprintf(stderr, "kernel_launch: unexpected shapes (n_in %d, out %d, ws %zu)\n", n_in, out_size, ws_size); grid = -1; return; }
        int dev = 0, cus = 0, per_cu = 0;
        if (hipGetDevice(&dev) != hipSuccess || hipDeviceGetAttribute(&cus, hipDeviceAttributeMultiprocessorCount, dev) != hipSuccess) { grid = -1; return; }
        if (hipFuncSetAttribute((const void*)fwd_kernel, hipFuncAttributeMaxDynamicSharedMemorySize, LDS_BYTES) != hipSuccess) { fprintf(stderr, "kernel_launch: hipFuncSetAttribute failed\n"); grid = -1; return; }
        if (hipOccupancyMaxActiveBlocksPerMultiprocessor(&per_cu, (const void*)fwd_kernel, NWAVES * 64, LDS_BYTES) != hipSuccess || per_cu < 1) fprintf(stderr, "kernel_launch: occupancy query reports %d\n", per_cu);
        (void)hipGetLastError();
        grid = cus;
    }
    if (grid < 0) return;
    if (hipMemsetAsync((char*)d_ws + WS_CTL, 0, CTL_ZERO_BYTES, stream) != hipSuccess) return;
    Args a{};
    for (int i = 0; i < 33; ++i) a.in[i] = (const float*)d_in[i];
    a.out = (float*)d_out; a.ws = (unsigned char*)d_ws;
    for (int li = 0; li < N_LAUNCHES; ++li) {
        a.ph_lo = (N_LAUNCHES == 1) ? 0 : li; a.ph_hi = (N_LAUNCHES == 1) ? NPH : li + 1; a.li = li;
        const int nrep = (N_LAUNCHES != 1 && (((PROBE_DUP_MASK) >> li) & 1)) ? 2 : 1;
        for (int r = 0; r < nrep; ++r) hipLaunchKernelGGL(fwd_kernel, dim3(grid), dim3(NWAVES * 64), LDS_BYTES, stream, a);
    }
}
```

```cpp
#include <hip/hip_runtime.h>
#include <cstdio>
#include <cstdint>

#ifndef MK_N_LAUNCHES
#define MK_N_LAUNCHES 1
#endif
#ifndef PROBE_DUP_MASK
#define PROBE_DUP_MASK 0
#endif
#ifndef P4_REP_M
#define P4_REP_M 1
#endif
#ifndef P4_MODE
#define P4_MODE 0
#endif
#ifndef P4_REP_S
#define P4_REP_S 1
#endif

namespace pg8 {
#define PG8_LAS __attribute__((address_space(3)))
typedef unsigned short bf16_t;
typedef short bf16x8 __attribute__((ext_vector_type(8)));
typedef float f32x4 __attribute__((ext_vector_type(4)));
typedef unsigned u32x4 __attribute__((ext_vector_type(4)));
constexpr int BM = 256, BK = 64, HALF = 128, HTB = HALF * BK * 2, STAGE_BYTES = 8 * HTB, NXCD = 8, WGM = 8;

__host__ __device__ __forceinline__ int lds_byte(int r, int c) { const int st = (r >> 4) * 2 + (c >> 5), rr = r & 15, cc = c & 31, ob = rr * 64 + cc * 2; return st * 1024 + (ob ^ (((ob >> 9) & 1) << 5)); }
__host__ __device__ __forceinline__ void stage_rc(int b, int& R, int& C) { const int st = b / 1024, sb = b % 1024, swz = sb ^ (((sb >> 9) & 1) << 5); R = (st >> 1) * 16 + swz / 64; C = (st & 1) * 32 + (swz % 64) / 2; }
__host__ __device__ __forceinline__ int perm32(int rho) { const int n = rho >> 4, i = rho & 15; return 8 * (i >> 2) + 4 * n + (i & 3); }

struct Unit { int pm, pn, lbase, nvalid; };
struct Gemm { const bf16_t* A; const bf16_t* Bt; int K; const PG8_LAS unsigned short* ridx; int sa, sb; };

__device__ __forceinline__ int xcd_remap(int L, int nwg) { const int q = nwg / NXCD, r = nwg % NXCD, xcd = L % NXCD, off = L / NXCD; return (xcd < r ? xcd * (q + 1) : r * (q + 1) + (xcd - r) * q) + off; }

struct StaticOrder {
    int nM, nN, nwg, G, c;
    __device__ void init(int M, int N, int G_, int c_) { nM = M / BM; nN = N / BM; nwg = nM * nN; G = G_; c = c_; }
    __device__ __forceinline__ bool next(int i, Unit& u) const {
        const long L = (long)i * G + c; if (L >= nwg) return false;
        const int wgid = xcd_remap((int)L, nwg);
        const int nig = WGM * nN, gid = wgid / nig, fm = gid * WGM, gsz = (nM - fm) < WGM ? (nM - fm) : WGM;
        u.pm = fm + ((wgid % nig) % gsz); u.pn = (wgid % nig) / gsz; u.lbase = 0; u.nvalid = 0; return true;
    }
};

__device__ __forceinline__ unsigned cvt_pk_bf16(float lo, float hi) { unsigned r; asm volatile("v_cvt_pk_bf16_f32 %0, %1, %2" : "=v"(r) : "v"(lo), "v"(hi)); return r; }

typedef int v8i __attribute__((ext_vector_type(8)));
typedef short s16x16 __attribute__((ext_vector_type(16)));
template <class Epi, class Sched, bool GATHER, bool FP8 = false>
__device__ __forceinline__ void gemm_phase(PG8_LAS unsigned char* lds, const Gemm g, const Sched& S, const Epi& E) {
    const int tid = threadIdx.x, wid = __builtin_amdgcn_readfirstlane(tid >> 6), lane = tid & 63, wr = wid >> 2, wc = wid & 3, fr = lane & 15, fq = lane >> 4;
    const int K = g.K, nt = K / BK;
    int Rr[2]; unsigned cby[2], voffB[2];
#pragma unroll
    for (int i = 0; i < 2; ++i) { int R, C; stage_rc(tid * 16 + i * 8192, R, C); const int Rb = Epi::PERM ? ((R & ~31) + perm32(R & 31)) : R;
        Rr[i] = R; cby[i] = (unsigned)C * 2u; voffB[i] = (unsigned)(Rb * K + C) * 2u; }
    const size_t kstep = (size_t)(BK * 2);
    const size_t hstep = (size_t)HALF * K * 2;
    const size_t tstep = 2 * hstep;
    const unsigned ldsw = (unsigned)wid * 1024u;
    const int aoff = lds_byte(wr * 64 + fr, FP8 ? fq * 16 : fq * 8), boff = lds_byte(wc * 32 + fr, FP8 ? fq * 16 : fq * 8);

#define PG8_SA(b, h) (((b) * 2 + (h)) * HTB)
#define PG8_SB(b, h) ((4 + (b) * 2 + (h)) * HTB)
#define PG8_STAGE(bufoff, gbase, voff) do { _Pragma("unroll") for (int _i = 0; _i < 2; ++_i) \
        __builtin_amdgcn_global_load_lds((const unsigned*)((const char*)(gbase) + (voff)[_i]), (PG8_LAS unsigned*)(lds + (bufoff) + ldsw + _i * 8192), 16, 0, 0); } while (0)
#define PG8_LDA(dst, b, h) do { if constexpr (FP8) { _Pragma("unroll") for (int m = 0; m < 4; ++m) { const bf16x8 _lo = *(const PG8_LAS bf16x8*)(lds + PG8_SA(b, h) + aoff + m * 2048), _hi = *(const PG8_LAS bf16x8*)(lds + PG8_SA(b, h) + aoff + m * 2048 + 16); dst##8[m] = __builtin_bit_cast(v8i, __builtin_shufflevector(_lo, _hi, 0, 1, 2, 3, 4, 5, 6, 7, 8, 9, 10, 11, 12, 13, 14, 15)); } } \
        else { _Pragma("unroll") for (int m = 0; m < 4; ++m) _Pragma("unroll") for (int k = 0; k < 2; ++k) dst[m][k] = *(const PG8_LAS bf16x8*)(lds + PG8_SA(b, h) + aoff + m * 2048 + k * 1024); } } while (0)
#define PG8_LDB(dst, b, h) do { if constexpr (FP8) { _Pragma("unroll") for (int n = 0; n < 2; ++n) { const bf16x8 _lo = *(const PG8_LAS bf16x8*)(lds + PG8_SB(b, h) + boff + n * 2048), _hi = *(const PG8_LAS bf16x8*)(lds + PG8_SB(b, h) + boff + n * 2048 + 16); dst##8[n] = __builtin_bit_cast(v8i, __builtin_shufflevector(_lo, _hi, 0, 1, 2, 3, 4, 5, 6, 7, 8, 9, 10, 11, 12, 13, 14, 15)); } } \
        else { _Pragma("unroll") for (int n = 0; n < 2; ++n) _Pragma("unroll") for (int k = 0; k < 2; ++k) dst[n][k] = *(const PG8_LAS bf16x8*)(lds + PG8_SB(b, h) + boff + n * 2048 + k * 1024); } } while (0)
#define PG8_MMA(ai, bj, At, Bt) do { __builtin_amdgcn_s_setprio(1); _Pragma("unroll") for (int m = 0; m < 4; ++m) _Pragma("unroll") for (int n = 0; n < 2; ++n) { \
        if constexpr (FP8) asm volatile("v_mfma_scale_f32_16x16x128_f8f6f4 %0, %1, %2, %0, %3, %4 op_sel_hi:[0,0,0]" : "+v"(acc[ai][bj][m][n]) : "v"(Bt##8[n]), "v"(At##8[m]), "v"(vsb), "v"(vsa));   \
        else { _Pragma("unroll") for (int k = 0; k < 2; ++k) acc[ai][bj][m][n] = __builtin_amdgcn_mfma_f32_16x16x32_bf16(Bt[n][k], At[m][k], acc[ai][bj][m][n], 0, 0, 0); } } \
        __builtin_amdgcn_s_setprio(0); } while (0)
#define PG8_WAIT_V(n) asm volatile("s_waitcnt vmcnt(" #n ")" ::: "memory")
#define PG8_WAIT_L(n) asm volatile("s_waitcnt lgkmcnt(" #n ")" ::: "memory")
#define PG8_BAR __builtin_amdgcn_s_barrier()
#define PG8_SCHED __builtin_amdgcn_sched_barrier(0)
#define PG8_AOFF(dst, u, uord) do { _Pragma("unroll") for (int _h = 0; _h < 2; ++_h) _Pragma("unroll") for (int _i = 0; _i < 2; ++_i) { const int _r = _h * HALF + Rr[_i]; \
        if constexpr (GATHER) { const int _idx = g.ridx[(uord) * 256 + _r]; dst[_h][_i] = (unsigned)_idx * (unsigned)(K * 2) + cby[_i]; } \
        else { dst[_h][_i] = (unsigned)(_r * K * 2) + cby[_i]; } } } while (0)
    Unit cur, nxt; int ui = 0;
    if (!S.next(0, cur)) return;
    f32x4 acc[2][2][4][2];
#pragma unroll
    for (int a = 0; a < 2; ++a)
#pragma unroll
        for (int b = 0; b < 2; ++b)
#pragma unroll
            for (int m = 0; m < 4; ++m)
#pragma unroll
                for (int n = 0; n < 2; ++n) acc[a][b][m][n] = (f32x4){0.f, 0.f, 0.f, 0.f};
    const int vsa = g.sa, vsb = g.sb;
    bf16x8 At[4][2], B0[2][2], B1[2][2];
    v8i At8[4], B08[2], B18[2];
    unsigned vc[2][2], vn[2][2];
    PG8_AOFF(vc, cur, 0);
    const char* cA = GATHER ? (const char*)g.A : (const char*)g.A + (size_t)cur.pm * tstep; const char* cB = (const char*)g.Bt + (size_t)cur.pn * tstep;
    PG8_STAGE(PG8_SB(0, 0), cB, voffB); PG8_STAGE(PG8_SB(0, 1), cB + hstep, voffB); PG8_STAGE(PG8_SA(0, 0), cA, vc[0]); PG8_STAGE(PG8_SA(0, 1), cA, vc[1]);
    if (wr == 1) PG8_BAR;
    PG8_WAIT_V(2); PG8_BAR;
    PG8_STAGE(PG8_SB(1, 0), cB + kstep, voffB); PG8_STAGE(PG8_SA(1, 0), cA + kstep, vc[0]); PG8_STAGE(PG8_SB(1, 1), cB + hstep + kstep, voffB);
    PG8_WAIT_V(6); PG8_BAR;
    for (;;) {
        const bool has_next = S.next(ui + 1, nxt);
        const char* nA = (has_next && !GATHER) ? (const char*)g.A + (size_t)nxt.pm * tstep : cA; const char* nB = has_next ? (const char*)g.Bt + (size_t)nxt.pn * tstep : cB;
        if constexpr (GATHER) { if (has_next) { PG8_AOFF(vn, nxt, ui + 1); } else {
#pragma unroll
            for (int h = 0; h < 2; ++h) { vn[h][0] = vc[h][0]; vn[h][1] = vc[h][1]; } } }
#pragma unroll 1
        for (int t = 0; t < nt; t += 2) {
            const bool last = (t == nt - 2);
            const char* a1 = cA + (size_t)(t + 1) * kstep;
            const char* a2 = last ? nA : cA + (size_t)(t + 2) * kstep; const char* b2 = last ? nB : cB + (size_t)(t + 2) * kstep;
            const char* a3 = a2 + kstep; const char* b3 = b2 + kstep;
            unsigned v2[2][2];
#pragma unroll
            for (int h = 0; h < 2; ++h)
#pragma unroll
                for (int i = 0; i < 2; ++i) v2[h][i] = GATHER ? (last ? vn[h][i] : vc[h][i]) : vc[h][i];
            PG8_LDB(B0, 0, 0); PG8_LDB(B1, 0, 1); PG8_SCHED; PG8_LDA(At, 0, 0); PG8_STAGE(PG8_SA(1, 1), a1, vc[1]);
            PG8_WAIT_V(8); PG8_WAIT_L(0); PG8_BAR; PG8_MMA(0, 0, At, B0); PG8_MMA(0, 1, At, B1); PG8_BAR; PG8_SCHED;
            PG8_LDA(At, 0, 1); PG8_STAGE(PG8_SB(0, 0), b2, voffB); PG8_STAGE(PG8_SB(0, 1), b2 + hstep, voffB); PG8_STAGE(PG8_SA(0, 0), a2, v2[0]);
            PG8_WAIT_V(8); PG8_WAIT_L(0); PG8_BAR; PG8_MMA(1, 0, At, B0); PG8_MMA(1, 1, At, B1); PG8_BAR; PG8_SCHED;
            PG8_LDB(B0, 1, 0); PG8_LDB(B1, 1, 1); PG8_SCHED; PG8_LDA(At, 1, 0); PG8_STAGE(PG8_SA(0, 1), a2, v2[1]);
            PG8_WAIT_V(8); PG8_WAIT_L(0); PG8_BAR; PG8_MMA(0, 0, At, B0); PG8_MMA(0, 1, At, B1); PG8_BAR; PG8_SCHED;
            PG8_LDA(At, 1, 1); PG8_STAGE(PG8_SB(1, 0), b3, voffB); PG8_STAGE(PG8_SB(1, 1), b3 + hstep, voffB); PG8_STAGE(PG8_SA(1, 0), a3, v2[0]);
            PG8_WAIT_V(8); PG8_WAIT_L(0); PG8_BAR; PG8_MMA(1, 0, At, B0); PG8_MMA(1, 1, At, B1); PG8_BAR; PG8_SCHED;
        }
        if (wr == 0) PG8_BAR;
        if constexpr (FP8) asm volatile("s_nop 15\n\ts_nop 15" ::: "memory");
        E(acc, cur, wr, wc, fr, fq);
        if (!has_next) break;
#pragma unroll
        for (int a = 0; a < 2; ++a)
#pragma unroll
            for (int b = 0; b < 2; ++b)
#pragma unroll
                for (int m = 0; m < 4; ++m)
#pragma unroll
                    for (int n = 0; n < 2; ++n) acc[a][b][m][n] = (f32x4){0.f, 0.f, 0.f, 0.f};
        cur = nxt; cA = nA; cB = nB; ++ui;
        if constexpr (GATHER) {
#pragma unroll
            for (int h = 0; h < 2; ++h) { vc[h][0] = vn[h][0]; vc[h][1] = vn[h][1]; } }
        if (wr == 1) PG8_BAR;
    }
    PG8_WAIT_V(0);
    PG8_BAR;
#undef PG8_SA
#undef PG8_SB
#undef PG8_STAGE
#undef PG8_LDA
#undef PG8_LDB
#undef PG8_MMA
#undef PG8_WAIT_V
#undef PG8_WAIT_L
#undef PG8_BAR
#undef PG8_SCHED
#undef PG8_AOFF
}
}

constexpr int NWAVES = 8;
constexpr int D = 1024, NB = 8, SEQ = 4096, CTXL = 256;
constexpr int ML = NB * SEQ, MC = NB * CTXL, MT = ML + MC;
constexpr int LDP = 5888;
constexpr int PC_QK = 0, PC_V = 1024, PC_U = 2048, PC_O = 2560, PC_G = 3584, PC_IF = 5632;
constexpr int NEXP = 32, TOPK = 4;
constexpr int MAXTILES = (ML * TOPK + NEXP * 256) / 256;
constexpr float EPS = 1e-6f;
constexpr int NPH = 14;
constexpr int N_LAUNCHES = MK_N_LAUNCHES;

constexpr size_t MiB = 1u << 20;
constexpr size_t WS_CTL = 0, CTL_ZERO_BYTES = 1 * MiB;
constexpr size_t WS_MOD = 1 * MiB;
constexpr size_t WS_TOPE = 2 * MiB, WS_POS = 2 * MiB + 512 * 1024, WS_TOPP = 3 * MiB, WS_LIST = 4 * MiB;
constexpr size_t WS_WIN = 8 * MiB, WS_WGLU = 20 * MiB, WS_WA = 21 * MiB, WS_WB = 23 * MiB, WS_WO = 24 * MiB, WS_WEIN = 26 * MiB, WS_WEOUT = 154 * MiB;
constexpr size_t WS_R0 = 218 * MiB;
constexpr size_t WS_PROJ = WS_R0, WS_H1 = 609 * MiB, WS_QKC = 677 * MiB, WS_HDIR = 745 * MiB, WS_YDIR = 873 * MiB, WS_END = 937 * MiB;
constexpr size_t WS_A1 = WS_H1, WS_A2 = WS_QKC, WS_A3 = WS_QKC + 32 * MiB, WS_YA = WS_HDIR, WS_MERGED = WS_HDIR + 64 * MiB;
constexpr size_t WS_GS = 940 * MiB, WS_END2 = 948 * MiB;
constexpr size_t WS_H2 = WS_R0, WS_ACT = 282 * MiB, WS_Y = 554 * MiB;
static_assert(WS_PROJ + (size_t)MT * LDP * 2 <= WS_H1 && WS_Y + (size_t)MAXTILES * 256 * 1024 * 2 <= WS_END, "ws map");
constexpr int CW_BAR = 4096, CW_CNT = 16384;

constexpr int RING_BYTES = 131072;
constexpr int LDSCTL_OFF = RING_BYTES, MISC_OFF = LDSCTL_OFF + 320, TAB_OFF = LDSCTL_OFF + 512;
constexpr int LDS_BYTES = 147456;

#define GAS __attribute__((address_space(1)))
#define LAS __attribute__((address_space(3)))
typedef unsigned short bf16;
typedef unsigned v4u __attribute__((ext_vector_type(4)));
typedef unsigned v2u __attribute__((ext_vector_type(2)));
typedef float f32x4 __attribute__((ext_vector_type(4)));
typedef float f32x16 __attribute__((ext_vector_type(16)));
typedef short bf16x8 __attribute__((ext_vector_type(8)));
typedef GAS unsigned gu32;
#define RLX_AGENT __ATOMIC_RELAXED, __HIP_MEMORY_SCOPE_AGENT
#define LDS_WAIT() asm volatile("s_waitcnt lgkmcnt(0)" ::: "memory")
#define LBAR() do { asm volatile("s_waitcnt lgkmcnt(0)" ::: "memory"); __builtin_amdgcn_s_barrier(); asm volatile("" ::: "memory"); } while (0)
__device__ __forceinline__ unsigned f2bf(float f) { unsigned u = __builtin_bit_cast(unsigned, f); return (u + 0x7fffu + ((u >> 16) & 1u)) >> 16; }
typedef __bf16 bf16x2_t __attribute__((ext_vector_type(2)));
__device__ __forceinline__ unsigned cvtpk(float lo, float hi) { const bf16x2_t v = {(__bf16)lo, (__bf16)hi}; return __builtin_bit_cast(unsigned, v); }
__device__ __forceinline__ unsigned pk2(float lo, float hi) { return cvtpk(lo, hi); }
__device__ __forceinline__ float clamp448(float x) { return fminf(fmaxf(x, -448.0f), 448.0f); }
__device__ __forceinline__ unsigned pk4_fp8(float a, float b, float c, float d) {
    unsigned w = 0; w = __builtin_amdgcn_cvt_pk_fp8_f32(clamp448(a), clamp448(b), w, false); w = __builtin_amdgcn_cvt_pk_fp8_f32(clamp448(c), clamp448(d), w, true); return w; }
__device__ __forceinline__ float bf2f(unsigned b) { return __builtin_bit_cast(float, b << 16); }
__device__ __forceinline__ float bflo(unsigned w) { return __builtin_bit_cast(float, w << 16); }
__device__ __forceinline__ float bfhi(unsigned w) { return __builtin_bit_cast(float, w & 0xffff0000u); }
__device__ __forceinline__ float sigmoidf_(float x) { return 1.0f / (1.0f + __expf(-x)); }

#define XB_TMO      128
#define XB_XCNT(j)  (256  + 64 * (j))
#define XB_XSUB(j)  (1280 + 64 * (j))
#define XB_XGEN(j)  (2304 + 64 * (j))
#define XB_TOP      3328
#define XB_TOPGEN   3392
#define XCD_BAR_WORDS 3456
#define XB_SPIN_CAP (1u << 22)
__device__ __forceinline__ unsigned xb_ld(unsigned* p)              { return __hip_atomic_load(p, __ATOMIC_RELAXED, __HIP_MEMORY_SCOPE_AGENT); }
__device__ __forceinline__ unsigned xb_add(unsigned* p, unsigned v) { return __hip_atomic_fetch_add(p, v, __ATOMIC_RELAXED, __HIP_MEMORY_SCOPE_AGENT); }
__device__ __forceinline__ unsigned xb_xcc_id() { return (unsigned)__builtin_amdgcn_s_getreg((3 << 11) | 20) & 0xFu; }
#define XB_SPIN(cond, bar) do { unsigned _sp = 0; while (cond) { __builtin_amdgcn_s_sleep(1); \
    if ((++_sp & 255u) == 0u) { if (xb_ld(&(bar)[XB_TMO])) break; if (_sp > XB_SPIN_CAP) { atomicAdd(&(bar)[XB_TMO], 1u); break; } } } } while (0)
struct XcdBarrier { unsigned* bar; unsigned x; volatile LAS unsigned* st; };
__device__ __forceinline__ XcdBarrier xcd_barrier_post(unsigned* bar, volatile LAS unsigned* st) {
    XcdBarrier b; b.bar = bar; b.x = xb_xcc_id(); b.st = st;
    if (threadIdx.x == 0) (void)xb_add(&bar[XB_XCNT(b.x)], 1u);
    return b;
}
__device__ __forceinline__ void xcd_barrier_complete(unsigned* bar, unsigned x, unsigned& nloc, unsigned& nx) {
    const unsigned G = gridDim.x * gridDim.y * gridDim.z;
    unsigned sum, cnt, mine, sp = 0u;
    for (;;) {
        sum = 0u; cnt = 0u; mine = 0u;
#pragma unroll
        for (unsigned j = 0; j < 16; ++j) { const unsigned c = xb_ld(&bar[XB_XCNT(j)]); sum += c; cnt += (c > 0u) ? 1u : 0u; mine = (j == x) ? c : mine; }
        if (sum == G) break;
        __builtin_amdgcn_s_sleep(1);
        if ((++sp & 255u) == 0u) { if (xb_ld(&bar[XB_TMO])) break; if (sp > XB_SPIN_CAP) { atomicAdd(&bar[XB_TMO], 1u); break; } }
    }
    nloc = mine > 0u ? mine : 1u; nx = cnt > 0u ? cnt : 1u;
}
__device__ __forceinline__ void xcd_barrier(const XcdBarrier& b) {
    asm volatile("s_waitcnt vmcnt(0)" ::: "memory");
    __syncthreads();
    if (threadIdx.x == 0) {
        unsigned* bar = b.bar;
        __builtin_amdgcn_s_waitcnt(0);
        unsigned nloc = b.st[0], nx = b.st[1];
        if (nloc == 0u) { xcd_barrier_complete(bar, b.x, nloc, nx); b.st[0] = nloc; b.st[1] = nx; }
        const unsigned old = xb_add(&bar[XB_XSUB(b.x)], 1u);
        const unsigned gen = old / nloc;
        if (old + 1u == (gen + 1u) * nloc) {
            __builtin_amdgcn_fence(__ATOMIC_RELEASE, "agent");
            asm volatile("s_waitcnt vmcnt(0)" ::: "memory");
            const unsigned og = xb_add(&bar[XB_TOP], 1u);
            const unsigned tg = og / nx;
            if (og + 1u == (tg + 1u) * nx) xb_add(&bar[XB_TOPGEN], 1u);
            else XB_SPIN(xb_ld(&bar[XB_TOPGEN]) == tg, bar);
            __builtin_amdgcn_fence(__ATOMIC_ACQUIRE, "agent");
            xb_add(&bar[XB_XGEN(b.x)], 1u);
            asm volatile("s_waitcnt vmcnt(0)" ::: "memory");
        } else {
            XB_SPIN(xb_ld(&bar[XB_XGEN(b.x)]) == gen, bar);
            __builtin_amdgcn_fence(__ATOMIC_ACQUIRE, "agent");
            asm volatile("s_waitcnt vmcnt(0)" ::: "memory");
        }
    }
    __syncthreads();
}

struct Frame {
    LAS unsigned char* lds;
    gu32* ctl;
    int tid, lane, wave, vcu, G;
    float* out; unsigned char* ws;
};
__device__ __forceinline__ float wave_sum(float v) {
#pragma unroll
    for (int o = 1; o < 64; o <<= 1) v += __shfl_xor(v, o);
    return v;
}

struct InProjOrder {
    int G, c;
    __device__ __forceinline__ bool next(int i, pg8::Unit& u) const {
        const int NL = 128 * 23, NC = 8 * 11;
        const long L = (long)i * G + c; if (L >= NL + NC) return false;
        u.lbase = 0; u.nvalid = 0;
        if (L < NL) { const int wgid = pg8::xcd_remap((int)L, NL); const int nig = 8 * 23, gid = wgid / nig, fm = gid * 8; u.pm = fm + ((wgid % nig) % 8); u.pn = (wgid % nig) / 8; }
        else { const int r = (int)L - NL; u.pm = 128 + r / 11; const int q = r % 11; u.pn = q < 10 ? q : 22; }
        return true;
    }
};
struct MoeOrder {
    int G, c, npn; const LAS int* tab;
    __device__ __forceinline__ bool next(int i, pg8::Unit& u) const {
        const int nT = __builtin_amdgcn_readfirstlane(tab[32]); const int nU = nT * npn;
        const long L = (long)i * G + c; if (L >= nU) return false;
        const int wgid = pg8::xcd_remap((int)L, nU);
        const int tau = wgid / npn, pl = wgid % npn;
        int e = 0;
        for (int k = 1; k < 32; ++k) e += (__builtin_amdgcn_readfirstlane(tab[k]) <= tau) ? 1 : 0;
        const int il = tau - __builtin_amdgcn_readfirstlane(tab[e]);
        u.pm = tau; u.pn = e * npn + pl; u.lbase = e * ML + 256 * il; u.nvalid = __builtin_amdgcn_readfirstlane(tab[33 + e]) - 256 * il;
        return true;
    }
};
__device__ __forceinline__ void moe_tables(Frame& F) {
    LAS int* tab = (LAS int*)(F.lds + TAB_OFF);
    __syncthreads();
    if (F.tid < 32) tab[33 + F.tid] = (int)__hip_atomic_load(F.ctl + CW_CNT + 64 * F.tid, RLX_AGENT);
    __syncthreads();
    if (F.tid == 0) {
        int acc = 0;
        for (int e = 0; e < 32; ++e) { tab[e] = acc; acc += (tab[33 + e] + 255) >> 8; }
        tab[32] = acc;
    }
    __syncthreads();
}

using pg8::f32x4; using pg8::u32x4; using pg8::cvt_pk_bf16;
#define EPI_ROWS(u) const int row0 = (u).pm * 256 + wr * 64 + fr
#define EPI_LOOP _Pragma("unroll") for (int ai = 0; ai < 2; ++ai) _Pragma("unroll") for (int m = 0; m < 4; ++m)
__device__ __forceinline__ u32x4 pack8(const f32x4 a, const f32x4 b) { u32x4 w; w.x = cvt_pk_bf16(a[0], a[1]); w.y = cvt_pk_bf16(a[2], a[3]); w.z = cvt_pk_bf16(b[0], b[1]); w.w = cvt_pk_bf16(b[2], b[3]); return w; }
__device__ __forceinline__ void unpack8(const u32x4 w, f32x4& a, f32x4& b) { a = (f32x4){bflo(w.x), bfhi(w.x), bflo(w.y), bfhi(w.y)}; b = (f32x4){bflo(w.z), bfhi(w.z), bflo(w.w), bfhi(w.w)}; }
__device__ __forceinline__ f32x4 sig4(f32x4 x) { return (f32x4){sigmoidf_(x[0]), sigmoidf_(x[1]), sigmoidf_(x[2]), sigmoidf_(x[3])}; }

struct EpiStore {
    static constexpr bool PERM = true; bf16* O; int ldc;
    __device__ __forceinline__ void operator()(const f32x4 (&acc)[2][2][4][2], const pg8::Unit& u, int wr, int wc, int fr, int fq) const {
        EPI_ROWS(u); const int col0 = u.pn * 256 + wc * 32 + 8 * fq;
        EPI_LOOP { bf16* rowp = O + (size_t)(row0 + ai * 128 + m * 16) * ldc + col0;
#pragma unroll
            for (int bj = 0; bj < 2; ++bj) *(u32x4*)(rowp + bj * 128) = pack8(acc[ai][bj][m][0], acc[ai][bj][m][1]); }
    }
};
struct EpiGlu {
    static constexpr bool PERM = true; const bf16* A2; bf16* A3; const float* bias;
    __device__ __forceinline__ void operator()(const f32x4 (&acc)[2][2][4][2], const pg8::Unit& u, int wr, int wc, int fr, int fq) const {
        EPI_ROWS(u); const int col0 = u.pn * 256 + wc * 32 + 8 * fq;
        f32x4 bv[2][2];
#pragma unroll
        for (int bj = 0; bj < 2; ++bj)
#pragma unroll
            for (int n = 0; n < 2; ++n) bv[bj][n] = *(const f32x4*)(bias + col0 + bj * 128 + 4 * n);
        EPI_LOOP { const size_t off = (size_t)(row0 + ai * 128 + m * 16) * 512 + col0;
#pragma unroll
            for (int bj = 0; bj < 2; ++bj) { f32x4 a0, a1; unpack8(*(const u32x4*)(A2 + off + bj * 128), a0, a1);
                const f32x4 v0 = a0 * sig4(acc[ai][bj][m][0] + bv[bj][0]), v1 = a1 * sig4(acc[ai][bj][m][1] + bv[bj][1]);
                *(u32x4*)(A3 + off + bj * 128) = pack8(v0, v1); } }
    }
};
template <bool ADD> struct EpiGate {
    static constexpr bool PERM = true; const bf16* proj; int gc0; const float* bg; const bf16* Prev; bf16* O;
    __device__ __forceinline__ void operator()(const f32x4 (&acc)[2][2][4][2], const pg8::Unit& u, int wr, int wc, int fr, int fq) const {
        EPI_ROWS(u); const int col0 = u.pn * 256 + wc * 32 + 8 * fq;
        f32x4 bv[2][2];
#pragma unroll
        for (int bj = 0; bj < 2; ++bj)
#pragma unroll
            for (int n = 0; n < 2; ++n) bv[bj][n] = *(const f32x4*)(bg + col0 + bj * 128 + 4 * n);
        EPI_LOOP { const int row = row0 + ai * 128 + m * 16; const size_t off = (size_t)row * 1024 + col0; const size_t poff = (size_t)row * LDP + gc0 + col0;
#pragma unroll
            for (int bj = 0; bj < 2; ++bj) { f32x4 g0, g1; unpack8(*(const u32x4*)(proj + poff + bj * 128), g0, g1);
                f32x4 v0 = sig4(g0 + bv[bj][0]) * acc[ai][bj][m][0], v1 = sig4(g1 + bv[bj][1]) * acc[ai][bj][m][1];
                if (ADD) { f32x4 p0, p1; unpack8(*(const u32x4*)(Prev + off + bj * 128), p0, p1); v0 += p0; v1 += p1; }
                *(u32x4*)(O + off + bj * 128) = pack8(v0, v1); } }
    }
};
struct EpiX1 {
    static constexpr bool PERM = false; const float* x; const float* mod; float* X1;
    __device__ __forceinline__ void operator()(const f32x4 (&acc)[2][2][4][2], const pg8::Unit& u, int wr, int wc, int fr, int fq) const {
        EPI_ROWS(u); const int col0 = u.pn * 256 + wc * 32 + 4 * fq; const int b = (u.pm * 256) / SEQ;
        f32x4 gv[2][2];
#pragma unroll
        for (int bj = 0; bj < 2; ++bj)
#pragma unroll
            for (int n = 0; n < 2; ++n) gv[bj][n] = *(const f32x4*)(mod + b * 6144 + 2 * D + col0 + bj * 128 + n * 16);
        EPI_LOOP { const size_t off = (size_t)(row0 + ai * 128 + m * 16) * D + col0;
#pragma unroll
            for (int bj = 0; bj < 2; ++bj)
#pragma unroll
                for (int n = 0; n < 2; ++n) *(f32x4*)(X1 + off + bj * 128 + n * 16) = *(const f32x4*)(x + off + bj * 128 + n * 16) + gv[bj][n] * acc[ai][bj][m][n]; }
    }
};
struct EpiSwiglu {
    static constexpr bool PERM = true; const float* bin; bf16* ACT;
    __device__ __forceinline__ void operator()(const f32x4 (&acc)[2][2][4][2], const pg8::Unit& u, int wr, int wc, int fr, int fq) const {
        EPI_ROWS(u); const int e = u.pn >> 3, pl = u.pn & 7; const int f0 = pl * 128 + wc * 32 + 8 * fq;
        f32x4 bg[2], bl[2];
#pragma unroll
        for (int n = 0; n < 2; ++n) { bg[n] = *(const f32x4*)(bin + e * 2048 + f0 + 4 * n); bl[n] = *(const f32x4*)(bin + e * 2048 + 1024 + f0 + 4 * n); }
        EPI_LOOP { f32x4 o[2];
#pragma unroll
            for (int n = 0; n < 2; ++n) { const f32x4 zg = acc[ai][0][m][n] + bg[n], zl = acc[ai][1][m][n] + bl[n];
#pragma unroll
                for (int j = 0; j < 4; ++j) { const float gl = fminf(zg[j], 7.0f); const float li = fminf(fmaxf(zl[j], -7.0f), 7.0f); o[n][j] = gl * sigmoidf_(1.702f * gl) * (li + 1.0f); } }
            *(v2u*)((unsigned char*)ACT + (size_t)(row0 + ai * 128 + m * 16) * 1024 + f0) = (v2u){pk4_fp8(8.f * o[0][0], 8.f * o[0][1], 8.f * o[0][2], 8.f * o[0][3]), pk4_fp8(8.f * o[1][0], 8.f * o[1][1], 8.f * o[1][2], 8.f * o[1][3])}; }
    }
};
struct EpiY {
    static constexpr bool PERM = true; const float* bout; bf16* Y;
    __device__ __forceinline__ void operator()(const f32x4 (&acc)[2][2][4][2], const pg8::Unit& u, int wr, int wc, int fr, int fq) const {
        EPI_ROWS(u); const int e = u.pn >> 2, pl = u.pn & 3; const int col0 = pl * 256 + wc * 32 + 8 * fq;
        f32x4 bv[2][2];
#pragma unroll
        for (int bj = 0; bj < 2; ++bj)
#pragma unroll
            for (int n = 0; n < 2; ++n) bv[bj][n] = *(const f32x4*)(bout + e * 1024 + col0 + bj * 128 + 4 * n);
        EPI_LOOP { bf16* rowp = Y + (size_t)(row0 + ai * 128 + m * 16) * 1024 + col0;
#pragma unroll
            for (int bj = 0; bj < 2; ++bj) *(u32x4*)(rowp + bj * 128) = pack8(acc[ai][bj][m][0] + bv[bj][0], acc[ai][bj][m][1] + bv[bj][1]); }
    }
};

struct TItem { const float* src; bf16* dst; int ld, ldk; int f8; };
__device__ __forceinline__ void titem_load(const TItem& t, int lane, f32x4 (&r)[8]) {
#pragma unroll
    for (int i = 0; i < 8; ++i) r[i] = *(const f32x4*)(t.src + (size_t)(8 * i + (lane >> 3)) * t.ld + 4 * (lane & 7));
}
__device__ __forceinline__ void titem_store(const TItem& t, int lane, const f32x4 (&r)[8], LAS float* scr) {
#pragma unroll
    for (int i = 0; i < 8; ++i) { LAS float* p = scr + (8 * i + (lane >> 3)) * 33 + 4 * (lane & 7); p[0] = r[i][0]; p[1] = r[i][1]; p[2] = r[i][2]; p[3] = r[i][3]; }
    LDS_WAIT(); asm volatile("" ::: "memory");
    const int c = lane & 7;
#pragma unroll
    for (int j = 0; j < 4; ++j) { const int n = (lane >> 3) + 8 * j; const LAS float* s = scr + (8 * c) * 33 + n;
        if (t.f8) { *(GAS v2u*)((unsigned char*)t.dst + (size_t)n * t.ldk + 8 * c) = (v2u){pk4_fp8(32.f * s[0 * 33], 32.f * s[1 * 33], 32.f * s[2 * 33], 32.f * s[3 * 33]), pk4_fp8(32.f * s[4 * 33], 32.f * s[5 * 33], 32.f * s[6 * 33], 32.f * s[7 * 33])}; }
        else { v4u o; o.x = pk2(s[0 * 33], s[1 * 33]); o.y = pk2(s[2 * 33], s[3 * 33]); o.z = pk2(s[4 * 33], s[5 * 33]); o.w = pk2(s[6 * 33], s[7 * 33]);
            *(GAS v4u*)(t.dst + (size_t)n * t.ldk + 8 * c) = o; } }
    LDS_WAIT(); asm volatile("" ::: "memory");
}
__device__ __forceinline__ void p0_prologue(Frame& F, const float* const* __restrict__ INP) {
    {
        LAS float* sc = (LAS float*)(F.lds);
        LAS float* red = (LAS float*)(F.lds + 9 * 1024 * 4);
        for (int i = F.tid; i < 9 * 1024; i += NWAVES * 64) { const int r = i >> 10, k = i & 1023; const float v = r < 8 ? INP[1][r * 1024 + k] : INP[3][k]; sc[i] = v / (1.0f + __expf(-v)); }
        __syncthreads();
        const float* wada = INP[4]; const float* bada = INP[5];
        float* mod = (float*)(F.ws + WS_MOD);
        for (int cg = blockIdx.x; cg < 256; cg += F.G) {
            const int j0 = cg * 24, col = F.lane & 31, kp = F.lane >> 5;
            float a[9];
#pragma unroll
            for (int r = 0; r < 9; ++r) a[r] = 0.f;
            if (col < 24) {
                for (int i = 0; i < 64; ++i) { const int k = F.wave * 128 + 2 * i + kp; const float wv = wada[(size_t)k * 6144 + j0 + col];
#pragma unroll
                    for (int r = 0; r < 9; ++r) a[r] += sc[r * 1024 + k] * wv; }
            }
#pragma unroll
            for (int r = 0; r < 9; ++r) red[((F.wave * 2 + kp) * 9 + r) * 32 + col] = a[r];
            __syncthreads();
            if (F.tid < 9 * 32) { const int r = F.tid >> 5, cc = F.tid & 31;
                if (cc < 24) { float s = 0.f; for (int p = 0; p < 16; ++p) s += red[(p * 9 + r) * 32 + cc]; const int j = j0 + cc; s += bada[j];
                    if (r < 8) mod[r * 6144 + j] = s; else if (j < 2048) mod[8 * 6144 + j] = s; } }
            __syncthreads();
        }
    }
    LAS float* scr = (LAS float*)(F.lds + F.wave * 16384);
    const int gw = F.vcu * NWAVES + F.wave, NGW = F.G * NWAVES;
    bf16* WIN = (bf16*)(F.ws + WS_WIN); bf16* WGLU = (bf16*)(F.ws + WS_WGLU); bf16* WA = (bf16*)(F.ws + WS_WA); bf16* WB = (bf16*)(F.ws + WS_WB); bf16* WO = (bf16*)(F.ws + WS_WO);
    bf16* WEIN = (bf16*)(F.ws + WS_WEIN); bf16* WEOUT = (bf16*)(F.ws + WS_WEOUT);
    constexpr int I_IN = 177 * 16, I_GLU = 16 * 8, I_A = 32 * 16, I_B = 32 * 8, I_O = 32 * 16, I_EIN = 32 * 64 * 16, I_EOUT = 32 * 32 * 16;
    constexpr int NITEMS = I_IN + I_GLU + I_A + I_B + I_O + I_EIN + I_EOUT;
#define P0_DECODE(it_, T) do { int r = (it_); \
        if (r < I_IN) { const int kb = r / 177, nb = r % 177, n0 = nb * 32; const int sc0 = n0 < 2048 ? n0 : (n0 < 5632 ? n0 + 32 : 2048); \
            T.src = INP[8] + (size_t)kb * 64 * 5664 + sc0; T.ld = 5664; T.dst = WIN + (size_t)n0 * 1024 + kb * 64; T.ldk = 1024; T.f8 = 0; break; } r -= I_IN; \
        if (r < I_GLU) { const int kb = r / 16, nb = r % 16; T.src = INP[21] + (size_t)kb * 64 * 512 + nb * 32; T.ld = 512; T.dst = WGLU + (size_t)nb * 32 * 512 + kb * 64; T.ldk = 512; T.f8 = 0; break; } r -= I_GLU; \
        if (r < I_A) { const int kb = r / 32, nb = r % 32; T.src = INP[12] + (size_t)kb * 64 * 1024 + nb * 32; T.ld = 1024; T.dst = WA + (size_t)nb * 32 * 1024 + kb * 64; T.ldk = 1024; T.f8 = 0; break; } r -= I_A; \
        if (r < I_B) { const int kb = r / 32, nb = r % 32; T.src = INP[23] + (size_t)kb * 64 * 1024 + nb * 32; T.ld = 1024; T.dst = WB + (size_t)nb * 32 * 512 + kb * 64; T.ldk = 512; T.f8 = 0; break; } r -= I_B; \
        if (r < I_O) { const int kb = r / 32, nb = r % 32; T.src = INP[25] + (size_t)kb * 64 * 1024 + nb * 32; T.ld = 1024; T.dst = WO + (size_t)nb * 32 * 1024 + kb * 64; T.ldk = 1024; T.f8 = 0; break; } r -= I_O; \
        if (r < I_EIN) { const int e = r / 1024, q = r % 1024, kb = q / 64, nb = q % 64; const int dr = nb * 32, pn = dr >> 8, bj = (dr >> 7) & 1, xx = dr & 127; \
            T.src = INP[28] + (size_t)e * 1024 * 2048 + (size_t)kb * 64 * 2048 + bj * 1024 + pn * 128 + xx; T.ld = 2048; T.dst = (bf16*)((unsigned char*)WEIN + (size_t)e * 2048 * 1024 + (size_t)dr * 1024 + kb * 64); T.ldk = 1024; T.f8 = 1; break; } r -= I_EIN; \
        { const int e = r / 512, q = r % 512, kb = q / 32, nb = q % 32; \
            T.src = INP[30] + (size_t)e * 1024 * 1024 + (size_t)kb * 64 * 1024 + nb * 32; T.ld = 1024; T.dst = (bf16*)((unsigned char*)WEOUT + (size_t)e * 1024 * 1024 + (size_t)nb * 32 * 1024 + kb * 64); T.ldk = 1024; T.f8 = 1; } } while (0)
    {
        TItem ta, tb; f32x4 ra[8], rb[8];
        int it = gw;
        if (it < NITEMS) { P0_DECODE(it, ta); titem_load(ta, F.lane, ra); }
        while (it < NITEMS) {
            const int nx = it + NGW;
            if (nx < NITEMS) { P0_DECODE(nx, tb); titem_load(tb, F.lane, rb); }
            titem_store(ta, F.lane, ra, scr);
            ta = tb;
#pragma unroll
            for (int i = 0; i < 8; ++i) ra[i] = rb[i];
            it = nx;
        }
    }
#undef P0_DECODE
    { const int gt = blockIdx.x * (NWAVES * 64) + F.tid, NT = F.G * NWAVES * 64; GAS v4u* z = (GAS v4u*)(WIN + (size_t)5664 * 1024);
        for (int i = gt; i < 224 * 1024 / 8; i += NT) z[i] = (v4u){0u, 0u, 0u, 0u}; }
}

__device__ __forceinline__ void p1_norm1(Frame& F, const float* const* __restrict__ INP) {
    const int gw = F.vcu * NWAVES + F.wave, NGW = F.G * NWAVES;
    const float* mod = (const float*)(F.ws + WS_MOD); bf16* H1 = (bf16*)(F.ws + WS_H1);
    for (int m = gw; m < MT; m += NGW) {
        const float* xr; const float* sh; const float* scl;
        if (m < ML) { const int b = m / SEQ; xr = INP[0] + (size_t)m * D; sh = mod + b * 6144; scl = sh + D; }
        else { xr = INP[2] + (size_t)(m - ML) * D; sh = mod + 8 * 6144; scl = sh + D; }
        f32x4 v[4]; float s = 0.f;
#pragma unroll
        for (int j = 0; j < 4; ++j) { v[j] = *(const f32x4*)(xr + 256 * j + 4 * F.lane); s += (v[j][0] * v[j][0] + v[j][1] * v[j][1]) + (v[j][2] * v[j][2] + v[j][3] * v[j][3]); }
        const float rstd = 1.0f / sqrtf(wave_sum(s) * (1.0f / D) + EPS);
#pragma unroll
        for (int j = 0; j < 4; ++j) { const int c = 256 * j + 4 * F.lane; const f32x4 g = *(const f32x4*)(INP[6] + c), a = *(const f32x4*)(scl + c), bb = *(const f32x4*)(sh + c);
            const f32x4 y = v[j] * rstd * g * (a + 1.0f) + bb;
            *(v2u*)(H1 + (size_t)m * D + c) = (v2u){pk2(y[0], y[1]), pk2(y[2], y[3])}; }
    }
}

__device__ __forceinline__ void conv_fma8(float (&a)[8], const v4u x, const float* wp) {
    const f32x4 w0 = *(const f32x4*)(wp), w1 = *(const f32x4*)(wp + 4);
    a[0] += bflo(x.x) * w0[0]; a[1] += bfhi(x.x) * w0[1]; a[2] += bflo(x.y) * w0[2]; a[3] += bfhi(x.y) * w0[3];
    a[4] += bflo(x.z) * w1[0]; a[5] += bfhi(x.z) * w1[1]; a[6] += bflo(x.w) * w1[2]; a[7] += bfhi(x.w) * w1[3];
}
__device__ __forceinline__ void p3_conv(Frame& F, const float* const* __restrict__ INP) {
    const bf16* PROJ = (const bf16*)(F.ws + WS_PROJ); bf16* QKC = (bf16*)(F.ws + WS_QKC); const float* wc = INP[9];
    const int NT = F.G * NWAVES * 64;
    for (int it = F.vcu * (NWAVES * 64) + F.tid; it < NB * 64 * 4 * 128; it += NT) {
        const int ch0 = (it & 127) * 8, seg = (it >> 7) & 3, gr = (it >> 9) & 63, b = it >> 15, c0 = seg * 16;
        const bf16* base = PROJ + (size_t)(b * SEQ) * LDP + ch0;
        const float scale = ch0 < 512 ? 0.125f : 1.0f;
        v4u win[3][3];
        const v4u z = (v4u){0u, 0u, 0u, 0u};
#define P3_LOADCOL(slot, cc) do { _Pragma("unroll") for (int ky = 0; ky < 3; ++ky) { const int rr = gr + ky - 1; \
            win[slot][ky] = (rr >= 0 && rr < 64 && (cc) >= 0 && (cc) < 64) ? *(const v4u*)(base + (size_t)(rr * 64 + (cc)) * LDP) : z; } } while (0)
        P3_LOADCOL(0, c0 - 1); P3_LOADCOL(1, c0);
#pragma unroll
        for (int cc = 0; cc < 16; ++cc) {
            const int c = c0 + cc;
            P3_LOADCOL((cc + 2) % 3, c + 1);
            float a[8];
#pragma unroll
            for (int j = 0; j < 8; ++j) a[j] = 0.f;
#pragma unroll
            for (int ky = 0; ky < 3; ++ky)
#pragma unroll
                for (int kx = 0; kx < 3; ++kx) conv_fma8(a, win[(cc + kx) % 3][ky], wc + (ky * 3 + kx) * 1024 + ch0);
#pragma unroll
            for (int j = 0; j < 8; ++j) a[j] = a[j] / (1.0f + __expf(-a[j])) * scale;
            *(v4u*)(QKC + (size_t)(b * SEQ + gr * 64 + c) * 1024 + ch0) = (v4u){pk2(a[0], a[1]), pk2(a[2], a[3]), pk2(a[4], a[5]), pk2(a[6], a[7])};
        }
#undef P3_LOADCOL
    }
    for (int w = F.vcu * (NWAVES * 64) + F.tid; w < MC * 128; w += NT) {
        const int row = ML + (w >> 7), ch0 = (w & 127) * 8, t = (w >> 7) % CTXL;
        float a[8];
#pragma unroll
        for (int j = 0; j < 8; ++j) a[j] = 0.f;
#pragma unroll
        for (int kx = 0; kx < 3; ++kx) { const int tt = t + kx - 1;
            if (tt >= 0 && tt < CTXL) conv_fma8(a, *(const v4u*)(PROJ + (size_t)(row + kx - 1) * LDP + ch0), wc + (3 + kx) * 1024 + ch0); }
        const float scale = ch0 < 512 ? 0.125f : 1.0f;
#pragma unroll
        for (int j = 0; j < 8; ++j) a[j] = a[j] / (1.0f + __expf(-a[j])) * scale;
        *(v4u*)(QKC + (size_t)row * 1024 + ch0) = (v4u){pk2(a[0], a[1]), pk2(a[2], a[3]), pk2(a[4], a[5]), pk2(a[6], a[7])};
    }
    {
        float* GB = (float*)(F.ws + WS_GS); float* GG = GB + 128 * 4352; float* GP = GG + 128 * 4352;
        const int gw = F.vcu * NWAVES + F.wave, NGW = F.G * NWAVES, lane = F.lane;
        for (int it = gw; it < 128 * 34; it += NGW) {
            const int jc = it % 34, dbh = it / 34, h = dbh & 7, b = (dbh >> 3) & 7, d = dbh >> 6;
            const bool lat = jc >= 2; const int p0 = lat ? 128 * (jc - 2) : 128 * jc, Lseq = lat ? SEQ : CTXL, rowbase = lat ? b * SEQ : ML + b * CTXL;
            const float bi_ = INP[10][d * 16 + h], bf_ = INP[10][d * 16 + 8 + h];
            float li2[2], lf2[2];
#pragma unroll
            for (int e = 0; e < 2; ++e) { const int sp = 2 * lane + e; const int tt = d ? (Lseq - 1 - (p0 + sp)) : (p0 + sp); const size_t row = (size_t)(rowbase + tt);
                li2[e] = bf2f(PROJ[row * LDP + PC_IF + d * 16 + h]) + bi_; const float xf = bf2f(PROJ[row * LDP + PC_IF + d * 16 + 8 + h]) + bf_;
                lf2[e] = fminf(xf, 0.f) - log1pf(expf(-fabsf(xf))); }
            const float c1 = lf2[0] + lf2[1]; float inc = c1;
#pragma unroll
            for (int o = 1; o < 64; o <<= 1) { const float t = __shfl_up(inc, o); if (lane >= o) inc += t; }
            const float exc = inc - c1, b0 = exc + lf2[0], b1 = exc + c1, g0 = li2[0] - b0, g1 = li2[1] - b1;
            float pmx = fmaxf(g0, g1);
#pragma unroll
            for (int o = 1; o < 64; o <<= 1) { const float t = __shfl_up(pmx, o); if (lane >= o) pmx = fmaxf(pmx, t); }
            float pex = __shfl_up(pmx, 1); if (lane == 0) pex = -INFINITY;
            const size_t o = (size_t)dbh * 4352 + 128 * jc + 2 * lane;
            *(float2*)(GB + o) = make_float2(b0, b1); *(float2*)(GG + o) = make_float2(g0, g1); *(float2*)(GP + o) = make_float2(fmaxf(pex, g0), pmx);
        }
    }
}

__device__ __forceinline__ void mma32_nt(f32x16& acc, const LAS bf16* A, int lda, const LAS bf16* Bt, int ldb, int K, int lane) {
    const int r = lane & 31, h = lane >> 5;
#pragma unroll
    for (int k0 = 0; k0 < K; k0 += 16) {
        const bf16x8 a = *(const LAS bf16x8*)(A + r * lda + k0 + 8 * h);
        const bf16x8 b = *(const LAS bf16x8*)(Bt + r * ldb + k0 + 8 * h);
        acc = __builtin_amdgcn_mfma_f32_32x32x16_bf16(a, b, acc, 0, 0, 0);
        if ((k0 & 63) == 48) __builtin_amdgcn_sched_barrier(0);
    }
}
__device__ __forceinline__ void mma16_nt(f32x4& acc, const LAS bf16* A, int lda, const LAS bf16* Bt, int ldb, int K, int lane) {
    const int r = lane & 15, q = lane >> 4;
    for (int k0 = 0; k0 < K; k0 += 32) {
        const bf16x8 a = *(const LAS bf16x8*)(A + r * lda + k0 + 8 * q);
        const bf16x8 b = *(const LAS bf16x8*)(Bt + r * ldb + k0 + 8 * q);
        acc = __builtin_amdgcn_mfma_f32_16x16x32_bf16(a, b, acc, 0, 0, 0);
    }
}
__device__ __forceinline__ int row32(int reg, int lane) { return (reg & 3) + 8 * (reg >> 2) + 4 * (lane >> 5); }
__device__ __forceinline__ float logsigmoidf_(float x) { return fminf(x, 0.f) - log1pf(expf(-fabsf(x))); }

typedef short s16x4 __attribute__((ext_vector_type(4)));
__device__ __forceinline__ s16x4 tr_read(const LAS bf16* p) { return __builtin_amdgcn_ds_read_tr16_b64_v4i16((LAS s16x4*)p); }
__device__ __forceinline__ bf16x8 tr_frag32_perm(const LAS bf16* T, int ld, int k0, int x0, int lane) {
    const int h = lane >> 5, i = lane & 15, q = i >> 2, p = i & 3, xb = 16 * ((lane >> 4) & 1);
    const LAS bf16* a = T + (k0 + 4 * h + q) * ld + x0 + xb + 4 * p;
    const s16x4 lo = tr_read(a), hi = tr_read(a + 8 * ld);
    return (bf16x8){lo[0], lo[1], lo[2], lo[3], hi[0], hi[1], hi[2], hi[3]};
}
__device__ __forceinline__ bf16x8 tr_frag16(const LAS bf16* T, int ld, int k0, int x0, int lane) {
    const int q4 = lane >> 4, i = lane & 15, q = i >> 2, p = i & 3;
    const LAS bf16* a = T + (k0 + 8 * q4 + q) * ld + x0 + 4 * p;
    const s16x4 lo = tr_read(a), hi = tr_read(a + 4 * ld);
    return (bf16x8){lo[0], lo[1], lo[2], lo[3], hi[0], hi[1], hi[2], hi[3]};
}
__device__ __forceinline__ v4u scale8(const v4u k8, float ww) {
    return (v4u){pk2(ww * bflo(k8.x), ww * bfhi(k8.x)), pk2(ww * bflo(k8.y), ww * bfhi(k8.y)), pk2(ww * bflo(k8.z), ww * bfhi(k8.z)), pk2(ww * bflo(k8.w), ww * bfhi(k8.w))};
}

template <int MODE>
__device__ __forceinline__ void p4_mlstm(Frame& F, const float* const* __restrict__ INP, int unit) {
    const int vh = unit & 1, h = (unit >> 1) & 7, b = (unit >> 4) & 7, d = unit >> 7;
    LAS bf16* Qs = (LAS bf16*)(F.lds + 0);
    LAS bf16* Ks = (LAS bf16*)(F.lds + 18432);
    LAS bf16* Kw = (LAS bf16*)(F.lds + 36864);
    LAS bf16* Vs = (LAS bf16*)(F.lds + 55296);
    LAS bf16* Cb = (LAS bf16*)(F.lds + 73728);
    LAS float* vec = (LAS float*)(F.lds + 82944);
    LAS float *rowt = vec, *colt = vec + 128, *iev = vec + 256, *emt = vec + 384, *nv = vec + 512, *npart = vec + 576;
    const bf16* PROJ = (const bf16*)(F.ws + WS_PROJ); const bf16* QKC = (const bf16*)(F.ws + WS_QKC); bf16* HDIR = (bf16*)(F.ws + WS_HDIR) + (size_t)d * ML * 1024;
    const float* GB = (const float*)(F.ws + WS_GS) + (size_t)((d * 8 + b) * 8 + h) * 4352; const float* GG = GB + 128 * 4352; const float* GP = GG + 128 * 4352;
    int tid = F.tid; asm volatile("" : "+v"(tid));
    const int lane = tid & 63, w = F.wave;
    for (int i = tid; i < 64 * 72; i += 512) Cb[i] = 0;
    if (tid < 64) nv[tid] = 0.f;
    f32x4 accC[2] = {(f32x4){0.f, 0.f, 0.f, 0.f}, (f32x4){0.f, 0.f, 0.f, 0.f}};
    float m_old = 0.f, dec_prev = 0.f;
    v4u pq[2], pk[2], pv[2]; float pgb = 0.f, pgp = 0.f, pgc = 0.f, pgg[2], pbend, pgmax; v2u hout[4]; bf16* hptr = nullptr; bool hpend = false;
    const int zl = tid >> 9;
#define ML_PREFETCH(jn) do { const bool lat_ = (jn) >= 2; const int p0_ = lat_ ? 128 * ((jn) - 2) : 128 * (jn), L_ = lat_ ? SEQ : CTXL, rb_ = lat_ ? b * SEQ : ML + b * CTXL; \
        _Pragma("unroll") for (int i = 0; i < 2; ++i) { const int id = tid + 512 * i, s_ = id >> 3, c_ = id & 7; const int tt = d ? (L_ - 1 - (p0_ + s_)) : (p0_ + s_); const size_t row = (size_t)(rb_ + tt); \
            pq[i] = *(const v4u*)(QKC + row * 1024 + h * 64 + c_ * 8); pk[i] = *(const v4u*)(QKC + row * 1024 + 512 + h * 64 + c_ * 8); pv[i] = *(const v4u*)(PROJ + row * LDP + PC_V + h * 128 + vh * 64 + c_ * 8); \
            pgg[i] = GG[128 * (jn) + s_]; } \
        if (tid < 128) { pgb = GB[128 * (jn) + tid]; pgp = GP[128 * (jn) + tid]; pgc = GG[128 * (jn) + tid]; } \
        pbend = GB[128 * (jn) + 127 + zl]; pgmax = GP[128 * (jn) + 127 + zl]; } while (0)
    ML_PREFETCH(0);
    __syncthreads();
    for (int j = 0; j < 34; ++j) {
        const bool lat = j >= 2;
        const int p0 = lat ? 128 * (j - 2) : 128 * j, Lseq = lat ? SEQ : CTXL, rowbase = lat ? b * SEQ : ML + b * CTXL;
        const float bend = pbend, gmax = pgmax;
        const float mnew = fmaxf(bend + m_old, bend + gmax), dec = __expf(bend + m_old - mnew);
#pragma unroll
        for (int i = 0; i < 2; ++i) { const int id = tid + 512 * i, s = id >> 3, c = id & 7;
            *(LAS v4u*)(Qs + s * 72 + c * 8) = pq[i]; *(LAS v4u*)(Ks + s * 72 + c * 8) = pk[i]; *(LAS v4u*)(Vs + s * 72 + c * 8) = pv[i];
            *(LAS v4u*)(Kw + s * 72 + c * 8) = scale8(pk[i], __expf(bend + pgg[i] - mnew)); }
        if (tid < 128) { const float r = fmaxf(m_old, pgp); rowt[tid] = -r * 1.44269504089f; colt[tid] = pgc * 1.44269504089f; iev[tid] = __expf(m_old - r); emt[tid] = __expf(-pgb - r); }
        if (j > 0) {
            const int vi = w >> 1;
#pragma unroll
            for (int jj = 0; jj < 2; ++jj) { const int ki = 2 * (w & 1) + jj;
#pragma unroll
                for (int reg = 0; reg < 4; ++reg) Cb[(16 * vi + (lane >> 4) * 4 + reg) * 72 + 16 * ki + (lane & 15)] = (bf16)f2bf(accC[jj][reg]); }
            if (tid < 64) { float sacc = 0.f;
#pragma unroll
                for (int p = 0; p < 8; ++p) sacc += npart[p * 64 + tid];
                nv[tid] = dec_prev * nv[tid] + sacc; }
        }
        LBAR();
        if (j + 1 < 34 && !(MODE & 4)) ML_PREFETCH(j + 1);
        if (hpend) {
#pragma unroll
            for (int rg = 0; rg < 4; ++rg) *(v2u*)(hptr + 8 * rg) = hout[rg];
            hpend = false; }
        if (lat && !(MODE & 1)) { const int tm = w >> 1, vt = w & 1, tl = lane & 31, t = 32 * tm + tl, hh = lane >> 5; f32x16 acc;
#pragma unroll
            for (int reg = 0; reg < 16; ++reg) acc[reg] = 0.f;
            mma32_nt(acc, Cb + 32 * vt * 72, 72, Qs + 32 * tm * 72, 72, 64, lane);
            const float ie = iev[t], rt = rowt[t];
#pragma unroll
            for (int reg = 0; reg < 16; ++reg) acc[reg] *= ie;
            float rs = 0.f;
            for (int st = (MODE & 8) ? tm : 0; st <= tm; ++st) {
                f32x16 X;
#pragma unroll
                for (int reg = 0; reg < 16; ++reg) X[reg] = 0.f;
                mma32_nt(X, Ks + 32 * st * 72, 72, Qs + 32 * tm * 72, 72, 64, lane);
                const LAS float* cp = colt + 32 * st + 4 * hh;
                if (st == tm) { const int dlim = tl - 4 * hh;
#pragma unroll
                    for (int rg = 0; rg < 4; ++rg) { const f32x4 c4 = *(const LAS f32x4*)(cp + 8 * rg);
#pragma unroll
                        for (int e = 0; e < 4; ++e) { const float arg = (8 * rg + e <= dlim) ? c4[e] + rt : -INFINITY; const float pvv = X[4 * rg + e] * __builtin_amdgcn_exp2f(arg); X[4 * rg + e] = pvv; rs += pvv; } }
                } else {
#pragma unroll
                    for (int rg = 0; rg < 4; ++rg) { const f32x4 c4 = *(const LAS f32x4*)(cp + 8 * rg);
#pragma unroll
                        for (int e = 0; e < 4; ++e) { const float pvv = X[4 * rg + e] * __builtin_amdgcn_exp2f(c4[e] + rt); X[4 * rg + e] = pvv; rs += pvv; } }
                }
#pragma unroll
                for (int ks = 0; ks < 2; ++ks) {
                    const v4u bw = (v4u){cvtpk(X[8 * ks], X[8 * ks + 1]), cvtpk(X[8 * ks + 2], X[8 * ks + 3]), cvtpk(X[8 * ks + 4], X[8 * ks + 5]), cvtpk(X[8 * ks + 6], X[8 * ks + 7])};
                    const bf16x8 af = tr_frag32_perm(Vs, 72, 32 * st + 16 * ks, 32 * vt, lane);
                    acc = __builtin_amdgcn_mfma_f32_32x32x16_bf16(af, __builtin_bit_cast(bf16x8, bw), acc, 0, 0, 0); }
            }
            float nq = 0.f;
#pragma unroll
            for (int q = 0; q < 4; ++q) { const v4u q8 = *(const LAS v4u*)(Qs + t * 72 + 32 * hh + 8 * q); const LAS float* nn = nv + 32 * hh + 8 * q;
                nq += bflo(q8.x) * nn[0] + bfhi(q8.x) * nn[1] + bflo(q8.y) * nn[2] + bfhi(q8.y) * nn[3] + bflo(q8.z) * nn[4] + bfhi(q8.z) * nn[5] + bflo(q8.w) * nn[6] + bfhi(q8.w) * nn[7]; }
            rs += __shfl_xor(rs, 32); nq += __shfl_xor(nq, 32);
            const float rd = 1.0f / fmaxf(fabsf(ie * nq + rs), emt[t]);
            const int tt = d ? (Lseq - 1 - (p0 + t)) : (p0 + t);
            hptr = HDIR + (size_t)(rowbase + tt) * 1024 + h * 128 + vh * 64 + 32 * vt + 4 * hh;
#pragma unroll
            for (int rg = 0; rg < 4; ++rg) hout[rg] = (v2u){pk2(acc[4 * rg] * rd, acc[4 * rg + 1] * rd), pk2(acc[4 * rg + 2] * rd, acc[4 * rg + 3] * rd)};
            hpend = true; }
        if (!(MODE & 2)) { const int vi = w >> 1;
            accC[0] *= dec; accC[1] *= dec;
#pragma unroll
            for (int st4 = 0; st4 < 4; ++st4) { const bf16x8 af = tr_frag16(Vs, 72, 32 * st4, 16 * vi, lane);
#pragma unroll
                for (int jj = 0; jj < 2; ++jj) { const bf16x8 bfr = tr_frag16(Kw, 72, 32 * st4, 16 * (2 * (w & 1) + jj), lane); accC[jj] = __builtin_amdgcn_mfma_f32_16x16x32_bf16(af, bfr, accC[jj], 0, 0, 0); } } }
        { const int k = tid & 63, part = tid >> 6; float sacc = 0.f;
#pragma unroll
            for (int q = 0; q < 16; ++q) sacc += bf2f(Kw[(16 * part + q) * 72 + k]);
            npart[part * 64 + k] = sacc; }
        m_old = mnew; dec_prev = dec;
        LBAR();
    }
    if (hpend) {
#pragma unroll
        for (int rg = 0; rg < 4; ++rg) *(v2u*)(hptr + 8 * rg) = hout[rg]; }
#undef ML_PREFETCH
}

__device__ __forceinline__ void s5_disc(const float* const* __restrict__ INP, int d, int g, int p, float& ar, float& ai, float& cfr, float& cfi) {
    const float dt = expf(INP[15][d * 32 + g]); const float are = INP[13][(d * 32 + g) * 64 + p], aim = INP[14][(d * 32 + g) * 64 + p];
    const float mag = expf(dt * are), ang = dt * aim; ar = mag * cosf(ang); ai = mag * sinf(ang);
    const float den = are * are + aim * aim, xr = ar - 1.0f; cfr = (xr * are + ai * aim) / den; cfi = (ai * are - xr * aim) / den;
}
__device__ __forceinline__ void p4_s5(Frame& F, const float* const* __restrict__ INP, int unit) {
    const int gp = unit & 15, b = (unit >> 4) & 7, d = unit >> 7;
    LAS bf16* BHt = (LAS bf16*)(F.lds + 0);
    LAS bf16* Cm = (LAS bf16*)(F.lds + 69632);
    LAS float* Eb = (LAS float*)(F.lds + 78336);
    LAS bf16* Us = (LAS bf16*)(F.lds + 82432);
    LAS bf16* BBs = (LAS bf16*)(F.lds + 92672);
    const bf16* PROJ = (const bf16*)(F.ws + WS_PROJ); bf16* YDIR = (bf16*)(F.ws + WS_YDIR) + (size_t)d * ML * 512;
    int tid = F.tid; asm volatile("" : "+v"(tid));
    const int lane = tid & 63, w = F.wave;
    const int sg = tid & 127, seg = tid >> 7;
    float ar, ai, a32r, a32i;
    { float cfr, cfi; s5_disc(INP, d, 2 * gp + (sg >> 6), sg & 63, ar, ai, cfr, cfi); a32r = ar; a32i = ai;
#pragma unroll
        for (int q = 0; q < 5; ++q) { const float nr = a32r * a32r - a32i * a32i, ni = 2.0f * a32r * a32i; a32r = nr; a32i = ni; } }
    for (int idx = tid; idx < 4096; idx += 512) {
        { const int gg = idx >> 11, pp = (idx >> 4) & 127, c = idx & 15, g = 2 * gp + gg, p = pp & 63; float xr_, xi_, cfr, cfi; s5_disc(INP, d, g, p, xr_, xi_, cfr, cfi);
            const float bre = INP[16][((size_t)(d * 32 + g) * 64 + p) * 16 + c], bim = INP[17][((size_t)(d * 32 + g) * 64 + p) * 16 + c];
            BBs[(gg * 128 + pp) * 24 + c] = (bf16)f2bf(pp < 64 ? cfr * bre - cfi * bim : cfr * bim + cfi * bre); }
        { const int gg = idx >> 11, c = (idx >> 7) & 15, pp = idx & 127, g = 2 * gp + gg, p = pp & 63;
            const float v = pp < 64 ? INP[18][((size_t)(d * 32 + g) * 16 + c) * 64 + p] : -INP[19][((size_t)(d * 32 + g) * 16 + c) * 64 + p];
            Cm[(gg * 16 + c) * 136 + pp] = (bf16)f2bf(v); }
    }
    float h0r = 0.f, h0i = 0.f;
    LAS bf16* rowre = BHt + ((sg >> 6) * 128 + (sg & 63)) * 136 + 32 * seg;
    v4u pu; v2u yout[2]; bf16* yptr[2]; bool ypend = false;
#define S5_PREFETCH(jn) do { const bool lat_ = (jn) >= 2; const int p0_ = lat_ ? 128 * ((jn) - 2) : 128 * (jn), L_ = lat_ ? SEQ : CTXL, rb_ = lat_ ? b * SEQ : ML + b * CTXL; \
        const int s_ = tid >> 2, c_ = tid & 3; const int tt = d ? (L_ - 1 - (p0_ + s_)) : (p0_ + s_); pu = *(const v4u*)(PROJ + (size_t)(rb_ + tt) * LDP + PC_U + gp * 32 + c_ * 8); } while (0)
    S5_PREFETCH(0);
    __syncthreads();
    for (int j = 0; j < 34; ++j) {
        const bool lat = j >= 2;
        const int p0 = lat ? 128 * (j - 2) : 128 * j, Lseq = lat ? SEQ : CTXL, rowbase = lat ? b * SEQ : ML + b * CTXL;
        *(LAS v4u*)(Us + (tid >> 2) * 40 + (tid & 3) * 8) = pu;
        LBAR();
        if (j + 1 < 34) S5_PREFETCH(j + 1);
        if (ypend) { *(v2u*)yptr[0] = yout[0]; *(v2u*)yptr[1] = yout[1]; ypend = false; }
        { const int gg = w >> 2, tm = w & 3, r = lane & 31, hh = lane >> 5;
            const bf16x8 a = *(const LAS bf16x8*)(Us + (32 * tm + r) * 40 + gg * 16 + 8 * hh);
            LAS bf16* bp = BHt + (gg * 128 + r) * 136 + 32 * tm + 4 * hh;
#pragma unroll
            for (int tn = 0; tn < 4; ++tn) { f32x16 acc;
#pragma unroll
                for (int reg = 0; reg < 16; ++reg) acc[reg] = 0.f;
                const bf16x8 bb = *(const LAS bf16x8*)(BBs + (gg * 128 + 32 * tn + r) * 24 + 8 * hh);
                acc = __builtin_amdgcn_mfma_f32_32x32x16_bf16(a, bb, acc, 0, 0, 0);
#pragma unroll
                for (int rg = 0; rg < 4; ++rg) *(LAS v2u*)(bp + 32 * tn * 136 + 8 * rg) = (v2u){cvtpk(acc[4 * rg], acc[4 * rg + 1]), cvtpk(acc[4 * rg + 2], acc[4 * rg + 3])}; } }
        LBAR();
        v4u xr[4], xi[4];
#pragma unroll
        for (int q = 0; q < 4; ++q) { xr[q] = *(const LAS v4u*)(rowre + 8 * q); xi[q] = *(const LAS v4u*)(rowre + 64 * 136 + 8 * q); }
        { float hr = 0.f, hi = 0.f;
#pragma unroll
            for (int q = 0; q < 4; ++q)
#pragma unroll
                for (int e = 0; e < 4; ++e) { const unsigned wr_ = xr[q][e], wi_ = xi[q][e];
                    { const float br = bflo(wr_), bi = bflo(wi_); const float nr = ar * hr - ai * hi + br, ni = ar * hi + ai * hr + bi; hr = nr; hi = ni; }
                    { const float br = bfhi(wr_), bi = bfhi(wi_); const float nr = ar * hr - ai * hi + br, ni = ar * hi + ai * hr + bi; hr = nr; hi = ni; } }
            Eb[(seg * 128 + sg) * 2] = hr; Eb[(seg * 128 + sg) * 2 + 1] = hi; }
        LBAR();
        { float hcr = h0r, hci = h0i, hr = 0.f, hi = 0.f;
#pragma unroll
            for (int s2 = 0; s2 < 4; ++s2) { if (s2 == seg) { hr = hcr; hi = hci; } const float er = Eb[(s2 * 128 + sg) * 2], ei = Eb[(s2 * 128 + sg) * 2 + 1];
                const float nr = a32r * hcr - a32i * hci + er, ni = a32r * hci + a32i * hcr + ei; hcr = nr; hci = ni; }
            h0r = hcr; h0i = hci;
#pragma unroll
            for (int q = 0; q < 4; ++q) { v4u orr, oi;
#pragma unroll
                for (int e = 0; e < 4; ++e) { const unsigned wr_ = xr[q][e], wi_ = xi[q][e]; float r0, i0, r1, i1;
                    { const float br = bflo(wr_), bi = bflo(wi_); const float nr = ar * hr - ai * hi + br, ni = ar * hi + ai * hr + bi; hr = nr; hi = ni; r0 = hr; i0 = hi; }
                    { const float br = bfhi(wr_), bi = bfhi(wi_); const float nr = ar * hr - ai * hi + br, ni = ar * hi + ai * hr + bi; hr = nr; hi = ni; r1 = hr; i1 = hi; }
                    orr[e] = cvtpk(r0, r1); oi[e] = cvtpk(i0, i1); }
                *(LAS v4u*)(rowre + 8 * q) = orr; *(LAS v4u*)(rowre + 64 * 136 + 8 * q) = oi; } }
        LBAR();
        if (lat) { const int gg = w >> 2;
#pragma unroll
            for (int jj = 0; jj < 2; ++jj) { const int tm = 2 * (w & 3) + jj; f32x4 acc = (f32x4){0.f, 0.f, 0.f, 0.f};
#pragma unroll
                for (int st4 = 0; st4 < 4; ++st4) { const bf16x8 af = *(const LAS bf16x8*)(Cm + (gg * 16 + (lane & 15)) * 136 + 32 * st4 + 8 * (lane >> 4));
                    const bf16x8 bfr = tr_frag16(BHt + gg * 128 * 136, 136, 32 * st4, 16 * tm, lane);
                    acc = __builtin_amdgcn_mfma_f32_16x16x32_bf16(af, bfr, acc, 0, 0, 0); }
                const int t = 16 * tm + (lane & 15); const int tt = d ? (Lseq - 1 - (p0 + t)) : (p0 + t);
                yptr[jj] = YDIR + (size_t)(rowbase + tt) * 512 + (2 * gp + gg) * 16 + 4 * (lane >> 4); yout[jj] = (v2u){pk2(acc[0], acc[1]), pk2(acc[2], acc[3])}; }
            ypend = true; }
    }
    if (ypend) { *(v2u*)yptr[0] = yout[0]; *(v2u*)yptr[1] = yout[1]; }
#undef S5_PREFETCH
    __syncthreads();
}

__device__ __forceinline__ float gelu_tanh(float x) { const float u = 0.7978845608028654f * (x + 0.044715f * x * x * x); const float e = __expf(2.0f * u); const float th = 1.0f - 2.0f / (e + 1.0f); return 0.5f * x * (1.0f + th); }
__device__ __forceinline__ void p5a_prep(Frame& F, const float* const* __restrict__ INP) {
    const int gw = F.vcu * NWAVES + F.wave, NGW = F.G * NWAVES, lane = F.lane;
    const bf16* PROJ = (const bf16*)(F.ws + WS_PROJ); const bf16* HD0 = (const bf16*)(F.ws + WS_HDIR); const bf16* HD1 = HD0 + (size_t)ML * 1024;
    const bf16* YD0 = (const bf16*)(F.ws + WS_YDIR); const bf16* YD1 = YD0 + (size_t)ML * 512;
    bf16* A1 = (bf16*)(F.ws + WS_A1); bf16* A2 = (bf16*)(F.ws + WS_A2);
    for (int m = gw; m < ML; m += NGW) {
        float hm[16]; float ss = 0.f;
#pragma unroll
        for (int q = 0; q < 2; ++q) { const v4u a = *(const v4u*)(HD0 + (size_t)m * 1024 + 16 * lane + 8 * q), bq = *(const v4u*)(HD1 + (size_t)m * 1024 + 16 * lane + 8 * q);
            hm[8 * q + 0] = bflo(a.x) + bflo(bq.x); hm[8 * q + 1] = bfhi(a.x) + bfhi(bq.x); hm[8 * q + 2] = bflo(a.y) + bflo(bq.y); hm[8 * q + 3] = bfhi(a.y) + bfhi(bq.y);
            hm[8 * q + 4] = bflo(a.z) + bflo(bq.z); hm[8 * q + 5] = bfhi(a.z) + bfhi(bq.z); hm[8 * q + 6] = bflo(a.w) + bflo(bq.w); hm[8 * q + 7] = bfhi(a.w) + bfhi(bq.w); }
#pragma unroll
        for (int q = 0; q < 16; ++q) ss += hm[q] * hm[q];
        ss += __shfl_xor(ss, 1); ss += __shfl_xor(ss, 2); ss += __shfl_xor(ss, 4);
        const float rs = 1.0f / sqrtf(ss * (1.0f / 128.0f) + EPS);
#pragma unroll
        for (int q = 0; q < 2; ++q) { const v4u o8 = *(const v4u*)(PROJ + (size_t)m * LDP + PC_O + 16 * lane + 8 * q); const float* gm = INP[11] + 16 * lane + 8 * q;
            float r[8]; const float og[8] = {bflo(o8.x), bfhi(o8.x), bflo(o8.y), bfhi(o8.y), bflo(o8.z), bfhi(o8.z), bflo(o8.w), bfhi(o8.w)};
#pragma unroll
            for (int e = 0; e < 8; ++e) r[e] = hm[8 * q + e] * rs * gm[e] * sigmoidf_(og[e]);
            *(v4u*)(A1 + (size_t)m * 1024 + 16 * lane + 8 * q) = (v4u){pk2(r[0], r[1]), pk2(r[2], r[3]), pk2(r[4], r[5]), pk2(r[6], r[7])}; }
        { const v4u a = *(const v4u*)(YD0 + (size_t)m * 512 + 8 * lane), bq = *(const v4u*)(YD1 + (size_t)m * 512 + 8 * lane), u8 = *(const v4u*)(PROJ + (size_t)m * LDP + PC_U + 8 * lane);
            const float* dd = INP[20] + 8 * lane;
            float r[8] = {bflo(a.x) + bflo(bq.x) + dd[0] * bflo(u8.x), bfhi(a.x) + bfhi(bq.x) + dd[1] * bfhi(u8.x), bflo(a.y) + bflo(bq.y) + dd[2] * bflo(u8.y), bfhi(a.y) + bfhi(bq.y) + dd[3] * bfhi(u8.y),
                          bflo(a.z) + bflo(bq.z) + dd[4] * bflo(u8.z), bfhi(a.z) + bfhi(bq.z) + dd[5] * bfhi(u8.z), bflo(a.w) + bflo(bq.w) + dd[6] * bflo(u8.w), bfhi(a.w) + bfhi(bq.w) + dd[7] * bfhi(u8.w)};
#pragma unroll
            for (int e = 0; e < 8; ++e) r[e] = gelu_tanh(r[e]);
            *(v4u*)(A2 + (size_t)m * 512 + 8 * lane) = (v4u){pk2(r[0], r[1]), pk2(r[2], r[3]), pk2(r[4], r[5]), pk2(r[6], r[7])}; }
    }
}

__device__ __forceinline__ void route_reduce_top4(float (&acc)[32], const float* br, int lane, float (&tv)[4], int (&ti)[4]) {
#pragma unroll
    for (int i = 0; i < 16; ++i) { const float send = (lane & 32) ? acc[i] : acc[i + 16]; const float keep = (lane & 32) ? acc[i + 16] : acc[i]; acc[i] = keep + __shfl_xor(send, 32); }
#pragma unroll
    for (int i = 0; i < 8; ++i) { const float send = (lane & 16) ? acc[i] : acc[i + 8]; const float keep = (lane & 16) ? acc[i + 8] : acc[i]; acc[i] = keep + __shfl_xor(send, 16); }
#pragma unroll
    for (int i = 0; i < 4; ++i) { const float send = (lane & 8) ? acc[i] : acc[i + 4]; const float keep = (lane & 8) ? acc[i + 4] : acc[i]; acc[i] = keep + __shfl_xor(send, 8); }
#pragma unroll
    for (int i = 0; i < 2; ++i) { const float send = (lane & 4) ? acc[i] : acc[i + 2]; const float keep = (lane & 4) ? acc[i + 2] : acc[i]; acc[i] = keep + __shfl_xor(send, 4); }
    { const float send = (lane & 2) ? acc[0] : acc[1]; const float keep = (lane & 2) ? acc[1] : acc[0]; acc[0] = keep + __shfl_xor(send, 2); }
    acc[0] += __shfl_xor(acc[0], 1);
    float val = acc[0] + br[lane >> 1];
    if (lane & 1) val = -INFINITY;
#pragma unroll
    for (int r = 0; r < 4; ++r) { float mx = val;
#pragma unroll
        for (int o = 1; o < 64; o <<= 1) mx = fmaxf(mx, __shfl_xor(mx, o));
        const unsigned long long bal = __ballot(val == mx); const int wl = __ffsll((long long)bal) - 1;
        tv[r] = mx; ti[r] = wl >> 1; if (lane == wl) val = -INFINITY; }
}
__device__ __forceinline__ void p6_route(Frame& F, const float* const* __restrict__ INP) {
    const float* X1 = F.out; const float* mod = (const float*)(F.ws + WS_MOD); bf16* H2 = (bf16*)(F.ws + WS_H2);
    int* TOPE = (int*)(F.ws + WS_TOPE); int* POS = (int*)(F.ws + WS_POS); float* TOPP = (float*)(F.ws + WS_TOPP); int* LIST = (int*)(F.ws + WS_LIST);
    LAS float* Wt = (LAS float*)(F.lds);
    LAS int* pe = (LAS int*)(F.lds + LDSCTL_OFF + 1024); LAS int* hist = pe + 512; LAS int* base = hist + 32; LAS int* rank = base + 32;
    const float* wr = INP[26]; const float* br = INP[27];
    const int lane = F.lane, w = F.wave;
    for (int idx = F.tid; idx < 32768; idx += NWAVES * 64) { const int e = idx >> 10, k = idx & 1023; Wt[((((k >> 8) * 4 + (k & 3)) * 32 + e) << 6) + ((k >> 2) & 63)] = wr[k * 32 + e]; }
    __syncthreads();
    for (int tg = blockIdx.x; tg < ML / 128; tg += F.G) {
        if (F.tid < 32) hist[F.tid] = 0;
        __syncthreads();
#pragma unroll 1
        for (int q = 0; q < 16; q += 2) {
            const int tl = w * 16 + q, m = tg * 128 + tl, b = m / SEQ;
            const float* sh = mod + b * 6144 + 3 * D; const float* scl = sh + D;
            float s0 = 0.f, s1 = 0.f;
#pragma unroll
            for (int j = 0; j < 4; ++j) { const f32x4 x0 = *(const f32x4*)(X1 + (size_t)m * D + 256 * j + 4 * lane), x1 = *(const f32x4*)(X1 + (size_t)(m + 1) * D + 256 * j + 4 * lane);
                s0 += (x0[0] * x0[0] + x0[1] * x0[1]) + (x0[2] * x0[2] + x0[3] * x0[3]); s1 += (x1[0] * x1[0] + x1[1] * x1[1]) + (x1[2] * x1[2] + x1[3] * x1[3]); }
            const float r0 = 1.0f / sqrtf(wave_sum(s0) * (1.0f / D) + EPS), r1 = 1.0f / sqrtf(wave_sum(s1) * (1.0f / D) + EPS);
            float a0[32], a1[32];
#pragma unroll
            for (int e = 0; e < 32; ++e) { a0[e] = 0.f; a1[e] = 0.f; }
#pragma unroll 1
            for (int j = 0; j < 4; ++j) { const int c = 256 * j + 4 * lane; const f32x4 g = *(const f32x4*)(INP[7] + c), a = *(const f32x4*)(scl + c), bb = *(const f32x4*)(sh + c);
                const f32x4 x0 = *(const f32x4*)(X1 + (size_t)m * D + c), x1 = *(const f32x4*)(X1 + (size_t)(m + 1) * D + c);
                const f32x4 gs = g * (a + 1.0f); const f32x4 y0 = x0 * r0 * gs + bb, y1 = x1 * r1 * gs + bb;
                *(unsigned*)((unsigned char*)H2 + (size_t)m * D + c) = pk4_fp8(y0[0], y0[1], y0[2], y0[3]); *(unsigned*)((unsigned char*)H2 + (size_t)(m + 1) * D + c) = pk4_fp8(y1[0], y1[1], y1[2], y1[3]);
                const LAS float* wj = Wt + j * 8192 + lane;
#pragma unroll
                for (int qq = 0; qq < 4; ++qq) { const LAS float* wp = wj + qq * 2048; const float ya = y0[qq], yb = y1[qq];
#pragma unroll
                    for (int e = 0; e < 32; ++e) { const float wv = wp[e * 64]; a0[e] += ya * wv; a1[e] += yb * wv; }
                    asm volatile("" ::: "memory"); } }
            float tv[4]; int ti[4];
#pragma unroll
            for (int tk = 0; tk < 2; ++tk) {
                if (tk == 0) route_reduce_top4(a0, br, lane, tv, ti); else route_reduce_top4(a1, br, lane, tv, ti);
                const float e1 = __expf(tv[1] - tv[0]), e2 = __expf(tv[2] - tv[0]), e3 = __expf(tv[3] - tv[0]); const float inv = 1.0f / (1.0f + e1 + e2 + e3);
                if (lane < 4) { const float p = lane == 0 ? inv : (lane == 1 ? e1 * inv : (lane == 2 ? e2 * inv : e3 * inv)); const int ee = lane == 0 ? ti[0] : (lane == 1 ? ti[1] : (lane == 2 ? ti[2] : ti[3]));
                    TOPP[(m + tk) * 4 + lane] = p; TOPE[(m + tk) * 4 + lane] = ee; pe[(tl + tk) * 4 + lane] = ee; }
            }
        }
        __syncthreads();
        { const int e = pe[F.tid]; rank[F.tid] = __hip_atomic_fetch_add(&hist[e], 1, __ATOMIC_RELAXED, __HIP_MEMORY_SCOPE_WORKGROUP); }
        __syncthreads();
        if (F.tid < 32) base[F.tid] = (int)__hip_atomic_fetch_add(F.ctl + CW_CNT + 64 * F.tid, (unsigned)hist[F.tid], RLX_AGENT);
        __syncthreads();
        { const int e = pe[F.tid]; const int pos = base[e] + rank[F.tid]; const int m = tg * 128 + (F.tid >> 2); LIST[e * ML + pos] = m; POS[m * 4 + (F.tid & 3)] = pos; }
        __syncthreads();
    }
}

__device__ __forceinline__ void p10_combine(Frame& F, const float* const* __restrict__ INP) {
    moe_tables(F);
    const LAS int* tab = (const LAS int*)(F.lds + TAB_OFF);
    const float* X1 = F.out; float* OUT = F.out; const float* mod = (const float*)(F.ws + WS_MOD); const bf16* Y = (const bf16*)(F.ws + WS_Y);
    const int* TOPE = (const int*)(F.ws + WS_TOPE); const int* POS = (const int*)(F.ws + WS_POS); const float* TOPP = (const float*)(F.ws + WS_TOPP);
    const int gw = F.vcu * NWAVES + F.wave, NGW = F.G * NWAVES, lane = F.lane;
    for (int m = gw; m < ML; m += NGW) {
        const int b = m / SEQ; const float* gt2 = mod + b * 6144 + 5 * D;
        f32x4 mo[4];
#pragma unroll
        for (int j = 0; j < 4; ++j) mo[j] = (f32x4){0.f, 0.f, 0.f, 0.f};
#pragma unroll
        for (int k = 0; k < 4; ++k) { const int e = TOPE[m * 4 + k]; const float p = TOPP[m * 4 + k]; const size_t slot = (size_t)256 * tab[e] + POS[m * 4 + k];
#pragma unroll
            for (int j = 0; j < 4; ++j) { const v2u y = *(const v2u*)(Y + slot * 1024 + 256 * j + 4 * lane); mo[j] += (f32x4){bflo(y.x), bfhi(y.x), bflo(y.y), bfhi(y.y)} * p; } }
        f32x4 v[4]; float s = 0.f;
#pragma unroll
        for (int j = 0; j < 4; ++j) { const int c = 256 * j + 4 * lane; v[j] = *(const f32x4*)(X1 + (size_t)m * D + c) + *(const f32x4*)(gt2 + c) * mo[j]; s += (v[j][0] * v[j][0] + v[j][1] * v[j][1]) + (v[j][2] * v[j][2] + v[j][3] * v[j][3]); }
        const float rstd = 1.0f / sqrtf(wave_sum(s) * (1.0f / D) + EPS);
#pragma unroll
        for (int j = 0; j < 4; ++j) { const int c = 256 * j + 4 * lane; *(f32x4*)(OUT + (size_t)m * D + c) = v[j] * rstd * *(const f32x4*)(INP[32] + c); }
    }
}

struct Args { const float* in[33]; float* out; unsigned char* ws; int ph_lo, ph_hi, li, pad; };
__global__ void __launch_bounds__(NWAVES * 64, 2) fwd_kernel(Args args) {
    extern __shared__ __attribute__((aligned(16))) unsigned char lds[];
    Frame F;
    F.lds = (LAS unsigned char*)lds;
    F.tid = threadIdx.x; F.lane = F.tid & 63; F.wave = __builtin_amdgcn_readfirstlane(F.tid >> 6);
    F.G = gridDim.x; { const int bx = blockIdx.x; F.vcu = (F.G % 8 == 0) ? (bx % 8) * (F.G / 8) + bx / 8 : bx; }
    F.ws = args.ws; F.ctl = (gu32*)(args.ws + WS_CTL); F.out = args.out;
    for (int u = F.tid; u < (LDS_BYTES - LDSCTL_OFF) / 4; u += NWAVES * 64) ((LAS unsigned*)(F.lds + LDSCTL_OFF))[u] = 0u;
    __syncthreads();
    XcdBarrier bar; bar.bar = (unsigned*)(F.ctl + CW_BAR); bar.x = 0; bar.st = nullptr;
    if (N_LAUNCHES == 1) bar = xcd_barrier_post((unsigned*)(F.ctl + CW_BAR), (volatile LAS unsigned*)(F.lds + MISC_OFF) + 8);
    const int lo = args.ph_lo, hi = args.ph_hi;
    const float* const* __restrict__ INP = args.in;
#ifndef PH_MASK
#define PH_MASK 0x3fff
#endif
#define IN(k) ((((PH_MASK) >> (k)) & 1) && lo <= (k) && (k) < hi)
#define SEAM(k) do { if (IN(k) && IN((k) + 1)) xcd_barrier(bar); } while (0)
    const bf16* WIN = (const bf16*)(F.ws + WS_WIN);

    if (IN(0)) { p0_prologue(F, INP); } SEAM(0);
    if (IN(1)) { p1_norm1(F, INP); } SEAM(1);
    if (IN(2)) {
        pg8::Gemm g{(const bf16*)(F.ws + WS_H1), WIN, 1024, nullptr, 0, 0}; InProjOrder S{F.G, (int)blockIdx.x};
        EpiStore E{(bf16*)(F.ws + WS_PROJ), LDP};
        pg8::gemm_phase<EpiStore, InProjOrder, false>(F.lds, g, S, E);
    } SEAM(2);
    if (IN(3)) { p3_conv(F, INP); } SEAM(3);
    if (IN(4)) { for (int u = blockIdx.x; u < 256; u += F.G) { p4_mlstm<0>(F, INP, u); if (P4_REP_M > 1) p4_mlstm<P4_MODE>(F, INP, u); for (int r_ = 0; r_ < P4_REP_S; ++r_) p4_s5(F, INP, u); } } SEAM(4);
    if (IN(5)) { p5a_prep(F, INP); } SEAM(5);
    if (IN(6)) {
        pg8::Gemm g{(const bf16*)(F.ws + WS_A2), (const bf16*)(F.ws + WS_WGLU), 512, nullptr, 0, 0}; pg8::StaticOrder S; S.init(ML, 512, F.G, (int)blockIdx.x);
        EpiGlu E{(const bf16*)(F.ws + WS_A2), (bf16*)(F.ws + WS_A3), INP[22]};
        pg8::gemm_phase<EpiGlu, pg8::StaticOrder, false>(F.lds, g, S, E);
    }
    if (IN(7)) {
        pg8::Gemm g{(const bf16*)(F.ws + WS_A1), (const bf16*)(F.ws + WS_WA), 1024, nullptr, 0, 0}; pg8::StaticOrder S; S.init(ML, 1024, F.G, (int)blockIdx.x);
        EpiGate<false> E{(const bf16*)(F.ws + WS_PROJ), PC_G, INP[24], nullptr, (bf16*)(F.ws + WS_YA)};
        pg8::gemm_phase<EpiGate<false>, pg8::StaticOrder, false>(F.lds, g, S, E);
    } SEAM(7);
    if (IN(8)) {
        pg8::Gemm g{(const bf16*)(F.ws + WS_A3), (const bf16*)(F.ws + WS_WB), 512, nullptr, 0, 0}; pg8::StaticOrder S; S.init(ML, 1024, F.G, (int)blockIdx.x);
        EpiGate<true> E{(const bf16*)(F.ws + WS_PROJ), PC_G + 1024, INP[24] + 1024, (const bf16*)(F.ws + WS_YA), (bf16*)(F.ws + WS_MERGED)};
        pg8::gemm_phase<EpiGate<true>, pg8::StaticOrder, false>(F.lds, g, S, E);
    } SEAM(8);
    if (IN(9)) {
        pg8::Gemm g{(const bf16*)(F.ws + WS_MERGED), (const bf16*)(F.ws + WS_WO), 1024, nullptr, 0, 0}; pg8::StaticOrder S; S.init(ML, 1024, F.G, (int)blockIdx.x);
        EpiX1 E{INP[0], (const float*)(F.ws + WS_MOD), F.out};
        pg8::gemm_phase<EpiX1, pg8::StaticOrder, false>(F.lds, g, S, E);
    } SEAM(9);
    if (IN(10)) { p6_route(F, INP); } SEAM(10);
    if (IN(11)) {
        moe_tables(F);
        MoeOrder S{F.G, (int)blockIdx.x, 8, (const LAS int*)(F.lds + TAB_OFF)};
        LAS unsigned short* ridx = (LAS unsigned short*)(F.lds + LDSCTL_OFF + 1024);
        { const int* LIST = (const int*)(F.ws + WS_LIST);
            for (int i = 0; i < 30; ++i) { pg8::Unit u; if (!S.next(i, u)) break;
                if (F.tid < 256) { const int rc = F.tid < u.nvalid ? F.tid : u.nvalid - 1; ridx[i * 256 + F.tid] = (unsigned short)LIST[u.lbase + rc]; } }
            __syncthreads(); }
        pg8::Gemm g{(const bf16*)(F.ws + WS_H2), (const bf16*)(F.ws + WS_WEIN), 512, ridx, 0x7f7f7f7f, 0x7a7a7a7a};
        EpiSwiglu E{INP[29], (bf16*)(F.ws + WS_ACT)};
        pg8::gemm_phase<EpiSwiglu, MoeOrder, true, true>(F.lds, g, S, E);
    } SEAM(11);
    if (IN(12)) {
        moe_tables(F);
        pg8::Gemm g{(const bf16*)(F.ws + WS_ACT), (const bf16*)(F.ws + WS_WEOUT), 512, nullptr, 0x7c7c7c7c, 0x7a7a7a7a}; MoeOrder S{F.G, (int)blockIdx.x, 4, (const LAS int*)(F.lds + TAB_OFF)};
        EpiY E{INP[31], (bf16*)(F.ws + WS_Y)};
        pg8::gemm_phase<EpiY, MoeOrder, false, true>(F.lds, g, S, E);
    } SEAM(12);
    if (IN(13)) { p10_combine(F, INP); }
#undef IN
#undef SEAM
}

extern "C" void kernel_launch(void* const* d_in, const int* in_sizes, int n_in, void* d_out, int out_size, void* d_ws, size_t ws_size, hipStream_t stream) {
    static int grid = 0;
    if (grid == 0) {
        if (n_in != 33 || out_size != ML * D || ws_size < WS_END2) { fprintf(stderr, "kernel_launch: unexpected shapes (n_in %d, out %d, ws %zu)\n", n_in, out_size, ws_size); grid = -1; return; }
        int dev = 0, cus = 0, per_cu = 0;
        if (hipGetDevice(&dev) != hipSuccess || hipDeviceGetAttribute(&cus, hipDeviceAttributeMultiprocessorCount, dev) != hipSuccess) { grid = -1; return; }
        if (hipFuncSetAttribute((const void*)fwd_kernel, hipFuncAttributeMaxDynamicSharedMemorySize, LDS_BYTES) != hipSuccess) { fprintf(stderr, "kernel_launch: hipFuncSetAttribute failed\n"); grid = -1; return; }
        if (hipOccupancyMaxActiveBlocksPerMultiprocessor(&per_cu, (const void*)fwd_kernel, NWAVES * 64, LDS_BYTES) != hipSuccess || per_cu < 1) fprintf(stderr, "kernel_launch: occupancy query reports %d\n", per_cu);
        (void)hipGetLastError();
        grid = cus;
    }
    if (grid < 0) return;
    if (hipMemsetAsync((char*)d_ws + WS_CTL, 0, CTL_ZERO_BYTES, stream) != hipSuccess) return;
    Args a{};
    for (int i = 0; i < 33; ++i) a.in[i] = (const float*)d_in[i];
    a.out = (float*)d_out; a.ws = (unsigned char*)d_ws;
    for (int li = 0; li < N_LAUNCHES; ++li) {
        a.ph_lo = (N_LAUNCHES == 1) ? 0 : li; a.ph_hi = (N_LAUNCHES == 1) ? NPH : li + 1; a.li = li;
        const int nrep = (N_LAUNCHES != 1 && (((PROBE_DUP_MASK) >> li) & 1)) ? 2 : 1;
        for (int r = 0; r < nrep; ++r) hipLaunchKernelGGL(fwd_kernel, dim3(grid), dim3(NWAVES * 64), LDS_BYTES, stream, a);
    }
}
```

```cpp
#include <hip/hip_runtime.h>
#include <cstdio>
#include <cstdint>

#ifndef MK_N_LAUNCHES
#define MK_N_LAUNCHES 1
#endif
#ifndef PROBE_DUP_MASK
#define PROBE_DUP_MASK 0
#endif
#ifndef P4_REP_M
#define P4_REP_M 1
#endif
#ifndef P4_MODE
#define P4_MODE 0
#endif
#ifndef P4_REP_S
#define P4_REP_S 1
#endif

namespace pg8 {
#define PG8_LAS __attribute__((address_space(3)))
typedef unsigned short bf16_t;
typedef short bf16x8 __attribute__((ext_vector_type(8)));
typedef float f32x4 __attribute__((ext_vector_type(4)));
typedef unsigned u32x4 __attribute__((ext_vector_type(4)));
constexpr int BM = 256, BK = 64, HALF = 128, HTB = HALF * BK * 2, STAGE_BYTES = 8 * HTB, NXCD = 8, WGM = 8;

__host__ __device__ __forceinline__ int lds_byte(int r, int c) { const int st = (r >> 4) * 2 + (c >> 5), rr = r & 15, cc = c & 31, ob = rr * 64 + cc * 2; return st * 1024 + (ob ^ (((ob >> 9) & 1) << 5)); }
__host__ __device__ __forceinline__ void stage_rc(int b, int& R, int& C) { const int st = b / 1024, sb = b % 1024, swz = sb ^ (((sb >> 9) & 1) << 5); R = (st >> 1) * 16 + swz / 64; C = (st & 1) * 32 + (swz % 64) / 2; }
__host__ __device__ __forceinline__ int perm32(int rho) { const int n = rho >> 4, i = rho & 15; return 8 * (i >> 2) + 4 * n + (i & 3); }

struct Unit { int pm, pn, lbase, nvalid; };
struct Gemm { const bf16_t* A; const bf16_t* Bt; int K; const PG8_LAS unsigned short* ridx; int sa, sb; };

__device__ __forceinline__ int xcd_remap(int L, int nwg) { const int q = nwg / NXCD, r = nwg % NXCD, xcd = L % NXCD, off = L / NXCD; return (xcd < r ? xcd * (q + 1) : r * (q + 1) + (xcd - r) * q) + off; }

struct StaticOrder {
    int nM, nN, nwg, G, c;
    __device__ void init(int M, int N, int G_, int c_) { nM = M / BM; nN = N / BM; nwg = nM * nN; G = G_; c = c_; }
    __device__ __forceinline__ bool next(int i, Unit& u) const {
        const long L = (long)i * G + c; if (L >= nwg) return false;
        const int wgid = xcd_remap((int)L, nwg);
        const int nig = WGM * nN, gid = wgid / nig, fm = gid * WGM, gsz = (nM - fm) < WGM ? (nM - fm) : WGM;
        u.pm = fm + ((wgid % nig) % gsz); u.pn = (wgid % nig) / gsz; u.lbase = 0; u.nvalid = 0; return true;
    }
};

__device__ __forceinline__ unsigned cvt_pk_bf16(float lo, float hi) { unsigned r; asm volatile("v_cvt_pk_bf16_f32 %0, %1, %2" : "=v"(r) : "v"(lo), "v"(hi)); return r; }

typedef int v8i __attribute__((ext_vector_type(8)));
typedef short s16x16 __attribute__((ext_vector_type(16)));
template <class Epi, class Sched, bool GATHER, bool FP8 = false>
__device__ __forceinline__ void gemm_phase(PG8_LAS unsigned char* lds, const Gemm g, const Sched& S, const Epi& E) {
    const int tid = threadIdx.x, wid = __builtin_amdgcn_readfirstlane(tid >> 6), lane = tid & 63, wr = wid >> 2, wc = wid & 3, fr = lane & 15, fq = lane >> 4;
    const int K = g.K, nt = K / BK;
    int Rr[2]; unsigned cby[2], voffB[2];
#pragma unroll
    for (int i = 0; i < 2; ++i) { int R, C; stage_rc(tid * 16 + i * 8192, R, C); const int Rb = Epi::PERM ? ((R & ~31) + perm32(R & 31)) : R;
        Rr[i] = R; cby[i] = (unsigned)C * 2u; voffB[i] = (unsigned)(Rb * K + C) * 2u; }
    const size_t kstep = (size_t)(BK * 2);
    const size_t hstep = (size_t)HALF * K * 2;
    const size_t tstep = 2 * hstep;
    const unsigned ldsw = (unsigned)wid * 1024u;
    const int aoff = lds_byte(wr * 64 + fr, FP8 ? fq * 16 : fq * 8), boff = lds_byte(wc * 32 + fr, FP8 ? fq * 16 : fq * 8);

#define PG8_SA(b, h) (((b) * 2 + (h)) * HTB)
#define PG8_SB(b, h) ((4 + (b) * 2 + (h)) * HTB)
#define PG8_STAGE(bufoff, gbase, voff) do { _Pragma("unroll") for (int _i = 0; _i < 2; ++_i) \
        __builtin_amdgcn_global_load_lds((const unsigned*)((const char*)(gbase) + (voff)[_i]), (PG8_LAS unsigned*)(lds + (bufoff) + ldsw + _i * 8192), 16, 0, 0); } while (0)
#define PG8_LDA(dst, b, h) do { if constexpr (FP8) { _Pragma("unroll") for (int m = 0; m < 4; ++m) { const bf16x8 _lo = *(const PG8_LAS bf16x8*)(lds + PG8_SA(b, h) + aoff + m * 2048), _hi = *(const PG8_LAS bf16x8*)(lds + PG8_SA(b, h) + aoff + m * 2048 + 16); dst##8[m] = __builtin_bit_cast(v8i, __builtin_shufflevector(_lo, _hi, 0, 1, 2, 3, 4, 5, 6, 7, 8, 9, 10, 11, 12, 13, 14, 15)); } } \
        else { _Pragma("unroll") for (int m = 0; m < 4; ++m) _Pragma("unroll") for (int k = 0; k < 2; ++k) dst[m][k] = *(const PG8_LAS bf16x8*)(lds + PG8_SA(b, h) + aoff + m * 2048 + k * 1024); } } while (0)
#define PG8_LDB(dst, b, h) do { if constexpr (FP8) { _Pragma("unroll") for (int n = 0; n < 2; ++n) { const bf16x8 _lo = *(const PG8_LAS bf16x8*)(lds + PG8_SB(b, h) + boff + n * 2048), _hi = *(const PG8_LAS bf16x8*)(lds + PG8_SB(b, h) + boff + n * 2048 + 16); dst##8[n] = __builtin_bit_cast(v8i, __builtin_shufflevector(_lo, _hi, 0, 1, 2, 3, 4, 5, 6, 7, 8, 9, 10, 11, 12, 13, 14, 15)); } } \
        else { _Pragma("unroll") for (int n = 0; n < 2; ++n) _Pragma("unroll") for (int k = 0; k < 2; ++k) dst[n][k] = *(const PG8_LAS bf16x8*)(lds + PG8_SB(b, h) + boff + n * 2048 + k * 1024); } } while (0)
#define PG8_MMA(ai, bj, At, Bt) do { __builtin_amdgcn_s_setprio(1); _Pragma("unroll") for (int m = 0; m < 4; ++m) _Pragma("unroll") for (int n = 0; n < 2; ++n) { \
        if constexpr (FP8) asm volatile("v_mfma_scale_f32_16x16x128_f8f6f4 %0, %1, %2, %0, %3, %4 op_sel_hi:[0,0,0]" : "+v"(acc[ai][bj][m][n]) : "v"(Bt##8[n]), "v"(At##8[m]), "v"(vsb), "v"(vsa));   \
        else { _Pragma("unroll") for (int k = 0; k < 2; ++k) acc[ai][bj][m][n] = __builtin_amdgcn_mfma_f32_16x16x32_bf16(Bt[n][k], At[m][k], acc[ai][bj][m][n], 0, 0, 0); } } \
        __builtin_amdgcn_s_setprio(0); } while (0)
#define PG8_WAIT_V(n) asm volatile("s_waitcnt vmcnt(" #n ")" ::: "memory")
#define PG8_WAIT_L(n) asm volatile("s_waitcnt lgkmcnt(" #n ")" ::: "memory")
#define PG8_BAR __builtin_amdgcn_s_barrier()
#define PG8_SCHED __builtin_amdgcn_sched_barrier(0)
#define PG8_AOFF(dst, u, uord) do { _Pragma("unroll") for (int _h = 0; _h < 2; ++_h) _Pragma("unroll") for (int _i = 0; _i < 2; ++_i) { const int _r = _h * HALF + Rr[_i]; \
        if constexpr (GATHER) { const int _idx = g.ridx[(uord) * 256 + _r]; dst[_h][_i] = (unsigned)_idx * (unsigned)(K * 2) + cby[_i]; } \
        else { dst[_h][_i] = (unsigned)(_r * K * 2) + cby[_i]; } } } while (0)
    Unit cur, nxt; int ui = 0;
    if (!S.next(0, cur)) return;
    f32x4 acc[2][2][4][2];
#pragma unroll
    for (int a = 0; a < 2; ++a)
#pragma unroll
        for (int b = 0; b < 2; ++b)
#pragma unroll
            for (int m = 0; m < 4; ++m)
#pragma unroll
                for (int n = 0; n < 2; ++n) acc[a][b][m][n] = (f32x4){0.f, 0.f, 0.f, 0.f};
    const int vsa = g.sa, vsb = g.sb;
    bf16x8 At[4][2], B0[2][2], B1[2][2];
    v8i At8[4], B08[2], B18[2];
    unsigned vc[2][2], vn[2][2];
    PG8_AOFF(vc, cur, 0);
    const char* cA = GATHER ? (const char*)g.A : (const char*)g.A + (size_t)cur.pm * tstep; const char* cB = (const char*)g.Bt + (size_t)cur.pn * tstep;
    PG8_STAGE(PG8_SB(0, 0), cB, voffB); PG8_STAGE(PG8_SB(0, 1), cB + hstep, voffB); PG8_STAGE(PG8_SA(0, 0), cA, vc[0]); PG8_STAGE(PG8_SA(0, 1), cA, vc[1]);
    if (wr == 1) PG8_BAR;
    PG8_WAIT_V(2); PG8_BAR;
    PG8_STAGE(PG8_SB(1, 0), cB + kstep, voffB); PG8_STAGE(PG8_SA(1, 0), cA + kstep, vc[0]); PG8_STAGE(PG8_SB(1, 1), cB + hstep + kstep, voffB);
    PG8_WAIT_V(6); PG8_BAR;
    for (;;) {
        const bool has_next = S.next(ui + 1, nxt);
        const char* nA = (has_next && !GATHER) ? (const char*)g.A + (size_t)nxt.pm * tstep : cA; const char* nB = has_next ? (const char*)g.Bt + (size_t)nxt.pn * tstep : cB;
        if constexpr (GATHER) { if (has_next) { PG8_AOFF(vn, nxt, ui + 1); } else {
#pragma unroll
            for (int h = 0; h < 2; ++h) { vn[h][0] = vc[h][0]; vn[h][1] = vc[h][1]; } } }
#pragma unroll 1
        for (int t = 0; t < nt; t += 2) {
            const bool last = (t == nt - 2);
            const char* a1 = cA + (size_t)(t + 1) * kstep;
            const char* a2 = last ? nA : cA + (size_t)(t + 2) * kstep; const char* b2 = last ? nB : cB + (size_t)(t + 2) * kstep;
            const char* a3 = a2 + kstep; const char* b3 = b2 + kstep;
            unsigned v2[2][2];
#pragma unroll
            for (int h = 0; h < 2; ++h)
#pragma unroll
                for (int i = 0; i < 2; ++i) v2[h][i] = GATHER ? (last ? vn[h][i] : vc[h][i]) : vc[h][i];
            PG8_LDB(B0, 0, 0); PG8_LDB(B1, 0, 1); PG8_SCHED; PG8_LDA(At, 0, 0); PG8_STAGE(PG8_SA(1, 1), a1, vc[1]);
            PG8_WAIT_V(8); PG8_WAIT_L(0); PG8_BAR; PG8_MMA(0, 0, At, B0); PG8_MMA(0, 1, At, B1); PG8_BAR; PG8_SCHED;
            PG8_LDA(At, 0, 1); PG8_STAGE(PG8_SB(0, 0), b2, voffB); PG8_STAGE(PG8_SB(0, 1), b2 + hstep, voffB); PG8_STAGE(PG8_SA(0, 0), a2, v2[0]);
            PG8_WAIT_V(8); PG8_WAIT_L(0); PG8_BAR; PG8_MMA(1, 0, At, B0); PG8_MMA(1, 1, At, B1); PG8_BAR; PG8_SCHED;
            PG8_LDB(B0, 1, 0); PG8_LDB(B1, 1, 1); PG8_SCHED; PG8_LDA(At, 1, 0); PG8_STAGE(PG8_SA(0, 1), a2, v2[1]);
            PG8_WAIT_V(8); PG8_WAIT_L(0); PG8_BAR; PG8_MMA(0, 0, At, B0); PG8_MMA(0, 1, At, B1); PG8_BAR; PG8_SCHED;
            PG8_LDA(At, 1, 1); PG8_STAGE(PG8_SB(1, 0), b3, voffB); PG8_STAGE(PG8_SB(1, 1), b3 + hstep, voffB); PG8_STAGE(PG8_SA(1, 0), a3, v2[0]);
            PG8_WAIT_V(8); PG8_WAIT_L(0); PG8_BAR; PG8_MMA(1, 0, At, B0); PG8_MMA(1, 1, At, B1); PG8_BAR; PG8_SCHED;
        }
        if (wr == 0) PG8_BAR;
        if constexpr (FP8) asm volatile("s_nop 15\n\ts_nop 15" ::: "memory");
        E(acc, cur, wr, wc, fr, fq);
        if (!has_next) break;
#pragma unroll
        for (int a = 0; a < 2; ++a)
#pragma unroll
            for (int b = 0; b < 2; ++b)
#pragma unroll
                for (int m = 0; m < 4; ++m)
#pragma unroll
                    for (int n = 0; n < 2; ++n) acc[a][b][m][n] = (f32x4){0.f, 0.f, 0.f, 0.f};
        cur = nxt; cA = nA; cB = nB; ++ui;
        if constexpr (GATHER) {
#pragma unroll
            for (int h = 0; h < 2; ++h) { vc[h][0] = vn[h][0]; vc[h][1] = vn[h][1]; } }
        if (wr == 1) PG8_BAR;
    }
    PG8_WAIT_V(0);
    PG8_BAR;
#undef PG8_SA
#undef PG8_SB
#undef PG8_STAGE
#undef PG8_LDA
#undef PG8_LDB
#undef PG8_MMA
#undef PG8_WAIT_V
#undef PG8_WAIT_L
#undef PG8_BAR
#undef PG8_SCHED
#undef PG8_AOFF
}
}

constexpr int NWAVES = 8;
constexpr int D = 1024, NB = 8, SEQ = 4096, CTXL = 256;
constexpr int ML = NB * SEQ, MC = NB * CTXL, MT = ML + MC;
constexpr int LDP = 5888;
constexpr int PC_QK = 0, PC_V = 1024, PC_U = 2048, PC_O = 2560, PC_G = 3584, PC_IF = 5632;
constexpr int NEXP = 32, TOPK = 4;
constexpr int MAXTILES = (ML * TOPK + NEXP * 256) / 256;
constexpr float EPS = 1e-6f;
constexpr int NPH = 14;
constexpr int N_LAUNCHES = MK_N_LAUNCHES;

constexpr size_t MiB = 1u << 20;
constexpr size_t WS_CTL = 0, CTL_ZERO_BYTES = 1 * MiB;
constexpr size_t WS_MOD = 1 * MiB;
constexpr size_t WS_TOPE = 2 * MiB, WS_POS = 2 * MiB + 512 * 1024, WS_TOPP = 3 * MiB, WS_LIST = 4 * MiB;
constexpr size_t WS_WIN = 8 * MiB, WS_WGLU = 20 * MiB, WS_WA = 21 * MiB, WS_WB = 23 * MiB, WS_WO = 24 * MiB, WS_WEIN = 26 * MiB, WS_WEOUT = 154 * MiB;
constexpr size_t WS_R0 = 218 * MiB;
constexpr size_t WS_PROJ = WS_R0, WS_H1 = 609 * MiB, WS_QKC = 677 * MiB, WS_HDIR = 745 * MiB, WS_YDIR = 873 * MiB, WS_END = 937 * MiB;
constexpr size_t WS_A1 = WS_H1, WS_A2 = WS_QKC, WS_A3 = WS_QKC + 32 * MiB, WS_YA = WS_HDIR, WS_MERGED = WS_HDIR + 64 * MiB;
constexpr size_t WS_GS = 940 * MiB, WS_END2 = 948 * MiB;
constexpr size_t WS_H2 = WS_R0, WS_ACT = 282 * MiB, WS_Y = 554 * MiB;
static_assert(WS_PROJ + (size_t)MT * LDP * 2 <= WS_H1 && WS_Y + (size_t)MAXTILES * 256 * 1024 * 2 <= WS_END, "ws map");
constexpr int CW_BAR = 4096, CW_CNT = 16384;

constexpr int RING_BYTES = 131072;
constexpr int LDSCTL_OFF = RING_BYTES, MISC_OFF = LDSCTL_OFF + 320, TAB_OFF = LDSCTL_OFF + 512;
constexpr int LDS_BYTES = 147456;

#define GAS __attribute__((address_space(1)))
#define LAS __attribute__((address_space(3)))
typedef unsigned short bf16;
typedef unsigned v4u __attribute__((ext_vector_type(4)));
typedef unsigned v2u __attribute__((ext_vector_type(2)));
typedef float f32x4 __attribute__((ext_vector_type(4)));
typedef float f32x16 __attribute__((ext_vector_type(16)));
typedef short bf16x8 __attribute__((ext_vector_type(8)));
typedef GAS unsigned gu32;
#define RLX_AGENT __ATOMIC_RELAXED, __HIP_MEMORY_SCOPE_AGENT
#define LDS_WAIT() asm volatile("s_waitcnt lgkmcnt(0)" ::: "memory")
#define LBAR() do { asm volatile("s_waitcnt lgkmcnt(0)" ::: "memory"); __builtin_amdgcn_s_barrier(); asm volatile("" ::: "memory"); } while (0)
__device__ __forceinline__ unsigned f2bf(float f) { unsigned u = __builtin_bit_cast(unsigned, f); return (u + 0x7fffu + ((u >> 16) & 1u)) >> 16; }
typedef __bf16 bf16x2_t __attribute__((ext_vector_type(2)));
__device__ __forceinline__ unsigned cvtpk(float lo, float hi) { const bf16x2_t v = {(__bf16)lo, (__bf16)hi}; return __builtin_bit_cast(unsigned, v); }
__device__ __forceinline__ unsigned pk2(float lo, float hi) { return cvtpk(lo, hi); }
__device__ __forceinline__ float clamp448(float x) { return fminf(fmaxf(x, -448.0f), 448.0f); }
__device__ __forceinline__ unsigned pk4_fp8(float a, float b, float c, float d) {
    unsigned w = 0; w = __builtin_amdgcn_cvt_pk_fp8_f32(clamp448(a), clamp448(b), w, false); w = __builtin_amdgcn_cvt_pk_fp8_f32(clamp448(c), clamp448(d), w, true); return w; }
__device__ __forceinline__ float bf2f(unsigned b) { return __builtin_bit_cast(float, b << 16); }
__device__ __forceinline__ float bflo(unsigned w) { return __builtin_bit_cast(float, w << 16); }
__device__ __forceinline__ float bfhi(unsigned w) { return __builtin_bit_cast(float, w & 0xffff0000u); }
__device__ __forceinline__ float sigmoidf_(float x) { return 1.0f / (1.0f + __expf(-x)); }

#define XB_TMO      128
#define XB_XCNT(j)  (256  + 64 * (j))
#define XB_XSUB(j)  (1280 + 64 * (j))
#define XB_XGEN(j)  (2304 + 64 * (j))
#define XB_TOP      3328
#define XB_TOPGEN   3392
#define XCD_BAR_WORDS 3456
#define XB_SPIN_CAP (1u << 22)
__device__ __forceinline__ unsigned xb_ld(unsigned* p)              { return __hip_atomic_load(p, __ATOMIC_RELAXED, __HIP_MEMORY_SCOPE_AGENT); }
__device__ __forceinline__ unsigned xb_add(unsigned* p, unsigned v) { return __hip_atomic_fetch_add(p, v, __ATOMIC_RELAXED, __HIP_MEMORY_SCOPE_AGENT); }
__device__ __forceinline__ unsigned xb_xcc_id() { return (unsigned)__builtin_amdgcn_s_getreg((3 << 11) | 20) & 0xFu; }
#define XB_SPIN(cond, bar) do { unsigned _sp = 0; while (cond) { __builtin_amdgcn_s_sleep(1); \
    if ((++_sp & 255u) == 0u) { if (xb_ld(&(bar)[XB_TMO])) break; if (_sp > XB_SPIN_CAP) { atomicAdd(&(bar)[XB_TMO], 1u); break; } } } } while (0)
struct XcdBarrier { unsigned* bar; unsigned x; volatile LAS unsigned* st; };
__device__ __forceinline__ XcdBarrier xcd_barrier_post(unsigned* bar, volatile LAS unsigned* st) {
    XcdBarrier b; b.bar = bar; b.x = xb_xcc_id(); b.st = st;
    if (threadIdx.x == 0) (void)xb_add(&bar[XB_XCNT(b.x)], 1u);
    return b;
}
__device__ __forceinline__ void xcd_barrier_complete(unsigned* bar, unsigned x, unsigned& nloc, unsigned& nx) {
    const unsigned G = gridDim.x * gridDim.y * gridDim.z;
    unsigned sum, cnt, mine, sp = 0u;
    for (;;) {
        sum = 0u; cnt = 0u; mine = 0u;
#pragma unroll
        for (unsigned j = 0; j < 16; ++j) { const unsigned c = xb_ld(&bar[XB_XCNT(j)]); sum += c; cnt += (c > 0u) ? 1u : 0u; mine = (j == x) ? c : mine; }
        if (sum == G) break;
        __builtin_amdgcn_s_sleep(1);
        if ((++sp & 255u) == 0u) { if (xb_ld(&bar[XB_TMO])) break; if (sp > XB_SPIN_CAP) { atomicAdd(&bar[XB_TMO], 1u); break; } }
    }
    nloc = mine > 0u ? mine : 1u; nx = cnt > 0u ? cnt : 1u;
}
__device__ __forceinline__ void xcd_barrier(const XcdBarrier& b) {
    asm volatile("s_waitcnt vmcnt(0)" ::: "memory");
    __syncthreads();
    if (threadIdx.x == 0) {
        unsigned* bar = b.bar;
        __builtin_amdgcn_s_waitcnt(0);
        unsigned nloc = b.st[0], nx = b.st[1];
        if (nloc == 0u) { xcd_barrier_complete(bar, b.x, nloc, nx); b.st[0] = nloc; b.st[1] = nx; }
        const unsigned old = xb_add(&bar[XB_XSUB(b.x)], 1u);
        const unsigned gen = old / nloc;
        if (old + 1u == (gen + 1u) * nloc) {
            __builtin_amdgcn_fence(__ATOMIC_RELEASE, "agent");
            asm volatile("s_waitcnt vmcnt(0)" ::: "memory");
            const unsigned og = xb_add(&bar[XB_TOP], 1u);
            const unsigned tg = og / nx;
            if (og + 1u == (tg + 1u) * nx) xb_add(&bar[XB_TOPGEN], 1u);
            else XB_SPIN(xb_ld(&bar[XB_TOPGEN]) == tg, bar);
            __builtin_amdgcn_fence(__ATOMIC_ACQUIRE, "agent");
            xb_add(&bar[XB_XGEN(b.x)], 1u);
            asm volatile("s_waitcnt vmcnt(0)" ::: "memory");
        } else {
            XB_SPIN(xb_ld(&bar[XB_XGEN(b.x)]) == gen, bar);
            __builtin_amdgcn_fence(__ATOMIC_ACQUIRE, "agent");
            asm volatile("s_waitcnt vmcnt(0)" ::: "memory");
        }
    }
    __syncthreads();
}

struct Frame {
    LAS unsigned char* lds;
    gu32* ctl;
    int tid, lane, wave, vcu, G;
    float* out; unsigned char* ws;
};
__device__ __forceinline__ float wave_sum(float v) {
#pragma unroll
    for (int o = 1; o < 64; o <<= 1) v += __shfl_xor(v, o);
    return v;
}

struct InProjOrder {
    int G, c;
    __device__ __forceinline__ bool next(int i, pg8::Unit& u) const {
        const int NL = 128 * 23, NC = 8 * 11;
        const long L = (long)i * G + c; if (L >= NL + NC) return false;
        u.lbase = 0; u.nvalid = 0;
        if (L < NL) { const int wgid = pg8::xcd_remap((int)L, NL); const int nig = 8 * 23, gid = wgid / nig, fm = gid * 8; u.pm = fm + ((wgid % nig) % 8); u.pn = (wgid % nig) / 8; }
        else { const int r = (int)L - NL; u.pm = 128 + r / 11; const int q = r % 11; u.pn = q < 10 ? q : 22; }
        return true;
    }
};
struct MoeOrder {
    int G, c, npn; const LAS int* tab;
    __device__ __forceinline__ bool next(int i, pg8::Unit& u) const {
        const int nT = __builtin_amdgcn_readfirstlane(tab[32]); const int nU = nT * npn;
        const long L = (long)i * G + c; if (L >= nU) return false;
        const int wgid = pg8::xcd_remap((int)L, nU);
        const int tau = wgid / npn, pl = wgid % npn;
        int e = 0;
        for (int k = 1; k < 32; ++k) e += (__builtin_amdgcn_readfirstlane(tab[k]) <= tau) ? 1 : 0;
        const int il = tau - __builtin_amdgcn_readfirstlane(tab[e]);
        u.pm = tau; u.pn = e * npn + pl; u.lbase = e * ML + 256 * il; u.nvalid = __builtin_amdgcn_readfirstlane(tab[33 + e]) - 256 * il;
        return true;
    }
};
__device__ __forceinline__ void moe_tables(Frame& F) {
    LAS int* tab = (LAS int*)(F.lds + TAB_OFF);
    __syncthreads();
    if (F.tid < 32) tab[33 + F.tid] = (int)__hip_atomic_load(F.ctl + CW_CNT + 64 * F.tid, RLX_AGENT);
    __syncthreads();
    if (F.tid == 0) {
        int acc = 0;
        for (int e = 0; e < 32; ++e) { tab[e] = acc; acc += (tab[33 + e] + 255) >> 8; }
        tab[32] = acc;
    }
    __syncthreads();
}

using pg8::f32x4; using pg8::u32x4; using pg8::cvt_pk_bf16;
#define EPI_ROWS(u) const int row0 = (u).pm * 256 + wr * 64 + fr
#define EPI_LOOP _Pragma("unroll") for (int ai = 0; ai < 2; ++ai) _Pragma("unroll") for (int m = 0; m < 4; ++m)
__device__ __forceinline__ u32x4 pack8(const f32x4 a, const f32x4 b) { u32x4 w; w.x = cvt_pk_bf16(a[0], a[1]); w.y = cvt_pk_bf16(a[2], a[3]); w.z = cvt_pk_bf16(b[0], b[1]); w.w = cvt_pk_bf16(b[2], b[3]); return w; }
__device__ __forceinline__ void unpack8(const u32x4 w, f32x4& a, f32x4& b) { a = (f32x4){bflo(w.x), bfhi(w.x), bflo(w.y), bfhi(w.y)}; b = (f32x4){bflo(w.z), bfhi(w.z), bflo(w.w), bfhi(w.w)}; }
__device__ __forceinline__ f32x4 sig4(f32x4 x) { return (f32x4){sigmoidf_(x[0]), sigmoidf_(x[1]), sigmoidf_(x[2]), sigmoidf_(x[3])}; }

struct EpiStore {
    static constexpr bool PERM = true; bf16* O; int ldc;
    __device__ __forceinline__ void operator()(const f32x4 (&acc)[2][2][4][2], const pg8::Unit& u, int wr, int wc, int fr, int fq) const {
        EPI_ROWS(u); const int col0 = u.pn * 256 + wc * 32 + 8 * fq;
        EPI_LOOP { bf16* rowp = O + (size_t)(row0 + ai * 128 + m * 16) * ldc + col0;
#pragma unroll
            for (int bj = 0; bj < 2; ++bj) *(u32x4*)(rowp + bj * 128) = pack8(acc[ai][bj][m][0], acc[ai][bj][m][1]); }
    }
};
struct EpiGlu {
    static constexpr bool PERM = true; const bf16* A2; bf16* A3; const float* bias;
    __device__ __forceinline__ void operator()(const f32x4 (&acc)[2][2][4][2], const pg8::Unit& u, int wr, int wc, int fr, int fq) const {
        EPI_ROWS(u); const int col0 = u.pn * 256 + wc * 32 + 8 * fq;
        f32x4 bv[2][2];
#pragma unroll
        for (int bj = 0; bj < 2; ++bj)
#pragma unroll
            for (int n = 0; n < 2; ++n) bv[bj][n] = *(const f32x4*)(bias + col0 + bj * 128 + 4 * n);
        EPI_LOOP { const size_t off = (size_t)(row0 + ai * 128 + m * 16) * 512 + col0;
#pragma unroll
            for (int bj = 0; bj < 2; ++bj) { f32x4 a0, a1; unpack8(*(const u32x4*)(A2 + off + bj * 128), a0, a1);
                const f32x4 v0 = a0 * sig4(acc[ai][bj][m][0] + bv[bj][0]), v1 = a1 * sig4(acc[ai][bj][m][1] + bv[bj][1]);
                *(u32x4*)(A3 + off + bj * 128) = pack8(v0, v1); } }
    }
};
template <bool ADD> struct EpiGate {
    static constexpr bool PERM = true; const bf16* proj; int gc0; const float* bg; const bf16* Prev; bf16* O;
    __device__ __forceinline__ void operator()(const f32x4 (&acc)[2][2][4][2], const pg8::Unit& u, int wr, int wc, int fr, int fq) const {
        EPI_ROWS(u); const int col0 = u.pn * 256 + wc * 32 + 8 * fq;
        f32x4 bv[2][2];
#pragma unroll
        for (int bj = 0; bj < 2; ++bj)
#pragma unroll
            for (int n = 0; n < 2; ++n) bv[bj][n] = *(const f32x4*)(bg + col0 + bj * 128 + 4 * n);
        EPI_LOOP { const int row = row0 + ai * 128 + m * 16; const size_t off = (size_t)row * 1024 + col0; const size_t poff = (size_t)row * LDP + gc0 + col0;
#pragma unroll
            for (int bj = 0; bj < 2; ++bj) { f32x4 g0, g1; unpack8(*(const u32x4*)(proj + poff + bj * 128), g0, g1);
                f32x4 v0 = sig4(g0 + bv[bj][0]) * acc[ai][bj][m][0], v1 = sig4(g1 + bv[bj][1]) * acc[ai][bj][m][1];
                if (ADD) { f32x4 p0, p1; unpack8(*(const u32x4*)(Prev + off + bj * 128), p0, p1); v0 += p0; v1 += p1; }
                *(u32x4*)(O + off + bj * 128) = pack8(v0, v1); } }
    }
};
struct EpiX1 {
    static constexpr bool PERM = false; const float* x; const float* mod; float* X1;
    __device__ __forceinline__ void operator()(const f32x4 (&acc)[2][2][4][2], const pg8::Unit& u, int wr, int wc, int fr, int fq) const {
        EPI_ROWS(u); const int col0 = u.pn * 256 + wc * 32 + 4 * fq; const int b = (u.pm * 256) / SEQ;
        f32x4 gv[2][2];
#pragma unroll
        for (int bj = 0; bj < 2; ++bj)
#pragma unroll
            for (int n = 0; n < 2; ++n) gv[bj][n] = *(const f32x4*)(mod + b * 6144 + 2 * D + col0 + bj * 128 + n * 16);
        EPI_LOOP { const size_t off = (size_t)(row0 + ai * 128 + m * 16) * D + col0;
#pragma unroll
            for (int bj = 0; bj < 2; ++bj)
#pragma unroll
                for (int n = 0; n < 2; ++n) *(f32x4*)(X1 + off + bj * 128 + n * 16) = *(const f32x4*)(x + off + bj * 128 + n * 16) + gv[bj][n] * acc[ai][bj][m][n]; }
    }
};
struct EpiSwiglu {
    static constexpr bool PERM = true; const float* bin; bf16* ACT;
    __device__ __forceinline__ void operator()(const f32x4 (&acc)[2][2][4][2], const pg8::Unit& u, int wr, int wc, int fr, int fq) const {
        EPI_ROWS(u); const int e = u.pn >> 3, pl = u.pn & 7; const int f0 = pl * 128 + wc * 32 + 8 * fq;
        f32x4 bg[2], bl[2];
#pragma unroll
        for (int n = 0; n < 2; ++n) { bg[n] = *(const f32x4*)(bin + e * 2048 + f0 + 4 * n); bl[n] = *(const f32x4*)(bin + e * 2048 + 1024 + f0 + 4 * n); }
        EPI_LOOP { f32x4 o[2];
#pragma unroll
            for (int n = 0; n < 2; ++n) { const f32x4 zg = acc[ai][0][m][n] + bg[n], zl = acc[ai][1][m][n] + bl[n];
#pragma unroll
                for (int j = 0; j < 4; ++j) { const float gl = fminf(zg[j], 7.0f); const float li = fminf(fmaxf(zl[j], -7.0f), 7.0f); o[n][j] = gl * sigmoidf_(1.702f * gl) * (li + 1.0f); } }
            *(v2u*)((unsigned char*)ACT + (size_t)(row0 + ai * 128 + m * 16) * 1024 + f0) = (v2u){pk4_fp8(8.f * o[0][0], 8.f * o[0][1], 8.f * o[0][2], 8.f * o[0][3]), pk4_fp8(8.f * o[1][0], 8.f * o[1][1], 8.f * o[1][2], 8.f * o[1][3])}; }
    }
};
struct EpiY {
    static constexpr bool PERM = true; const float* bout; bf16* Y;
    __device__ __forceinline__ void operator()(const f32x4 (&acc)[2][2][4][2], const pg8::Unit& u, int wr, int wc, int fr, int fq) const {
        EPI_ROWS(u); const int e = u.pn >> 2, pl = u.pn & 3; const int col0 = pl * 256 + wc * 32 + 8 * fq;
        f32x4 bv[2][2];
#pragma unroll
        for (int bj = 0; bj < 2; ++bj)
#pragma unroll
            for (int n = 0; n < 2; ++n) bv[bj][n] = *(const f32x4*)(bout + e * 1024 + col0 + bj * 128 + 4 * n);
        EPI_LOOP { bf16* rowp = Y + (size_t)(row0 + ai * 128 + m * 16) * 1024 + col0;
#pragma unroll
            for (int bj = 0; bj < 2; ++bj) *(u32x4*)(rowp + bj * 128) = pack8(acc[ai][bj][m][0] + bv[bj][0], acc[ai][bj][m][1] + bv[bj][1]); }
    }
};

struct TItem { const float* src; bf16* dst; int ld, ldk; int f8; };
__device__ __forceinline__ void titem_load(const TItem& t, int lane, f32x4 (&r)[8]) {
#pragma unroll
    for (int i = 0; i < 8; ++i) r[i] = *(const f32x4*)(t.src + (size_t)(8 * i + (lane >> 3)) * t.ld + 4 * (lane & 7));
}
__device__ __forceinline__ void titem_store(const TItem& t, int lane, const f32x4 (&r)[8], LAS float* scr) {
#pragma unroll
    for (int i = 0; i < 8; ++i) { LAS float* p = scr + (8 * i + (lane >> 3)) * 33 + 4 * (lane & 7); p[0] = r[i][0]; p[1] = r[i][1]; p[2] = r[i][2]; p[3] = r[i][3]; }
    LDS_WAIT(); asm volatile("" ::: "memory");
    const int c = lane & 7;
#pragma unroll
    for (int j = 0; j < 4; ++j) { const int n = (lane >> 3) + 8 * j; const LAS float* s = scr + (8 * c) * 33 + n;
        if (t.f8) { *(GAS v2u*)((unsigned char*)t.dst + (size_t)n * t.ldk + 8 * c) = (v2u){pk4_fp8(32.f * s[0 * 33], 32.f * s[1 * 33], 32.f * s[2 * 33], 32.f * s[3 * 33]), pk4_fp8(32.f * s[4 * 33], 32.f * s[5 * 33], 32.f * s[6 * 33], 32.f * s[7 * 33])}; }
        else { v4u o; o.x = pk2(s[0 * 33], s[1 * 33]); o.y = pk2(s[2 * 33], s[3 * 33]); o.z = pk2(s[4 * 33], s[5 * 33]); o.w = pk2(s[6 * 33], s[7 * 33]);
            *(GAS v4u*)(t.dst + (size_t)n * t.ldk + 8 * c) = o; } }
    LDS_WAIT(); asm volatile("" ::: "memory");
}
__device__ __forceinline__ void p0_prologue(Frame& F, const float* const* __restrict__ INP) {
    {
        LAS float* sc = (LAS float*)(F.lds);
        LAS float* red = (LAS float*)(F.lds + 9 * 1024 * 4);
        for (int i = F.tid; i < 9 * 1024; i += NWAVES * 64) { const int r = i >> 10, k = i & 1023; const float v = r < 8 ? INP[1][r * 1024 + k] : INP[3][k]; sc[i] = v / (1.0f + __expf(-v)); }
        __syncthreads();
        const float* wada = INP[4]; const float* bada = INP[5];
        float* mod = (float*)(F.ws + WS_MOD);
        for (int cg = blockIdx.x; cg < 256; cg += F.G) {
            const int j0 = cg * 24, col = F.lane & 31, kp = F.lane >> 5;
            float a[9];
#pragma unroll
            for (int r = 0; r < 9; ++r) a[r] = 0.f;
            if (col < 24) {
                for (int i = 0; i < 64; ++i) { const int k = F.wave * 128 + 2 * i + kp; const float wv = wada[(size_t)k * 6144 + j0 + col];
#pragma unroll
                    for (int r = 0; r < 9; ++r) a[r] += sc[r * 1024 + k] * wv; }
            }
#pragma unroll
            for (int r = 0; r < 9; ++r) red[((F.wave * 2 + kp) * 9 + r) * 32 + col] = a[r];
            __syncthreads();
            if (F.tid < 9 * 32) { const int r = F.tid >> 5, cc = F.tid & 31;
                if (cc < 24) { float s = 0.f; for (int p = 0; p < 16; ++p) s += red[(p * 9 + r) * 32 + cc]; const int j = j0 + cc; s += bada[j];
                    if (r < 8) mod[r * 6144 + j] = s; else if (j < 2048) mod[8 * 6144 + j] = s; } }
            __syncthreads();
        }
    }
    LAS float* scr = (LAS float*)(F.lds + F.wave * 16384);
    const int gw = F.vcu * NWAVES + F.wave, NGW = F.G * NWAVES;
    bf16* WIN = (bf16*)(F.ws + WS_WIN); bf16* WGLU = (bf16*)(F.ws + WS_WGLU); bf16* WA = (bf16*)(F.ws + WS_WA); bf16* WB = (bf16*)(F.ws + WS_WB); bf16* WO = (bf16*)(F.ws + WS_WO);
    bf16* WEIN = (bf16*)(F.ws + WS_WEIN); bf16* WEOUT = (bf16*)(F.ws + WS_WEOUT);
    constexpr int I_IN = 177 * 16, I_GLU = 16 * 8, I_A = 32 * 16, I_B = 32 * 8, I_O = 32 * 16, I_EIN = 32 * 64 * 16, I_EOUT = 32 * 32 * 16;
    constexpr int NITEMS = I_IN + I_GLU + I_A + I_B + I_O + I_EIN + I_EOUT;
#define P0_DECODE(it_, T) do { int r = (it_); \
        if (r < I_IN) { const int kb = r / 177, nb = r % 177, n0 = nb * 32; const int sc0 = n0 < 2048 ? n0 : (n0 < 5632 ? n0 + 32 : 2048); \
            T.src = INP[8] + (size_t)kb * 64 * 5664 + sc0; T.ld = 5664; T.dst = (bf16*)((unsigned char*)WIN + (size_t)n0 * 1024 + kb * 64); T.ldk = 1024; T.f8 = 1; break; } r -= I_IN; \
        if (r < I_GLU) { const int kb = r / 16, nb = r % 16; T.src = INP[21] + (size_t)kb * 64 * 512 + nb * 32; T.ld = 512; T.dst = WGLU + (size_t)nb * 32 * 512 + kb * 64; T.ldk = 512; T.f8 = 0; break; } r -= I_GLU; \
        if (r < I_A) { const int kb = r / 32, nb = r % 32; T.src = INP[12] + (size_t)kb * 64 * 1024 + nb * 32; T.ld = 1024; T.dst = WA + (size_t)nb * 32 * 1024 + kb * 64; T.ldk = 1024; T.f8 = 0; break; } r -= I_A; \
        if (r < I_B) { const int kb = r / 32, nb = r % 32; T.src = INP[23] + (size_t)kb * 64 * 1024 + nb * 32; T.ld = 1024; T.dst = WB + (size_t)nb * 32 * 512 + kb * 64; T.ldk = 512; T.f8 = 0; break; } r -= I_B; \
        if (r < I_O) { const int kb = r / 32, nb = r % 32; T.src = INP[25] + (size_t)kb * 64 * 1024 + nb * 32; T.ld = 1024; T.dst = WO + (size_t)nb * 32 * 1024 + kb * 64; T.ldk = 1024; T.f8 = 0; break; } r -= I_O; \
        if (r < I_EIN) { const int e = r / 1024, q = r % 1024, kb = q / 64, nb = q % 64; const int dr = nb * 32, pn = dr >> 8, bj = (dr >> 7) & 1, xx = dr & 127; \
            T.src = INP[28] + (size_t)e * 1024 * 2048 + (size_t)kb * 64 * 2048 + bj * 1024 + pn * 128 + xx; T.ld = 2048; T.dst = (bf16*)((unsigned char*)WEIN + (size_t)e * 2048 * 1024 + (size_t)dr * 1024 + kb * 64); T.ldk = 1024; T.f8 = 1; break; } r -= I_EIN; \
        { const int e = r / 512, q = r % 512, kb = q / 32, nb = q % 32; \
            T.src = INP[30] + (size_t)e * 1024 * 1024 + (size_t)kb * 64 * 1024 + nb * 32; T.ld = 1024; T.dst = (bf16*)((unsigned char*)WEOUT + (size_t)e * 1024 * 1024 + (size_t)nb * 32 * 1024 + kb * 64); T.ldk = 1024; T.f8 = 1; } } while (0)
    {
        TItem ta, tb; f32x4 ra[8], rb[8];
        int it = gw;
        if (it < NITEMS) { P0_DECODE(it, ta); titem_load(ta, F.lane, ra); }
        while (it < NITEMS) {
            const int nx = it + NGW;
            if (nx < NITEMS) { P0_DECODE(nx, tb); titem_load(tb, F.lane, rb); }
            titem_store(ta, F.lane, ra, scr);
            ta = tb;
#pragma unroll
            for (int i = 0; i < 8; ++i) ra[i] = rb[i];
            it = nx;
        }
    }
#undef P0_DECODE
    { const int gt = blockIdx.x * (NWAVES * 64) + F.tid, NT = F.G * NWAVES * 64; GAS v4u* z = (GAS v4u*)((unsigned char*)WIN + (size_t)5664 * 1024);
        for (int i = gt; i < 224 * 1024 / 16; i += NT) z[i] = (v4u){0u, 0u, 0u, 0u}; }
}

__device__ __forceinline__ void p1_norm1(Frame& F, const float* const* __restrict__ INP) {
    const int gw = F.vcu * NWAVES + F.wave, NGW = F.G * NWAVES;
    const float* mod = (const float*)(F.ws + WS_MOD); bf16* H1 = (bf16*)(F.ws + WS_H1);
    for (int m = gw; m < MT; m += NGW) {
        const float* xr; const float* sh; const float* scl;
        if (m < ML) { const int b = m / SEQ; xr = INP[0] + (size_t)m * D; sh = mod + b * 6144; scl = sh + D; }
        else { xr = INP[2] + (size_t)(m - ML) * D; sh = mod + 8 * 6144; scl = sh + D; }
        f32x4 v[4]; float s = 0.f;
#pragma unroll
        for (int j = 0; j < 4; ++j) { v[j] = *(const f32x4*)(xr + 256 * j + 4 * F.lane); s += (v[j][0] * v[j][0] + v[j][1] * v[j][1]) + (v[j][2] * v[j][2] + v[j][3] * v[j][3]); }
        const float rstd = 1.0f / sqrtf(wave_sum(s) * (1.0f / D) + EPS);
#pragma unroll
        for (int j = 0; j < 4; ++j) { const int c = 256 * j + 4 * F.lane; const f32x4 g = *(const f32x4*)(INP[6] + c), a = *(const f32x4*)(scl + c), bb = *(const f32x4*)(sh + c);
            const f32x4 y = v[j] * rstd * g * (a + 1.0f) + bb;
            *(unsigned*)((unsigned char*)H1 + (size_t)m * D + c) = pk4_fp8(y[0], y[1], y[2], y[3]); }
    }
}

__device__ __forceinline__ void conv_fma8(float (&a)[8], const v4u x, const float* wp) {
    const f32x4 w0 = *(const f32x4*)(wp), w1 = *(const f32x4*)(wp + 4);
    a[0] += bflo(x.x) * w0[0]; a[1] += bfhi(x.x) * w0[1]; a[2] += bflo(x.y) * w0[2]; a[3] += bfhi(x.y) * w0[3];
    a[4] += bflo(x.z) * w1[0]; a[5] += bfhi(x.z) * w1[1]; a[6] += bflo(x.w) * w1[2]; a[7] += bfhi(x.w) * w1[3];
}
__device__ __forceinline__ void p3_conv(Frame& F, const float* const* __restrict__ INP) {
    const bf16* PROJ = (const bf16*)(F.ws + WS_PROJ); bf16* QKC = (bf16*)(F.ws + WS_QKC); const float* wc = INP[9];
    const int NT = F.G * NWAVES * 64;
    for (int it = F.vcu * (NWAVES * 64) + F.tid; it < NB * 64 * 4 * 128; it += NT) {
        const int ch0 = (it & 127) * 8, seg = (it >> 7) & 3, gr = (it >> 9) & 63, b = it >> 15, c0 = seg * 16;
        const bf16* base = PROJ + (size_t)(b * SEQ) * LDP + ch0;
        const float scale = ch0 < 512 ? 0.125f : 1.0f;
        v4u win[3][3];
        const v4u z = (v4u){0u, 0u, 0u, 0u};
#define P3_LOADCOL(slot, cc) do { _Pragma("unroll") for (int ky = 0; ky < 3; ++ky) { const int rr = gr + ky - 1; \
            win[slot][ky] = (rr >= 0 && rr < 64 && (cc) >= 0 && (cc) < 64) ? *(const v4u*)(base + (size_t)(rr * 64 + (cc)) * LDP) : z; } } while (0)
        P3_LOADCOL(0, c0 - 1); P3_LOADCOL(1, c0);
#pragma unroll
        for (int cc = 0; cc < 16; ++cc) {
            const int c = c0 + cc;
            P3_LOADCOL((cc + 2) % 3, c + 1);
            float a[8];
#pragma unroll
            for (int j = 0; j < 8; ++j) a[j] = 0.f;
#pragma unroll
            for (int ky = 0; ky < 3; ++ky)
#pragma unroll
                for (int kx = 0; kx < 3; ++kx) conv_fma8(a, win[(cc + kx) % 3][ky], wc + (ky * 3 + kx) * 1024 + ch0);
#pragma unroll
            for (int j = 0; j < 8; ++j) a[j] = a[j] / (1.0f + __expf(-a[j])) * scale;
            *(v4u*)(QKC + (size_t)(b * SEQ + gr * 64 + c) * 1024 + ch0) = (v4u){pk2(a[0], a[1]), pk2(a[2], a[3]), pk2(a[4], a[5]), pk2(a[6], a[7])};
        }
#undef P3_LOADCOL
    }
    for (int w = F.vcu * (NWAVES * 64) + F.tid; w < MC * 128; w += NT) {
        const int row = ML + (w >> 7), ch0 = (w & 127) * 8, t = (w >> 7) % CTXL;
        float a[8];
#pragma unroll
        for (int j = 0; j < 8; ++j) a[j] = 0.f;
#pragma unroll
        for (int kx = 0; kx < 3; ++kx) { const int tt = t + kx - 1;
            if (tt >= 0 && tt < CTXL) conv_fma8(a, *(const v4u*)(PROJ + (size_t)(row + kx - 1) * LDP + ch0), wc + (3 + kx) * 1024 + ch0); }
        const float scale = ch0 < 512 ? 0.125f : 1.0f;
#pragma unroll
        for (int j = 0; j < 8; ++j) a[j] = a[j] / (1.0f + __expf(-a[j])) * scale;
        *(v4u*)(QKC + (size_t)row * 1024 + ch0) = (v4u){pk2(a[0], a[1]), pk2(a[2], a[3]), pk2(a[4], a[5]), pk2(a[6], a[7])};
    }
    {
        float* GB = (float*)(F.ws + WS_GS); float* GG = GB + 128 * 4352; float* GP = GG + 128 * 4352;
        const int gw = F.vcu * NWAVES + F.wave, NGW = F.G * NWAVES, lane = F.lane;
        for (int it = gw; it < 128 * 34; it += NGW) {
            const int jc = it % 34, dbh = it / 34, h = dbh & 7, b = (dbh >> 3) & 7, d = dbh >> 6;
            const bool lat = jc >= 2; const int p0 = lat ? 128 * (jc - 2) : 128 * jc, Lseq = lat ? SEQ : CTXL, rowbase = lat ? b * SEQ : ML + b * CTXL;
            const float bi_ = INP[10][d * 16 + h], bf_ = INP[10][d * 16 + 8 + h];
            float li2[2], lf2[2];
#pragma unroll
            for (int e = 0; e < 2; ++e) { const int sp = 2 * lane + e; const int tt = d ? (Lseq - 1 - (p0 + sp)) : (p0 + sp); const size_t row = (size_t)(rowbase + tt);
                li2[e] = bf2f(PROJ[row * LDP + PC_IF + d * 16 + h]) + bi_; const float xf = bf2f(PROJ[row * LDP + PC_IF + d * 16 + 8 + h]) + bf_;
                lf2[e] = fminf(xf, 0.f) - log1pf(expf(-fabsf(xf))); }
            const float c1 = lf2[0] + lf2[1]; float inc = c1;
#pragma unroll
            for (int o = 1; o < 64; o <<= 1) { const float t = __shfl_up(inc, o); if (lane >= o) inc += t; }
            const float exc = inc - c1, b0 = exc + lf2[0], b1 = exc + c1, g0 = li2[0] - b0, g1 = li2[1] - b1;
            float pmx = fmaxf(g0, g1);
#pragma unroll
            for (int o = 1; o < 64; o <<= 1) { const float t = __shfl_up(pmx, o); if (lane >= o) pmx = fmaxf(pmx, t); }
            float pex = __shfl_up(pmx, 1); if (lane == 0) pex = -INFINITY;
            const size_t o = (size_t)dbh * 4352 + 128 * jc + 2 * lane;
            *(float2*)(GB + o) = make_float2(b0, b1); *(float2*)(GG + o) = make_float2(g0, g1); *(float2*)(GP + o) = make_float2(fmaxf(pex, g0), pmx);
        }
    }
}

__device__ __forceinline__ void mma32_nt(f32x16& acc, const LAS bf16* A, int lda, const LAS bf16* Bt, int ldb, int K, int lane) {
    const int r = lane & 31, h = lane >> 5;
#pragma unroll
    for (int k0 = 0; k0 < K; k0 += 16) {
        const bf16x8 a = *(const LAS bf16x8*)(A + r * lda + k0 + 8 * h);
        const bf16x8 b = *(const LAS bf16x8*)(Bt + r * ldb + k0 + 8 * h);
        acc = __builtin_amdgcn_mfma_f32_32x32x16_bf16(a, b, acc, 0, 0, 0);
        if ((k0 & 63) == 48) __builtin_amdgcn_sched_barrier(0);
    }
}
__device__ __forceinline__ void mma16_nt(f32x4& acc, const LAS bf16* A, int lda, const LAS bf16* Bt, int ldb, int K, int lane) {
    const int r = lane & 15, q = lane >> 4;
    for (int k0 = 0; k0 < K; k0 += 32) {
        const bf16x8 a = *(const LAS bf16x8*)(A + r * lda + k0 + 8 * q);
        const bf16x8 b = *(const LAS bf16x8*)(Bt + r * ldb + k0 + 8 * q);
        acc = __builtin_amdgcn_mfma_f32_16x16x32_bf16(a, b, acc, 0, 0, 0);
    }
}
__device__ __forceinline__ int row32(int reg, int lane) { return (reg & 3) + 8 * (reg >> 2) + 4 * (lane >> 5); }
__device__ __forceinline__ float logsigmoidf_(float x) { return fminf(x, 0.f) - log1pf(expf(-fabsf(x))); }

typedef short s16x4 __attribute__((ext_vector_type(4)));
__device__ __forceinline__ s16x4 tr_read(const LAS bf16* p) { return __builtin_amdgcn_ds_read_tr16_b64_v4i16((LAS s16x4*)p); }
__device__ __forceinline__ bf16x8 tr_frag32_perm(const LAS bf16* T, int ld, int k0, int x0, int lane) {
    const int h = lane >> 5, i = lane & 15, q = i >> 2, p = i & 3, xb = 16 * ((lane >> 4) & 1);
    const LAS bf16* a = T + (k0 + 4 * h + q) * ld + x0 + xb + 4 * p;
    const s16x4 lo = tr_read(a), hi = tr_read(a + 8 * ld);
    return (bf16x8){lo[0], lo[1], lo[2], lo[3], hi[0], hi[1], hi[2], hi[3]};
}
__device__ __forceinline__ bf16x8 tr_frag16(const LAS bf16* T, int ld, int k0, int x0, int lane) {
    const int q4 = lane >> 4, i = lane & 15, q = i >> 2, p = i & 3;
    const LAS bf16* a = T + (k0 + 8 * q4 + q) * ld + x0 + 4 * p;
    const s16x4 lo = tr_read(a), hi = tr_read(a + 4 * ld);
    return (bf16x8){lo[0], lo[1], lo[2], lo[3], hi[0], hi[1], hi[2], hi[3]};
}
__device__ __forceinline__ v4u scale8(const v4u k8, float ww) {
    return (v4u){pk2(ww * bflo(k8.x), ww * bfhi(k8.x)), pk2(ww * bflo(k8.y), ww * bfhi(k8.y)), pk2(ww * bflo(k8.z), ww * bfhi(k8.z)), pk2(ww * bflo(k8.w), ww * bfhi(k8.w))};
}

template <int MODE>
__device__ __forceinline__ void p4_mlstm(Frame& F, const float* const* __restrict__ INP, int unit) {
    const int vh = unit & 1, h = (unit >> 1) & 7, b = (unit >> 4) & 7, d = unit >> 7;
    LAS bf16* Qs = (LAS bf16*)(F.lds + 0);
    LAS bf16* Ks = (LAS bf16*)(F.lds + 18432);
    LAS bf16* Kw = (LAS bf16*)(F.lds + 36864);
    LAS bf16* Vs = (LAS bf16*)(F.lds + 55296);
    LAS bf16* Cb = (LAS bf16*)(F.lds + 73728);
    LAS float* vec = (LAS float*)(F.lds + 82944);
    LAS float *rowt = vec, *colt = vec + 128, *iev = vec + 256, *emt = vec + 384, *nv = vec + 512, *npart = vec + 576;
    const bf16* PROJ = (const bf16*)(F.ws + WS_PROJ); const bf16* QKC = (const bf16*)(F.ws + WS_QKC); bf16* HDIR = (bf16*)(F.ws + WS_HDIR) + (size_t)d * ML * 1024;
    const float* GB = (const float*)(F.ws + WS_GS) + (size_t)((d * 8 + b) * 8 + h) * 4352; const float* GG = GB + 128 * 4352; const float* GP = GG + 128 * 4352;
    int tid = F.tid; asm volatile("" : "+v"(tid));
    const int lane = tid & 63, w = F.wave;
    for (int i = tid; i < 64 * 72; i += 512) Cb[i] = 0;
    if (tid < 64) nv[tid] = 0.f;
    f32x4 accC[2] = {(f32x4){0.f, 0.f, 0.f, 0.f}, (f32x4){0.f, 0.f, 0.f, 0.f}};
    float m_old = 0.f, dec_prev = 0.f;
    v4u pq[2], pk[2], pv[2]; float pgb = 0.f, pgp = 0.f, pgc = 0.f, pgg[2], pbend, pgmax; v2u hout[4]; bf16* hptr = nullptr; bool hpend = false;
    const int zl = tid >> 9;
#define ML_PREFETCH(jn) do { const bool lat_ = (jn) >= 2; const int p0_ = lat_ ? 128 * ((jn) - 2) : 128 * (jn), L_ = lat_ ? SEQ : CTXL, rb_ = lat_ ? b * SEQ : ML + b * CTXL; \
        _Pragma("unroll") for (int i = 0; i < 2; ++i) { const int id = tid + 512 * i, s_ = id >> 3, c_ = id & 7; const int tt = d ? (L_ - 1 - (p0_ + s_)) : (p0_ + s_); const size_t row = (size_t)(rb_ + tt); \
            pq[i] = *(const v4u*)(QKC + row * 1024 + h * 64 + c_ * 8); pk[i] = *(const v4u*)(QKC + row * 1024 + 512 + h * 64 + c_ * 8); pv[i] = *(const v4u*)(PROJ + row * LDP + PC_V + h * 128 + vh * 64 + c_ * 8); \
            pgg[i] = GG[128 * (jn) + s_]; } \
        if (tid < 128) { pgb = GB[128 * (jn) + tid]; pgp = GP[128 * (jn) + tid]; pgc = GG[128 * (jn) + tid]; } \
        pbend = GB[128 * (jn) + 127 + zl]; pgmax = GP[128 * (jn) + 127 + zl]; } while (0)
    ML_PREFETCH(0);
    __syncthreads();
    for (int j = 0; j < 34; ++j) {
        const bool lat = j >= 2;
        const int p0 = lat ? 128 * (j - 2) : 128 * j, Lseq = lat ? SEQ : CTXL, rowbase = lat ? b * SEQ : ML + b * CTXL;
        const float bend = pbend, gmax = pgmax;
        const float mnew = fmaxf(bend + m_old, bend + gmax), dec = __expf(bend + m_old - mnew);
#pragma unroll
        for (int i = 0; i < 2; ++i) { const int id = tid + 512 * i, s = id >> 3, c = id & 7;
            *(LAS v4u*)(Qs + s * 72 + c * 8) = pq[i]; *(LAS v4u*)(Ks + s * 72 + c * 8) = pk[i]; *(LAS v4u*)(Vs + s * 72 + c * 8) = pv[i];
            *(LAS v4u*)(Kw + s * 72 + c * 8) = scale8(pk[i], __expf(bend + pgg[i] - mnew)); }
        if (tid < 128) { const float r = fmaxf(m_old, pgp); rowt[tid] = -r * 1.44269504089f; colt[tid] = pgc * 1.44269504089f; iev[tid] = __expf(m_old - r); emt[tid] = __expf(-pgb - r); }
        if (j > 0) {
            const int vi = w >> 1;
#pragma unroll
            for (int jj = 0; jj < 2; ++jj) { const int ki = 2 * (w & 1) + jj;
#pragma unroll
                for (int reg = 0; reg < 4; ++reg) Cb[(16 * vi + (lane >> 4) * 4 + reg) * 72 + 16 * ki + (lane & 15)] = (bf16)f2bf(accC[jj][reg]); }
            if (tid < 64) { float sacc = 0.f;
#pragma unroll
                for (int p = 0; p < 8; ++p) sacc += npart[p * 64 + tid];
                nv[tid] = dec_prev * nv[tid] + sacc; }
        }
        LBAR();
        if (j + 1 < 34 && !(MODE & 4)) ML_PREFETCH(j + 1);
        if (hpend) {
#pragma unroll
            for (int rg = 0; rg < 4; ++rg) *(v2u*)(hptr + 8 * rg) = hout[rg];
            hpend = false; }
        if (lat && !(MODE & 1)) { const int tm = w >> 1, vt = w & 1, tl = lane & 31, t = 32 * tm + tl, hh = lane >> 5; f32x16 acc;
#pragma unroll
            for (int reg = 0; reg < 16; ++reg) acc[reg] = 0.f;
            mma32_nt(acc, Cb + 32 * vt * 72, 72, Qs + 32 * tm * 72, 72, 64, lane);
            const float ie = iev[t], rt = rowt[t];
#pragma unroll
            for (int reg = 0; reg < 16; ++reg) acc[reg] *= ie;
            float rs = 0.f;
            for (int st = (MODE & 8) ? tm : 0; st <= tm; ++st) {
                f32x16 X;
#pragma unroll
                for (int reg = 0; reg < 16; ++reg) X[reg] = 0.f;
                mma32_nt(X, Ks + 32 * st * 72, 72, Qs + 32 * tm * 72, 72, 64, lane);
                const LAS float* cp = colt + 32 * st + 4 * hh;
                if (st == tm) { const int dlim = tl - 4 * hh;
#pragma unroll
                    for (int rg = 0; rg < 4; ++rg) { const f32x4 c4 = *(const LAS f32x4*)(cp + 8 * rg);
#pragma unroll
                        for (int e = 0; e < 4; ++e) { const float arg = (8 * rg + e <= dlim) ? c4[e] + rt : -INFINITY; const float pvv = X[4 * rg + e] * __builtin_amdgcn_exp2f(arg); X[4 * rg + e] = pvv; rs += pvv; } }
                } else {
#pragma unroll
                    for (int rg = 0; rg < 4; ++rg) { const f32x4 c4 = *(const LAS f32x4*)(cp + 8 * rg);
#pragma unroll
                        for (int e = 0; e < 4; ++e) { const float pvv = X[4 * rg + e] * __builtin_amdgcn_exp2f(c4[e] + rt); X[4 * rg + e] = pvv; rs += pvv; } }
                }
#pragma unroll
                for (int ks = 0; ks < 2; ++ks) {
                    const v4u bw = (v4u){cvtpk(X[8 * ks], X[8 * ks + 1]), cvtpk(X[8 * ks + 2], X[8 * ks + 3]), cvtpk(X[8 * ks + 4], X[8 * ks + 5]), cvtpk(X[8 * ks + 6], X[8 * ks + 7])};
                    const bf16x8 af = tr_frag32_perm(Vs, 72, 32 * st + 16 * ks, 32 * vt, lane);
                    acc = __builtin_amdgcn_mfma_f32_32x32x16_bf16(af, __builtin_bit_cast(bf16x8, bw), acc, 0, 0, 0); }
            }
            float nq = 0.f;
#pragma unroll
            for (int q = 0; q < 4; ++q) { const v4u q8 = *(const LAS v4u*)(Qs + t * 72 + 32 * hh + 8 * q); const LAS float* nn = nv + 32 * hh + 8 * q;
                nq += bflo(q8.x) * nn[0] + bfhi(q8.x) * nn[1] + bflo(q8.y) * nn[2] + bfhi(q8.y) * nn[3] + bflo(q8.z) * nn[4] + bfhi(q8.z) * nn[5] + bflo(q8.w) * nn[6] + bfhi(q8.w) * nn[7]; }
            rs += __shfl_xor(rs, 32); nq += __shfl_xor(nq, 32);
            const float rd = 1.0f / fmaxf(fabsf(ie * nq + rs), emt[t]);
            const int tt = d ? (Lseq - 1 - (p0 + t)) : (p0 + t);
            hptr = HDIR + (size_t)(rowbase + tt) * 1024 + h * 128 + vh * 64 + 32 * vt + 4 * hh;
#pragma unroll
            for (int rg = 0; rg < 4; ++rg) hout[rg] = (v2u){pk2(acc[4 * rg] * rd, acc[4 * rg + 1] * rd), pk2(acc[4 * rg + 2] * rd, acc[4 * rg + 3] * rd)};
            hpend = true; }
        if (!(MODE & 2)) { const int vi = w >> 1;
            accC[0] *= dec; accC[1] *= dec;
#pragma unroll
            for (int st4 = 0; st4 < 4; ++st4) { const bf16x8 af = tr_frag16(Vs, 72, 32 * st4, 16 * vi, lane);
#pragma unroll
                for (int jj = 0; jj < 2; ++jj) { const bf16x8 bfr = tr_frag16(Kw, 72, 32 * st4, 16 * (2 * (w & 1) + jj), lane); accC[jj] = __builtin_amdgcn_mfma_f32_16x16x32_bf16(af, bfr, accC[jj], 0, 0, 0); } } }
        { const int k = tid & 63, part = tid >> 6; float sacc = 0.f;
#pragma unroll
            for (int q = 0; q < 16; ++q) sacc += bf2f(Kw[(16 * part + q) * 72 + k]);
            npart[part * 64 + k] = sacc; }
        m_old = mnew; dec_prev = dec;
        LBAR();
    }
    if (hpend) {
#pragma unroll
        for (int rg = 0; rg < 4; ++rg) *(v2u*)(hptr + 8 * rg) = hout[rg]; }
#undef ML_PREFETCH
}

__device__ __forceinline__ void s5_disc(const float* const* __restrict__ INP, int d, int g, int p, float& ar, float& ai, float& cfr, float& cfi) {
    const float dt = expf(INP[15][d * 32 + g]); const float are = INP[13][(d * 32 + g) * 64 + p], aim = INP[14][(d * 32 + g) * 64 + p];
    const float mag = expf(dt * are), ang = dt * aim; ar = mag * cosf(ang); ai = mag * sinf(ang);
    const float den = are * are + aim * aim, xr = ar - 1.0f; cfr = (xr * are + ai * aim) / den; cfi = (ai * are - xr * aim) / den;
}
__device__ __forceinline__ void p4_s5(Frame& F, const float* const* __restrict__ INP, int unit) {
    const int gp = unit & 15, b = (unit >> 4) & 7, d = unit >> 7;
    LAS bf16* BHt = (LAS bf16*)(F.lds + 0);
    LAS bf16* Cm = (LAS bf16*)(F.lds + 69632);
    LAS float* Eb = (LAS float*)(F.lds + 78336);
    LAS bf16* Us = (LAS bf16*)(F.lds + 82432);
    LAS bf16* BBs = (LAS bf16*)(F.lds + 92672);
    const bf16* PROJ = (const bf16*)(F.ws + WS_PROJ); bf16* YDIR = (bf16*)(F.ws + WS_YDIR) + (size_t)d * ML * 512;
    int tid = F.tid; asm volatile("" : "+v"(tid));
    const int lane = tid & 63, w = F.wave;
    const int sg = tid & 127, seg = tid >> 7;
    float ar, ai, a32r, a32i;
    { float cfr, cfi; s5_disc(INP, d, 2 * gp + (sg >> 6), sg & 63, ar, ai, cfr, cfi); a32r = ar; a32i = ai;
#pragma unroll
        for (int q = 0; q < 5; ++q) { const float nr = a32r * a32r - a32i * a32i, ni = 2.0f * a32r * a32i; a32r = nr; a32i = ni; } }
    for (int idx = tid; idx < 4096; idx += 512) {
        { const int gg = idx >> 11, pp = (idx >> 4) & 127, c = idx & 15, g = 2 * gp + gg, p = pp & 63; float xr_, xi_, cfr, cfi; s5_disc(INP, d, g, p, xr_, xi_, cfr, cfi);
            const float bre = INP[16][((size_t)(d * 32 + g) * 64 + p) * 16 + c], bim = INP[17][((size_t)(d * 32 + g) * 64 + p) * 16 + c];
            BBs[(gg * 128 + pp) * 24 + c] = (bf16)f2bf(pp < 64 ? cfr * bre - cfi * bim : cfr * bim + cfi * bre); }
        { const int gg = idx >> 11, c = (idx >> 7) & 15, pp = idx & 127, g = 2 * gp + gg, p = pp & 63;
            const float v = pp < 64 ? INP[18][((size_t)(d * 32 + g) * 16 + c) * 64 + p] : -INP[19][((size_t)(d * 32 + g) * 16 + c) * 64 + p];
            Cm[(gg * 16 + c) * 136 + pp] = (bf16)f2bf(v); }
    }
    float h0r = 0.f, h0i = 0.f;
    LAS bf16* rowre = BHt + ((sg >> 6) * 128 + (sg & 63)) * 136 + 32 * seg;
    v4u pu; v2u yout[2]; bf16* yptr[2]; bool ypend = false;
#define S5_PREFETCH(jn) do { const bool lat_ = (jn) >= 2; const int p0_ = lat_ ? 128 * ((jn) - 2) : 128 * (jn), L_ = lat_ ? SEQ : CTXL, rb_ = lat_ ? b * SEQ : ML + b * CTXL; \
        const int s_ = tid >> 2, c_ = tid & 3; const int tt = d ? (L_ - 1 - (p0_ + s_)) : (p0_ + s_); pu = *(const v4u*)(PROJ + (size_t)(rb_ + tt) * LDP + PC_U + gp * 32 + c_ * 8); } while (0)
    S5_PREFETCH(0);
    __syncthreads();
    for (int j = 0; j < 34; ++j) {
        const bool lat = j >= 2;
        const int p0 = lat ? 128 * (j - 2) : 128 * j, Lseq = lat ? SEQ : CTXL, rowbase = lat ? b * SEQ : ML + b * CTXL;
        *(LAS v4u*)(Us + (tid >> 2) * 40 + (tid & 3) * 8) = pu;
        LBAR();
        if (j + 1 < 34) S5_PREFETCH(j + 1);
        if (ypend) { *(v2u*)yptr[0] = yout[0]; *(v2u*)yptr[1] = yout[1]; ypend = false; }
        { const int gg = w >> 2, tm = w & 3, r = lane & 31, hh = lane >> 5;
            const bf16x8 a = *(const LAS bf16x8*)(Us + (32 * tm + r) * 40 + gg * 16 + 8 * hh);
            LAS bf16* bp = BHt + (gg * 128 + r) * 136 + 32 * tm + 4 * hh;
#pragma unroll
            for (int tn = 0; tn < 4; ++tn) { f32x16 acc;
#pragma unroll
                for (int reg = 0; reg < 16; ++reg) acc[reg] = 0.f;
                const bf16x8 bb = *(const LAS bf16x8*)(BBs + (gg * 128 + 32 * tn + r) * 24 + 8 * hh);
                acc = __builtin_amdgcn_mfma_f32_32x32x16_bf16(a, bb, acc, 0, 0, 0);
#pragma unroll
                for (int rg = 0; rg < 4; ++rg) *(LAS v2u*)(bp + 32 * tn * 136 + 8 * rg) = (v2u){cvtpk(acc[4 * rg], acc[4 * rg + 1]), cvtpk(acc[4 * rg + 2], acc[4 * rg + 3])}; } }
        LBAR();
        v4u xr[4], xi[4];
#pragma unroll
        for (int q = 0; q < 4; ++q) { xr[q] = *(const LAS v4u*)(rowre + 8 * q); xi[q] = *(const LAS v4u*)(rowre + 64 * 136 + 8 * q); }
        { float hr = 0.f, hi = 0.f;
#pragma unroll
            for (int q = 0; q < 4; ++q)
#pragma unroll
                for (int e = 0; e < 4; ++e) { const unsigned wr_ = xr[q][e], wi_ = xi[q][e];
                    { const float br = bflo(wr_), bi = bflo(wi_); const float nr = ar * hr - ai * hi + br, ni = ar * hi + ai * hr + bi; hr = nr; hi = ni; }
                    { const float br = bfhi(wr_), bi = bfhi(wi_); const float nr = ar * hr - ai * hi + br, ni = ar * hi + ai * hr + bi; hr = nr; hi = ni; } }
            Eb[(seg * 128 + sg) * 2] = hr; Eb[(seg * 128 + sg) * 2 + 1] = hi; }
        LBAR();
        { float hcr = h0r, hci = h0i, hr = 0.f, hi = 0.f;
#pragma unroll
            for (int s2 = 0; s2 < 4; ++s2) { if (s2 == seg) { hr = hcr; hi = hci; } const float er = Eb[(s2 * 128 + sg) * 2], ei = Eb[(s2 * 128 + sg) * 2 + 1];
                const float nr = a32r * hcr - a32i * hci + er, ni = a32r * hci + a32i * hcr + ei; hcr = nr; hci = ni; }
            h0r = hcr; h0i = hci;
#pragma unroll
            for (int q = 0; q < 4; ++q) { v4u orr, oi;
#pragma unroll
                for (int e = 0; e < 4; ++e) { const unsigned wr_ = xr[q][e], wi_ = xi[q][e]; float r0, i0, r1, i1;
                    { const float br = bflo(wr_), bi = bflo(wi_); const float nr = ar * hr - ai * hi + br, ni = ar * hi + ai * hr + bi; hr = nr; hi = ni; r0 = hr; i0 = hi; }
                    { const float br = bfhi(wr_), bi = bfhi(wi_); const float nr = ar * hr - ai * hi + br, ni = ar * hi + ai * hr + bi; hr = nr; hi = ni; r1 = hr; i1 = hi; }
                    orr[e] = cvtpk(r0, r1); oi[e] = cvtpk(i0, i1); }
                *(LAS v4u*)(rowre + 8 * q) = orr; *(LAS v4u*)(rowre + 64 * 136 + 8 * q) = oi; } }
        LBAR();
        if (lat) { const int gg = w >> 2;
#pragma unroll
            for (int jj = 0; jj < 2; ++jj) { const int tm = 2 * (w & 3) + jj; f32x4 acc = (f32x4){0.f, 0.f, 0.f, 0.f};
#pragma unroll
                for (int st4 = 0; st4 < 4; ++st4) { const bf16x8 af = *(const LAS bf16x8*)(Cm + (gg * 16 + (lane & 15)) * 136 + 32 * st4 + 8 * (lane >> 4));
                    const bf16x8 bfr = tr_frag16(BHt + gg * 128 * 136, 136, 32 * st4, 16 * tm, lane);
                    acc = __builtin_amdgcn_mfma_f32_16x16x32_bf16(af, bfr, acc, 0, 0, 0); }
                const int t = 16 * tm + (lane & 15); const int tt = d ? (Lseq - 1 - (p0 + t)) : (p0 + t);
                yptr[jj] = YDIR + (size_t)(rowbase + tt) * 512 + (2 * gp + gg) * 16 + 4 * (lane >> 4); yout[jj] = (v2u){pk2(acc[0], acc[1]), pk2(acc[2], acc[3])}; }
            ypend = true; }
    }
    if (ypend) { *(v2u*)yptr[0] = yout[0]; *(v2u*)yptr[1] = yout[1]; }
#undef S5_PREFETCH
    __syncthreads();
}

__device__ __forceinline__ float gelu_tanh(float x) { const float u = 0.7978845608028654f * (x + 0.044715f * x * x * x); const float e = __expf(2.0f * u); const float th = 1.0f - 2.0f / (e + 1.0f); return 0.5f * x * (1.0f + th); }
__device__ __forceinline__ void p5a_prep(Frame& F, const float* const* __restrict__ INP) {
    const int gw = F.vcu * NWAVES + F.wave, NGW = F.G * NWAVES, lane = F.lane;
    const bf16* PROJ = (const bf16*)(F.ws + WS_PROJ); const bf16* HD0 = (const bf16*)(F.ws + WS_HDIR); const bf16* HD1 = HD0 + (size_t)ML * 1024;
    const bf16* YD0 = (const bf16*)(F.ws + WS_YDIR); const bf16* YD1 = YD0 + (size_t)ML * 512;
    bf16* A1 = (bf16*)(F.ws + WS_A1); bf16* A2 = (bf16*)(F.ws + WS_A2);
    for (int m = gw; m < ML; m += NGW) {
        float hm[16]; float ss = 0.f;
#pragma unroll
        for (int q = 0; q < 2; ++q) { const v4u a = *(const v4u*)(HD0 + (size_t)m * 1024 + 16 * lane + 8 * q), bq = *(const v4u*)(HD1 + (size_t)m * 1024 + 16 * lane + 8 * q);
            hm[8 * q + 0] = bflo(a.x) + bflo(bq.x); hm[8 * q + 1] = bfhi(a.x) + bfhi(bq.x); hm[8 * q + 2] = bflo(a.y) + bflo(bq.y); hm[8 * q + 3] = bfhi(a.y) + bfhi(bq.y);
            hm[8 * q + 4] = bflo(a.z) + bflo(bq.z); hm[8 * q + 5] = bfhi(a.z) + bfhi(bq.z); hm[8 * q + 6] = bflo(a.w) + bflo(bq.w); hm[8 * q + 7] = bfhi(a.w) + bfhi(bq.w); }
#pragma unroll
        for (int q = 0; q < 16; ++q) ss += hm[q] * hm[q];
        ss += __shfl_xor(ss, 1); ss += __shfl_xor(ss, 2); ss += __shfl_xor(ss, 4);
        const float rs = 1.0f / sqrtf(ss * (1.0f / 128.0f) + EPS);
#pragma unroll
        for (int q = 0; q < 2; ++q) { const v4u o8 = *(const v4u*)(PROJ + (size_t)m * LDP + PC_O + 16 * lane + 8 * q); const float* gm = INP[11] + 16 * lane + 8 * q;
            float r[8]; const float og[8] = {bflo(o8.x), bfhi(o8.x), bflo(o8.y), bfhi(o8.y), bflo(o8.z), bfhi(o8.z), bflo(o8.w), bfhi(o8.w)};
#pragma unroll
            for (int e = 0; e < 8; ++e) r[e] = hm[8 * q + e] * rs * gm[e] * sigmoidf_(og[e]);
            *(v4u*)(A1 + (size_t)m * 1024 + 16 * lane + 8 * q) = (v4u){pk2(r[0], r[1]), pk2(r[2], r[3]), pk2(r[4], r[5]), pk2(r[6], r[7])}; }
        { const v4u a = *(const v4u*)(YD0 + (size_t)m * 512 + 8 * lane), bq = *(const v4u*)(YD1 + (size_t)m * 512 + 8 * lane), u8 = *(const v4u*)(PROJ + (size_t)m * LDP + PC_U + 8 * lane);
            const float* dd = INP[20] + 8 * lane;
            float r[8] = {bflo(a.x) + bflo(bq.x) + dd[0] * bflo(u8.x), bfhi(a.x) + bfhi(bq.x) + dd[1] * bfhi(u8.x), bflo(a.y) + bflo(bq.y) + dd[2] * bflo(u8.y), bfhi(a.y) + bfhi(bq.y) + dd[3] * bfhi(u8.y),
                          bflo(a.z) + bflo(bq.z) + dd[4] * bflo(u8.z), bfhi(a.z) + bfhi(bq.z) + dd[5] * bfhi(u8.z), bflo(a.w) + bflo(bq.w) + dd[6] * bflo(u8.w), bfhi(a.w) + bfhi(bq.w) + dd[7] * bfhi(u8.w)};
#pragma unroll
            for (int e = 0; e < 8; ++e) r[e] = gelu_tanh(r[e]);
            *(v4u*)(A2 + (size_t)m * 512 + 8 * lane) = (v4u){pk2(r[0], r[1]), pk2(r[2], r[3]), pk2(r[4], r[5]), pk2(r[6], r[7])}; }
    }
}

__device__ __forceinline__ void route_reduce_top4(float (&acc)[32], const float* br, int lane, float (&tv)[4], int (&ti)[4]) {
#pragma unroll
    for (int i = 0; i < 16; ++i) { const float send = (lane & 32) ? acc[i] : acc[i + 16]; const float keep = (lane & 32) ? acc[i + 16] : acc[i]; acc[i] = keep + __shfl_xor(send, 32); }
#pragma unroll
    for (int i = 0; i < 8; ++i) { const float send = (lane & 16) ? acc[i] : acc[i + 8]; const float keep = (lane & 16) ? acc[i + 8] : acc[i]; acc[i] = keep + __shfl_xor(send, 16); }
#pragma unroll
    for (int i = 0; i < 4; ++i) { const float send = (lane & 8) ? acc[i] : acc[i + 4]; const float keep = (lane & 8) ? acc[i + 4] : acc[i]; acc[i] = keep + __shfl_xor(send, 8); }
#pragma unroll
    for (int i = 0; i < 2; ++i) { const float send = (lane & 4) ? acc[i] : acc[i + 2]; const float keep = (lane & 4) ? acc[i + 2] : acc[i]; acc[i] = keep + __shfl_xor(send, 4); }
    { const float send = (lane & 2) ? acc[0] : acc[1]; const float keep = (lane & 2) ? acc[1] : acc[0]; acc[0] = keep + __shfl_xor(send, 2); }
    acc[0] += __shfl_xor(acc[0], 1);
    float val = acc[0] + br[lane >> 1];
    if (lane & 1) val = -INFINITY;
#pragma unroll
    for (int r = 0; r < 4; ++r) { float mx = val;
#pragma unroll
        for (int o = 1; o < 64; o <<= 1) mx = fmaxf(mx, __shfl_xor(mx, o));
        const unsigned long long bal = __ballot(val == mx); const int wl = __ffsll((long long)bal) - 1;
        tv[r] = mx; ti[r] = wl >> 1; if (lane == wl) val = -INFINITY; }
}
__device__ __forceinline__ void p6_route(Frame& F, const float* const* __restrict__ INP) {
    const float* X1 = F.out; const float* mod = (const float*)(F.ws + WS_MOD); bf16* H2 = (bf16*)(F.ws + WS_H2);
    int* TOPE = (int*)(F.ws + WS_TOPE); int* POS = (int*)(F.ws + WS_POS); float* TOPP = (float*)(F.ws + WS_TOPP); int* LIST = (int*)(F.ws + WS_LIST);
    LAS float* Wt = (LAS float*)(F.lds);
    LAS int* pe = (LAS int*)(F.lds + LDSCTL_OFF + 1024); LAS int* hist = pe + 512; LAS int* base = hist + 32; LAS int* rank = base + 32;
    const float* wr = INP[26]; const float* br = INP[27];
    const int lane = F.lane, w = F.wave;
    for (int idx = F.tid; idx < 32768; idx += NWAVES * 64) { const int e = idx >> 10, k = idx & 1023; Wt[((((k >> 8) * 4 + (k & 3)) * 32 + e) << 6) + ((k >> 2) & 63)] = wr[k * 32 + e]; }
    __syncthreads();
    for (int tg = blockIdx.x; tg < ML / 128; tg += F.G) {
        if (F.tid < 32) hist[F.tid] = 0;
        __syncthreads();
#pragma unroll 1
        for (int q = 0; q < 16; q += 2) {
            const int tl = w * 16 + q, m = tg * 128 + tl, b = m / SEQ;
            const float* sh = mod + b * 6144 + 3 * D; const float* scl = sh + D;
            float s0 = 0.f, s1 = 0.f;
#pragma unroll
            for (int j = 0; j < 4; ++j) { const f32x4 x0 = *(const f32x4*)(X1 + (size_t)m * D + 256 * j + 4 * lane), x1 = *(const f32x4*)(X1 + (size_t)(m + 1) * D + 256 * j + 4 * lane);
                s0 += (x0[0] * x0[0] + x0[1] * x0[1]) + (x0[2] * x0[2] + x0[3] * x0[3]); s1 += (x1[0] * x1[0] + x1[1] * x1[1]) + (x1[2] * x1[2] + x1[3] * x1[3]); }
            const float r0 = 1.0f / sqrtf(wave_sum(s0) * (1.0f / D) + EPS), r1 = 1.0f / sqrtf(wave_sum(s1) * (1.0f / D) + EPS);
            float a0[32], a1[32];
#pragma unroll
            for (int e = 0; e < 32; ++e) { a0[e] = 0.f; a1[e] = 0.f; }
#pragma unroll 1
            for (int j = 0; j < 4; ++j) { const int c = 256 * j + 4 * lane; const f32x4 g = *(const f32x4*)(INP[7] + c), a = *(const f32x4*)(scl + c), bb = *(const f32x4*)(sh + c);
                const f32x4 x0 = *(const f32x4*)(X1 + (size_t)m * D + c), x1 = *(const f32x4*)(X1 + (size_t)(m + 1) * D + c);
                const f32x4 gs = g * (a + 1.0f); const f32x4 y0 = x0 * r0 * gs + bb, y1 = x1 * r1 * gs + bb;
                *(unsigned*)((unsigned char*)H2 + (size_t)m * D + c) = pk4_fp8(y0[0], y0[1], y0[2], y0[3]); *(unsigned*)((unsigned char*)H2 + (size_t)(m + 1) * D + c) = pk4_fp8(y1[0], y1[1], y1[2], y1[3]);
                const LAS float* wj = Wt + j * 8192 + lane;
#pragma unroll
                for (int qq = 0; qq < 4; ++qq) { const LAS float* wp = wj + qq * 2048; const float ya = y0[qq], yb = y1[qq];
#pragma unroll
                    for (int e = 0; e < 32; ++e) { const float wv = wp[e * 64]; a0[e] += ya * wv; a1[e] += yb * wv; }
                    asm volatile("" ::: "memory"); } }
            float tv[4]; int ti[4];
#pragma unroll
            for (int tk = 0; tk < 2; ++tk) {
                if (tk == 0) route_reduce_top4(a0, br, lane, tv, ti); else route_reduce_top4(a1, br, lane, tv, ti);
                const float e1 = __expf(tv[1] - tv[0]), e2 = __expf(tv[2] - tv[0]), e3 = __expf(tv[3] - tv[0]); const float inv = 1.0f / (1.0f + e1 + e2 + e3);
                if (lane < 4) { const float p = lane == 0 ? inv : (lane == 1 ? e1 * inv : (lane == 2 ? e2 * inv : e3 * inv)); const int ee = lane == 0 ? ti[0] : (lane == 1 ? ti[1] : (lane == 2 ? ti[2] : ti[3]));
                    TOPP[(m + tk) * 4 + lane] = p; TOPE[(m + tk) * 4 + lane] = ee; pe[(tl + tk) * 4 + lane] = ee; }
            }
        }
        __syncthreads();
        { const int e = pe[F.tid]; rank[F.tid] = __hip_atomic_fetch_add(&hist[e], 1, __ATOMIC_RELAXED, __HIP_MEMORY_SCOPE_WORKGROUP); }
        __syncthreads();
        if (F.tid < 32) base[F.tid] = (int)__hip_atomic_fetch_add(F.ctl + CW_CNT + 64 * F.tid, (unsigned)hist[F.tid], RLX_AGENT);
        __syncthreads();
        { const int e = pe[F.tid]; const int pos = base[e] + rank[F.tid]; const int m = tg * 128 + (F.tid >> 2); LIST[e * ML + pos] = m; POS[m * 4 + (F.tid & 3)] = pos; }
        __syncthreads();
    }
}

__device__ __forceinline__ void p10_combine(Frame& F, const float* const* __restrict__ INP) {
    moe_tables(F);
    const LAS int* tab = (const LAS int*)(F.lds + TAB_OFF);
    const float* X1 = F.out; float* OUT = F.out; const float* mod = (const float*)(F.ws + WS_MOD); const bf16* Y = (const bf16*)(F.ws + WS_Y);
    const int* TOPE = (const int*)(F.ws + WS_TOPE); const int* POS = (const int*)(F.ws + WS_POS); const float* TOPP = (const float*)(F.ws + WS_TOPP);
    const int gw = F.vcu * NWAVES + F.wave, NGW = F.G * NWAVES, lane = F.lane;
    for (int m = gw; m < ML; m += NGW) {
        const int b = m / SEQ; const float* gt2 = mod + b * 6144 + 5 * D;
        f32x4 mo[4];
#pragma unroll
        for (int j = 0; j < 4; ++j) mo[j] = (f32x4){0.f, 0.f, 0.f, 0.f};
#pragma unroll
        for (int k = 0; k < 4; ++k) { const int e = TOPE[m * 4 + k]; const float p = TOPP[m * 4 + k]; const size_t slot = (size_t)256 * tab[e] + POS[m * 4 + k];
#pragma unroll
            for (int j = 0; j < 4; ++j) { const v2u y = *(const v2u*)(Y + slot * 1024 + 256 * j + 4 * lane); mo[j] += (f32x4){bflo(y.x), bfhi(y.x), bflo(y.y), bfhi(y.y)} * p; } }
        f32x4 v[4]; float s = 0.f;
#pragma unroll
        for (int j = 0; j < 4; ++j) { const int c = 256 * j + 4 * lane; v[j] = *(const f32x4*)(X1 + (size_t)m * D + c) + *(const f32x4*)(gt2 + c) * mo[j]; s += (v[j][0] * v[j][0] + v[j][1] * v[j][1]) + (v[j][2] * v[j][2] + v[j][3] * v[j][3]); }
        const float rstd = 1.0f / sqrtf(wave_sum(s) * (1.0f / D) + EPS);
#pragma unroll
        for (int j = 0; j < 4; ++j) { const int c = 256 * j + 4 * lane; *(f32x4*)(OUT + (size_t)m * D + c) = v[j] * rstd * *(const f32x4*)(INP[32] + c); }
    }
}

struct Args { const float* in[33]; float* out; unsigned char* ws; int ph_lo, ph_hi, li, pad; };
__global__ void __launch_bounds__(NWAVES * 64, 2) fwd_kernel(Args args) {
    extern __shared__ __attribute__((aligned(16))) unsigned char lds[];
    Frame F;
    F.lds = (LAS unsigned char*)lds;
    F.tid = threadIdx.x; F.lane = F.tid & 63; F.wave = __builtin_amdgcn_readfirstlane(F.tid >> 6);
    F.G = gridDim.x; { const int bx = blockIdx.x; F.vcu = (F.G % 8 == 0) ? (bx % 8) * (F.G / 8) + bx / 8 : bx; }
    F.ws = args.ws; F.ctl = (gu32*)(args.ws + WS_CTL); F.out = args.out;
    for (int u = F.tid; u < (LDS_BYTES - LDSCTL_OFF) / 4; u += NWAVES * 64) ((LAS unsigned*)(F.lds + LDSCTL_OFF))[u] = 0u;
    __syncthreads();
    XcdBarrier bar; bar.bar = (unsigned*)(F.ctl + CW_BAR); bar.x = 0; bar.st = nullptr;
    if (N_LAUNCHES == 1) bar = xcd_barrier_post((unsigned*)(F.ctl + CW_BAR), (volatile LAS unsigned*)(F.lds + MISC_OFF) + 8);
    const int lo = args.ph_lo, hi = args.ph_hi;
    const float* const* __restrict__ INP = args.in;
#ifndef PH_MASK
#define PH_MASK 0x3fff
#endif
#define IN(k) ((((PH_MASK) >> (k)) & 1) && lo <= (k) && (k) < hi)
#define SEAM(k) do { if (IN(k) && IN((k) + 1)) xcd_barrier(bar); } while (0)
    const bf16* WIN = (const bf16*)(F.ws + WS_WIN);

    if (IN(0)) { p0_prologue(F, INP); } SEAM(0);
    if (IN(1)) { p1_norm1(F, INP); } SEAM(1);
    if (IN(2)) {
        pg8::Gemm g{(const bf16*)(F.ws + WS_H1), WIN, 512, nullptr, 0x7f7f7f7f, 0x7a7a7a7a}; InProjOrder S{F.G, (int)blockIdx.x};
        EpiStore E{(bf16*)(F.ws + WS_PROJ), LDP};
        pg8::gemm_phase<EpiStore, InProjOrder, false, true>(F.lds, g, S, E);
    } SEAM(2);
    if (IN(3)) { p3_conv(F, INP); } SEAM(3);
    if (IN(4)) { for (int u = blockIdx.x; u < 256; u += F.G) { p4_mlstm<0>(F, INP, u); if (P4_REP_M > 1) p4_mlstm<P4_MODE>(F, INP, u); for (int r_ = 0; r_ < P4_REP_S; ++r_) p4_s5(F, INP, u); } } SEAM(4);
    if (IN(5)) { p5a_prep(F, INP); } SEAM(5);
    if (IN(6)) {
        pg8::Gemm g{(const bf16*)(F.ws + WS_A2), (const bf16*)(F.ws + WS_WGLU), 512, nullptr, 0, 0}; pg8::StaticOrder S; S.init(ML, 512, F.G, (int)blockIdx.x);
        EpiGlu E{(const bf16*)(F.ws + WS_A2), (bf16*)(F.ws + WS_A3), INP[22]};
        pg8::gemm_phase<EpiGlu, pg8::StaticOrder, false>(F.lds, g, S, E);
    }
    if (IN(7)) {
        pg8::Gemm g{(const bf16*)(F.ws + WS_A1), (const bf16*)(F.ws + WS_WA), 1024, nullptr, 0, 0}; pg8::StaticOrder S; S.init(ML, 1024, F.G, (int)blockIdx.x);
        EpiGate<false> E{(const bf16*)(F.ws + WS_PROJ), PC_G, INP[24], nullptr, (bf16*)(F.ws + WS_YA)};
        pg8::gemm_phase<EpiGate<false>, pg8::StaticOrder, false>(F.lds, g, S, E);
    } SEAM(7);
    if (IN(8)) {
        pg8::Gemm g{(const bf16*)(F.ws + WS_A3), (const bf16*)(F.ws + WS_WB), 512, nullptr, 0, 0}; pg8::StaticOrder S; S.init(ML, 1024, F.G, (int)blockIdx.x);
        EpiGate<true> E{(const bf16*)(F.ws + WS_PROJ), PC_G + 1024, INP[24] + 1024, (const bf16*)(F.ws + WS_YA), (bf16*)(F.ws + WS_MERGED)};
        pg8::gemm_phase<EpiGate<true>, pg8::StaticOrder, false>(F.lds, g, S, E);
    } SEAM(8);
    if (IN(9)) {
        pg8::Gemm g{(const bf16*)(F.ws + WS_MERGED), (const bf16*)(F.ws + WS_WO), 1024, nullptr, 0, 0}; pg8::StaticOrder S; S.init(ML, 1024, F.G, (int)blockIdx.x);
        EpiX1 E{INP[0], (const float*)(F.ws + WS_MOD), F.out};
        pg8::gemm_phase<EpiX1, pg8::StaticOrder, false>(F.lds, g, S, E);
    } SEAM(9);
    if (IN(10)) { p6_route(F, INP); } SEAM(10);
    if (IN(11)) {
        moe_tables(F);
        MoeOrder S{F.G, (int)blockIdx.x, 8, (const LAS int*)(F.lds + TAB_OFF)};
        LAS unsigned short* ridx = (LAS unsigned short*)(F.lds + LDSCTL_OFF + 1024);
        { const int* LIST = (const int*)(F.ws + WS_LIST);
            for (int i = 0; i < 30; ++i) { pg8::Unit u; if (!S.next(i, u)) break;
                if (F.tid < 256) { const int rc = F.tid < u.nvalid ? F.tid : u.nvalid - 1; ridx[i * 256 + F.tid] = (unsigned short)LIST[u.lbase + rc]; } }
            __syncthreads(); }
        pg8::Gemm g{(const bf16*)(F.ws + WS_H2), (const bf16*)(F.ws + WS_WEIN), 512, ridx, 0x7f7f7f7f, 0x7a7a7a7a};
        EpiSwiglu E{INP[29], (bf16*)(F.ws + WS_ACT)};
        pg8::gemm_phase<EpiSwiglu, MoeOrder, true, true>(F.lds, g, S, E);
    } SEAM(11);
    if (IN(12)) {
        moe_tables(F);
        pg8::Gemm g{(const bf16*)(F.ws + WS_ACT), (const bf16*)(F.ws + WS_WEOUT), 512, nullptr, 0x7c7c7c7c, 0x7a7a7a7a}; MoeOrder S{F.G, (int)blockIdx.x, 4, (const LAS int*)(F.lds + TAB_OFF)};
        EpiY E{INP[31], (bf16*)(F.ws + WS_Y)};
        pg8::gemm_phase<EpiY, MoeOrder, false, true>(F.lds, g, S, E);
    } SEAM(12);
    if (IN(13)) { p10_combine(F, INP); }
#undef IN
#undef SEAM
}

extern "C" void kernel_launch(void* const* d_in, const int* in_sizes, int n_in, void* d_out, int out_size, void* d_ws, size_t ws_size, hipStream_t stream) {
    static int grid = 0;
    if (grid == 0) {
        if (n_in != 33 || out_size != ML * D || ws_size < WS_END2) { fprintf(stderr, "kernel_launch: unexpected shapes (n_in %d, out %d, ws %zu)\n", n_in, out_size, ws_size); grid = -1; return; }
        int dev = 0, cus = 0, per_cu = 0;
        if (hipGetDevice(&dev) != hipSuccess || hipDeviceGetAttribute(&cus, hipDeviceAttributeMultiprocessorCount, dev) != hipSuccess) { grid = -1; return; }
        if (hipFuncSetAttribute((const void*)fwd_kernel, hipFuncAttributeMaxDynamicSharedMemorySize, LDS_BYTES) != hipSuccess) { fprintf(stderr, "kernel_launch: hipFuncSetAttribute failed\n"); grid = -1; return; }
        if (hipOccupancyMaxActiveBlocksPerMultiprocessor(&per_cu, (const void*)fwd_kernel, NWAVES * 64, LDS_BYTES) != hipSuccess || per_cu < 1) fprintf(stderr, "kernel_launch: occupancy query reports %d\n", per_cu);
        (void)hipGetLastError();
        grid = cus;
    }
    if (grid < 0) return;
    if (hipMemsetAsync((char*)d_ws + WS_CTL, 0, CTL_ZERO_BYTES, stream) != hipSuccess) return;
    Args a{};
    for (int i = 0; i < 33; ++i) a.in[i] = (const float*)d_in[i];
    a.out = (float*)d_out; a.ws = (unsigned char*)d_ws;
    for (int li = 0; li < N_LAUNCHES; ++li) {
        a.ph_lo = (N_LAUNCHES == 1) ? 0 : li; a.ph_hi = (N_LAUNCHES == 1) ? NPH : li + 1; a.li = li;
        const int nrep = (N_LAUNCHES != 1 && (((PROBE_DUP_MASK) >> li) & 1)) ? 2 : 1;
        for (int r = 0; r < nrep; ++r) hipLaunchKernelGGL(fwd_kernel, dim3(grid), dim3(NWAVES * 64), LDS_BYTES, stream, a);
    }
}
```

```cpp
#include <hip/hip_runtime.h>
#include <cstdio>
#include <cstdint>

#ifndef MK_N_LAUNCHES
#define MK_N_LAUNCHES 1
#endif
#ifndef PROBE_DUP_MASK
#define PROBE_DUP_MASK 0
#endif
#ifndef P4_REP_M
#define P4_REP_M 1
#endif
#ifndef P4_MODE
#define P4_MODE 0
#endif
#ifndef P4_REP_S
#define P4_REP_S 1
#endif

namespace pg8 {
#define PG8_LAS __attribute__((address_space(3)))
typedef unsigned short bf16_t;
typedef short bf16x8 __attribute__((ext_vector_type(8)));
typedef float f32x4 __attribute__((ext_vector_type(4)));
typedef unsigned u32x4 __attribute__((ext_vector_type(4)));
constexpr int BM = 256, BK = 64, HALF = 128, HTB = HALF * BK * 2, STAGE_BYTES = 8 * HTB, NXCD = 8, WGM = 8;

__host__ __device__ __forceinline__ int lds_byte(int r, int c) { const int st = (r >> 4) * 2 + (c >> 5), rr = r & 15, cc = c & 31, ob = rr * 64 + cc * 2; return st * 1024 + (ob ^ (((ob >> 9) & 1) << 5)); }
__host__ __device__ __forceinline__ void stage_rc(int b, int& R, int& C) { const int st = b / 1024, sb = b % 1024, swz = sb ^ (((sb >> 9) & 1) << 5); R = (st >> 1) * 16 + swz / 64; C = (st & 1) * 32 + (swz % 64) / 2; }
__host__ __device__ __forceinline__ int perm32(int rho) { const int n = rho >> 4, i = rho & 15; return 8 * (i >> 2) + 4 * n + (i & 3); }

struct Unit { int pm, pn, lbase, nvalid; };
struct Gemm { const bf16_t* A; const bf16_t* Bt; int K; const PG8_LAS unsigned short* ridx; int sa, sb; };

__device__ __forceinline__ int xcd_remap(int L, int nwg) { const int q = nwg / NXCD, r = nwg % NXCD, xcd = L % NXCD, off = L / NXCD; return (xcd < r ? xcd * (q + 1) : r * (q + 1) + (xcd - r) * q) + off; }

struct StaticOrder {
    int nM, nN, nwg, G, c;
    __device__ void init(int M, int N, int G_, int c_) { nM = M / BM; nN = N / BM; nwg = nM * nN; G = G_; c = c_; }
    __device__ __forceinline__ bool next(int i, Unit& u) const {
        const long L = (long)i * G + c; if (L >= nwg) return false;
        const int wgid = xcd_remap((int)L, nwg);
        const int nig = WGM * nN, gid = wgid / nig, fm = gid * WGM, gsz = (nM - fm) < WGM ? (nM - fm) : WGM;
        u.pm = fm + ((wgid % nig) % gsz); u.pn = (wgid % nig) / gsz; u.lbase = 0; u.nvalid = 0; return true;
    }
};

__device__ __forceinline__ unsigned cvt_pk_bf16(float lo, float hi) { unsigned r; asm volatile("v_cvt_pk_bf16_f32 %0, %1, %2" : "=v"(r) : "v"(lo), "v"(hi)); return r; }

typedef int v8i __attribute__((ext_vector_type(8)));
typedef short s16x16 __attribute__((ext_vector_type(16)));
template <class Epi, class Sched, bool GATHER, bool FP8 = false>
__device__ __forceinline__ void gemm_phase(PG8_LAS unsigned char* lds, const Gemm g, const Sched& S, const Epi& E) {
    const int tid = threadIdx.x, wid = __builtin_amdgcn_readfirstlane(tid >> 6), lane = tid & 63, wr = wid >> 2, wc = wid & 3, fr = lane & 15, fq = lane >> 4;
    const int K = g.K, nt = K / BK;
    int Rr[2]; unsigned cby[2], voffB[2];
#pragma unroll
    for (int i = 0; i < 2; ++i) { int R, C; stage_rc(tid * 16 + i * 8192, R, C); const int Rb = Epi::PERM ? ((R & ~31) + perm32(R & 31)) : R;
        Rr[i] = R; cby[i] = (unsigned)C * 2u; voffB[i] = (unsigned)(Rb * K + C) * 2u; }
    const size_t kstep = (size_t)(BK * 2);
    const size_t hstep = (size_t)HALF * K * 2;
    const size_t tstep = 2 * hstep;
    const unsigned ldsw = (unsigned)wid * 1024u;
    const int aoff = lds_byte(wr * 64 + fr, FP8 ? fq * 16 : fq * 8), boff = lds_byte(wc * 32 + fr, FP8 ? fq * 16 : fq * 8);

#define PG8_SA(b, h) (((b) * 2 + (h)) * HTB)
#define PG8_SB(b, h) ((4 + (b) * 2 + (h)) * HTB)
#define PG8_STAGE(bufoff, gbase, voff) do { _Pragma("unroll") for (int _i = 0; _i < 2; ++_i) \
        __builtin_amdgcn_global_load_lds((const unsigned*)((const char*)(gbase) + (voff)[_i]), (PG8_LAS unsigned*)(lds + (bufoff) + ldsw + _i * 8192), 16, 0, 0); } while (0)
#define PG8_LDA(dst, b, h) do { if constexpr (FP8) { _Pragma("unroll") for (int m = 0; m < 4; ++m) { const bf16x8 _lo = *(const PG8_LAS bf16x8*)(lds + PG8_SA(b, h) + aoff + m * 2048), _hi = *(const PG8_LAS bf16x8*)(lds + PG8_SA(b, h) + aoff + m * 2048 + 16); dst##8[m] = __builtin_bit_cast(v8i, __builtin_shufflevector(_lo, _hi, 0, 1, 2, 3, 4, 5, 6, 7, 8, 9, 10, 11, 12, 13, 14, 15)); } } \
        else { _Pragma("unroll") for (int m = 0; m < 4; ++m) _Pragma("unroll") for (int k = 0; k < 2; ++k) dst[m][k] = *(const PG8_LAS bf16x8*)(lds + PG8_SA(b, h) + aoff + m * 2048 + k * 1024); } } while (0)
#define PG8_LDB(dst, b, h) do { if constexpr (FP8) { _Pragma("unroll") for (int n = 0; n < 2; ++n) { const bf16x8 _lo = *(const PG8_LAS bf16x8*)(lds + PG8_SB(b, h) + boff + n * 2048), _hi = *(const PG8_LAS bf16x8*)(lds + PG8_SB(b, h) + boff + n * 2048 + 16); dst##8[n] = __builtin_bit_cast(v8i, __builtin_shufflevector(_lo, _hi, 0, 1, 2, 3, 4, 5, 6, 7, 8, 9, 10, 11, 12, 13, 14, 15)); } } \
        else { _Pragma("unroll") for (int n = 0; n < 2; ++n) _Pragma("unroll") for (int k = 0; k < 2; ++k) dst[n][k] = *(const PG8_LAS bf16x8*)(lds + PG8_SB(b, h) + boff + n * 2048 + k * 1024); } } while (0)
#define PG8_MMA(ai, bj, At, Bt) do { __builtin_amdgcn_s_setprio(1); _Pragma("unroll") for (int m = 0; m < 4; ++m) _Pragma("unroll") for (int n = 0; n < 2; ++n) { \
        if constexpr (FP8) asm volatile("v_mfma_scale_f32_16x16x128_f8f6f4 %0, %1, %2, %0, %3, %4 op_sel_hi:[0,0,0]" : "+v"(acc[ai][bj][m][n]) : "v"(Bt##8[n]), "v"(At##8[m]), "v"(vsb), "v"(vsa));   \
        else { _Pragma("unroll") for (int k = 0; k < 2; ++k) acc[ai][bj][m][n] = __builtin_amdgcn_mfma_f32_16x16x32_bf16(Bt[n][k], At[m][k], acc[ai][bj][m][n], 0, 0, 0); } } \
        __builtin_amdgcn_s_setprio(0); } while (0)
#define PG8_WAIT_V(n) asm volatile("s_waitcnt vmcnt(" #n ")" ::: "memory")
#define PG8_WAIT_L(n) asm volatile("s_waitcnt lgkmcnt(" #n ")" ::: "memory")
#define PG8_BAR __builtin_amdgcn_s_barrier()
#define PG8_SCHED __builtin_amdgcn_sched_barrier(0)
#define PG8_AOFF(dst, u, uord) do { _Pragma("unroll") for (int _h = 0; _h < 2; ++_h) _Pragma("unroll") for (int _i = 0; _i < 2; ++_i) { const int _r = _h * HALF + Rr[_i]; \
        if constexpr (GATHER) { const int _idx = g.ridx[(uord) * 256 + _r]; dst[_h][_i] = (unsigned)_idx * (unsigned)(K * 2) + cby[_i]; } \
        else { dst[_h][_i] = (unsigned)(_r * K * 2) + cby[_i]; } } } while (0)
    Unit cur, nxt; int ui = 0;
    if (!S.next(0, cur)) return;
    f32x4 acc[2][2][4][2];
#pragma unroll
    for (int a = 0; a < 2; ++a)
#pragma unroll
        for (int b = 0; b < 2; ++b)
#pragma unroll
            for (int m = 0; m < 4; ++m)
#pragma unroll
                for (int n = 0; n < 2; ++n) acc[a][b][m][n] = (f32x4){0.f, 0.f, 0.f, 0.f};
    const int vsa = g.sa, vsb = g.sb;
    bf16x8 At[4][2], B0[2][2], B1[2][2];
    v8i At8[4], B08[2], B18[2];
    unsigned vc[2][2], vn[2][2];
    PG8_AOFF(vc, cur, 0);
    const char* cA = GATHER ? (const char*)g.A : (const char*)g.A + (size_t)cur.pm * tstep; const char* cB = (const char*)g.Bt + (size_t)cur.pn * tstep;
    PG8_STAGE(PG8_SB(0, 0), cB, voffB); PG8_STAGE(PG8_SB(0, 1), cB + hstep, voffB); PG8_STAGE(PG8_SA(0, 0), cA, vc[0]); PG8_STAGE(PG8_SA(0, 1), cA, vc[1]);
    if (wr == 1) PG8_BAR;
    PG8_WAIT_V(2); PG8_BAR;
    PG8_STAGE(PG8_SB(1, 0), cB + kstep, voffB); PG8_STAGE(PG8_SA(1, 0), cA + kstep, vc[0]); PG8_STAGE(PG8_SB(1, 1), cB + hstep + kstep, voffB);
    PG8_WAIT_V(6); PG8_BAR;
    for (;;) {
        const bool has_next = S.next(ui + 1, nxt);
        const char* nA = (has_next && !GATHER) ? (const char*)g.A + (size_t)nxt.pm * tstep : cA; const char* nB = has_next ? (const char*)g.Bt + (size_t)nxt.pn * tstep : cB;
        if constexpr (GATHER) { if (has_next) { PG8_AOFF(vn, nxt, ui + 1); } else {
#pragma unroll
            for (int h = 0; h < 2; ++h) { vn[h][0] = vc[h][0]; vn[h][1] = vc[h][1]; } } }
#pragma unroll 1
        for (int t = 0; t < nt; t += 2) {
            const bool last = (t == nt - 2);
            const char* a1 = cA + (size_t)(t + 1) * kstep;
            const char* a2 = last ? nA : cA + (size_t)(t + 2) * kstep; const char* b2 = last ? nB : cB + (size_t)(t + 2) * kstep;
            const char* a3 = a2 + kstep; const char* b3 = b2 + kstep;
            unsigned v2[2][2];
#pragma unroll
            for (int h = 0; h < 2; ++h)
#pragma unroll
                for (int i = 0; i < 2; ++i) v2[h][i] = GATHER ? (last ? vn[h][i] : vc[h][i]) : vc[h][i];
            PG8_LDB(B0, 0, 0); PG8_LDB(B1, 0, 1); PG8_SCHED; PG8_LDA(At, 0, 0); PG8_STAGE(PG8_SA(1, 1), a1, vc[1]);
            PG8_WAIT_V(8); PG8_WAIT_L(0); PG8_BAR; PG8_MMA(0, 0, At, B0); PG8_MMA(0, 1, At, B1); PG8_BAR; PG8_SCHED;
            PG8_LDA(At, 0, 1); PG8_STAGE(PG8_SB(0, 0), b2, voffB); PG8_STAGE(PG8_SB(0, 1), b2 + hstep, voffB); PG8_STAGE(PG8_SA(0, 0), a2, v2[0]);
            PG8_WAIT_V(8); PG8_WAIT_L(0); PG8_BAR; PG8_MMA(1, 0, At, B0); PG8_MMA(1, 1, At, B1); PG8_BAR; PG8_SCHED;
            PG8_LDB(B0, 1, 0); PG8_LDB(B1, 1, 1); PG8_SCHED; PG8_LDA(At, 1, 0); PG8_STAGE(PG8_SA(0, 1), a2, v2[1]);
            PG8_WAIT_V(8); PG8_WAIT_L(0); PG8_BAR; PG8_MMA(0, 0, At, B0); PG8_MMA(0, 1, At, B1); PG8_BAR; PG8_SCHED;
            PG8_LDA(At, 1, 1); PG8_STAGE(PG8_SB(1, 0), b3, voffB); PG8_STAGE(PG8_SB(1, 1), b3 + hstep, voffB); PG8_STAGE(PG8_SA(1, 0), a3, v2[0]);
            PG8_WAIT_V(8); PG8_WAIT_L(0); PG8_BAR; PG8_MMA(1, 0, At, B0); PG8_MMA(1, 1, At, B1); PG8_BAR; PG8_SCHED;
        }
        if (wr == 0) PG8_BAR;
        if constexpr (FP8) asm volatile("s_nop 15\n\ts_nop 15" ::: "memory");
        E(acc, cur, wr, wc, fr, fq);
        if (!has_next) break;
#pragma unroll
        for (int a = 0; a < 2; ++a)
#pragma unroll
            for (int b = 0; b < 2; ++b)
#pragma unroll
                for (int m = 0; m < 4; ++m)
#pragma unroll
                    for (int n = 0; n < 2; ++n) acc[a][b][m][n] = (f32x4){0.f, 0.f, 0.f, 0.f};
        cur = nxt; cA = nA; cB = nB; ++ui;
        if constexpr (GATHER) {
#pragma unroll
            for (int h = 0; h < 2; ++h) { vc[h][0] = vn[h][0]; vc[h][1] = vn[h][1]; } }
        if (wr == 1) PG8_BAR;
    }
    PG8_WAIT_V(0);
    PG8_BAR;
#undef PG8_SA
#undef PG8_SB
#undef PG8_STAGE
#undef PG8_LDA
#undef PG8_LDB
#undef PG8_MMA
#undef PG8_WAIT_V
#undef PG8_WAIT_L
#undef PG8_BAR
#undef PG8_SCHED
#undef PG8_AOFF
}
}

constexpr int NWAVES = 8;
constexpr int D = 1024, NB = 8, SEQ = 4096, CTXL = 256;
constexpr int ML = NB * SEQ, MC = NB * CTXL, MT = ML + MC;
constexpr int LDP = 5888;
constexpr int PC_QK = 0, PC_V = 1024, PC_U = 2048, PC_O = 2560, PC_G = 3584, PC_IF = 5632;
constexpr int NEXP = 32, TOPK = 4;
constexpr int MAXTILES = (ML * TOPK + NEXP * 256) / 256;
constexpr float EPS = 1e-6f;
constexpr int NPH = 14;
constexpr int N_LAUNCHES = MK_N_LAUNCHES;

constexpr size_t MiB = 1u << 20;
constexpr size_t WS_CTL = 0, CTL_ZERO_BYTES = 1 * MiB;
constexpr size_t WS_MOD = 1 * MiB;
constexpr size_t WS_TOPE = 2 * MiB, WS_POS = 2 * MiB + 512 * 1024, WS_TOPP = 3 * MiB, WS_LIST = 4 * MiB;
constexpr size_t WS_WIN = 8 * MiB, WS_WGLU = 20 * MiB, WS_WA = 21 * MiB, WS_WB = 23 * MiB, WS_WO = 24 * MiB, WS_WEIN = 26 * MiB, WS_WEOUT = 154 * MiB;
constexpr size_t WS_R0 = 218 * MiB;
constexpr size_t WS_PROJ = WS_R0, WS_H1 = 609 * MiB, WS_QKC = 677 * MiB, WS_HDIR = 745 * MiB, WS_YDIR = 873 * MiB, WS_END = 937 * MiB;
constexpr size_t WS_A1 = WS_H1, WS_A2 = WS_QKC, WS_A3 = WS_QKC + 32 * MiB, WS_YA = WS_HDIR, WS_MERGED = WS_HDIR + 64 * MiB;
constexpr size_t WS_GS = 940 * MiB, WS_X1 = 940 * MiB, WS_END2 = 1004 * MiB;
constexpr size_t WS_H2 = WS_R0, WS_ACT = 282 * MiB, WS_Y = 554 * MiB;
static_assert(WS_PROJ + (size_t)MT * LDP * 2 <= WS_H1 && WS_Y + (size_t)MAXTILES * 256 * 1024 * 2 <= WS_END, "ws map");
constexpr int CW_BAR = 4096, CW_CNT = 16384;

constexpr int RING_BYTES = 131072;
constexpr int LDSCTL_OFF = RING_BYTES, MISC_OFF = LDSCTL_OFF + 320, TAB_OFF = LDSCTL_OFF + 512;
constexpr int LDS_BYTES = 147456;

#define GAS __attribute__((address_space(1)))
#define LAS __attribute__((address_space(3)))
typedef unsigned short bf16;
typedef unsigned v4u __attribute__((ext_vector_type(4)));
typedef unsigned v2u __attribute__((ext_vector_type(2)));
typedef float f32x4 __attribute__((ext_vector_type(4)));
typedef float f32x16 __attribute__((ext_vector_type(16)));
typedef short bf16x8 __attribute__((ext_vector_type(8)));
typedef GAS unsigned gu32;
#define RLX_AGENT __ATOMIC_RELAXED, __HIP_MEMORY_SCOPE_AGENT
#define LDS_WAIT() asm volatile("s_waitcnt lgkmcnt(0)" ::: "memory")
#define LBAR() do { asm volatile("s_waitcnt lgkmcnt(0)" ::: "memory"); __builtin_amdgcn_s_barrier(); asm volatile("" ::: "memory"); } while (0)
__device__ __forceinline__ unsigned f2bf(float f) { unsigned u = __builtin_bit_cast(unsigned, f); return (u + 0x7fffu + ((u >> 16) & 1u)) >> 16; }
typedef __bf16 bf16x2_t __attribute__((ext_vector_type(2)));
__device__ __forceinline__ unsigned cvtpk(float lo, float hi) { const bf16x2_t v = {(__bf16)lo, (__bf16)hi}; return __builtin_bit_cast(unsigned, v); }
__device__ __forceinline__ unsigned pk2(float lo, float hi) { return cvtpk(lo, hi); }
__device__ __forceinline__ float clamp448(float x) { return fminf(fmaxf(x, -448.0f), 448.0f); }
__device__ __forceinline__ unsigned pk4_fp8(float a, float b, float c, float d) {
    unsigned w = 0; w = __builtin_amdgcn_cvt_pk_fp8_f32(clamp448(a), clamp448(b), w, false); w = __builtin_amdgcn_cvt_pk_fp8_f32(clamp448(c), clamp448(d), w, true); return w; }
__device__ __forceinline__ float bf2f(unsigned b) { return __builtin_bit_cast(float, b << 16); }
__device__ __forceinline__ float bflo(unsigned w) { return __builtin_bit_cast(float, w << 16); }
__device__ __forceinline__ float bfhi(unsigned w) { return __builtin_bit_cast(float, w & 0xffff0000u); }
__device__ __forceinline__ float sigmoidf_(float x) { return 1.0f / (1.0f + __expf(-x)); }

#define XB_TMO      128
#define XB_XCNT(j)  (256  + 64 * (j))
#define XB_XSUB(j)  (1280 + 64 * (j))
#define XB_XGEN(j)  (2304 + 64 * (j))
#define XB_TOP      3328
#define XB_TOPGEN   3392
#define XCD_BAR_WORDS 3456
#define XB_SPIN_CAP (1u << 22)
__device__ __forceinline__ unsigned xb_ld(unsigned* p)              { return __hip_atomic_load(p, __ATOMIC_RELAXED, __HIP_MEMORY_SCOPE_AGENT); }
__device__ __forceinline__ unsigned xb_add(unsigned* p, unsigned v) { return __hip_atomic_fetch_add(p, v, __ATOMIC_RELAXED, __HIP_MEMORY_SCOPE_AGENT); }
__device__ __forceinline__ unsigned xb_xcc_id() { return (unsigned)__builtin_amdgcn_s_getreg((3 << 11) | 20) & 0xFu; }
#define XB_SPIN(cond, bar) do { unsigned _sp = 0; while (cond) { __builtin_amdgcn_s_sleep(1); \
    if ((++_sp & 255u) == 0u) { if (xb_ld(&(bar)[XB_TMO])) break; if (_sp > XB_SPIN_CAP) { atomicAdd(&(bar)[XB_TMO], 1u); break; } } } } while (0)
struct XcdBarrier { unsigned* bar; unsigned x; volatile LAS unsigned* st; };
__device__ __forceinline__ XcdBarrier xcd_barrier_post(unsigned* bar, volatile LAS unsigned* st) {
    XcdBarrier b; b.bar = bar; b.x = xb_xcc_id(); b.st = st;
    if (threadIdx.x == 0) (void)xb_add(&bar[XB_XCNT(b.x)], 1u);
    return b;
}
__device__ __forceinline__ void xcd_barrier_complete(unsigned* bar, unsigned x, unsigned& nloc, unsigned& nx) {
    const unsigned G = gridDim.x * gridDim.y * gridDim.z;
    unsigned sum, cnt, mine, sp = 0u;
    for (;;) {
        sum = 0u; cnt = 0u; mine = 0u;
#pragma unroll
        for (unsigned j = 0; j < 16; ++j) { const unsigned c = xb_ld(&bar[XB_XCNT(j)]); sum += c; cnt += (c > 0u) ? 1u : 0u; mine = (j == x) ? c : mine; }
        if (sum == G) break;
        __builtin_amdgcn_s_sleep(1);
        if ((++sp & 255u) == 0u) { if (xb_ld(&bar[XB_TMO])) break; if (sp > XB_SPIN_CAP) { atomicAdd(&bar[XB_TMO], 1u); break; } }
    }
    nloc = mine > 0u ? mine : 1u; nx = cnt > 0u ? cnt : 1u;
}
__device__ __forceinline__ void xcd_barrier(const XcdBarrier& b) {
    asm volatile("s_waitcnt vmcnt(0)" ::: "memory");
    __syncthreads();
    if (threadIdx.x == 0) {
        unsigned* bar = b.bar;
        __builtin_amdgcn_s_waitcnt(0);
        unsigned nloc = b.st[0], nx = b.st[1];
        if (nloc == 0u) { xcd_barrier_complete(bar, b.x, nloc, nx); b.st[0] = nloc; b.st[1] = nx; }
        const unsigned old = xb_add(&bar[XB_XSUB(b.x)], 1u);
        const unsigned gen = old / nloc;
        if (old + 1u == (gen + 1u) * nloc) {
            __builtin_amdgcn_fence(__ATOMIC_RELEASE, "agent");
            asm volatile("s_waitcnt vmcnt(0)" ::: "memory");
            const unsigned og = xb_add(&bar[XB_TOP], 1u);
            const unsigned tg = og / nx;
            if (og + 1u == (tg + 1u) * nx) xb_add(&bar[XB_TOPGEN], 1u);
            else XB_SPIN(xb_ld(&bar[XB_TOPGEN]) == tg, bar);
            __builtin_amdgcn_fence(__ATOMIC_ACQUIRE, "agent");
            xb_add(&bar[XB_XGEN(b.x)], 1u);
            asm volatile("s_waitcnt vmcnt(0)" ::: "memory");
        } else {
            XB_SPIN(xb_ld(&bar[XB_XGEN(b.x)]) == gen, bar);
            __builtin_amdgcn_fence(__ATOMIC_ACQUIRE, "agent");
            asm volatile("s_waitcnt vmcnt(0)" ::: "memory");
        }
    }
    __syncthreads();
}

struct Frame {
    LAS unsigned char* lds;
    gu32* ctl;
    int tid, lane, wave, vcu, G;
    float* out; unsigned char* ws;
};
__device__ __forceinline__ float wave_sum(float v) {
#pragma unroll
    for (int o = 1; o < 64; o <<= 1) v += __shfl_xor(v, o);
    return v;
}

struct InProjOrder {
    int G, c;
    __device__ __forceinline__ bool next(int i, pg8::Unit& u) const {
        const int NL = 128 * 23, NC = 8 * 11;
        const long L = (long)i * G + c; if (L >= NL + NC) return false;
        u.lbase = 0; u.nvalid = 0;
        if (L < NL) { const int wgid = pg8::xcd_remap((int)L, NL); const int nig = 8 * 23, gid = wgid / nig, fm = gid * 8; u.pm = fm + ((wgid % nig) % 8); u.pn = (wgid % nig) / 8; }
        else { const int r = (int)L - NL; u.pm = 128 + r / 11; const int q = r % 11; u.pn = q < 10 ? q : 22; }
        return true;
    }
};
struct MoeOrder {
    int G, c, npn; const LAS int* tab;
    __device__ __forceinline__ bool next(int i, pg8::Unit& u) const {
        const int nT = __builtin_amdgcn_readfirstlane(tab[32]); const int nU = nT * npn;
        const long L = (long)i * G + c; if (L >= nU) return false;
        const int wgid = pg8::xcd_remap((int)L, nU);
        const int tau = wgid / npn, pl = wgid % npn;
        int e = 0;
        for (int k = 1; k < 32; ++k) e += (__builtin_amdgcn_readfirstlane(tab[k]) <= tau) ? 1 : 0;
        const int il = tau - __builtin_amdgcn_readfirstlane(tab[e]);
        u.pm = tau; u.pn = e * npn + pl; u.lbase = e * ML + 256 * il; u.nvalid = __builtin_amdgcn_readfirstlane(tab[33 + e]) - 256 * il;
        return true;
    }
};
__device__ __forceinline__ void moe_tables(Frame& F) {
    LAS int* tab = (LAS int*)(F.lds + TAB_OFF);
    __syncthreads();
    if (F.tid < 32) tab[33 + F.tid] = (int)__hip_atomic_load(F.ctl + CW_CNT + 64 * F.tid, RLX_AGENT);
    __syncthreads();
    if (F.tid == 0) {
        int acc = 0;
        for (int e = 0; e < 32; ++e) { tab[e] = acc; acc += (tab[33 + e] + 255) >> 8; }
        tab[32] = acc;
    }
    __syncthreads();
}

using pg8::f32x4; using pg8::u32x4; using pg8::cvt_pk_bf16;
#define EPI_ROWS(u) const int row0 = (u).pm * 256 + wr * 64 + fr
#define EPI_LOOP _Pragma("unroll") for (int ai = 0; ai < 2; ++ai) _Pragma("unroll") for (int m = 0; m < 4; ++m)
__device__ __forceinline__ u32x4 pack8(const f32x4 a, const f32x4 b) { u32x4 w; w.x = cvt_pk_bf16(a[0], a[1]); w.y = cvt_pk_bf16(a[2], a[3]); w.z = cvt_pk_bf16(b[0], b[1]); w.w = cvt_pk_bf16(b[2], b[3]); return w; }
__device__ __forceinline__ void unpack8(const u32x4 w, f32x4& a, f32x4& b) { a = (f32x4){bflo(w.x), bfhi(w.x), bflo(w.y), bfhi(w.y)}; b = (f32x4){bflo(w.z), bfhi(w.z), bflo(w.w), bfhi(w.w)}; }
__device__ __forceinline__ f32x4 sig4(f32x4 x) { return (f32x4){sigmoidf_(x[0]), sigmoidf_(x[1]), sigmoidf_(x[2]), sigmoidf_(x[3])}; }

struct EpiStore {
    static constexpr bool PERM = true; bf16* O; int ldc;
    __device__ __forceinline__ void operator()(const f32x4 (&acc)[2][2][4][2], const pg8::Unit& u, int wr, int wc, int fr, int fq) const {
        EPI_ROWS(u); const int col0 = u.pn * 256 + wc * 32 + 8 * fq;
        EPI_LOOP { bf16* rowp = O + (size_t)(row0 + ai * 128 + m * 16) * ldc + col0;
#pragma unroll
            for (int bj = 0; bj < 2; ++bj) *(u32x4*)(rowp + bj * 128) = pack8(acc[ai][bj][m][0], acc[ai][bj][m][1]); }
    }
};
struct EpiGlu {
    static constexpr bool PERM = true; const bf16* A2; bf16* A3; const float* bias;
    __device__ __forceinline__ void operator()(const f32x4 (&acc)[2][2][4][2], const pg8::Unit& u, int wr, int wc, int fr, int fq) const {
        EPI_ROWS(u); const int col0 = u.pn * 256 + wc * 32 + 8 * fq;
        f32x4 bv[2][2];
#pragma unroll
        for (int bj = 0; bj < 2; ++bj)
#pragma unroll
            for (int n = 0; n < 2; ++n) bv[bj][n] = *(const f32x4*)(bias + col0 + bj * 128 + 4 * n);
        EPI_LOOP { const size_t off = (size_t)(row0 + ai * 128 + m * 16) * 512 + col0;
#pragma unroll
            for (int bj = 0; bj < 2; ++bj) { f32x4 a0, a1; unpack8(*(const u32x4*)(A2 + off + bj * 128), a0, a1);
                const f32x4 v0 = a0 * sig4(acc[ai][bj][m][0] + bv[bj][0]), v1 = a1 * sig4(acc[ai][bj][m][1] + bv[bj][1]);
                *(u32x4*)(A3 + off + bj * 128) = pack8(v0, v1); } }
    }
};
template <bool ADD> struct EpiGate {
    static constexpr bool PERM = true; const bf16* proj; int gc0; const float* bg; const bf16* Prev; bf16* O;
    __device__ __forceinline__ void operator()(const f32x4 (&acc)[2][2][4][2], const pg8::Unit& u, int wr, int wc, int fr, int fq) const {
        EPI_ROWS(u); const int col0 = u.pn * 256 + wc * 32 + 8 * fq;
        f32x4 bv[2][2];
#pragma unroll
        for (int bj = 0; bj < 2; ++bj)
#pragma unroll
            for (int n = 0; n < 2; ++n) bv[bj][n] = *(const f32x4*)(bg + col0 + bj * 128 + 4 * n);
        EPI_LOOP { const int row = row0 + ai * 128 + m * 16; const size_t off = (size_t)row * 1024 + col0; const size_t poff = (size_t)row * LDP + gc0 + col0;
#pragma unroll
            for (int bj = 0; bj < 2; ++bj) { f32x4 g0, g1; unpack8(*(const u32x4*)(proj + poff + bj * 128), g0, g1);
                f32x4 v0 = sig4(g0 + bv[bj][0]) * acc[ai][bj][m][0], v1 = sig4(g1 + bv[bj][1]) * acc[ai][bj][m][1];
                if (ADD) { f32x4 p0, p1; unpack8(*(const u32x4*)(Prev + off + bj * 128), p0, p1); v0 += p0; v1 += p1; }
                *(u32x4*)(O + off + bj * 128) = pack8(v0, v1); } }
    }
};
struct EpiX1 {
    static constexpr bool PERM = true; const float* x; const float* mod; bf16* X1;
    __device__ __forceinline__ void operator()(const f32x4 (&acc)[2][2][4][2], const pg8::Unit& u, int wr, int wc, int fr, int fq) const {
        EPI_ROWS(u); const int col0 = u.pn * 256 + wc * 32 + 8 * fq; const int b = (u.pm * 256) / SEQ;
        f32x4 gv[2][2];
#pragma unroll
        for (int bj = 0; bj < 2; ++bj)
#pragma unroll
            for (int n = 0; n < 2; ++n) gv[bj][n] = *(const f32x4*)(mod + b * 6144 + 2 * D + col0 + bj * 128 + 4 * n);
        EPI_LOOP { const size_t off = (size_t)(row0 + ai * 128 + m * 16) * D + col0;
#pragma unroll
            for (int bj = 0; bj < 2; ++bj) { const f32x4 v0 = *(const f32x4*)(x + off + bj * 128) + gv[bj][0] * acc[ai][bj][m][0], v1 = *(const f32x4*)(x + off + bj * 128 + 4) + gv[bj][1] * acc[ai][bj][m][1];
                *(u32x4*)(X1 + off + bj * 128) = pack8(v0, v1); } }
    }
};
struct EpiSwiglu {
    static constexpr bool PERM = true; const float* bin; bf16* ACT;
    __device__ __forceinline__ void operator()(const f32x4 (&acc)[2][2][4][2], const pg8::Unit& u, int wr, int wc, int fr, int fq) const {
        EPI_ROWS(u); const int e = u.pn >> 3, pl = u.pn & 7; const int f0 = pl * 128 + wc * 32 + 8 * fq;
        f32x4 bg[2], bl[2];
#pragma unroll
        for (int n = 0; n < 2; ++n) { bg[n] = *(const f32x4*)(bin + e * 2048 + f0 + 4 * n); bl[n] = *(const f32x4*)(bin + e * 2048 + 1024 + f0 + 4 * n); }
        EPI_LOOP { f32x4 o[2];
#pragma unroll
            for (int n = 0; n < 2; ++n) { const f32x4 zg = acc[ai][0][m][n] + bg[n], zl = acc[ai][1][m][n] + bl[n];
#pragma unroll
                for (int j = 0; j < 4; ++j) { const float gl = fminf(zg[j], 7.0f); const float li = fminf(fmaxf(zl[j], -7.0f), 7.0f); o[n][j] = gl * sigmoidf_(1.702f * gl) * (li + 1.0f); } }
            *(v2u*)((unsigned char*)ACT + (size_t)(row0 + ai * 128 + m * 16) * 1024 + f0) = (v2u){pk4_fp8(8.f * o[0][0], 8.f * o[0][1], 8.f * o[0][2], 8.f * o[0][3]), pk4_fp8(8.f * o[1][0], 8.f * o[1][1], 8.f * o[1][2], 8.f * o[1][3])}; }
    }
};
struct EpiY {
    static constexpr bool PERM = true; const float* bout; bf16* Y;
    __device__ __forceinline__ void operator()(const f32x4 (&acc)[2][2][4][2], const pg8::Unit& u, int wr, int wc, int fr, int fq) const {
        EPI_ROWS(u); const int e = u.pn >> 2, pl = u.pn & 3; const int col0 = pl * 256 + wc * 32 + 8 * fq;
        f32x4 bv[2][2];
#pragma unroll
        for (int bj = 0; bj < 2; ++bj)
#pragma unroll
            for (int n = 0; n < 2; ++n) bv[bj][n] = *(const f32x4*)(bout + e * 1024 + col0 + bj * 128 + 4 * n);
        EPI_LOOP { unsigned char* rowp = (unsigned char*)Y + (size_t)(row0 + ai * 128 + m * 16) * 1024 + col0;
#pragma unroll
            for (int bj = 0; bj < 2; ++bj) { const f32x4 v0 = (acc[ai][bj][m][0] + bv[bj][0]) * 16.0f, v1 = (acc[ai][bj][m][1] + bv[bj][1]) * 16.0f;
                *(v2u*)(rowp + bj * 128) = (v2u){pk4_fp8(v0[0], v0[1], v0[2], v0[3]), pk4_fp8(v1[0], v1[1], v1[2], v1[3])}; } }
    }
};

struct TItem { const float* src; bf16* dst; int ld, ldk; int f8; };
__device__ __forceinline__ void titem_load(const TItem& t, int lane, f32x4 (&r)[8]) {
#pragma unroll
    for (int i = 0; i < 8; ++i) r[i] = *(const f32x4*)(t.src + (size_t)(8 * i + (lane >> 3)) * t.ld + 4 * (lane & 7));
}
__device__ __forceinline__ void titem_store(const TItem& t, int lane, const f32x4 (&r)[8], LAS float* scr) {
#pragma unroll
    for (int i = 0; i < 8; ++i) { LAS float* p = scr + (8 * i + (lane >> 3)) * 33 + 4 * (lane & 7); p[0] = r[i][0]; p[1] = r[i][1]; p[2] = r[i][2]; p[3] = r[i][3]; }
    LDS_WAIT(); asm volatile("" ::: "memory");
    const int c = lane & 7;
#pragma unroll
    for (int j = 0; j < 4; ++j) { const int n = (lane >> 3) + 8 * j; const LAS float* s = scr + (8 * c) * 33 + n;
        if (t.f8) { *(GAS v2u*)((unsigned char*)t.dst + (size_t)n * t.ldk + 8 * c) = (v2u){pk4_fp8(32.f * s[0 * 33], 32.f * s[1 * 33], 32.f * s[2 * 33], 32.f * s[3 * 33]), pk4_fp8(32.f * s[4 * 33], 32.f * s[5 * 33], 32.f * s[6 * 33], 32.f * s[7 * 33])}; }
        else { v4u o; o.x = pk2(s[0 * 33], s[1 * 33]); o.y = pk2(s[2 * 33], s[3 * 33]); o.z = pk2(s[4 * 33], s[5 * 33]); o.w = pk2(s[6 * 33], s[7 * 33]);
            *(GAS v4u*)(t.dst + (size_t)n * t.ldk + 8 * c) = o; } }
    LDS_WAIT(); asm volatile("" ::: "memory");
}
__device__ __forceinline__ void p0_prologue(Frame& F, const float* const* __restrict__ INP) {
    {
        LAS float* sc = (LAS float*)(F.lds);
        LAS float* red = (LAS float*)(F.lds + 9 * 1024 * 4);
        for (int i = F.tid; i < 9 * 1024; i += NWAVES * 64) { const int r = i >> 10, k = i & 1023; const float v = r < 8 ? INP[1][r * 1024 + k] : INP[3][k]; sc[i] = v / (1.0f + __expf(-v)); }
        __syncthreads();
        const float* wada = INP[4]; const float* bada = INP[5];
        float* mod = (float*)(F.ws + WS_MOD);
        for (int cg = blockIdx.x; cg < 256; cg += F.G) {
            const int j0 = cg * 24, col = F.lane & 31, kp = F.lane >> 5;
            float a[9];
#pragma unroll
            for (int r = 0; r < 9; ++r) a[r] = 0.f;
            if (col < 24) {
                for (int i = 0; i < 64; ++i) { const int k = F.wave * 128 + 2 * i + kp; const float wv = wada[(size_t)k * 6144 + j0 + col];
#pragma unroll
                    for (int r = 0; r < 9; ++r) a[r] += sc[r * 1024 + k] * wv; }
            }
#pragma unroll
            for (int r = 0; r < 9; ++r) red[((F.wave * 2 + kp) * 9 + r) * 32 + col] = a[r];
            __syncthreads();
            if (F.tid < 9 * 32) { const int r = F.tid >> 5, cc = F.tid & 31;
                if (cc < 24) { float s = 0.f; for (int p = 0; p < 16; ++p) s += red[(p * 9 + r) * 32 + cc]; const int j = j0 + cc; s += bada[j];
                    if (r < 8) mod[r * 6144 + j] = s; else if (j < 2048) mod[8 * 6144 + j] = s; } }
            __syncthreads();
        }
    }
    LAS float* scr = (LAS float*)(F.lds + F.wave * 16384);
    const int gw = F.vcu * NWAVES + F.wave, NGW = F.G * NWAVES;
    bf16* WIN = (bf16*)(F.ws + WS_WIN); bf16* WGLU = (bf16*)(F.ws + WS_WGLU); bf16* WA = (bf16*)(F.ws + WS_WA); bf16* WB = (bf16*)(F.ws + WS_WB); bf16* WO = (bf16*)(F.ws + WS_WO);
    bf16* WEIN = (bf16*)(F.ws + WS_WEIN); bf16* WEOUT = (bf16*)(F.ws + WS_WEOUT);
    constexpr int I_IN = 177 * 16, I_GLU = 16 * 8, I_A = 32 * 16, I_B = 32 * 8, I_O = 32 * 16, I_EIN = 32 * 64 * 16, I_EOUT = 32 * 32 * 16;
    constexpr int NITEMS = I_IN + I_GLU + I_A + I_B + I_O + I_EIN + I_EOUT;
#define P0_DECODE(it_, T) do { int r = (it_); \
        if (r < I_IN) { const int kb = r / 177, nb = r % 177, n0 = nb * 32; const int sc0 = n0 < 2048 ? n0 : (n0 < 5632 ? n0 + 32 : 2048); \
            T.src = INP[8] + (size_t)kb * 64 * 5664 + sc0; T.ld = 5664; T.dst = (bf16*)((unsigned char*)WIN + (size_t)n0 * 1024 + kb * 64); T.ldk = 1024; T.f8 = 1; break; } r -= I_IN; \
        if (r < I_GLU) { const int kb = r / 16, nb = r % 16; T.src = INP[21] + (size_t)kb * 64 * 512 + nb * 32; T.ld = 512; T.dst = WGLU + (size_t)nb * 32 * 512 + kb * 64; T.ldk = 512; T.f8 = 0; break; } r -= I_GLU; \
        if (r < I_A) { const int kb = r / 32, nb = r % 32; T.src = INP[12] + (size_t)kb * 64 * 1024 + nb * 32; T.ld = 1024; T.dst = WA + (size_t)nb * 32 * 1024 + kb * 64; T.ldk = 1024; T.f8 = 0; break; } r -= I_A; \
        if (r < I_B) { const int kb = r / 32, nb = r % 32; T.src = INP[23] + (size_t)kb * 64 * 1024 + nb * 32; T.ld = 1024; T.dst = WB + (size_t)nb * 32 * 512 + kb * 64; T.ldk = 512; T.f8 = 0; break; } r -= I_B; \
        if (r < I_O) { const int kb = r / 32, nb = r % 32; T.src = INP[25] + (size_t)kb * 64 * 1024 + nb * 32; T.ld = 1024; T.dst = WO + (size_t)nb * 32 * 1024 + kb * 64; T.ldk = 1024; T.f8 = 0; break; } r -= I_O; \
        if (r < I_EIN) { const int e = r / 1024, q = r % 1024, kb = q / 64, nb = q % 64; const int dr = nb * 32, pn = dr >> 8, bj = (dr >> 7) & 1, xx = dr & 127; \
            T.src = INP[28] + (size_t)e * 1024 * 2048 + (size_t)kb * 64 * 2048 + bj * 1024 + pn * 128 + xx; T.ld = 2048; T.dst = (bf16*)((unsigned char*)WEIN + (size_t)e * 2048 * 1024 + (size_t)dr * 1024 + kb * 64); T.ldk = 1024; T.f8 = 1; break; } r -= I_EIN; \
        { const int e = r / 512, q = r % 512, kb = q / 32, nb = q % 32; \
            T.src = INP[30] + (size_t)e * 1024 * 1024 + (size_t)kb * 64 * 1024 + nb * 32; T.ld = 1024; T.dst = (bf16*)((unsigned char*)WEOUT + (size_t)e * 1024 * 1024 + (size_t)nb * 32 * 1024 + kb * 64); T.ldk = 1024; T.f8 = 1; } } while (0)
    {
        TItem ta, tb; f32x4 ra[8], rb[8];
        int it = gw;
        if (it < NITEMS) { P0_DECODE(it, ta); titem_load(ta, F.lane, ra); }
        while (it < NITEMS) {
            const int nx = it + NGW;
            if (nx < NITEMS) { P0_DECODE(nx, tb); titem_load(tb, F.lane, rb); }
            titem_store(ta, F.lane, ra, scr);
            ta = tb;
#pragma unroll
            for (int i = 0; i < 8; ++i) ra[i] = rb[i];
            it = nx;
        }
    }
#undef P0_DECODE
    { const int gt = blockIdx.x * (NWAVES * 64) + F.tid, NT = F.G * NWAVES * 64; GAS v4u* z = (GAS v4u*)((unsigned char*)WIN + (size_t)5664 * 1024);
        for (int i = gt; i < 224 * 1024 / 16; i += NT) z[i] = (v4u){0u, 0u, 0u, 0u}; }
}

__device__ __forceinline__ void p1_norm1(Frame& F, const float* const* __restrict__ INP) {
    const int gw = F.vcu * NWAVES + F.wave, NGW = F.G * NWAVES;
    const float* mod = (const float*)(F.ws + WS_MOD); bf16* H1 = (bf16*)(F.ws + WS_H1);
    for (int m = gw; m < MT; m += NGW) {
        const float* xr; const float* sh; const float* scl;
        if (m < ML) { const int b = m / SEQ; xr = INP[0] + (size_t)m * D; sh = mod + b * 6144; scl = sh + D; }
        else { xr = INP[2] + (size_t)(m - ML) * D; sh = mod + 8 * 6144; scl = sh + D; }
        f32x4 v[4]; float s = 0.f;
#pragma unroll
        for (int j = 0; j < 4; ++j) { v[j] = *(const f32x4*)(xr + 256 * j + 4 * F.lane); s += (v[j][0] * v[j][0] + v[j][1] * v[j][1]) + (v[j][2] * v[j][2] + v[j][3] * v[j][3]); }
        const float rstd = 1.0f / sqrtf(wave_sum(s) * (1.0f / D) + EPS);
#pragma unroll
        for (int j = 0; j < 4; ++j) { const int c = 256 * j + 4 * F.lane; const f32x4 g = *(const f32x4*)(INP[6] + c), a = *(const f32x4*)(scl + c), bb = *(const f32x4*)(sh + c);
            const f32x4 y = v[j] * rstd * g * (a + 1.0f) + bb;
            *(unsigned*)((unsigned char*)H1 + (size_t)m * D + c) = pk4_fp8(y[0], y[1], y[2], y[3]); }
    }
}

__device__ __forceinline__ void conv_fma8(float (&a)[8], const v4u x, const float* wp) {
    const f32x4 w0 = *(const f32x4*)(wp), w1 = *(const f32x4*)(wp + 4);
    a[0] += bflo(x.x) * w0[0]; a[1] += bfhi(x.x) * w0[1]; a[2] += bflo(x.y) * w0[2]; a[3] += bfhi(x.y) * w0[3];
    a[4] += bflo(x.z) * w1[0]; a[5] += bfhi(x.z) * w1[1]; a[6] += bflo(x.w) * w1[2]; a[7] += bfhi(x.w) * w1[3];
}
__device__ __forceinline__ void p3_conv(Frame& F, const float* const* __restrict__ INP) {
    const bf16* PROJ = (const bf16*)(F.ws + WS_PROJ); bf16* QKC = (bf16*)(F.ws + WS_QKC); const float* wc = INP[9];
    const int NT = F.G * NWAVES * 64;
    for (int it = F.vcu * (NWAVES * 64) + F.tid; it < NB * 64 * 4 * 128; it += NT) {
        const int ch0 = (it & 127) * 8, seg = (it >> 7) & 3, gr = (it >> 9) & 63, b = it >> 15, c0 = seg * 16;
        const bf16* base = PROJ + (size_t)(b * SEQ) * LDP + ch0;
        const float scale = ch0 < 512 ? 0.125f : 1.0f;
        v4u win[3][3];
        const v4u z = (v4u){0u, 0u, 0u, 0u};
#define P3_LOADCOL(slot, cc) do { _Pragma("unroll") for (int ky = 0; ky < 3; ++ky) { const int rr = gr + ky - 1; \
            win[slot][ky] = (rr >= 0 && rr < 64 && (cc) >= 0 && (cc) < 64) ? *(const v4u*)(base + (size_t)(rr * 64 + (cc)) * LDP) : z; } } while (0)
        P3_LOADCOL(0, c0 - 1); P3_LOADCOL(1, c0);
#pragma unroll
        for (int cc = 0; cc < 16; ++cc) {
            const int c = c0 + cc;
            P3_LOADCOL((cc + 2) % 3, c + 1);
            float a[8];
#pragma unroll
            for (int j = 0; j < 8; ++j) a[j] = 0.f;
#pragma unroll
            for (int ky = 0; ky < 3; ++ky)
#pragma unroll
                for (int kx = 0; kx < 3; ++kx) conv_fma8(a, win[(cc + kx) % 3][ky], wc + (ky * 3 + kx) * 1024 + ch0);
#pragma unroll
            for (int j = 0; j < 8; ++j) a[j] = a[j] / (1.0f + __expf(-a[j])) * scale;
            *(v4u*)(QKC + (size_t)(b * SEQ + gr * 64 + c) * 1024 + ch0) = (v4u){pk2(a[0], a[1]), pk2(a[2], a[3]), pk2(a[4], a[5]), pk2(a[6], a[7])};
        }
#undef P3_LOADCOL
    }
    for (int w = F.vcu * (NWAVES * 64) + F.tid; w < MC * 128; w += NT) {
        const int row = ML + (w >> 7), ch0 = (w & 127) * 8, t = (w >> 7) % CTXL;
        float a[8];
#pragma unroll
        for (int j = 0; j < 8; ++j) a[j] = 0.f;
#pragma unroll
        for (int kx = 0; kx < 3; ++kx) { const int tt = t + kx - 1;
            if (tt >= 0 && tt < CTXL) conv_fma8(a, *(const v4u*)(PROJ + (size_t)(row + kx - 1) * LDP + ch0), wc + (3 + kx) * 1024 + ch0); }
        const float scale = ch0 < 512 ? 0.125f : 1.0f;
#pragma unroll
        for (int j = 0; j < 8; ++j) a[j] = a[j] / (1.0f + __expf(-a[j])) * scale;
        *(v4u*)(QKC + (size_t)row * 1024 + ch0) = (v4u){pk2(a[0], a[1]), pk2(a[2], a[3]), pk2(a[4], a[5]), pk2(a[6], a[7])};
    }
    {
        float* GB = (float*)(F.ws + WS_GS); float* GG = GB + 128 * 4352; float* GP = GG + 128 * 4352;
        const int gw = F.vcu * NWAVES + F.wave, NGW = F.G * NWAVES, lane = F.lane;
        for (int it = gw; it < 128 * 34; it += NGW) {
            const int jc = it % 34, dbh = it / 34, h = dbh & 7, b = (dbh >> 3) & 7, d = dbh >> 6;
            const bool lat = jc >= 2; const int p0 = lat ? 128 * (jc - 2) : 128 * jc, Lseq = lat ? SEQ : CTXL, rowbase = lat ? b * SEQ : ML + b * CTXL;
            const float bi_ = INP[10][d * 16 + h], bf_ = INP[10][d * 16 + 8 + h];
            float li2[2], lf2[2];
#pragma unroll
            for (int e = 0; e < 2; ++e) { const int sp = 2 * lane + e; const int tt = d ? (Lseq - 1 - (p0 + sp)) : (p0 + sp); const size_t row = (size_t)(rowbase + tt);
                li2[e] = bf2f(PROJ[row * LDP + PC_IF + d * 16 + h]) + bi_; const float xf = bf2f(PROJ[row * LDP + PC_IF + d * 16 + 8 + h]) + bf_;
                lf2[e] = fminf(xf, 0.f) - log1pf(expf(-fabsf(xf))); }
            const float c1 = lf2[0] + lf2[1]; float inc = c1;
#pragma unroll
            for (int o = 1; o < 64; o <<= 1) { const float t = __shfl_up(inc, o); if (lane >= o) inc += t; }
            const float exc = inc - c1, b0 = exc + lf2[0], b1 = exc + c1, g0 = li2[0] - b0, g1 = li2[1] - b1;
            float pmx = fmaxf(g0, g1);
#pragma unroll
            for (int o = 1; o < 64; o <<= 1) { const float t = __shfl_up(pmx, o); if (lane >= o) pmx = fmaxf(pmx, t); }
            float pex = __shfl_up(pmx, 1); if (lane == 0) pex = -INFINITY;
            const size_t o = (size_t)dbh * 4352 + 128 * jc + 2 * lane;
            *(float2*)(GB + o) = make_float2(b0, b1); *(float2*)(GG + o) = make_float2(g0, g1); *(float2*)(GP + o) = make_float2(fmaxf(pex, g0), pmx);
        }
    }
}

__device__ __forceinline__ void mma32_nt(f32x16& acc, const LAS bf16* A, int lda, const LAS bf16* Bt, int ldb, int K, int lane) {
    const int r = lane & 31, h = lane >> 5;
#pragma unroll
    for (int k0 = 0; k0 < K; k0 += 16) {
        const bf16x8 a = *(const LAS bf16x8*)(A + r * lda + k0 + 8 * h);
        const bf16x8 b = *(const LAS bf16x8*)(Bt + r * ldb + k0 + 8 * h);
        acc = __builtin_amdgcn_mfma_f32_32x32x16_bf16(a, b, acc, 0, 0, 0);
        if ((k0 & 63) == 48) __builtin_amdgcn_sched_barrier(0);
    }
}
__device__ __forceinline__ void mma16_nt(f32x4& acc, const LAS bf16* A, int lda, const LAS bf16* Bt, int ldb, int K, int lane) {
    const int r = lane & 15, q = lane >> 4;
    for (int k0 = 0; k0 < K; k0 += 32) {
        const bf16x8 a = *(const LAS bf16x8*)(A + r * lda + k0 + 8 * q);
        const bf16x8 b = *(const LAS bf16x8*)(Bt + r * ldb + k0 + 8 * q);
        acc = __builtin_amdgcn_mfma_f32_16x16x32_bf16(a, b, acc, 0, 0, 0);
    }
}
__device__ __forceinline__ int row32(int reg, int lane) { return (reg & 3) + 8 * (reg >> 2) + 4 * (lane >> 5); }
__device__ __forceinline__ float logsigmoidf_(float x) { return fminf(x, 0.f) - log1pf(expf(-fabsf(x))); }

typedef short s16x4 __attribute__((ext_vector_type(4)));
__device__ __forceinline__ s16x4 tr_read(const LAS bf16* p) { return __builtin_amdgcn_ds_read_tr16_b64_v4i16((LAS s16x4*)p); }
__device__ __forceinline__ bf16x8 tr_frag32_perm(const LAS bf16* T, int ld, int k0, int x0, int lane) {
    const int h = lane >> 5, i = lane & 15, q = i >> 2, p = i & 3, xb = 16 * ((lane >> 4) & 1);
    const LAS bf16* a = T + (k0 + 4 * h + q) * ld + x0 + xb + 4 * p;
    const s16x4 lo = tr_read(a), hi = tr_read(a + 8 * ld);
    return (bf16x8){lo[0], lo[1], lo[2], lo[3], hi[0], hi[1], hi[2], hi[3]};
}
__device__ __forceinline__ bf16x8 tr_frag16(const LAS bf16* T, int ld, int k0, int x0, int lane) {
    const int q4 = lane >> 4, i = lane & 15, q = i >> 2, p = i & 3;
    const LAS bf16* a = T + (k0 + 8 * q4 + q) * ld + x0 + 4 * p;
    const s16x4 lo = tr_read(a), hi = tr_read(a + 4 * ld);
    return (bf16x8){lo[0], lo[1], lo[2], lo[3], hi[0], hi[1], hi[2], hi[3]};
}
__device__ __forceinline__ v4u scale8(const v4u k8, float ww) {
    return (v4u){pk2(ww * bflo(k8.x), ww * bfhi(k8.x)), pk2(ww * bflo(k8.y), ww * bfhi(k8.y)), pk2(ww * bflo(k8.z), ww * bfhi(k8.z)), pk2(ww * bflo(k8.w), ww * bfhi(k8.w))};
}

template <int MODE>
__device__ __forceinline__ void p4_mlstm(Frame& F, const float* const* __restrict__ INP, int unit) {
    const int vh = unit & 1, h = (unit >> 1) & 7, b = (unit >> 4) & 7, d = unit >> 7;
    LAS bf16* Qs = (LAS bf16*)(F.lds + 0);
    LAS bf16* Ks = (LAS bf16*)(F.lds + 18432);
    LAS bf16* Kw = (LAS bf16*)(F.lds + 36864);
    LAS bf16* Vs = (LAS bf16*)(F.lds + 55296);
    LAS bf16* Cb = (LAS bf16*)(F.lds + 73728);
    LAS float* vec = (LAS float*)(F.lds + 82944);
    LAS float *rowt = vec, *colt = vec + 128, *iev = vec + 256, *emt = vec + 384, *nv = vec + 512, *npart = vec + 576;
    const bf16* PROJ = (const bf16*)(F.ws + WS_PROJ); const bf16* QKC = (const bf16*)(F.ws + WS_QKC); bf16* HDIR = (bf16*)(F.ws + WS_HDIR) + (size_t)d * ML * 1024;
    const float* GB = (const float*)(F.ws + WS_GS) + (size_t)((d * 8 + b) * 8 + h) * 4352; const float* GG = GB + 128 * 4352; const float* GP = GG + 128 * 4352;
    int tid = F.tid; asm volatile("" : "+v"(tid));
    const int lane = tid & 63, w = F.wave;
    for (int i = tid; i < 64 * 72; i += 512) Cb[i] = 0;
    if (tid < 64) nv[tid] = 0.f;
    f32x4 accC[2] = {(f32x4){0.f, 0.f, 0.f, 0.f}, (f32x4){0.f, 0.f, 0.f, 0.f}};
    float m_old = 0.f, dec_prev = 0.f;
    v4u pq[2], pk[2], pv[2]; float pgb = 0.f, pgp = 0.f, pgc = 0.f, pgg[2], pbend, pgmax; v2u hout[4]; bf16* hptr = nullptr; bool hpend = false;
    const int zl = tid >> 9;
#define ML_PREFETCH(jn) do { const bool lat_ = (jn) >= 2; const int p0_ = lat_ ? 128 * ((jn) - 2) : 128 * (jn), L_ = lat_ ? SEQ : CTXL, rb_ = lat_ ? b * SEQ : ML + b * CTXL; \
        _Pragma("unroll") for (int i = 0; i < 2; ++i) { const int id = tid + 512 * i, s_ = id >> 3, c_ = id & 7; const int tt = d ? (L_ - 1 - (p0_ + s_)) : (p0_ + s_); const size_t row = (size_t)(rb_ + tt); \
            pq[i] = *(const v4u*)(QKC + row * 1024 + h * 64 + c_ * 8); pk[i] = *(const v4u*)(QKC + row * 1024 + 512 + h * 64 + c_ * 8); pv[i] = *(const v4u*)(PROJ + row * LDP + PC_V + h * 128 + vh * 64 + c_ * 8); \
            pgg[i] = GG[128 * (jn) + s_]; } \
        if (tid < 128) { pgb = GB[128 * (jn) + tid]; pgp = GP[128 * (jn) + tid]; pgc = GG[128 * (jn) + tid]; } \
        pbend = GB[128 * (jn) + 127 + zl]; pgmax = GP[128 * (jn) + 127 + zl]; } while (0)
    ML_PREFETCH(0);
    __syncthreads();
    for (int j = 0; j < 34; ++j) {
        const bool lat = j >= 2;
        const int p0 = lat ? 128 * (j - 2) : 128 * j, Lseq = lat ? SEQ : CTXL, rowbase = lat ? b * SEQ : ML + b * CTXL;
        const float bend = pbend, gmax = pgmax;
        const float mnew = fmaxf(bend + m_old, bend + gmax), dec = __expf(bend + m_old - mnew);
#pragma unroll
        for (int i = 0; i < 2; ++i) { const int id = tid + 512 * i, s = id >> 3, c = id & 7;
            *(LAS v4u*)(Qs + s * 72 + c * 8) = pq[i]; *(LAS v4u*)(Ks + s * 72 + c * 8) = pk[i]; *(LAS v4u*)(Vs + s * 72 + c * 8) = pv[i];
            *(LAS v4u*)(Kw + s * 72 + c * 8) = scale8(pk[i], __expf(bend + pgg[i] - mnew)); }
        if (tid < 128) { const float r = fmaxf(m_old, pgp); rowt[tid] = -r * 1.44269504089f; colt[tid] = pgc * 1.44269504089f; iev[tid] = __expf(m_old - r); emt[tid] = __expf(-pgb - r); }
        if (j > 0) {
            const int vi = w >> 1;
#pragma unroll
            for (int jj = 0; jj < 2; ++jj) { const int ki = 2 * (w & 1) + jj;
#pragma unroll
                for (int reg = 0; reg < 4; ++reg) Cb[(16 * vi + (lane >> 4) * 4 + reg) * 72 + 16 * ki + (lane & 15)] = (bf16)f2bf(accC[jj][reg]); }
            if (tid < 64) { float sacc = 0.f;
#pragma unroll
                for (int p = 0; p < 8; ++p) sacc += npart[p * 64 + tid];
                nv[tid] = dec_prev * nv[tid] + sacc; }
        }
        LBAR();
        if (j + 1 < 34 && !(MODE & 4)) ML_PREFETCH(j + 1);
        if (hpend) {
#pragma unroll
            for (int rg = 0; rg < 4; ++rg) *(v2u*)(hptr + 8 * rg) = hout[rg];
            hpend = false; }
        if (lat && !(MODE & 1)) { const int tm = w >> 1, vt = w & 1, tl = lane & 31, t = 32 * tm + tl, hh = lane >> 5; f32x16 acc;
#pragma unroll
            for (int reg = 0; reg < 16; ++reg) acc[reg] = 0.f;
            mma32_nt(acc, Cb + 32 * vt * 72, 72, Qs + 32 * tm * 72, 72, 64, lane);
            const float ie = iev[t], rt = rowt[t];
#pragma unroll
            for (int reg = 0; reg < 16; ++reg) acc[reg] *= ie;
            float rs = 0.f;
            for (int st = (MODE & 8) ? tm : 0; st <= tm; ++st) {
                f32x16 X;
#pragma unroll
                for (int reg = 0; reg < 16; ++reg) X[reg] = 0.f;
                mma32_nt(X, Ks + 32 * st * 72, 72, Qs + 32 * tm * 72, 72, 64, lane);
                const LAS float* cp = colt + 32 * st + 4 * hh;
                if (st == tm) { const int dlim = tl - 4 * hh;
#pragma unroll
                    for (int rg = 0; rg < 4; ++rg) { const f32x4 c4 = *(const LAS f32x4*)(cp + 8 * rg);
#pragma unroll
                        for (int e = 0; e < 4; ++e) { const float arg = (8 * rg + e <= dlim) ? c4[e] + rt : -INFINITY; const float pvv = X[4 * rg + e] * __builtin_amdgcn_exp2f(arg); X[4 * rg + e] = pvv; rs += pvv; } }
                } else {
#pragma unroll
                    for (int rg = 0; rg < 4; ++rg) { const f32x4 c4 = *(const LAS f32x4*)(cp + 8 * rg);
#pragma unroll
                        for (int e = 0; e < 4; ++e) { const float pvv = X[4 * rg + e] * __builtin_amdgcn_exp2f(c4[e] + rt); X[4 * rg + e] = pvv; rs += pvv; } }
                }
#pragma unroll
                for (int ks = 0; ks < 2; ++ks) {
                    const v4u bw = (v4u){cvtpk(X[8 * ks], X[8 * ks + 1]), cvtpk(X[8 * ks + 2], X[8 * ks + 3]), cvtpk(X[8 * ks + 4], X[8 * ks + 5]), cvtpk(X[8 * ks + 6], X[8 * ks + 7])};
                    const bf16x8 af = tr_frag32_perm(Vs, 72, 32 * st + 16 * ks, 32 * vt, lane);
                    acc = __builtin_amdgcn_mfma_f32_32x32x16_bf16(af, __builtin_bit_cast(bf16x8, bw), acc, 0, 0, 0); }
            }
            float nq = 0.f;
#pragma unroll
            for (int q = 0; q < 4; ++q) { const v4u q8 = *(const LAS v4u*)(Qs + t * 72 + 32 * hh + 8 * q); const LAS float* nn = nv + 32 * hh + 8 * q;
                nq += bflo(q8.x) * nn[0] + bfhi(q8.x) * nn[1] + bflo(q8.y) * nn[2] + bfhi(q8.y) * nn[3] + bflo(q8.z) * nn[4] + bfhi(q8.z) * nn[5] + bflo(q8.w) * nn[6] + bfhi(q8.w) * nn[7]; }
            rs += __shfl_xor(rs, 32); nq += __shfl_xor(nq, 32);
            const float rd = 1.0f / fmaxf(fabsf(ie * nq + rs), emt[t]);
            const int tt = d ? (Lseq - 1 - (p0 + t)) : (p0 + t);
            hptr = HDIR + (size_t)(rowbase + tt) * 1024 + h * 128 + vh * 64 + 32 * vt + 4 * hh;
#pragma unroll
            for (int rg = 0; rg < 4; ++rg) hout[rg] = (v2u){pk2(acc[4 * rg] * rd, acc[4 * rg + 1] * rd), pk2(acc[4 * rg + 2] * rd, acc[4 * rg + 3] * rd)};
            hpend = true; }
        if (!(MODE & 2)) { const int vi = w >> 1;
            accC[0] *= dec; accC[1] *= dec;
#pragma unroll
            for (int st4 = 0; st4 < 4; ++st4) { const bf16x8 af = tr_frag16(Vs, 72, 32 * st4, 16 * vi, lane);
#pragma unroll
                for (int jj = 0; jj < 2; ++jj) { const bf16x8 bfr = tr_frag16(Kw, 72, 32 * st4, 16 * (2 * (w & 1) + jj), lane); accC[jj] = __builtin_amdgcn_mfma_f32_16x16x32_bf16(af, bfr, accC[jj], 0, 0, 0); } } }
        { const int k = tid & 63, part = tid >> 6; float sacc = 0.f;
#pragma unroll
            for (int q = 0; q < 16; ++q) sacc += bf2f(Kw[(16 * part + q) * 72 + k]);
            npart[part * 64 + k] = sacc; }
        m_old = mnew; dec_prev = dec;
        LBAR();
    }
    if (hpend) {
#pragma unroll
        for (int rg = 0; rg < 4; ++rg) *(v2u*)(hptr + 8 * rg) = hout[rg]; }
#undef ML_PREFETCH
}

__device__ __forceinline__ void s5_disc(const float* const* __restrict__ INP, int d, int g, int p, float& ar, float& ai, float& cfr, float& cfi) {
    const float dt = expf(INP[15][d * 32 + g]); const float are = INP[13][(d * 32 + g) * 64 + p], aim = INP[14][(d * 32 + g) * 64 + p];
    const float mag = expf(dt * are), ang = dt * aim; ar = mag * cosf(ang); ai = mag * sinf(ang);
    const float den = are * are + aim * aim, xr = ar - 1.0f; cfr = (xr * are + ai * aim) / den; cfi = (ai * are - xr * aim) / den;
}
__device__ __forceinline__ void p4_s5(Frame& F, const float* const* __restrict__ INP, int unit) {
    const int gp = unit & 15, b = (unit >> 4) & 7, d = unit >> 7;
    LAS bf16* BHt = (LAS bf16*)(F.lds + 0);
    LAS bf16* Cm = (LAS bf16*)(F.lds + 69632);
    LAS float* Eb = (LAS float*)(F.lds + 78336);
    LAS bf16* Us = (LAS bf16*)(F.lds + 82432);
    LAS bf16* BBs = (LAS bf16*)(F.lds + 92672);
    const bf16* PROJ = (const bf16*)(F.ws + WS_PROJ); bf16* YDIR = (bf16*)(F.ws + WS_YDIR) + (size_t)d * ML * 512;
    int tid = F.tid; asm volatile("" : "+v"(tid));
    const int lane = tid & 63, w = F.wave;
    const int sg = tid & 127, seg = tid >> 7;
    float ar, ai, a32r, a32i;
    { float cfr, cfi; s5_disc(INP, d, 2 * gp + (sg >> 6), sg & 63, ar, ai, cfr, cfi); a32r = ar; a32i = ai;
#pragma unroll
        for (int q = 0; q < 5; ++q) { const float nr = a32r * a32r - a32i * a32i, ni = 2.0f * a32r * a32i; a32r = nr; a32i = ni; } }
    for (int idx = tid; idx < 4096; idx += 512) {
        { const int gg = idx >> 11, pp = (idx >> 4) & 127, c = idx & 15, g = 2 * gp + gg, p = pp & 63; float xr_, xi_, cfr, cfi; s5_disc(INP, d, g, p, xr_, xi_, cfr, cfi);
            const float bre = INP[16][((size_t)(d * 32 + g) * 64 + p) * 16 + c], bim = INP[17][((size_t)(d * 32 + g) * 64 + p) * 16 + c];
            BBs[(gg * 128 + pp) * 24 + c] = (bf16)f2bf(pp < 64 ? cfr * bre - cfi * bim : cfr * bim + cfi * bre); }
        { const int gg = idx >> 11, c = (idx >> 7) & 15, pp = idx & 127, g = 2 * gp + gg, p = pp & 63;
            const float v = pp < 64 ? INP[18][((size_t)(d * 32 + g) * 16 + c) * 64 + p] : -INP[19][((size_t)(d * 32 + g) * 16 + c) * 64 + p];
            Cm[(gg * 16 + c) * 136 + pp] = (bf16)f2bf(v); }
    }
    float h0r = 0.f, h0i = 0.f;
    LAS bf16* rowre = BHt + ((sg >> 6) * 128 + (sg & 63)) * 136 + 32 * seg;
    v4u pu; v2u yout[2]; bf16* yptr[2]; bool ypend = false;
#define S5_PREFETCH(jn) do { const bool lat_ = (jn) >= 2; const int p0_ = lat_ ? 128 * ((jn) - 2) : 128 * (jn), L_ = lat_ ? SEQ : CTXL, rb_ = lat_ ? b * SEQ : ML + b * CTXL; \
        const int s_ = tid >> 2, c_ = tid & 3; const int tt = d ? (L_ - 1 - (p0_ + s_)) : (p0_ + s_); pu = *(const v4u*)(PROJ + (size_t)(rb_ + tt) * LDP + PC_U + gp * 32 + c_ * 8); } while (0)
    S5_PREFETCH(0);
    __syncthreads();
    for (int j = 0; j < 34; ++j) {
        const bool lat = j >= 2;
        const int p0 = lat ? 128 * (j - 2) : 128 * j, Lseq = lat ? SEQ : CTXL, rowbase = lat ? b * SEQ : ML + b * CTXL;
        *(LAS v4u*)(Us + (tid >> 2) * 40 + (tid & 3) * 8) = pu;
        LBAR();
        if (j + 1 < 34) S5_PREFETCH(j + 1);
        if (ypend) { *(v2u*)yptr[0] = yout[0]; *(v2u*)yptr[1] = yout[1]; ypend = false; }
        { const int gg = w >> 2, tm = w & 3, r = lane & 31, hh = lane >> 5;
            const bf16x8 a = *(const LAS bf16x8*)(Us + (32 * tm + r) * 40 + gg * 16 + 8 * hh);
            LAS bf16* bp = BHt + (gg * 128 + r) * 136 + 32 * tm + 4 * hh;
#pragma unroll
            for (int tn = 0; tn < 4; ++tn) { f32x16 acc;
#pragma unroll
                for (int reg = 0; reg < 16; ++reg) acc[reg] = 0.f;
                const bf16x8 bb = *(const LAS bf16x8*)(BBs + (gg * 128 + 32 * tn + r) * 24 + 8 * hh);
                acc = __builtin_amdgcn_mfma_f32_32x32x16_bf16(a, bb, acc, 0, 0, 0);
#pragma unroll
                for (int rg = 0; rg < 4; ++rg) *(LAS v2u*)(bp + 32 * tn * 136 + 8 * rg) = (v2u){cvtpk(acc[4 * rg], acc[4 * rg + 1]), cvtpk(acc[4 * rg + 2], acc[4 * rg + 3])}; } }
        LBAR();
        v4u xr[4], xi[4];
#pragma unroll
        for (int q = 0; q < 4; ++q) { xr[q] = *(const LAS v4u*)(rowre + 8 * q); xi[q] = *(const LAS v4u*)(rowre + 64 * 136 + 8 * q); }
        { float hr = 0.f, hi = 0.f;
#pragma unroll
            for (int q = 0; q < 4; ++q)
#pragma unroll
                for (int e = 0; e < 4; ++e) { const unsigned wr_ = xr[q][e], wi_ = xi[q][e];
                    { const float br = bflo(wr_), bi = bflo(wi_); const float nr = ar * hr - ai * hi + br, ni = ar * hi + ai * hr + bi; hr = nr; hi = ni; }
                    { const float br = bfhi(wr_), bi = bfhi(wi_); const float nr = ar * hr - ai * hi + br, ni = ar * hi + ai * hr + bi; hr = nr; hi = ni; } }
            Eb[(seg * 128 + sg) * 2] = hr; Eb[(seg * 128 + sg) * 2 + 1] = hi; }
        LBAR();
        { float hcr = h0r, hci = h0i, hr = 0.f, hi = 0.f;
#pragma unroll
            for (int s2 = 0; s2 < 4; ++s2) { if (s2 == seg) { hr = hcr; hi = hci; } const float er = Eb[(s2 * 128 + sg) * 2], ei = Eb[(s2 * 128 + sg) * 2 + 1];
                const float nr = a32r * hcr - a32i * hci + er, ni = a32r * hci + a32i * hcr + ei; hcr = nr; hci = ni; }
            h0r = hcr; h0i = hci;
#pragma unroll
            for (int q = 0; q < 4; ++q) { v4u orr, oi;
#pragma unroll
                for (int e = 0; e < 4; ++e) { const unsigned wr_ = xr[q][e], wi_ = xi[q][e]; float r0, i0, r1, i1;
                    { const float br = bflo(wr_), bi = bflo(wi_); const float nr = ar * hr - ai * hi + br, ni = ar * hi + ai * hr + bi; hr = nr; hi = ni; r0 = hr; i0 = hi; }
                    { const float br = bfhi(wr_), bi = bfhi(wi_); const float nr = ar * hr - ai * hi + br, ni = ar * hi + ai * hr + bi; hr = nr; hi = ni; r1 = hr; i1 = hi; }
                    orr[e] = cvtpk(r0, r1); oi[e] = cvtpk(i0, i1); }
                *(LAS v4u*)(rowre + 8 * q) = orr; *(LAS v4u*)(rowre + 64 * 136 + 8 * q) = oi; } }
        LBAR();
        if (lat) { const int gg = w >> 2;
#pragma unroll
            for (int jj = 0; jj < 2; ++jj) { const int tm = 2 * (w & 3) + jj; f32x4 acc = (f32x4){0.f, 0.f, 0.f, 0.f};
#pragma unroll
                for (int st4 = 0; st4 < 4; ++st4) { const bf16x8 af = *(const LAS bf16x8*)(Cm + (gg * 16 + (lane & 15)) * 136 + 32 * st4 + 8 * (lane >> 4));
                    const bf16x8 bfr = tr_frag16(BHt + gg * 128 * 136, 136, 32 * st4, 16 * tm, lane);
                    acc = __builtin_amdgcn_mfma_f32_16x16x32_bf16(af, bfr, acc, 0, 0, 0); }
                const int t = 16 * tm + (lane & 15); const int tt = d ? (Lseq - 1 - (p0 + t)) : (p0 + t);
                yptr[jj] = YDIR + (size_t)(rowbase + tt) * 512 + (2 * gp + gg) * 16 + 4 * (lane >> 4); yout[jj] = (v2u){pk2(acc[0], acc[1]), pk2(acc[2], acc[3])}; }
            ypend = true; }
    }
    if (ypend) { *(v2u*)yptr[0] = yout[0]; *(v2u*)yptr[1] = yout[1]; }
#undef S5_PREFETCH
    __syncthreads();
}

__device__ __forceinline__ float gelu_tanh(float x) { const float u = 0.7978845608028654f * (x + 0.044715f * x * x * x); const float e = __expf(2.0f * u); const float th = 1.0f - 2.0f / (e + 1.0f); return 0.5f * x * (1.0f + th); }
__device__ __forceinline__ void p5a_prep(Frame& F, const float* const* __restrict__ INP) {
    const int gw = F.vcu * NWAVES + F.wave, NGW = F.G * NWAVES, lane = F.lane;
    const bf16* PROJ = (const bf16*)(F.ws + WS_PROJ); const bf16* HD0 = (const bf16*)(F.ws + WS_HDIR); const bf16* HD1 = HD0 + (size_t)ML * 1024;
    const bf16* YD0 = (const bf16*)(F.ws + WS_YDIR); const bf16* YD1 = YD0 + (size_t)ML * 512;
    bf16* A1 = (bf16*)(F.ws + WS_A1); bf16* A2 = (bf16*)(F.ws + WS_A2);
    for (int m = gw; m < ML; m += NGW) {
        float hm[16]; float ss = 0.f;
#pragma unroll
        for (int q = 0; q < 2; ++q) { const v4u a = *(const v4u*)(HD0 + (size_t)m * 1024 + 16 * lane + 8 * q), bq = *(const v4u*)(HD1 + (size_t)m * 1024 + 16 * lane + 8 * q);
            hm[8 * q + 0] = bflo(a.x) + bflo(bq.x); hm[8 * q + 1] = bfhi(a.x) + bfhi(bq.x); hm[8 * q + 2] = bflo(a.y) + bflo(bq.y); hm[8 * q + 3] = bfhi(a.y) + bfhi(bq.y);
            hm[8 * q + 4] = bflo(a.z) + bflo(bq.z); hm[8 * q + 5] = bfhi(a.z) + bfhi(bq.z); hm[8 * q + 6] = bflo(a.w) + bflo(bq.w); hm[8 * q + 7] = bfhi(a.w) + bfhi(bq.w); }
#pragma unroll
        for (int q = 0; q < 16; ++q) ss += hm[q] * hm[q];
        ss += __shfl_xor(ss, 1); ss += __shfl_xor(ss, 2); ss += __shfl_xor(ss, 4);
        const float rs = 1.0f / sqrtf(ss * (1.0f / 128.0f) + EPS);
#pragma unroll
        for (int q = 0; q < 2; ++q) { const v4u o8 = *(const v4u*)(PROJ + (size_t)m * LDP + PC_O + 16 * lane + 8 * q); const float* gm = INP[11] + 16 * lane + 8 * q;
            float r[8]; const float og[8] = {bflo(o8.x), bfhi(o8.x), bflo(o8.y), bfhi(o8.y), bflo(o8.z), bfhi(o8.z), bflo(o8.w), bfhi(o8.w)};
#pragma unroll
            for (int e = 0; e < 8; ++e) r[e] = hm[8 * q + e] * rs * gm[e] * sigmoidf_(og[e]);
            *(v4u*)(A1 + (size_t)m * 1024 + 16 * lane + 8 * q) = (v4u){pk2(r[0], r[1]), pk2(r[2], r[3]), pk2(r[4], r[5]), pk2(r[6], r[7])}; }
        { const v4u a = *(const v4u*)(YD0 + (size_t)m * 512 + 8 * lane), bq = *(const v4u*)(YD1 + (size_t)m * 512 + 8 * lane), u8 = *(const v4u*)(PROJ + (size_t)m * LDP + PC_U + 8 * lane);
            const float* dd = INP[20] + 8 * lane;
            float r[8] = {bflo(a.x) + bflo(bq.x) + dd[0] * bflo(u8.x), bfhi(a.x) + bfhi(bq.x) + dd[1] * bfhi(u8.x), bflo(a.y) + bflo(bq.y) + dd[2] * bflo(u8.y), bfhi(a.y) + bfhi(bq.y) + dd[3] * bfhi(u8.y),
                          bflo(a.z) + bflo(bq.z) + dd[4] * bflo(u8.z), bfhi(a.z) + bfhi(bq.z) + dd[5] * bfhi(u8.z), bflo(a.w) + bflo(bq.w) + dd[6] * bflo(u8.w), bfhi(a.w) + bfhi(bq.w) + dd[7] * bfhi(u8.w)};
#pragma unroll
            for (int e = 0; e < 8; ++e) r[e] = gelu_tanh(r[e]);
            *(v4u*)(A2 + (size_t)m * 512 + 8 * lane) = (v4u){pk2(r[0], r[1]), pk2(r[2], r[3]), pk2(r[4], r[5]), pk2(r[6], r[7])}; }
    }
}

__device__ __forceinline__ void route_reduce_top4(float (&acc)[32], const float* br, int lane, float (&tv)[4], int (&ti)[4]) {
#pragma unroll
    for (int i = 0; i < 16; ++i) { const float send = (lane & 32) ? acc[i] : acc[i + 16]; const float keep = (lane & 32) ? acc[i + 16] : acc[i]; acc[i] = keep + __shfl_xor(send, 32); }
#pragma unroll
    for (int i = 0; i < 8; ++i) { const float send = (lane & 16) ? acc[i] : acc[i + 8]; const float keep = (lane & 16) ? acc[i + 8] : acc[i]; acc[i] = keep + __shfl_xor(send, 16); }
#pragma unroll
    for (int i = 0; i < 4; ++i) { const float send = (lane & 8) ? acc[i] : acc[i + 4]; const float keep = (lane & 8) ? acc[i + 4] : acc[i]; acc[i] = keep + __shfl_xor(send, 8); }
#pragma unroll
    for (int i = 0; i < 2; ++i) { const float send = (lane & 4) ? acc[i] : acc[i + 2]; const float keep = (lane & 4) ? acc[i + 2] : acc[i]; acc[i] = keep + __shfl_xor(send, 4); }
    { const float send = (lane & 2) ? acc[0] : acc[1]; const float keep = (lane & 2) ? acc[1] : acc[0]; acc[0] = keep + __shfl_xor(send, 2); }
    acc[0] += __shfl_xor(acc[0], 1);
    float val = acc[0] + br[lane >> 1];
    if (lane & 1) val = -INFINITY;
#pragma unroll
    for (int r = 0; r < 4; ++r) { float mx = val;
#pragma unroll
        for (int o = 1; o < 64; o <<= 1) mx = fmaxf(mx, __shfl_xor(mx, o));
        const unsigned long long bal = __ballot(val == mx); const int wl = __ffsll((long long)bal) - 1;
        tv[r] = mx; ti[r] = wl >> 1; if (lane == wl) val = -INFINITY; }
}
__device__ __forceinline__ void p6_route(Frame& F, const float* const* __restrict__ INP) {
    const bf16* X1 = (const bf16*)(F.ws + WS_X1); const float* mod = (const float*)(F.ws + WS_MOD); bf16* H2 = (bf16*)(F.ws + WS_H2);
    int* TOPE = (int*)(F.ws + WS_TOPE); int* POS = (int*)(F.ws + WS_POS); float* TOPP = (float*)(F.ws + WS_TOPP); int* LIST = (int*)(F.ws + WS_LIST);
    LAS float* Wt = (LAS float*)(F.lds);
    LAS int* pe = (LAS int*)(F.lds + LDSCTL_OFF + 1024); LAS int* hist = pe + 512; LAS int* base = hist + 32; LAS int* rank = base + 32;
    const float* wr = INP[26]; const float* br = INP[27];
    const int lane = F.lane, w = F.wave;
    for (int idx = F.tid; idx < 32768; idx += NWAVES * 64) { const int e = idx >> 10, k = idx & 1023; Wt[((((k >> 8) * 4 + (k & 3)) * 32 + e) << 6) + ((k >> 2) & 63)] = wr[k * 32 + e]; }
    __syncthreads();
    for (int tg = blockIdx.x; tg < ML / 128; tg += F.G) {
        if (F.tid < 32) hist[F.tid] = 0;
        __syncthreads();
#pragma unroll 1
        for (int q = 0; q < 16; q += 2) {
            const int tl = w * 16 + q, m = tg * 128 + tl, b = m / SEQ;
            const float* sh = mod + b * 6144 + 3 * D; const float* scl = sh + D;
            float s0 = 0.f, s1 = 0.f;
#pragma unroll
            for (int j = 0; j < 4; ++j) { const v2u w0 = *(const v2u*)(X1 + (size_t)m * D + 256 * j + 4 * lane), w1 = *(const v2u*)(X1 + (size_t)(m + 1) * D + 256 * j + 4 * lane);
                const f32x4 x0 = (f32x4){bflo(w0.x), bfhi(w0.x), bflo(w0.y), bfhi(w0.y)}, x1 = (f32x4){bflo(w1.x), bfhi(w1.x), bflo(w1.y), bfhi(w1.y)};
                s0 += (x0[0] * x0[0] + x0[1] * x0[1]) + (x0[2] * x0[2] + x0[3] * x0[3]); s1 += (x1[0] * x1[0] + x1[1] * x1[1]) + (x1[2] * x1[2] + x1[3] * x1[3]); }
            const float r0 = 1.0f / sqrtf(wave_sum(s0) * (1.0f / D) + EPS), r1 = 1.0f / sqrtf(wave_sum(s1) * (1.0f / D) + EPS);
            float a0[32], a1[32];
#pragma unroll
            for (int e = 0; e < 32; ++e) { a0[e] = 0.f; a1[e] = 0.f; }
#pragma unroll 1
            for (int j = 0; j < 4; ++j) { const int c = 256 * j + 4 * lane; const f32x4 g = *(const f32x4*)(INP[7] + c), a = *(const f32x4*)(scl + c), bb = *(const f32x4*)(sh + c);
                const v2u w0 = *(const v2u*)(X1 + (size_t)m * D + c), w1 = *(const v2u*)(X1 + (size_t)(m + 1) * D + c);
                const f32x4 x0 = (f32x4){bflo(w0.x), bfhi(w0.x), bflo(w0.y), bfhi(w0.y)}, x1 = (f32x4){bflo(w1.x), bfhi(w1.x), bflo(w1.y), bfhi(w1.y)};
                const f32x4 gs = g * (a + 1.0f); const f32x4 y0 = x0 * r0 * gs + bb, y1 = x1 * r1 * gs + bb;
                *(unsigned*)((unsigned char*)H2 + (size_t)m * D + c) = pk4_fp8(y0[0], y0[1], y0[2], y0[3]); *(unsigned*)((unsigned char*)H2 + (size_t)(m + 1) * D + c) = pk4_fp8(y1[0], y1[1], y1[2], y1[3]);
                const LAS float* wj = Wt + j * 8192 + lane;
#pragma unroll
                for (int qq = 0; qq < 4; ++qq) { const LAS float* wp = wj + qq * 2048; const float ya = y0[qq], yb = y1[qq];
#pragma unroll
                    for (int e = 0; e < 32; ++e) { const float wv = wp[e * 64]; a0[e] += ya * wv; a1[e] += yb * wv; }
                    asm volatile("" ::: "memory"); } }
            float tv[4]; int ti[4];
#pragma unroll
            for (int tk = 0; tk < 2; ++tk) {
                if (tk == 0) route_reduce_top4(a0, br, lane, tv, ti); else route_reduce_top4(a1, br, lane, tv, ti);
                const float e1 = __expf(tv[1] - tv[0]), e2 = __expf(tv[2] - tv[0]), e3 = __expf(tv[3] - tv[0]); const float inv = 1.0f / (1.0f + e1 + e2 + e3);
                if (lane < 4) { const float p = lane == 0 ? inv : (lane == 1 ? e1 * inv : (lane == 2 ? e2 * inv : e3 * inv)); const int ee = lane == 0 ? ti[0] : (lane == 1 ? ti[1] : (lane == 2 ? ti[2] : ti[3]));
                    TOPP[(m + tk) * 4 + lane] = p; TOPE[(m + tk) * 4 + lane] = ee; pe[(tl + tk) * 4 + lane] = ee; }
            }
        }
        __syncthreads();
        { const int e = pe[F.tid]; rank[F.tid] = __hip_atomic_fetch_add(&hist[e], 1, __ATOMIC_RELAXED, __HIP_MEMORY_SCOPE_WORKGROUP); }
        __syncthreads();
        if (F.tid < 32) base[F.tid] = (int)__hip_atomic_fetch_add(F.ctl + CW_CNT + 64 * F.tid, (unsigned)hist[F.tid], RLX_AGENT);
        __syncthreads();
        { const int e = pe[F.tid]; const int pos = base[e] + rank[F.tid]; const int m = tg * 128 + (F.tid >> 2); LIST[e * ML + pos] = m; POS[m * 4 + (F.tid & 3)] = pos; }
        __syncthreads();
    }
}

__device__ __forceinline__ void p10_combine(Frame& F, const float* const* __restrict__ INP) {
    moe_tables(F);
    const LAS int* tab = (const LAS int*)(F.lds + TAB_OFF);
    const bf16* X1 = (const bf16*)(F.ws + WS_X1); float* OUT = F.out; const float* mod = (const float*)(F.ws + WS_MOD); const bf16* Y = (const bf16*)(F.ws + WS_Y);
    const int* TOPE = (const int*)(F.ws + WS_TOPE); const int* POS = (const int*)(F.ws + WS_POS); const float* TOPP = (const float*)(F.ws + WS_TOPP);
    const int gw = F.vcu * NWAVES + F.wave, NGW = F.G * NWAVES, lane = F.lane;
    for (int m = gw; m < ML; m += NGW) {
        const int b = m / SEQ; const float* gt2 = mod + b * 6144 + 5 * D;
        f32x4 mo[4];
#pragma unroll
        for (int j = 0; j < 4; ++j) mo[j] = (f32x4){0.f, 0.f, 0.f, 0.f};
#pragma unroll
        for (int k = 0; k < 4; ++k) { const int e = TOPE[m * 4 + k]; const float p = TOPP[m * 4 + k]; const size_t slot = (size_t)256 * tab[e] + POS[m * 4 + k];
#pragma unroll
            for (int j = 0; j < 4; ++j) { const unsigned y = *(const unsigned*)((const unsigned char*)Y + slot * 1024 + 256 * j + 4 * lane);
                const auto lo = __builtin_amdgcn_cvt_pk_f32_fp8((int)y, false), hi = __builtin_amdgcn_cvt_pk_f32_fp8((int)y, true);
                mo[j] += (f32x4){lo[0], lo[1], hi[0], hi[1]} * (p * 0.0625f); } }
        f32x4 v[4]; float s = 0.f;
#pragma unroll
        for (int j = 0; j < 4; ++j) { const int c = 256 * j + 4 * lane; const v2u xw = *(const v2u*)(X1 + (size_t)m * D + c); v[j] = (f32x4){bflo(xw.x), bfhi(xw.x), bflo(xw.y), bfhi(xw.y)} + *(const f32x4*)(gt2 + c) * mo[j]; s += (v[j][0] * v[j][0] + v[j][1] * v[j][1]) + (v[j][2] * v[j][2] + v[j][3] * v[j][3]); }
        const float rstd = 1.0f / sqrtf(wave_sum(s) * (1.0f / D) + EPS);
#pragma unroll
        for (int j = 0; j < 4; ++j) { const int c = 256 * j + 4 * lane; *(f32x4*)(OUT + (size_t)m * D + c) = v[j] * rstd * *(const f32x4*)(INP[32] + c); }
    }
}

struct Args { const float* in[33]; float* out; unsigned char* ws; int ph_lo, ph_hi, li, pad; };
__global__ void __launch_bounds__(NWAVES * 64, 2) fwd_kernel(Args args) {
    extern __shared__ __attribute__((aligned(16))) unsigned char lds[];
    Frame F;
    F.lds = (LAS unsigned char*)lds;
    F.tid = threadIdx.x; F.lane = F.tid & 63; F.wave = __builtin_amdgcn_readfirstlane(F.tid >> 6);
    F.G = gridDim.x; { const int bx = blockIdx.x; F.vcu = (F.G % 8 == 0) ? (bx % 8) * (F.G / 8) + bx / 8 : bx; }
    F.ws = args.ws; F.ctl = (gu32*)(args.ws + WS_CTL); F.out = args.out;
    for (int u = F.tid; u < (LDS_BYTES - LDSCTL_OFF) / 4; u += NWAVES * 64) ((LAS unsigned*)(F.lds + LDSCTL_OFF))[u] = 0u;
    __syncthreads();
    XcdBarrier bar; bar.bar = (unsigned*)(F.ctl + CW_BAR); bar.x = 0; bar.st = nullptr;
    if (N_LAUNCHES == 1) bar = xcd_barrier_post((unsigned*)(F.ctl + CW_BAR), (volatile LAS unsigned*)(F.lds + MISC_OFF) + 8);
    const int lo = args.ph_lo, hi = args.ph_hi;
    const float* const* __restrict__ INP = args.in;
#ifndef PH_MASK
#define PH_MASK 0x3fff
#endif
#define IN(k) ((((PH_MASK) >> (k)) & 1) && lo <= (k) && (k) < hi)
#define SEAM(k) do { if (IN(k) && IN((k) + 1)) xcd_barrier(bar); } while (0)
    const bf16* WIN = (const bf16*)(F.ws + WS_WIN);

    if (IN(0)) { p0_prologue(F, INP); } SEAM(0);
    if (IN(1)) { p1_norm1(F, INP); } SEAM(1);
    if (IN(2)) {
        pg8::Gemm g{(const bf16*)(F.ws + WS_H1), WIN, 512, nullptr, 0x7f7f7f7f, 0x7a7a7a7a}; InProjOrder S{F.G, (int)blockIdx.x};
        EpiStore E{(bf16*)(F.ws + WS_PROJ), LDP};
        pg8::gemm_phase<EpiStore, InProjOrder, false, true>(F.lds, g, S, E);
    } SEAM(2);
    if (IN(3)) { p3_conv(F, INP); } SEAM(3);
    if (IN(4)) { for (int u = blockIdx.x; u < 256; u += F.G) { p4_mlstm<0>(F, INP, u); if (P4_REP_M > 1) p4_mlstm<P4_MODE>(F, INP, u); for (int r_ = 0; r_ < P4_REP_S; ++r_) p4_s5(F, INP, u); } } SEAM(4);
    if (IN(5)) { p5a_prep(F, INP); } SEAM(5);
    if (IN(6)) {
        pg8::Gemm g{(const bf16*)(F.ws + WS_A2), (const bf16*)(F.ws + WS_WGLU), 512, nullptr, 0, 0}; pg8::StaticOrder S; S.init(ML, 512, F.G, (int)blockIdx.x);
        EpiGlu E{(const bf16*)(F.ws + WS_A2), (bf16*)(F.ws + WS_A3), INP[22]};
        pg8::gemm_phase<EpiGlu, pg8::StaticOrder, false>(F.lds, g, S, E);
    }
    if (IN(7)) {
        pg8::Gemm g{(const bf16*)(F.ws + WS_A1), (const bf16*)(F.ws + WS_WA), 1024, nullptr, 0, 0}; pg8::StaticOrder S; S.init(ML, 1024, F.G, (int)blockIdx.x);
        EpiGate<false> E{(const bf16*)(F.ws + WS_PROJ), PC_G, INP[24], nullptr, (bf16*)(F.ws + WS_YA)};
        pg8::gemm_phase<EpiGate<false>, pg8::StaticOrder, false>(F.lds, g, S, E);
    } SEAM(7);
    if (IN(8)) {
        pg8::Gemm g{(const bf16*)(F.ws + WS_A3), (const bf16*)(F.ws + WS_WB), 512, nullptr, 0, 0}; pg8::StaticOrder S; S.init(ML, 1024, F.G, (int)blockIdx.x);
        EpiGate<true> E{(const bf16*)(F.ws + WS_PROJ), PC_G + 1024, INP[24] + 1024, (const bf16*)(F.ws + WS_YA), (bf16*)(F.ws + WS_MERGED)};
        pg8::gemm_phase<EpiGate<true>, pg8::StaticOrder, false>(F.lds, g, S, E);
    } SEAM(8);
    if (IN(9)) {
        pg8::Gemm g{(const bf16*)(F.ws + WS_MERGED), (const bf16*)(F.ws + WS_WO), 1024, nullptr, 0, 0}; pg8::StaticOrder S; S.init(ML, 1024, F.G, (int)blockIdx.x);
        EpiX1 E{INP[0], (const float*)(F.ws + WS_MOD), (bf16*)(F.ws + WS_X1)};
        pg8::gemm_phase<EpiX1, pg8::StaticOrder, false>(F.lds, g, S, E);
    } SEAM(9);
    if (IN(10)) { p6_route(F, INP); } SEAM(10);
    if (IN(11)) {
        moe_tables(F);
        MoeOrder S{F.G, (int)blockIdx.x, 8, (const LAS int*)(F.lds + TAB_OFF)};
        LAS unsigned short* ridx = (LAS unsigned short*)(F.lds + LDSCTL_OFF + 1024);
        { const int* LIST = (const int*)(F.ws + WS_LIST);
            for (int i = 0; i < 30; ++i) { pg8::Unit u; if (!S.next(i, u)) break;
                if (F.tid < 256) { const int rc = F.tid < u.nvalid ? F.tid : u.nvalid - 1; ridx[i * 256 + F.tid] = (unsigned short)LIST[u.lbase + rc]; } }
            __syncthreads(); }
        pg8::Gemm g{(const bf16*)(F.ws + WS_H2), (const bf16*)(F.ws + WS_WEIN), 512, ridx, 0x7f7f7f7f, 0x7a7a7a7a};
        EpiSwiglu E{INP[29], (bf16*)(F.ws + WS_ACT)};
        pg8::gemm_phase<EpiSwiglu, MoeOrder, true, true>(F.lds, g, S, E);
    } SEAM(11);
    if (IN(12)) {
        moe_tables(F);
        pg8::Gemm g{(const bf16*)(F.ws + WS_ACT), (const bf16*)(F.ws + WS_WEOUT), 512, nullptr, 0x7c7c7c7c, 0x7a7a7a7a}; MoeOrder S{F.G, (int)blockIdx.x, 4, (const LAS int*)(F.lds + TAB_OFF)};
        EpiY E{INP[31], (bf16*)(F.ws + WS_Y)};
        pg8::gemm_phase<EpiY, MoeOrder, false, true>(F.lds, g, S, E);
    } SEAM(12);
    if (IN(13)) { p10_combine(F, INP); }
#undef IN
#undef SEAM
}

extern "C" void kernel_launch(void* const* d_in, const int* in_sizes, int n_in, void* d_out, int out_size, void* d_ws, size_t ws_size, hipStream_t stream) {
    static int grid = 0;
    if (grid == 0) {
        if (n_in != 33 || out_size != ML * D || ws_size < WS_END2) { fprintf(stderr, "kernel_launch: unexpected shapes (n_in %d, out %d, ws %zu)\n", n_in, out_size, ws_size); grid = -1; return; }
        int dev = 0, cus = 0, per_cu = 0;
        if (hipGetDevice(&dev) != hipSuccess || hipDeviceGetAttribute(&cus, hipDeviceAttributeMultiprocessorCount, dev) != hipSuccess) { grid = -1; return; }
        if (hipFuncSetAttribute((const void*)fwd_kernel, hipFuncAttributeMaxDynamicSharedMemorySize, LDS_BYTES) != hipSuccess) { fprintf(stderr, "kernel_launch: hipFuncSetAttribute failed\n"); grid = -1; return; }
        if (hipOccupancyMaxActiveBlocksPerMultiprocessor(&per_cu, (const void*)fwd_kernel, NWAVES * 64, LDS_BYTES) != hipSuccess || per_cu < 1) fprintf(stderr, "kernel_launch: occupancy query reports %d\n", per_cu);
        (void)hipGetLastError();
        grid = cus;
    }
    if (grid < 0) return;
    if (hipMemsetAsync((char*)d_ws + WS_CTL, 0, CTL_ZERO_BYTES, stream) != hipSuccess) return;
    Args a{};
    for (int i = 0; i < 33; ++i) a.in[i] = (const float*)d_in[i];
    a.out = (float*)d_out; a.ws = (unsigned char*)d_ws;
    for (int li = 0; li < N_LAUNCHES; ++li) {
        a.ph_lo = (N_LAUNCHES == 1) ? 0 : li; a.ph_hi = (N_LAUNCHES == 1) ? NPH : li + 1; a.li = li;
        const int nrep = (N_LAUNCHES != 1 && (((PROBE_DUP_MASK) >> li) & 1)) ? 2 : 1;
        for (int r = 0; r < nrep; ++r) hipLaunchKernelGGL(fwd_kernel, dim3(grid), dim3(NWAVES * 64), LDS_BYTES, stream, a);
    }
}
```

```cpp
#include <hip/hip_runtime.h>
#include <cstdio>
#include <cstdint>

#ifndef MK_N_LAUNCHES
#define MK_N_LAUNCHES 1
#endif
#ifndef PROBE_DUP_MASK
#define PROBE_DUP_MASK 0
#endif
#ifndef P4_REP_M
#define P4_REP_M 1
#endif
#ifndef P4_MODE
#define P4_MODE 0
#endif
#ifndef P4_REP_S
#define P4_REP_S 1
#endif

namespace pg8 {
#define PG8_LAS __attribute__((address_space(3)))
typedef unsigned short bf16_t;
typedef short bf16x8 __attribute__((ext_vector_type(8)));
typedef float f32x4 __attribute__((ext_vector_type(4)));
typedef unsigned u32x4 __attribute__((ext_vector_type(4)));
constexpr int BM = 256, BK = 64, HALF = 128, HTB = HALF * BK * 2, STAGE_BYTES = 8 * HTB, NXCD = 8, WGM = 8;

__host__ __device__ __forceinline__ int lds_byte(int r, int c) { const int st = (r >> 4) * 2 + (c >> 5), rr = r & 15, cc = c & 31, ob = rr * 64 + cc * 2; return st * 1024 + (ob ^ (((ob >> 9) & 1) << 5)); }
__host__ __device__ __forceinline__ void stage_rc(int b, int& R, int& C) { const int st = b / 1024, sb = b % 1024, swz = sb ^ (((sb >> 9) & 1) << 5); R = (st >> 1) * 16 + swz / 64; C = (st & 1) * 32 + (swz % 64) / 2; }
__host__ __device__ __forceinline__ int perm32(int rho) { const int n = rho >> 4, i = rho & 15; return 8 * (i >> 2) + 4 * n + (i & 3); }

struct Unit { int pm, pn, lbase, nvalid; };
struct Gemm { const bf16_t* A; const bf16_t* Bt; int K; const PG8_LAS unsigned short* ridx; int sa, sb; };

__device__ __forceinline__ int xcd_remap(int L, int nwg) { const int q = nwg / NXCD, r = nwg % NXCD, xcd = L % NXCD, off = L / NXCD; return (xcd < r ? xcd * (q + 1) : r * (q + 1) + (xcd - r) * q) + off; }

struct StaticOrder {
    int nM, nN, nwg, G, c;
    __device__ void init(int M, int N, int G_, int c_) { nM = M / BM; nN = N / BM; nwg = nM * nN; G = G_; c = c_; }
    __device__ __forceinline__ bool next(int i, Unit& u) const {
        const long L = (long)i * G + c; if (L >= nwg) return false;
        const int wgid = xcd_remap((int)L, nwg);
        const int nig = WGM * nN, gid = wgid / nig, fm = gid * WGM, gsz = (nM - fm) < WGM ? (nM - fm) : WGM;
        u.pm = fm + ((wgid % nig) % gsz); u.pn = (wgid % nig) / gsz; u.lbase = 0; u.nvalid = 0; return true;
    }
};

__device__ __forceinline__ unsigned cvt_pk_bf16(float lo, float hi) { unsigned r; asm volatile("v_cvt_pk_bf16_f32 %0, %1, %2" : "=v"(r) : "v"(lo), "v"(hi)); return r; }

typedef int v8i __attribute__((ext_vector_type(8)));
typedef short s16x16 __attribute__((ext_vector_type(16)));
template <class Epi, class Sched, bool GATHER, bool FP8 = false>
__device__ __forceinline__ void gemm_phase(PG8_LAS unsigned char* lds, const Gemm g, const Sched& S, const Epi& E) {
    const int tid = threadIdx.x, wid = __builtin_amdgcn_readfirstlane(tid >> 6), lane = tid & 63, wr = wid >> 2, wc = wid & 3, fr = lane & 15, fq = lane >> 4;
    const int K = g.K, nt = K / BK;
    int Rr[2]; unsigned cby[2], voffB[2];
#pragma unroll
    for (int i = 0; i < 2; ++i) { int R, C; stage_rc(tid * 16 + i * 8192, R, C); const int Rb = Epi::PERM ? ((R & ~31) + perm32(R & 31)) : R;
        Rr[i] = R; cby[i] = (unsigned)C * 2u; voffB[i] = (unsigned)(Rb * K + C) * 2u; }
    const size_t kstep = (size_t)(BK * 2);
    const size_t hstep = (size_t)HALF * K * 2;
    const size_t tstep = 2 * hstep;
    const unsigned ldsw = (unsigned)wid * 1024u;
    const int aoff = lds_byte(wr * 64 + fr, FP8 ? fq * 16 : fq * 8), boff = lds_byte(wc * 32 + fr, FP8 ? fq * 16 : fq * 8);

#define PG8_SA(b, h) (((b) * 2 + (h)) * HTB)
#define PG8_SB(b, h) ((4 + (b) * 2 + (h)) * HTB)
#define PG8_STAGE(bufoff, gbase, voff) do { _Pragma("unroll") for (int _i = 0; _i < 2; ++_i) \
        __builtin_amdgcn_global_load_lds((const unsigned*)((const char*)(gbase) + (voff)[_i]), (PG8_LAS unsigned*)(lds + (bufoff) + ldsw + _i * 8192), 16, 0, 0); } while (0)
#define PG8_LDA(dst, b, h) do { if constexpr (FP8) { _Pragma("unroll") for (int m = 0; m < 4; ++m) { const bf16x8 _lo = *(const PG8_LAS bf16x8*)(lds + PG8_SA(b, h) + aoff + m * 2048), _hi = *(const PG8_LAS bf16x8*)(lds + PG8_SA(b, h) + aoff + m * 2048 + 16); dst##8[m] = __builtin_bit_cast(v8i, __builtin_shufflevector(_lo, _hi, 0, 1, 2, 3, 4, 5, 6, 7, 8, 9, 10, 11, 12, 13, 14, 15)); } } \
        else { _Pragma("unroll") for (int m = 0; m < 4; ++m) _Pragma("unroll") for (int k = 0; k < 2; ++k) dst[m][k] = *(const PG8_LAS bf16x8*)(lds + PG8_SA(b, h) + aoff + m * 2048 + k * 1024); } } while (0)
#define PG8_LDB(dst, b, h) do { if constexpr (FP8) { _Pragma("unroll") for (int n = 0; n < 2; ++n) { const bf16x8 _lo = *(const PG8_LAS bf16x8*)(lds + PG8_SB(b, h) + boff + n * 2048), _hi = *(const PG8_LAS bf16x8*)(lds + PG8_SB(b, h) + boff + n * 2048 + 16); dst##8[n] = __builtin_bit_cast(v8i, __builtin_shufflevector(_lo, _hi, 0, 1, 2, 3, 4, 5, 6, 7, 8, 9, 10, 11, 12, 13, 14, 15)); } } \
        else { _Pragma("unroll") for (int n = 0; n < 2; ++n) _Pragma("unroll") for (int k = 0; k < 2; ++k) dst[n][k] = *(const PG8_LAS bf16x8*)(lds + PG8_SB(b, h) + boff + n * 2048 + k * 1024); } } while (0)
#define PG8_MMA(ai, bj, At, Bt) do { __builtin_amdgcn_s_setprio(1); _Pragma("unroll") for (int m = 0; m < 4; ++m) _Pragma("unroll") for (int n = 0; n < 2; ++n) { \
        if constexpr (FP8) asm volatile("v_mfma_scale_f32_16x16x128_f8f6f4 %0, %1, %2, %0, %3, %4 op_sel_hi:[0,0,0]" : "+v"(acc[ai][bj][m][n]) : "v"(Bt##8[n]), "v"(At##8[m]), "v"(vsb), "v"(vsa));   \
        else { _Pragma("unroll") for (int k = 0; k < 2; ++k) acc[ai][bj][m][n] = __builtin_amdgcn_mfma_f32_16x16x32_bf16(Bt[n][k], At[m][k], acc[ai][bj][m][n], 0, 0, 0); } } \
        __builtin_amdgcn_s_setprio(0); } while (0)
#define PG8_WAIT_V(n) asm volatile("s_waitcnt vmcnt(" #n ")" ::: "memory")
#define PG8_WAIT_L(n) asm volatile("s_waitcnt lgkmcnt(" #n ")" ::: "memory")
#define PG8_BAR __builtin_amdgcn_s_barrier()
#define PG8_SCHED __builtin_amdgcn_sched_barrier(0)
#define PG8_AOFF(dst, u, uord) do { _Pragma("unroll") for (int _h = 0; _h < 2; ++_h) _Pragma("unroll") for (int _i = 0; _i < 2; ++_i) { const int _r = _h * HALF + Rr[_i]; \
        if constexpr (GATHER) { const int _idx = g.ridx[(uord) * 256 + _r]; dst[_h][_i] = (unsigned)_idx * (unsigned)(K * 2) + cby[_i]; } \
        else { dst[_h][_i] = (unsigned)(_r * K * 2) + cby[_i]; } } } while (0)
    Unit cur, nxt; int ui = 0;
    if (!S.next(0, cur)) return;
    f32x4 acc[2][2][4][2];
#pragma unroll
    for (int a = 0; a < 2; ++a)
#pragma unroll
        for (int b = 0; b < 2; ++b)
#pragma unroll
            for (int m = 0; m < 4; ++m)
#pragma unroll
                for (int n = 0; n < 2; ++n) acc[a][b][m][n] = (f32x4){0.f, 0.f, 0.f, 0.f};
    const int vsa = g.sa, vsb = g.sb;
    bf16x8 At[4][2], B0[2][2], B1[2][2];
    v8i At8[4], B08[2], B18[2];
    unsigned vc[2][2], vn[2][2];
    PG8_AOFF(vc, cur, 0);
    const char* cA = GATHER ? (const char*)g.A : (const char*)g.A + (size_t)cur.pm * tstep; const char* cB = (const char*)g.Bt + (size_t)cur.pn * tstep;
    PG8_STAGE(PG8_SB(0, 0), cB, voffB); PG8_STAGE(PG8_SB(0, 1), cB + hstep, voffB); PG8_STAGE(PG8_SA(0, 0), cA, vc[0]); PG8_STAGE(PG8_SA(0, 1), cA, vc[1]);
    if (wr == 1) PG8_BAR;
    PG8_WAIT_V(2); PG8_BAR;
    PG8_STAGE(PG8_SB(1, 0), cB + kstep, voffB); PG8_STAGE(PG8_SA(1, 0), cA + kstep, vc[0]); PG8_STAGE(PG8_SB(1, 1), cB + hstep + kstep, voffB);
    PG8_WAIT_V(6); PG8_BAR;
    for (;;) {
        const bool has_next = S.next(ui + 1, nxt);
        const char* nA = (has_next && !GATHER) ? (const char*)g.A + (size_t)nxt.pm * tstep : cA; const char* nB = has_next ? (const char*)g.Bt + (size_t)nxt.pn * tstep : cB;
        if constexpr (GATHER) { if (has_next) { PG8_AOFF(vn, nxt, ui + 1); } else {
#pragma unroll
            for (int h = 0; h < 2; ++h) { vn[h][0] = vc[h][0]; vn[h][1] = vc[h][1]; } } }
#pragma unroll 1
        for (int t = 0; t < nt; t += 2) {
            const bool last = (t == nt - 2);
            const char* a1 = cA + (size_t)(t + 1) * kstep;
            const char* a2 = last ? nA : cA + (size_t)(t + 2) * kstep; const char* b2 = last ? nB : cB + (size_t)(t + 2) * kstep;
            const char* a3 = a2 + kstep; const char* b3 = b2 + kstep;
            unsigned v2[2][2];
#pragma unroll
            for (int h = 0; h < 2; ++h)
#pragma unroll
                for (int i = 0; i < 2; ++i) v2[h][i] = GATHER ? (last ? vn[h][i] : vc[h][i]) : vc[h][i];
            PG8_LDB(B0, 0, 0); PG8_LDB(B1, 0, 1); PG8_SCHED; PG8_LDA(At, 0, 0); PG8_STAGE(PG8_SA(1, 1), a1, vc[1]);
            PG8_WAIT_V(8); PG8_WAIT_L(0); PG8_BAR; PG8_MMA(0, 0, At, B0); PG8_MMA(0, 1, At, B1); PG8_BAR; PG8_SCHED;
            PG8_LDA(At, 0, 1); PG8_STAGE(PG8_SB(0, 0), b2, voffB); PG8_STAGE(PG8_SB(0, 1), b2 + hstep, voffB); PG8_STAGE(PG8_SA(0, 0), a2, v2[0]);
            PG8_WAIT_V(8); PG8_WAIT_L(0); PG8_BAR; PG8_MMA(1, 0, At, B0); PG8_MMA(1, 1, At, B1); PG8_BAR; PG8_SCHED;
            PG8_LDB(B0, 1, 0); PG8_LDB(B1, 1, 1); PG8_SCHED; PG8_LDA(At, 1, 0); PG8_STAGE(PG8_SA(0, 1), a2, v2[1]);
            PG8_WAIT_V(8); PG8_WAIT_L(0); PG8_BAR; PG8_MMA(0, 0, At, B0); PG8_MMA(0, 1, At, B1); PG8_BAR; PG8_SCHED;
            PG8_LDA(At, 1, 1); PG8_STAGE(PG8_SB(1, 0), b3, voffB); PG8_STAGE(PG8_SB(1, 1), b3 + hstep, voffB); PG8_STAGE(PG8_SA(1, 0), a3, v2[0]);
            PG8_WAIT_V(8); PG8_WAIT_L(0); PG8_BAR; PG8_MMA(1, 0, At, B0); PG8_MMA(1, 1, At, B1); PG8_BAR; PG8_SCHED;
        }
        if (wr == 0) PG8_BAR;
        if constexpr (FP8) asm volatile("s_nop 15\n\ts_nop 15" ::: "memory");
        E(acc, cur, wr, wc, fr, fq);
        if (!has_next) break;
#pragma unroll
        for (int a = 0; a < 2; ++a)
#pragma unroll
            for (int b = 0; b < 2; ++b)
#pragma unroll
                for (int m = 0; m < 4; ++m)
#pragma unroll
                    for (int n = 0; n < 2; ++n) acc[a][b][m][n] = (f32x4){0.f, 0.f, 0.f, 0.f};
        cur = nxt; cA = nA; cB = nB; ++ui;
        if constexpr (GATHER) {
#pragma unroll
            for (int h = 0; h < 2; ++h) { vc[h][0] = vn[h][0]; vc[h][1] = vn[h][1]; } }
        if (wr == 1) PG8_BAR;
    }
    PG8_WAIT_V(0);
    PG8_BAR;
#undef PG8_SA
#undef PG8_SB
#undef PG8_STAGE
#undef PG8_LDA
#undef PG8_LDB
#undef PG8_MMA
#undef PG8_WAIT_V
#undef PG8_WAIT_L
#undef PG8_BAR
#undef PG8_SCHED
#undef PG8_AOFF
}
}

constexpr int NWAVES = 8;
constexpr int D = 1024, NB = 8, SEQ = 4096, CTXL = 256;
constexpr int ML = NB * SEQ, MC = NB * CTXL, MT = ML + MC;
constexpr int LDP = 5888;
constexpr int PC_QK = 0, PC_V = 1024, PC_U = 2048, PC_O = 2560, PC_G = 3584, PC_IF = 5632;
constexpr int NEXP = 32, TOPK = 4;
constexpr int MAXTILES = (ML * TOPK + NEXP * 256) / 256;
constexpr float EPS = 1e-6f;
constexpr int NPH = 14;
constexpr int N_LAUNCHES = MK_N_LAUNCHES;

constexpr size_t MiB = 1u << 20;
constexpr size_t WS_CTL = 0, CTL_ZERO_BYTES = 1 * MiB;
constexpr size_t WS_MOD = 1 * MiB;
constexpr size_t WS_TOPE = 2 * MiB, WS_POS = 2 * MiB + 512 * 1024, WS_TOPP = 3 * MiB, WS_LIST = 4 * MiB;
constexpr size_t WS_WIN = 8 * MiB, WS_WGLU = 20 * MiB, WS_WA = 21 * MiB, WS_WB = 23 * MiB, WS_WO = 24 * MiB, WS_WEIN = 26 * MiB, WS_WEOUT = 154 * MiB;
constexpr size_t WS_R0 = 218 * MiB;
constexpr size_t WS_PROJ = WS_R0, WS_H1 = 609 * MiB, WS_QKC = 677 * MiB, WS_HDIR = 745 * MiB, WS_YDIR = 873 * MiB, WS_END = 937 * MiB;
constexpr size_t WS_A1 = WS_H1, WS_A2 = WS_QKC, WS_A3 = WS_QKC + 32 * MiB, WS_YA = WS_HDIR, WS_MERGED = WS_HDIR + 64 * MiB;
constexpr size_t WS_GS = 940 * MiB, WS_X1 = 940 * MiB, WS_END2 = 1004 * MiB;
constexpr size_t WS_H2 = WS_R0, WS_ACT = 282 * MiB, WS_Y = 554 * MiB;
static_assert(WS_PROJ + (size_t)MT * LDP * 2 <= WS_H1 && WS_Y + (size_t)MAXTILES * 256 * 1024 * 2 <= WS_END, "ws map");
constexpr int CW_BAR = 4096, CW_CNT = 16384;

constexpr int RING_BYTES = 131072;
constexpr int LDSCTL_OFF = RING_BYTES, MISC_OFF = LDSCTL_OFF + 320, TAB_OFF = LDSCTL_OFF + 512;
constexpr int LDS_BYTES = 147456;

#define GAS __attribute__((address_space(1)))
#define LAS __attribute__((address_space(3)))
typedef unsigned short bf16;
typedef unsigned v4u __attribute__((ext_vector_type(4)));
typedef unsigned v2u __attribute__((ext_vector_type(2)));
typedef float f32x4 __attribute__((ext_vector_type(4)));
typedef float f32x16 __attribute__((ext_vector_type(16)));
typedef short bf16x8 __attribute__((ext_vector_type(8)));
typedef GAS unsigned gu32;
#define RLX_AGENT __ATOMIC_RELAXED, __HIP_MEMORY_SCOPE_AGENT
#define LDS_WAIT() asm volatile("s_waitcnt lgkmcnt(0)" ::: "memory")
#define LBAR() do { asm volatile("s_waitcnt lgkmcnt(0)" ::: "memory"); __builtin_amdgcn_s_barrier(); asm volatile("" ::: "memory"); } while (0)
__device__ __forceinline__ unsigned f2bf(float f) { unsigned u = __builtin_bit_cast(unsigned, f); return (u + 0x7fffu + ((u >> 16) & 1u)) >> 16; }
typedef __bf16 bf16x2_t __attribute__((ext_vector_type(2)));
__device__ __forceinline__ unsigned cvtpk(float lo, float hi) { const bf16x2_t v = {(__bf16)lo, (__bf16)hi}; return __builtin_bit_cast(unsigned, v); }
__device__ __forceinline__ unsigned pk2(float lo, float hi) { return cvtpk(lo, hi); }
__device__ __forceinline__ float clamp448(float x) { return fminf(fmaxf(x, -448.0f), 448.0f); }
__device__ __forceinline__ unsigned pk4_fp8(float a, float b, float c, float d) {
    unsigned w = 0; w = __builtin_amdgcn_cvt_pk_fp8_f32(clamp448(a), clamp448(b), w, false); w = __builtin_amdgcn_cvt_pk_fp8_f32(clamp448(c), clamp448(d), w, true); return w; }
__device__ __forceinline__ float bf2f(unsigned b) { return __builtin_bit_cast(float, b << 16); }
__device__ __forceinline__ float bflo(unsigned w) { return __builtin_bit_cast(float, w << 16); }
__device__ __forceinline__ float bfhi(unsigned w) { return __builtin_bit_cast(float, w & 0xffff0000u); }
__device__ __forceinline__ float sigmoidf_(float x) { return 1.0f / (1.0f + __expf(-x)); }

#define XB_TMO      128
#define XB_XCNT(j)  (256  + 64 * (j))
#define XB_XSUB(j)  (1280 + 64 * (j))
#define XB_XGEN(j)  (2304 + 64 * (j))
#define XB_TOP      3328
#define XB_TOPGEN   3392
#define XCD_BAR_WORDS 3456
#define XB_SPIN_CAP (1u << 22)
__device__ __forceinline__ unsigned xb_ld(unsigned* p)              { return __hip_atomic_load(p, __ATOMIC_RELAXED, __HIP_MEMORY_SCOPE_AGENT); }
__device__ __forceinline__ unsigned xb_add(unsigned* p, unsigned v) { return __hip_atomic_fetch_add(p, v, __ATOMIC_RELAXED, __HIP_MEMORY_SCOPE_AGENT); }
__device__ __forceinline__ unsigned xb_xcc_id() { return (unsigned)__builtin_amdgcn_s_getreg((3 << 11) | 20) & 0xFu; }
#define XB_SPIN(cond, bar) do { unsigned _sp = 0; while (cond) { __builtin_amdgcn_s_sleep(1); \
    if ((++_sp & 255u) == 0u) { if (xb_ld(&(bar)[XB_TMO])) break; if (_sp > XB_SPIN_CAP) { atomicAdd(&(bar)[XB_TMO], 1u); break; } } } } while (0)
struct XcdBarrier { unsigned* bar; unsigned x; volatile LAS unsigned* st; };
__device__ __forceinline__ XcdBarrier xcd_barrier_post(unsigned* bar, volatile LAS unsigned* st) {
    XcdBarrier b; b.bar = bar; b.x = xb_xcc_id(); b.st = st;
    if (threadIdx.x == 0) (void)xb_add(&bar[XB_XCNT(b.x)], 1u);
    return b;
}
__device__ __forceinline__ void xcd_barrier_complete(unsigned* bar, unsigned x, unsigned& nloc, unsigned& nx) {
    const unsigned G = gridDim.x * gridDim.y * gridDim.z;
    unsigned sum, cnt, mine, sp = 0u;
    for (;;) {
        sum = 0u; cnt = 0u; mine = 0u;
#pragma unroll
        for (unsigned j = 0; j < 16; ++j) { const unsigned c = xb_ld(&bar[XB_XCNT(j)]); sum += c; cnt += (c > 0u) ? 1u : 0u; mine = (j == x) ? c : mine; }
        if (sum == G) break;
        __builtin_amdgcn_s_sleep(1);
        if ((++sp & 255u) == 0u) { if (xb_ld(&bar[XB_TMO])) break; if (sp > XB_SPIN_CAP) { atomicAdd(&bar[XB_TMO], 1u); break; } }
    }
    nloc = mine > 0u ? mine : 1u; nx = cnt > 0u ? cnt : 1u;
}
__device__ __forceinline__ void xcd_barrier(const XcdBarrier& b) {
    asm volatile("s_waitcnt vmcnt(0)" ::: "memory");
    __syncthreads();
    if (threadIdx.x == 0) {
        unsigned* bar = b.bar;
        __builtin_amdgcn_s_waitcnt(0);
        unsigned nloc = b.st[0], nx = b.st[1];
        if (nloc == 0u) { xcd_barrier_complete(bar, b.x, nloc, nx); b.st[0] = nloc; b.st[1] = nx; }
        const unsigned old = xb_add(&bar[XB_XSUB(b.x)], 1u);
        const unsigned gen = old / nloc;
        if (old + 1u == (gen + 1u) * nloc) {
            __builtin_amdgcn_fence(__ATOMIC_RELEASE, "agent");
            asm volatile("s_waitcnt vmcnt(0)" ::: "memory");
            const unsigned og = xb_add(&bar[XB_TOP], 1u);
            const unsigned tg = og / nx;
            if (og + 1u == (tg + 1u) * nx) xb_add(&bar[XB_TOPGEN], 1u);
            else XB_SPIN(xb_ld(&bar[XB_TOPGEN]) == tg, bar);
            __builtin_amdgcn_fence(__ATOMIC_ACQUIRE, "agent");
            xb_add(&bar[XB_XGEN(b.x)], 1u);
            asm volatile("s_waitcnt vmcnt(0)" ::: "memory");
        } else {
            XB_SPIN(xb_ld(&bar[XB_XGEN(b.x)]) == gen, bar);
            __builtin_amdgcn_fence(__ATOMIC_ACQUIRE, "agent");
            asm volatile("s_waitcnt vmcnt(0)" ::: "memory");
        }
    }
    __syncthreads();
}

struct Frame {
    LAS unsigned char* lds;
    gu32* ctl;
    int tid, lane, wave, vcu, G;
    float* out; unsigned char* ws;
};
__device__ __forceinline__ float wave_sum(float v) {
#pragma unroll
    for (int o = 1; o < 64; o <<= 1) v += __shfl_xor(v, o);
    return v;
}

struct InProjOrder {
    int G, c;
    __device__ __forceinline__ bool next(int i, pg8::Unit& u) const {
        const int NL = 128 * 23, NC = 8 * 11;
        const long L = (long)i * G + c; if (L >= NL + NC) return false;
        u.lbase = 0; u.nvalid = 0;
        if (L < NL) { const int wgid = pg8::xcd_remap((int)L, NL); const int nig = 8 * 23, gid = wgid / nig, fm = gid * 8; u.pm = fm + ((wgid % nig) % 8); u.pn = (wgid % nig) / 8; }
        else { const int r = (int)L - NL; u.pm = 128 + r / 11; const int q = r % 11; u.pn = q < 10 ? q : 22; }
        return true;
    }
};
struct MoeOrder {
    int G, c, npn; const LAS int* tab;
    __device__ __forceinline__ bool next(int i, pg8::Unit& u) const {
        const int nT = __builtin_amdgcn_readfirstlane(tab[32]); const int nU = nT * npn;
        const long L = (long)i * G + c; if (L >= nU) return false;
        const int wgid = pg8::xcd_remap((int)L, nU);
        const int tau = wgid / npn, pl = wgid % npn;
        int e = 0;
        for (int k = 1; k < 32; ++k) e += (__builtin_amdgcn_readfirstlane(tab[k]) <= tau) ? 1 : 0;
        const int il = tau - __builtin_amdgcn_readfirstlane(tab[e]);
        u.pm = tau; u.pn = e * npn + pl; u.lbase = e * ML + 256 * il; u.nvalid = __builtin_amdgcn_readfirstlane(tab[33 + e]) - 256 * il;
        return true;
    }
};
__device__ __forceinline__ void moe_tables(Frame& F) {
    LAS int* tab = (LAS int*)(F.lds + TAB_OFF);
    __syncthreads();
    if (F.tid < 32) tab[33 + F.tid] = (int)__hip_atomic_load(F.ctl + CW_CNT + 64 * F.tid, RLX_AGENT);
    __syncthreads();
    if (F.tid == 0) {
        int acc = 0;
        for (int e = 0; e < 32; ++e) { tab[e] = acc; acc += (tab[33 + e] + 255) >> 8; }
        tab[32] = acc;
    }
    __syncthreads();
}

using pg8::f32x4; using pg8::u32x4; using pg8::cvt_pk_bf16;
#define EPI_ROWS(u) const int row0 = (u).pm * 256 + wr * 64 + fr
#define EPI_LOOP _Pragma("unroll") for (int ai = 0; ai < 2; ++ai) _Pragma("unroll") for (int m = 0; m < 4; ++m)
__device__ __forceinline__ u32x4 pack8(const f32x4 a, const f32x4 b) { u32x4 w; w.x = cvt_pk_bf16(a[0], a[1]); w.y = cvt_pk_bf16(a[2], a[3]); w.z = cvt_pk_bf16(b[0], b[1]); w.w = cvt_pk_bf16(b[2], b[3]); return w; }
__device__ __forceinline__ void unpack8(const u32x4 w, f32x4& a, f32x4& b) { a = (f32x4){bflo(w.x), bfhi(w.x), bflo(w.y), bfhi(w.y)}; b = (f32x4){bflo(w.z), bfhi(w.z), bflo(w.w), bfhi(w.w)}; }
__device__ __forceinline__ void unpack8_fp8(const v2u w, f32x4& a, f32x4& b) {
    const auto l0 = __builtin_amdgcn_cvt_pk_f32_fp8((int)w.x, false), h0 = __builtin_amdgcn_cvt_pk_f32_fp8((int)w.x, true), l1 = __builtin_amdgcn_cvt_pk_f32_fp8((int)w.y, false), h1 = __builtin_amdgcn_cvt_pk_f32_fp8((int)w.y, true);
    a = (f32x4){l0[0], l0[1], h0[0], h0[1]}; b = (f32x4){l1[0], l1[1], h1[0], h1[1]}; }
__device__ __forceinline__ v2u pack8_fp8(const f32x4 a, const f32x4 b) { return (v2u){pk4_fp8(a[0], a[1], a[2], a[3]), pk4_fp8(b[0], b[1], b[2], b[3])}; }
__device__ __forceinline__ f32x4 sig4(f32x4 x) { return (f32x4){sigmoidf_(x[0]), sigmoidf_(x[1]), sigmoidf_(x[2]), sigmoidf_(x[3])}; }

struct EpiStore {
    static constexpr bool PERM = true; bf16* O; int ldc;
    __device__ __forceinline__ void operator()(const f32x4 (&acc)[2][2][4][2], const pg8::Unit& u, int wr, int wc, int fr, int fq) const {
        EPI_ROWS(u); const int col0 = u.pn * 256 + wc * 32 + 8 * fq;
        if (u.pn == 22 && wc != 0) return;
        EPI_LOOP { bf16* rowp = O + (size_t)(row0 + ai * 128 + m * 16) * ldc + col0;
#pragma unroll
            for (int bj = 0; bj < 2; ++bj) if (u.pn != 22 || bj == 0) *(u32x4*)(rowp + bj * 128) = pack8(acc[ai][bj][m][0], acc[ai][bj][m][1]); }
    }
};
struct EpiGlu {
    static constexpr bool PERM = true; const bf16* A2; bf16* A3; const float* bias;
    __device__ __forceinline__ void operator()(const f32x4 (&acc)[2][2][4][2], const pg8::Unit& u, int wr, int wc, int fr, int fq) const {
        EPI_ROWS(u); const int col0 = u.pn * 256 + wc * 32 + 8 * fq;
        f32x4 bv[2][2];
#pragma unroll
        for (int bj = 0; bj < 2; ++bj)
#pragma unroll
            for (int n = 0; n < 2; ++n) bv[bj][n] = *(const f32x4*)(bias + col0 + bj * 128 + 4 * n);
#pragma unroll
        for (int ai = 0; ai < 2; ++ai) {
            v2u ld[4][2];
#pragma unroll
            for (int m = 0; m < 4; ++m)
#pragma unroll
                for (int bj = 0; bj < 2; ++bj) ld[m][bj] = *(const v2u*)((const unsigned char*)A2 + (size_t)(row0 + ai * 128 + m * 16) * 512 + col0 + bj * 128);
            __builtin_amdgcn_sched_barrier(0);
#pragma unroll
            for (int m = 0; m < 4; ++m)
#pragma unroll
                for (int bj = 0; bj < 2; ++bj) { f32x4 a0, a1; unpack8_fp8(ld[m][bj], a0, a1);
                    const f32x4 v0 = a0 * sig4(acc[ai][bj][m][0] + bv[bj][0]), v1 = a1 * sig4(acc[ai][bj][m][1] + bv[bj][1]);
                    *(v2u*)((unsigned char*)A3 + (size_t)(row0 + ai * 128 + m * 16) * 512 + col0 + bj * 128) = pack8_fp8(v0, v1); }
        }
    }
};
template <bool ADD> struct EpiGate {
    static constexpr bool PERM = true; const bf16* proj; int gc0; const float* bg; const bf16* Prev; bf16* O;
    __device__ __forceinline__ void operator()(const f32x4 (&acc)[2][2][4][2], const pg8::Unit& u, int wr, int wc, int fr, int fq) const {
        EPI_ROWS(u); const int col0 = u.pn * 256 + wc * 32 + 8 * fq;
        f32x4 bv[2][2];
#pragma unroll
        for (int bj = 0; bj < 2; ++bj)
#pragma unroll
            for (int n = 0; n < 2; ++n) bv[bj][n] = *(const f32x4*)(bg + col0 + bj * 128 + 4 * n);
        constexpr int MB = ADD ? 2 : 4;
#pragma unroll
        for (int g = 0; g < 8 / MB; ++g) {
            u32x4 lg[MB][2], lp[MB][2];
#pragma unroll
            for (int mm = 0; mm < MB; ++mm)
#pragma unroll
                for (int bj = 0; bj < 2; ++bj) { const int q = g * MB + mm, row = row0 + (q >> 2) * 128 + (q & 3) * 16; lg[mm][bj] = *(const u32x4*)(proj + (size_t)row * LDP + gc0 + col0 + bj * 128);
                    if (ADD) lp[mm][bj] = *(const u32x4*)(Prev + (size_t)row * 1024 + col0 + bj * 128); }
            __builtin_amdgcn_sched_barrier(0);
#pragma unroll
            for (int mm = 0; mm < MB; ++mm)
#pragma unroll
                for (int bj = 0; bj < 2; ++bj) { const int q = g * MB + mm, ai = q >> 2, m = q & 3; f32x4 g0, g1; unpack8(lg[mm][bj], g0, g1);
                    f32x4 v0 = sig4(g0 + bv[bj][0]) * acc[ai][bj][m][0], v1 = sig4(g1 + bv[bj][1]) * acc[ai][bj][m][1];
                    if (ADD) { f32x4 p0, p1; unpack8(lp[mm][bj], p0, p1); v0 += p0; v1 += p1; }
                    if (ADD) *(v2u*)((unsigned char*)O + (size_t)(row0 + ai * 128 + m * 16) * 1024 + col0 + bj * 128) = pack8_fp8(v0 * 4.0f, v1 * 4.0f);
                    else *(u32x4*)(O + (size_t)(row0 + ai * 128 + m * 16) * 1024 + col0 + bj * 128) = pack8(v0, v1); }
            __builtin_amdgcn_sched_barrier(0);
        }
    }
};
struct EpiX1 {
    static constexpr bool PERM = true; const float* x; const float* mod; bf16* X1;
    __device__ __forceinline__ void operator()(const f32x4 (&acc)[2][2][4][2], const pg8::Unit& u, int wr, int wc, int fr, int fq) const {
        EPI_ROWS(u); const int col0 = u.pn * 256 + wc * 32 + 8 * fq; const int b = (u.pm * 256) / SEQ;
        f32x4 gv[2][2];
#pragma unroll
        for (int bj = 0; bj < 2; ++bj)
#pragma unroll
            for (int n = 0; n < 2; ++n) gv[bj][n] = *(const f32x4*)(mod + b * 6144 + 2 * D + col0 + bj * 128 + 4 * n);
#pragma unroll
        for (int g = 0; g < 4; ++g) {
            f32x4 lx[2][2][2];
#pragma unroll
            for (int mm = 0; mm < 2; ++mm)
#pragma unroll
                for (int bj = 0; bj < 2; ++bj) { const int q = g * 2 + mm; const size_t off = (size_t)(row0 + (q >> 2) * 128 + (q & 3) * 16) * D + col0 + bj * 128; lx[mm][bj][0] = *(const f32x4*)(x + off); lx[mm][bj][1] = *(const f32x4*)(x + off + 4); }
            __builtin_amdgcn_sched_barrier(0);
#pragma unroll
            for (int mm = 0; mm < 2; ++mm)
#pragma unroll
                for (int bj = 0; bj < 2; ++bj) { const int q = g * 2 + mm, ai = q >> 2, m = q & 3; const size_t off = (size_t)(row0 + ai * 128 + m * 16) * D + col0 + bj * 128;
                    *(u32x4*)(X1 + off) = pack8(lx[mm][bj][0] + gv[bj][0] * acc[ai][bj][m][0], lx[mm][bj][1] + gv[bj][1] * acc[ai][bj][m][1]); }
            __builtin_amdgcn_sched_barrier(0);
        }
    }
};
struct EpiSwiglu {
    static constexpr bool PERM = true; const float* bin; bf16* ACT;
    __device__ __forceinline__ void operator()(const f32x4 (&acc)[2][2][4][2], const pg8::Unit& u, int wr, int wc, int fr, int fq) const {
        EPI_ROWS(u); const int e = u.pn >> 3, pl = u.pn & 7; const int f0 = pl * 128 + wc * 32 + 8 * fq;
        f32x4 bg[2], bl[2];
#pragma unroll
        for (int n = 0; n < 2; ++n) { bg[n] = *(const f32x4*)(bin + e * 2048 + f0 + 4 * n); bl[n] = *(const f32x4*)(bin + e * 2048 + 1024 + f0 + 4 * n); }
        EPI_LOOP { f32x4 o[2];
#pragma unroll
            for (int n = 0; n < 2; ++n) { const f32x4 zg = acc[ai][0][m][n] + bg[n], zl = acc[ai][1][m][n] + bl[n];
#pragma unroll
                for (int j = 0; j < 4; ++j) { const float gl = fminf(zg[j], 7.0f); const float li = fminf(fmaxf(zl[j], -7.0f), 7.0f); o[n][j] = gl * sigmoidf_(1.702f * gl) * (li + 1.0f); } }
            *(v2u*)((unsigned char*)ACT + (size_t)(row0 + ai * 128 + m * 16) * 1024 + f0) = (v2u){pk4_fp8(8.f * o[0][0], 8.f * o[0][1], 8.f * o[0][2], 8.f * o[0][3]), pk4_fp8(8.f * o[1][0], 8.f * o[1][1], 8.f * o[1][2], 8.f * o[1][3])}; }
    }
};
struct EpiY {
    static constexpr bool PERM = true; const float* bout; bf16* Y;
    __device__ __forceinline__ void operator()(const f32x4 (&acc)[2][2][4][2], const pg8::Unit& u, int wr, int wc, int fr, int fq) const {
        EPI_ROWS(u); const int e = u.pn >> 2, pl = u.pn & 3; const int col0 = pl * 256 + wc * 32 + 8 * fq;
        f32x4 bv[2][2];
#pragma unroll
        for (int bj = 0; bj < 2; ++bj)
#pragma unroll
            for (int n = 0; n < 2; ++n) bv[bj][n] = *(const f32x4*)(bout + e * 1024 + col0 + bj * 128 + 4 * n);
        EPI_LOOP { unsigned char* rowp = (unsigned char*)Y + (size_t)(row0 + ai * 128 + m * 16) * 1024 + col0;
#pragma unroll
            for (int bj = 0; bj < 2; ++bj) { const f32x4 v0 = (acc[ai][bj][m][0] + bv[bj][0]) * 16.0f, v1 = (acc[ai][bj][m][1] + bv[bj][1]) * 16.0f;
                *(v2u*)(rowp + bj * 128) = (v2u){pk4_fp8(v0[0], v0[1], v0[2], v0[3]), pk4_fp8(v1[0], v1[1], v1[2], v1[3])}; } }
    }
};

struct TItem { const float* src; bf16* dst; int ld, ldk; int f8; };
__device__ __forceinline__ void titem_load(const TItem& t, int lane, f32x4 (&r)[8]) {
#pragma unroll
    for (int i = 0; i < 8; ++i) r[i] = *(const f32x4*)(t.src + (size_t)(8 * i + (lane >> 3)) * t.ld + 4 * (lane & 7));
}
__device__ __forceinline__ void titem_store(const TItem& t, int lane, const f32x4 (&r)[8], LAS float* scr) {
#pragma unroll
    for (int i = 0; i < 8; ++i) { LAS float* p = scr + (8 * i + (lane >> 3)) * 33 + 4 * (lane & 7); p[0] = r[i][0]; p[1] = r[i][1]; p[2] = r[i][2]; p[3] = r[i][3]; }
    LDS_WAIT(); asm volatile("" ::: "memory");
    const int c = lane & 7;
#pragma unroll
    for (int j = 0; j < 4; ++j) { const int n = (lane >> 3) + 8 * j; const LAS float* s = scr + (8 * c) * 33 + n;
        if (t.f8) { *(GAS v2u*)((unsigned char*)t.dst + (size_t)n * t.ldk + 8 * c) = (v2u){pk4_fp8(32.f * s[0 * 33], 32.f * s[1 * 33], 32.f * s[2 * 33], 32.f * s[3 * 33]), pk4_fp8(32.f * s[4 * 33], 32.f * s[5 * 33], 32.f * s[6 * 33], 32.f * s[7 * 33])}; }
        else { v4u o; o.x = pk2(s[0 * 33], s[1 * 33]); o.y = pk2(s[2 * 33], s[3 * 33]); o.z = pk2(s[4 * 33], s[5 * 33]); o.w = pk2(s[6 * 33], s[7 * 33]);
            *(GAS v4u*)(t.dst + (size_t)n * t.ldk + 8 * c) = o; } }
    LDS_WAIT(); asm volatile("" ::: "memory");
}
__device__ __forceinline__ void p0_prologue(Frame& F, const float* const* __restrict__ INP) {
    {
        LAS float* sc = (LAS float*)(F.lds);
        LAS float* red = (LAS float*)(F.lds + 9 * 1024 * 4);
        for (int i = F.tid; i < 9 * 1024; i += NWAVES * 64) { const int r = i >> 10, k = i & 1023; const float v = r < 8 ? INP[1][r * 1024 + k] : INP[3][k]; sc[i] = v / (1.0f + __expf(-v)); }
        __syncthreads();
        const float* wada = INP[4]; const float* bada = INP[5];
        float* mod = (float*)(F.ws + WS_MOD);
        for (int cg = blockIdx.x; cg < 256; cg += F.G) {
            const int j0 = cg * 24, col = F.lane & 31, kp = F.lane >> 5;
            float a[9];
#pragma unroll
            for (int r = 0; r < 9; ++r) a[r] = 0.f;
            if (col < 24) {
#pragma unroll 16
                for (int i = 0; i < 64; ++i) { const int k = F.wave * 128 + 2 * i + kp; const float wv = wada[(size_t)k * 6144 + j0 + col];
#pragma unroll
                    for (int r = 0; r < 9; ++r) a[r] += sc[r * 1024 + k] * wv; }
            }
#pragma unroll
            for (int r = 0; r < 9; ++r) red[((F.wave * 2 + kp) * 9 + r) * 32 + col] = a[r];
            __syncthreads();
            if (F.tid < 9 * 32) { const int r = F.tid >> 5, cc = F.tid & 31;
                if (cc < 24) { float s = 0.f; for (int p = 0; p < 16; ++p) s += red[(p * 9 + r) * 32 + cc]; const int j = j0 + cc; s += bada[j];
                    if (r < 8) mod[r * 6144 + j] = s; else if (j < 2048) mod[8 * 6144 + j] = s; } }
            __syncthreads();
        }
    }
    LAS float* scr = (LAS float*)(F.lds + F.wave * 16384);
    const int gw = F.vcu * NWAVES + F.wave, NGW = F.G * NWAVES;
    bf16* WIN = (bf16*)(F.ws + WS_WIN); bf16* WGLU = (bf16*)(F.ws + WS_WGLU); bf16* WA = (bf16*)(F.ws + WS_WA); bf16* WB = (bf16*)(F.ws + WS_WB); bf16* WO = (bf16*)(F.ws + WS_WO);
    bf16* WEIN = (bf16*)(F.ws + WS_WEIN); bf16* WEOUT = (bf16*)(F.ws + WS_WEOUT);
    constexpr int I_IN = 177 * 16, I_GLU = 16 * 8, I_A = 32 * 16, I_B = 32 * 8, I_O = 32 * 16, I_EIN = 32 * 64 * 16, I_EOUT = 32 * 32 * 16;
    constexpr int NITEMS = I_IN + I_GLU + I_A + I_B + I_O + I_EIN + I_EOUT;
#define P0_DECODE(it_, T) do { int r = (it_); \
        if (r < I_IN) { const int kb = r / 177, nb = r % 177, n0 = nb * 32; const int sc0 = n0 < 2048 ? n0 : (n0 < 5632 ? n0 + 32 : 2048); \
            T.src = INP[8] + (size_t)kb * 64 * 5664 + sc0; T.ld = 5664; T.dst = (bf16*)((unsigned char*)WIN + (size_t)n0 * 1024 + kb * 64); T.ldk = 1024; T.f8 = 1; break; } r -= I_IN; \
        if (r < I_GLU) { const int kb = r / 16, nb = r % 16; T.src = INP[21] + (size_t)kb * 64 * 512 + nb * 32; T.ld = 512; T.dst = (bf16*)((unsigned char*)WGLU + (size_t)nb * 32 * 512 + kb * 64); T.ldk = 512; T.f8 = 1; break; } r -= I_GLU; \
        if (r < I_A) { const int kb = r / 32, nb = r % 32; T.src = INP[12] + (size_t)kb * 64 * 1024 + nb * 32; T.ld = 1024; T.dst = (bf16*)((unsigned char*)WA + (size_t)nb * 32 * 1024 + kb * 64); T.ldk = 1024; T.f8 = 1; break; } r -= I_A; \
        if (r < I_B) { const int kb = r / 32, nb = r % 32; T.src = INP[23] + (size_t)kb * 64 * 1024 + nb * 32; T.ld = 1024; T.dst = (bf16*)((unsigned char*)WB + (size_t)nb * 32 * 512 + kb * 64); T.ldk = 512; T.f8 = 1; break; } r -= I_B; \
        if (r < I_O) { const int kb = r / 32, nb = r % 32; T.src = INP[25] + (size_t)kb * 64 * 1024 + nb * 32; T.ld = 1024; T.dst = (bf16*)((unsigned char*)WO + (size_t)nb * 32 * 1024 + kb * 64); T.ldk = 1024; T.f8 = 1; break; } r -= I_O; \
        if (r < I_EIN) { const int e = r / 1024, q = r % 1024, kb = q / 64, nb = q % 64; const int dr = nb * 32, pn = dr >> 8, bj = (dr >> 7) & 1, xx = dr & 127; \
            T.src = INP[28] + (size_t)e * 1024 * 2048 + (size_t)kb * 64 * 2048 + bj * 1024 + pn * 128 + xx; T.ld = 2048; T.dst = (bf16*)((unsigned char*)WEIN + (size_t)e * 2048 * 1024 + (size_t)dr * 1024 + kb * 64); T.ldk = 1024; T.f8 = 1; break; } r -= I_EIN; \
        { const int e = r / 512, q = r % 512, kb = q / 32, nb = q % 32; \
            T.src = INP[30] + (size_t)e * 1024 * 1024 + (size_t)kb * 64 * 1024 + nb * 32; T.ld = 1024; T.dst = (bf16*)((unsigned char*)WEOUT + (size_t)e * 1024 * 1024 + (size_t)nb * 32 * 1024 + kb * 64); T.ldk = 1024; T.f8 = 1; } } while (0)
    {
        TItem ta, tb; f32x4 ra[8], rb[8];
        int it = gw;
        if (it < NITEMS) { P0_DECODE(it, ta); titem_load(ta, F.lane, ra); }
        while (it < NITEMS) {
            const int nx = it + NGW;
            if (nx < NITEMS) { P0_DECODE(nx, tb); titem_load(tb, F.lane, rb); }
            titem_store(ta, F.lane, ra, scr);
            ta = tb;
#pragma unroll
            for (int i = 0; i < 8; ++i) ra[i] = rb[i];
            it = nx;
        }
    }
#undef P0_DECODE
    { const int gt = blockIdx.x * (NWAVES * 64) + F.tid, NT = F.G * NWAVES * 64; GAS v4u* z = (GAS v4u*)((unsigned char*)WIN + (size_t)5664 * 1024);
        for (int i = gt; i < 224 * 1024 / 16; i += NT) z[i] = (v4u){0u, 0u, 0u, 0u}; }
}

__device__ __forceinline__ void p1_norm1(Frame& F, const float* const* __restrict__ INP) {
    const int gw = F.vcu * NWAVES + F.wave, NGW = F.G * NWAVES;
    const float* mod = (const float*)(F.ws + WS_MOD); bf16* H1 = (bf16*)(F.ws + WS_H1);
    for (int m = gw; m < MT; m += NGW) {
        const float* xr; const float* sh; const float* scl;
        if (m < ML) { const int b = m / SEQ; xr = INP[0] + (size_t)m * D; sh = mod + b * 6144; scl = sh + D; }
        else { xr = INP[2] + (size_t)(m - ML) * D; sh = mod + 8 * 6144; scl = sh + D; }
        f32x4 v[4]; float s = 0.f;
#pragma unroll
        for (int j = 0; j < 4; ++j) { v[j] = *(const f32x4*)(xr + 256 * j + 4 * F.lane); s += (v[j][0] * v[j][0] + v[j][1] * v[j][1]) + (v[j][2] * v[j][2] + v[j][3] * v[j][3]); }
        const float rstd = 1.0f / sqrtf(wave_sum(s) * (1.0f / D) + EPS);
#pragma unroll
        for (int j = 0; j < 4; ++j) { const int c = 256 * j + 4 * F.lane; const f32x4 g = *(const f32x4*)(INP[6] + c), a = *(const f32x4*)(scl + c), bb = *(const f32x4*)(sh + c);
            const f32x4 y = v[j] * rstd * g * (a + 1.0f) + bb;
            *(unsigned*)((unsigned char*)H1 + (size_t)m * D + c) = pk4_fp8(y[0], y[1], y[2], y[3]); }
    }
}

__device__ __forceinline__ void conv_fma8(float (&a)[8], const v4u x, const float* wp) {
    const f32x4 w0 = *(const f32x4*)(wp), w1 = *(const f32x4*)(wp + 4);
    a[0] += bflo(x.x) * w0[0]; a[1] += bfhi(x.x) * w0[1]; a[2] += bflo(x.y) * w0[2]; a[3] += bfhi(x.y) * w0[3];
    a[4] += bflo(x.z) * w1[0]; a[5] += bfhi(x.z) * w1[1]; a[6] += bflo(x.w) * w1[2]; a[7] += bfhi(x.w) * w1[3];
}
__device__ __forceinline__ void p3_conv(Frame& F, const float* const* __restrict__ INP) {
    const bf16* PROJ = (const bf16*)(F.ws + WS_PROJ); bf16* QKC = (bf16*)(F.ws + WS_QKC); const float* wc = INP[9];
    const int NT = F.G * NWAVES * 64;
    for (int it = F.vcu * (NWAVES * 64) + F.tid; it < NB * 64 * 16 * 128; it += NT) {
        const int ch0 = (it & 127) * 8, seg = (it >> 7) & 15, gr = (it >> 11) & 63, b = it >> 17, c0 = seg * 4;
        const bf16* base = PROJ + (size_t)(b * SEQ) * LDP + ch0;
        const float scale = ch0 < 512 ? 0.125f : 1.0f;
        v4u win[6][3];
        const v4u z = (v4u){0u, 0u, 0u, 0u};
#pragma unroll
        for (int cc = 0; cc < 6; ++cc)
#pragma unroll
            for (int ky = 0; ky < 3; ++ky) { const int rr = gr + ky - 1, c = c0 + cc - 1;
                win[cc][ky] = (rr >= 0 && rr < 64 && c >= 0 && c < 64) ? *(const v4u*)(base + (size_t)(rr * 64 + c) * LDP) : z; }
        __builtin_amdgcn_sched_barrier(0);
        float a[4][8];
#pragma unroll
        for (int cc = 0; cc < 4; ++cc)
#pragma unroll
            for (int j = 0; j < 8; ++j) a[cc][j] = 0.f;
#pragma unroll
        for (int ky = 0; ky < 3; ++ky)
#pragma unroll
            for (int kx = 0; kx < 3; ++kx) {
                const f32x4 w0 = *(const f32x4*)(wc + (ky * 3 + kx) * 1024 + ch0), w1 = *(const f32x4*)(wc + (ky * 3 + kx) * 1024 + ch0 + 4);
#pragma unroll
                for (int cc = 0; cc < 4; ++cc) { const v4u x = win[cc + kx][ky];
                    a[cc][0] += bflo(x.x) * w0[0]; a[cc][1] += bfhi(x.x) * w0[1]; a[cc][2] += bflo(x.y) * w0[2]; a[cc][3] += bfhi(x.y) * w0[3];
                    a[cc][4] += bflo(x.z) * w1[0]; a[cc][5] += bfhi(x.z) * w1[1]; a[cc][6] += bflo(x.w) * w1[2]; a[cc][7] += bfhi(x.w) * w1[3]; }
                asm volatile("" ::: "memory");
            }
#pragma unroll
        for (int cc = 0; cc < 4; ++cc) {
#pragma unroll
            for (int j = 0; j < 8; ++j) a[cc][j] = a[cc][j] / (1.0f + __expf(-a[cc][j])) * scale;
            *(v4u*)(QKC + (size_t)(b * SEQ + gr * 64 + c0 + cc) * 1024 + ch0) = (v4u){pk2(a[cc][0], a[cc][1]), pk2(a[cc][2], a[cc][3]), pk2(a[cc][4], a[cc][5]), pk2(a[cc][6], a[cc][7])};
        }
    }
    for (int w = F.vcu * (NWAVES * 64) + F.tid; w < MC * 128; w += NT) {
        const int row = ML + (w >> 7), ch0 = (w & 127) * 8, t = (w >> 7) % CTXL;
        float a[8];
#pragma unroll
        for (int j = 0; j < 8; ++j) a[j] = 0.f;
#pragma unroll
        for (int kx = 0; kx < 3; ++kx) { const int tt = t + kx - 1;
            if (tt >= 0 && tt < CTXL) conv_fma8(a, *(const v4u*)(PROJ + (size_t)(row + kx - 1) * LDP + ch0), wc + (3 + kx) * 1024 + ch0); }
        const float scale = ch0 < 512 ? 0.125f : 1.0f;
#pragma unroll
        for (int j = 0; j < 8; ++j) a[j] = a[j] / (1.0f + __expf(-a[j])) * scale;
        *(v4u*)(QKC + (size_t)row * 1024 + ch0) = (v4u){pk2(a[0], a[1]), pk2(a[2], a[3]), pk2(a[4], a[5]), pk2(a[6], a[7])};
    }
    {
        float* GB = (float*)(F.ws + WS_GS); float* GG = GB + 128 * 4352; float* GP = GG + 128 * 4352;
        const int gw = F.vcu * NWAVES + F.wave, NGW = F.G * NWAVES, lane = F.lane;
        for (int it = gw; it < 128 * 34; it += NGW) {
            const int jc = it % 34, dbh = it / 34, h = dbh & 7, b = (dbh >> 3) & 7, d = dbh >> 6;
            const bool lat = jc >= 2; const int p0 = lat ? 128 * (jc - 2) : 128 * jc, Lseq = lat ? SEQ : CTXL, rowbase = lat ? b * SEQ : ML + b * CTXL;
            const float bi_ = INP[10][d * 16 + h], bf_ = INP[10][d * 16 + 8 + h];
            float li2[2], lf2[2];
#pragma unroll
            for (int e = 0; e < 2; ++e) { const int sp = 2 * lane + e; const int tt = d ? (Lseq - 1 - (p0 + sp)) : (p0 + sp); const size_t row = (size_t)(rowbase + tt);
                li2[e] = bf2f(PROJ[row * LDP + PC_IF + d * 16 + h]) + bi_; const float xf = bf2f(PROJ[row * LDP + PC_IF + d * 16 + 8 + h]) + bf_;
                lf2[e] = fminf(xf, 0.f) - log1pf(expf(-fabsf(xf))); }
            const float c1 = lf2[0] + lf2[1]; float inc = c1;
#pragma unroll
            for (int o = 1; o < 64; o <<= 1) { const float t = __shfl_up(inc, o); if (lane >= o) inc += t; }
            const float exc = inc - c1, b0 = exc + lf2[0], b1 = exc + c1, g0 = li2[0] - b0, g1 = li2[1] - b1;
            float pmx = fmaxf(g0, g1);
#pragma unroll
            for (int o = 1; o < 64; o <<= 1) { const float t = __shfl_up(pmx, o); if (lane >= o) pmx = fmaxf(pmx, t); }
            float pex = __shfl_up(pmx, 1); if (lane == 0) pex = -INFINITY;
            const size_t o = (size_t)dbh * 4352 + 128 * jc + 2 * lane;
            *(float2*)(GB + o) = make_float2(b0, b1); *(float2*)(GG + o) = make_float2(g0, g1); *(float2*)(GP + o) = make_float2(fmaxf(pex, g0), pmx);
        }
    }
}

__device__ __forceinline__ void mma32_nt(f32x16& acc, const LAS bf16* A, int lda, const LAS bf16* Bt, int ldb, int K, int lane) {
    const int r = lane & 31, h = lane >> 5;
#pragma unroll
    for (int k0 = 0; k0 < K; k0 += 16) {
        const bf16x8 a = *(const LAS bf16x8*)(A + r * lda + k0 + 8 * h);
        const bf16x8 b = *(const LAS bf16x8*)(Bt + r * ldb + k0 + 8 * h);
        acc = __builtin_amdgcn_mfma_f32_32x32x16_bf16(a, b, acc, 0, 0, 0);
        if ((k0 & 63) == 48) __builtin_amdgcn_sched_barrier(0);
    }
}
__device__ __forceinline__ void mma16_nt(f32x4& acc, const LAS bf16* A, int lda, const LAS bf16* Bt, int ldb, int K, int lane) {
    const int r = lane & 15, q = lane >> 4;
    for (int k0 = 0; k0 < K; k0 += 32) {
        const bf16x8 a = *(const LAS bf16x8*)(A + r * lda + k0 + 8 * q);
        const bf16x8 b = *(const LAS bf16x8*)(Bt + r * ldb + k0 + 8 * q);
        acc = __builtin_amdgcn_mfma_f32_16x16x32_bf16(a, b, acc, 0, 0, 0);
    }
}
__device__ __forceinline__ int row32(int reg, int lane) { return (reg & 3) + 8 * (reg >> 2) + 4 * (lane >> 5); }
__device__ __forceinline__ float logsigmoidf_(float x) { return fminf(x, 0.f) - log1pf(expf(-fabsf(x))); }

typedef short s16x4 __attribute__((ext_vector_type(4)));
__device__ __forceinline__ s16x4 tr_read(const LAS bf16* p) { return __builtin_amdgcn_ds_read_tr16_b64_v4i16((LAS s16x4*)p); }
__device__ __forceinline__ bf16x8 tr_frag32_perm(const LAS bf16* T, int ld, int k0, int x0, int lane) {
    const int h = lane >> 5, i = lane & 15, q = i >> 2, p = i & 3, xb = 16 * ((lane >> 4) & 1);
    const LAS bf16* a = T + (k0 + 4 * h + q) * ld + x0 + xb + 4 * p;
    const s16x4 lo = tr_read(a), hi = tr_read(a + 8 * ld);
    return (bf16x8){lo[0], lo[1], lo[2], lo[3], hi[0], hi[1], hi[2], hi[3]};
}
__device__ __forceinline__ bf16x8 tr_frag16(const LAS bf16* T, int ld, int k0, int x0, int lane) {
    const int q4 = lane >> 4, i = lane & 15, q = i >> 2, p = i & 3;
    const LAS bf16* a = T + (k0 + 8 * q4 + q) * ld + x0 + 4 * p;
    const s16x4 lo = tr_read(a), hi = tr_read(a + 4 * ld);
    return (bf16x8){lo[0], lo[1], lo[2], lo[3], hi[0], hi[1], hi[2], hi[3]};
}
__device__ __forceinline__ v4u scale8(const v4u k8, float ww) {
    return (v4u){pk2(ww * bflo(k8.x), ww * bfhi(k8.x)), pk2(ww * bflo(k8.y), ww * bfhi(k8.y)), pk2(ww * bflo(k8.z), ww * bfhi(k8.z)), pk2(ww * bflo(k8.w), ww * bfhi(k8.w))};
}

template <int MODE>
__device__ __forceinline__ void p4_mlstm(Frame& F, const float* const* __restrict__ INP, int unit) {
    const int vh = unit & 1, h = (unit >> 1) & 7, b = (unit >> 4) & 7, d = unit >> 7;
    LAS bf16* Qs = (LAS bf16*)(F.lds + 0);
    LAS bf16* Ks = (LAS bf16*)(F.lds + 18432);
    LAS bf16* Kw = (LAS bf16*)(F.lds + 36864);
    LAS bf16* Vs = (LAS bf16*)(F.lds + 55296);
    LAS bf16* Cb = (LAS bf16*)(F.lds + 73728);
    LAS float* vec = (LAS float*)(F.lds + 82944);
    LAS float *rowt = vec, *colt = vec + 128, *iev = vec + 256, *emt = vec + 384, *nv = vec + 512, *npart = vec + 576;
    const bf16* PROJ = (const bf16*)(F.ws + WS_PROJ); const bf16* QKC = (const bf16*)(F.ws + WS_QKC); bf16* HDIR = (bf16*)(F.ws + WS_HDIR) + (size_t)d * ML * 1024;
    const float* GB = (const float*)(F.ws + WS_GS) + (size_t)((d * 8 + b) * 8 + h) * 4352; const float* GG = GB + 128 * 4352; const float* GP = GG + 128 * 4352;
    int tid = F.tid; asm volatile("" : "+v"(tid));
    const int lane = tid & 63, w = F.wave;
    for (int i = tid; i < 64 * 72; i += 512) Cb[i] = 0;
    if (tid < 64) nv[tid] = 0.f;
    f32x4 accC[2] = {(f32x4){0.f, 0.f, 0.f, 0.f}, (f32x4){0.f, 0.f, 0.f, 0.f}};
    float m_old = 0.f, dec_prev = 0.f;
    v4u pq[2], pk[2], pv[2]; float pgb = 0.f, pgp = 0.f, pgc = 0.f, pgg[2], pbend, pgmax; v2u hout[4]; bf16* hptr = nullptr; bool hpend = false;
    const int zl = tid >> 9;
#define ML_PREFETCH(jn) do { const bool lat_ = (jn) >= 2; const int p0_ = lat_ ? 128 * ((jn) - 2) : 128 * (jn), L_ = lat_ ? SEQ : CTXL, rb_ = lat_ ? b * SEQ : ML + b * CTXL; \
        _Pragma("unroll") for (int i = 0; i < 2; ++i) { const int id = tid + 512 * i, s_ = id >> 3, c_ = id & 7; const int tt = d ? (L_ - 1 - (p0_ + s_)) : (p0_ + s_); const size_t row = (size_t)(rb_ + tt); \
            pq[i] = *(const v4u*)(QKC + row * 1024 + h * 64 + c_ * 8); pk[i] = *(const v4u*)(QKC + row * 1024 + 512 + h * 64 + c_ * 8); pv[i] = *(const v4u*)(PROJ + row * LDP + PC_V + h * 128 + vh * 64 + c_ * 8); \
            pgg[i] = GG[128 * (jn) + s_]; } \
        if (tid < 128) { pgb = GB[128 * (jn) + tid]; pgp = GP[128 * (jn) + tid]; pgc = GG[128 * (jn) + tid]; } \
        pbend = GB[128 * (jn) + 127 + zl]; pgmax = GP[128 * (jn) + 127 + zl]; } while (0)
    ML_PREFETCH(0);
    __syncthreads();
    for (int j = 0; j < 34; ++j) {
        const bool lat = j >= 2;
        const int p0 = lat ? 128 * (j - 2) : 128 * j, Lseq = lat ? SEQ : CTXL, rowbase = lat ? b * SEQ : ML + b * CTXL;
        const float bend = pbend, gmax = pgmax;
        const float mnew = fmaxf(bend + m_old, bend + gmax), dec = __expf(bend + m_old - mnew);
#pragma unroll
        for (int i = 0; i < 2; ++i) { const int id = tid + 512 * i, s = id >> 3, c = id & 7;
            *(LAS v4u*)(Qs + s * 72 + c * 8) = pq[i]; *(LAS v4u*)(Ks + s * 72 + c * 8) = pk[i]; *(LAS v4u*)(Vs + s * 72 + c * 8) = pv[i];
            *(LAS v4u*)(Kw + s * 72 + c * 8) = scale8(pk[i], __expf(bend + pgg[i] - mnew)); }
        if (tid < 128) { const float r = fmaxf(m_old, pgp); rowt[tid] = -r * 1.44269504089f; colt[tid] = pgc * 1.44269504089f; iev[tid] = __expf(m_old - r); emt[tid] = __expf(-pgb - r); }
        if (j > 0) {
            const int vi = w >> 1;
#pragma unroll
            for (int jj = 0; jj < 2; ++jj) { const int ki = 2 * (w & 1) + jj;
#pragma unroll
                for (int reg = 0; reg < 4; ++reg) Cb[(16 * vi + (lane >> 4) * 4 + reg) * 72 + 16 * ki + (lane & 15)] = (bf16)f2bf(accC[jj][reg]); }
            if (tid < 64) { float sacc = 0.f;
#pragma unroll
                for (int p = 0; p < 8; ++p) sacc += npart[p * 64 + tid];
                nv[tid] = dec_prev * nv[tid] + sacc; }
        }
        LBAR();
        if (j + 1 < 34 && !(MODE & 4)) ML_PREFETCH(j + 1);
        if (hpend) {
#pragma unroll
            for (int rg = 0; rg < 4; ++rg) *(v2u*)(hptr + 8 * rg) = hout[rg];
            hpend = false; }
        if (lat && !(MODE & 1)) { const int tm = w >> 1, vt = w & 1, tl = lane & 31, t = 32 * tm + tl, hh = lane >> 5; f32x16 acc;
#pragma unroll
            for (int reg = 0; reg < 16; ++reg) acc[reg] = 0.f;
            mma32_nt(acc, Cb + 32 * vt * 72, 72, Qs + 32 * tm * 72, 72, 64, lane);
            const float ie = iev[t], rt = rowt[t];
#pragma unroll
            for (int reg = 0; reg < 16; ++reg) acc[reg] *= ie;
            float rs = 0.f;
            for (int st = (MODE & 8) ? tm : 0; st <= tm; ++st) {
                f32x16 X;
#pragma unroll
                for (int reg = 0; reg < 16; ++reg) X[reg] = 0.f;
                mma32_nt(X, Ks + 32 * st * 72, 72, Qs + 32 * tm * 72, 72, 64, lane);
                const LAS float* cp = colt + 32 * st + 4 * hh;
                if (st == tm) { const int dlim = tl - 4 * hh;
#pragma unroll
                    for (int rg = 0; rg < 4; ++rg) { const f32x4 c4 = *(const LAS f32x4*)(cp + 8 * rg);
#pragma unroll
                        for (int e = 0; e < 4; ++e) { const float arg = (8 * rg + e <= dlim) ? c4[e] + rt : -INFINITY; const float pvv = X[4 * rg + e] * __builtin_amdgcn_exp2f(arg); X[4 * rg + e] = pvv; rs += pvv; } }
                } else {
#pragma unroll
                    for (int rg = 0; rg < 4; ++rg) { const f32x4 c4 = *(const LAS f32x4*)(cp + 8 * rg);
#pragma unroll
                        for (int e = 0; e < 4; ++e) { const float pvv = X[4 * rg + e] * __builtin_amdgcn_exp2f(c4[e] + rt); X[4 * rg + e] = pvv; rs += pvv; } }
                }
#pragma unroll
                for (int ks = 0; ks < 2; ++ks) {
                    const v4u bw = (v4u){cvtpk(X[8 * ks], X[8 * ks + 1]), cvtpk(X[8 * ks + 2], X[8 * ks + 3]), cvtpk(X[8 * ks + 4], X[8 * ks + 5]), cvtpk(X[8 * ks + 6], X[8 * ks + 7])};
                    const bf16x8 af = tr_frag32_perm(Vs, 72, 32 * st + 16 * ks, 32 * vt, lane);
                    acc = __builtin_amdgcn_mfma_f32_32x32x16_bf16(af, __builtin_bit_cast(bf16x8, bw), acc, 0, 0, 0); }
            }
            float nq = 0.f;
#pragma unroll
            for (int q = 0; q < 4; ++q) { const v4u q8 = *(const LAS v4u*)(Qs + t * 72 + 32 * hh + 8 * q); const LAS float* nn = nv + 32 * hh + 8 * q;
                nq += bflo(q8.x) * nn[0] + bfhi(q8.x) * nn[1] + bflo(q8.y) * nn[2] + bfhi(q8.y) * nn[3] + bflo(q8.z) * nn[4] + bfhi(q8.z) * nn[5] + bflo(q8.w) * nn[6] + bfhi(q8.w) * nn[7]; }
            rs += __shfl_xor(rs, 32); nq += __shfl_xor(nq, 32);
            const float rd = 1.0f / fmaxf(fabsf(ie * nq + rs), emt[t]);
            const int tt = d ? (Lseq - 1 - (p0 + t)) : (p0 + t);
            hptr = HDIR + (size_t)(rowbase + tt) * 1024 + h * 128 + vh * 64 + 32 * vt + 4 * hh;
#pragma unroll
            for (int rg = 0; rg < 4; ++rg) hout[rg] = (v2u){pk2(acc[4 * rg] * rd, acc[4 * rg + 1] * rd), pk2(acc[4 * rg + 2] * rd, acc[4 * rg + 3] * rd)};
            hpend = true; }
        if (!(MODE & 2)) { const int vi = w >> 1;
            accC[0] *= dec; accC[1] *= dec;
#pragma unroll
            for (int st4 = 0; st4 < 4; ++st4) { const bf16x8 af = tr_frag16(Vs, 72, 32 * st4, 16 * vi, lane);
#pragma unroll
                for (int jj = 0; jj < 2; ++jj) { const bf16x8 bfr = tr_frag16(Kw, 72, 32 * st4, 16 * (2 * (w & 1) + jj), lane); accC[jj] = __builtin_amdgcn_mfma_f32_16x16x32_bf16(af, bfr, accC[jj], 0, 0, 0); } } }
        { const int k = tid & 63, part = tid >> 6; float sacc = 0.f;
#pragma unroll
            for (int q = 0; q < 16; ++q) sacc += bf2f(Kw[(16 * part + q) * 72 + k]);
            npart[part * 64 + k] = sacc; }
        m_old = mnew; dec_prev = dec;
        LBAR();
    }
    if (hpend) {
#pragma unroll
        for (int rg = 0; rg < 4; ++rg) *(v2u*)(hptr + 8 * rg) = hout[rg]; }
#undef ML_PREFETCH
}

__device__ __forceinline__ void s5_disc(const float* const* __restrict__ INP, int d, int g, int p, float& ar, float& ai, float& cfr, float& cfi) {
    const float dt = expf(INP[15][d * 32 + g]); const float are = INP[13][(d * 32 + g) * 64 + p], aim = INP[14][(d * 32 + g) * 64 + p];
    const float mag = expf(dt * are), ang = dt * aim; ar = mag * cosf(ang); ai = mag * sinf(ang);
    const float den = are * are + aim * aim, xr = ar - 1.0f; cfr = (xr * are + ai * aim) / den; cfi = (ai * are - xr * aim) / den;
}
__device__ __forceinline__ void p4_s5(Frame& F, const float* const* __restrict__ INP, int unit) {
    const int gp = unit & 15, b = (unit >> 4) & 7, d = unit >> 7;
    LAS bf16* BHt = (LAS bf16*)(F.lds + 0);
    LAS bf16* Cm = (LAS bf16*)(F.lds + 69632);
    LAS float* Eb = (LAS float*)(F.lds + 78336);
    LAS bf16* Us = (LAS bf16*)(F.lds + 82432);
    LAS bf16* BBs = (LAS bf16*)(F.lds + 92672);
    const bf16* PROJ = (const bf16*)(F.ws + WS_PROJ); bf16* YDIR = (bf16*)(F.ws + WS_YDIR) + (size_t)d * ML * 512;
    int tid = F.tid; asm volatile("" : "+v"(tid));
    const int lane = tid & 63, w = F.wave;
    const int sg = tid & 127, seg = tid >> 7;
    float ar, ai, a32r, a32i;
    { float cfr, cfi; s5_disc(INP, d, 2 * gp + (sg >> 6), sg & 63, ar, ai, cfr, cfi); a32r = ar; a32i = ai;
#pragma unroll
        for (int q = 0; q < 5; ++q) { const float nr = a32r * a32r - a32i * a32i, ni = 2.0f * a32r * a32i; a32r = nr; a32i = ni; } }
    for (int idx = tid; idx < 4096; idx += 512) {
        { const int gg = idx >> 11, pp = (idx >> 4) & 127, c = idx & 15, g = 2 * gp + gg, p = pp & 63; float xr_, xi_, cfr, cfi; s5_disc(INP, d, g, p, xr_, xi_, cfr, cfi);
            const float bre = INP[16][((size_t)(d * 32 + g) * 64 + p) * 16 + c], bim = INP[17][((size_t)(d * 32 + g) * 64 + p) * 16 + c];
            BBs[(gg * 128 + pp) * 24 + c] = (bf16)f2bf(pp < 64 ? cfr * bre - cfi * bim : cfr * bim + cfi * bre); }
        { const int gg = idx >> 11, c = (idx >> 7) & 15, pp = idx & 127, g = 2 * gp + gg, p = pp & 63;
            const float v = pp < 64 ? INP[18][((size_t)(d * 32 + g) * 16 + c) * 64 + p] : -INP[19][((size_t)(d * 32 + g) * 16 + c) * 64 + p];
            Cm[(gg * 16 + c) * 136 + pp] = (bf16)f2bf(v); }
    }
    float h0r = 0.f, h0i = 0.f;
    LAS bf16* rowre = BHt + ((sg >> 6) * 128 + (sg & 63)) * 136 + 32 * seg;
    v4u pu; v2u yout[2]; bf16* yptr[2]; bool ypend = false;
#define S5_PREFETCH(jn) do { const bool lat_ = (jn) >= 2; const int p0_ = lat_ ? 128 * ((jn) - 2) : 128 * (jn), L_ = lat_ ? SEQ : CTXL, rb_ = lat_ ? b * SEQ : ML + b * CTXL; \
        const int s_ = tid >> 2, c_ = tid & 3; const int tt = d ? (L_ - 1 - (p0_ + s_)) : (p0_ + s_); pu = *(const v4u*)(PROJ + (size_t)(rb_ + tt) * LDP + PC_U + gp * 32 + c_ * 8); } while (0)
    S5_PREFETCH(0);
    __syncthreads();
    for (int j = 0; j < 34; ++j) {
        const bool lat = j >= 2;
        const int p0 = lat ? 128 * (j - 2) : 128 * j, Lseq = lat ? SEQ : CTXL, rowbase = lat ? b * SEQ : ML + b * CTXL;
        *(LAS v4u*)(Us + (tid >> 2) * 40 + (tid & 3) * 8) = pu;
        LBAR();
        if (j + 1 < 34) S5_PREFETCH(j + 1);
        if (ypend) { *(v2u*)yptr[0] = yout[0]; *(v2u*)yptr[1] = yout[1]; ypend = false; }
        { const int gg = w >> 2, tm = w & 3, r = lane & 31, hh = lane >> 5;
            const bf16x8 a = *(const LAS bf16x8*)(Us + (32 * tm + r) * 40 + gg * 16 + 8 * hh);
            LAS bf16* bp = BHt + (gg * 128 + r) * 136 + 32 * tm + 4 * hh;
#pragma unroll
            for (int tn = 0; tn < 4; ++tn) { f32x16 acc;
#pragma unroll
                for (int reg = 0; reg < 16; ++reg) acc[reg] = 0.f;
                const bf16x8 bb = *(const LAS bf16x8*)(BBs + (gg * 128 + 32 * tn + r) * 24 + 8 * hh);
                acc = __builtin_amdgcn_mfma_f32_32x32x16_bf16(a, bb, acc, 0, 0, 0);
#pragma unroll
                for (int rg = 0; rg < 4; ++rg) *(LAS v2u*)(bp + 32 * tn * 136 + 8 * rg) = (v2u){cvtpk(acc[4 * rg], acc[4 * rg + 1]), cvtpk(acc[4 * rg + 2], acc[4 * rg + 3])}; } }
        LBAR();
        v4u xr[4], xi[4];
#pragma unroll
        for (int q = 0; q < 4; ++q) { xr[q] = *(const LAS v4u*)(rowre + 8 * q); xi[q] = *(const LAS v4u*)(rowre + 64 * 136 + 8 * q); }
        { float hr = 0.f, hi = 0.f;
#pragma unroll
            for (int q = 0; q < 4; ++q)
#pragma unroll
                for (int e = 0; e < 4; ++e) { const unsigned wr_ = xr[q][e], wi_ = xi[q][e];
                    { const float br = bflo(wr_), bi = bflo(wi_); const float nr = ar * hr - ai * hi + br, ni = ar * hi + ai * hr + bi; hr = nr; hi = ni; }
                    { const float br = bfhi(wr_), bi = bfhi(wi_); const float nr = ar * hr - ai * hi + br, ni = ar * hi + ai * hr + bi; hr = nr; hi = ni; } }
            Eb[(seg * 128 + sg) * 2] = hr; Eb[(seg * 128 + sg) * 2 + 1] = hi; }
        LBAR();
        { float hcr = h0r, hci = h0i, hr = 0.f, hi = 0.f;
#pragma unroll
            for (int s2 = 0; s2 < 4; ++s2) { if (s2 == seg) { hr = hcr; hi = hci; } const float er = Eb[(s2 * 128 + sg) * 2], ei = Eb[(s2 * 128 + sg) * 2 + 1];
                const float nr = a32r * hcr - a32i * hci + er, ni = a32r * hci + a32i * hcr + ei; hcr = nr; hci = ni; }
            h0r = hcr; h0i = hci;
#pragma unroll
            for (int q = 0; q < 4; ++q) { v4u orr, oi;
#pragma unroll
                for (int e = 0; e < 4; ++e) { const unsigned wr_ = xr[q][e], wi_ = xi[q][e]; float r0, i0, r1, i1;
                    { const float br = bflo(wr_), bi = bflo(wi_); const float nr = ar * hr - ai * hi + br, ni = ar * hi + ai * hr + bi; hr = nr; hi = ni; r0 = hr; i0 = hi; }
                    { const float br = bfhi(wr_), bi = bfhi(wi_); const float nr = ar * hr - ai * hi + br, ni = ar * hi + ai * hr + bi; hr = nr; hi = ni; r1 = hr; i1 = hi; }
                    orr[e] = cvtpk(r0, r1); oi[e] = cvtpk(i0, i1); }
                *(LAS v4u*)(rowre + 8 * q) = orr; *(LAS v4u*)(rowre + 64 * 136 + 8 * q) = oi; } }
        LBAR();
        if (lat) { const int gg = w >> 2;
#pragma unroll
            for (int jj = 0; jj < 2; ++jj) { const int tm = 2 * (w & 3) + jj; f32x4 acc = (f32x4){0.f, 0.f, 0.f, 0.f};
#pragma unroll
                for (int st4 = 0; st4 < 4; ++st4) { const bf16x8 af = *(const LAS bf16x8*)(Cm + (gg * 16 + (lane & 15)) * 136 + 32 * st4 + 8 * (lane >> 4));
                    const bf16x8 bfr = tr_frag16(BHt + gg * 128 * 136, 136, 32 * st4, 16 * tm, lane);
                    acc = __builtin_amdgcn_mfma_f32_16x16x32_bf16(af, bfr, acc, 0, 0, 0); }
                const int t = 16 * tm + (lane & 15); const int tt = d ? (Lseq - 1 - (p0 + t)) : (p0 + t);
                yptr[jj] = YDIR + (size_t)(rowbase + tt) * 512 + (2 * gp + gg) * 16 + 4 * (lane >> 4); yout[jj] = (v2u){pk2(acc[0], acc[1]), pk2(acc[2], acc[3])}; }
            ypend = true; }
    }
    if (ypend) { *(v2u*)yptr[0] = yout[0]; *(v2u*)yptr[1] = yout[1]; }
#undef S5_PREFETCH
    __syncthreads();
}

__device__ __forceinline__ float gelu_tanh(float x) { const float u = 0.7978845608028654f * (x + 0.044715f * x * x * x); const float e = __expf(2.0f * u); const float th = 1.0f - 2.0f / (e + 1.0f); return 0.5f * x * (1.0f + th); }
__device__ __forceinline__ void p5a_prep(Frame& F, const float* const* __restrict__ INP) {
    const int gw = F.vcu * NWAVES + F.wave, NGW = F.G * NWAVES, lane = F.lane;
    const bf16* PROJ = (const bf16*)(F.ws + WS_PROJ); const bf16* HD0 = (const bf16*)(F.ws + WS_HDIR); const bf16* HD1 = HD0 + (size_t)ML * 1024;
    const bf16* YD0 = (const bf16*)(F.ws + WS_YDIR); const bf16* YD1 = YD0 + (size_t)ML * 512;
    bf16* A1 = (bf16*)(F.ws + WS_A1); bf16* A2 = (bf16*)(F.ws + WS_A2);
    for (int m0 = 2 * gw; m0 < ML; m0 += 2 * NGW) {
        v4u ha[2][2], hb[2][2], ho[2][2], ya[2], yb[2], yu[2];
#pragma unroll
        for (int r = 0; r < 2; ++r) { const size_t m = (size_t)(m0 + r);
#pragma unroll
            for (int q = 0; q < 2; ++q) { ha[r][q] = *(const v4u*)(HD0 + m * 1024 + 16 * lane + 8 * q); hb[r][q] = *(const v4u*)(HD1 + m * 1024 + 16 * lane + 8 * q); ho[r][q] = *(const v4u*)(PROJ + m * LDP + PC_O + 16 * lane + 8 * q); }
            ya[r] = *(const v4u*)(YD0 + m * 512 + 8 * lane); yb[r] = *(const v4u*)(YD1 + m * 512 + 8 * lane); yu[r] = *(const v4u*)(PROJ + m * LDP + PC_U + 8 * lane); }
        __builtin_amdgcn_sched_barrier(0);
#pragma unroll
        for (int r = 0; r < 2; ++r) { const size_t m = (size_t)(m0 + r);
            float hm[16]; float ss = 0.f;
#pragma unroll
            for (int q = 0; q < 2; ++q) { const v4u a = ha[r][q], bq = hb[r][q];
                hm[8 * q + 0] = bflo(a.x) + bflo(bq.x); hm[8 * q + 1] = bfhi(a.x) + bfhi(bq.x); hm[8 * q + 2] = bflo(a.y) + bflo(bq.y); hm[8 * q + 3] = bfhi(a.y) + bfhi(bq.y);
                hm[8 * q + 4] = bflo(a.z) + bflo(bq.z); hm[8 * q + 5] = bfhi(a.z) + bfhi(bq.z); hm[8 * q + 6] = bflo(a.w) + bflo(bq.w); hm[8 * q + 7] = bfhi(a.w) + bfhi(bq.w); }
#pragma unroll
            for (int q = 0; q < 16; ++q) ss += hm[q] * hm[q];
            ss += __shfl_xor(ss, 1); ss += __shfl_xor(ss, 2); ss += __shfl_xor(ss, 4);
            const float rs = 1.0f / sqrtf(ss * (1.0f / 128.0f) + EPS);
#pragma unroll
            for (int q = 0; q < 2; ++q) { const v4u o8 = ho[r][q]; const float* gm = INP[11] + 16 * lane + 8 * q;
                float rr[8]; const float og[8] = {bflo(o8.x), bfhi(o8.x), bflo(o8.y), bfhi(o8.y), bflo(o8.z), bfhi(o8.z), bflo(o8.w), bfhi(o8.w)};
#pragma unroll
                for (int e = 0; e < 8; ++e) rr[e] = hm[8 * q + e] * rs * gm[e] * sigmoidf_(og[e]);
                *(v2u*)((unsigned char*)A1 + m * 1024 + 16 * lane + 8 * q) = (v2u){pk4_fp8(rr[0], rr[1], rr[2], rr[3]), pk4_fp8(rr[4], rr[5], rr[6], rr[7])}; }
            { const v4u a = ya[r], bq = yb[r], u8 = yu[r]; const float* dd = INP[20] + 8 * lane;
                float rr[8] = {bflo(a.x) + bflo(bq.x) + dd[0] * bflo(u8.x), bfhi(a.x) + bfhi(bq.x) + dd[1] * bfhi(u8.x), bflo(a.y) + bflo(bq.y) + dd[2] * bflo(u8.y), bfhi(a.y) + bfhi(bq.y) + dd[3] * bfhi(u8.y),
                               bflo(a.z) + bflo(bq.z) + dd[4] * bflo(u8.z), bfhi(a.z) + bfhi(bq.z) + dd[5] * bfhi(u8.z), bflo(a.w) + bflo(bq.w) + dd[6] * bflo(u8.w), bfhi(a.w) + bfhi(bq.w) + dd[7] * bfhi(u8.w)};
#pragma unroll
                for (int e = 0; e < 8; ++e) rr[e] = gelu_tanh(rr[e]);
                *(v2u*)((unsigned char*)A2 + m * 512 + 8 * lane) = (v2u){pk4_fp8(rr[0], rr[1], rr[2], rr[3]), pk4_fp8(rr[4], rr[5], rr[6], rr[7])}; }
        }
    }
}

__device__ __forceinline__ void route_reduce_top4(float (&acc)[32], const float* br, int lane, float (&tv)[4], int (&ti)[4]) {
#pragma unroll
    for (int i = 0; i < 16; ++i) { const float send = (lane & 32) ? acc[i] : acc[i + 16]; const float keep = (lane & 32) ? acc[i + 16] : acc[i]; acc[i] = keep + __shfl_xor(send, 32); }
#pragma unroll
    for (int i = 0; i < 8; ++i) { const float send = (lane & 16) ? acc[i] : acc[i + 8]; const float keep = (lane & 16) ? acc[i + 8] : acc[i]; acc[i] = keep + __shfl_xor(send, 16); }
#pragma unroll
    for (int i = 0; i < 4; ++i) { const float send = (lane & 8) ? acc[i] : acc[i + 4]; const float keep = (lane & 8) ? acc[i + 4] : acc[i]; acc[i] = keep + __shfl_xor(send, 8); }
#pragma unroll
    for (int i = 0; i < 2; ++i) { const float send = (lane & 4) ? acc[i] : acc[i + 2]; const float keep = (lane & 4) ? acc[i + 2] : acc[i]; acc[i] = keep + __shfl_xor(send, 4); }
    { const float send = (lane & 2) ? acc[0] : acc[1]; const float keep = (lane & 2) ? acc[1] : acc[0]; acc[0] = keep + __shfl_xor(send, 2); }
    acc[0] += __shfl_xor(acc[0], 1);
    float val = acc[0] + br[lane >> 1];
    if (lane & 1) val = -INFINITY;
#pragma unroll
    for (int r = 0; r < 4; ++r) { float mx = val;
#pragma unroll
        for (int o = 1; o < 64; o <<= 1) mx = fmaxf(mx, __shfl_xor(mx, o));
        const unsigned long long bal = __ballot(val == mx); const int wl = __ffsll((long long)bal) - 1;
        tv[r] = mx; ti[r] = wl >> 1; if (lane == wl) val = -INFINITY; }
}
__device__ __forceinline__ void p6_route(Frame& F, const float* const* __restrict__ INP) {
    const bf16* X1 = (const bf16*)(F.ws + WS_X1); const float* mod = (const float*)(F.ws + WS_MOD); bf16* H2 = (bf16*)(F.ws + WS_H2);
    int* TOPE = (int*)(F.ws + WS_TOPE); int* POS = (int*)(F.ws + WS_POS); float* TOPP = (float*)(F.ws + WS_TOPP); int* LIST = (int*)(F.ws + WS_LIST);
    LAS float* Wt = (LAS float*)(F.lds);
    LAS int* pe = (LAS int*)(F.lds + LDSCTL_OFF + 1024); LAS int* hist = pe + 512; LAS int* base = hist + 32; LAS int* rank = base + 32;
    const float* wr = INP[26]; const float* br = INP[27];
    const int lane = F.lane, w = F.wave;
    for (int idx = F.tid; idx < 32768; idx += NWAVES * 64) { const int e = idx >> 10, k = idx & 1023; Wt[((((k >> 8) * 4 + (k & 3)) * 32 + e) << 6) + ((k >> 2) & 63)] = wr[k * 32 + e]; }
    __syncthreads();
    for (int tg = blockIdx.x; tg < ML / 128; tg += F.G) {
        if (F.tid < 32) hist[F.tid] = 0;
        __syncthreads();
#pragma unroll 1
        for (int q = 0; q < 16; q += 2) {
            const int tl = w * 16 + q, m = tg * 128 + tl, b = m / SEQ;
            const float* sh = mod + b * 6144 + 3 * D; const float* scl = sh + D;
            float s0 = 0.f, s1 = 0.f;
#pragma unroll
            for (int j = 0; j < 4; ++j) { const v2u w0 = *(const v2u*)(X1 + (size_t)m * D + 256 * j + 4 * lane), w1 = *(const v2u*)(X1 + (size_t)(m + 1) * D + 256 * j + 4 * lane);
                const f32x4 x0 = (f32x4){bflo(w0.x), bfhi(w0.x), bflo(w0.y), bfhi(w0.y)}, x1 = (f32x4){bflo(w1.x), bfhi(w1.x), bflo(w1.y), bfhi(w1.y)};
                s0 += (x0[0] * x0[0] + x0[1] * x0[1]) + (x0[2] * x0[2] + x0[3] * x0[3]); s1 += (x1[0] * x1[0] + x1[1] * x1[1]) + (x1[2] * x1[2] + x1[3] * x1[3]); }
            const float r0 = 1.0f / sqrtf(wave_sum(s0) * (1.0f / D) + EPS), r1 = 1.0f / sqrtf(wave_sum(s1) * (1.0f / D) + EPS);
            float a0[32], a1[32];
#pragma unroll
            for (int e = 0; e < 32; ++e) { a0[e] = 0.f; a1[e] = 0.f; }
#pragma unroll 1
            for (int j = 0; j < 4; ++j) { const int c = 256 * j + 4 * lane; const f32x4 g = *(const f32x4*)(INP[7] + c), a = *(const f32x4*)(scl + c), bb = *(const f32x4*)(sh + c);
                const v2u w0 = *(const v2u*)(X1 + (size_t)m * D + c), w1 = *(const v2u*)(X1 + (size_t)(m + 1) * D + c);
                const f32x4 x0 = (f32x4){bflo(w0.x), bfhi(w0.x), bflo(w0.y), bfhi(w0.y)}, x1 = (f32x4){bflo(w1.x), bfhi(w1.x), bflo(w1.y), bfhi(w1.y)};
                const f32x4 gs = g * (a + 1.0f); const f32x4 y0 = x0 * r0 * gs + bb, y1 = x1 * r1 * gs + bb;
                *(unsigned*)((unsigned char*)H2 + (size_t)m * D + c) = pk4_fp8(y0[0], y0[1], y0[2], y0[3]); *(unsigned*)((unsigned char*)H2 + (size_t)(m + 1) * D + c) = pk4_fp8(y1[0], y1[1], y1[2], y1[3]);
                const LAS float* wj = Wt + j * 8192 + lane;
#pragma unroll
                for (int qq = 0; qq < 4; ++qq) { const LAS float* wp = wj + qq * 2048; const float ya = y0[qq], yb = y1[qq];
#pragma unroll
                    for (int e = 0; e < 32; ++e) { const float wv = wp[e * 64]; a0[e] += ya * wv; a1[e] += yb * wv; }
                    asm volatile("" ::: "memory"); } }
            float tv[4]; int ti[4];
#pragma unroll
            for (int tk = 0; tk < 2; ++tk) {
                if (tk == 0) route_reduce_top4(a0, br, lane, tv, ti); else route_reduce_top4(a1, br, lane, tv, ti);
                const float e1 = __expf(tv[1] - tv[0]), e2 = __expf(tv[2] - tv[0]), e3 = __expf(tv[3] - tv[0]); const float inv = 1.0f / (1.0f + e1 + e2 + e3);
                if (lane < 4) { const float p = lane == 0 ? inv : (lane == 1 ? e1 * inv : (lane == 2 ? e2 * inv : e3 * inv)); const int ee = lane == 0 ? ti[0] : (lane == 1 ? ti[1] : (lane == 2 ? ti[2] : ti[3]));
                    TOPP[(m + tk) * 4 + lane] = p; TOPE[(m + tk) * 4 + lane] = ee; pe[(tl + tk) * 4 + lane] = ee; }
            }
        }
        __syncthreads();
        { const int e = pe[F.tid]; rank[F.tid] = __hip_atomic_fetch_add(&hist[e], 1, __ATOMIC_RELAXED, __HIP_MEMORY_SCOPE_WORKGROUP); }
        __syncthreads();
        if (F.tid < 32) base[F.tid] = (int)__hip_atomic_fetch_add(F.ctl + CW_CNT + 64 * F.tid, (unsigned)hist[F.tid], RLX_AGENT);
        __syncthreads();
        { const int e = pe[F.tid]; const int pos = base[e] + rank[F.tid]; const int m = tg * 128 + (F.tid >> 2); LIST[e * ML + pos] = m; POS[m * 4 + (F.tid & 3)] = pos; }
        __syncthreads();
    }
}

typedef int i32x4 __attribute__((ext_vector_type(4)));
__device__ __forceinline__ void p10_combine(Frame& F, const float* const* __restrict__ INP) {
    moe_tables(F);
    const LAS int* tab = (const LAS int*)(F.lds + TAB_OFF);
    const bf16* X1 = (const bf16*)(F.ws + WS_X1); float* OUT = F.out; const float* mod = (const float*)(F.ws + WS_MOD); const unsigned char* Y = (const unsigned char*)(F.ws + WS_Y);
    const int* TOPE = (const int*)(F.ws + WS_TOPE); const int* POS = (const int*)(F.ws + WS_POS); const float* TOPP = (const float*)(F.ws + WS_TOPP);
    const int gw = F.vcu * NWAVES + F.wave, NGW = F.G * NWAVES, lane = F.lane;
    i32x4 te[2], tp[2]; f32x4 tw[2];
    int m0 = 2 * gw;
    if (m0 < ML) {
#pragma unroll
        for (int r = 0; r < 2; ++r) { te[r] = *(const i32x4*)(TOPE + (m0 + r) * 4); tp[r] = *(const i32x4*)(POS + (m0 + r) * 4); tw[r] = *(const f32x4*)(TOPP + (m0 + r) * 4); } }
    for (; m0 < ML; m0 += 2 * NGW) {
        unsigned yv[2][4][4]; v2u xv[2][4];
#pragma unroll
        for (int r = 0; r < 2; ++r) {
#pragma unroll
            for (int k = 0; k < 4; ++k) { const size_t slot = (size_t)256 * tab[te[r][k]] + tp[r][k];
#pragma unroll
                for (int j = 0; j < 4; ++j) yv[r][k][j] = *(const unsigned*)(Y + slot * 1024 + 256 * j + 4 * lane); }
#pragma unroll
            for (int j = 0; j < 4; ++j) xv[r][j] = *(const v2u*)(X1 + (size_t)(m0 + r) * D + 256 * j + 4 * lane); }
        const f32x4 cw[2] = {tw[0], tw[1]};
        const int mn = m0 + 2 * NGW;
        if (mn < ML) {
#pragma unroll
            for (int r = 0; r < 2; ++r) { te[r] = *(const i32x4*)(TOPE + (mn + r) * 4); tp[r] = *(const i32x4*)(POS + (mn + r) * 4); tw[r] = *(const f32x4*)(TOPP + (mn + r) * 4); } }
        __builtin_amdgcn_sched_barrier(0);
#pragma unroll
        for (int r = 0; r < 2; ++r) { const int m = m0 + r, b = m / SEQ; const float* gt2 = mod + b * 6144 + 5 * D;
            f32x4 v[4]; float s = 0.f;
#pragma unroll
            for (int j = 0; j < 4; ++j) { const int c = 256 * j + 4 * lane; f32x4 mo = (f32x4){0.f, 0.f, 0.f, 0.f};
#pragma unroll
                for (int k = 0; k < 4; ++k) { const unsigned y = yv[r][k][j]; const auto lo = __builtin_amdgcn_cvt_pk_f32_fp8((int)y, false), hi = __builtin_amdgcn_cvt_pk_f32_fp8((int)y, true);
                    mo += (f32x4){lo[0], lo[1], hi[0], hi[1]} * (cw[r][k] * 0.0625f); }
                const v2u xw = xv[r][j]; v[j] = (f32x4){bflo(xw.x), bfhi(xw.x), bflo(xw.y), bfhi(xw.y)} + *(const f32x4*)(gt2 + c) * mo;
                s += (v[j][0] * v[j][0] + v[j][1] * v[j][1]) + (v[j][2] * v[j][2] + v[j][3] * v[j][3]); }
            const float rstd = 1.0f / sqrtf(wave_sum(s) * (1.0f / D) + EPS);
#pragma unroll
            for (int j = 0; j < 4; ++j) { const int c = 256 * j + 4 * lane; *(f32x4*)(OUT + (size_t)m * D + c) = v[j] * rstd * *(const f32x4*)(INP[32] + c); }
        }
    }
}

struct Args { const float* in[33]; float* out; unsigned char* ws; int ph_lo, ph_hi, li, pad; };
__global__ void __launch_bounds__(NWAVES * 64, 2) fwd_kernel(Args args) {
    extern __shared__ __attribute__((aligned(16))) unsigned char lds[];
    Frame F;
    F.lds = (LAS unsigned char*)lds;
    F.tid = threadIdx.x; F.lane = F.tid & 63; F.wave = __builtin_amdgcn_readfirstlane(F.tid >> 6);
    F.G = gridDim.x; { const int bx = blockIdx.x; F.vcu = (F.G % 8 == 0) ? (bx % 8) * (F.G / 8) + bx / 8 : bx; }
    F.ws = args.ws; F.ctl = (gu32*)(args.ws + WS_CTL); F.out = args.out;
    for (int u = F.tid; u < (LDS_BYTES - LDSCTL_OFF) / 4; u += NWAVES * 64) ((LAS unsigned*)(F.lds + LDSCTL_OFF))[u] = 0u;
    __syncthreads();
    XcdBarrier bar; bar.bar = (unsigned*)(F.ctl + CW_BAR); bar.x = 0; bar.st = nullptr;
    if (N_LAUNCHES == 1) bar = xcd_barrier_post((unsigned*)(F.ctl + CW_BAR), (volatile LAS unsigned*)(F.lds + MISC_OFF) + 8);
    const int lo = args.ph_lo, hi = args.ph_hi;
    const float* const* __restrict__ INP = args.in;
#ifndef PH_MASK
#define PH_MASK 0x3fff
#endif
#define IN(k) ((((PH_MASK) >> (k)) & 1) && lo <= (k) && (k) < hi)
#define SEAM(k) do { if (IN(k) && IN((k) + 1)) xcd_barrier(bar); } while (0)
    const bf16* WIN = (const bf16*)(F.ws + WS_WIN);

    if (IN(0)) { p0_prologue(F, INP); } SEAM(0);
    if (IN(1)) { p1_norm1(F, INP); } SEAM(1);
    if (IN(2)) {
        pg8::Gemm g{(const bf16*)(F.ws + WS_H1), WIN, 512, nullptr, 0x7f7f7f7f, 0x7a7a7a7a}; InProjOrder S{F.G, (int)blockIdx.x};
        EpiStore E{(bf16*)(F.ws + WS_PROJ), LDP};
        pg8::gemm_phase<EpiStore, InProjOrder, false, true>(F.lds, g, S, E);
    } SEAM(2);
    if (IN(3)) { p3_conv(F, INP); } SEAM(3);
    if (IN(4)) { for (int u = blockIdx.x; u < 256; u += F.G) { p4_mlstm<0>(F, INP, u); if (P4_REP_M > 1) p4_mlstm<P4_MODE>(F, INP, u); for (int r_ = 0; r_ < P4_REP_S; ++r_) p4_s5(F, INP, u); } } SEAM(4);
    if (IN(5)) { p5a_prep(F, INP); } SEAM(5);
    if (IN(6)) {
        pg8::Gemm g{(const bf16*)(F.ws + WS_A2), (const bf16*)(F.ws + WS_WGLU), 256, nullptr, 0x7f7f7f7f, 0x7a7a7a7a}; pg8::StaticOrder S; S.init(ML, 512, F.G, (int)blockIdx.x);
        EpiGlu E{(const bf16*)(F.ws + WS_A2), (bf16*)(F.ws + WS_A3), INP[22]};
        pg8::gemm_phase<EpiGlu, pg8::StaticOrder, false, true>(F.lds, g, S, E);
    }
    if (IN(7)) {
        pg8::Gemm g{(const bf16*)(F.ws + WS_A1), (const bf16*)(F.ws + WS_WA), 512, nullptr, 0x7f7f7f7f, 0x7a7a7a7a}; pg8::StaticOrder S; S.init(ML, 1024, F.G, (int)blockIdx.x);
        EpiGate<false> E{(const bf16*)(F.ws + WS_PROJ), PC_G, INP[24], nullptr, (bf16*)(F.ws + WS_YA)};
        pg8::gemm_phase<EpiGate<false>, pg8::StaticOrder, false, true>(F.lds, g, S, E);
    } SEAM(7);
    if (IN(8)) {
        pg8::Gemm g{(const bf16*)(F.ws + WS_A3), (const bf16*)(F.ws + WS_WB), 256, nullptr, 0x7f7f7f7f, 0x7a7a7a7a}; pg8::StaticOrder S; S.init(ML, 1024, F.G, (int)blockIdx.x);
        EpiGate<true> E{(const bf16*)(F.ws + WS_PROJ), PC_G + 1024, INP[24] + 1024, (const bf16*)(F.ws + WS_YA), (bf16*)(F.ws + WS_MERGED)};
        pg8::gemm_phase<EpiGate<true>, pg8::StaticOrder, false, true>(F.lds, g, S, E);
    } SEAM(8);
    if (IN(9)) {
        pg8::Gemm g{(const bf16*)(F.ws + WS_MERGED), (const bf16*)(F.ws + WS_WO), 512, nullptr, 0x7d7d7d7d, 0x7a7a7a7a}; pg8::StaticOrder S; S.init(ML, 1024, F.G, (int)blockIdx.x);
        EpiX1 E{INP[0], (const float*)(F.ws + WS_MOD), (bf16*)(F.ws + WS_X1)};
        pg8::gemm_phase<EpiX1, pg8::StaticOrder, false, true>(F.lds, g, S, E);
    } SEAM(9);
    if (IN(10)) { p6_route(F, INP); } SEAM(10);
    if (IN(11)) {
        moe_tables(F);
        MoeOrder S{F.G, (int)blockIdx.x, 8, (const LAS int*)(F.lds + TAB_OFF)};
        LAS unsigned short* ridx = (LAS unsigned short*)(F.lds + LDSCTL_OFF + 1024);
        { const int* LIST = (const int*)(F.ws + WS_LIST);
            for (int i = 0; i < 30; ++i) { pg8::Unit u; if (!S.next(i, u)) break;
                if (F.tid < 256) { const int rc = F.tid < u.nvalid ? F.tid : u.nvalid - 1; ridx[i * 256 + F.tid] = (unsigned short)LIST[u.lbase + rc]; } }
            __syncthreads(); }
        pg8::Gemm g{(const bf16*)(F.ws + WS_H2), (const bf16*)(F.ws + WS_WEIN), 512, ridx, 0x7f7f7f7f, 0x7a7a7a7a};
        EpiSwiglu E{INP[29], (bf16*)(F.ws + WS_ACT)};
        pg8::gemm_phase<EpiSwiglu, MoeOrder, true, true>(F.lds, g, S, E);
    } SEAM(11);
    if (IN(12)) {
        moe_tables(F);
        pg8::Gemm g{(const bf16*)(F.ws + WS_ACT), (const bf16*)(F.ws + WS_WEOUT), 512, nullptr, 0x7c7c7c7c, 0x7a7a7a7a}; MoeOrder S{F.G, (int)blockIdx.x, 4, (const LAS int*)(F.lds + TAB_OFF)};
        EpiY E{INP[31], (bf16*)(F.ws + WS_Y)};
        pg8::gemm_phase<EpiY, MoeOrder, false, true>(F.lds, g, S, E);
    } SEAM(12);
    if (IN(13)) { p10_combine(F, INP); }
#undef IN
#undef SEAM
}

extern "C" void kernel_launch(void* const* d_in, const int* in_sizes, int n_in, void* d_out, int out_size, void* d_ws, size_t ws_size, hipStream_t stream) {
    static int grid = 0;
    if (grid == 0) {
        if (n_in != 33 || out_size != ML * D || ws_size < WS_END2) { fprintf(stderr, "kernel_launch: unexpected shapes (n_in %d, out %d, ws %zu)\n", n_in, out_size, ws_size); grid = -1; return; }
        int dev = 0, cus = 0, per_cu = 0;
        if (hipGetDevice(&dev) != hipSuccess || hipDeviceGetAttribute(&cus, hipDeviceAttributeMultiprocessorCount, dev) != hipSuccess) { grid = -1; return; }
        if (hipFuncSetAttribute((const void*)fwd_kernel, hipFuncAttributeMaxDynamicSharedMemorySize, LDS_BYTES) != hipSuccess) { fprintf(stderr, "kernel_launch: hipFuncSetAttribute failed\n"); grid = -1; return; }
        if (hipOccupancyMaxActiveBlocksPerMultiprocessor(&per_cu, (const void*)fwd_kernel, NWAVES * 64, LDS_BYTES) != hipSuccess || per_cu < 1) fprintf(stderr, "kernel_launch: occupancy query reports %d\n", per_cu);
        (void)hipGetLastError();
        grid = cus;
    }
    if (grid < 0) return;
    if (hipMemsetAsync((char*)d_ws + WS_CTL, 0, CTL_ZERO_BYTES, stream) != hipSuccess) return;
    Args a{};
    for (int i = 0; i < 33; ++i) a.in[i] = (const float*)d_in[i];
    a.out = (float*)d_out; a.ws = (unsigned char*)d_ws;
    for (int li = 0; li < N_LAUNCHES; ++li) {
        a.ph_lo = (N_LAUNCHES == 1) ? 0 : li; a.ph_hi = (N_LAUNCHES == 1) ? NPH : li + 1; a.li = li;
        const int nrep = (N_LAUNCHES != 1 && (((PROBE_DUP_MASK) >> li) & 1)) ? 2 : 1;
        for (int r = 0; r < nrep; ++r) hipLaunchKernelGGL(fwd_kernel, dim3(grid), dim3(NWAVES * 64), LDS_BYTES, stream, a);
    }
}
```

```cpp
#include <hip/hip_runtime.h>
#include <cstdio>
#include <cstdint>

#ifndef MK_N_LAUNCHES
#define MK_N_LAUNCHES 1
#endif
#ifndef PROBE_DUP_MASK
#define PROBE_DUP_MASK 0
#endif
#ifndef P4_REP_M
#define P4_REP_M 1
#endif
#ifndef P4_MODE
#define P4_MODE 0
#endif
#ifndef P4_REP_S
#define P4_REP_S 1
#endif

namespace pg8 {
#define PG8_LAS __attribute__((address_space(3)))
typedef unsigned short bf16_t;
typedef short bf16x8 __attribute__((ext_vector_type(8)));
typedef float f32x4 __attribute__((ext_vector_type(4)));
typedef unsigned u32x4 __attribute__((ext_vector_type(4)));
constexpr int BM = 256, BK = 64, HALF = 128, HTB = HALF * BK * 2, STAGE_BYTES = 8 * HTB, NXCD = 8, WGM = 8;

__host__ __device__ __forceinline__ int lds_byte(int r, int c) { const int st = (r >> 4) * 2 + (c >> 5), rr = r & 15, cc = c & 31, ob = rr * 64 + cc * 2; return st * 1024 + (ob ^ (((ob >> 9) & 1) << 5)); }
__host__ __device__ __forceinline__ void stage_rc(int b, int& R, int& C) { const int st = b / 1024, sb = b % 1024, swz = sb ^ (((sb >> 9) & 1) << 5); R = (st >> 1) * 16 + swz / 64; C = (st & 1) * 32 + (swz % 64) / 2; }
__host__ __device__ __forceinline__ int perm32(int rho) { const int n = rho >> 4, i = rho & 15; return 8 * (i >> 2) + 4 * n + (i & 3); }

struct Unit { int pm, pn, lbase, nvalid; };
struct Gemm { const bf16_t* A; const bf16_t* Bt; int K; const PG8_LAS unsigned short* ridx; int sa, sb; };

__device__ __forceinline__ int xcd_remap(int L, int nwg) { const int q = nwg / NXCD, r = nwg % NXCD, xcd = L % NXCD, off = L / NXCD; return (xcd < r ? xcd * (q + 1) : r * (q + 1) + (xcd - r) * q) + off; }

struct StaticOrder {
    int nM, nN, nwg, G, c;
    __device__ void init(int M, int N, int G_, int c_) { nM = M / BM; nN = N / BM; nwg = nM * nN; G = G_; c = c_; }
    __device__ __forceinline__ bool next(int i, Unit& u) const {
        const long L = (long)i * G + c; if (L >= nwg) return false;
        const int wgid = xcd_remap((int)L, nwg);
        const int nig = WGM * nN, gid = wgid / nig, fm = gid * WGM, gsz = (nM - fm) < WGM ? (nM - fm) : WGM;
        u.pm = fm + ((wgid % nig) % gsz); u.pn = (wgid % nig) / gsz; u.lbase = 0; u.nvalid = 0; return true;
    }
};

__device__ __forceinline__ unsigned cvt_pk_bf16(float lo, float hi) { unsigned r; asm volatile("v_cvt_pk_bf16_f32 %0, %1, %2" : "=v"(r) : "v"(lo), "v"(hi)); return r; }

typedef int v8i __attribute__((ext_vector_type(8)));
typedef short s16x16 __attribute__((ext_vector_type(16)));
template <class Epi, class Sched, bool GATHER, bool FP8 = false>
__device__ __forceinline__ void gemm_phase(PG8_LAS unsigned char* lds, const Gemm g, const Sched& S, const Epi& E) {
    const int tid = threadIdx.x, wid = __builtin_amdgcn_readfirstlane(tid >> 6), lane = tid & 63, wr = wid >> 2, wc = wid & 3, fr = lane & 15, fq = lane >> 4;
    const int K = g.K, nt = K / BK;
    int Rr[2]; unsigned cby[2], voffB[2];
#pragma unroll
    for (int i = 0; i < 2; ++i) { int R, C; stage_rc(tid * 16 + i * 8192, R, C); const int Rb = Epi::PERM ? ((R & ~31) + perm32(R & 31)) : R;
        Rr[i] = R; cby[i] = (unsigned)C * 2u; voffB[i] = (unsigned)(Rb * K + C) * 2u; }
    const size_t kstep = (size_t)(BK * 2);
    const size_t hstep = (size_t)HALF * K * 2;
    const size_t tstep = 2 * hstep;
    const unsigned ldsw = (unsigned)wid * 1024u;
    const int aoff = lds_byte(wr * 64 + fr, FP8 ? fq * 16 : fq * 8), boff = lds_byte(wc * 32 + fr, FP8 ? fq * 16 : fq * 8);

#define PG8_SA(b, h) (((b) * 2 + (h)) * HTB)
#define PG8_SB(b, h) ((4 + (b) * 2 + (h)) * HTB)
#define PG8_STAGE(bufoff, gbase, voff) do { _Pragma("unroll") for (int _i = 0; _i < 2; ++_i) \
        __builtin_amdgcn_global_load_lds((const unsigned*)((const char*)(gbase) + (voff)[_i]), (PG8_LAS unsigned*)(lds + (bufoff) + ldsw + _i * 8192), 16, 0, 0); } while (0)
#define PG8_LDA(dst, b, h) do { if constexpr (FP8) { _Pragma("unroll") for (int m = 0; m < 4; ++m) { const bf16x8 _lo = *(const PG8_LAS bf16x8*)(lds + PG8_SA(b, h) + aoff + m * 2048), _hi = *(const PG8_LAS bf16x8*)(lds + PG8_SA(b, h) + aoff + m * 2048 + 16); dst##8[m] = __builtin_bit_cast(v8i, __builtin_shufflevector(_lo, _hi, 0, 1, 2, 3, 4, 5, 6, 7, 8, 9, 10, 11, 12, 13, 14, 15)); } } \
        else { _Pragma("unroll") for (int m = 0; m < 4; ++m) _Pragma("unroll") for (int k = 0; k < 2; ++k) dst[m][k] = *(const PG8_LAS bf16x8*)(lds + PG8_SA(b, h) + aoff + m * 2048 + k * 1024); } } while (0)
#define PG8_LDB(dst, b, h) do { if constexpr (FP8) { _Pragma("unroll") for (int n = 0; n < 2; ++n) { const bf16x8 _lo = *(const PG8_LAS bf16x8*)(lds + PG8_SB(b, h) + boff + n * 2048), _hi = *(const PG8_LAS bf16x8*)(lds + PG8_SB(b, h) + boff + n * 2048 + 16); dst##8[n] = __builtin_bit_cast(v8i, __builtin_shufflevector(_lo, _hi, 0, 1, 2, 3, 4, 5, 6, 7, 8, 9, 10, 11, 12, 13, 14, 15)); } } \
        else { _Pragma("unroll") for (int n = 0; n < 2; ++n) _Pragma("unroll") for (int k = 0; k < 2; ++k) dst[n][k] = *(const PG8_LAS bf16x8*)(lds + PG8_SB(b, h) + boff + n * 2048 + k * 1024); } } while (0)
#define PG8_MMA(ai, bj, At, Bt) do { __builtin_amdgcn_s_setprio(1); _Pragma("unroll") for (int m = 0; m < 4; ++m) _Pragma("unroll") for (int n = 0; n < 2; ++n) { \
        if constexpr (FP8) asm volatile("v_mfma_scale_f32_16x16x128_f8f6f4 %0, %1, %2, %0, %3, %4 op_sel_hi:[0,0,0]" : "+v"(acc[ai][bj][m][n]) : "v"(Bt##8[n]), "v"(At##8[m]), "v"(vsb), "v"(vsa));   \
        else { _Pragma("unroll") for (int k = 0; k < 2; ++k) acc[ai][bj][m][n] = __builtin_amdgcn_mfma_f32_16x16x32_bf16(Bt[n][k], At[m][k], acc[ai][bj][m][n], 0, 0, 0); } } \
        __builtin_amdgcn_s_setprio(0); } while (0)
#define PG8_WAIT_V(n) asm volatile("s_waitcnt vmcnt(" #n ")" ::: "memory")
#define PG8_WAIT_L(n) asm volatile("s_waitcnt lgkmcnt(" #n ")" ::: "memory")
#define PG8_BAR __builtin_amdgcn_s_barrier()
#define PG8_SCHED __builtin_amdgcn_sched_barrier(0)
#define PG8_AOFF(dst, u, uord) do { _Pragma("unroll") for (int _h = 0; _h < 2; ++_h) _Pragma("unroll") for (int _i = 0; _i < 2; ++_i) { const int _r = _h * HALF + Rr[_i]; \
        if constexpr (GATHER) { const int _idx = g.ridx[(uord) * 256 + _r]; dst[_h][_i] = (unsigned)_idx * (unsigned)(K * 2) + cby[_i]; } \
        else { dst[_h][_i] = (unsigned)(_r * K * 2) + cby[_i]; } } } while (0)
    Unit cur, nxt; int ui = 0;
    if (!S.next(0, cur)) return;
    f32x4 acc[2][2][4][2];
#pragma unroll
    for (int a = 0; a < 2; ++a)
#pragma unroll
        for (int b = 0; b < 2; ++b)
#pragma unroll
            for (int m = 0; m < 4; ++m)
#pragma unroll
                for (int n = 0; n < 2; ++n) acc[a][b][m][n] = (f32x4){0.f, 0.f, 0.f, 0.f};
    const int vsa = g.sa, vsb = g.sb;
    bf16x8 At[4][2], B0[2][2], B1[2][2];
    v8i At8[4], B08[2], B18[2];
    unsigned vc[2][2], vn[2][2];
    PG8_AOFF(vc, cur, 0);
    const char* cA = GATHER ? (const char*)g.A : (const char*)g.A + (size_t)cur.pm * tstep; const char* cB = (const char*)g.Bt + (size_t)cur.pn * tstep;
    PG8_STAGE(PG8_SB(0, 0), cB, voffB); PG8_STAGE(PG8_SB(0, 1), cB + hstep, voffB); PG8_STAGE(PG8_SA(0, 0), cA, vc[0]); PG8_STAGE(PG8_SA(0, 1), cA, vc[1]);
    if (wr == 1) PG8_BAR;
    PG8_WAIT_V(2); PG8_BAR;
    PG8_STAGE(PG8_SB(1, 0), cB + kstep, voffB); PG8_STAGE(PG8_SA(1, 0), cA + kstep, vc[0]); PG8_STAGE(PG8_SB(1, 1), cB + hstep + kstep, voffB);
    PG8_WAIT_V(6); PG8_BAR;
    for (;;) {
        const bool has_next = S.next(ui + 1, nxt);
        const char* nA = (has_next && !GATHER) ? (const char*)g.A + (size_t)nxt.pm * tstep : cA; const char* nB = has_next ? (const char*)g.Bt + (size_t)nxt.pn * tstep : cB;
        if constexpr (GATHER) { if (has_next) { PG8_AOFF(vn, nxt, ui + 1); } else {
#pragma unroll
            for (int h = 0; h < 2; ++h) { vn[h][0] = vc[h][0]; vn[h][1] = vc[h][1]; } } }
#pragma unroll 1
        for (int t = 0; t < nt; t += 2) {
            const bool last = (t == nt - 2);
            const char* a1 = cA + (size_t)(t + 1) * kstep;
            const char* a2 = last ? nA : cA + (size_t)(t + 2) * kstep; const char* b2 = last ? nB : cB + (size_t)(t + 2) * kstep;
            const char* a3 = a2 + kstep; const char* b3 = b2 + kstep;
            unsigned v2[2][2];
#pragma unroll
            for (int h = 0; h < 2; ++h)
#pragma unroll
                for (int i = 0; i < 2; ++i) v2[h][i] = GATHER ? (last ? vn[h][i] : vc[h][i]) : vc[h][i];
            PG8_LDB(B0, 0, 0); PG8_LDB(B1, 0, 1); PG8_SCHED; PG8_LDA(At, 0, 0); PG8_STAGE(PG8_SA(1, 1), a1, vc[1]);
            PG8_WAIT_V(8); PG8_WAIT_L(0); PG8_BAR; PG8_MMA(0, 0, At, B0); PG8_MMA(0, 1, At, B1); PG8_BAR; PG8_SCHED;
            PG8_LDA(At, 0, 1); PG8_STAGE(PG8_SB(0, 0), b2, voffB); PG8_STAGE(PG8_SB(0, 1), b2 + hstep, voffB); PG8_STAGE(PG8_SA(0, 0), a2, v2[0]);
            PG8_WAIT_V(8); PG8_WAIT_L(0); PG8_BAR; PG8_MMA(1, 0, At, B0); PG8_MMA(1, 1, At, B1); PG8_BAR; PG8_SCHED;
            PG8_LDB(B0, 1, 0); PG8_LDB(B1, 1, 1); PG8_SCHED; PG8_LDA(At, 1, 0); PG8_STAGE(PG8_SA(0, 1), a2, v2[1]);
            PG8_WAIT_V(8); PG8_WAIT_L(0); PG8_BAR; PG8_MMA(0, 0, At, B0); PG8_MMA(0, 1, At, B1); PG8_BAR; PG8_SCHED;
            PG8_LDA(At, 1, 1); PG8_STAGE(PG8_SB(1, 0), b3, voffB); PG8_STAGE(PG8_SB(1, 1), b3 + hstep, voffB); PG8_STAGE(PG8_SA(1, 0), a3, v2[0]);
            PG8_WAIT_V(8); PG8_WAIT_L(0); PG8_BAR; PG8_MMA(1, 0, At, B0); PG8_MMA(1, 1, At, B1); PG8_BAR; PG8_SCHED;
        }
        if (wr == 0) PG8_BAR;
        if constexpr (FP8) asm volatile("s_nop 15\n\ts_nop 15" ::: "memory");
        E(acc, cur, wr, wc, fr, fq);
        if (!has_next) break;
#pragma unroll
        for (int a = 0; a < 2; ++a)
#pragma unroll
            for (int b = 0; b < 2; ++b)
#pragma unroll
                for (int m = 0; m < 4; ++m)
#pragma unroll
                    for (int n = 0; n < 2; ++n) acc[a][b][m][n] = (f32x4){0.f, 0.f, 0.f, 0.f};
        cur = nxt; cA = nA; cB = nB; ++ui;
        if constexpr (GATHER) {
#pragma unroll
            for (int h = 0; h < 2; ++h) { vc[h][0] = vn[h][0]; vc[h][1] = vn[h][1]; } }
        if (wr == 1) PG8_BAR;
    }
    PG8_WAIT_V(0);
    PG8_BAR;
#undef PG8_SA
#undef PG8_SB
#undef PG8_STAGE
#undef PG8_LDA
#undef PG8_LDB
#undef PG8_MMA
#undef PG8_WAIT_V
#undef PG8_WAIT_L
#undef PG8_BAR
#undef PG8_SCHED
#undef PG8_AOFF
}
}

constexpr int NWAVES = 8;
constexpr int D = 1024, NB = 8, SEQ = 4096, CTXL = 256;
constexpr int ML = NB * SEQ, MC = NB * CTXL, MT = ML + MC;
constexpr int LDP = 5888;
constexpr int PC_QK = 0, PC_V = 1024, PC_U = 2048, PC_O = 2560, PC_G = 3584, PC_IF = 5632;
constexpr int NEXP = 32, TOPK = 4;
constexpr int MAXTILES = (ML * TOPK + NEXP * 256) / 256;
constexpr float EPS = 1e-6f;
constexpr int NPH = 14;
constexpr int N_LAUNCHES = MK_N_LAUNCHES;

constexpr size_t MiB = 1u << 20;
constexpr size_t WS_CTL = 0, CTL_ZERO_BYTES = 1 * MiB;
constexpr size_t WS_MOD = 1 * MiB;
constexpr size_t WS_TOPE = 2 * MiB, WS_POS = 2 * MiB + 512 * 1024, WS_TOPP = 3 * MiB, WS_LIST = 4 * MiB;
constexpr size_t WS_WIN = 8 * MiB, WS_WGLU = 20 * MiB, WS_WA = 21 * MiB, WS_WB = 23 * MiB, WS_WO = 24 * MiB, WS_WEIN = 26 * MiB, WS_WEOUT = 154 * MiB;
constexpr size_t WS_R0 = 218 * MiB;
constexpr size_t WS_PROJ = WS_R0, WS_H1 = 609 * MiB, WS_QKC = 677 * MiB, WS_HDIR = 745 * MiB, WS_YDIR = 873 * MiB, WS_END = 937 * MiB;
constexpr size_t WS_A1 = WS_H1, WS_A2 = WS_QKC, WS_A3 = WS_QKC + 32 * MiB, WS_YA = WS_HDIR, WS_MERGED = WS_HDIR + 64 * MiB;
constexpr size_t WS_GS = 940 * MiB, WS_X1 = 940 * MiB, WS_END2 = 1004 * MiB;
constexpr size_t WS_H2 = WS_R0, WS_ACT = 282 * MiB, WS_Y = 554 * MiB;
static_assert(WS_PROJ + (size_t)MT * LDP * 2 <= WS_H1 && WS_Y + (size_t)MAXTILES * 256 * 1024 * 2 <= WS_END, "ws map");
constexpr int CW_BAR = 4096, CW_CNT = 16384;

constexpr int RING_BYTES = 131072;
constexpr int LDSCTL_OFF = RING_BYTES, MISC_OFF = LDSCTL_OFF + 320, TAB_OFF = LDSCTL_OFF + 512;
constexpr int LDS_BYTES = 147456;

#define GAS __attribute__((address_space(1)))
#define LAS __attribute__((address_space(3)))
typedef unsigned short bf16;
typedef unsigned v4u __attribute__((ext_vector_type(4)));
typedef unsigned v2u __attribute__((ext_vector_type(2)));
typedef float f32x4 __attribute__((ext_vector_type(4)));
typedef float f32x16 __attribute__((ext_vector_type(16)));
typedef short bf16x8 __attribute__((ext_vector_type(8)));
typedef GAS unsigned gu32;
#define RLX_AGENT __ATOMIC_RELAXED, __HIP_MEMORY_SCOPE_AGENT
#define LDS_WAIT() asm volatile("s_waitcnt lgkmcnt(0)" ::: "memory")
#define LBAR() do { asm volatile("s_waitcnt lgkmcnt(0)" ::: "memory"); __builtin_amdgcn_s_barrier(); asm volatile("" ::: "memory"); } while (0)
__device__ __forceinline__ unsigned f2bf(float f) { unsigned u = __builtin_bit_cast(unsigned, f); return (u + 0x7fffu + ((u >> 16) & 1u)) >> 16; }
typedef __bf16 bf16x2_t __attribute__((ext_vector_type(2)));
__device__ __forceinline__ unsigned cvtpk(float lo, float hi) { const bf16x2_t v = {(__bf16)lo, (__bf16)hi}; return __builtin_bit_cast(unsigned, v); }
__device__ __forceinline__ unsigned pk2(float lo, float hi) { return cvtpk(lo, hi); }
__device__ __forceinline__ float clamp448(float x) { return fminf(fmaxf(x, -448.0f), 448.0f); }
__device__ __forceinline__ unsigned pk4_fp8(float a, float b, float c, float d) {
    unsigned w = 0; w = __builtin_amdgcn_cvt_pk_fp8_f32(clamp448(a), clamp448(b), w, false); w = __builtin_amdgcn_cvt_pk_fp8_f32(clamp448(c), clamp448(d), w, true); return w; }
__device__ __forceinline__ float bf2f(unsigned b) { return __builtin_bit_cast(float, b << 16); }
__device__ __forceinline__ float bflo(unsigned w) { return __builtin_bit_cast(float, w << 16); }
__device__ __forceinline__ float bfhi(unsigned w) { return __builtin_bit_cast(float, w & 0xffff0000u); }
__device__ __forceinline__ float frcp(float x) { return __builtin_amdgcn_rcpf(x); }
__device__ __forceinline__ float sigmoidf_(float x) { return frcp(1.0f + __expf(-x)); }

#define XB_TMO      128
#define XB_XCNT(j)  (256  + 64 * (j))
#define XB_XSUB(j)  (1280 + 64 * (j))
#define XB_XGEN(j)  (2304 + 64 * (j))
#define XB_TOP      3328
#define XB_TOPGEN   3392
#define XCD_BAR_WORDS 3456
#define XB_SPIN_CAP (1u << 22)
__device__ __forceinline__ unsigned xb_ld(unsigned* p)              { return __hip_atomic_load(p, __ATOMIC_RELAXED, __HIP_MEMORY_SCOPE_AGENT); }
__device__ __forceinline__ unsigned xb_add(unsigned* p, unsigned v) { return __hip_atomic_fetch_add(p, v, __ATOMIC_RELAXED, __HIP_MEMORY_SCOPE_AGENT); }
__device__ __forceinline__ unsigned xb_xcc_id() { return (unsigned)__builtin_amdgcn_s_getreg((3 << 11) | 20) & 0xFu; }
#define XB_SPIN(cond, bar) do { unsigned _sp = 0; while (cond) { __builtin_amdgcn_s_sleep(1); \
    if ((++_sp & 255u) == 0u) { if (xb_ld(&(bar)[XB_TMO])) break; if (_sp > XB_SPIN_CAP) { atomicAdd(&(bar)[XB_TMO], 1u); break; } } } } while (0)
struct XcdBarrier { unsigned* bar; unsigned x; volatile LAS unsigned* st; };
__device__ __forceinline__ XcdBarrier xcd_barrier_post(unsigned* bar, volatile LAS unsigned* st) {
    XcdBarrier b; b.bar = bar; b.x = xb_xcc_id(); b.st = st;
    if (threadIdx.x == 0) (void)xb_add(&bar[XB_XCNT(b.x)], 1u);
    return b;
}
__device__ __forceinline__ void xcd_barrier_complete(unsigned* bar, unsigned x, unsigned& nloc, unsigned& nx) {
    const unsigned G = gridDim.x * gridDim.y * gridDim.z;
    unsigned sum, cnt, mine, sp = 0u;
    for (;;) {
        sum = 0u; cnt = 0u; mine = 0u;
#pragma unroll
        for (unsigned j = 0; j < 16; ++j) { const unsigned c = xb_ld(&bar[XB_XCNT(j)]); sum += c; cnt += (c > 0u) ? 1u : 0u; mine = (j == x) ? c : mine; }
        if (sum == G) break;
        __builtin_amdgcn_s_sleep(1);
        if ((++sp & 255u) == 0u) { if (xb_ld(&bar[XB_TMO])) break; if (sp > XB_SPIN_CAP) { atomicAdd(&bar[XB_TMO], 1u); break; } }
    }
    nloc = mine > 0u ? mine : 1u; nx = cnt > 0u ? cnt : 1u;
}
__device__ __forceinline__ void xcd_barrier(const XcdBarrier& b) {
    asm volatile("s_waitcnt vmcnt(0)" ::: "memory");
    __syncthreads();
    if (threadIdx.x == 0) {
        unsigned* bar = b.bar;
        __builtin_amdgcn_s_waitcnt(0);
        unsigned nloc = b.st[0], nx = b.st[1];
        if (nloc == 0u) { xcd_barrier_complete(bar, b.x, nloc, nx); b.st[0] = nloc; b.st[1] = nx; }
        const unsigned old = xb_add(&bar[XB_XSUB(b.x)], 1u);
        const unsigned gen = old / nloc;
        if (old + 1u == (gen + 1u) * nloc) {
            __builtin_amdgcn_fence(__ATOMIC_RELEASE, "agent");
            asm volatile("s_waitcnt vmcnt(0)" ::: "memory");
            const unsigned og = xb_add(&bar[XB_TOP], 1u);
            const unsigned tg = og / nx;
            if (og + 1u == (tg + 1u) * nx) xb_add(&bar[XB_TOPGEN], 1u);
            else XB_SPIN(xb_ld(&bar[XB_TOPGEN]) == tg, bar);
            __builtin_amdgcn_fence(__ATOMIC_ACQUIRE, "agent");
            xb_add(&bar[XB_XGEN(b.x)], 1u);
            asm volatile("s_waitcnt vmcnt(0)" ::: "memory");
        } else {
            XB_SPIN(xb_ld(&bar[XB_XGEN(b.x)]) == gen, bar);
            __builtin_amdgcn_fence(__ATOMIC_ACQUIRE, "agent");
            asm volatile("s_waitcnt vmcnt(0)" ::: "memory");
        }
    }
    __syncthreads();
}

struct Frame {
    LAS unsigned char* lds;
    gu32* ctl;
    int tid, lane, wave, vcu, G;
    float* out; unsigned char* ws;
};
__device__ __forceinline__ float wave_sum(float v) {
#pragma unroll
    for (int o = 1; o < 64; o <<= 1) v += __shfl_xor(v, o);
    return v;
}

struct InProjOrder {
    int G, c;
    __device__ __forceinline__ bool next(int i, pg8::Unit& u) const {
        const int NL = 128 * 23, NC = 8 * 11;
        const long L = (long)i * G + c; if (L >= NL + NC) return false;
        u.lbase = 0; u.nvalid = 0;
        if (L < NL) { const int wgid = pg8::xcd_remap((int)L, NL); const int nig = 8 * 23, gid = wgid / nig, fm = gid * 8; u.pm = fm + ((wgid % nig) % 8); u.pn = (wgid % nig) / 8; }
        else { const int r = (int)L - NL; u.pm = 128 + r / 11; const int q = r % 11; u.pn = q < 10 ? q : 22; }
        return true;
    }
};
struct MoeOrder {
    int G, c, npn; const LAS int* tab;
    __device__ __forceinline__ bool next(int i, pg8::Unit& u) const {
        const int nT = __builtin_amdgcn_readfirstlane(tab[32]); const int nU = nT * npn;
        const long L = (long)i * G + c; if (L >= nU) return false;
        const int wgid = pg8::xcd_remap((int)L, nU);
        const int tau = wgid / npn, pl = wgid % npn;
        int e = 0;
        for (int k = 1; k < 32; ++k) e += (__builtin_amdgcn_readfirstlane(tab[k]) <= tau) ? 1 : 0;
        const int il = tau - __builtin_amdgcn_readfirstlane(tab[e]);
        u.pm = tau; u.pn = e * npn + pl; u.lbase = e * ML + 256 * il; u.nvalid = __builtin_amdgcn_readfirstlane(tab[33 + e]) - 256 * il;
        return true;
    }
};
__device__ __forceinline__ void moe_tables(Frame& F) {
    LAS int* tab = (LAS int*)(F.lds + TAB_OFF);
    __syncthreads();
    if (F.tid < 32) tab[33 + F.tid] = (int)__hip_atomic_load(F.ctl + CW_CNT + 64 * F.tid, RLX_AGENT);
    __syncthreads();
    if (F.tid == 0) {
        int acc = 0;
        for (int e = 0; e < 32; ++e) { tab[e] = acc; acc += (tab[33 + e] + 255) >> 8; }
        tab[32] = acc;
    }
    __syncthreads();
}

using pg8::f32x4; using pg8::u32x4; using pg8::cvt_pk_bf16;
#define EPI_ROWS(u) const int row0 = (u).pm * 256 + wr * 64 + fr
#define EPI_LOOP _Pragma("unroll") for (int ai = 0; ai < 2; ++ai) _Pragma("unroll") for (int m = 0; m < 4; ++m)
__device__ __forceinline__ u32x4 pack8(const f32x4 a, const f32x4 b) { u32x4 w; w.x = cvt_pk_bf16(a[0], a[1]); w.y = cvt_pk_bf16(a[2], a[3]); w.z = cvt_pk_bf16(b[0], b[1]); w.w = cvt_pk_bf16(b[2], b[3]); return w; }
__device__ __forceinline__ void unpack8(const u32x4 w, f32x4& a, f32x4& b) { a = (f32x4){bflo(w.x), bfhi(w.x), bflo(w.y), bfhi(w.y)}; b = (f32x4){bflo(w.z), bfhi(w.z), bflo(w.w), bfhi(w.w)}; }
__device__ __forceinline__ void unpack8_fp8(const v2u w, f32x4& a, f32x4& b) {
    const auto l0 = __builtin_amdgcn_cvt_pk_f32_fp8((int)w.x, false), h0 = __builtin_amdgcn_cvt_pk_f32_fp8((int)w.x, true), l1 = __builtin_amdgcn_cvt_pk_f32_fp8((int)w.y, false), h1 = __builtin_amdgcn_cvt_pk_f32_fp8((int)w.y, true);
    a = (f32x4){l0[0], l0[1], h0[0], h0[1]}; b = (f32x4){l1[0], l1[1], h1[0], h1[1]}; }
__device__ __forceinline__ v2u pack8_fp8(const f32x4 a, const f32x4 b) { return (v2u){pk4_fp8(a[0], a[1], a[2], a[3]), pk4_fp8(b[0], b[1], b[2], b[3])}; }
__device__ __forceinline__ f32x4 sig4(f32x4 x) { return (f32x4){sigmoidf_(x[0]), sigmoidf_(x[1]), sigmoidf_(x[2]), sigmoidf_(x[3])}; }

struct EpiStore {
    static constexpr bool PERM = true; bf16* O; int ldc;
    __device__ __forceinline__ void operator()(const f32x4 (&acc)[2][2][4][2], const pg8::Unit& u, int wr, int wc, int fr, int fq) const {
        EPI_ROWS(u); const int col0 = u.pn * 256 + wc * 32 + 8 * fq;
        if (u.pn == 22 && wc != 0) return;
        EPI_LOOP { bf16* rowp = O + (size_t)(row0 + ai * 128 + m * 16) * ldc + col0;
#pragma unroll
            for (int bj = 0; bj < 2; ++bj) if (u.pn != 22 || bj == 0) *(u32x4*)(rowp + bj * 128) = pack8(acc[ai][bj][m][0], acc[ai][bj][m][1]); }
    }
};
struct EpiGlu {
    static constexpr bool PERM = true; const bf16* A2; bf16* A3; const float* bias;
    __device__ __forceinline__ void operator()(const f32x4 (&acc)[2][2][4][2], const pg8::Unit& u, int wr, int wc, int fr, int fq) const {
        EPI_ROWS(u); const int col0 = u.pn * 256 + wc * 32 + 8 * fq;
        f32x4 bv[2][2];
#pragma unroll
        for (int bj = 0; bj < 2; ++bj)
#pragma unroll
            for (int n = 0; n < 2; ++n) bv[bj][n] = *(const f32x4*)(bias + col0 + bj * 128 + 4 * n);
#pragma unroll
        for (int ai = 0; ai < 2; ++ai) {
            v2u ld[4][2];
#pragma unroll
            for (int m = 0; m < 4; ++m)
#pragma unroll
                for (int bj = 0; bj < 2; ++bj) ld[m][bj] = *(const v2u*)((const unsigned char*)A2 + (size_t)(row0 + ai * 128 + m * 16) * 512 + col0 + bj * 128);
            __builtin_amdgcn_sched_barrier(0);
#pragma unroll
            for (int m = 0; m < 4; ++m)
#pragma unroll
                for (int bj = 0; bj < 2; ++bj) { f32x4 a0, a1; unpack8_fp8(ld[m][bj], a0, a1);
                    const f32x4 v0 = a0 * sig4(acc[ai][bj][m][0] + bv[bj][0]), v1 = a1 * sig4(acc[ai][bj][m][1] + bv[bj][1]);
                    *(v2u*)((unsigned char*)A3 + (size_t)(row0 + ai * 128 + m * 16) * 512 + col0 + bj * 128) = pack8_fp8(v0, v1); }
        }
    }
};
template <bool ADD> struct EpiGate {
    static constexpr bool PERM = true; const bf16* proj; int gc0; const float* bg; const bf16* Prev; bf16* O;
    __device__ __forceinline__ void operator()(const f32x4 (&acc)[2][2][4][2], const pg8::Unit& u, int wr, int wc, int fr, int fq) const {
        EPI_ROWS(u); const int col0 = u.pn * 256 + wc * 32 + 8 * fq;
        f32x4 bv[2][2];
#pragma unroll
        for (int bj = 0; bj < 2; ++bj)
#pragma unroll
            for (int n = 0; n < 2; ++n) bv[bj][n] = *(const f32x4*)(bg + col0 + bj * 128 + 4 * n);
        constexpr int MB = ADD ? 2 : 4;
#pragma unroll
        for (int g = 0; g < 8 / MB; ++g) {
            u32x4 lg[MB][2], lp[MB][2];
#pragma unroll
            for (int mm = 0; mm < MB; ++mm)
#pragma unroll
                for (int bj = 0; bj < 2; ++bj) { const int q = g * MB + mm, row = row0 + (q >> 2) * 128 + (q & 3) * 16; lg[mm][bj] = *(const u32x4*)(proj + (size_t)row * LDP + gc0 + col0 + bj * 128);
                    if (ADD) lp[mm][bj] = *(const u32x4*)(Prev + (size_t)row * 1024 + col0 + bj * 128); }
            __builtin_amdgcn_sched_barrier(0);
#pragma unroll
            for (int mm = 0; mm < MB; ++mm)
#pragma unroll
                for (int bj = 0; bj < 2; ++bj) { const int q = g * MB + mm, ai = q >> 2, m = q & 3; f32x4 g0, g1; unpack8(lg[mm][bj], g0, g1);
                    f32x4 v0 = sig4(g0 + bv[bj][0]) * acc[ai][bj][m][0], v1 = sig4(g1 + bv[bj][1]) * acc[ai][bj][m][1];
                    if (ADD) { f32x4 p0, p1; unpack8(lp[mm][bj], p0, p1); v0 += p0; v1 += p1; }
                    if (ADD) *(v2u*)((unsigned char*)O + (size_t)(row0 + ai * 128 + m * 16) * 1024 + col0 + bj * 128) = pack8_fp8(v0 * 4.0f, v1 * 4.0f);
                    else *(u32x4*)(O + (size_t)(row0 + ai * 128 + m * 16) * 1024 + col0 + bj * 128) = pack8(v0, v1); }
            __builtin_amdgcn_sched_barrier(0);
        }
    }
};
struct EpiX1 {
    static constexpr bool PERM = true; const float* x; const float* mod; bf16* X1;
    __device__ __forceinline__ void operator()(const f32x4 (&acc)[2][2][4][2], const pg8::Unit& u, int wr, int wc, int fr, int fq) const {
        EPI_ROWS(u); const int col0 = u.pn * 256 + wc * 32 + 8 * fq; const int b = (u.pm * 256) / SEQ;
        f32x4 gv[2][2];
#pragma unroll
        for (int bj = 0; bj < 2; ++bj)
#pragma unroll
            for (int n = 0; n < 2; ++n) gv[bj][n] = *(const f32x4*)(mod + b * 6144 + 2 * D + col0 + bj * 128 + 4 * n);
#pragma unroll
        for (int g = 0; g < 4; ++g) {
            f32x4 lx[2][2][2];
#pragma unroll
            for (int mm = 0; mm < 2; ++mm)
#pragma unroll
                for (int bj = 0; bj < 2; ++bj) { const int q = g * 2 + mm; const size_t off = (size_t)(row0 + (q >> 2) * 128 + (q & 3) * 16) * D + col0 + bj * 128; lx[mm][bj][0] = *(const f32x4*)(x + off); lx[mm][bj][1] = *(const f32x4*)(x + off + 4); }
            __builtin_amdgcn_sched_barrier(0);
#pragma unroll
            for (int mm = 0; mm < 2; ++mm)
#pragma unroll
                for (int bj = 0; bj < 2; ++bj) { const int q = g * 2 + mm, ai = q >> 2, m = q & 3; const size_t off = (size_t)(row0 + ai * 128 + m * 16) * D + col0 + bj * 128;
                    *(u32x4*)(X1 + off) = pack8(lx[mm][bj][0] + gv[bj][0] * acc[ai][bj][m][0], lx[mm][bj][1] + gv[bj][1] * acc[ai][bj][m][1]); }
            __builtin_amdgcn_sched_barrier(0);
        }
    }
};
struct EpiSwiglu {
    static constexpr bool PERM = true; const float* bin; bf16* ACT;
    __device__ __forceinline__ void operator()(const f32x4 (&acc)[2][2][4][2], const pg8::Unit& u, int wr, int wc, int fr, int fq) const {
        EPI_ROWS(u); const int e = u.pn >> 3, pl = u.pn & 7; const int f0 = pl * 128 + wc * 32 + 8 * fq;
        f32x4 bg[2], bl[2];
#pragma unroll
        for (int n = 0; n < 2; ++n) { bg[n] = *(const f32x4*)(bin + e * 2048 + f0 + 4 * n); bl[n] = *(const f32x4*)(bin + e * 2048 + 1024 + f0 + 4 * n); }
        EPI_LOOP { f32x4 o[2];
#pragma unroll
            for (int n = 0; n < 2; ++n) { const f32x4 zg = acc[ai][0][m][n] + bg[n], zl = acc[ai][1][m][n] + bl[n];
#pragma unroll
                for (int j = 0; j < 4; ++j) { const float gl = fminf(zg[j], 7.0f); const float li = fminf(fmaxf(zl[j], -7.0f), 7.0f); o[n][j] = gl * sigmoidf_(1.702f * gl) * (li + 1.0f); } }
            *(v2u*)((unsigned char*)ACT + (size_t)(row0 + ai * 128 + m * 16) * 1024 + f0) = (v2u){pk4_fp8(8.f * o[0][0], 8.f * o[0][1], 8.f * o[0][2], 8.f * o[0][3]), pk4_fp8(8.f * o[1][0], 8.f * o[1][1], 8.f * o[1][2], 8.f * o[1][3])}; }
    }
};
struct EpiY {
    static constexpr bool PERM = true; const float* bout; bf16* Y;
    __device__ __forceinline__ void operator()(const f32x4 (&acc)[2][2][4][2], const pg8::Unit& u, int wr, int wc, int fr, int fq) const {
        EPI_ROWS(u); const int e = u.pn >> 2, pl = u.pn & 3; const int col0 = pl * 256 + wc * 32 + 8 * fq;
        f32x4 bv[2][2];
#pragma unroll
        for (int bj = 0; bj < 2; ++bj)
#pragma unroll
            for (int n = 0; n < 2; ++n) bv[bj][n] = *(const f32x4*)(bout + e * 1024 + col0 + bj * 128 + 4 * n);
        EPI_LOOP { unsigned char* rowp = (unsigned char*)Y + (size_t)(row0 + ai * 128 + m * 16) * 1024 + col0;
#pragma unroll
            for (int bj = 0; bj < 2; ++bj) { const f32x4 v0 = (acc[ai][bj][m][0] + bv[bj][0]) * 16.0f, v1 = (acc[ai][bj][m][1] + bv[bj][1]) * 16.0f;
                *(v2u*)(rowp + bj * 128) = (v2u){pk4_fp8(v0[0], v0[1], v0[2], v0[3]), pk4_fp8(v1[0], v1[1], v1[2], v1[3])}; } }
    }
};

struct TItem { const float* src; bf16* dst; int ld, ldk; int f8; };
__device__ __forceinline__ void titem_load(const TItem& t, int lane, f32x4 (&r)[8]) {
#pragma unroll
    for (int i = 0; i < 8; ++i) r[i] = *(const f32x4*)(t.src + (size_t)(8 * i + (lane >> 3)) * t.ld + 4 * (lane & 7));
}
__device__ __forceinline__ void titem_store(const TItem& t, int lane, const f32x4 (&r)[8], LAS float* scr) {
#pragma unroll
    for (int i = 0; i < 8; ++i) { LAS float* p = scr + (8 * i + (lane >> 3)) * 33 + 4 * (lane & 7); p[0] = r[i][0]; p[1] = r[i][1]; p[2] = r[i][2]; p[3] = r[i][3]; }
    LDS_WAIT(); asm volatile("" ::: "memory");
    const int c = lane & 7;
#pragma unroll
    for (int j = 0; j < 4; ++j) { const int n = (lane >> 3) + 8 * j; const LAS float* s = scr + (8 * c) * 33 + n;
        if (t.f8) { *(GAS v2u*)((unsigned char*)t.dst + (size_t)n * t.ldk + 8 * c) = (v2u){pk4_fp8(32.f * s[0 * 33], 32.f * s[1 * 33], 32.f * s[2 * 33], 32.f * s[3 * 33]), pk4_fp8(32.f * s[4 * 33], 32.f * s[5 * 33], 32.f * s[6 * 33], 32.f * s[7 * 33])}; }
        else { v4u o; o.x = pk2(s[0 * 33], s[1 * 33]); o.y = pk2(s[2 * 33], s[3 * 33]); o.z = pk2(s[4 * 33], s[5 * 33]); o.w = pk2(s[6 * 33], s[7 * 33]);
            *(GAS v4u*)(t.dst + (size_t)n * t.ldk + 8 * c) = o; } }
    LDS_WAIT(); asm volatile("" ::: "memory");
}
__device__ __forceinline__ void p0_prologue(Frame& F, const float* const* __restrict__ INP) {
    {
        LAS float* sc = (LAS float*)(F.lds);
        LAS float* red = (LAS float*)(F.lds + 9 * 1024 * 4);
        for (int i = F.tid; i < 9 * 1024; i += NWAVES * 64) { const int r = i >> 10, k = i & 1023; const float v = r < 8 ? INP[1][r * 1024 + k] : INP[3][k]; sc[i] = v / (1.0f + expf(-v)); }
        __syncthreads();
        const float* wada = INP[4]; const float* bada = INP[5];
        float* mod = (float*)(F.ws + WS_MOD);
        for (int cg = blockIdx.x; cg < 256; cg += F.G) {
            const int j0 = cg * 24, col = F.lane & 31, kp = F.lane >> 5;
            float a[9];
#pragma unroll
            for (int r = 0; r < 9; ++r) a[r] = 0.f;
            if (col < 24) {
#pragma unroll 16
                for (int i = 0; i < 64; ++i) { const int k = F.wave * 128 + 2 * i + kp; const float wv = wada[(size_t)k * 6144 + j0 + col];
#pragma unroll
                    for (int r = 0; r < 9; ++r) a[r] += sc[r * 1024 + k] * wv; }
            }
#pragma unroll
            for (int r = 0; r < 9; ++r) red[((F.wave * 2 + kp) * 9 + r) * 32 + col] = a[r];
            __syncthreads();
            if (F.tid < 9 * 32) { const int r = F.tid >> 5, cc = F.tid & 31;
                if (cc < 24) { float s = 0.f; for (int p = 0; p < 16; ++p) s += red[(p * 9 + r) * 32 + cc]; const int j = j0 + cc; s += bada[j];
                    if (r < 8) mod[r * 6144 + j] = s; else if (j < 2048) mod[8 * 6144 + j] = s; } }
            __syncthreads();
        }
    }
    LAS float* scr = (LAS float*)(F.lds + F.wave * 16384);
    const int gw = F.vcu * NWAVES + F.wave, NGW = F.G * NWAVES;
    bf16* WIN = (bf16*)(F.ws + WS_WIN); bf16* WGLU = (bf16*)(F.ws + WS_WGLU); bf16* WA = (bf16*)(F.ws + WS_WA); bf16* WB = (bf16*)(F.ws + WS_WB); bf16* WO = (bf16*)(F.ws + WS_WO);
    bf16* WEIN = (bf16*)(F.ws + WS_WEIN); bf16* WEOUT = (bf16*)(F.ws + WS_WEOUT);
    constexpr int I_IN = 177 * 16, I_GLU = 16 * 8, I_A = 32 * 16, I_B = 32 * 8, I_O = 32 * 16, I_EIN = 32 * 64 * 16, I_EOUT = 32 * 32 * 16;
    constexpr int NITEMS = I_IN + I_GLU + I_A + I_B + I_O + I_EIN + I_EOUT;
#define P0_DECODE(it_, T) do { int r = (it_); \
        if (r < I_IN) { const int kb = r / 177, nb = r % 177, n0 = nb * 32; const int sc0 = n0 < 2048 ? n0 : (n0 < 5632 ? n0 + 32 : 2048); \
            T.src = INP[8] + (size_t)kb * 64 * 5664 + sc0; T.ld = 5664; T.dst = (bf16*)((unsigned char*)WIN + (size_t)n0 * 1024 + kb * 64); T.ldk = 1024; T.f8 = 1; break; } r -= I_IN; \
        if (r < I_GLU) { const int kb = r / 16, nb = r % 16; T.src = INP[21] + (size_t)kb * 64 * 512 + nb * 32; T.ld = 512; T.dst = (bf16*)((unsigned char*)WGLU + (size_t)nb * 32 * 512 + kb * 64); T.ldk = 512; T.f8 = 1; break; } r -= I_GLU; \
        if (r < I_A) { const int kb = r / 32, nb = r % 32; T.src = INP[12] + (size_t)kb * 64 * 1024 + nb * 32; T.ld = 1024; T.dst = (bf16*)((unsigned char*)WA + (size_t)nb * 32 * 1024 + kb * 64); T.ldk = 1024; T.f8 = 1; break; } r -= I_A; \
        if (r < I_B) { const int kb = r / 32, nb = r % 32; T.src = INP[23] + (size_t)kb * 64 * 1024 + nb * 32; T.ld = 1024; T.dst = (bf16*)((unsigned char*)WB + (size_t)nb * 32 * 512 + kb * 64); T.ldk = 512; T.f8 = 1; break; } r -= I_B; \
        if (r < I_O) { const int kb = r / 32, nb = r % 32; T.src = INP[25] + (size_t)kb * 64 * 1024 + nb * 32; T.ld = 1024; T.dst = (bf16*)((unsigned char*)WO + (size_t)nb * 32 * 1024 + kb * 64); T.ldk = 1024; T.f8 = 1; break; } r -= I_O; \
        if (r < I_EIN) { const int e = r / 1024, q = r % 1024, kb = q / 64, nb = q % 64; const int dr = nb * 32, pn = dr >> 8, bj = (dr >> 7) & 1, xx = dr & 127; \
            T.src = INP[28] + (size_t)e * 1024 * 2048 + (size_t)kb * 64 * 2048 + bj * 1024 + pn * 128 + xx; T.ld = 2048; T.dst = (bf16*)((unsigned char*)WEIN + (size_t)e * 2048 * 1024 + (size_t)dr * 1024 + kb * 64); T.ldk = 1024; T.f8 = 1; break; } r -= I_EIN; \
        { const int e = r / 512, q = r % 512, kb = q / 32, nb = q % 32; \
            T.src = INP[30] + (size_t)e * 1024 * 1024 + (size_t)kb * 64 * 1024 + nb * 32; T.ld = 1024; T.dst = (bf16*)((unsigned char*)WEOUT + (size_t)e * 1024 * 1024 + (size_t)nb * 32 * 1024 + kb * 64); T.ldk = 1024; T.f8 = 1; } } while (0)
    {
        TItem ta, tb; f32x4 ra[8], rb[8];
        int it = gw;
        if (it < NITEMS) { P0_DECODE(it, ta); titem_load(ta, F.lane, ra); }
        while (it < NITEMS) {
            const int nx = it + NGW;
            if (nx < NITEMS) { P0_DECODE(nx, tb); titem_load(tb, F.lane, rb); }
            titem_store(ta, F.lane, ra, scr);
            ta = tb;
#pragma unroll
            for (int i = 0; i < 8; ++i) ra[i] = rb[i];
            it = nx;
        }
    }
#undef P0_DECODE
    { const int gt = blockIdx.x * (NWAVES * 64) + F.tid, NT = F.G * NWAVES * 64; GAS v4u* z = (GAS v4u*)((unsigned char*)WIN + (size_t)5664 * 1024);
        for (int i = gt; i < 224 * 1024 / 16; i += NT) z[i] = (v4u){0u, 0u, 0u, 0u}; }
}

__device__ __forceinline__ void p1_norm1(Frame& F, const float* const* __restrict__ INP) {
    const int gw = F.vcu * NWAVES + F.wave, NGW = F.G * NWAVES;
    const float* mod = (const float*)(F.ws + WS_MOD); bf16* H1 = (bf16*)(F.ws + WS_H1);
    for (int m = gw; m < MT; m += NGW) {
        const float* xr; const float* sh; const float* scl;
        if (m < ML) { const int b = m / SEQ; xr = INP[0] + (size_t)m * D; sh = mod + b * 6144; scl = sh + D; }
        else { xr = INP[2] + (size_t)(m - ML) * D; sh = mod + 8 * 6144; scl = sh + D; }
        f32x4 v[4]; float s = 0.f;
#pragma unroll
        for (int j = 0; j < 4; ++j) { v[j] = *(const f32x4*)(xr + 256 * j + 4 * F.lane); s += (v[j][0] * v[j][0] + v[j][1] * v[j][1]) + (v[j][2] * v[j][2] + v[j][3] * v[j][3]); }
        const float rstd = 1.0f / sqrtf(wave_sum(s) * (1.0f / D) + EPS);
#pragma unroll
        for (int j = 0; j < 4; ++j) { const int c = 256 * j + 4 * F.lane; const f32x4 g = *(const f32x4*)(INP[6] + c), a = *(const f32x4*)(scl + c), bb = *(const f32x4*)(sh + c);
            const f32x4 y = v[j] * rstd * g * (a + 1.0f) + bb;
            *(unsigned*)((unsigned char*)H1 + (size_t)m * D + c) = pk4_fp8(y[0], y[1], y[2], y[3]); }
    }
}

__device__ __forceinline__ void conv_fma8(float (&a)[8], const v4u x, const float* wp) {
    const f32x4 w0 = *(const f32x4*)(wp), w1 = *(const f32x4*)(wp + 4);
    a[0] += bflo(x.x) * w0[0]; a[1] += bfhi(x.x) * w0[1]; a[2] += bflo(x.y) * w0[2]; a[3] += bfhi(x.y) * w0[3];
    a[4] += bflo(x.z) * w1[0]; a[5] += bfhi(x.z) * w1[1]; a[6] += bflo(x.w) * w1[2]; a[7] += bfhi(x.w) * w1[3];
}
__device__ __forceinline__ void p3_conv(Frame& F, const float* const* __restrict__ INP) {
    const bf16* PROJ = (const bf16*)(F.ws + WS_PROJ); bf16* QKC = (bf16*)(F.ws + WS_QKC); const float* wc = INP[9];
    const int NT = F.G * NWAVES * 64;
    for (int it = F.vcu * (NWAVES * 64) + F.tid; it < NB * 64 * 16 * 128; it += NT) {
        const int ch0 = (it & 127) * 8, seg = (it >> 7) & 15, gr = (it >> 11) & 63, b = it >> 17, c0 = seg * 4;
        const bf16* base = PROJ + (size_t)(b * SEQ) * LDP + ch0;
        const float scale = ch0 < 512 ? 0.125f : 1.0f;
        v4u win[6][3];
        const v4u z = (v4u){0u, 0u, 0u, 0u};
#pragma unroll
        for (int cc = 0; cc < 6; ++cc)
#pragma unroll
            for (int ky = 0; ky < 3; ++ky) { const int rr = gr + ky - 1, c = c0 + cc - 1;
                win[cc][ky] = (rr >= 0 && rr < 64 && c >= 0 && c < 64) ? *(const v4u*)(base + (size_t)(rr * 64 + c) * LDP) : z; }
        __builtin_amdgcn_sched_barrier(0);
        float a[4][8];
#pragma unroll
        for (int cc = 0; cc < 4; ++cc)
#pragma unroll
            for (int j = 0; j < 8; ++j) a[cc][j] = 0.f;
#pragma unroll
        for (int ky = 0; ky < 3; ++ky)
#pragma unroll
            for (int kx = 0; kx < 3; ++kx) {
                const f32x4 w0 = *(const f32x4*)(wc + (ky * 3 + kx) * 1024 + ch0), w1 = *(const f32x4*)(wc + (ky * 3 + kx) * 1024 + ch0 + 4);
#pragma unroll
                for (int cc = 0; cc < 4; ++cc) { const v4u x = win[cc + kx][ky];
                    a[cc][0] += bflo(x.x) * w0[0]; a[cc][1] += bfhi(x.x) * w0[1]; a[cc][2] += bflo(x.y) * w0[2]; a[cc][3] += bfhi(x.y) * w0[3];
                    a[cc][4] += bflo(x.z) * w1[0]; a[cc][5] += bfhi(x.z) * w1[1]; a[cc][6] += bflo(x.w) * w1[2]; a[cc][7] += bfhi(x.w) * w1[3]; }
                asm volatile("" ::: "memory");
            }
#pragma unroll
        for (int cc = 0; cc < 4; ++cc) {
#pragma unroll
            for (int j = 0; j < 8; ++j) a[cc][j] = a[cc][j] * frcp(1.0f + __expf(-a[cc][j])) * scale;
            *(v4u*)(QKC + (size_t)(b * SEQ + gr * 64 + c0 + cc) * 1024 + ch0) = (v4u){pk2(a[cc][0], a[cc][1]), pk2(a[cc][2], a[cc][3]), pk2(a[cc][4], a[cc][5]), pk2(a[cc][6], a[cc][7])};
        }
    }
    for (int w = F.vcu * (NWAVES * 64) + F.tid; w < MC * 128; w += NT) {
        const int row = ML + (w >> 7), ch0 = (w & 127) * 8, t = (w >> 7) % CTXL;
        float a[8];
#pragma unroll
        for (int j = 0; j < 8; ++j) a[j] = 0.f;
#pragma unroll
        for (int kx = 0; kx < 3; ++kx) { const int tt = t + kx - 1;
            if (tt >= 0 && tt < CTXL) conv_fma8(a, *(const v4u*)(PROJ + (size_t)(row + kx - 1) * LDP + ch0), wc + (3 + kx) * 1024 + ch0); }
        const float scale = ch0 < 512 ? 0.125f : 1.0f;
#pragma unroll
        for (int j = 0; j < 8; ++j) a[j] = a[j] * frcp(1.0f + __expf(-a[j])) * scale;
        *(v4u*)(QKC + (size_t)row * 1024 + ch0) = (v4u){pk2(a[0], a[1]), pk2(a[2], a[3]), pk2(a[4], a[5]), pk2(a[6], a[7])};
    }
    {
        float* GB = (float*)(F.ws + WS_GS); float* GG = GB + 128 * 4352; float* GP = GG + 128 * 4352;
        const int gw = F.vcu * NWAVES + F.wave, NGW = F.G * NWAVES, lane = F.lane;
        for (int it = gw; it < 128 * 34; it += NGW) {
            const int jc = it % 34, dbh = it / 34, h = dbh & 7, b = (dbh >> 3) & 7, d = dbh >> 6;
            const bool lat = jc >= 2; const int p0 = lat ? 128 * (jc - 2) : 128 * jc, Lseq = lat ? SEQ : CTXL, rowbase = lat ? b * SEQ : ML + b * CTXL;
            const float bi_ = INP[10][d * 16 + h], bf_ = INP[10][d * 16 + 8 + h];
            float li2[2], lf2[2];
#pragma unroll
            for (int e = 0; e < 2; ++e) { const int sp = 2 * lane + e; const int tt = d ? (Lseq - 1 - (p0 + sp)) : (p0 + sp); const size_t row = (size_t)(rowbase + tt);
                li2[e] = bf2f(PROJ[row * LDP + PC_IF + d * 16 + h]) + bi_; const float xf = bf2f(PROJ[row * LDP + PC_IF + d * 16 + 8 + h]) + bf_;
                lf2[e] = fminf(xf, 0.f) - log1pf(expf(-fabsf(xf))); }
            const float c1 = lf2[0] + lf2[1]; float inc = c1;
#pragma unroll
            for (int o = 1; o < 64; o <<= 1) { const float t = __shfl_up(inc, o); if (lane >= o) inc += t; }
            const float exc = inc - c1, b0 = exc + lf2[0], b1 = exc + c1, g0 = li2[0] - b0, g1 = li2[1] - b1;
            float pmx = fmaxf(g0, g1);
#pragma unroll
            for (int o = 1; o < 64; o <<= 1) { const float t = __shfl_up(pmx, o); if (lane >= o) pmx = fmaxf(pmx, t); }
            float pex = __shfl_up(pmx, 1); if (lane == 0) pex = -INFINITY;
            const size_t o = (size_t)dbh * 4352 + 128 * jc + 2 * lane;
            *(float2*)(GB + o) = make_float2(b0, b1); *(float2*)(GG + o) = make_float2(g0, g1); *(float2*)(GP + o) = make_float2(fmaxf(pex, g0), pmx);
        }
    }
}

__device__ __forceinline__ void mma32_nt(f32x16& acc, const LAS bf16* A, int lda, const LAS bf16* Bt, int ldb, int K, int lane) {
    const int r = lane & 31, h = lane >> 5;
#pragma unroll
    for (int k0 = 0; k0 < K; k0 += 16) {
        const bf16x8 a = *(const LAS bf16x8*)(A + r * lda + k0 + 8 * h);
        const bf16x8 b = *(const LAS bf16x8*)(Bt + r * ldb + k0 + 8 * h);
        acc = __builtin_amdgcn_mfma_f32_32x32x16_bf16(a, b, acc, 0, 0, 0);
        if ((k0 & 63) == 48) __builtin_amdgcn_sched_barrier(0);
    }
}
__device__ __forceinline__ void mma16_nt(f32x4& acc, const LAS bf16* A, int lda, const LAS bf16* Bt, int ldb, int K, int lane) {
    const int r = lane & 15, q = lane >> 4;
    for (int k0 = 0; k0 < K; k0 += 32) {
        const bf16x8 a = *(const LAS bf16x8*)(A + r * lda + k0 + 8 * q);
        const bf16x8 b = *(const LAS bf16x8*)(Bt + r * ldb + k0 + 8 * q);
        acc = __builtin_amdgcn_mfma_f32_16x16x32_bf16(a, b, acc, 0, 0, 0);
    }
}
__device__ __forceinline__ int row32(int reg, int lane) { return (reg & 3) + 8 * (reg >> 2) + 4 * (lane >> 5); }
__device__ __forceinline__ float logsigmoidf_(float x) { return fminf(x, 0.f) - log1pf(expf(-fabsf(x))); }

typedef short s16x4 __attribute__((ext_vector_type(4)));
__device__ __forceinline__ s16x4 tr_read(const LAS bf16* p) { return __builtin_amdgcn_ds_read_tr16_b64_v4i16((LAS s16x4*)p); }
__device__ __forceinline__ bf16x8 tr_frag32_perm(const LAS bf16* T, int ld, int k0, int x0, int lane) {
    const int h = lane >> 5, i = lane & 15, q = i >> 2, p = i & 3, xb = 16 * ((lane >> 4) & 1);
    const LAS bf16* a = T + (k0 + 4 * h + q) * ld + x0 + xb + 4 * p;
    const s16x4 lo = tr_read(a), hi = tr_read(a + 8 * ld);
    return (bf16x8){lo[0], lo[1], lo[2], lo[3], hi[0], hi[1], hi[2], hi[3]};
}
__device__ __forceinline__ bf16x8 tr_frag16(const LAS bf16* T, int ld, int k0, int x0, int lane) {
    const int q4 = lane >> 4, i = lane & 15, q = i >> 2, p = i & 3;
    const LAS bf16* a = T + (k0 + 8 * q4 + q) * ld + x0 + 4 * p;
    const s16x4 lo = tr_read(a), hi = tr_read(a + 4 * ld);
    return (bf16x8){lo[0], lo[1], lo[2], lo[3], hi[0], hi[1], hi[2], hi[3]};
}
__device__ __forceinline__ v4u scale8(const v4u k8, float ww) {
    return (v4u){pk2(ww * bflo(k8.x), ww * bfhi(k8.x)), pk2(ww * bflo(k8.y), ww * bfhi(k8.y)), pk2(ww * bflo(k8.z), ww * bfhi(k8.z)), pk2(ww * bflo(k8.w), ww * bfhi(k8.w))};
}

template <int MODE>
__device__ __forceinline__ void p4_mlstm(Frame& F, const float* const* __restrict__ INP, int unit) {
    const int vh = unit & 1, h = (unit >> 1) & 7, b = (unit >> 4) & 7, d = unit >> 7;
    LAS bf16* Qs = (LAS bf16*)(F.lds + 0);
    LAS bf16* Ks = (LAS bf16*)(F.lds + 18432);
    LAS bf16* Kw = (LAS bf16*)(F.lds + 36864);
    LAS bf16* Vs = (LAS bf16*)(F.lds + 55296);
    LAS bf16* Cb = (LAS bf16*)(F.lds + 73728);
    LAS float* vec = (LAS float*)(F.lds + 82944);
    LAS float *rowt = vec, *colt = vec + 128, *iev = vec + 256, *emt = vec + 384, *nv = vec + 512, *npart = vec + 576;
    const bf16* PROJ = (const bf16*)(F.ws + WS_PROJ); const bf16* QKC = (const bf16*)(F.ws + WS_QKC); bf16* HDIR = (bf16*)(F.ws + WS_HDIR) + (size_t)d * ML * 1024;
    const float* GB = (const float*)(F.ws + WS_GS) + (size_t)((d * 8 + b) * 8 + h) * 4352; const float* GG = GB + 128 * 4352; const float* GP = GG + 128 * 4352;
    int tid = F.tid; asm volatile("" : "+v"(tid));
    const int lane = tid & 63, w = F.wave;
    for (int i = tid; i < 64 * 72; i += 512) Cb[i] = 0;
    if (tid < 64) nv[tid] = 0.f;
    f32x4 accC[2] = {(f32x4){0.f, 0.f, 0.f, 0.f}, (f32x4){0.f, 0.f, 0.f, 0.f}};
    float m_old = 0.f, dec_prev = 0.f;
    v4u pq[2], pk[2], pv[2]; float pgb = 0.f, pgp = 0.f, pgc = 0.f, pgg[2], pbend, pgmax; v2u hout[4]; bf16* hptr = nullptr; bool hpend = false;
    const int zl = tid >> 9;
#define ML_PREFETCH(jn) do { const bool lat_ = (jn) >= 2; const int p0_ = lat_ ? 128 * ((jn) - 2) : 128 * (jn), L_ = lat_ ? SEQ : CTXL, rb_ = lat_ ? b * SEQ : ML + b * CTXL; \
        _Pragma("unroll") for (int i = 0; i < 2; ++i) { const int id = tid + 512 * i, s_ = id >> 3, c_ = id & 7; const int tt = d ? (L_ - 1 - (p0_ + s_)) : (p0_ + s_); const size_t row = (size_t)(rb_ + tt); \
            pq[i] = *(const v4u*)(QKC + row * 1024 + h * 64 + c_ * 8); pk[i] = *(const v4u*)(QKC + row * 1024 + 512 + h * 64 + c_ * 8); pv[i] = *(const v4u*)(PROJ + row * LDP + PC_V + h * 128 + vh * 64 + c_ * 8); \
            pgg[i] = GG[128 * (jn) + s_]; } \
        if (tid < 128) { pgb = GB[128 * (jn) + tid]; pgp = GP[128 * (jn) + tid]; pgc = GG[128 * (jn) + tid]; } \
        pbend = GB[128 * (jn) + 127 + zl]; pgmax = GP[128 * (jn) + 127 + zl]; } while (0)
    ML_PREFETCH(0);
    __syncthreads();
    for (int j = 0; j < 34; ++j) {
        const bool lat = j >= 2;
        const int p0 = lat ? 128 * (j - 2) : 128 * j, Lseq = lat ? SEQ : CTXL, rowbase = lat ? b * SEQ : ML + b * CTXL;
        const float bend = pbend, gmax = pgmax;
        const float mnew = fmaxf(bend + m_old, bend + gmax), dec = __expf(bend + m_old - mnew);
#pragma unroll
        for (int i = 0; i < 2; ++i) { const int id = tid + 512 * i, s = id >> 3, c = id & 7;
            *(LAS v4u*)(Qs + s * 72 + c * 8) = pq[i]; *(LAS v4u*)(Ks + s * 72 + c * 8) = pk[i]; *(LAS v4u*)(Vs + s * 72 + c * 8) = pv[i];
            *(LAS v4u*)(Kw + s * 72 + c * 8) = scale8(pk[i], __expf(bend + pgg[i] - mnew)); }
        if (tid < 128) { const float r = fmaxf(m_old, pgp); rowt[tid] = -r * 1.44269504089f; colt[tid] = pgc * 1.44269504089f; iev[tid] = __expf(m_old - r); emt[tid] = __expf(-pgb - r); }
        if (j > 0) {
            const int vi = w >> 1;
#pragma unroll
            for (int jj = 0; jj < 2; ++jj) { const int ki = 2 * (w & 1) + jj;
#pragma unroll
                for (int reg = 0; reg < 4; ++reg) Cb[(16 * vi + (lane >> 4) * 4 + reg) * 72 + 16 * ki + (lane & 15)] = (bf16)f2bf(accC[jj][reg]); }
            if (tid < 64) { float sacc = 0.f;
#pragma unroll
                for (int p = 0; p < 8; ++p) sacc += npart[p * 64 + tid];
                nv[tid] = dec_prev * nv[tid] + sacc; }
        }
        LBAR();
        if (j + 1 < 34 && !(MODE & 4)) ML_PREFETCH(j + 1);
        if (hpend) {
#pragma unroll
            for (int rg = 0; rg < 4; ++rg) *(v2u*)(hptr + 8 * rg) = hout[rg];
            hpend = false; }
        if (lat && !(MODE & 1)) { const int tm = w >> 1, vt = w & 1, tl = lane & 31, t = 32 * tm + tl, hh = lane >> 5; f32x16 acc;
#pragma unroll
            for (int reg = 0; reg < 16; ++reg) acc[reg] = 0.f;
            mma32_nt(acc, Cb + 32 * vt * 72, 72, Qs + 32 * tm * 72, 72, 64, lane);
            const float ie = iev[t], rt = rowt[t];
#pragma unroll
            for (int reg = 0; reg < 16; ++reg) acc[reg] *= ie;
            float rs = 0.f;
            for (int st = (MODE & 8) ? tm : 0; st <= tm; ++st) {
                f32x16 X;
#pragma unroll
                for (int reg = 0; reg < 16; ++reg) X[reg] = 0.f;
                mma32_nt(X, Ks + 32 * st * 72, 72, Qs + 32 * tm * 72, 72, 64, lane);
                const LAS float* cp = colt + 32 * st + 4 * hh;
                if (st == tm) { const int dlim = tl - 4 * hh;
#pragma unroll
                    for (int rg = 0; rg < 4; ++rg) { const f32x4 c4 = *(const LAS f32x4*)(cp + 8 * rg);
#pragma unroll
                        for (int e = 0; e < 4; ++e) { const float arg = (8 * rg + e <= dlim) ? c4[e] + rt : -INFINITY; const float pvv = X[4 * rg + e] * __builtin_amdgcn_exp2f(arg); X[4 * rg + e] = pvv; rs += pvv; } }
                } else {
#pragma unroll
                    for (int rg = 0; rg < 4; ++rg) { const f32x4 c4 = *(const LAS f32x4*)(cp + 8 * rg);
#pragma unroll
                        for (int e = 0; e < 4; ++e) { const float pvv = X[4 * rg + e] * __builtin_amdgcn_exp2f(c4[e] + rt); X[4 * rg + e] = pvv; rs += pvv; } }
                }
#pragma unroll
                for (int ks = 0; ks < 2; ++ks) {
                    const v4u bw = (v4u){cvtpk(X[8 * ks], X[8 * ks + 1]), cvtpk(X[8 * ks + 2], X[8 * ks + 3]), cvtpk(X[8 * ks + 4], X[8 * ks + 5]), cvtpk(X[8 * ks + 6], X[8 * ks + 7])};
                    const bf16x8 af = tr_frag32_perm(Vs, 72, 32 * st + 16 * ks, 32 * vt, lane);
                    acc = __builtin_amdgcn_mfma_f32_32x32x16_bf16(af, __builtin_bit_cast(bf16x8, bw), acc, 0, 0, 0); }
            }
            float nq = 0.f;
#pragma unroll
            for (int q = 0; q < 4; ++q) { const v4u q8 = *(const LAS v4u*)(Qs + t * 72 + 32 * hh + 8 * q); const LAS float* nn = nv + 32 * hh + 8 * q;
                nq += bflo(q8.x) * nn[0] + bfhi(q8.x) * nn[1] + bflo(q8.y) * nn[2] + bfhi(q8.y) * nn[3] + bflo(q8.z) * nn[4] + bfhi(q8.z) * nn[5] + bflo(q8.w) * nn[6] + bfhi(q8.w) * nn[7]; }
            rs += __shfl_xor(rs, 32); nq += __shfl_xor(nq, 32);
            const float rd = 1.0f / fmaxf(fabsf(ie * nq + rs), emt[t]);
            const int tt = d ? (Lseq - 1 - (p0 + t)) : (p0 + t);
            hptr = HDIR + (size_t)(rowbase + tt) * 1024 + h * 128 + vh * 64 + 32 * vt + 4 * hh;
#pragma unroll
            for (int rg = 0; rg < 4; ++rg) hout[rg] = (v2u){pk2(acc[4 * rg] * rd, acc[4 * rg + 1] * rd), pk2(acc[4 * rg + 2] * rd, acc[4 * rg + 3] * rd)};
            hpend = true; }
        if (!(MODE & 2)) { const int vi = w >> 1;
            accC[0] *= dec; accC[1] *= dec;
#pragma unroll
            for (int st4 = 0; st4 < 4; ++st4) { const bf16x8 af = tr_frag16(Vs, 72, 32 * st4, 16 * vi, lane);
#pragma unroll
                for (int jj = 0; jj < 2; ++jj) { const bf16x8 bfr = tr_frag16(Kw, 72, 32 * st4, 16 * (2 * (w & 1) + jj), lane); accC[jj] = __builtin_amdgcn_mfma_f32_16x16x32_bf16(af, bfr, accC[jj], 0, 0, 0); } } }
        { const int k = tid & 63, part = tid >> 6; float sacc = 0.f;
#pragma unroll
            for (int q = 0; q < 16; ++q) sacc += bf2f(Kw[(16 * part + q) * 72 + k]);
            npart[part * 64 + k] = sacc; }
        m_old = mnew; dec_prev = dec;
        LBAR();
    }
    if (hpend) {
#pragma unroll
        for (int rg = 0; rg < 4; ++rg) *(v2u*)(hptr + 8 * rg) = hout[rg]; }
#undef ML_PREFETCH
}

__device__ __forceinline__ void s5_disc(const float* const* __restrict__ INP, int d, int g, int p, float& ar, float& ai, float& cfr, float& cfi) {
    const float dt = expf(INP[15][d * 32 + g]); const float are = INP[13][(d * 32 + g) * 64 + p], aim = INP[14][(d * 32 + g) * 64 + p];
    const float mag = expf(dt * are), ang = dt * aim; ar = mag * cosf(ang); ai = mag * sinf(ang);
    const float den = are * are + aim * aim, xr = ar - 1.0f; cfr = (xr * are + ai * aim) / den; cfi = (ai * are - xr * aim) / den;
}
__device__ __forceinline__ void p4_s5(Frame& F, const float* const* __restrict__ INP, int unit) {
    const int gp = unit & 15, b = (unit >> 4) & 7, d = unit >> 7;
    LAS bf16* BHt = (LAS bf16*)(F.lds + 0);
    LAS bf16* Cm = (LAS bf16*)(F.lds + 69632);
    LAS float* Eb = (LAS float*)(F.lds + 78336);
    LAS bf16* Us = (LAS bf16*)(F.lds + 82432);
    LAS bf16* BBs = (LAS bf16*)(F.lds + 92672);
    const bf16* PROJ = (const bf16*)(F.ws + WS_PROJ); bf16* YDIR = (bf16*)(F.ws + WS_YDIR) + (size_t)d * ML * 512;
    int tid = F.tid; asm volatile("" : "+v"(tid));
    const int lane = tid & 63, w = F.wave;
    const int sg = tid & 127, seg = tid >> 7;
    float ar, ai, a32r, a32i;
    { float cfr, cfi; s5_disc(INP, d, 2 * gp + (sg >> 6), sg & 63, ar, ai, cfr, cfi); a32r = ar; a32i = ai;
#pragma unroll
        for (int q = 0; q < 5; ++q) { const float nr = a32r * a32r - a32i * a32i, ni = 2.0f * a32r * a32i; a32r = nr; a32i = ni; } }
    for (int idx = tid; idx < 4096; idx += 512) {
        { const int gg = idx >> 11, pp = (idx >> 4) & 127, c = idx & 15, g = 2 * gp + gg, p = pp & 63; float xr_, xi_, cfr, cfi; s5_disc(INP, d, g, p, xr_, xi_, cfr, cfi);
            const float bre = INP[16][((size_t)(d * 32 + g) * 64 + p) * 16 + c], bim = INP[17][((size_t)(d * 32 + g) * 64 + p) * 16 + c];
            BBs[(gg * 128 + pp) * 24 + c] = (bf16)f2bf(pp < 64 ? cfr * bre - cfi * bim : cfr * bim + cfi * bre); }
        { const int gg = idx >> 11, c = (idx >> 7) & 15, pp = idx & 127, g = 2 * gp + gg, p = pp & 63;
            const float v = pp < 64 ? INP[18][((size_t)(d * 32 + g) * 16 + c) * 64 + p] : -INP[19][((size_t)(d * 32 + g) * 16 + c) * 64 + p];
            Cm[(gg * 16 + c) * 136 + pp] = (bf16)f2bf(v); }
    }
    float h0r = 0.f, h0i = 0.f;
    LAS bf16* rowre = BHt + ((sg >> 6) * 128 + (sg & 63)) * 136 + 32 * seg;
    v4u pu; v2u yout[2]; bf16* yptr[2]; bool ypend = false;
#define S5_PREFETCH(jn) do { const bool lat_ = (jn) >= 2; const int p0_ = lat_ ? 128 * ((jn) - 2) : 128 * (jn), L_ = lat_ ? SEQ : CTXL, rb_ = lat_ ? b * SEQ : ML + b * CTXL; \
        const int s_ = tid >> 2, c_ = tid & 3; const int tt = d ? (L_ - 1 - (p0_ + s_)) : (p0_ + s_); pu = *(const v4u*)(PROJ + (size_t)(rb_ + tt) * LDP + PC_U + gp * 32 + c_ * 8); } while (0)
    S5_PREFETCH(0);
    __syncthreads();
    for (int j = 0; j < 34; ++j) {
        const bool lat = j >= 2;
        const int p0 = lat ? 128 * (j - 2) : 128 * j, Lseq = lat ? SEQ : CTXL, rowbase = lat ? b * SEQ : ML + b * CTXL;
        *(LAS v4u*)(Us + (tid >> 2) * 40 + (tid & 3) * 8) = pu;
        LBAR();
        if (j + 1 < 34) S5_PREFETCH(j + 1);
        if (ypend) { *(v2u*)yptr[0] = yout[0]; *(v2u*)yptr[1] = yout[1]; ypend = false; }
        { const int gg = w >> 2, tm = w & 3, r = lane & 31, hh = lane >> 5;
            const bf16x8 a = *(const LAS bf16x8*)(Us + (32 * tm + r) * 40 + gg * 16 + 8 * hh);
            LAS bf16* bp = BHt + (gg * 128 + r) * 136 + 32 * tm + 4 * hh;
#pragma unroll
            for (int tn = 0; tn < 4; ++tn) { f32x16 acc;
#pragma unroll
                for (int reg = 0; reg < 16; ++reg) acc[reg] = 0.f;
                const bf16x8 bb = *(const LAS bf16x8*)(BBs + (gg * 128 + 32 * tn + r) * 24 + 8 * hh);
                acc = __builtin_amdgcn_mfma_f32_32x32x16_bf16(a, bb, acc, 0, 0, 0);
#pragma unroll
                for (int rg = 0; rg < 4; ++rg) *(LAS v2u*)(bp + 32 * tn * 136 + 8 * rg) = (v2u){cvtpk(acc[4 * rg], acc[4 * rg + 1]), cvtpk(acc[4 * rg + 2], acc[4 * rg + 3])}; } }
        LBAR();
        v4u xr[4], xi[4];
#pragma unroll
        for (int q = 0; q < 4; ++q) { xr[q] = *(const LAS v4u*)(rowre + 8 * q); xi[q] = *(const LAS v4u*)(rowre + 64 * 136 + 8 * q); }
        { float hr = 0.f, hi = 0.f;
#pragma unroll
            for (int q = 0; q < 4; ++q)
#pragma unroll
                for (int e = 0; e < 4; ++e) { const unsigned wr_ = xr[q][e], wi_ = xi[q][e];
                    { const float br = bflo(wr_), bi = bflo(wi_); const float nr = ar * hr - ai * hi + br, ni = ar * hi + ai * hr + bi; hr = nr; hi = ni; }
                    { const float br = bfhi(wr_), bi = bfhi(wi_); const float nr = ar * hr - ai * hi + br, ni = ar * hi + ai * hr + bi; hr = nr; hi = ni; } }
            Eb[(seg * 128 + sg) * 2] = hr; Eb[(seg * 128 + sg) * 2 + 1] = hi; }
        LBAR();
        { float hcr = h0r, hci = h0i, hr = 0.f, hi = 0.f;
#pragma unroll
            for (int s2 = 0; s2 < 4; ++s2) { if (s2 == seg) { hr = hcr; hi = hci; } const float er = Eb[(s2 * 128 + sg) * 2], ei = Eb[(s2 * 128 + sg) * 2 + 1];
                const float nr = a32r * hcr - a32i * hci + er, ni = a32r * hci + a32i * hcr + ei; hcr = nr; hci = ni; }
            h0r = hcr; h0i = hci;
#pragma unroll
            for (int q = 0; q < 4; ++q) { v4u orr, oi;
#pragma unroll
                for (int e = 0; e < 4; ++e) { const unsigned wr_ = xr[q][e], wi_ = xi[q][e]; float r0, i0, r1, i1;
                    { const float br = bflo(wr_), bi = bflo(wi_); const float nr = ar * hr - ai * hi + br, ni = ar * hi + ai * hr + bi; hr = nr; hi = ni; r0 = hr; i0 = hi; }
                    { const float br = bfhi(wr_), bi = bfhi(wi_); const float nr = ar * hr - ai * hi + br, ni = ar * hi + ai * hr + bi; hr = nr; hi = ni; r1 = hr; i1 = hi; }
                    orr[e] = cvtpk(r0, r1); oi[e] = cvtpk(i0, i1); }
                *(LAS v4u*)(rowre + 8 * q) = orr; *(LAS v4u*)(rowre + 64 * 136 + 8 * q) = oi; } }
        LBAR();
        if (lat) { const int gg = w >> 2;
#pragma unroll
            for (int jj = 0; jj < 2; ++jj) { const int tm = 2 * (w & 3) + jj; f32x4 acc = (f32x4){0.f, 0.f, 0.f, 0.f};
#pragma unroll
                for (int st4 = 0; st4 < 4; ++st4) { const bf16x8 af = *(const LAS bf16x8*)(Cm + (gg * 16 + (lane & 15)) * 136 + 32 * st4 + 8 * (lane >> 4));
                    const bf16x8 bfr = tr_frag16(BHt + gg * 128 * 136, 136, 32 * st4, 16 * tm, lane);
                    acc = __builtin_amdgcn_mfma_f32_16x16x32_bf16(af, bfr, acc, 0, 0, 0); }
                const int t = 16 * tm + (lane & 15); const int tt = d ? (Lseq - 1 - (p0 + t)) : (p0 + t);
                yptr[jj] = YDIR + (size_t)(rowbase + tt) * 512 + (2 * gp + gg) * 16 + 4 * (lane >> 4); yout[jj] = (v2u){pk2(acc[0], acc[1]), pk2(acc[2], acc[3])}; }
            ypend = true; }
    }
    if (ypend) { *(v2u*)yptr[0] = yout[0]; *(v2u*)yptr[1] = yout[1]; }
#undef S5_PREFETCH
    __syncthreads();
}

__device__ __forceinline__ float gelu_tanh(float x) { const float u = 0.7978845608028654f * (x + 0.044715f * x * x * x); const float e = __expf(2.0f * u); const float th = 1.0f - 2.0f * frcp(e + 1.0f); return 0.5f * x * (1.0f + th); }
__device__ __forceinline__ void p5a_prep(Frame& F, const float* const* __restrict__ INP) {
    const int gw = F.vcu * NWAVES + F.wave, NGW = F.G * NWAVES, lane = F.lane;
    const bf16* PROJ = (const bf16*)(F.ws + WS_PROJ); const bf16* HD0 = (const bf16*)(F.ws + WS_HDIR); const bf16* HD1 = HD0 + (size_t)ML * 1024;
    const bf16* YD0 = (const bf16*)(F.ws + WS_YDIR); const bf16* YD1 = YD0 + (size_t)ML * 512;
    bf16* A1 = (bf16*)(F.ws + WS_A1); bf16* A2 = (bf16*)(F.ws + WS_A2);
    for (int m0 = 2 * gw; m0 < ML; m0 += 2 * NGW) {
        v4u ha[2][2], hb[2][2], ho[2][2], ya[2], yb[2], yu[2];
#pragma unroll
        for (int r = 0; r < 2; ++r) { const size_t m = (size_t)(m0 + r);
#pragma unroll
            for (int q = 0; q < 2; ++q) { ha[r][q] = *(const v4u*)(HD0 + m * 1024 + 16 * lane + 8 * q); hb[r][q] = *(const v4u*)(HD1 + m * 1024 + 16 * lane + 8 * q); ho[r][q] = *(const v4u*)(PROJ + m * LDP + PC_O + 16 * lane + 8 * q); }
            ya[r] = *(const v4u*)(YD0 + m * 512 + 8 * lane); yb[r] = *(const v4u*)(YD1 + m * 512 + 8 * lane); yu[r] = *(const v4u*)(PROJ + m * LDP + PC_U + 8 * lane); }
        __builtin_amdgcn_sched_barrier(0);
#pragma unroll
        for (int r = 0; r < 2; ++r) { const size_t m = (size_t)(m0 + r);
            float hm[16]; float ss = 0.f;
#pragma unroll
            for (int q = 0; q < 2; ++q) { const v4u a = ha[r][q], bq = hb[r][q];
                hm[8 * q + 0] = bflo(a.x) + bflo(bq.x); hm[8 * q + 1] = bfhi(a.x) + bfhi(bq.x); hm[8 * q + 2] = bflo(a.y) + bflo(bq.y); hm[8 * q + 3] = bfhi(a.y) + bfhi(bq.y);
                hm[8 * q + 4] = bflo(a.z) + bflo(bq.z); hm[8 * q + 5] = bfhi(a.z) + bfhi(bq.z); hm[8 * q + 6] = bflo(a.w) + bflo(bq.w); hm[8 * q + 7] = bfhi(a.w) + bfhi(bq.w); }
#pragma unroll
            for (int q = 0; q < 16; ++q) ss += hm[q] * hm[q];
            ss += __shfl_xor(ss, 1); ss += __shfl_xor(ss, 2); ss += __shfl_xor(ss, 4);
            const float rs = 1.0f / sqrtf(ss * (1.0f / 128.0f) + EPS);
#pragma unroll
            for (int q = 0; q < 2; ++q) { const v4u o8 = ho[r][q]; const float* gm = INP[11] + 16 * lane + 8 * q;
                float rr[8]; const float og[8] = {bflo(o8.x), bfhi(o8.x), bflo(o8.y), bfhi(o8.y), bflo(o8.z), bfhi(o8.z), bflo(o8.w), bfhi(o8.w)};
#pragma unroll
                for (int e = 0; e < 8; ++e) rr[e] = hm[8 * q + e] * rs * gm[e] * sigmoidf_(og[e]);
                *(v2u*)((unsigned char*)A1 + m * 1024 + 16 * lane + 8 * q) = (v2u){pk4_fp8(rr[0], rr[1], rr[2], rr[3]), pk4_fp8(rr[4], rr[5], rr[6], rr[7])}; }
            { const v4u a = ya[r], bq = yb[r], u8 = yu[r]; const float* dd = INP[20] + 8 * lane;
                float rr[8] = {bflo(a.x) + bflo(bq.x) + dd[0] * bflo(u8.x), bfhi(a.x) + bfhi(bq.x) + dd[1] * bfhi(u8.x), bflo(a.y) + bflo(bq.y) + dd[2] * bflo(u8.y), bfhi(a.y) + bfhi(bq.y) + dd[3] * bfhi(u8.y),
                               bflo(a.z) + bflo(bq.z) + dd[4] * bflo(u8.z), bfhi(a.z) + bfhi(bq.z) + dd[5] * bfhi(u8.z), bflo(a.w) + bflo(bq.w) + dd[6] * bflo(u8.w), bfhi(a.w) + bfhi(bq.w) + dd[7] * bfhi(u8.w)};
#pragma unroll
                for (int e = 0; e < 8; ++e) rr[e] = gelu_tanh(rr[e]);
                *(v2u*)((unsigned char*)A2 + m * 512 + 8 * lane) = (v2u){pk4_fp8(rr[0], rr[1], rr[2], rr[3]), pk4_fp8(rr[4], rr[5], rr[6], rr[7])}; }
        }
    }
}

__device__ __forceinline__ void route_reduce_top4(float (&acc)[32], const float* br, int lane, float (&tv)[4], int (&ti)[4]) {
#pragma unroll
    for (int i = 0; i < 16; ++i) { const float send = (lane & 32) ? acc[i] : acc[i + 16]; const float keep = (lane & 32) ? acc[i + 16] : acc[i]; acc[i] = keep + __shfl_xor(send, 32); }
#pragma unroll
    for (int i = 0; i < 8; ++i) { const float send = (lane & 16) ? acc[i] : acc[i + 8]; const float keep = (lane & 16) ? acc[i + 8] : acc[i]; acc[i] = keep + __shfl_xor(send, 16); }
#pragma unroll
    for (int i = 0; i < 4; ++i) { const float send = (lane & 8) ? acc[i] : acc[i + 4]; const float keep = (lane & 8) ? acc[i + 4] : acc[i]; acc[i] = keep + __shfl_xor(send, 8); }
#pragma unroll
    for (int i = 0; i < 2; ++i) { const float send = (lane & 4) ? acc[i] : acc[i + 2]; const float keep = (lane & 4) ? acc[i + 2] : acc[i]; acc[i] = keep + __shfl_xor(send, 4); }
    { const float send = (lane & 2) ? acc[0] : acc[1]; const float keep = (lane & 2) ? acc[1] : acc[0]; acc[0] = keep + __shfl_xor(send, 2); }
    acc[0] += __shfl_xor(acc[0], 1);
    float val = acc[0] + br[lane >> 1];
    if (lane & 1) val = -INFINITY;
#pragma unroll
    for (int r = 0; r < 4; ++r) { float mx = val;
#pragma unroll
        for (int o = 1; o < 64; o <<= 1) mx = fmaxf(mx, __shfl_xor(mx, o));
        const unsigned long long bal = __ballot(val == mx); const int wl = __ffsll((long long)bal) - 1;
        tv[r] = mx; ti[r] = wl >> 1; if (lane == wl) val = -INFINITY; }
}
__device__ __forceinline__ void p6_route(Frame& F, const float* const* __restrict__ INP) {
    const bf16* X1 = (const bf16*)(F.ws + WS_X1); const float* mod = (const float*)(F.ws + WS_MOD); bf16* H2 = (bf16*)(F.ws + WS_H2);
    int* TOPE = (int*)(F.ws + WS_TOPE); int* POS = (int*)(F.ws + WS_POS); float* TOPP = (float*)(F.ws + WS_TOPP); int* LIST = (int*)(F.ws + WS_LIST);
    LAS float* Wt = (LAS float*)(F.lds);
    LAS int* pe = (LAS int*)(F.lds + LDSCTL_OFF + 1024); LAS int* hist = pe + 512; LAS int* base = hist + 32; LAS int* rank = base + 32;
    const float* wr = INP[26]; const float* br = INP[27];
    const int lane = F.lane, w = F.wave;
    for (int idx = F.tid; idx < 32768; idx += NWAVES * 64) { const int e = idx >> 10, k = idx & 1023; Wt[((((k >> 8) * 4 + (k & 3)) * 32 + e) << 6) + ((k >> 2) & 63)] = wr[k * 32 + e]; }
    __syncthreads();
    for (int tg = blockIdx.x; tg < ML / 128; tg += F.G) {
        if (F.tid < 32) hist[F.tid] = 0;
        __syncthreads();
#pragma unroll 1
        for (int q = 0; q < 16; q += 2) {
            const int tl = w * 16 + q, m = tg * 128 + tl, b = m / SEQ;
            const float* sh = mod + b * 6144 + 3 * D; const float* scl = sh + D;
            float s0 = 0.f, s1 = 0.f;
#pragma unroll
            for (int j = 0; j < 4; ++j) { const v2u w0 = *(const v2u*)(X1 + (size_t)m * D + 256 * j + 4 * lane), w1 = *(const v2u*)(X1 + (size_t)(m + 1) * D + 256 * j + 4 * lane);
                const f32x4 x0 = (f32x4){bflo(w0.x), bfhi(w0.x), bflo(w0.y), bfhi(w0.y)}, x1 = (f32x4){bflo(w1.x), bfhi(w1.x), bflo(w1.y), bfhi(w1.y)};
                s0 += (x0[0] * x0[0] + x0[1] * x0[1]) + (x0[2] * x0[2] + x0[3] * x0[3]); s1 += (x1[0] * x1[0] + x1[1] * x1[1]) + (x1[2] * x1[2] + x1[3] * x1[3]); }
            const float r0 = 1.0f / sqrtf(wave_sum(s0) * (1.0f / D) + EPS), r1 = 1.0f / sqrtf(wave_sum(s1) * (1.0f / D) + EPS);
            float a0[32], a1[32];
#pragma unroll
            for (int e = 0; e < 32; ++e) { a0[e] = 0.f; a1[e] = 0.f; }
#pragma unroll 1
            for (int j = 0; j < 4; ++j) { const int c = 256 * j + 4 * lane; const f32x4 g = *(const f32x4*)(INP[7] + c), a = *(const f32x4*)(scl + c), bb = *(const f32x4*)(sh + c);
                const v2u w0 = *(const v2u*)(X1 + (size_t)m * D + c), w1 = *(const v2u*)(X1 + (size_t)(m + 1) * D + c);
                const f32x4 x0 = (f32x4){bflo(w0.x), bfhi(w0.x), bflo(w0.y), bfhi(w0.y)}, x1 = (f32x4){bflo(w1.x), bfhi(w1.x), bflo(w1.y), bfhi(w1.y)};
                const f32x4 gs = g * (a + 1.0f); const f32x4 y0 = x0 * r0 * gs + bb, y1 = x1 * r1 * gs + bb;
                *(unsigned*)((unsigned char*)H2 + (size_t)m * D + c) = pk4_fp8(y0[0], y0[1], y0[2], y0[3]); *(unsigned*)((unsigned char*)H2 + (size_t)(m + 1) * D + c) = pk4_fp8(y1[0], y1[1], y1[2], y1[3]);
                const LAS float* wj = Wt + j * 8192 + lane;
#pragma unroll
                for (int qq = 0; qq < 4; ++qq) { const LAS float* wp = wj + qq * 2048; const float ya = y0[qq], yb = y1[qq];
#pragma unroll
                    for (int e = 0; e < 32; ++e) { const float wv = wp[e * 64]; a0[e] += ya * wv; a1[e] += yb * wv; }
                    asm volatile("" ::: "memory"); } }
            float tv[4]; int ti[4];
#pragma unroll
            for (int tk = 0; tk < 2; ++tk) {
                if (tk == 0) route_reduce_top4(a0, br, lane, tv, ti); else route_reduce_top4(a1, br, lane, tv, ti);
                const float e1 = __expf(tv[1] - tv[0]), e2 = __expf(tv[2] - tv[0]), e3 = __expf(tv[3] - tv[0]); const float inv = 1.0f / (1.0f + e1 + e2 + e3);
                if (lane < 4) { const float p = lane == 0 ? inv : (lane == 1 ? e1 * inv : (lane == 2 ? e2 * inv : e3 * inv)); const int ee = lane == 0 ? ti[0] : (lane == 1 ? ti[1] : (lane == 2 ? ti[2] : ti[3]));
                    TOPP[(m + tk) * 4 + lane] = p; TOPE[(m + tk) * 4 + lane] = ee; pe[(tl + tk) * 4 + lane] = ee; }
            }
        }
        __syncthreads();
        { const int e = pe[F.tid]; rank[F.tid] = __hip_atomic_fetch_add(&hist[e], 1, __ATOMIC_RELAXED, __HIP_MEMORY_SCOPE_WORKGROUP); }
        __syncthreads();
        if (F.tid < 32) base[F.tid] = (int)__hip_atomic_fetch_add(F.ctl + CW_CNT + 64 * F.tid, (unsigned)hist[F.tid], RLX_AGENT);
        __syncthreads();
        { const int e = pe[F.tid]; const int pos = base[e] + rank[F.tid]; const int m = tg * 128 + (F.tid >> 2); LIST[e * ML + pos] = m; POS[m * 4 + (F.tid & 3)] = pos; }
        __syncthreads();
    }
}

typedef int i32x4 __attribute__((ext_vector_type(4)));
__device__ __forceinline__ void p10_combine(Frame& F, const float* const* __restrict__ INP) {
    moe_tables(F);
    const LAS int* tab = (const LAS int*)(F.lds + TAB_OFF);
    const bf16* X1 = (const bf16*)(F.ws + WS_X1); float* OUT = F.out; const float* mod = (const float*)(F.ws + WS_MOD); const unsigned char* Y = (const unsigned char*)(F.ws + WS_Y);
    const int* TOPE = (const int*)(F.ws + WS_TOPE); const int* POS = (const int*)(F.ws + WS_POS); const float* TOPP = (const float*)(F.ws + WS_TOPP);
    const int gw = F.vcu * NWAVES + F.wave, NGW = F.G * NWAVES, lane = F.lane;
    i32x4 te[2], tp[2]; f32x4 tw[2];
    int m0 = 2 * gw;
    if (m0 < ML) {
#pragma unroll
        for (int r = 0; r < 2; ++r) { te[r] = *(const i32x4*)(TOPE + (m0 + r) * 4); tp[r] = *(const i32x4*)(POS + (m0 + r) * 4); tw[r] = *(const f32x4*)(TOPP + (m0 + r) * 4); } }
    for (; m0 < ML; m0 += 2 * NGW) {
        unsigned yv[2][4][4]; v2u xv[2][4];
#pragma unroll
        for (int r = 0; r < 2; ++r) {
#pragma unroll
            for (int k = 0; k < 4; ++k) { const size_t slot = (size_t)256 * tab[te[r][k]] + tp[r][k];
#pragma unroll
                for (int j = 0; j < 4; ++j) yv[r][k][j] = *(const unsigned*)(Y + slot * 1024 + 256 * j + 4 * lane); }
#pragma unroll
            for (int j = 0; j < 4; ++j) xv[r][j] = *(const v2u*)(X1 + (size_t)(m0 + r) * D + 256 * j + 4 * lane); }
        const f32x4 cw[2] = {tw[0], tw[1]};
        const int mn = m0 + 2 * NGW;
        if (mn < ML) {
#pragma unroll
            for (int r = 0; r < 2; ++r) { te[r] = *(const i32x4*)(TOPE + (mn + r) * 4); tp[r] = *(const i32x4*)(POS + (mn + r) * 4); tw[r] = *(const f32x4*)(TOPP + (mn + r) * 4); } }
        __builtin_amdgcn_sched_barrier(0);
#pragma unroll
        for (int r = 0; r < 2; ++r) { const int m = m0 + r, b = m / SEQ; const float* gt2 = mod + b * 6144 + 5 * D;
            f32x4 v[4]; float s = 0.f;
#pragma unroll
            for (int j = 0; j < 4; ++j) { const int c = 256 * j + 4 * lane; f32x4 mo = (f32x4){0.f, 0.f, 0.f, 0.f};
#pragma unroll
                for (int k = 0; k < 4; ++k) { const unsigned y = yv[r][k][j]; const auto lo = __builtin_amdgcn_cvt_pk_f32_fp8((int)y, false), hi = __builtin_amdgcn_cvt_pk_f32_fp8((int)y, true);
                    mo += (f32x4){lo[0], lo[1], hi[0], hi[1]} * (cw[r][k] * 0.0625f); }
                const v2u xw = xv[r][j]; v[j] = (f32x4){bflo(xw.x), bfhi(xw.x), bflo(xw.y), bfhi(xw.y)} + *(const f32x4*)(gt2 + c) * mo;
                s += (v[j][0] * v[j][0] + v[j][1] * v[j][1]) + (v[j][2] * v[j][2] + v[j][3] * v[j][3]); }
            const float rstd = 1.0f / sqrtf(wave_sum(s) * (1.0f / D) + EPS);
#pragma unroll
            for (int j = 0; j < 4; ++j) { const int c = 256 * j + 4 * lane; *(f32x4*)(OUT + (size_t)m * D + c) = v[j] * rstd * *(const f32x4*)(INP[32] + c); }
        }
    }
}

struct Args { const float* in[33]; float* out; unsigned char* ws; int ph_lo, ph_hi, li, pad; };
__global__ void __launch_bounds__(NWAVES * 64, 2) fwd_kernel(Args args) {
    extern __shared__ __attribute__((aligned(16))) unsigned char lds[];
    Frame F;
    F.lds = (LAS unsigned char*)lds;
    F.tid = threadIdx.x; F.lane = F.tid & 63; F.wave = __builtin_amdgcn_readfirstlane(F.tid >> 6);
    F.G = gridDim.x; { const int bx = blockIdx.x; F.vcu = (F.G % 8 == 0) ? (bx % 8) * (F.G / 8) + bx / 8 : bx; }
    F.ws = args.ws; F.ctl = (gu32*)(args.ws + WS_CTL); F.out = args.out;
    for (int u = F.tid; u < (LDS_BYTES - LDSCTL_OFF) / 4; u += NWAVES * 64) ((LAS unsigned*)(F.lds + LDSCTL_OFF))[u] = 0u;
    __syncthreads();
    XcdBarrier bar; bar.bar = (unsigned*)(F.ctl + CW_BAR); bar.x = 0; bar.st = nullptr;
    if (N_LAUNCHES == 1) bar = xcd_barrier_post((unsigned*)(F.ctl + CW_BAR), (volatile LAS unsigned*)(F.lds + MISC_OFF) + 8);
    const int lo = args.ph_lo, hi = args.ph_hi;
    const float* const* __restrict__ INP = args.in;
#ifndef PH_MASK
#define PH_MASK 0x3fff
#endif
#define IN(k) ((((PH_MASK) >> (k)) & 1) && lo <= (k) && (k) < hi)
#define SEAM(k) do { if (IN(k) && IN((k) + 1)) xcd_barrier(bar); } while (0)
    const bf16* WIN = (const bf16*)(F.ws + WS_WIN);

    if (IN(0)) { p0_prologue(F, INP); } SEAM(0);
    if (IN(1)) { p1_norm1(F, INP); } SEAM(1);
    if (IN(2)) {
        pg8::Gemm g{(const bf16*)(F.ws + WS_H1), WIN, 512, nullptr, 0x7f7f7f7f, 0x7a7a7a7a}; InProjOrder S{F.G, (int)blockIdx.x};
        EpiStore E{(bf16*)(F.ws + WS_PROJ), LDP};
        pg8::gemm_phase<EpiStore, InProjOrder, false, true>(F.lds, g, S, E);
    } SEAM(2);
    if (IN(3)) { p3_conv(F, INP); } SEAM(3);
    if (IN(4)) { for (int u = blockIdx.x; u < 256; u += F.G) { p4_mlstm<0>(F, INP, u); if (P4_REP_M > 1) p4_mlstm<P4_MODE>(F, INP, u); for (int r_ = 0; r_ < P4_REP_S; ++r_) p4_s5(F, INP, u); } } SEAM(4);
    if (IN(5)) { p5a_prep(F, INP); } SEAM(5);
    if (IN(6)) {
        pg8::Gemm g{(const bf16*)(F.ws + WS_A2), (const bf16*)(F.ws + WS_WGLU), 256, nullptr, 0x7f7f7f7f, 0x7a7a7a7a}; pg8::StaticOrder S; S.init(ML, 512, F.G, (int)blockIdx.x);
        EpiGlu E{(const bf16*)(F.ws + WS_A2), (bf16*)(F.ws + WS_A3), INP[22]};
        pg8::gemm_phase<EpiGlu, pg8::StaticOrder, false, true>(F.lds, g, S, E);
    }
    if (IN(7)) {
        pg8::Gemm g{(const bf16*)(F.ws + WS_A1), (const bf16*)(F.ws + WS_WA), 512, nullptr, 0x7f7f7f7f, 0x7a7a7a7a}; pg8::StaticOrder S; S.init(ML, 1024, F.G, (int)blockIdx.x);
        EpiGate<false> E{(const bf16*)(F.ws + WS_PROJ), PC_G, INP[24], nullptr, (bf16*)(F.ws + WS_YA)};
        pg8::gemm_phase<EpiGate<false>, pg8::StaticOrder, false, true>(F.lds, g, S, E);
    } SEAM(7);
    if (IN(8)) {
        pg8::Gemm g{(const bf16*)(F.ws + WS_A3), (const bf16*)(F.ws + WS_WB), 256, nullptr, 0x7f7f7f7f, 0x7a7a7a7a}; pg8::StaticOrder S; S.init(ML, 1024, F.G, (int)blockIdx.x);
        EpiGate<true> E{(const bf16*)(F.ws + WS_PROJ), PC_G + 1024, INP[24] + 1024, (const bf16*)(F.ws + WS_YA), (bf16*)(F.ws + WS_MERGED)};
        pg8::gemm_phase<EpiGate<true>, pg8::StaticOrder, false, true>(F.lds, g, S, E);
    } SEAM(8);
    if (IN(9)) {
        pg8::Gemm g{(const bf16*)(F.ws + WS_MERGED), (const bf16*)(F.ws + WS_WO), 512, nullptr, 0x7d7d7d7d, 0x7a7a7a7a}; pg8::StaticOrder S; S.init(ML, 1024, F.G, (int)blockIdx.x);
        EpiX1 E{INP[0], (const float*)(F.ws + WS_MOD), (bf16*)(F.ws + WS_X1)};
        pg8::gemm_phase<EpiX1, pg8::StaticOrder, false, true>(F.lds, g, S, E);
    } SEAM(9);
    if (IN(10)) { p6_route(F, INP); } SEAM(10);
    if (IN(11)) {
        moe_tables(F);
        MoeOrder S{F.G, (int)blockIdx.x, 8, (const LAS int*)(F.lds + TAB_OFF)};
        LAS unsigned short* ridx = (LAS unsigned short*)(F.lds + LDSCTL_OFF + 1024);
        { const int* LIST = (const int*)(F.ws + WS_LIST);
            for (int i = 0; i < 30; ++i) { pg8::Unit u; if (!S.next(i, u)) break;
                if (F.tid < 256) { const int rc = F.tid < u.nvalid ? F.tid : u.nvalid - 1; ridx[i * 256 + F.tid] = (unsigned short)LIST[u.lbase + rc]; } }
            __syncthreads(); }
        pg8::Gemm g{(const bf16*)(F.ws + WS_H2), (const bf16*)(F.ws + WS_WEIN), 512, ridx, 0x7f7f7f7f, 0x7a7a7a7a};
        EpiSwiglu E{INP[29], (bf16*)(F.ws + WS_ACT)};
        pg8::gemm_phase<EpiSwiglu, MoeOrder, true, true>(F.lds, g, S, E);
    } SEAM(11);
    if (IN(12)) {
        moe_tables(F);
        pg8::Gemm g{(const bf16*)(F.ws + WS_ACT), (const bf16*)(F.ws + WS_WEOUT), 512, nullptr, 0x7c7c7c7c, 0x7a7a7a7a}; MoeOrder S{F.G, (int)blockIdx.x, 4, (const LAS int*)(F.lds + TAB_OFF)};
        EpiY E{INP[31], (bf16*)(F.ws + WS_Y)};
        pg8::gemm_phase<EpiY, MoeOrder, false, true>(F.lds, g, S, E);
    } SEAM(12);
    if (IN(13)) { p10_combine(F, INP); }
#undef IN
#undef SEAM
}

extern "C" void kernel_launch(void* const* d_in, const int* in_sizes, int n_in, void* d_out, int out_size, void* d_ws, size_t ws_size, hipStream_t stream) {
    static int grid = 0;
    if (grid == 0) {
        if (n_in != 33 || out_size != ML * D || ws_size < WS_END2) { fprintf(stderr, "kernel_launch: unexpected shapes (n_in %d, out %d, ws %zu)\n", n_in, out_size, ws_size); grid = -1; return; }
        int dev = 0, cus = 0, per_cu = 0;
        if (hipGetDevice(&dev) != hipSuccess || hipDeviceGetAttribute(&cus, hipDeviceAttributeMultiprocessorCount, dev) != hipSuccess) { grid = -1; return; }
        if (hipFuncSetAttribute((const void*)fwd_kernel, hipFuncAttributeMaxDynamicSharedMemorySize, LDS_BYTES) != hipSuccess) { fprintf(stderr, "kernel_launch: hipFuncSetAttribute failed\n"); grid = -1; return; }
        if (hipOccupancyMaxActiveBlocksPerMultiprocessor(&per_cu, (const void*)fwd_kernel, NWAVES * 64, LDS_BYTES) != hipSuccess || per_cu < 1) fprintf(stderr, "kernel_launch: occupancy query reports %d\n", per_cu);
        (void)hipGetLastError();
        grid = cus;
    }
    if (grid < 0) return;
    if (hipMemsetAsync((char*)d_ws + WS_CTL, 0, CTL_ZERO_BYTES, stream) != hipSuccess) return;
    Args a{};
    for (int i = 0; i < 33; ++i) a.in[i] = (const float*)d_in[i];
    a.out = (float*)d_out; a.ws = (unsigned char*)d_ws;
    for (int li = 0; li < N_LAUNCHES; ++li) {
        a.ph_lo = (N_LAUNCHES == 1) ? 0 : li; a.ph_hi = (N_LAUNCHES == 1) ? NPH : li + 1; a.li = li;
        const int nrep = (N_LAUNCHES != 1 && (((PROBE_DUP_MASK) >> li) & 1)) ? 2 : 1;
        for (int r = 0; r < nrep; ++r) hipLaunchKernelGGL(fwd_kernel, dim3(grid), dim3(NWAVES * 64), LDS_BYTES, stream, a);
    }
}
```

```cpp
#include <hip/hip_runtime.h>
#include <cstdio>
#include <cstdint>

#ifndef MK_N_LAUNCHES
#define MK_N_LAUNCHES 1
#endif
#ifndef PROBE_DUP_MASK
#define PROBE_DUP_MASK 0
#endif
#ifndef P4_REP_M
#define P4_REP_M 1
#endif
#ifndef P4_MODE
#define P4_MODE 0
#endif
#ifndef P4_REP_S
#define P4_REP_S 1
#endif

namespace pg8 {
#define PG8_LAS __attribute__((address_space(3)))
typedef unsigned short bf16_t;
typedef short bf16x8 __attribute__((ext_vector_type(8)));
typedef float f32x4 __attribute__((ext_vector_type(4)));
typedef unsigned u32x4 __attribute__((ext_vector_type(4)));
constexpr int BM = 256, BK = 64, HALF = 128, HTB = HALF * BK * 2, STAGE_BYTES = 8 * HTB, NXCD = 8, WGM = 8;

__host__ __device__ __forceinline__ int lds_byte(int r, int c) { const int st = (r >> 4) * 2 + (c >> 5), rr = r & 15, cc = c & 31, ob = rr * 64 + cc * 2; return st * 1024 + (ob ^ (((ob >> 9) & 1) << 5)); }
__host__ __device__ __forceinline__ void stage_rc(int b, int& R, int& C) { const int st = b / 1024, sb = b % 1024, swz = sb ^ (((sb >> 9) & 1) << 5); R = (st >> 1) * 16 + swz / 64; C = (st & 1) * 32 + (swz % 64) / 2; }
__host__ __device__ __forceinline__ int perm32(int rho) { const int n = rho >> 4, i = rho & 15; return 8 * (i >> 2) + 4 * n + (i & 3); }

struct Unit { int pm, pn, lbase, nvalid; };
struct Gemm { const bf16_t* A; const bf16_t* Bt; int K; const PG8_LAS unsigned short* ridx; int sa, sb; };

__device__ __forceinline__ int xcd_remap(int L, int nwg) { const int q = nwg / NXCD, r = nwg % NXCD, xcd = L % NXCD, off = L / NXCD; return (xcd < r ? xcd * (q + 1) : r * (q + 1) + (xcd - r) * q) + off; }

struct StaticOrder {
    int nM, nN, nwg, G, c;
    __device__ void init(int M, int N, int G_, int c_) { nM = M / BM; nN = N / BM; nwg = nM * nN; G = G_; c = c_; }
    __device__ __forceinline__ bool next(int i, Unit& u) const {
        const long L = (long)i * G + c; if (L >= nwg) return false;
        const int wgid = xcd_remap((int)L, nwg);
        const int nig = WGM * nN, gid = wgid / nig, fm = gid * WGM, gsz = (nM - fm) < WGM ? (nM - fm) : WGM;
        u.pm = fm + ((wgid % nig) % gsz); u.pn = (wgid % nig) / gsz; u.lbase = 0; u.nvalid = 0; return true;
    }
};

__device__ __forceinline__ unsigned cvt_pk_bf16(float lo, float hi) { unsigned r; asm volatile("v_cvt_pk_bf16_f32 %0, %1, %2" : "=v"(r) : "v"(lo), "v"(hi)); return r; }

typedef int v8i __attribute__((ext_vector_type(8)));
typedef short s16x16 __attribute__((ext_vector_type(16)));
template <class Epi, class Sched, bool GATHER, bool FP8 = false>
__device__ __forceinline__ void gemm_phase(PG8_LAS unsigned char* lds, const Gemm g, const Sched& S, const Epi& E) {
    const int tid = threadIdx.x, wid = __builtin_amdgcn_readfirstlane(tid >> 6), lane = tid & 63, wr = wid >> 2, wc = wid & 3, fr = lane & 15, fq = lane >> 4;
    const int K = g.K, nt = K / BK;
    int Rr[2]; unsigned cby[2], voffB[2];
#pragma unroll
    for (int i = 0; i < 2; ++i) { int R, C; stage_rc(tid * 16 + i * 8192, R, C); const int Rb = Epi::PERM ? ((R & ~31) + perm32(R & 31)) : R;
        Rr[i] = R; cby[i] = (unsigned)C * 2u; voffB[i] = (unsigned)(Rb * K + C) * 2u; }
    const size_t kstep = (size_t)(BK * 2);
    const size_t hstep = (size_t)HALF * K * 2;
    const size_t tstep = 2 * hstep;
    const unsigned ldsw = (unsigned)wid * 1024u;
    const int aoff = lds_byte(wr * 64 + fr, FP8 ? fq * 16 : fq * 8), boff = lds_byte(wc * 32 + fr, FP8 ? fq * 16 : fq * 8);

#define PG8_SA(b, h) (((b) * 2 + (h)) * HTB)
#define PG8_SB(b, h) ((4 + (b) * 2 + (h)) * HTB)
#define PG8_STAGE(bufoff, gbase, voff) do { _Pragma("unroll") for (int _i = 0; _i < 2; ++_i) \
        __builtin_amdgcn_global_load_lds((const unsigned*)((const char*)(gbase) + (voff)[_i]), (PG8_LAS unsigned*)(lds + (bufoff) + ldsw + _i * 8192), 16, 0, 0); } while (0)
#define PG8_LDA(dst, b, h) do { if constexpr (FP8) { _Pragma("unroll") for (int m = 0; m < 4; ++m) { const bf16x8 _lo = *(const PG8_LAS bf16x8*)(lds + PG8_SA(b, h) + aoff + m * 2048), _hi = *(const PG8_LAS bf16x8*)(lds + PG8_SA(b, h) + aoff + m * 2048 + 16); dst##8[m] = __builtin_bit_cast(v8i, __builtin_shufflevector(_lo, _hi, 0, 1, 2, 3, 4, 5, 6, 7, 8, 9, 10, 11, 12, 13, 14, 15)); } } \
        else { _Pragma("unroll") for (int m = 0; m < 4; ++m) _Pragma("unroll") for (int k = 0; k < 2; ++k) dst[m][k] = *(const PG8_LAS bf16x8*)(lds + PG8_SA(b, h) + aoff + m * 2048 + k * 1024); } } while (0)
#define PG8_LDB(dst, b, h) do { if constexpr (FP8) { _Pragma("unroll") for (int n = 0; n < 2; ++n) { const bf16x8 _lo = *(const PG8_LAS bf16x8*)(lds + PG8_SB(b, h) + boff + n * 2048), _hi = *(const PG8_LAS bf16x8*)(lds + PG8_SB(b, h) + boff + n * 2048 + 16); dst##8[n] = __builtin_bit_cast(v8i, __builtin_shufflevector(_lo, _hi, 0, 1, 2, 3, 4, 5, 6, 7, 8, 9, 10, 11, 12, 13, 14, 15)); } } \
        else { _Pragma("unroll") for (int n = 0; n < 2; ++n) _Pragma("unroll") for (int k = 0; k < 2; ++k) dst[n][k] = *(const PG8_LAS bf16x8*)(lds + PG8_SB(b, h) + boff + n * 2048 + k * 1024); } } while (0)
#define PG8_MMA(ai, bj, At, Bt) do { __builtin_amdgcn_s_setprio(1); _Pragma("unroll") for (int m = 0; m < 4; ++m) _Pragma("unroll") for (int n = 0; n < 2; ++n) { \
        if constexpr (FP8) asm volatile("v_mfma_scale_f32_16x16x128_f8f6f4 %0, %1, %2, %0, %3, %4 op_sel_hi:[0,0,0]" : "+v"(acc[ai][bj][m][n]) : "v"(Bt##8[n]), "v"(At##8[m]), "v"(vsb), "v"(vsa));   \
        else { _Pragma("unroll") for (int k = 0; k < 2; ++k) acc[ai][bj][m][n] = __builtin_amdgcn_mfma_f32_16x16x32_bf16(Bt[n][k], At[m][k], acc[ai][bj][m][n], 0, 0, 0); } } \
        __builtin_amdgcn_s_setprio(0); } while (0)
#define PG8_WAIT_V(n) asm volatile("s_waitcnt vmcnt(" #n ")" ::: "memory")
#define PG8_WAIT_L(n) asm volatile("s_waitcnt lgkmcnt(" #n ")" ::: "memory")
#define PG8_BAR __builtin_amdgcn_s_barrier()
#define PG8_SCHED __builtin_amdgcn_sched_barrier(0)
#define PG8_AOFF(dst, u, uord) do { _Pragma("unroll") for (int _h = 0; _h < 2; ++_h) _Pragma("unroll") for (int _i = 0; _i < 2; ++_i) { const int _r = _h * HALF + Rr[_i]; \
        if constexpr (GATHER) { const int _idx = g.ridx[(uord) * 256 + _r]; dst[_h][_i] = (unsigned)_idx * (unsigned)(K * 2) + cby[_i]; } \
        else { dst[_h][_i] = (unsigned)(_r * K * 2) + cby[_i]; } } } while (0)
    Unit cur, nxt; int ui = 0;
    if (!S.next(0, cur)) return;
    f32x4 acc[2][2][4][2];
#pragma unroll
    for (int a = 0; a < 2; ++a)
#pragma unroll
        for (int b = 0; b < 2; ++b)
#pragma unroll
            for (int m = 0; m < 4; ++m)
#pragma unroll
                for (int n = 0; n < 2; ++n) acc[a][b][m][n] = (f32x4){0.f, 0.f, 0.f, 0.f};
    const int vsa = g.sa, vsb = g.sb;
    bf16x8 At[4][2], B0[2][2], B1[2][2];
    v8i At8[4], B08[2], B18[2];
    unsigned vc[2][2], vn[2][2];
    PG8_AOFF(vc, cur, 0);
    const char* cA = GATHER ? (const char*)g.A : (const char*)g.A + (size_t)cur.pm * tstep; const char* cB = (const char*)g.Bt + (size_t)cur.pn * tstep;
    PG8_STAGE(PG8_SB(0, 0), cB, voffB); PG8_STAGE(PG8_SB(0, 1), cB + hstep, voffB); PG8_STAGE(PG8_SA(0, 0), cA, vc[0]); PG8_STAGE(PG8_SA(0, 1), cA, vc[1]);
    if (wr == 1) PG8_BAR;
    PG8_WAIT_V(2); PG8_BAR;
    PG8_STAGE(PG8_SB(1, 0), cB + kstep, voffB); PG8_STAGE(PG8_SA(1, 0), cA + kstep, vc[0]); PG8_STAGE(PG8_SB(1, 1), cB + hstep + kstep, voffB);
    PG8_WAIT_V(6); PG8_BAR;
    for (;;) {
        const bool has_next = S.next(ui + 1, nxt);
        const char* nA = (has_next && !GATHER) ? (const char*)g.A + (size_t)nxt.pm * tstep : cA; const char* nB = has_next ? (const char*)g.Bt + (size_t)nxt.pn * tstep : cB;
        if constexpr (GATHER) { if (has_next) { PG8_AOFF(vn, nxt, ui + 1); } else {
#pragma unroll
            for (int h = 0; h < 2; ++h) { vn[h][0] = vc[h][0]; vn[h][1] = vc[h][1]; } } }
#pragma unroll 1
        for (int t = 0; t < nt; t += 2) {
            const bool last = (t == nt - 2);
            const char* a1 = cA + (size_t)(t + 1) * kstep;
            const char* a2 = last ? nA : cA + (size_t)(t + 2) * kstep; const char* b2 = last ? nB : cB + (size_t)(t + 2) * kstep;
            const char* a3 = a2 + kstep; const char* b3 = b2 + kstep;
            unsigned v2[2][2];
#pragma unroll
            for (int h = 0; h < 2; ++h)
#pragma unroll
                for (int i = 0; i < 2; ++i) v2[h][i] = GATHER ? (last ? vn[h][i] : vc[h][i]) : vc[h][i];
            PG8_LDB(B0, 0, 0); PG8_LDB(B1, 0, 1); PG8_SCHED; PG8_LDA(At, 0, 0); PG8_STAGE(PG8_SA(1, 1), a1, vc[1]);
            PG8_WAIT_V(8); PG8_WAIT_L(0); PG8_BAR; PG8_MMA(0, 0, At, B0); PG8_MMA(0, 1, At, B1); PG8_BAR; PG8_SCHED;
            PG8_LDA(At, 0, 1); PG8_STAGE(PG8_SB(0, 0), b2, voffB); PG8_STAGE(PG8_SB(0, 1), b2 + hstep, voffB); PG8_STAGE(PG8_SA(0, 0), a2, v2[0]);
            PG8_WAIT_V(8); PG8_WAIT_L(0); PG8_BAR; PG8_MMA(1, 0, At, B0); PG8_MMA(1, 1, At, B1); PG8_BAR; PG8_SCHED;
            PG8_LDB(B0, 1, 0); PG8_LDB(B1, 1, 1); PG8_SCHED; PG8_LDA(At, 1, 0); PG8_STAGE(PG8_SA(0, 1), a2, v2[1]);
            PG8_WAIT_V(8); PG8_WAIT_L(0); PG8_BAR; PG8_MMA(0, 0, At, B0); PG8_MMA(0, 1, At, B1); PG8_BAR; PG8_SCHED;
            PG8_LDA(At, 1, 1); PG8_STAGE(PG8_SB(1, 0), b3, voffB); PG8_STAGE(PG8_SB(1, 1), b3 + hstep, voffB); PG8_STAGE(PG8_SA(1, 0), a3, v2[0]);
            PG8_WAIT_V(8); PG8_WAIT_L(0); PG8_BAR; PG8_MMA(1, 0, At, B0); PG8_MMA(1, 1, At, B1); PG8_BAR; PG8_SCHED;
        }
        if (wr == 0) PG8_BAR;
        if constexpr (FP8) asm volatile("s_nop 15\n\ts_nop 15" ::: "memory");
        E(acc, cur, wr, wc, fr, fq);
        if (!has_next) break;
#pragma unroll
        for (int a = 0; a < 2; ++a)
#pragma unroll
            for (int b = 0; b < 2; ++b)
#pragma unroll
                for (int m = 0; m < 4; ++m)
#pragma unroll
                    for (int n = 0; n < 2; ++n) acc[a][b][m][n] = (f32x4){0.f, 0.f, 0.f, 0.f};
        cur = nxt; cA = nA; cB = nB; ++ui;
        if constexpr (GATHER) {
#pragma unroll
            for (int h = 0; h < 2; ++h) { vc[h][0] = vn[h][0]; vc[h][1] = vn[h][1]; } }
        if (wr == 1) PG8_BAR;
    }
    PG8_WAIT_V(0);
    PG8_BAR;
#undef PG8_SA
#undef PG8_SB
#undef PG8_STAGE
#undef PG8_LDA
#undef PG8_LDB
#undef PG8_MMA
#undef PG8_WAIT_V
#undef PG8_WAIT_L
#undef PG8_BAR
#undef PG8_SCHED
#undef PG8_AOFF
}
}

constexpr int NWAVES = 8;
constexpr int D = 1024, NB = 8, SEQ = 4096, CTXL = 256;
constexpr int ML = NB * SEQ, MC = NB * CTXL, MT = ML + MC;
constexpr int LDP = 5888;
constexpr int PC_QK = 0, PC_V = 1024, PC_U = 2048, PC_O = 2560, PC_G = 3584, PC_IF = 5632;
constexpr int NEXP = 32, TOPK = 4;
constexpr int MAXTILES = (ML * TOPK + NEXP * 256) / 256;
constexpr float EPS = 1e-6f;
constexpr int NPH = 14;
constexpr int N_LAUNCHES = MK_N_LAUNCHES;

constexpr size_t MiB = 1u << 20;
constexpr size_t WS_CTL = 0, CTL_ZERO_BYTES = 1 * MiB;
constexpr size_t WS_MOD = 1 * MiB;
constexpr size_t WS_TOPE = 2 * MiB, WS_POS = 2 * MiB + 512 * 1024, WS_TOPP = 3 * MiB, WS_LIST = 4 * MiB;
constexpr size_t WS_WIN = 8 * MiB, WS_WGLU = 20 * MiB, WS_WA = 21 * MiB, WS_WB = 23 * MiB, WS_WO = 24 * MiB, WS_WEIN = 26 * MiB, WS_WEOUT = 154 * MiB;
constexpr size_t WS_R0 = 218 * MiB;
constexpr size_t WS_PROJ = WS_R0, WS_H1 = 609 * MiB, WS_QKC = 677 * MiB, WS_HDIR = 745 * MiB, WS_YDIR = 873 * MiB, WS_END = 937 * MiB;
constexpr size_t WS_A1 = WS_H1, WS_A2 = WS_QKC, WS_A3 = WS_QKC + 32 * MiB, WS_YA = WS_HDIR, WS_MERGED = WS_HDIR + 64 * MiB;
constexpr size_t WS_GS = 940 * MiB, WS_X1 = 940 * MiB, WS_END2 = 1004 * MiB;
constexpr size_t WS_H2 = WS_R0, WS_ACT = 282 * MiB, WS_Y = 554 * MiB;
static_assert(WS_PROJ + (size_t)MT * LDP * 2 <= WS_H1 && WS_Y + (size_t)MAXTILES * 256 * 1024 * 2 <= WS_END, "ws map");
constexpr int CW_BAR = 4096, CW_CNT = 16384;

constexpr int RING_BYTES = 131072;
constexpr int LDSCTL_OFF = RING_BYTES, MISC_OFF = LDSCTL_OFF + 320, TAB_OFF = LDSCTL_OFF + 512;
constexpr int LDS_BYTES = 147456;

#define GAS __attribute__((address_space(1)))
#define LAS __attribute__((address_space(3)))
typedef unsigned short bf16;
typedef unsigned v4u __attribute__((ext_vector_type(4)));
typedef unsigned v2u __attribute__((ext_vector_type(2)));
typedef float f32x4 __attribute__((ext_vector_type(4)));
typedef float f32x16 __attribute__((ext_vector_type(16)));
typedef short bf16x8 __attribute__((ext_vector_type(8)));
typedef GAS unsigned gu32;
#define RLX_AGENT __ATOMIC_RELAXED, __HIP_MEMORY_SCOPE_AGENT
#define LDS_WAIT() asm volatile("s_waitcnt lgkmcnt(0)" ::: "memory")
#define LBAR() do { asm volatile("s_waitcnt lgkmcnt(0)" ::: "memory"); __builtin_amdgcn_s_barrier(); asm volatile("" ::: "memory"); } while (0)
__device__ __forceinline__ unsigned f2bf(float f) { unsigned u = __builtin_bit_cast(unsigned, f); return (u + 0x7fffu + ((u >> 16) & 1u)) >> 16; }
typedef __bf16 bf16x2_t __attribute__((ext_vector_type(2)));
__device__ __forceinline__ unsigned cvtpk(float lo, float hi) { const bf16x2_t v = {(__bf16)lo, (__bf16)hi}; return __builtin_bit_cast(unsigned, v); }
__device__ __forceinline__ unsigned pk2(float lo, float hi) { return cvtpk(lo, hi); }
__device__ __forceinline__ float clamp448(float x) { return fminf(fmaxf(x, -448.0f), 448.0f); }
__device__ __forceinline__ unsigned pk4_fp8(float a, float b, float c, float d) {
    unsigned w = 0; w = __builtin_amdgcn_cvt_pk_fp8_f32(clamp448(a), clamp448(b), w, false); w = __builtin_amdgcn_cvt_pk_fp8_f32(clamp448(c), clamp448(d), w, true); return w; }
__device__ __forceinline__ float bf2f(unsigned b) { return __builtin_bit_cast(float, b << 16); }
__device__ __forceinline__ float bflo(unsigned w) { return __builtin_bit_cast(float, w << 16); }
__device__ __forceinline__ float bfhi(unsigned w) { return __builtin_bit_cast(float, w & 0xffff0000u); }
__device__ __forceinline__ float frcp(float x) { return __builtin_amdgcn_rcpf(x); }
__device__ __forceinline__ float sigmoidf_(float x) { return frcp(1.0f + __expf(-x)); }

#define XB_TMO      128
#define XB_XCNT(j)  (256  + 64 * (j))
#define XB_XSUB(j)  (1280 + 64 * (j))
#define XB_XGEN(j)  (2304 + 64 * (j))
#define XB_TOP      3328
#define XB_TOPGEN   3392
#define XCD_BAR_WORDS 3456
#define XB_SPIN_CAP (1u << 22)
__device__ __forceinline__ unsigned xb_ld(unsigned* p)              { return __hip_atomic_load(p, __ATOMIC_RELAXED, __HIP_MEMORY_SCOPE_AGENT); }
__device__ __forceinline__ unsigned xb_add(unsigned* p, unsigned v) { return __hip_atomic_fetch_add(p, v, __ATOMIC_RELAXED, __HIP_MEMORY_SCOPE_AGENT); }
__device__ __forceinline__ unsigned xb_xcc_id() { return (unsigned)__builtin_amdgcn_s_getreg((3 << 11) | 20) & 0xFu; }
#define XB_SPIN(cond, bar) do { unsigned _sp = 0; while (cond) { __builtin_amdgcn_s_sleep(1); \
    if ((++_sp & 255u) == 0u) { if (xb_ld(&(bar)[XB_TMO])) break; if (_sp > XB_SPIN_CAP) { atomicAdd(&(bar)[XB_TMO], 1u); break; } } } } while (0)
struct XcdBarrier { unsigned* bar; unsigned x; volatile LAS unsigned* st; };
__device__ __forceinline__ XcdBarrier xcd_barrier_post(unsigned* bar, volatile LAS unsigned* st) {
    XcdBarrier b; b.bar = bar; b.x = xb_xcc_id(); b.st = st;
    if (threadIdx.x == 0) (void)xb_add(&bar[XB_XCNT(b.x)], 1u);
    return b;
}
__device__ __forceinline__ void xcd_barrier_complete(unsigned* bar, unsigned x, unsigned& nloc, unsigned& nx) {
    const unsigned G = gridDim.x * gridDim.y * gridDim.z;
    unsigned sum, cnt, mine, sp = 0u;
    for (;;) {
        sum = 0u; cnt = 0u; mine = 0u;
#pragma unroll
        for (unsigned j = 0; j < 16; ++j) { const unsigned c = xb_ld(&bar[XB_XCNT(j)]); sum += c; cnt += (c > 0u) ? 1u : 0u; mine = (j == x) ? c : mine; }
        if (sum == G) break;
        __builtin_amdgcn_s_sleep(1);
        if ((++sp & 255u) == 0u) { if (xb_ld(&bar[XB_TMO])) break; if (sp > XB_SPIN_CAP) { atomicAdd(&bar[XB_TMO], 1u); break; } }
    }
    nloc = mine > 0u ? mine : 1u; nx = cnt > 0u ? cnt : 1u;
}
__device__ __forceinline__ void xcd_barrier(const XcdBarrier& b) {
    asm volatile("s_waitcnt vmcnt(0)" ::: "memory");
    __syncthreads();
    if (threadIdx.x == 0) {
        unsigned* bar = b.bar;
        __builtin_amdgcn_s_waitcnt(0);
        unsigned nloc = b.st[0], nx = b.st[1];
        if (nloc == 0u) { xcd_barrier_complete(bar, b.x, nloc, nx); b.st[0] = nloc; b.st[1] = nx; }
        const unsigned old = xb_add(&bar[XB_XSUB(b.x)], 1u);
        const unsigned gen = old / nloc;
        if (old + 1u == (gen + 1u) * nloc) {
            __builtin_amdgcn_fence(__ATOMIC_RELEASE, "agent");
            asm volatile("s_waitcnt vmcnt(0)" ::: "memory");
            const unsigned og = xb_add(&bar[XB_TOP], 1u);
            const unsigned tg = og / nx;
            if (og + 1u == (tg + 1u) * nx) xb_add(&bar[XB_TOPGEN], 1u);
            else XB_SPIN(xb_ld(&bar[XB_TOPGEN]) == tg, bar);
            __builtin_amdgcn_fence(__ATOMIC_ACQUIRE, "agent");
            xb_add(&bar[XB_XGEN(b.x)], 1u);
            asm volatile("s_waitcnt vmcnt(0)" ::: "memory");
        } else {
            XB_SPIN(xb_ld(&bar[XB_XGEN(b.x)]) == gen, bar);
            __builtin_amdgcn_fence(__ATOMIC_ACQUIRE, "agent");
            asm volatile("s_waitcnt vmcnt(0)" ::: "memory");
        }
    }
    __syncthreads();
}

struct Frame {
    LAS unsigned char* lds;
    gu32* ctl;
    int tid, lane, wave, vcu, G;
    float* out; unsigned char* ws;
};
__device__ __forceinline__ float wave_sum(float v) {
#pragma unroll
    for (int o = 1; o < 64; o <<= 1) v += __shfl_xor(v, o);
    return v;
}

struct InProjOrder {
    int G, c;
    __device__ __forceinline__ bool next(int i, pg8::Unit& u) const {
        const int NL = 128 * 23, NC = 8 * 11;
        const long L = (long)i * G + c; if (L >= NL + NC) return false;
        u.lbase = 0; u.nvalid = 0;
        if (L < NL) { const int wgid = pg8::xcd_remap((int)L, NL); const int nig = 8 * 23, gid = wgid / nig, fm = gid * 8; u.pm = fm + ((wgid % nig) % 8); u.pn = (wgid % nig) / 8; }
        else { const int r = (int)L - NL; u.pm = 128 + r / 11; const int q = r % 11; u.pn = q < 10 ? q : 22; }
        return true;
    }
};
struct MoeOrder {
    int G, c, npn; const LAS int* tab;
    __device__ __forceinline__ bool next(int i, pg8::Unit& u) const {
        const int nT = __builtin_amdgcn_readfirstlane(tab[32]); const int nU = nT * npn;
        const long L = (long)i * G + c; if (L >= nU) return false;
        const int wgid = pg8::xcd_remap((int)L, nU);
        const int tau = wgid / npn, pl = wgid % npn;
        int e = 0;
        for (int k = 1; k < 32; ++k) e += (__builtin_amdgcn_readfirstlane(tab[k]) <= tau) ? 1 : 0;
        const int il = tau - __builtin_amdgcn_readfirstlane(tab[e]);
        u.pm = tau; u.pn = e * npn + pl; u.lbase = e * ML + 256 * il; u.nvalid = __builtin_amdgcn_readfirstlane(tab[33 + e]) - 256 * il;
        return true;
    }
};
__device__ __forceinline__ void moe_tables(Frame& F) {
    LAS int* tab = (LAS int*)(F.lds + TAB_OFF);
    __syncthreads();
    if (F.tid < 32) tab[33 + F.tid] = (int)__hip_atomic_load(F.ctl + CW_CNT + 64 * F.tid, RLX_AGENT);
    __syncthreads();
    if (F.tid == 0) {
        int acc = 0;
        for (int e = 0; e < 32; ++e) { tab[e] = acc; acc += (tab[33 + e] + 255) >> 8; }
        tab[32] = acc;
    }
    __syncthreads();
}

using pg8::f32x4; using pg8::u32x4; using pg8::cvt_pk_bf16;
#define EPI_ROWS(u) const int row0 = (u).pm * 256 + wr * 64 + fr
#define EPI_LOOP _Pragma("unroll") for (int ai = 0; ai < 2; ++ai) _Pragma("unroll") for (int m = 0; m < 4; ++m)
__device__ __forceinline__ u32x4 pack8(const f32x4 a, const f32x4 b) { u32x4 w; w.x = cvt_pk_bf16(a[0], a[1]); w.y = cvt_pk_bf16(a[2], a[3]); w.z = cvt_pk_bf16(b[0], b[1]); w.w = cvt_pk_bf16(b[2], b[3]); return w; }
__device__ __forceinline__ void unpack8(const u32x4 w, f32x4& a, f32x4& b) { a = (f32x4){bflo(w.x), bfhi(w.x), bflo(w.y), bfhi(w.y)}; b = (f32x4){bflo(w.z), bfhi(w.z), bflo(w.w), bfhi(w.w)}; }
__device__ __forceinline__ void unpack8_fp8(const v2u w, f32x4& a, f32x4& b) {
    const auto l0 = __builtin_amdgcn_cvt_pk_f32_fp8((int)w.x, false), h0 = __builtin_amdgcn_cvt_pk_f32_fp8((int)w.x, true), l1 = __builtin_amdgcn_cvt_pk_f32_fp8((int)w.y, false), h1 = __builtin_amdgcn_cvt_pk_f32_fp8((int)w.y, true);
    a = (f32x4){l0[0], l0[1], h0[0], h0[1]}; b = (f32x4){l1[0], l1[1], h1[0], h1[1]}; }
__device__ __forceinline__ v2u pack8_fp8(const f32x4 a, const f32x4 b) { return (v2u){pk4_fp8(a[0], a[1], a[2], a[3]), pk4_fp8(b[0], b[1], b[2], b[3])}; }
__device__ __forceinline__ f32x4 sig4(f32x4 x) { return (f32x4){sigmoidf_(x[0]), sigmoidf_(x[1]), sigmoidf_(x[2]), sigmoidf_(x[3])}; }

struct EpiStore {
    static constexpr bool PERM = true; bf16* O; int ldc;
    __device__ __forceinline__ void operator()(const f32x4 (&acc)[2][2][4][2], const pg8::Unit& u, int wr, int wc, int fr, int fq) const {
        EPI_ROWS(u); const int col0 = u.pn * 256 + wc * 32 + 8 * fq;
        if (u.pn == 22 && wc != 0) return;
        EPI_LOOP { bf16* rowp = O + (size_t)(row0 + ai * 128 + m * 16) * ldc + col0;
#pragma unroll
            for (int bj = 0; bj < 2; ++bj) if (u.pn != 22 || bj == 0) *(u32x4*)(rowp + bj * 128) = pack8(acc[ai][bj][m][0], acc[ai][bj][m][1]); }
    }
};
struct EpiGlu {
    static constexpr bool PERM = true; const bf16* A2; bf16* A3; const float* bias;
    __device__ __forceinline__ void operator()(const f32x4 (&acc)[2][2][4][2], const pg8::Unit& u, int wr, int wc, int fr, int fq) const {
        EPI_ROWS(u); const int col0 = u.pn * 256 + wc * 32 + 8 * fq;
        f32x4 bv[2][2];
#pragma unroll
        for (int bj = 0; bj < 2; ++bj)
#pragma unroll
            for (int n = 0; n < 2; ++n) bv[bj][n] = *(const f32x4*)(bias + col0 + bj * 128 + 4 * n);
#pragma unroll
        for (int ai = 0; ai < 2; ++ai) {
            v2u ld[4][2];
#pragma unroll
            for (int m = 0; m < 4; ++m)
#pragma unroll
                for (int bj = 0; bj < 2; ++bj) ld[m][bj] = *(const v2u*)((const unsigned char*)A2 + (size_t)(row0 + ai * 128 + m * 16) * 512 + col0 + bj * 128);
            __builtin_amdgcn_sched_barrier(0);
#pragma unroll
            for (int m = 0; m < 4; ++m)
#pragma unroll
                for (int bj = 0; bj < 2; ++bj) { f32x4 a0, a1; unpack8_fp8(ld[m][bj], a0, a1);
                    const f32x4 v0 = a0 * sig4(acc[ai][bj][m][0] + bv[bj][0]), v1 = a1 * sig4(acc[ai][bj][m][1] + bv[bj][1]);
                    *(v2u*)((unsigned char*)A3 + (size_t)(row0 + ai * 128 + m * 16) * 512 + col0 + bj * 128) = pack8_fp8(v0, v1); }
        }
    }
};
template <bool ADD> struct EpiGate {
    static constexpr bool PERM = true; const bf16* proj; int gc0; const float* bg; const bf16* Prev; bf16* O;
    __device__ __forceinline__ void operator()(const f32x4 (&acc)[2][2][4][2], const pg8::Unit& u, int wr, int wc, int fr, int fq) const {
        EPI_ROWS(u); const int col0 = u.pn * 256 + wc * 32 + 8 * fq;
        f32x4 bv[2][2];
#pragma unroll
        for (int bj = 0; bj < 2; ++bj)
#pragma unroll
            for (int n = 0; n < 2; ++n) bv[bj][n] = *(const f32x4*)(bg + col0 + bj * 128 + 4 * n);
        constexpr int MB = ADD ? 2 : 4;
#pragma unroll
        for (int g = 0; g < 8 / MB; ++g) {
            u32x4 lg[MB][2], lp[MB][2];
#pragma unroll
            for (int mm = 0; mm < MB; ++mm)
#pragma unroll
                for (int bj = 0; bj < 2; ++bj) { const int q = g * MB + mm, row = row0 + (q >> 2) * 128 + (q & 3) * 16; lg[mm][bj] = *(const u32x4*)(proj + (size_t)row * LDP + gc0 + col0 + bj * 128);
                    if (ADD) lp[mm][bj] = *(const u32x4*)(Prev + (size_t)row * 1024 + col0 + bj * 128); }
            __builtin_amdgcn_sched_barrier(0);
#pragma unroll
            for (int mm = 0; mm < MB; ++mm)
#pragma unroll
                for (int bj = 0; bj < 2; ++bj) { const int q = g * MB + mm, ai = q >> 2, m = q & 3; f32x4 g0, g1; unpack8(lg[mm][bj], g0, g1);
                    f32x4 v0 = sig4(g0 + bv[bj][0]) * acc[ai][bj][m][0], v1 = sig4(g1 + bv[bj][1]) * acc[ai][bj][m][1];
                    if (ADD) { f32x4 p0, p1; unpack8(lp[mm][bj], p0, p1); v0 += p0; v1 += p1; }
                    if (ADD) *(v2u*)((unsigned char*)O + (size_t)(row0 + ai * 128 + m * 16) * 1024 + col0 + bj * 128) = pack8_fp8(v0 * 4.0f, v1 * 4.0f);
                    else *(u32x4*)(O + (size_t)(row0 + ai * 128 + m * 16) * 1024 + col0 + bj * 128) = pack8(v0, v1); }
            __builtin_amdgcn_sched_barrier(0);
        }
    }
};
struct EpiX1 {
    static constexpr bool PERM = true; const float* x; const float* mod; bf16* X1;
    __device__ __forceinline__ void operator()(const f32x4 (&acc)[2][2][4][2], const pg8::Unit& u, int wr, int wc, int fr, int fq) const {
        EPI_ROWS(u); const int col0 = u.pn * 256 + wc * 32 + 8 * fq; const int b = (u.pm * 256) / SEQ;
        f32x4 gv[2][2];
#pragma unroll
        for (int bj = 0; bj < 2; ++bj)
#pragma unroll
            for (int n = 0; n < 2; ++n) gv[bj][n] = *(const f32x4*)(mod + b * 6144 + 2 * D + col0 + bj * 128 + 4 * n);
#pragma unroll
        for (int g = 0; g < 4; ++g) {
            f32x4 lx[2][2][2];
#pragma unroll
            for (int mm = 0; mm < 2; ++mm)
#pragma unroll
                for (int bj = 0; bj < 2; ++bj) { const int q = g * 2 + mm; const size_t off = (size_t)(row0 + (q >> 2) * 128 + (q & 3) * 16) * D + col0 + bj * 128; lx[mm][bj][0] = *(const f32x4*)(x + off); lx[mm][bj][1] = *(const f32x4*)(x + off + 4); }
            __builtin_amdgcn_sched_barrier(0);
#pragma unroll
            for (int mm = 0; mm < 2; ++mm)
#pragma unroll
                for (int bj = 0; bj < 2; ++bj) { const int q = g * 2 + mm, ai = q >> 2, m = q & 3; const size_t off = (size_t)(row0 + ai * 128 + m * 16) * D + col0 + bj * 128;
                    *(u32x4*)(X1 + off) = pack8(lx[mm][bj][0] + gv[bj][0] * acc[ai][bj][m][0], lx[mm][bj][1] + gv[bj][1] * acc[ai][bj][m][1]); }
            __builtin_amdgcn_sched_barrier(0);
        }
    }
};
struct EpiSwiglu {
    static constexpr bool PERM = true; const float* bin; bf16* ACT;
    __device__ __forceinline__ void operator()(const f32x4 (&acc)[2][2][4][2], const pg8::Unit& u, int wr, int wc, int fr, int fq) const {
        EPI_ROWS(u); const int e = u.pn >> 3, pl = u.pn & 7; const int f0 = pl * 128 + wc * 32 + 8 * fq;
        f32x4 bg[2], bl[2];
#pragma unroll
        for (int n = 0; n < 2; ++n) { bg[n] = *(const f32x4*)(bin + e * 2048 + f0 + 4 * n); bl[n] = *(const f32x4*)(bin + e * 2048 + 1024 + f0 + 4 * n); }
        EPI_LOOP { f32x4 o[2];
#pragma unroll
            for (int n = 0; n < 2; ++n) { const f32x4 zg = acc[ai][0][m][n] + bg[n], zl = acc[ai][1][m][n] + bl[n];
#pragma unroll
                for (int j = 0; j < 4; ++j) { const float gl = fminf(zg[j], 7.0f); const float li = fminf(fmaxf(zl[j], -7.0f), 7.0f); o[n][j] = gl * sigmoidf_(1.702f * gl) * (li + 1.0f); } }
            *(v2u*)((unsigned char*)ACT + (size_t)(row0 + ai * 128 + m * 16) * 1024 + f0) = (v2u){pk4_fp8(8.f * o[0][0], 8.f * o[0][1], 8.f * o[0][2], 8.f * o[0][3]), pk4_fp8(8.f * o[1][0], 8.f * o[1][1], 8.f * o[1][2], 8.f * o[1][3])}; }
    }
};
struct EpiY {
    static constexpr bool PERM = true; const float* bout; bf16* Y;
    __device__ __forceinline__ void operator()(const f32x4 (&acc)[2][2][4][2], const pg8::Unit& u, int wr, int wc, int fr, int fq) const {
        EPI_ROWS(u); const int e = u.pn >> 2, pl = u.pn & 3; const int col0 = pl * 256 + wc * 32 + 8 * fq;
        f32x4 bv[2][2];
#pragma unroll
        for (int bj = 0; bj < 2; ++bj)
#pragma unroll
            for (int n = 0; n < 2; ++n) bv[bj][n] = *(const f32x4*)(bout + e * 1024 + col0 + bj * 128 + 4 * n);
        EPI_LOOP { unsigned char* rowp = (unsigned char*)Y + (size_t)(row0 + ai * 128 + m * 16) * 1024 + col0;
#pragma unroll
            for (int bj = 0; bj < 2; ++bj) { const f32x4 v0 = (acc[ai][bj][m][0] + bv[bj][0]) * 16.0f, v1 = (acc[ai][bj][m][1] + bv[bj][1]) * 16.0f;
                *(v2u*)(rowp + bj * 128) = (v2u){pk4_fp8(v0[0], v0[1], v0[2], v0[3]), pk4_fp8(v1[0], v1[1], v1[2], v1[3])}; } }
    }
};

struct TItem { const float* src; bf16* dst; int ld, ldk; int f8; };
__device__ __forceinline__ void titem_load(const TItem& t, int lane, f32x4 (&r)[8]) {
#pragma unroll
    for (int i = 0; i < 8; ++i) r[i] = *(const f32x4*)(t.src + (size_t)(8 * i + (lane >> 3)) * t.ld + 4 * (lane & 7));
}
__device__ __forceinline__ void titem_store(const TItem& t, int lane, const f32x4 (&r)[8], LAS float* scr) {
#pragma unroll
    for (int i = 0; i < 8; ++i) { LAS float* p = scr + (8 * i + (lane >> 3)) * 33 + 4 * (lane & 7); p[0] = r[i][0]; p[1] = r[i][1]; p[2] = r[i][2]; p[3] = r[i][3]; }
    LDS_WAIT(); asm volatile("" ::: "memory");
    const int c = lane & 7;
#pragma unroll
    for (int j = 0; j < 4; ++j) { const int n = (lane >> 3) + 8 * j; const LAS float* s = scr + (8 * c) * 33 + n;
        if (t.f8) { *(GAS v2u*)((unsigned char*)t.dst + (size_t)n * t.ldk + 8 * c) = (v2u){pk4_fp8(32.f * s[0 * 33], 32.f * s[1 * 33], 32.f * s[2 * 33], 32.f * s[3 * 33]), pk4_fp8(32.f * s[4 * 33], 32.f * s[5 * 33], 32.f * s[6 * 33], 32.f * s[7 * 33])}; }
        else { v4u o; o.x = pk2(s[0 * 33], s[1 * 33]); o.y = pk2(s[2 * 33], s[3 * 33]); o.z = pk2(s[4 * 33], s[5 * 33]); o.w = pk2(s[6 * 33], s[7 * 33]);
            *(GAS v4u*)(t.dst + (size_t)n * t.ldk + 8 * c) = o; } }
    LDS_WAIT(); asm volatile("" ::: "memory");
}
__device__ __forceinline__ void p0_prologue(Frame& F, const float* const* __restrict__ INP) {
    {
        LAS float* sc = (LAS float*)(F.lds);
        LAS float* red = (LAS float*)(F.lds + 9 * 1024 * 4);
        for (int i = F.tid; i < 9 * 1024; i += NWAVES * 64) { const int r = i >> 10, k = i & 1023; const float v = r < 8 ? INP[1][r * 1024 + k] : INP[3][k]; sc[i] = v / (1.0f + expf(-v)); }
        __syncthreads();
        const float* wada = INP[4]; const float* bada = INP[5];
        float* mod = (float*)(F.ws + WS_MOD);
        for (int cg = blockIdx.x; cg < 256; cg += F.G) {
            const int j0 = cg * 24, col = F.lane & 31, kp = F.lane >> 5;
            float a[9];
#pragma unroll
            for (int r = 0; r < 9; ++r) a[r] = 0.f;
            if (col < 24) {
#pragma unroll 16
                for (int i = 0; i < 64; ++i) { const int k = F.wave * 128 + 2 * i + kp; const float wv = wada[(size_t)k * 6144 + j0 + col];
#pragma unroll
                    for (int r = 0; r < 9; ++r) a[r] += sc[r * 1024 + k] * wv; }
            }
#pragma unroll
            for (int r = 0; r < 9; ++r) red[((F.wave * 2 + kp) * 9 + r) * 32 + col] = a[r];
            __syncthreads();
            if (F.tid < 9 * 32) { const int r = F.tid >> 5, cc = F.tid & 31;
                if (cc < 24) { float s = 0.f; for (int p = 0; p < 16; ++p) s += red[(p * 9 + r) * 32 + cc]; const int j = j0 + cc; s += bada[j];
                    if (r < 8) mod[r * 6144 + j] = s; else if (j < 2048) mod[8 * 6144 + j] = s; } }
            __syncthreads();
        }
    }
    LAS float* scr = (LAS float*)(F.lds + F.wave * 16384);
    const int gw = F.vcu * NWAVES + F.wave, NGW = F.G * NWAVES;
    bf16* WIN = (bf16*)(F.ws + WS_WIN); bf16* WGLU = (bf16*)(F.ws + WS_WGLU); bf16* WA = (bf16*)(F.ws + WS_WA); bf16* WB = (bf16*)(F.ws + WS_WB); bf16* WO = (bf16*)(F.ws + WS_WO);
    bf16* WEIN = (bf16*)(F.ws + WS_WEIN); bf16* WEOUT = (bf16*)(F.ws + WS_WEOUT);
    constexpr int I_IN = 177 * 16, I_GLU = 16 * 8, I_A = 32 * 16, I_B = 32 * 8, I_O = 32 * 16, I_EIN = 32 * 64 * 16, I_EOUT = 32 * 32 * 16;
    constexpr int NITEMS = I_IN + I_GLU + I_A + I_B + I_O + I_EIN + I_EOUT;
#define P0_DECODE(it_, T) do { int r = (it_); \
        if (r < I_IN) { const int kb = r / 177, nb = r % 177, n0 = nb * 32; const int sc0 = n0 < 2048 ? n0 : (n0 < 5632 ? n0 + 32 : 2048); \
            T.src = INP[8] + (size_t)kb * 64 * 5664 + sc0; T.ld = 5664; T.dst = (bf16*)((unsigned char*)WIN + (size_t)n0 * 1024 + kb * 64); T.ldk = 1024; T.f8 = 1; break; } r -= I_IN; \
        if (r < I_GLU) { const int kb = r / 16, nb = r % 16; T.src = INP[21] + (size_t)kb * 64 * 512 + nb * 32; T.ld = 512; T.dst = (bf16*)((unsigned char*)WGLU + (size_t)nb * 32 * 512 + kb * 64); T.ldk = 512; T.f8 = 1; break; } r -= I_GLU; \
        if (r < I_A) { const int kb = r / 32, nb = r % 32; T.src = INP[12] + (size_t)kb * 64 * 1024 + nb * 32; T.ld = 1024; T.dst = (bf16*)((unsigned char*)WA + (size_t)nb * 32 * 1024 + kb * 64); T.ldk = 1024; T.f8 = 1; break; } r -= I_A; \
        if (r < I_B) { const int kb = r / 32, nb = r % 32; T.src = INP[23] + (size_t)kb * 64 * 1024 + nb * 32; T.ld = 1024; T.dst = (bf16*)((unsigned char*)WB + (size_t)nb * 32 * 512 + kb * 64); T.ldk = 512; T.f8 = 1; break; } r -= I_B; \
        if (r < I_O) { const int kb = r / 32, nb = r % 32; T.src = INP[25] + (size_t)kb * 64 * 1024 + nb * 32; T.ld = 1024; T.dst = (bf16*)((unsigned char*)WO + (size_t)nb * 32 * 1024 + kb * 64); T.ldk = 1024; T.f8 = 1; break; } r -= I_O; \
        if (r < I_EIN) { const int e = r / 1024, q = r % 1024, kb = q / 64, nb = q % 64; const int dr = nb * 32, pn = dr >> 8, bj = (dr >> 7) & 1, xx = dr & 127; \
            T.src = INP[28] + (size_t)e * 1024 * 2048 + (size_t)kb * 64 * 2048 + bj * 1024 + pn * 128 + xx; T.ld = 2048; T.dst = (bf16*)((unsigned char*)WEIN + (size_t)e * 2048 * 1024 + (size_t)dr * 1024 + kb * 64); T.ldk = 1024; T.f8 = 1; break; } r -= I_EIN; \
        { const int e = r / 512, q = r % 512, kb = q / 32, nb = q % 32; \
            T.src = INP[30] + (size_t)e * 1024 * 1024 + (size_t)kb * 64 * 1024 + nb * 32; T.ld = 1024; T.dst = (bf16*)((unsigned char*)WEOUT + (size_t)e * 1024 * 1024 + (size_t)nb * 32 * 1024 + kb * 64); T.ldk = 1024; T.f8 = 1; } } while (0)
    {
        TItem ta, tb; f32x4 ra[8], rb[8];
        int it = gw;
        if (it < NITEMS - I_EIN - I_EOUT) { P0_DECODE(it, ta); titem_load(ta, F.lane, ra); }
        constexpr int NITEMS0 = NITEMS - I_EIN - I_EOUT;
        while (it < NITEMS0) {
            const int nx = it + NGW;
            if (nx < NITEMS0) { P0_DECODE(nx, tb); titem_load(tb, F.lane, rb); }
            titem_store(ta, F.lane, ra, scr);
            ta = tb;
#pragma unroll
            for (int i = 0; i < 8; ++i) ra[i] = rb[i];
            it = nx;
        }
    }
#undef P0_DECODE
    { const int gt = blockIdx.x * (NWAVES * 64) + F.tid, NT = F.G * NWAVES * 64; GAS v4u* z = (GAS v4u*)((unsigned char*)WIN + (size_t)5664 * 1024);
        for (int i = gt; i < 224 * 1024 / 16; i += NT) z[i] = (v4u){0u, 0u, 0u, 0u}; }
}

__device__ __forceinline__ void p1_norm1(Frame& F, const float* const* __restrict__ INP) {
    const int gw = F.vcu * NWAVES + F.wave, NGW = F.G * NWAVES;
    const float* mod = (const float*)(F.ws + WS_MOD); bf16* H1 = (bf16*)(F.ws + WS_H1);
    for (int m = gw; m < MT; m += NGW) {
        const float* xr; const float* sh; const float* scl;
        if (m < ML) { const int b = m / SEQ; xr = INP[0] + (size_t)m * D; sh = mod + b * 6144; scl = sh + D; }
        else { xr = INP[2] + (size_t)(m - ML) * D; sh = mod + 8 * 6144; scl = sh + D; }
        f32x4 v[4]; float s = 0.f;
#pragma unroll
        for (int j = 0; j < 4; ++j) { v[j] = *(const f32x4*)(xr + 256 * j + 4 * F.lane); s += (v[j][0] * v[j][0] + v[j][1] * v[j][1]) + (v[j][2] * v[j][2] + v[j][3] * v[j][3]); }
        const float rstd = 1.0f / sqrtf(wave_sum(s) * (1.0f / D) + EPS);
#pragma unroll
        for (int j = 0; j < 4; ++j) { const int c = 256 * j + 4 * F.lane; const f32x4 g = *(const f32x4*)(INP[6] + c), a = *(const f32x4*)(scl + c), bb = *(const f32x4*)(sh + c);
            const f32x4 y = v[j] * rstd * g * (a + 1.0f) + bb;
            *(unsigned*)((unsigned char*)H1 + (size_t)m * D + c) = pk4_fp8(y[0], y[1], y[2], y[3]); }
    }
}

__device__ __forceinline__ void conv_fma8(float (&a)[8], const v4u x, const float* wp) {
    const f32x4 w0 = *(const f32x4*)(wp), w1 = *(const f32x4*)(wp + 4);
    a[0] += bflo(x.x) * w0[0]; a[1] += bfhi(x.x) * w0[1]; a[2] += bflo(x.y) * w0[2]; a[3] += bfhi(x.y) * w0[3];
    a[4] += bflo(x.z) * w1[0]; a[5] += bfhi(x.z) * w1[1]; a[6] += bflo(x.w) * w1[2]; a[7] += bfhi(x.w) * w1[3];
}
__device__ __forceinline__ void p3_conv(Frame& F, const float* const* __restrict__ INP) {
    const bf16* PROJ = (const bf16*)(F.ws + WS_PROJ); bf16* QKC = (bf16*)(F.ws + WS_QKC); const float* wc = INP[9];
    const int NT = F.G * NWAVES * 64;
    for (int it = F.vcu * (NWAVES * 64) + F.tid; it < NB * 64 * 16 * 128; it += NT) {
        const int ch0 = (it & 127) * 8, seg = (it >> 7) & 15, gr = (it >> 11) & 63, b = it >> 17, c0 = seg * 4;
        const bf16* base = PROJ + (size_t)(b * SEQ) * LDP + ch0;
        const float scale = ch0 < 512 ? 0.125f : 1.0f;
        v4u win[6][3];
        const v4u z = (v4u){0u, 0u, 0u, 0u};
#pragma unroll
        for (int cc = 0; cc < 6; ++cc)
#pragma unroll
            for (int ky = 0; ky < 3; ++ky) { const int rr = gr + ky - 1, c = c0 + cc - 1;
                win[cc][ky] = (rr >= 0 && rr < 64 && c >= 0 && c < 64) ? *(const v4u*)(base + (size_t)(rr * 64 + c) * LDP) : z; }
        __builtin_amdgcn_sched_barrier(0);
        float a[4][8];
#pragma unroll
        for (int cc = 0; cc < 4; ++cc)
#pragma unroll
            for (int j = 0; j < 8; ++j) a[cc][j] = 0.f;
#pragma unroll
        for (int ky = 0; ky < 3; ++ky)
#pragma unroll
            for (int kx = 0; kx < 3; ++kx) {
                const f32x4 w0 = *(const f32x4*)(wc + (ky * 3 + kx) * 1024 + ch0), w1 = *(const f32x4*)(wc + (ky * 3 + kx) * 1024 + ch0 + 4);
#pragma unroll
                for (int cc = 0; cc < 4; ++cc) { const v4u x = win[cc + kx][ky];
                    a[cc][0] += bflo(x.x) * w0[0]; a[cc][1] += bfhi(x.x) * w0[1]; a[cc][2] += bflo(x.y) * w0[2]; a[cc][3] += bfhi(x.y) * w0[3];
                    a[cc][4] += bflo(x.z) * w1[0]; a[cc][5] += bfhi(x.z) * w1[1]; a[cc][6] += bflo(x.w) * w1[2]; a[cc][7] += bfhi(x.w) * w1[3]; }
                asm volatile("" ::: "memory");
            }
#pragma unroll
        for (int cc = 0; cc < 4; ++cc) {
#pragma unroll
            for (int j = 0; j < 8; ++j) a[cc][j] = a[cc][j] * frcp(1.0f + __expf(-a[cc][j])) * scale;
            *(v4u*)(QKC + (size_t)(b * SEQ + gr * 64 + c0 + cc) * 1024 + ch0) = (v4u){pk2(a[cc][0], a[cc][1]), pk2(a[cc][2], a[cc][3]), pk2(a[cc][4], a[cc][5]), pk2(a[cc][6], a[cc][7])};
        }
    }
    for (int w = F.vcu * (NWAVES * 64) + F.tid; w < MC * 128; w += NT) {
        const int row = ML + (w >> 7), ch0 = (w & 127) * 8, t = (w >> 7) % CTXL;
        float a[8];
#pragma unroll
        for (int j = 0; j < 8; ++j) a[j] = 0.f;
#pragma unroll
        for (int kx = 0; kx < 3; ++kx) { const int tt = t + kx - 1;
            if (tt >= 0 && tt < CTXL) conv_fma8(a, *(const v4u*)(PROJ + (size_t)(row + kx - 1) * LDP + ch0), wc + (3 + kx) * 1024 + ch0); }
        const float scale = ch0 < 512 ? 0.125f : 1.0f;
#pragma unroll
        for (int j = 0; j < 8; ++j) a[j] = a[j] * frcp(1.0f + __expf(-a[j])) * scale;
        *(v4u*)(QKC + (size_t)row * 1024 + ch0) = (v4u){pk2(a[0], a[1]), pk2(a[2], a[3]), pk2(a[4], a[5]), pk2(a[6], a[7])};
    }
    {
        float* GB = (float*)(F.ws + WS_GS); float* GG = GB + 128 * 4352; float* GP = GG + 128 * 4352;
        const int gw = F.vcu * NWAVES + F.wave, NGW = F.G * NWAVES, lane = F.lane;
        for (int it = gw; it < 128 * 34; it += NGW) {
            const int jc = it % 34, dbh = it / 34, h = dbh & 7, b = (dbh >> 3) & 7, d = dbh >> 6;
            const bool lat = jc >= 2; const int p0 = lat ? 128 * (jc - 2) : 128 * jc, Lseq = lat ? SEQ : CTXL, rowbase = lat ? b * SEQ : ML + b * CTXL;
            const float bi_ = INP[10][d * 16 + h], bf_ = INP[10][d * 16 + 8 + h];
            float li2[2], lf2[2];
#pragma unroll
            for (int e = 0; e < 2; ++e) { const int sp = 2 * lane + e; const int tt = d ? (Lseq - 1 - (p0 + sp)) : (p0 + sp); const size_t row = (size_t)(rowbase + tt);
                li2[e] = bf2f(PROJ[row * LDP + PC_IF + d * 16 + h]) + bi_; const float xf = bf2f(PROJ[row * LDP + PC_IF + d * 16 + 8 + h]) + bf_;
                lf2[e] = fminf(xf, 0.f) - log1pf(expf(-fabsf(xf))); }
            const float c1 = lf2[0] + lf2[1]; float inc = c1;
#pragma unroll
            for (int o = 1; o < 64; o <<= 1) { const float t = __shfl_up(inc, o); if (lane >= o) inc += t; }
            const float exc = inc - c1, b0 = exc + lf2[0], b1 = exc + c1, g0 = li2[0] - b0, g1 = li2[1] - b1;
            float pmx = fmaxf(g0, g1);
#pragma unroll
            for (int o = 1; o < 64; o <<= 1) { const float t = __shfl_up(pmx, o); if (lane >= o) pmx = fmaxf(pmx, t); }
            float pex = __shfl_up(pmx, 1); if (lane == 0) pex = -INFINITY;
            const size_t o = (size_t)dbh * 4352 + 128 * jc + 2 * lane;
            *(float2*)(GB + o) = make_float2(b0, b1); *(float2*)(GG + o) = make_float2(g0, g1); *(float2*)(GP + o) = make_float2(fmaxf(pex, g0), pmx);
        }
    }
}

__device__ __forceinline__ void mma32_nt(f32x16& acc, const LAS bf16* A, int lda, const LAS bf16* Bt, int ldb, int K, int lane) {
    const int r = lane & 31, h = lane >> 5;
#pragma unroll
    for (int k0 = 0; k0 < K; k0 += 16) {
        const bf16x8 a = *(const LAS bf16x8*)(A + r * lda + k0 + 8 * h);
        const bf16x8 b = *(const LAS bf16x8*)(Bt + r * ldb + k0 + 8 * h);
        acc = __builtin_amdgcn_mfma_f32_32x32x16_bf16(a, b, acc, 0, 0, 0);
        if ((k0 & 63) == 48) __builtin_amdgcn_sched_barrier(0);
    }
}
__device__ __forceinline__ void mma16_nt(f32x4& acc, const LAS bf16* A, int lda, const LAS bf16* Bt, int ldb, int K, int lane) {
    const int r = lane & 15, q = lane >> 4;
    for (int k0 = 0; k0 < K; k0 += 32) {
        const bf16x8 a = *(const LAS bf16x8*)(A + r * lda + k0 + 8 * q);
        const bf16x8 b = *(const LAS bf16x8*)(Bt + r * ldb + k0 + 8 * q);
        acc = __builtin_amdgcn_mfma_f32_16x16x32_bf16(a, b, acc, 0, 0, 0);
    }
}
__device__ __forceinline__ int row32(int reg, int lane) { return (reg & 3) + 8 * (reg >> 2) + 4 * (lane >> 5); }
__device__ __forceinline__ float logsigmoidf_(float x) { return fminf(x, 0.f) - log1pf(expf(-fabsf(x))); }

typedef short s16x4 __attribute__((ext_vector_type(4)));
__device__ __forceinline__ s16x4 tr_read(const LAS bf16* p) { return __builtin_amdgcn_ds_read_tr16_b64_v4i16((LAS s16x4*)p); }
__device__ __forceinline__ bf16x8 tr_frag32_perm(const LAS bf16* T, int ld, int k0, int x0, int lane) {
    const int h = lane >> 5, i = lane & 15, q = i >> 2, p = i & 3, xb = 16 * ((lane >> 4) & 1);
    const LAS bf16* a = T + (k0 + 4 * h + q) * ld + x0 + xb + 4 * p;
    const s16x4 lo = tr_read(a), hi = tr_read(a + 8 * ld);
    return (bf16x8){lo[0], lo[1], lo[2], lo[3], hi[0], hi[1], hi[2], hi[3]};
}
__device__ __forceinline__ bf16x8 tr_frag16(const LAS bf16* T, int ld, int k0, int x0, int lane) {
    const int q4 = lane >> 4, i = lane & 15, q = i >> 2, p = i & 3;
    const LAS bf16* a = T + (k0 + 8 * q4 + q) * ld + x0 + 4 * p;
    const s16x4 lo = tr_read(a), hi = tr_read(a + 4 * ld);
    return (bf16x8){lo[0], lo[1], lo[2], lo[3], hi[0], hi[1], hi[2], hi[3]};
}
__device__ __forceinline__ v4u scale8(const v4u k8, float ww) {
    return (v4u){pk2(ww * bflo(k8.x), ww * bfhi(k8.x)), pk2(ww * bflo(k8.y), ww * bfhi(k8.y)), pk2(ww * bflo(k8.z), ww * bfhi(k8.z)), pk2(ww * bflo(k8.w), ww * bfhi(k8.w))};
}

constexpr int XI_EIN = 32 * 64 * 16, XI_EOUT = 32 * 32 * 16, XI_PER_UNIT = (XI_EIN + XI_EOUT) / 256;
__device__ __forceinline__ void xitem_decode(const float* const* __restrict__ INP, unsigned char* ws, int r, const float*& src, int& ld, unsigned char*& dst) {
    if (r < XI_EIN) { const int e = r / 1024, q = r % 1024, kb = q / 64, nb = q % 64; const int dr = nb * 32, pn = dr >> 8, bj = (dr >> 7) & 1, xx = dr & 127;
        src = INP[28] + (size_t)e * 1024 * 2048 + (size_t)kb * 64 * 2048 + bj * 1024 + pn * 128 + xx; ld = 2048; dst = ws + WS_WEIN + (size_t)e * 2048 * 1024 + (size_t)dr * 1024 + kb * 64; }
    else { r -= XI_EIN; const int e = r / 512, q = r % 512, kb = q / 32, nb = q % 32;
        src = INP[30] + (size_t)e * 1024 * 1024 + (size_t)kb * 64 * 1024 + nb * 32; ld = 1024; dst = ws + WS_WEOUT + (size_t)e * 1024 * 1024 + (size_t)nb * 32 * 1024 + kb * 64; }
}
template <int MODE>
__device__ __forceinline__ void p4_mlstm(Frame& F, const float* const* __restrict__ INP, int unit) {
    const int vh = unit & 1, h = (unit >> 1) & 7, b = (unit >> 4) & 7, d = unit >> 7;
    LAS bf16* Qs = (LAS bf16*)(F.lds + 0);
    LAS bf16* Ks = (LAS bf16*)(F.lds + 18432);
    LAS bf16* Kw = (LAS bf16*)(F.lds + 36864);
    LAS bf16* Vs = (LAS bf16*)(F.lds + 55296);
    LAS bf16* Cb = (LAS bf16*)(F.lds + 73728);
    LAS float* vec = (LAS float*)(F.lds + 82944);
    LAS float *rowt = vec, *colt = vec + 128, *iev = vec + 256, *emt = vec + 384, *nv = vec + 512, *npart = vec + 576;
    const bf16* PROJ = (const bf16*)(F.ws + WS_PROJ); const bf16* QKC = (const bf16*)(F.ws + WS_QKC); bf16* HDIR = (bf16*)(F.ws + WS_HDIR) + (size_t)d * ML * 1024;
    const float* GB = (const float*)(F.ws + WS_GS) + (size_t)((d * 8 + b) * 8 + h) * 4352; const float* GG = GB + 128 * 4352; const float* GP = GG + 128 * 4352;
    int tid = F.tid; asm volatile("" : "+v"(tid));
    const int lane = tid & 63, w = F.wave;
    for (int i = tid; i < 64 * 72; i += 512) Cb[i] = 0;
    if (tid < 64) nv[tid] = 0.f;
    f32x4 accC[2] = {(f32x4){0.f, 0.f, 0.f, 0.f}, (f32x4){0.f, 0.f, 0.f, 0.f}};
    float m_old = 0.f, dec_prev = 0.f;
    v4u pq[2], pk[2], pv[2]; float pgb = 0.f, pgp = 0.f, pgc = 0.f, pgg[2], pbend, pgmax; v2u hout[4]; bf16* hptr = nullptr; bool hpend = false;
    f32x4 xr[8]; v2u xo[4]; unsigned char* xdst = nullptr; unsigned char* xodst = nullptr; bool xload = false, xout = false;
    LAS float* xscr = (LAS float*)(F.lds + (w < 5 ? 87296 + w * 8448 : 132096));
    const int zl = tid >> 9;
#define ML_PREFETCH(jn) do { const bool lat_ = (jn) >= 2; const int p0_ = lat_ ? 128 * ((jn) - 2) : 128 * (jn), L_ = lat_ ? SEQ : CTXL, rb_ = lat_ ? b * SEQ : ML + b * CTXL; \
        _Pragma("unroll") for (int i = 0; i < 2; ++i) { const int id = tid + 512 * i, s_ = id >> 3, c_ = id & 7; const int tt = d ? (L_ - 1 - (p0_ + s_)) : (p0_ + s_); const size_t row = (size_t)(rb_ + tt); \
            pq[i] = *(const v4u*)(QKC + row * 1024 + h * 64 + c_ * 8); pk[i] = *(const v4u*)(QKC + row * 1024 + 512 + h * 64 + c_ * 8); pv[i] = *(const v4u*)(PROJ + row * LDP + PC_V + h * 128 + vh * 64 + c_ * 8); \
            pgg[i] = GG[128 * (jn) + s_]; } \
        if (tid < 128) { pgb = GB[128 * (jn) + tid]; pgp = GP[128 * (jn) + tid]; pgc = GG[128 * (jn) + tid]; } \
        pbend = GB[128 * (jn) + 127 + zl]; pgmax = GP[128 * (jn) + 127 + zl]; } while (0)
    ML_PREFETCH(0);
    __syncthreads();
    for (int j = 0; j < 34; ++j) {
        const bool lat = j >= 2;
        const int p0 = lat ? 128 * (j - 2) : 128 * j, Lseq = lat ? SEQ : CTXL, rowbase = lat ? b * SEQ : ML + b * CTXL;
        const float bend = pbend, gmax = pgmax;
        const float mnew = fmaxf(bend + m_old, bend + gmax), dec = __expf(bend + m_old - mnew);
#pragma unroll
        for (int i = 0; i < 2; ++i) { const int id = tid + 512 * i, s = id >> 3, c = id & 7;
            *(LAS v4u*)(Qs + s * 72 + c * 8) = pq[i]; *(LAS v4u*)(Ks + s * 72 + c * 8) = pk[i]; *(LAS v4u*)(Vs + s * 72 + c * 8) = pv[i];
            *(LAS v4u*)(Kw + s * 72 + c * 8) = scale8(pk[i], __expf(bend + pgg[i] - mnew)); }
        if (tid < 128) { const float r = fmaxf(m_old, pgp); rowt[tid] = -r * 1.44269504089f; colt[tid] = pgc * 1.44269504089f; iev[tid] = __expf(m_old - r); emt[tid] = __expf(-pgb - r); }
        if (j > 0) {
            const int vi = w >> 1;
#pragma unroll
            for (int jj = 0; jj < 2; ++jj) { const int ki = 2 * (w & 1) + jj;
#pragma unroll
                for (int reg = 0; reg < 4; ++reg) Cb[(16 * vi + (lane >> 4) * 4 + reg) * 72 + 16 * ki + (lane & 15)] = (bf16)f2bf(accC[jj][reg]); }
            if (tid < 64) { float sacc = 0.f;
#pragma unroll
                for (int p = 0; p < 8; ++p) sacc += npart[p * 64 + tid];
                nv[tid] = dec_prev * nv[tid] + sacc; }
        }
        LBAR();
        if (j + 1 < 34 && !(MODE & 4)) ML_PREFETCH(j + 1);
        if (hpend) {
#pragma unroll
            for (int rg = 0; rg < 4; ++rg) *(v2u*)(hptr + 8 * rg) = hout[rg];
            hpend = false; }
        if (MODE == 0 && w < 6) {
            if (xout) {
#pragma unroll
                for (int q = 0; q < 4; ++q) *(GAS v2u*)(xodst + (size_t)(8 * q) * 1024) = xo[q];
                xout = false; }
            const int sl = j * 6 + w;
            if (sl < XI_PER_UNIT) { const float* xsrc; int xld; xitem_decode(INP, F.ws, unit * XI_PER_UNIT + sl, xsrc, xld, xdst);
#pragma unroll
                for (int i = 0; i < 8; ++i) xr[i] = *(const f32x4*)(xsrc + (size_t)(8 * i + (lane >> 3)) * xld + 4 * (lane & 7));
                xload = true; }
        }
        if (lat && !(MODE & 1)) { const int tm = w >> 1, vt = w & 1, tl = lane & 31, t = 32 * tm + tl, hh = lane >> 5; f32x16 acc;
#pragma unroll
            for (int reg = 0; reg < 16; ++reg) acc[reg] = 0.f;
            mma32_nt(acc, Cb + 32 * vt * 72, 72, Qs + 32 * tm * 72, 72, 64, lane);
            const float ie = iev[t], rt = rowt[t];
#pragma unroll
            for (int reg = 0; reg < 16; ++reg) acc[reg] *= ie;
            float rs = 0.f;
            for (int st = (MODE & 8) ? tm : 0; st <= tm; ++st) {
                f32x16 X;
#pragma unroll
                for (int reg = 0; reg < 16; ++reg) X[reg] = 0.f;
                mma32_nt(X, Ks + 32 * st * 72, 72, Qs + 32 * tm * 72, 72, 64, lane);
                const LAS float* cp = colt + 32 * st + 4 * hh;
                if (st == tm) { const int dlim = tl - 4 * hh;
#pragma unroll
                    for (int rg = 0; rg < 4; ++rg) { const f32x4 c4 = *(const LAS f32x4*)(cp + 8 * rg);
#pragma unroll
                        for (int e = 0; e < 4; ++e) { const float arg = (8 * rg + e <= dlim) ? c4[e] + rt : -INFINITY; const float pvv = X[4 * rg + e] * __builtin_amdgcn_exp2f(arg); X[4 * rg + e] = pvv; rs += pvv; } }
                } else {
#pragma unroll
                    for (int rg = 0; rg < 4; ++rg) { const f32x4 c4 = *(const LAS f32x4*)(cp + 8 * rg);
#pragma unroll
                        for (int e = 0; e < 4; ++e) { const float pvv = X[4 * rg + e] * __builtin_amdgcn_exp2f(c4[e] + rt); X[4 * rg + e] = pvv; rs += pvv; } }
                }
#pragma unroll
                for (int ks = 0; ks < 2; ++ks) {
                    const v4u bw = (v4u){cvtpk(X[8 * ks], X[8 * ks + 1]), cvtpk(X[8 * ks + 2], X[8 * ks + 3]), cvtpk(X[8 * ks + 4], X[8 * ks + 5]), cvtpk(X[8 * ks + 6], X[8 * ks + 7])};
                    const bf16x8 af = tr_frag32_perm(Vs, 72, 32 * st + 16 * ks, 32 * vt, lane);
                    acc = __builtin_amdgcn_mfma_f32_32x32x16_bf16(af, __builtin_bit_cast(bf16x8, bw), acc, 0, 0, 0); }
            }
            float nq = 0.f;
#pragma unroll
            for (int q = 0; q < 4; ++q) { const v4u q8 = *(const LAS v4u*)(Qs + t * 72 + 32 * hh + 8 * q); const LAS float* nn = nv + 32 * hh + 8 * q;
                nq += bflo(q8.x) * nn[0] + bfhi(q8.x) * nn[1] + bflo(q8.y) * nn[2] + bfhi(q8.y) * nn[3] + bflo(q8.z) * nn[4] + bfhi(q8.z) * nn[5] + bflo(q8.w) * nn[6] + bfhi(q8.w) * nn[7]; }
            rs += __shfl_xor(rs, 32); nq += __shfl_xor(nq, 32);
            const float rd = 1.0f / fmaxf(fabsf(ie * nq + rs), emt[t]);
            const int tt = d ? (Lseq - 1 - (p0 + t)) : (p0 + t);
            hptr = HDIR + (size_t)(rowbase + tt) * 1024 + h * 128 + vh * 64 + 32 * vt + 4 * hh;
#pragma unroll
            for (int rg = 0; rg < 4; ++rg) hout[rg] = (v2u){pk2(acc[4 * rg] * rd, acc[4 * rg + 1] * rd), pk2(acc[4 * rg + 2] * rd, acc[4 * rg + 3] * rd)};
            hpend = true; }
        if (!(MODE & 2)) { const int vi = w >> 1;
            accC[0] *= dec; accC[1] *= dec;
#pragma unroll
            for (int st4 = 0; st4 < 4; ++st4) { const bf16x8 af = tr_frag16(Vs, 72, 32 * st4, 16 * vi, lane);
#pragma unroll
                for (int jj = 0; jj < 2; ++jj) { const bf16x8 bfr = tr_frag16(Kw, 72, 32 * st4, 16 * (2 * (w & 1) + jj), lane); accC[jj] = __builtin_amdgcn_mfma_f32_16x16x32_bf16(af, bfr, accC[jj], 0, 0, 0); } } }
        { const int k = tid & 63, part = tid >> 6; float sacc = 0.f;
#pragma unroll
            for (int q = 0; q < 16; ++q) sacc += bf2f(Kw[(16 * part + q) * 72 + k]);
            npart[part * 64 + k] = sacc; }
        if (MODE == 0 && w < 6 && xload) {
#pragma unroll
            for (int i = 0; i < 8; ++i) { LAS float* p = xscr + (8 * i + (lane >> 3)) * 33 + 4 * (lane & 7); p[0] = xr[i][0]; p[1] = xr[i][1]; p[2] = xr[i][2]; p[3] = xr[i][3]; }
            LDS_WAIT(); asm volatile("" ::: "memory");
            const int c = lane & 7;
#pragma unroll
            for (int q = 0; q < 4; ++q) { const LAS float* sp = xscr + (8 * c) * 33 + (lane >> 3) + 8 * q;
                xo[q] = (v2u){pk4_fp8(32.f * sp[0 * 33], 32.f * sp[1 * 33], 32.f * sp[2 * 33], 32.f * sp[3 * 33]), pk4_fp8(32.f * sp[4 * 33], 32.f * sp[5 * 33], 32.f * sp[6 * 33], 32.f * sp[7 * 33])}; }
            xodst = xdst + (size_t)(lane >> 3) * 1024 + 8 * c; xout = true; xload = false;
        }
        m_old = mnew; dec_prev = dec;
        LBAR();
    }
    if (MODE == 0 && w < 6 && xout) {
#pragma unroll
        for (int q = 0; q < 4; ++q) *(GAS v2u*)(xodst + (size_t)(8 * q) * 1024) = xo[q]; }
    if (hpend) {
#pragma unroll
        for (int rg = 0; rg < 4; ++rg) *(v2u*)(hptr + 8 * rg) = hout[rg]; }
#undef ML_PREFETCH
}

__device__ __forceinline__ void s5_disc(const float* const* __restrict__ INP, int d, int g, int p, float& ar, float& ai, float& cfr, float& cfi) {
    const float dt = expf(INP[15][d * 32 + g]); const float are = INP[13][(d * 32 + g) * 64 + p], aim = INP[14][(d * 32 + g) * 64 + p];
    const float mag = expf(dt * are), ang = dt * aim; ar = mag * cosf(ang); ai = mag * sinf(ang);
    const float den = are * are + aim * aim, xr = ar - 1.0f; cfr = (xr * are + ai * aim) / den; cfi = (ai * are - xr * aim) / den;
}
__device__ __forceinline__ void p4_s5(Frame& F, const float* const* __restrict__ INP, int unit) {
    const int gp = unit & 15, b = (unit >> 4) & 7, d = unit >> 7;
    LAS bf16* BHt = (LAS bf16*)(F.lds + 0);
    LAS bf16* Cm = (LAS bf16*)(F.lds + 69632);
    LAS float* Eb = (LAS float*)(F.lds + 78336);
    LAS bf16* Us = (LAS bf16*)(F.lds + 82432);
    LAS bf16* BBs = (LAS bf16*)(F.lds + 92672);
    const bf16* PROJ = (const bf16*)(F.ws + WS_PROJ); bf16* YDIR = (bf16*)(F.ws + WS_YDIR) + (size_t)d * ML * 512;
    int tid = F.tid; asm volatile("" : "+v"(tid));
    const int lane = tid & 63, w = F.wave;
    const int sg = tid & 127, seg = tid >> 7;
    float ar, ai, a32r, a32i;
    { float cfr, cfi; s5_disc(INP, d, 2 * gp + (sg >> 6), sg & 63, ar, ai, cfr, cfi); a32r = ar; a32i = ai;
#pragma unroll
        for (int q = 0; q < 5; ++q) { const float nr = a32r * a32r - a32i * a32i, ni = 2.0f * a32r * a32i; a32r = nr; a32i = ni; } }
    for (int idx = tid; idx < 4096; idx += 512) {
        { const int gg = idx >> 11, pp = (idx >> 4) & 127, c = idx & 15, g = 2 * gp + gg, p = pp & 63; float xr_, xi_, cfr, cfi; s5_disc(INP, d, g, p, xr_, xi_, cfr, cfi);
            const float bre = INP[16][((size_t)(d * 32 + g) * 64 + p) * 16 + c], bim = INP[17][((size_t)(d * 32 + g) * 64 + p) * 16 + c];
            BBs[(gg * 128 + pp) * 24 + c] = (bf16)f2bf(pp < 64 ? cfr * bre - cfi * bim : cfr * bim + cfi * bre); }
        { const int gg = idx >> 11, c = (idx >> 7) & 15, pp = idx & 127, g = 2 * gp + gg, p = pp & 63;
            const float v = pp < 64 ? INP[18][((size_t)(d * 32 + g) * 16 + c) * 64 + p] : -INP[19][((size_t)(d * 32 + g) * 16 + c) * 64 + p];
            Cm[(gg * 16 + c) * 136 + pp] = (bf16)f2bf(v); }
    }
    float h0r = 0.f, h0i = 0.f;
    LAS bf16* rowre = BHt + ((sg >> 6) * 128 + (sg & 63)) * 136 + 32 * seg;
    v4u pu; v2u yout[2]; bf16* yptr[2]; bool ypend = false;
#define S5_PREFETCH(jn) do { const bool lat_ = (jn) >= 2; const int p0_ = lat_ ? 128 * ((jn) - 2) : 128 * (jn), L_ = lat_ ? SEQ : CTXL, rb_ = lat_ ? b * SEQ : ML + b * CTXL; \
        const int s_ = tid >> 2, c_ = tid & 3; const int tt = d ? (L_ - 1 - (p0_ + s_)) : (p0_ + s_); pu = *(const v4u*)(PROJ + (size_t)(rb_ + tt) * LDP + PC_U + gp * 32 + c_ * 8); } while (0)
    S5_PREFETCH(0);
    __syncthreads();
    for (int j = 0; j < 34; ++j) {
        const bool lat = j >= 2;
        const int p0 = lat ? 128 * (j - 2) : 128 * j, Lseq = lat ? SEQ : CTXL, rowbase = lat ? b * SEQ : ML + b * CTXL;
        *(LAS v4u*)(Us + (tid >> 2) * 40 + (tid & 3) * 8) = pu;
        LBAR();
        if (j + 1 < 34) S5_PREFETCH(j + 1);
        if (ypend) { *(v2u*)yptr[0] = yout[0]; *(v2u*)yptr[1] = yout[1]; ypend = false; }
        { const int gg = w >> 2, tm = w & 3, r = lane & 31, hh = lane >> 5;
            const bf16x8 a = *(const LAS bf16x8*)(Us + (32 * tm + r) * 40 + gg * 16 + 8 * hh);
            LAS bf16* bp = BHt + (gg * 128 + r) * 136 + 32 * tm + 4 * hh;
#pragma unroll
            for (int tn = 0; tn < 4; ++tn) { f32x16 acc;
#pragma unroll
                for (int reg = 0; reg < 16; ++reg) acc[reg] = 0.f;
                const bf16x8 bb = *(const LAS bf16x8*)(BBs + (gg * 128 + 32 * tn + r) * 24 + 8 * hh);
                acc = __builtin_amdgcn_mfma_f32_32x32x16_bf16(a, bb, acc, 0, 0, 0);
#pragma unroll
                for (int rg = 0; rg < 4; ++rg) *(LAS v2u*)(bp + 32 * tn * 136 + 8 * rg) = (v2u){cvtpk(acc[4 * rg], acc[4 * rg + 1]), cvtpk(acc[4 * rg + 2], acc[4 * rg + 3])}; } }
        LBAR();
        v4u xr[4], xi[4];
#pragma unroll
        for (int q = 0; q < 4; ++q) { xr[q] = *(const LAS v4u*)(rowre + 8 * q); xi[q] = *(const LAS v4u*)(rowre + 64 * 136 + 8 * q); }
        { float hr = 0.f, hi = 0.f;
#pragma unroll
            for (int q = 0; q < 4; ++q)
#pragma unroll
                for (int e = 0; e < 4; ++e) { const unsigned wr_ = xr[q][e], wi_ = xi[q][e];
                    { const float br = bflo(wr_), bi = bflo(wi_); const float nr = ar * hr - ai * hi + br, ni = ar * hi + ai * hr + bi; hr = nr; hi = ni; }
                    { const float br = bfhi(wr_), bi = bfhi(wi_); const float nr = ar * hr - ai * hi + br, ni = ar * hi + ai * hr + bi; hr = nr; hi = ni; } }
            Eb[(seg * 128 + sg) * 2] = hr; Eb[(seg * 128 + sg) * 2 + 1] = hi; }
        LBAR();
        { float hcr = h0r, hci = h0i, hr = 0.f, hi = 0.f;
#pragma unroll
            for (int s2 = 0; s2 < 4; ++s2) { if (s2 == seg) { hr = hcr; hi = hci; } const float er = Eb[(s2 * 128 + sg) * 2], ei = Eb[(s2 * 128 + sg) * 2 + 1];
                const float nr = a32r * hcr - a32i * hci + er, ni = a32r * hci + a32i * hcr + ei; hcr = nr; hci = ni; }
            h0r = hcr; h0i = hci;
#pragma unroll
            for (int q = 0; q < 4; ++q) { v4u orr, oi;
#pragma unroll
                for (int e = 0; e < 4; ++e) { const unsigned wr_ = xr[q][e], wi_ = xi[q][e]; float r0, i0, r1, i1;
                    { const float br = bflo(wr_), bi = bflo(wi_); const float nr = ar * hr - ai * hi + br, ni = ar * hi + ai * hr + bi; hr = nr; hi = ni; r0 = hr; i0 = hi; }
                    { const float br = bfhi(wr_), bi = bfhi(wi_); const float nr = ar * hr - ai * hi + br, ni = ar * hi + ai * hr + bi; hr = nr; hi = ni; r1 = hr; i1 = hi; }
                    orr[e] = cvtpk(r0, r1); oi[e] = cvtpk(i0, i1); }
                *(LAS v4u*)(rowre + 8 * q) = orr; *(LAS v4u*)(rowre + 64 * 136 + 8 * q) = oi; } }
        LBAR();
        if (lat) { const int gg = w >> 2;
#pragma unroll
            for (int jj = 0; jj < 2; ++jj) { const int tm = 2 * (w & 3) + jj; f32x4 acc = (f32x4){0.f, 0.f, 0.f, 0.f};
#pragma unroll
                for (int st4 = 0; st4 < 4; ++st4) { const bf16x8 af = *(const LAS bf16x8*)(Cm + (gg * 16 + (lane & 15)) * 136 + 32 * st4 + 8 * (lane >> 4));
                    const bf16x8 bfr = tr_frag16(BHt + gg * 128 * 136, 136, 32 * st4, 16 * tm, lane);
                    acc = __builtin_amdgcn_mfma_f32_16x16x32_bf16(af, bfr, acc, 0, 0, 0); }
                const int t = 16 * tm + (lane & 15); const int tt = d ? (Lseq - 1 - (p0 + t)) : (p0 + t);
                yptr[jj] = YDIR + (size_t)(rowbase + tt) * 512 + (2 * gp + gg) * 16 + 4 * (lane >> 4); yout[jj] = (v2u){pk2(acc[0], acc[1]), pk2(acc[2], acc[3])}; }
            ypend = true; }
    }
    if (ypend) { *(v2u*)yptr[0] = yout[0]; *(v2u*)yptr[1] = yout[1]; }
#undef S5_PREFETCH
    __syncthreads();
}

__device__ __forceinline__ float gelu_tanh(float x) { const float u = 0.7978845608028654f * (x + 0.044715f * x * x * x); const float e = __expf(2.0f * u); const float th = 1.0f - 2.0f * frcp(e + 1.0f); return 0.5f * x * (1.0f + th); }
__device__ __forceinline__ void p5a_prep(Frame& F, const float* const* __restrict__ INP) {
    const int gw = F.vcu * NWAVES + F.wave, NGW = F.G * NWAVES, lane = F.lane;
    const bf16* PROJ = (const bf16*)(F.ws + WS_PROJ); const bf16* HD0 = (const bf16*)(F.ws + WS_HDIR); const bf16* HD1 = HD0 + (size_t)ML * 1024;
    const bf16* YD0 = (const bf16*)(F.ws + WS_YDIR); const bf16* YD1 = YD0 + (size_t)ML * 512;
    bf16* A1 = (bf16*)(F.ws + WS_A1); bf16* A2 = (bf16*)(F.ws + WS_A2);
    for (int m0 = 2 * gw; m0 < ML; m0 += 2 * NGW) {
        v4u ha[2][2], hb[2][2], ho[2][2], ya[2], yb[2], yu[2];
#pragma unroll
        for (int r = 0; r < 2; ++r) { const size_t m = (size_t)(m0 + r);
#pragma unroll
            for (int q = 0; q < 2; ++q) { ha[r][q] = *(const v4u*)(HD0 + m * 1024 + 16 * lane + 8 * q); hb[r][q] = *(const v4u*)(HD1 + m * 1024 + 16 * lane + 8 * q); ho[r][q] = *(const v4u*)(PROJ + m * LDP + PC_O + 16 * lane + 8 * q); }
            ya[r] = *(const v4u*)(YD0 + m * 512 + 8 * lane); yb[r] = *(const v4u*)(YD1 + m * 512 + 8 * lane); yu[r] = *(const v4u*)(PROJ + m * LDP + PC_U + 8 * lane); }
        __builtin_amdgcn_sched_barrier(0);
#pragma unroll
        for (int r = 0; r < 2; ++r) { const size_t m = (size_t)(m0 + r);
            float hm[16]; float ss = 0.f;
#pragma unroll
            for (int q = 0; q < 2; ++q) { const v4u a = ha[r][q], bq = hb[r][q];
                hm[8 * q + 0] = bflo(a.x) + bflo(bq.x); hm[8 * q + 1] = bfhi(a.x) + bfhi(bq.x); hm[8 * q + 2] = bflo(a.y) + bflo(bq.y); hm[8 * q + 3] = bfhi(a.y) + bfhi(bq.y);
                hm[8 * q + 4] = bflo(a.z) + bflo(bq.z); hm[8 * q + 5] = bfhi(a.z) + bfhi(bq.z); hm[8 * q + 6] = bflo(a.w) + bflo(bq.w); hm[8 * q + 7] = bfhi(a.w) + bfhi(bq.w); }
#pragma unroll
            for (int q = 0; q < 16; ++q) ss += hm[q] * hm[q];
            ss += __shfl_xor(ss, 1); ss += __shfl_xor(ss, 2); ss += __shfl_xor(ss, 4);
            const float rs = 1.0f / sqrtf(ss * (1.0f / 128.0f) + EPS);
#pragma unroll
            for (int q = 0; q < 2; ++q) { const v4u o8 = ho[r][q]; const float* gm = INP[11] + 16 * lane + 8 * q;
                float rr[8]; const float og[8] = {bflo(o8.x), bfhi(o8.x), bflo(o8.y), bfhi(o8.y), bflo(o8.z), bfhi(o8.z), bflo(o8.w), bfhi(o8.w)};
#pragma unroll
                for (int e = 0; e < 8; ++e) rr[e] = hm[8 * q + e] * rs * gm[e] * sigmoidf_(og[e]);
                *(v2u*)((unsigned char*)A1 + m * 1024 + 16 * lane + 8 * q) = (v2u){pk4_fp8(rr[0], rr[1], rr[2], rr[3]), pk4_fp8(rr[4], rr[5], rr[6], rr[7])}; }
            { const v4u a = ya[r], bq = yb[r], u8 = yu[r]; const float* dd = INP[20] + 8 * lane;
                float rr[8] = {bflo(a.x) + bflo(bq.x) + dd[0] * bflo(u8.x), bfhi(a.x) + bfhi(bq.x) + dd[1] * bfhi(u8.x), bflo(a.y) + bflo(bq.y) + dd[2] * bflo(u8.y), bfhi(a.y) + bfhi(bq.y) + dd[3] * bfhi(u8.y),
                               bflo(a.z) + bflo(bq.z) + dd[4] * bflo(u8.z), bfhi(a.z) + bfhi(bq.z) + dd[5] * bfhi(u8.z), bflo(a.w) + bflo(bq.w) + dd[6] * bflo(u8.w), bfhi(a.w) + bfhi(bq.w) + dd[7] * bfhi(u8.w)};
#pragma unroll
                for (int e = 0; e < 8; ++e) rr[e] = gelu_tanh(rr[e]);
                *(v2u*)((unsigned char*)A2 + m * 512 + 8 * lane) = (v2u){pk4_fp8(rr[0], rr[1], rr[2], rr[3]), pk4_fp8(rr[4], rr[5], rr[6], rr[7])}; }
        }
    }
}

__device__ __forceinline__ void route_reduce_top4(float (&acc)[32], const float* br, int lane, float (&tv)[4], int (&ti)[4]) {
#pragma unroll
    for (int i = 0; i < 16; ++i) { const float send = (lane & 32) ? acc[i] : acc[i + 16]; const float keep = (lane & 32) ? acc[i + 16] : acc[i]; acc[i] = keep + __shfl_xor(send, 32); }
#pragma unroll
    for (int i = 0; i < 8; ++i) { const float send = (lane & 16) ? acc[i] : acc[i + 8]; const float keep = (lane & 16) ? acc[i + 8] : acc[i]; acc[i] = keep + __shfl_xor(send, 16); }
#pragma unroll
    for (int i = 0; i < 4; ++i) { const float send = (lane & 8) ? acc[i] : acc[i + 4]; const float keep = (lane & 8) ? acc[i + 4] : acc[i]; acc[i] = keep + __shfl_xor(send, 8); }
#pragma unroll
    for (int i = 0; i < 2; ++i) { const float send = (lane & 4) ? acc[i] : acc[i + 2]; const float keep = (lane & 4) ? acc[i + 2] : acc[i]; acc[i] = keep + __shfl_xor(send, 4); }
    { const float send = (lane & 2) ? acc[0] : acc[1]; const float keep = (lane & 2) ? acc[1] : acc[0]; acc[0] = keep + __shfl_xor(send, 2); }
    acc[0] += __shfl_xor(acc[0], 1);
    float val = acc[0] + br[lane >> 1];
    if (lane & 1) val = -INFINITY;
#pragma unroll
    for (int r = 0; r < 4; ++r) { float mx = val;
#pragma unroll
        for (int o = 1; o < 64; o <<= 1) mx = fmaxf(mx, __shfl_xor(mx, o));
        const unsigned long long bal = __ballot(val == mx); const int wl = __ffsll((long long)bal) - 1;
        tv[r] = mx; ti[r] = wl >> 1; if (lane == wl) val = -INFINITY; }
}
__device__ __forceinline__ void p6_route(Frame& F, const float* const* __restrict__ INP) {
    const bf16* X1 = (const bf16*)(F.ws + WS_X1); const float* mod = (const float*)(F.ws + WS_MOD); bf16* H2 = (bf16*)(F.ws + WS_H2);
    int* TOPE = (int*)(F.ws + WS_TOPE); int* POS = (int*)(F.ws + WS_POS); float* TOPP = (float*)(F.ws + WS_TOPP); int* LIST = (int*)(F.ws + WS_LIST);
    LAS float* Wt = (LAS float*)(F.lds);
    LAS int* pe = (LAS int*)(F.lds + LDSCTL_OFF + 1024); LAS int* hist = pe + 512; LAS int* base = hist + 32; LAS int* rank = base + 32;
    const float* wr = INP[26]; const float* br = INP[27];
    const int lane = F.lane, w = F.wave;
    for (int idx = F.tid; idx < 32768; idx += NWAVES * 64) { const int e = idx >> 10, k = idx & 1023; Wt[((((k >> 8) * 4 + (k & 3)) * 32 + e) << 6) + ((k >> 2) & 63)] = wr[k * 32 + e]; }
    __syncthreads();
    for (int tg = blockIdx.x; tg < ML / 128; tg += F.G) {
        if (F.tid < 32) hist[F.tid] = 0;
        __syncthreads();
#pragma unroll 1
        for (int q = 0; q < 16; q += 2) {
            const int tl = w * 16 + q, m = tg * 128 + tl, b = m / SEQ;
            const float* sh = mod + b * 6144 + 3 * D; const float* scl = sh + D;
            float s0 = 0.f, s1 = 0.f;
#pragma unroll
            for (int j = 0; j < 4; ++j) { const v2u w0 = *(const v2u*)(X1 + (size_t)m * D + 256 * j + 4 * lane), w1 = *(const v2u*)(X1 + (size_t)(m + 1) * D + 256 * j + 4 * lane);
                const f32x4 x0 = (f32x4){bflo(w0.x), bfhi(w0.x), bflo(w0.y), bfhi(w0.y)}, x1 = (f32x4){bflo(w1.x), bfhi(w1.x), bflo(w1.y), bfhi(w1.y)};
                s0 += (x0[0] * x0[0] + x0[1] * x0[1]) + (x0[2] * x0[2] + x0[3] * x0[3]); s1 += (x1[0] * x1[0] + x1[1] * x1[1]) + (x1[2] * x1[2] + x1[3] * x1[3]); }
            const float r0 = 1.0f / sqrtf(wave_sum(s0) * (1.0f / D) + EPS), r1 = 1.0f / sqrtf(wave_sum(s1) * (1.0f / D) + EPS);
            float a0[32], a1[32];
#pragma unroll
            for (int e = 0; e < 32; ++e) { a0[e] = 0.f; a1[e] = 0.f; }
#pragma unroll 1
            for (int j = 0; j < 4; ++j) { const int c = 256 * j + 4 * lane; const f32x4 g = *(const f32x4*)(INP[7] + c), a = *(const f32x4*)(scl + c), bb = *(const f32x4*)(sh + c);
                const v2u w0 = *(const v2u*)(X1 + (size_t)m * D + c), w1 = *(const v2u*)(X1 + (size_t)(m + 1) * D + c);
                const f32x4 x0 = (f32x4){bflo(w0.x), bfhi(w0.x), bflo(w0.y), bfhi(w0.y)}, x1 = (f32x4){bflo(w1.x), bfhi(w1.x), bflo(w1.y), bfhi(w1.y)};
                const f32x4 gs = g * (a + 1.0f); const f32x4 y0 = x0 * r0 * gs + bb, y1 = x1 * r1 * gs + bb;
                *(unsigned*)((unsigned char*)H2 + (size_t)m * D + c) = pk4_fp8(y0[0], y0[1], y0[2], y0[3]); *(unsigned*)((unsigned char*)H2 + (size_t)(m + 1) * D + c) = pk4_fp8(y1[0], y1[1], y1[2], y1[3]);
                const LAS float* wj = Wt + j * 8192 + lane;
#pragma unroll
                for (int qq = 0; qq < 4; ++qq) { const LAS float* wp = wj + qq * 2048; const float ya = y0[qq], yb = y1[qq];
#pragma unroll
                    for (int e = 0; e < 32; ++e) { const float wv = wp[e * 64]; a0[e] += ya * wv; a1[e] += yb * wv; }
                    asm volatile("" ::: "memory"); } }
            float tv[4]; int ti[4];
#pragma unroll
            for (int tk = 0; tk < 2; ++tk) {
                if (tk == 0) route_reduce_top4(a0, br, lane, tv, ti); else route_reduce_top4(a1, br, lane, tv, ti);
                const float e1 = __expf(tv[1] - tv[0]), e2 = __expf(tv[2] - tv[0]), e3 = __expf(tv[3] - tv[0]); const float inv = 1.0f / (1.0f + e1 + e2 + e3);
                if (lane < 4) { const float p = lane == 0 ? inv : (lane == 1 ? e1 * inv : (lane == 2 ? e2 * inv : e3 * inv)); const int ee = lane == 0 ? ti[0] : (lane == 1 ? ti[1] : (lane == 2 ? ti[2] : ti[3]));
                    TOPP[(m + tk) * 4 + lane] = p; TOPE[(m + tk) * 4 + lane] = ee; pe[(tl + tk) * 4 + lane] = ee; }
            }
        }
        __syncthreads();
        { const int e = pe[F.tid]; rank[F.tid] = __hip_atomic_fetch_add(&hist[e], 1, __ATOMIC_RELAXED, __HIP_MEMORY_SCOPE_WORKGROUP); }
        __syncthreads();
        if (F.tid < 32) base[F.tid] = (int)__hip_atomic_fetch_add(F.ctl + CW_CNT + 64 * F.tid, (unsigned)hist[F.tid], RLX_AGENT);
        __syncthreads();
        { const int e = pe[F.tid]; const int pos = base[e] + rank[F.tid]; const int m = tg * 128 + (F.tid >> 2); LIST[e * ML + pos] = m; POS[m * 4 + (F.tid & 3)] = pos; }
        __syncthreads();
    }
}

typedef int i32x4 __attribute__((ext_vector_type(4)));
__device__ __forceinline__ void p10_combine(Frame& F, const float* const* __restrict__ INP) {
    moe_tables(F);
    const LAS int* tab = (const LAS int*)(F.lds + TAB_OFF);
    const bf16* X1 = (const bf16*)(F.ws + WS_X1); float* OUT = F.out; const float* mod = (const float*)(F.ws + WS_MOD); const unsigned char* Y = (const unsigned char*)(F.ws + WS_Y);
    const int* TOPE = (const int*)(F.ws + WS_TOPE); const int* POS = (const int*)(F.ws + WS_POS); const float* TOPP = (const float*)(F.ws + WS_TOPP);
    const int gw = F.vcu * NWAVES + F.wave, NGW = F.G * NWAVES, lane = F.lane;
    i32x4 te[2], tp[2]; f32x4 tw[2];
    int m0 = 2 * gw;
    if (m0 < ML) {
#pragma unroll
        for (int r = 0; r < 2; ++r) { te[r] = *(const i32x4*)(TOPE + (m0 + r) * 4); tp[r] = *(const i32x4*)(POS + (m0 + r) * 4); tw[r] = *(const f32x4*)(TOPP + (m0 + r) * 4); } }
    for (; m0 < ML; m0 += 2 * NGW) {
        unsigned yv[2][4][4]; v2u xv[2][4];
#pragma unroll
        for (int r = 0; r < 2; ++r) {
#pragma unroll
            for (int k = 0; k < 4; ++k) { const size_t slot = (size_t)256 * tab[te[r][k]] + tp[r][k];
#pragma unroll
                for (int j = 0; j < 4; ++j) yv[r][k][j] = *(const unsigned*)(Y + slot * 1024 + 256 * j + 4 * lane); }
#pragma unroll
            for (int j = 0; j < 4; ++j) xv[r][j] = *(const v2u*)(X1 + (size_t)(m0 + r) * D + 256 * j + 4 * lane); }
        const f32x4 cw[2] = {tw[0], tw[1]};
        const int mn = m0 + 2 * NGW;
        if (mn < ML) {
#pragma unroll
            for (int r = 0; r < 2; ++r) { te[r] = *(const i32x4*)(TOPE + (mn + r) * 4); tp[r] = *(const i32x4*)(POS + (mn + r) * 4); tw[r] = *(const f32x4*)(TOPP + (mn + r) * 4); } }
        __builtin_amdgcn_sched_barrier(0);
#pragma unroll
        for (int r = 0; r < 2; ++r) { const int m = m0 + r, b = m / SEQ; const float* gt2 = mod + b * 6144 + 5 * D;
            f32x4 v[4]; float s = 0.f;
#pragma unroll
            for (int j = 0; j < 4; ++j) { const int c = 256 * j + 4 * lane; f32x4 mo = (f32x4){0.f, 0.f, 0.f, 0.f};
#pragma unroll
                for (int k = 0; k < 4; ++k) { const unsigned y = yv[r][k][j]; const auto lo = __builtin_amdgcn_cvt_pk_f32_fp8((int)y, false), hi = __builtin_amdgcn_cvt_pk_f32_fp8((int)y, true);
                    mo += (f32x4){lo[0], lo[1], hi[0], hi[1]} * (cw[r][k] * 0.0625f); }
                const v2u xw = xv[r][j]; v[j] = (f32x4){bflo(xw.x), bfhi(xw.x), bflo(xw.y), bfhi(xw.y)} + *(const f32x4*)(gt2 + c) * mo;
                s += (v[j][0] * v[j][0] + v[j][1] * v[j][1]) + (v[j][2] * v[j][2] + v[j][3] * v[j][3]); }
            const float rstd = 1.0f / sqrtf(wave_sum(s) * (1.0f / D) + EPS);
#pragma unroll
            for (int j = 0; j < 4; ++j) { const int c = 256 * j + 4 * lane; *(f32x4*)(OUT + (size_t)m * D + c) = v[j] * rstd * *(const f32x4*)(INP[32] + c); }
        }
    }
}

struct Args { const float* in[33]; float* out; unsigned char* ws; int ph_lo, ph_hi, li, pad; };
__global__ void __launch_bounds__(NWAVES * 64, 2) fwd_kernel(Args args) {
    extern __shared__ __attribute__((aligned(16))) unsigned char lds[];
    Frame F;
    F.lds = (LAS unsigned char*)lds;
    F.tid = threadIdx.x; F.lane = F.tid & 63; F.wave = __builtin_amdgcn_readfirstlane(F.tid >> 6);
    F.G = gridDim.x; { const int bx = blockIdx.x; F.vcu = (F.G % 8 == 0) ? (bx % 8) * (F.G / 8) + bx / 8 : bx; }
    F.ws = args.ws; F.ctl = (gu32*)(args.ws + WS_CTL); F.out = args.out;
    for (int u = F.tid; u < (LDS_BYTES - LDSCTL_OFF) / 4; u += NWAVES * 64) ((LAS unsigned*)(F.lds + LDSCTL_OFF))[u] = 0u;
    __syncthreads();
    XcdBarrier bar; bar.bar = (unsigned*)(F.ctl + CW_BAR); bar.x = 0; bar.st = nullptr;
    if (N_LAUNCHES == 1) bar = xcd_barrier_post((unsigned*)(F.ctl + CW_BAR), (volatile LAS unsigned*)(F.lds + MISC_OFF) + 8);
    const int lo = args.ph_lo, hi = args.ph_hi;
    const float* const* __restrict__ INP = args.in;
#ifndef PH_MASK
#define PH_MASK 0x3fff
#endif
#define IN(k) ((((PH_MASK) >> (k)) & 1) && lo <= (k) && (k) < hi)
#define SEAM(k) do { if (IN(k) && IN((k) + 1)) xcd_barrier(bar); } while (0)
    const bf16* WIN = (const bf16*)(F.ws + WS_WIN);

    if (IN(0)) { p0_prologue(F, INP); } SEAM(0);
    if (IN(1)) { p1_norm1(F, INP); } SEAM(1);
    if (IN(2)) {
        pg8::Gemm g{(const bf16*)(F.ws + WS_H1), WIN, 512, nullptr, 0x7f7f7f7f, 0x7a7a7a7a}; InProjOrder S{F.G, (int)blockIdx.x};
        EpiStore E{(bf16*)(F.ws + WS_PROJ), LDP};
        pg8::gemm_phase<EpiStore, InProjOrder, false, true>(F.lds, g, S, E);
    } SEAM(2);
    if (IN(3)) { p3_conv(F, INP); } SEAM(3);
    if (IN(4)) { for (int u = blockIdx.x; u < 256; u += F.G) { p4_mlstm<0>(F, INP, u); if (P4_REP_M > 1) p4_mlstm<P4_MODE>(F, INP, u); for (int r_ = 0; r_ < P4_REP_S; ++r_) p4_s5(F, INP, u); } } SEAM(4);
    if (IN(5)) { p5a_prep(F, INP); } SEAM(5);
    if (IN(6)) {
        pg8::Gemm g{(const bf16*)(F.ws + WS_A2), (const bf16*)(F.ws + WS_WGLU), 256, nullptr, 0x7f7f7f7f, 0x7a7a7a7a}; pg8::StaticOrder S; S.init(ML, 512, F.G, (int)blockIdx.x);
        EpiGlu E{(const bf16*)(F.ws + WS_A2), (bf16*)(F.ws + WS_A3), INP[22]};
        pg8::gemm_phase<EpiGlu, pg8::StaticOrder, false, true>(F.lds, g, S, E);
    }
    if (IN(7)) {
        pg8::Gemm g{(const bf16*)(F.ws + WS_A1), (const bf16*)(F.ws + WS_WA), 512, nullptr, 0x7f7f7f7f, 0x7a7a7a7a}; pg8::StaticOrder S; S.init(ML, 1024, F.G, (int)blockIdx.x);
        EpiGate<false> E{(const bf16*)(F.ws + WS_PROJ), PC_G, INP[24], nullptr, (bf16*)(F.ws + WS_YA)};
        pg8::gemm_phase<EpiGate<false>, pg8::StaticOrder, false, true>(F.lds, g, S, E);
    } SEAM(7);
    if (IN(8)) {
        pg8::Gemm g{(const bf16*)(F.ws + WS_A3), (const bf16*)(F.ws + WS_WB), 256, nullptr, 0x7f7f7f7f, 0x7a7a7a7a}; pg8::StaticOrder S; S.init(ML, 1024, F.G, (int)blockIdx.x);
        EpiGate<true> E{(const bf16*)(F.ws + WS_PROJ), PC_G + 1024, INP[24] + 1024, (const bf16*)(F.ws + WS_YA), (bf16*)(F.ws + WS_MERGED)};
        pg8::gemm_phase<EpiGate<true>, pg8::StaticOrder, false, true>(F.lds, g, S, E);
    } SEAM(8);
    if (IN(9)) {
        pg8::Gemm g{(const bf16*)(F.ws + WS_MERGED), (const bf16*)(F.ws + WS_WO), 512, nullptr, 0x7d7d7d7d, 0x7a7a7a7a}; pg8::StaticOrder S; S.init(ML, 1024, F.G, (int)blockIdx.x);
        EpiX1 E{INP[0], (const float*)(F.ws + WS_MOD), (bf16*)(F.ws + WS_X1)};
        pg8::gemm_phase<EpiX1, pg8::StaticOrder, false, true>(F.lds, g, S, E);
    } SEAM(9);
    if (IN(10)) { p6_route(F, INP); } SEAM(10);
    if (IN(11)) {
        moe_tables(F);
        MoeOrder S{F.G, (int)blockIdx.x, 8, (const LAS int*)(F.lds + TAB_OFF)};
        LAS unsigned short* ridx = (LAS unsigned short*)(F.lds + LDSCTL_OFF + 1024);
        { const int* LIST = (const int*)(F.ws + WS_LIST);
            for (int i = 0; i < 30; ++i) { pg8::Unit u; if (!S.next(i, u)) break;
                if (F.tid < 256) { const int rc = F.tid < u.nvalid ? F.tid : u.nvalid - 1; ridx[i * 256 + F.tid] = (unsigned short)LIST[u.lbase + rc]; } }
            __syncthreads(); }
        pg8::Gemm g{(const bf16*)(F.ws + WS_H2), (const bf16*)(F.ws + WS_WEIN), 512, ridx, 0x7f7f7f7f, 0x7a7a7a7a};
        EpiSwiglu E{INP[29], (bf16*)(F.ws + WS_ACT)};
        pg8::gemm_phase<EpiSwiglu, MoeOrder, true, true>(F.lds, g, S, E);
    } SEAM(11);
    if (IN(12)) {
        moe_tables(F);
        pg8::Gemm g{(const bf16*)(F.ws + WS_ACT), (const bf16*)(F.ws + WS_WEOUT), 512, nullptr, 0x7c7c7c7c, 0x7a7a7a7a}; MoeOrder S{F.G, (int)blockIdx.x, 4, (const LAS int*)(F.lds + TAB_OFF)};
        EpiY E{INP[31], (bf16*)(F.ws + WS_Y)};
        pg8::gemm_phase<EpiY, MoeOrder, false, true>(F.lds, g, S, E);
    } SEAM(12);
    if (IN(13)) { p10_combine(F, INP); }
#undef IN
#undef SEAM
}

extern "C" void kernel_launch(void* const* d_in, const int* in_sizes, int n_in, void* d_out, int out_size, void* d_ws, size_t ws_size, hipStream_t stream) {
    static int grid = 0;
    if (grid == 0) {
        if (n_in != 33 || out_size != ML * D || ws_size < WS_END2) { fprintf(stderr, "kernel_launch: unexpected shapes (n_in %d, out %d, ws %zu)\n", n_in, out_size, ws_size); grid = -1; return; }
        int dev = 0, cus = 0, per_cu = 0;
        if (hipGetDevice(&dev) != hipSuccess || hipDeviceGetAttribute(&cus, hipDeviceAttributeMultiprocessorCount, dev) != hipSuccess) { grid = -1; return; }
        if (hipFuncSetAttribute((const void*)fwd_kernel, hipFuncAttributeMaxDynamicSharedMemorySize, LDS_BYTES) != hipSuccess) { fprintf(stderr, "kernel_launch: hipFuncSetAttribute failed\n"); grid = -1; return; }
        if (hipOccupancyMaxActiveBlocksPerMultiprocessor(&per_cu, (const void*)fwd_kernel, NWAVES * 64, LDS_BYTES) != hipSuccess || per_cu < 1) fprintf(stderr, "kernel_launch: occupancy query reports %d\n", per_cu);
        (void)hipGetLastError();
        grid = cus;
    }
    if (grid < 0) return;
    if (hipMemsetAsync((char*)d_ws + WS_CTL, 0, CTL_ZERO_BYTES, stream) != hipSuccess) return;
    Args a{};
    for (int i = 0; i < 33; ++i) a.in[i] = (const float*)d_in[i];
    a.out = (float*)d_out; a.ws = (unsigned char*)d_ws;
    for (int li = 0; li < N_LAUNCHES; ++li) {
        a.ph_lo = (N_LAUNCHES == 1) ? 0 : li; a.ph_hi = (N_LAUNCHES == 1) ? NPH : li + 1; a.li = li;
        const int nrep = (N_LAUNCHES != 1 && (((PROBE_DUP_MASK) >> li) & 1)) ? 2 : 1;
        for (int r = 0; r < nrep; ++r) hipLaunchKernelGGL(fwd_kernel, dim3(grid), dim3(NWAVES * 64), LDS_BYTES, stream, a);
    }
}
```

```cpp
#include <hip/hip_runtime.h>
#include <cstdio>
#include <cstdint>

#ifndef MK_N_LAUNCHES
#define MK_N_LAUNCHES 1
#endif
#ifndef PROBE_DUP_MASK
#define PROBE_DUP_MASK 0
#endif
#ifndef P4_REP_M
#define P4_REP_M 1
#endif
#ifndef P4_MODE
#define P4_MODE 0
#endif
#ifndef P4_REP_S
#define P4_REP_S 1
#endif

namespace pg8 {
#define PG8_LAS __attribute__((address_space(3)))
typedef unsigned short bf16_t;
typedef short bf16x8 __attribute__((ext_vector_type(8)));
typedef float f32x4 __attribute__((ext_vector_type(4)));
typedef unsigned u32x4 __attribute__((ext_vector_type(4)));
constexpr int BM = 256, BK = 64, HALF = 128, HTB = HALF * BK * 2, STAGE_BYTES = 8 * HTB, NXCD = 8, WGM = 8;

__host__ __device__ __forceinline__ int lds_byte(int r, int c) { const int st = (r >> 4) * 2 + (c >> 5), rr = r & 15, cc = c & 31, ob = rr * 64 + cc * 2; return st * 1024 + (ob ^ (((ob >> 9) & 1) << 5)); }
__host__ __device__ __forceinline__ void stage_rc(int b, int& R, int& C) { const int st = b / 1024, sb = b % 1024, swz = sb ^ (((sb >> 9) & 1) << 5); R = (st >> 1) * 16 + swz / 64; C = (st & 1) * 32 + (swz % 64) / 2; }
__host__ __device__ __forceinline__ int perm32(int rho) { const int n = rho >> 4, i = rho & 15; return 8 * (i >> 2) + 4 * n + (i & 3); }

struct Unit { int pm, pn, lbase, nvalid; };
struct Gemm { const bf16_t* A; const bf16_t* Bt; int K; const PG8_LAS unsigned short* ridx; int sa, sb; };

__device__ __forceinline__ int xcd_remap(int L, int nwg) { const int q = nwg / NXCD, r = nwg % NXCD, xcd = L % NXCD, off = L / NXCD; return (xcd < r ? xcd * (q + 1) : r * (q + 1) + (xcd - r) * q) + off; }

struct StaticOrder {
    int nM, nN, nwg, G, c;
    __device__ void init(int M, int N, int G_, int c_) { nM = M / BM; nN = N / BM; nwg = nM * nN; G = G_; c = c_; }
    __device__ __forceinline__ bool next(int i, Unit& u) const {
        const long L = (long)i * G + c; if (L >= nwg) return false;
        const int wgid = xcd_remap((int)L, nwg);
        const int nig = WGM * nN, gid = wgid / nig, fm = gid * WGM, gsz = (nM - fm) < WGM ? (nM - fm) : WGM;
        u.pm = fm + ((wgid % nig) % gsz); u.pn = (wgid % nig) / gsz; u.lbase = 0; u.nvalid = 0; return true;
    }
};

__device__ __forceinline__ unsigned cvt_pk_bf16(float lo, float hi) { unsigned r; asm volatile("v_cvt_pk_bf16_f32 %0, %1, %2" : "=v"(r) : "v"(lo), "v"(hi)); return r; }

typedef int v8i __attribute__((ext_vector_type(8)));
typedef short s16x16 __attribute__((ext_vector_type(16)));
template <class Epi, class Sched, bool GATHER, bool FP8 = false>
__device__ __forceinline__ void gemm_phase(PG8_LAS unsigned char* lds, const Gemm g, const Sched& S, const Epi& E) {
    const int tid = threadIdx.x, wid = __builtin_amdgcn_readfirstlane(tid >> 6), lane = tid & 63, wr = wid >> 2, wc = wid & 3, fr = lane & 15, fq = lane >> 4;
    const int K = g.K, nt = K / BK;
    int Rr[2]; unsigned cby[2], voffB[2];
#pragma unroll
    for (int i = 0; i < 2; ++i) { int R, C; stage_rc(tid * 16 + i * 8192, R, C); const int Rb = Epi::PERM ? ((R & ~31) + perm32(R & 31)) : R;
        Rr[i] = R; cby[i] = (unsigned)C * 2u; voffB[i] = (unsigned)(Rb * K + C) * 2u; }
    const size_t kstep = (size_t)(BK * 2);
    const size_t hstep = (size_t)HALF * K * 2;
    const size_t tstep = 2 * hstep;
    const unsigned ldsw = (unsigned)wid * 1024u;
    const int aoff = lds_byte(wr * 64 + fr, FP8 ? fq * 16 : fq * 8), boff = lds_byte(wc * 32 + fr, FP8 ? fq * 16 : fq * 8);

#define PG8_SA(b, h) (((b) * 2 + (h)) * HTB)
#define PG8_SB(b, h) ((4 + (b) * 2 + (h)) * HTB)
#define PG8_STAGE(bufoff, gbase, voff) do { _Pragma("unroll") for (int _i = 0; _i < 2; ++_i) \
        __builtin_amdgcn_global_load_lds((const unsigned*)((const char*)(gbase) + (voff)[_i]), (PG8_LAS unsigned*)(lds + (bufoff) + ldsw + _i * 8192), 16, 0, 0); } while (0)
#define PG8_LDA(dst, b, h) do { if constexpr (FP8) { _Pragma("unroll") for (int m = 0; m < 4; ++m) { const bf16x8 _lo = *(const PG8_LAS bf16x8*)(lds + PG8_SA(b, h) + aoff + m * 2048), _hi = *(const PG8_LAS bf16x8*)(lds + PG8_SA(b, h) + aoff + m * 2048 + 16); dst##8[m] = __builtin_bit_cast(v8i, __builtin_shufflevector(_lo, _hi, 0, 1, 2, 3, 4, 5, 6, 7, 8, 9, 10, 11, 12, 13, 14, 15)); } } \
        else { _Pragma("unroll") for (int m = 0; m < 4; ++m) _Pragma("unroll") for (int k = 0; k < 2; ++k) dst[m][k] = *(const PG8_LAS bf16x8*)(lds + PG8_SA(b, h) + aoff + m * 2048 + k * 1024); } } while (0)
#define PG8_LDB(dst, b, h) do { if constexpr (FP8) { _Pragma("unroll") for (int n = 0; n < 2; ++n) { const bf16x8 _lo = *(const PG8_LAS bf16x8*)(lds + PG8_SB(b, h) + boff + n * 2048), _hi = *(const PG8_LAS bf16x8*)(lds + PG8_SB(b, h) + boff + n * 2048 + 16); dst##8[n] = __builtin_bit_cast(v8i, __builtin_shufflevector(_lo, _hi, 0, 1, 2, 3, 4, 5, 6, 7, 8, 9, 10, 11, 12, 13, 14, 15)); } } \
        else { _Pragma("unroll") for (int n = 0; n < 2; ++n) _Pragma("unroll") for (int k = 0; k < 2; ++k) dst[n][k] = *(const PG8_LAS bf16x8*)(lds + PG8_SB(b, h) + boff + n * 2048 + k * 1024); } } while (0)
#define PG8_MMA(ai, bj, At, Bt) do { __builtin_amdgcn_s_setprio(1); _Pragma("unroll") for (int m = 0; m < 4; ++m) _Pragma("unroll") for (int n = 0; n < 2; ++n) { \
        if constexpr (FP8) asm volatile("v_mfma_scale_f32_16x16x128_f8f6f4 %0, %1, %2, %0, %3, %4 op_sel_hi:[0,0,0]" : "+v"(acc[ai][bj][m][n]) : "v"(Bt##8[n]), "v"(At##8[m]), "v"(vsb), "v"(vsa));   \
        else { _Pragma("unroll") for (int k = 0; k < 2; ++k) acc[ai][bj][m][n] = __builtin_amdgcn_mfma_f32_16x16x32_bf16(Bt[n][k], At[m][k], acc[ai][bj][m][n], 0, 0, 0); } } \
        __builtin_amdgcn_s_setprio(0); } while (0)
#define PG8_WAIT_V(n) asm volatile("s_waitcnt vmcnt(" #n ")" ::: "memory")
#define PG8_WAIT_L(n) asm volatile("s_waitcnt lgkmcnt(" #n ")" ::: "memory")
#define PG8_BAR __builtin_amdgcn_s_barrier()
#define PG8_SCHED __builtin_amdgcn_sched_barrier(0)
#define PG8_AOFF(dst, u, uord) do { _Pragma("unroll") for (int _h = 0; _h < 2; ++_h) _Pragma("unroll") for (int _i = 0; _i < 2; ++_i) { const int _r = _h * HALF + Rr[_i]; \
        if constexpr (GATHER) { const int _idx = g.ridx[(uord) * 256 + _r]; dst[_h][_i] = (unsigned)_idx * (unsigned)(K * 2) + cby[_i]; } \
        else { dst[_h][_i] = (unsigned)(_r * K * 2) + cby[_i]; } } } while (0)
    Unit cur, nxt; int ui = 0;
    if (!S.next(0, cur)) return;
    f32x4 acc[2][2][4][2];
#pragma unroll
    for (int a = 0; a < 2; ++a)
#pragma unroll
        for (int b = 0; b < 2; ++b)
#pragma unroll
            for (int m = 0; m < 4; ++m)
#pragma unroll
                for (int n = 0; n < 2; ++n) acc[a][b][m][n] = (f32x4){0.f, 0.f, 0.f, 0.f};
    const int vsa = g.sa, vsb = g.sb;
    bf16x8 At[4][2], B0[2][2], B1[2][2];
    v8i At8[4], B08[2], B18[2];
    unsigned vc[2][2], vn[2][2];
    PG8_AOFF(vc, cur, 0);
    const char* cA = GATHER ? (const char*)g.A : (const char*)g.A + (size_t)cur.pm * tstep; const char* cB = (const char*)g.Bt + (size_t)cur.pn * tstep;
    PG8_STAGE(PG8_SB(0, 0), cB, voffB); PG8_STAGE(PG8_SB(0, 1), cB + hstep, voffB); PG8_STAGE(PG8_SA(0, 0), cA, vc[0]); PG8_STAGE(PG8_SA(0, 1), cA, vc[1]);
    if (wr == 1) PG8_BAR;
    PG8_WAIT_V(2); PG8_BAR;
    PG8_STAGE(PG8_SB(1, 0), cB + kstep, voffB); PG8_STAGE(PG8_SA(1, 0), cA + kstep, vc[0]); PG8_STAGE(PG8_SB(1, 1), cB + hstep + kstep, voffB);
    PG8_WAIT_V(6); PG8_BAR;
    for (;;) {
        const bool has_next = S.next(ui + 1, nxt);
        const char* nA = (has_next && !GATHER) ? (const char*)g.A + (size_t)nxt.pm * tstep : cA; const char* nB = has_next ? (const char*)g.Bt + (size_t)nxt.pn * tstep : cB;
        if constexpr (GATHER) { if (has_next) { PG8_AOFF(vn, nxt, ui + 1); } else {
#pragma unroll
            for (int h = 0; h < 2; ++h) { vn[h][0] = vc[h][0]; vn[h][1] = vc[h][1]; } } }
#pragma unroll 1
        for (int t = 0; t < nt; t += 2) {
            const bool last = (t == nt - 2);
            const char* a1 = cA + (size_t)(t + 1) * kstep;
            const char* a2 = last ? nA : cA + (size_t)(t + 2) * kstep; const char* b2 = last ? nB : cB + (size_t)(t + 2) * kstep;
            const char* a3 = a2 + kstep; const char* b3 = b2 + kstep;
            unsigned v2[2][2];
#pragma unroll
            for (int h = 0; h < 2; ++h)
#pragma unroll
                for (int i = 0; i < 2; ++i) v2[h][i] = GATHER ? (last ? vn[h][i] : vc[h][i]) : vc[h][i];
            PG8_LDB(B0, 0, 0); PG8_LDB(B1, 0, 1); PG8_SCHED; PG8_LDA(At, 0, 0); PG8_STAGE(PG8_SA(1, 1), a1, vc[1]);
            PG8_WAIT_V(8); PG8_WAIT_L(0); PG8_BAR; PG8_MMA(0, 0, At, B0); PG8_MMA(0, 1, At, B1); PG8_BAR; PG8_SCHED;
            PG8_LDA(At, 0, 1); PG8_STAGE(PG8_SB(0, 0), b2, voffB); PG8_STAGE(PG8_SB(0, 1), b2 + hstep, voffB); PG8_STAGE(PG8_SA(0, 0), a2, v2[0]);
            PG8_WAIT_V(8); PG8_WAIT_L(0); PG8_BAR; PG8_MMA(1, 0, At, B0); PG8_MMA(1, 1, At, B1); PG8_BAR; PG8_SCHED;
            PG8_LDB(B0, 1, 0); PG8_LDB(B1, 1, 1); PG8_SCHED; PG8_LDA(At, 1, 0); PG8_STAGE(PG8_SA(0, 1), a2, v2[1]);
            PG8_WAIT_V(8); PG8_WAIT_L(0); PG8_BAR; PG8_MMA(0, 0, At, B0); PG8_MMA(0, 1, At, B1); PG8_BAR; PG8_SCHED;
            PG8_LDA(At, 1, 1); PG8_STAGE(PG8_SB(1, 0), b3, voffB); PG8_STAGE(PG8_SB(1, 1), b3 + hstep, voffB); PG8_STAGE(PG8_SA(1, 0), a3, v2[0]);
            PG8_WAIT_V(8); PG8_WAIT_L(0); PG8_BAR; PG8_MMA(1, 0, At, B0); PG8_MMA(1, 1, At, B1); PG8_BAR; PG8_SCHED;
        }
        if (wr == 0) PG8_BAR;
        if constexpr (FP8) asm volatile("s_nop 15\n\ts_nop 15" ::: "memory");
        E(acc, cur, wr, wc, fr, fq);
        if (!has_next) break;
#pragma unroll
        for (int a = 0; a < 2; ++a)
#pragma unroll
            for (int b = 0; b < 2; ++b)
#pragma unroll
                for (int m = 0; m < 4; ++m)
#pragma unroll
                    for (int n = 0; n < 2; ++n) acc[a][b][m][n] = (f32x4){0.f, 0.f, 0.f, 0.f};
        cur = nxt; cA = nA; cB = nB; ++ui;
        if constexpr (GATHER) {
#pragma unroll
            for (int h = 0; h < 2; ++h) { vc[h][0] = vn[h][0]; vc[h][1] = vn[h][1]; } }
        if (wr == 1) PG8_BAR;
    }
    PG8_WAIT_V(0);
    PG8_BAR;
#undef PG8_SA
#undef PG8_SB
#undef PG8_STAGE
#undef PG8_LDA
#undef PG8_LDB
#undef PG8_MMA
#undef PG8_WAIT_V
#undef PG8_WAIT_L
#undef PG8_BAR
#undef PG8_SCHED
#undef PG8_AOFF
}
}

constexpr int NWAVES = 8;
constexpr int D = 1024, NB = 8, SEQ = 4096, CTXL = 256;
constexpr int ML = NB * SEQ, MC = NB * CTXL, MT = ML + MC;
constexpr int LDP = 5888;
constexpr int PC_QK = 0, PC_V = 1024, PC_U = 2048, PC_O = 2560, PC_G = 3584, PC_IF = 5632;
constexpr int NEXP = 32, TOPK = 4;
constexpr int MAXTILES = (ML * TOPK + NEXP * 256) / 256;
constexpr float EPS = 1e-6f;
constexpr int NPH = 14;
constexpr int N_LAUNCHES = MK_N_LAUNCHES;

constexpr size_t MiB = 1u << 20;
constexpr size_t WS_CTL = 0, CTL_ZERO_BYTES = 1 * MiB;
constexpr size_t WS_MOD = 1 * MiB;
constexpr size_t WS_TOPE = 2 * MiB, WS_POS = 2 * MiB + 512 * 1024, WS_TOPP = 3 * MiB, WS_LIST = 4 * MiB;
constexpr size_t WS_WIN = 8 * MiB, WS_WGLU = 20 * MiB, WS_WA = 21 * MiB, WS_WB = 23 * MiB, WS_WO = 24 * MiB, WS_WEIN = 26 * MiB, WS_WEOUT = 90 * MiB, WS_PROJ8 = 122 * MiB;
constexpr size_t WS_R0 = 218 * MiB;
constexpr size_t WS_PROJ = WS_R0, WS_H1 = 609 * MiB, WS_QKC = 677 * MiB, WS_HDIR = 745 * MiB, WS_YDIR = 873 * MiB, WS_END = 937 * MiB;
constexpr size_t WS_A1 = WS_H1, WS_A2 = WS_QKC, WS_A3 = WS_QKC + 32 * MiB, WS_YA = WS_HDIR, WS_MERGED = WS_HDIR + 64 * MiB;
constexpr size_t WS_GS = 940 * MiB, WS_X1 = 940 * MiB, WS_END2 = 1004 * MiB;
constexpr size_t WS_H2 = WS_R0, WS_ACT = 282 * MiB, WS_Y = 554 * MiB;
static_assert(WS_PROJ + (size_t)MT * LDP * 2 <= WS_H1 && WS_Y + (size_t)MAXTILES * 256 * 1024 * 2 <= WS_END, "ws map");
constexpr int CW_BAR = 4096, CW_CNT = 16384;

constexpr int RING_BYTES = 131072;
constexpr int LDSCTL_OFF = RING_BYTES, MISC_OFF = LDSCTL_OFF + 320, TAB_OFF = LDSCTL_OFF + 512;
constexpr int LDS_BYTES = 147456;

#define GAS __attribute__((address_space(1)))
#define LAS __attribute__((address_space(3)))
typedef unsigned short bf16;
typedef unsigned v4u __attribute__((ext_vector_type(4)));
typedef unsigned v2u __attribute__((ext_vector_type(2)));
typedef float f32x4 __attribute__((ext_vector_type(4)));
typedef float f32x16 __attribute__((ext_vector_type(16)));
typedef short bf16x8 __attribute__((ext_vector_type(8)));
typedef GAS unsigned gu32;
#define RLX_AGENT __ATOMIC_RELAXED, __HIP_MEMORY_SCOPE_AGENT
#define LDS_WAIT() asm volatile("s_waitcnt lgkmcnt(0)" ::: "memory")
#define LBAR() do { asm volatile("s_waitcnt lgkmcnt(0)" ::: "memory"); __builtin_amdgcn_s_barrier(); asm volatile("" ::: "memory"); } while (0)
__device__ __forceinline__ unsigned f2bf(float f) { unsigned u = __builtin_bit_cast(unsigned, f); return (u + 0x7fffu + ((u >> 16) & 1u)) >> 16; }
typedef __bf16 bf16x2_t __attribute__((ext_vector_type(2)));
__device__ __forceinline__ unsigned cvtpk(float lo, float hi) { const bf16x2_t v = {(__bf16)lo, (__bf16)hi}; return __builtin_bit_cast(unsigned, v); }
__device__ __forceinline__ unsigned pk2(float lo, float hi) { return cvtpk(lo, hi); }
__device__ __forceinline__ float clamp448(float x) { return fminf(fmaxf(x, -448.0f), 448.0f); }
__device__ __forceinline__ unsigned pk4_fp8(float a, float b, float c, float d) {
    unsigned w = 0; w = __builtin_amdgcn_cvt_pk_fp8_f32(clamp448(a), clamp448(b), w, false); w = __builtin_amdgcn_cvt_pk_fp8_f32(clamp448(c), clamp448(d), w, true); return w; }
__device__ __forceinline__ float bf2f(unsigned b) { return __builtin_bit_cast(float, b << 16); }
__device__ __forceinline__ float bflo(unsigned w) { return __builtin_bit_cast(float, w << 16); }
__device__ __forceinline__ float bfhi(unsigned w) { return __builtin_bit_cast(float, w & 0xffff0000u); }
__device__ __forceinline__ float frcp(float x) { return __builtin_amdgcn_rcpf(x); }
__device__ __forceinline__ float sigmoidf_(float x) { return frcp(1.0f + __expf(-x)); }

#define XB_TMO      128
#define XB_XCNT(j)  (256  + 64 * (j))
#define XB_XSUB(j)  (1280 + 64 * (j))
#define XB_XGEN(j)  (2304 + 64 * (j))
#define XB_TOP      3328
#define XB_TOPGEN   3392
#define XCD_BAR_WORDS 3456
#define XB_SPIN_CAP (1u << 22)
__device__ __forceinline__ unsigned xb_ld(unsigned* p)              { return __hip_atomic_load(p, __ATOMIC_RELAXED, __HIP_MEMORY_SCOPE_AGENT); }
__device__ __forceinline__ unsigned xb_add(unsigned* p, unsigned v) { return __hip_atomic_fetch_add(p, v, __ATOMIC_RELAXED, __HIP_MEMORY_SCOPE_AGENT); }
__device__ __forceinline__ unsigned xb_xcc_id() { return (unsigned)__builtin_amdgcn_s_getreg((3 << 11) | 20) & 0xFu; }
#define XB_SPIN(cond, bar) do { unsigned _sp = 0; while (cond) { __builtin_amdgcn_s_sleep(1); \
    if ((++_sp & 255u) == 0u) { if (xb_ld(&(bar)[XB_TMO])) break; if (_sp > XB_SPIN_CAP) { atomicAdd(&(bar)[XB_TMO], 1u); break; } } } } while (0)
struct XcdBarrier { unsigned* bar; unsigned x; volatile LAS unsigned* st; };
__device__ __forceinline__ XcdBarrier xcd_barrier_post(unsigned* bar, volatile LAS unsigned* st) {
    XcdBarrier b; b.bar = bar; b.x = xb_xcc_id(); b.st = st;
    if (threadIdx.x == 0) (void)xb_add(&bar[XB_XCNT(b.x)], 1u);
    return b;
}
__device__ __forceinline__ void xcd_barrier_complete(unsigned* bar, unsigned x, unsigned& nloc, unsigned& nx) {
    const unsigned G = gridDim.x * gridDim.y * gridDim.z;
    unsigned sum, cnt, mine, sp = 0u;
    for (;;) {
        sum = 0u; cnt = 0u; mine = 0u;
#pragma unroll
        for (unsigned j = 0; j < 16; ++j) { const unsigned c = xb_ld(&bar[XB_XCNT(j)]); sum += c; cnt += (c > 0u) ? 1u : 0u; mine = (j == x) ? c : mine; }
        if (sum == G) break;
        __builtin_amdgcn_s_sleep(1);
        if ((++sp & 255u) == 0u) { if (xb_ld(&bar[XB_TMO])) break; if (sp > XB_SPIN_CAP) { atomicAdd(&bar[XB_TMO], 1u); break; } }
    }
    nloc = mine > 0u ? mine : 1u; nx = cnt > 0u ? cnt : 1u;
}
__device__ __forceinline__ void xcd_barrier(const XcdBarrier& b) {
    asm volatile("s_waitcnt vmcnt(0)" ::: "memory");
    __syncthreads();
    if (threadIdx.x == 0) {
        unsigned* bar = b.bar;
        __builtin_amdgcn_s_waitcnt(0);
        unsigned nloc = b.st[0], nx = b.st[1];
        if (nloc == 0u) { xcd_barrier_complete(bar, b.x, nloc, nx); b.st[0] = nloc; b.st[1] = nx; }
        const unsigned old = xb_add(&bar[XB_XSUB(b.x)], 1u);
        const unsigned gen = old / nloc;
        if (old + 1u == (gen + 1u) * nloc) {
            __builtin_amdgcn_fence(__ATOMIC_RELEASE, "agent");
            asm volatile("s_waitcnt vmcnt(0)" ::: "memory");
            const unsigned og = xb_add(&bar[XB_TOP], 1u);
            const unsigned tg = og / nx;
            if (og + 1u == (tg + 1u) * nx) xb_add(&bar[XB_TOPGEN], 1u);
            else XB_SPIN(xb_ld(&bar[XB_TOPGEN]) == tg, bar);
            __builtin_amdgcn_fence(__ATOMIC_ACQUIRE, "agent");
            xb_add(&bar[XB_XGEN(b.x)], 1u);
            asm volatile("s_waitcnt vmcnt(0)" ::: "memory");
        } else {
            XB_SPIN(xb_ld(&bar[XB_XGEN(b.x)]) == gen, bar);
            __builtin_amdgcn_fence(__ATOMIC_ACQUIRE, "agent");
            asm volatile("s_waitcnt vmcnt(0)" ::: "memory");
        }
    }
    __syncthreads();
}

struct Frame {
    LAS unsigned char* lds;
    gu32* ctl;
    int tid, lane, wave, vcu, G;
    float* out; unsigned char* ws;
};
__device__ __forceinline__ float wave_sum(float v) {
#pragma unroll
    for (int o = 1; o < 64; o <<= 1) v += __shfl_xor(v, o);
    return v;
}

struct InProjOrder {
    int G, c;
    __device__ __forceinline__ bool next(int i, pg8::Unit& u) const {
        const int NL = 128 * 23, NC = 8 * 11;
        const long L = (long)i * G + c; if (L >= NL + NC) return false;
        u.lbase = 0; u.nvalid = 0;
        if (L < NL) { const int wgid = pg8::xcd_remap((int)L, NL); const int nig = 8 * 23, gid = wgid / nig, fm = gid * 8; u.pm = fm + ((wgid % nig) % 8); u.pn = (wgid % nig) / 8; }
        else { const int r = (int)L - NL; u.pm = 128 + r / 11; const int q = r % 11; u.pn = q < 10 ? q : 22; }
        return true;
    }
};
struct MoeOrder {
    int G, c, npn; const LAS int* tab;
    __device__ __forceinline__ bool next(int i, pg8::Unit& u) const {
        const int nT = __builtin_amdgcn_readfirstlane(tab[32]); const int nU = nT * npn;
        const long L = (long)i * G + c; if (L >= nU) return false;
        const int wgid = pg8::xcd_remap((int)L, nU);
        const int tau = wgid / npn, pl = wgid % npn;
        int e = 0;
        for (int k = 1; k < 32; ++k) e += (__builtin_amdgcn_readfirstlane(tab[k]) <= tau) ? 1 : 0;
        const int il = tau - __builtin_amdgcn_readfirstlane(tab[e]);
        u.pm = tau; u.pn = e * npn + pl; u.lbase = e * ML + 256 * il; u.nvalid = __builtin_amdgcn_readfirstlane(tab[33 + e]) - 256 * il;
        return true;
    }
};
__device__ __forceinline__ void moe_tables(Frame& F) {
    LAS int* tab = (LAS int*)(F.lds + TAB_OFF);
    __syncthreads();
    if (F.tid < 32) tab[33 + F.tid] = (int)__hip_atomic_load(F.ctl + CW_CNT + 64 * F.tid, RLX_AGENT);
    __syncthreads();
    if (F.tid == 0) {
        int acc = 0;
        for (int e = 0; e < 32; ++e) { tab[e] = acc; acc += (tab[33 + e] + 255) >> 8; }
        tab[32] = acc;
    }
    __syncthreads();
}

using pg8::f32x4; using pg8::u32x4; using pg8::cvt_pk_bf16;
#define EPI_ROWS(u) const int row0 = (u).pm * 256 + wr * 64 + fr
#define EPI_LOOP _Pragma("unroll") for (int ai = 0; ai < 2; ++ai) _Pragma("unroll") for (int m = 0; m < 4; ++m)
__device__ __forceinline__ u32x4 pack8(const f32x4 a, const f32x4 b) { u32x4 w; w.x = cvt_pk_bf16(a[0], a[1]); w.y = cvt_pk_bf16(a[2], a[3]); w.z = cvt_pk_bf16(b[0], b[1]); w.w = cvt_pk_bf16(b[2], b[3]); return w; }
__device__ __forceinline__ void unpack8(const u32x4 w, f32x4& a, f32x4& b) { a = (f32x4){bflo(w.x), bfhi(w.x), bflo(w.y), bfhi(w.y)}; b = (f32x4){bflo(w.z), bfhi(w.z), bflo(w.w), bfhi(w.w)}; }
__device__ __forceinline__ void unpack8_fp8(const v2u w, f32x4& a, f32x4& b) {
    const auto l0 = __builtin_amdgcn_cvt_pk_f32_fp8((int)w.x, false), h0 = __builtin_amdgcn_cvt_pk_f32_fp8((int)w.x, true), l1 = __builtin_amdgcn_cvt_pk_f32_fp8((int)w.y, false), h1 = __builtin_amdgcn_cvt_pk_f32_fp8((int)w.y, true);
    a = (f32x4){l0[0], l0[1], h0[0], h0[1]}; b = (f32x4){l1[0], l1[1], h1[0], h1[1]}; }
__device__ __forceinline__ v2u pack8_fp8(const f32x4 a, const f32x4 b) { return (v2u){pk4_fp8(a[0], a[1], a[2], a[3]), pk4_fp8(b[0], b[1], b[2], b[3])}; }
__device__ __forceinline__ f32x4 sig4(f32x4 x) { return (f32x4){sigmoidf_(x[0]), sigmoidf_(x[1]), sigmoidf_(x[2]), sigmoidf_(x[3])}; }

struct EpiStore {
    static constexpr bool PERM = true; bf16* O; int ldc; unsigned char* P8;
    __device__ __forceinline__ void operator()(const f32x4 (&acc)[2][2][4][2], const pg8::Unit& u, int wr, int wc, int fr, int fq) const {
        EPI_ROWS(u); const int col0 = u.pn * 256 + wc * 32 + 8 * fq;
        if (u.pn == 22 && wc != 0) return;
        if (u.pn >= 10 && u.pn < 22) {
            EPI_LOOP { unsigned char* rowp = P8 + (size_t)(row0 + ai * 128 + m * 16) * 3072 + (col0 - PC_O);
#pragma unroll
                for (int bj = 0; bj < 2; ++bj) *(v2u*)(rowp + bj * 128) = pack8_fp8(acc[ai][bj][m][0], acc[ai][bj][m][1]); }
            return; }
        EPI_LOOP { bf16* rowp = O + (size_t)(row0 + ai * 128 + m * 16) * ldc + col0;
#pragma unroll
            for (int bj = 0; bj < 2; ++bj) if (u.pn != 22 || bj == 0) *(u32x4*)(rowp + bj * 128) = pack8(acc[ai][bj][m][0], acc[ai][bj][m][1]); }
    }
};
struct EpiGlu {
    static constexpr bool PERM = true; const bf16* A2; bf16* A3; const float* bias;
    __device__ __forceinline__ void operator()(const f32x4 (&acc)[2][2][4][2], const pg8::Unit& u, int wr, int wc, int fr, int fq) const {
        EPI_ROWS(u); const int col0 = u.pn * 256 + wc * 32 + 8 * fq;
        f32x4 bv[2][2];
#pragma unroll
        for (int bj = 0; bj < 2; ++bj)
#pragma unroll
            for (int n = 0; n < 2; ++n) bv[bj][n] = *(const f32x4*)(bias + col0 + bj * 128 + 4 * n);
#pragma unroll
        for (int ai = 0; ai < 2; ++ai) {
            v2u ld[4][2];
#pragma unroll
            for (int m = 0; m < 4; ++m)
#pragma unroll
                for (int bj = 0; bj < 2; ++bj) ld[m][bj] = *(const v2u*)((const unsigned char*)A2 + (size_t)(row0 + ai * 128 + m * 16) * 512 + col0 + bj * 128);
            __builtin_amdgcn_sched_barrier(0);
#pragma unroll
            for (int m = 0; m < 4; ++m)
#pragma unroll
                for (int bj = 0; bj < 2; ++bj) { f32x4 a0, a1; unpack8_fp8(ld[m][bj], a0, a1);
                    const f32x4 v0 = a0 * sig4(acc[ai][bj][m][0] + bv[bj][0]), v1 = a1 * sig4(acc[ai][bj][m][1] + bv[bj][1]);
                    *(v2u*)((unsigned char*)A3 + (size_t)(row0 + ai * 128 + m * 16) * 512 + col0 + bj * 128) = pack8_fp8(v0, v1); }
        }
    }
};
template <bool ADD> struct EpiGate {
    static constexpr bool PERM = true; const unsigned char* proj; int gc0; const float* bg; const bf16* Prev; bf16* O;
    __device__ __forceinline__ void operator()(const f32x4 (&acc)[2][2][4][2], const pg8::Unit& u, int wr, int wc, int fr, int fq) const {
        EPI_ROWS(u); const int col0 = u.pn * 256 + wc * 32 + 8 * fq;
        f32x4 bv[2][2];
#pragma unroll
        for (int bj = 0; bj < 2; ++bj)
#pragma unroll
            for (int n = 0; n < 2; ++n) bv[bj][n] = *(const f32x4*)(bg + col0 + bj * 128 + 4 * n);
        constexpr int MB = ADD ? 2 : 4;
#pragma unroll
        for (int g = 0; g < 8 / MB; ++g) {
            v2u lg[MB][2]; u32x4 lp[MB][2];
#pragma unroll
            for (int mm = 0; mm < MB; ++mm)
#pragma unroll
                for (int bj = 0; bj < 2; ++bj) { const int q = g * MB + mm, row = row0 + (q >> 2) * 128 + (q & 3) * 16; lg[mm][bj] = *(const v2u*)(proj + (size_t)row * 3072 + gc0 + col0 + bj * 128);
                    if (ADD) lp[mm][bj] = *(const u32x4*)(Prev + (size_t)row * 1024 + col0 + bj * 128); }
            __builtin_amdgcn_sched_barrier(0);
#pragma unroll
            for (int mm = 0; mm < MB; ++mm)
#pragma unroll
                for (int bj = 0; bj < 2; ++bj) { const int q = g * MB + mm, ai = q >> 2, m = q & 3; f32x4 g0, g1; unpack8_fp8(lg[mm][bj], g0, g1);
                    f32x4 v0 = sig4(g0 + bv[bj][0]) * acc[ai][bj][m][0], v1 = sig4(g1 + bv[bj][1]) * acc[ai][bj][m][1];
                    if (ADD) { f32x4 p0, p1; unpack8(lp[mm][bj], p0, p1); v0 += p0; v1 += p1; }
                    if (ADD) *(v2u*)((unsigned char*)O + (size_t)(row0 + ai * 128 + m * 16) * 1024 + col0 + bj * 128) = pack8_fp8(v0 * 4.0f, v1 * 4.0f);
                    else *(u32x4*)(O + (size_t)(row0 + ai * 128 + m * 16) * 1024 + col0 + bj * 128) = pack8(v0, v1); }
            __builtin_amdgcn_sched_barrier(0);
        }
    }
};
struct EpiX1 {
    static constexpr bool PERM = true; const float* x; const float* mod; bf16* X1;
    __device__ __forceinline__ void operator()(const f32x4 (&acc)[2][2][4][2], const pg8::Unit& u, int wr, int wc, int fr, int fq) const {
        EPI_ROWS(u); const int col0 = u.pn * 256 + wc * 32 + 8 * fq; const int b = (u.pm * 256) / SEQ;
        f32x4 gv[2][2];
#pragma unroll
        for (int bj = 0; bj < 2; ++bj)
#pragma unroll
            for (int n = 0; n < 2; ++n) gv[bj][n] = *(const f32x4*)(mod + b * 6144 + 2 * D + col0 + bj * 128 + 4 * n);
#pragma unroll
        for (int g = 0; g < 4; ++g) {
            f32x4 lx[2][2][2];
#pragma unroll
            for (int mm = 0; mm < 2; ++mm)
#pragma unroll
                for (int bj = 0; bj < 2; ++bj) { const int q = g * 2 + mm; const size_t off = (size_t)(row0 + (q >> 2) * 128 + (q & 3) * 16) * D + col0 + bj * 128; lx[mm][bj][0] = *(const f32x4*)(x + off); lx[mm][bj][1] = *(const f32x4*)(x + off + 4); }
            __builtin_amdgcn_sched_barrier(0);
#pragma unroll
            for (int mm = 0; mm < 2; ++mm)
#pragma unroll
                for (int bj = 0; bj < 2; ++bj) { const int q = g * 2 + mm, ai = q >> 2, m = q & 3; const size_t off = (size_t)(row0 + ai * 128 + m * 16) * D + col0 + bj * 128;
                    *(u32x4*)(X1 + off) = pack8(lx[mm][bj][0] + gv[bj][0] * acc[ai][bj][m][0], lx[mm][bj][1] + gv[bj][1] * acc[ai][bj][m][1]); }
            __builtin_amdgcn_sched_barrier(0);
        }
    }
};
struct EpiSwiglu {
    static constexpr bool PERM = true; const float* bin; bf16* ACT;
    __device__ __forceinline__ void operator()(const f32x4 (&acc)[2][2][4][2], const pg8::Unit& u, int wr, int wc, int fr, int fq) const {
        EPI_ROWS(u); const int e = u.pn >> 3, pl = u.pn & 7; const int f0 = pl * 128 + wc * 32 + 8 * fq;
        f32x4 bg[2], bl[2];
#pragma unroll
        for (int n = 0; n < 2; ++n) { bg[n] = *(const f32x4*)(bin + e * 2048 + f0 + 4 * n); bl[n] = *(const f32x4*)(bin + e * 2048 + 1024 + f0 + 4 * n); }
        EPI_LOOP { f32x4 o[2];
#pragma unroll
            for (int n = 0; n < 2; ++n) { const f32x4 zg = acc[ai][0][m][n] + bg[n], zl = acc[ai][1][m][n] + bl[n];
#pragma unroll
                for (int j = 0; j < 4; ++j) { const float gl = fminf(zg[j], 7.0f); const float li = fminf(fmaxf(zl[j], -7.0f), 7.0f); o[n][j] = gl * sigmoidf_(1.702f * gl) * (li + 1.0f); } }
            *(v2u*)((unsigned char*)ACT + (size_t)(row0 + ai * 128 + m * 16) * 1024 + f0) = (v2u){pk4_fp8(8.f * o[0][0], 8.f * o[0][1], 8.f * o[0][2], 8.f * o[0][3]), pk4_fp8(8.f * o[1][0], 8.f * o[1][1], 8.f * o[1][2], 8.f * o[1][3])}; }
    }
};
struct EpiY {
    static constexpr bool PERM = true; const float* bout; bf16* Y;
    __device__ __forceinline__ void operator()(const f32x4 (&acc)[2][2][4][2], const pg8::Unit& u, int wr, int wc, int fr, int fq) const {
        EPI_ROWS(u); const int e = u.pn >> 2, pl = u.pn & 3; const int col0 = pl * 256 + wc * 32 + 8 * fq;
        f32x4 bv[2][2];
#pragma unroll
        for (int bj = 0; bj < 2; ++bj)
#pragma unroll
            for (int n = 0; n < 2; ++n) bv[bj][n] = *(const f32x4*)(bout + e * 1024 + col0 + bj * 128 + 4 * n);
        EPI_LOOP { unsigned char* rowp = (unsigned char*)Y + (size_t)(row0 + ai * 128 + m * 16) * 1024 + col0;
#pragma unroll
            for (int bj = 0; bj < 2; ++bj) { const f32x4 v0 = (acc[ai][bj][m][0] + bv[bj][0]) * 16.0f, v1 = (acc[ai][bj][m][1] + bv[bj][1]) * 16.0f;
                *(v2u*)(rowp + bj * 128) = (v2u){pk4_fp8(v0[0], v0[1], v0[2], v0[3]), pk4_fp8(v1[0], v1[1], v1[2], v1[3])}; } }
    }
};

struct TItem { const float* src; bf16* dst; int ld, ldk; int f8; };
__device__ __forceinline__ void titem_load(const TItem& t, int lane, f32x4 (&r)[8]) {
#pragma unroll
    for (int i = 0; i < 8; ++i) r[i] = *(const f32x4*)(t.src + (size_t)(8 * i + (lane >> 3)) * t.ld + 4 * (lane & 7));
}
__device__ __forceinline__ void titem_store(const TItem& t, int lane, const f32x4 (&r)[8], LAS float* scr) {
#pragma unroll
    for (int i = 0; i < 8; ++i) { LAS float* p = scr + (8 * i + (lane >> 3)) * 33 + 4 * (lane & 7); p[0] = r[i][0]; p[1] = r[i][1]; p[2] = r[i][2]; p[3] = r[i][3]; }
    LDS_WAIT(); asm volatile("" ::: "memory");
    const int c = lane & 7;
#pragma unroll
    for (int j = 0; j < 4; ++j) { const int n = (lane >> 3) + 8 * j; const LAS float* s = scr + (8 * c) * 33 + n;
        if (t.f8) { *(GAS v2u*)((unsigned char*)t.dst + (size_t)n * t.ldk + 8 * c) = (v2u){pk4_fp8(32.f * s[0 * 33], 32.f * s[1 * 33], 32.f * s[2 * 33], 32.f * s[3 * 33]), pk4_fp8(32.f * s[4 * 33], 32.f * s[5 * 33], 32.f * s[6 * 33], 32.f * s[7 * 33])}; }
        else { v4u o; o.x = pk2(s[0 * 33], s[1 * 33]); o.y = pk2(s[2 * 33], s[3 * 33]); o.z = pk2(s[4 * 33], s[5 * 33]); o.w = pk2(s[6 * 33], s[7 * 33]);
            *(GAS v4u*)(t.dst + (size_t)n * t.ldk + 8 * c) = o; } }
    LDS_WAIT(); asm volatile("" ::: "memory");
}
__device__ __forceinline__ void p0_prologue(Frame& F, const float* const* __restrict__ INP) {
    {
        LAS float* sc = (LAS float*)(F.lds);
        LAS float* red = (LAS float*)(F.lds + 9 * 1024 * 4);
        for (int i = F.tid; i < 9 * 1024; i += NWAVES * 64) { const int r = i >> 10, k = i & 1023; const float v = r < 8 ? INP[1][r * 1024 + k] : INP[3][k]; sc[i] = v / (1.0f + expf(-v)); }
        __syncthreads();
        const float* wada = INP[4]; const float* bada = INP[5];
        float* mod = (float*)(F.ws + WS_MOD);
        for (int cg = blockIdx.x; cg < 256; cg += F.G) {
            const int j0 = cg * 24, col = F.lane & 31, kp = F.lane >> 5;
            float a[9];
#pragma unroll
            for (int r = 0; r < 9; ++r) a[r] = 0.f;
            if (col < 24) {
#pragma unroll 16
                for (int i = 0; i < 64; ++i) { const int k = F.wave * 128 + 2 * i + kp; const float wv = wada[(size_t)k * 6144 + j0 + col];
#pragma unroll
                    for (int r = 0; r < 9; ++r) a[r] += sc[r * 1024 + k] * wv; }
            }
#pragma unroll
            for (int r = 0; r < 9; ++r) red[((F.wave * 2 + kp) * 9 + r) * 32 + col] = a[r];
            __syncthreads();
            if (F.tid < 9 * 32) { const int r = F.tid >> 5, cc = F.tid & 31;
                if (cc < 24) { float s = 0.f; for (int p = 0; p < 16; ++p) s += red[(p * 9 + r) * 32 + cc]; const int j = j0 + cc; s += bada[j];
                    if (r < 8) mod[r * 6144 + j] = s; else if (j < 2048) mod[8 * 6144 + j] = s; } }
            __syncthreads();
        }
    }
    LAS float* scr = (LAS float*)(F.lds + F.wave * 16384);
    const int gw = F.vcu * NWAVES + F.wave, NGW = F.G * NWAVES;
    bf16* WIN = (bf16*)(F.ws + WS_WIN); bf16* WGLU = (bf16*)(F.ws + WS_WGLU); bf16* WA = (bf16*)(F.ws + WS_WA); bf16* WB = (bf16*)(F.ws + WS_WB); bf16* WO = (bf16*)(F.ws + WS_WO);
    bf16* WEIN = (bf16*)(F.ws + WS_WEIN); bf16* WEOUT = (bf16*)(F.ws + WS_WEOUT);
    constexpr int I_IN = 177 * 16, I_GLU = 16 * 8, I_A = 32 * 16, I_B = 32 * 8, I_O = 32 * 16, I_EIN = 32 * 64 * 16, I_EOUT = 32 * 32 * 16;
    constexpr int NITEMS = I_IN + I_GLU + I_A + I_B + I_O + I_EIN + I_EOUT;
#define P0_DECODE(it_, T) do { int r = (it_); \
        if (r < I_IN) { const int kb = r / 177, nb = r % 177, n0 = nb * 32; const int sc0 = n0 < 2048 ? n0 : (n0 < 5632 ? n0 + 32 : 2048); \
            T.src = INP[8] + (size_t)kb * 64 * 5664 + sc0; T.ld = 5664; T.dst = (bf16*)((unsigned char*)WIN + (size_t)n0 * 1024 + kb * 64); T.ldk = 1024; T.f8 = 1; break; } r -= I_IN; \
        if (r < I_GLU) { const int kb = r / 16, nb = r % 16; T.src = INP[21] + (size_t)kb * 64 * 512 + nb * 32; T.ld = 512; T.dst = (bf16*)((unsigned char*)WGLU + (size_t)nb * 32 * 512 + kb * 64); T.ldk = 512; T.f8 = 1; break; } r -= I_GLU; \
        if (r < I_A) { const int kb = r / 32, nb = r % 32; T.src = INP[12] + (size_t)kb * 64 * 1024 + nb * 32; T.ld = 1024; T.dst = (bf16*)((unsigned char*)WA + (size_t)nb * 32 * 1024 + kb * 64); T.ldk = 1024; T.f8 = 1; break; } r -= I_A; \
        if (r < I_B) { const int kb = r / 32, nb = r % 32; T.src = INP[23] + (size_t)kb * 64 * 1024 + nb * 32; T.ld = 1024; T.dst = (bf16*)((unsigned char*)WB + (size_t)nb * 32 * 512 + kb * 64); T.ldk = 512; T.f8 = 1; break; } r -= I_B; \
        if (r < I_O) { const int kb = r / 32, nb = r % 32; T.src = INP[25] + (size_t)kb * 64 * 1024 + nb * 32; T.ld = 1024; T.dst = (bf16*)((unsigned char*)WO + (size_t)nb * 32 * 1024 + kb * 64); T.ldk = 1024; T.f8 = 1; break; } r -= I_O; \
        if (r < I_EIN) { const int e = r / 1024, q = r % 1024, kb = q / 64, nb = q % 64; const int dr = nb * 32, pn = dr >> 8, bj = (dr >> 7) & 1, xx = dr & 127; \
            T.src = INP[28] + (size_t)e * 1024 * 2048 + (size_t)kb * 64 * 2048 + bj * 1024 + pn * 128 + xx; T.ld = 2048; T.dst = (bf16*)((unsigned char*)WEIN + (size_t)e * 2048 * 1024 + (size_t)dr * 1024 + kb * 64); T.ldk = 1024; T.f8 = 1; break; } r -= I_EIN; \
        { const int e = r / 512, q = r % 512, kb = q / 32, nb = q % 32; \
            T.src = INP[30] + (size_t)e * 1024 * 1024 + (size_t)kb * 64 * 1024 + nb * 32; T.ld = 1024; T.dst = (bf16*)((unsigned char*)WEOUT + (size_t)e * 1024 * 1024 + (size_t)nb * 32 * 1024 + kb * 64); T.ldk = 1024; T.f8 = 1; } } while (0)
    {
        TItem ta, tb; f32x4 ra[8], rb[8];
        int it = gw;
        if (it < NITEMS - I_EIN - I_EOUT) { P0_DECODE(it, ta); titem_load(ta, F.lane, ra); }
        constexpr int NITEMS0 = NITEMS - I_EIN - I_EOUT;
        while (it < NITEMS0) {
            const int nx = it + NGW;
            if (nx < NITEMS0) { P0_DECODE(nx, tb); titem_load(tb, F.lane, rb); }
            titem_store(ta, F.lane, ra, scr);
            ta = tb;
#pragma unroll
            for (int i = 0; i < 8; ++i) ra[i] = rb[i];
            it = nx;
        }
    }
#undef P0_DECODE
    { const int gt = blockIdx.x * (NWAVES * 64) + F.tid, NT = F.G * NWAVES * 64; GAS v4u* z = (GAS v4u*)((unsigned char*)WIN + (size_t)5664 * 1024);
        for (int i = gt; i < 224 * 1024 / 16; i += NT) z[i] = (v4u){0u, 0u, 0u, 0u}; }
}

__device__ __forceinline__ void p1_norm1(Frame& F, const float* const* __restrict__ INP) {
    const int gw = F.vcu * NWAVES + F.wave, NGW = F.G * NWAVES;
    const float* mod = (const float*)(F.ws + WS_MOD); bf16* H1 = (bf16*)(F.ws + WS_H1);
    for (int m = gw; m < MT; m += NGW) {
        const float* xr; const float* sh; const float* scl;
        if (m < ML) { const int b = m / SEQ; xr = INP[0] + (size_t)m * D; sh = mod + b * 6144; scl = sh + D; }
        else { xr = INP[2] + (size_t)(m - ML) * D; sh = mod + 8 * 6144; scl = sh + D; }
        f32x4 v[4]; float s = 0.f;
#pragma unroll
        for (int j = 0; j < 4; ++j) { v[j] = *(const f32x4*)(xr + 256 * j + 4 * F.lane); s += (v[j][0] * v[j][0] + v[j][1] * v[j][1]) + (v[j][2] * v[j][2] + v[j][3] * v[j][3]); }
        const float rstd = 1.0f / sqrtf(wave_sum(s) * (1.0f / D) + EPS);
#pragma unroll
        for (int j = 0; j < 4; ++j) { const int c = 256 * j + 4 * F.lane; const f32x4 g = *(const f32x4*)(INP[6] + c), a = *(const f32x4*)(scl + c), bb = *(const f32x4*)(sh + c);
            const f32x4 y = v[j] * rstd * g * (a + 1.0f) + bb;
            *(unsigned*)((unsigned char*)H1 + (size_t)m * D + c) = pk4_fp8(y[0], y[1], y[2], y[3]); }
    }
}

__device__ __forceinline__ void conv_fma8(float (&a)[8], const v4u x, const float* wp) {
    const f32x4 w0 = *(const f32x4*)(wp), w1 = *(const f32x4*)(wp + 4);
    a[0] += bflo(x.x) * w0[0]; a[1] += bfhi(x.x) * w0[1]; a[2] += bflo(x.y) * w0[2]; a[3] += bfhi(x.y) * w0[3];
    a[4] += bflo(x.z) * w1[0]; a[5] += bfhi(x.z) * w1[1]; a[6] += bflo(x.w) * w1[2]; a[7] += bfhi(x.w) * w1[3];
}
__device__ __forceinline__ void p3_conv(Frame& F, const float* const* __restrict__ INP) {
    const bf16* PROJ = (const bf16*)(F.ws + WS_PROJ); bf16* QKC = (bf16*)(F.ws + WS_QKC); const float* wc = INP[9];
    const int NT = F.G * NWAVES * 64;
    for (int it = F.vcu * (NWAVES * 64) + F.tid; it < NB * 64 * 16 * 128; it += NT) {
        const int ch0 = (it & 127) * 8, seg = (it >> 7) & 15, gr = (it >> 11) & 63, b = it >> 17, c0 = seg * 4;
        const bf16* base = PROJ + (size_t)(b * SEQ) * LDP + ch0;
        const float scale = ch0 < 512 ? 0.125f : 1.0f;
        v4u win[6][3];
        const v4u z = (v4u){0u, 0u, 0u, 0u};
#pragma unroll
        for (int cc = 0; cc < 6; ++cc)
#pragma unroll
            for (int ky = 0; ky < 3; ++ky) { const int rr = gr + ky - 1, c = c0 + cc - 1;
                win[cc][ky] = (rr >= 0 && rr < 64 && c >= 0 && c < 64) ? *(const v4u*)(base + (size_t)(rr * 64 + c) * LDP) : z; }
        __builtin_amdgcn_sched_barrier(0);
        float a[4][8];
#pragma unroll
        for (int cc = 0; cc < 4; ++cc)
#pragma unroll
            for (int j = 0; j < 8; ++j) a[cc][j] = 0.f;
#pragma unroll
        for (int ky = 0; ky < 3; ++ky)
#pragma unroll
            for (int kx = 0; kx < 3; ++kx) {
                const f32x4 w0 = *(const f32x4*)(wc + (ky * 3 + kx) * 1024 + ch0), w1 = *(const f32x4*)(wc + (ky * 3 + kx) * 1024 + ch0 + 4);
#pragma unroll
                for (int cc = 0; cc < 4; ++cc) { const v4u x = win[cc + kx][ky];
                    a[cc][0] += bflo(x.x) * w0[0]; a[cc][1] += bfhi(x.x) * w0[1]; a[cc][2] += bflo(x.y) * w0[2]; a[cc][3] += bfhi(x.y) * w0[3];
                    a[cc][4] += bflo(x.z) * w1[0]; a[cc][5] += bfhi(x.z) * w1[1]; a[cc][6] += bflo(x.w) * w1[2]; a[cc][7] += bfhi(x.w) * w1[3]; }
                asm volatile("" ::: "memory");
            }
#pragma unroll
        for (int cc = 0; cc < 4; ++cc) {
#pragma unroll
            for (int j = 0; j < 8; ++j) a[cc][j] = a[cc][j] * frcp(1.0f + __expf(-a[cc][j])) * scale;
            *(v4u*)(QKC + (size_t)(b * SEQ + gr * 64 + c0 + cc) * 1024 + ch0) = (v4u){pk2(a[cc][0], a[cc][1]), pk2(a[cc][2], a[cc][3]), pk2(a[cc][4], a[cc][5]), pk2(a[cc][6], a[cc][7])};
        }
    }
    for (int w = F.vcu * (NWAVES * 64) + F.tid; w < MC * 128; w += NT) {
        const int row = ML + (w >> 7), ch0 = (w & 127) * 8, t = (w >> 7) % CTXL;
        float a[8];
#pragma unroll
        for (int j = 0; j < 8; ++j) a[j] = 0.f;
#pragma unroll
        for (int kx = 0; kx < 3; ++kx) { const int tt = t + kx - 1;
            if (tt >= 0 && tt < CTXL) conv_fma8(a, *(const v4u*)(PROJ + (size_t)(row + kx - 1) * LDP + ch0), wc + (3 + kx) * 1024 + ch0); }
        const float scale = ch0 < 512 ? 0.125f : 1.0f;
#pragma unroll
        for (int j = 0; j < 8; ++j) a[j] = a[j] * frcp(1.0f + __expf(-a[j])) * scale;
        *(v4u*)(QKC + (size_t)row * 1024 + ch0) = (v4u){pk2(a[0], a[1]), pk2(a[2], a[3]), pk2(a[4], a[5]), pk2(a[6], a[7])};
    }
    {
        float* GB = (float*)(F.ws + WS_GS); float* GG = GB + 128 * 4352; float* GP = GG + 128 * 4352;
        const int gw = F.vcu * NWAVES + F.wave, NGW = F.G * NWAVES, lane = F.lane;
        for (int it = gw; it < 128 * 34; it += NGW) {
            const int jc = it % 34, dbh = it / 34, h = dbh & 7, b = (dbh >> 3) & 7, d = dbh >> 6;
            const bool lat = jc >= 2; const int p0 = lat ? 128 * (jc - 2) : 128 * jc, Lseq = lat ? SEQ : CTXL, rowbase = lat ? b * SEQ : ML + b * CTXL;
            const float bi_ = INP[10][d * 16 + h], bf_ = INP[10][d * 16 + 8 + h];
            float li2[2], lf2[2];
#pragma unroll
            for (int e = 0; e < 2; ++e) { const int sp = 2 * lane + e; const int tt = d ? (Lseq - 1 - (p0 + sp)) : (p0 + sp); const size_t row = (size_t)(rowbase + tt);
                li2[e] = bf2f(PROJ[row * LDP + PC_IF + d * 16 + h]) + bi_; const float xf = bf2f(PROJ[row * LDP + PC_IF + d * 16 + 8 + h]) + bf_;
                lf2[e] = fminf(xf, 0.f) - log1pf(expf(-fabsf(xf))); }
            const float c1 = lf2[0] + lf2[1]; float inc = c1;
#pragma unroll
            for (int o = 1; o < 64; o <<= 1) { const float t = __shfl_up(inc, o); if (lane >= o) inc += t; }
            const float exc = inc - c1, b0 = exc + lf2[0], b1 = exc + c1, g0 = li2[0] - b0, g1 = li2[1] - b1;
            float pmx = fmaxf(g0, g1);
#pragma unroll
            for (int o = 1; o < 64; o <<= 1) { const float t = __shfl_up(pmx, o); if (lane >= o) pmx = fmaxf(pmx, t); }
            float pex = __shfl_up(pmx, 1); if (lane == 0) pex = -INFINITY;
            const size_t o = (size_t)dbh * 4352 + 128 * jc + 2 * lane;
            *(float2*)(GB + o) = make_float2(b0, b1); *(float2*)(GG + o) = make_float2(g0, g1); *(float2*)(GP + o) = make_float2(fmaxf(pex, g0), pmx);
        }
    }
}

__device__ __forceinline__ void mma32_nt(f32x16& acc, const LAS bf16* A, int lda, const LAS bf16* Bt, int ldb, int K, int lane) {
    const int r = lane & 31, h = lane >> 5;
#pragma unroll
    for (int k0 = 0; k0 < K; k0 += 16) {
        const bf16x8 a = *(const LAS bf16x8*)(A + r * lda + k0 + 8 * h);
        const bf16x8 b = *(const LAS bf16x8*)(Bt + r * ldb + k0 + 8 * h);
        acc = __builtin_amdgcn_mfma_f32_32x32x16_bf16(a, b, acc, 0, 0, 0);
        if ((k0 & 63) == 48) __builtin_amdgcn_sched_barrier(0);
    }
}
__device__ __forceinline__ void mma16_nt(f32x4& acc, const LAS bf16* A, int lda, const LAS bf16* Bt, int ldb, int K, int lane) {
    const int r = lane & 15, q = lane >> 4;
    for (int k0 = 0; k0 < K; k0 += 32) {
        const bf16x8 a = *(const LAS bf16x8*)(A + r * lda + k0 + 8 * q);
        const bf16x8 b = *(const LAS bf16x8*)(Bt + r * ldb + k0 + 8 * q);
        acc = __builtin_amdgcn_mfma_f32_16x16x32_bf16(a, b, acc, 0, 0, 0);
    }
}
__device__ __forceinline__ int row32(int reg, int lane) { return (reg & 3) + 8 * (reg >> 2) + 4 * (lane >> 5); }
__device__ __forceinline__ float logsigmoidf_(float x) { return fminf(x, 0.f) - log1pf(expf(-fabsf(x))); }

typedef short s16x4 __attribute__((ext_vector_type(4)));
__device__ __forceinline__ s16x4 tr_read(const LAS bf16* p) { return __builtin_amdgcn_ds_read_tr16_b64_v4i16((LAS s16x4*)p); }
__device__ __forceinline__ bf16x8 tr_frag32_perm(const LAS bf16* T, int ld, int k0, int x0, int lane) {
    const int h = lane >> 5, i = lane & 15, q = i >> 2, p = i & 3, xb = 16 * ((lane >> 4) & 1);
    const LAS bf16* a = T + (k0 + 4 * h + q) * ld + x0 + xb + 4 * p;
    const s16x4 lo = tr_read(a), hi = tr_read(a + 8 * ld);
    return (bf16x8){lo[0], lo[1], lo[2], lo[3], hi[0], hi[1], hi[2], hi[3]};
}
__device__ __forceinline__ bf16x8 tr_frag16(const LAS bf16* T, int ld, int k0, int x0, int lane) {
    const int q4 = lane >> 4, i = lane & 15, q = i >> 2, p = i & 3;
    const LAS bf16* a = T + (k0 + 8 * q4 + q) * ld + x0 + 4 * p;
    const s16x4 lo = tr_read(a), hi = tr_read(a + 4 * ld);
    return (bf16x8){lo[0], lo[1], lo[2], lo[3], hi[0], hi[1], hi[2], hi[3]};
}
__device__ __forceinline__ v4u scale8(const v4u k8, float ww) {
    return (v4u){pk2(ww * bflo(k8.x), ww * bfhi(k8.x)), pk2(ww * bflo(k8.y), ww * bfhi(k8.y)), pk2(ww * bflo(k8.z), ww * bfhi(k8.z)), pk2(ww * bflo(k8.w), ww * bfhi(k8.w))};
}

constexpr int XI_EIN = 32 * 64 * 16, XI_EOUT = 32 * 32 * 16, XI_PER_UNIT = (XI_EIN + XI_EOUT) / 256;
__device__ __forceinline__ void xitem_decode(const float* const* __restrict__ INP, unsigned char* ws, int r, const float*& src, int& ld, unsigned char*& dst) {
    if (r < XI_EIN) { const int e = r / 1024, q = r % 1024, kb = q / 64, nb = q % 64; const int dr = nb * 32, pn = dr >> 8, bj = (dr >> 7) & 1, xx = dr & 127;
        src = INP[28] + (size_t)e * 1024 * 2048 + (size_t)kb * 64 * 2048 + bj * 1024 + pn * 128 + xx; ld = 2048; dst = ws + WS_WEIN + (size_t)e * 2048 * 1024 + (size_t)dr * 1024 + kb * 64; }
    else { r -= XI_EIN; const int e = r / 512, q = r % 512, kb = q / 32, nb = q % 32;
        src = INP[30] + (size_t)e * 1024 * 1024 + (size_t)kb * 64 * 1024 + nb * 32; ld = 1024; dst = ws + WS_WEOUT + (size_t)e * 1024 * 1024 + (size_t)nb * 32 * 1024 + kb * 64; }
}
template <int MODE>
__device__ __forceinline__ void p4_mlstm(Frame& F, const float* const* __restrict__ INP, int unit) {
    const int vh = unit & 1, h = (unit >> 1) & 7, b = (unit >> 4) & 7, d = unit >> 7;
    LAS bf16* Qs = (LAS bf16*)(F.lds + 0);
    LAS bf16* Ks = (LAS bf16*)(F.lds + 18432);
    LAS bf16* Kw = (LAS bf16*)(F.lds + 36864);
    LAS bf16* Vs = (LAS bf16*)(F.lds + 55296);
    LAS bf16* Cb = (LAS bf16*)(F.lds + 73728);
    LAS float* vec = (LAS float*)(F.lds + 82944);
    LAS float *rowt = vec, *colt = vec + 128, *iev = vec + 256, *emt = vec + 384, *nv = vec + 512, *npart = vec + 576;
    const bf16* PROJ = (const bf16*)(F.ws + WS_PROJ); const bf16* QKC = (const bf16*)(F.ws + WS_QKC); bf16* HDIR = (bf16*)(F.ws + WS_HDIR) + (size_t)d * ML * 1024;
    const float* GB = (const float*)(F.ws + WS_GS) + (size_t)((d * 8 + b) * 8 + h) * 4352; const float* GG = GB + 128 * 4352; const float* GP = GG + 128 * 4352;
    int tid = F.tid; asm volatile("" : "+v"(tid));
    const int lane = tid & 63, w = F.wave;
    for (int i = tid; i < 64 * 72; i += 512) Cb[i] = 0;
    if (tid < 64) nv[tid] = 0.f;
    f32x4 accC[2] = {(f32x4){0.f, 0.f, 0.f, 0.f}, (f32x4){0.f, 0.f, 0.f, 0.f}};
    float m_old = 0.f, dec_prev = 0.f;
    v4u pq[2], pk[2], pv[2]; float pgb = 0.f, pgp = 0.f, pgc = 0.f, pgg[2], pbend, pgmax; v2u hout[4]; bf16* hptr = nullptr; bool hpend = false;
    f32x4 xr[8]; v2u xo[4]; unsigned char* xdst = nullptr; unsigned char* xodst = nullptr; bool xload = false, xout = false;
    LAS float* xscr = (LAS float*)(F.lds + (w < 5 ? 87296 + w * 8448 : 132096));
    const int zl = tid >> 9;
#define ML_PREFETCH(jn) do { const bool lat_ = (jn) >= 2; const int p0_ = lat_ ? 128 * ((jn) - 2) : 128 * (jn), L_ = lat_ ? SEQ : CTXL, rb_ = lat_ ? b * SEQ : ML + b * CTXL; \
        _Pragma("unroll") for (int i = 0; i < 2; ++i) { const int id = tid + 512 * i, s_ = id >> 3, c_ = id & 7; const int tt = d ? (L_ - 1 - (p0_ + s_)) : (p0_ + s_); const size_t row = (size_t)(rb_ + tt); \
            pq[i] = *(const v4u*)(QKC + row * 1024 + h * 64 + c_ * 8); pk[i] = *(const v4u*)(QKC + row * 1024 + 512 + h * 64 + c_ * 8); pv[i] = *(const v4u*)(PROJ + row * LDP + PC_V + h * 128 + vh * 64 + c_ * 8); \
            pgg[i] = GG[128 * (jn) + s_]; } \
        if (tid < 128) { pgb = GB[128 * (jn) + tid]; pgp = GP[128 * (jn) + tid]; pgc = GG[128 * (jn) + tid]; } \
        pbend = GB[128 * (jn) + 127 + zl]; pgmax = GP[128 * (jn) + 127 + zl]; } while (0)
    ML_PREFETCH(0);
    __syncthreads();
    for (int j = 0; j < 34; ++j) {
        const bool lat = j >= 2;
        const int p0 = lat ? 128 * (j - 2) : 128 * j, Lseq = lat ? SEQ : CTXL, rowbase = lat ? b * SEQ : ML + b * CTXL;
        const float bend = pbend, gmax = pgmax;
        const float mnew = fmaxf(bend + m_old, bend + gmax), dec = __expf(bend + m_old - mnew);
#pragma unroll
        for (int i = 0; i < 2; ++i) { const int id = tid + 512 * i, s = id >> 3, c = id & 7;
            *(LAS v4u*)(Qs + s * 72 + c * 8) = pq[i]; *(LAS v4u*)(Ks + s * 72 + c * 8) = pk[i]; *(LAS v4u*)(Vs + s * 72 + c * 8) = pv[i];
            *(LAS v4u*)(Kw + s * 72 + c * 8) = scale8(pk[i], __expf(bend + pgg[i] - mnew)); }
        if (tid < 128) { const float r = fmaxf(m_old, pgp); rowt[tid] = -r * 1.44269504089f; colt[tid] = pgc * 1.44269504089f; iev[tid] = __expf(m_old - r); emt[tid] = __expf(-pgb - r); }
        if (j > 0) {
            const int vi = w >> 1;
#pragma unroll
            for (int jj = 0; jj < 2; ++jj) { const int ki = 2 * (w & 1) + jj;
#pragma unroll
                for (int reg = 0; reg < 4; ++reg) Cb[(16 * vi + (lane >> 4) * 4 + reg) * 72 + 16 * ki + (lane & 15)] = (bf16)f2bf(accC[jj][reg]); }
            if (tid < 64) { float sacc = 0.f;
#pragma unroll
                for (int p = 0; p < 8; ++p) sacc += npart[p * 64 + tid];
                nv[tid] = dec_prev * nv[tid] + sacc; }
        }
        LBAR();
        if (j + 1 < 34 && !(MODE & 4)) ML_PREFETCH(j + 1);
        if (hpend) {
#pragma unroll
            for (int rg = 0; rg < 4; ++rg) *(v2u*)(hptr + 8 * rg) = hout[rg];
            hpend = false; }
        if (MODE == 0 && w < 6) {
            if (xout) {
#pragma unroll
                for (int q = 0; q < 4; ++q) *(GAS v2u*)(xodst + (size_t)(8 * q) * 1024) = xo[q];
                xout = false; }
            const int sl = j * 6 + w;
            if (sl < XI_PER_UNIT) { const float* xsrc; int xld; xitem_decode(INP, F.ws, unit * XI_PER_UNIT + sl, xsrc, xld, xdst);
#pragma unroll
                for (int i = 0; i < 8; ++i) xr[i] = *(const f32x4*)(xsrc + (size_t)(8 * i + (lane >> 3)) * xld + 4 * (lane & 7));
                xload = true; }
        }
        if (lat && !(MODE & 1)) { const int tm = w >> 1, vt = w & 1, tl = lane & 31, t = 32 * tm + tl, hh = lane >> 5; f32x16 acc;
#pragma unroll
            for (int reg = 0; reg < 16; ++reg) acc[reg] = 0.f;
            mma32_nt(acc, Cb + 32 * vt * 72, 72, Qs + 32 * tm * 72, 72, 64, lane);
            const float ie = iev[t], rt = rowt[t];
#pragma unroll
            for (int reg = 0; reg < 16; ++reg) acc[reg] *= ie;
            float rs = 0.f;
            for (int st = (MODE & 8) ? tm : 0; st <= tm; ++st) {
                f32x16 X;
#pragma unroll
                for (int reg = 0; reg < 16; ++reg) X[reg] = 0.f;
                mma32_nt(X, Ks + 32 * st * 72, 72, Qs + 32 * tm * 72, 72, 64, lane);
                const LAS float* cp = colt + 32 * st + 4 * hh;
                if (st == tm) { const int dlim = tl - 4 * hh;
#pragma unroll
                    for (int rg = 0; rg < 4; ++rg) { const f32x4 c4 = *(const LAS f32x4*)(cp + 8 * rg);
#pragma unroll
                        for (int e = 0; e < 4; ++e) { const float arg = (8 * rg + e <= dlim) ? c4[e] + rt : -INFINITY; const float pvv = X[4 * rg + e] * __builtin_amdgcn_exp2f(arg); X[4 * rg + e] = pvv; rs += pvv; } }
                } else {
#pragma unroll
                    for (int rg = 0; rg < 4; ++rg) { const f32x4 c4 = *(const LAS f32x4*)(cp + 8 * rg);
#pragma unroll
                        for (int e = 0; e < 4; ++e) { const float pvv = X[4 * rg + e] * __builtin_amdgcn_exp2f(c4[e] + rt); X[4 * rg + e] = pvv; rs += pvv; } }
                }
#pragma unroll
                for (int ks = 0; ks < 2; ++ks) {
                    const v4u bw = (v4u){cvtpk(X[8 * ks], X[8 * ks + 1]), cvtpk(X[8 * ks + 2], X[8 * ks + 3]), cvtpk(X[8 * ks + 4], X[8 * ks + 5]), cvtpk(X[8 * ks + 6], X[8 * ks + 7])};
                    const bf16x8 af = tr_frag32_perm(Vs, 72, 32 * st + 16 * ks, 32 * vt, lane);
                    acc = __builtin_amdgcn_mfma_f32_32x32x16_bf16(af, __builtin_bit_cast(bf16x8, bw), acc, 0, 0, 0); }
            }
            float nq = 0.f;
#pragma unroll
            for (int q = 0; q < 4; ++q) { const v4u q8 = *(const LAS v4u*)(Qs + t * 72 + 32 * hh + 8 * q); const LAS float* nn = nv + 32 * hh + 8 * q;
                nq += bflo(q8.x) * nn[0] + bfhi(q8.x) * nn[1] + bflo(q8.y) * nn[2] + bfhi(q8.y) * nn[3] + bflo(q8.z) * nn[4] + bfhi(q8.z) * nn[5] + bflo(q8.w) * nn[6] + bfhi(q8.w) * nn[7]; }
            rs += __shfl_xor(rs, 32); nq += __shfl_xor(nq, 32);
            const float rd = 1.0f / fmaxf(fabsf(ie * nq + rs), emt[t]);
            const int tt = d ? (Lseq - 1 - (p0 + t)) : (p0 + t);
            hptr = HDIR + (size_t)(rowbase + tt) * 1024 + h * 128 + vh * 64 + 32 * vt + 4 * hh;
#pragma unroll
            for (int rg = 0; rg < 4; ++rg) hout[rg] = (v2u){pk2(acc[4 * rg] * rd, acc[4 * rg + 1] * rd), pk2(acc[4 * rg + 2] * rd, acc[4 * rg + 3] * rd)};
            hpend = true; }
        if (!(MODE & 2)) { const int vi = w >> 1;
            accC[0] *= dec; accC[1] *= dec;
#pragma unroll
            for (int st4 = 0; st4 < 4; ++st4) { const bf16x8 af = tr_frag16(Vs, 72, 32 * st4, 16 * vi, lane);
#pragma unroll
                for (int jj = 0; jj < 2; ++jj) { const bf16x8 bfr = tr_frag16(Kw, 72, 32 * st4, 16 * (2 * (w & 1) + jj), lane); accC[jj] = __builtin_amdgcn_mfma_f32_16x16x32_bf16(af, bfr, accC[jj], 0, 0, 0); } } }
        { const int k = tid & 63, part = tid >> 6; float sacc = 0.f;
#pragma unroll
            for (int q = 0; q < 16; ++q) sacc += bf2f(Kw[(16 * part + q) * 72 + k]);
            npart[part * 64 + k] = sacc; }
        if (MODE == 0 && w < 6 && xload) {
#pragma unroll
            for (int i = 0; i < 8; ++i) { LAS float* p = xscr + (8 * i + (lane >> 3)) * 33 + 4 * (lane & 7); p[0] = xr[i][0]; p[1] = xr[i][1]; p[2] = xr[i][2]; p[3] = xr[i][3]; }
            LDS_WAIT(); asm volatile("" ::: "memory");
            const int c = lane & 7;
#pragma unroll
            for (int q = 0; q < 4; ++q) { const LAS float* sp = xscr + (8 * c) * 33 + (lane >> 3) + 8 * q;
                xo[q] = (v2u){pk4_fp8(32.f * sp[0 * 33], 32.f * sp[1 * 33], 32.f * sp[2 * 33], 32.f * sp[3 * 33]), pk4_fp8(32.f * sp[4 * 33], 32.f * sp[5 * 33], 32.f * sp[6 * 33], 32.f * sp[7 * 33])}; }
            xodst = xdst + (size_t)(lane >> 3) * 1024 + 8 * c; xout = true; xload = false;
        }
        m_old = mnew; dec_prev = dec;
        LBAR();
    }
    if (MODE == 0 && w < 6 && xout) {
#pragma unroll
        for (int q = 0; q < 4; ++q) *(GAS v2u*)(xodst + (size_t)(8 * q) * 1024) = xo[q]; }
    if (hpend) {
#pragma unroll
        for (int rg = 0; rg < 4; ++rg) *(v2u*)(hptr + 8 * rg) = hout[rg]; }
#undef ML_PREFETCH
}

__device__ __forceinline__ void s5_disc(const float* const* __restrict__ INP, int d, int g, int p, float& ar, float& ai, float& cfr, float& cfi) {
    const float dt = expf(INP[15][d * 32 + g]); const float are = INP[13][(d * 32 + g) * 64 + p], aim = INP[14][(d * 32 + g) * 64 + p];
    const float mag = expf(dt * are), ang = dt * aim; ar = mag * cosf(ang); ai = mag * sinf(ang);
    const float den = are * are + aim * aim, xr = ar - 1.0f; cfr = (xr * are + ai * aim) / den; cfi = (ai * are - xr * aim) / den;
}
__device__ __forceinline__ void p4_s5(Frame& F, const float* const* __restrict__ INP, int unit) {
    const int gp = unit & 15, b = (unit >> 4) & 7, d = unit >> 7;
    LAS bf16* BHt = (LAS bf16*)(F.lds + 0);
    LAS bf16* Cm = (LAS bf16*)(F.lds + 69632);
    LAS float* Eb = (LAS float*)(F.lds + 78336);
    LAS bf16* Us = (LAS bf16*)(F.lds + 82432);
    LAS bf16* BBs = (LAS bf16*)(F.lds + 92672);
    const bf16* PROJ = (const bf16*)(F.ws + WS_PROJ); bf16* YDIR = (bf16*)(F.ws + WS_YDIR) + (size_t)d * ML * 512;
    int tid = F.tid; asm volatile("" : "+v"(tid));
    const int lane = tid & 63, w = F.wave;
    const int sg = tid & 127, seg = tid >> 7;
    float ar, ai, a32r, a32i;
    { float cfr, cfi; s5_disc(INP, d, 2 * gp + (sg >> 6), sg & 63, ar, ai, cfr, cfi); a32r = ar; a32i = ai;
#pragma unroll
        for (int q = 0; q < 5; ++q) { const float nr = a32r * a32r - a32i * a32i, ni = 2.0f * a32r * a32i; a32r = nr; a32i = ni; } }
    for (int idx = tid; idx < 4096; idx += 512) {
        { const int gg = idx >> 11, pp = (idx >> 4) & 127, c = idx & 15, g = 2 * gp + gg, p = pp & 63; float xr_, xi_, cfr, cfi; s5_disc(INP, d, g, p, xr_, xi_, cfr, cfi);
            const float bre = INP[16][((size_t)(d * 32 + g) * 64 + p) * 16 + c], bim = INP[17][((size_t)(d * 32 + g) * 64 + p) * 16 + c];
            BBs[(gg * 128 + pp) * 24 + c] = (bf16)f2bf(pp < 64 ? cfr * bre - cfi * bim : cfr * bim + cfi * bre); }
        { const int gg = idx >> 11, c = (idx >> 7) & 15, pp = idx & 127, g = 2 * gp + gg, p = pp & 63;
            const float v = pp < 64 ? INP[18][((size_t)(d * 32 + g) * 16 + c) * 64 + p] : -INP[19][((size_t)(d * 32 + g) * 16 + c) * 64 + p];
            Cm[(gg * 16 + c) * 136 + pp] = (bf16)f2bf(v); }
    }
    float h0r = 0.f, h0i = 0.f;
    LAS bf16* rowre = BHt + ((sg >> 6) * 128 + (sg & 63)) * 136 + 32 * seg;
    v4u pu; v2u yout[2]; bf16* yptr[2]; bool ypend = false;
#define S5_PREFETCH(jn) do { const bool lat_ = (jn) >= 2; const int p0_ = lat_ ? 128 * ((jn) - 2) : 128 * (jn), L_ = lat_ ? SEQ : CTXL, rb_ = lat_ ? b * SEQ : ML + b * CTXL; \
        const int s_ = tid >> 2, c_ = tid & 3; const int tt = d ? (L_ - 1 - (p0_ + s_)) : (p0_ + s_); pu = *(const v4u*)(PROJ + (size_t)(rb_ + tt) * LDP + PC_U + gp * 32 + c_ * 8); } while (0)
    S5_PREFETCH(0);
    __syncthreads();
    for (int j = 0; j < 34; ++j) {
        const bool lat = j >= 2;
        const int p0 = lat ? 128 * (j - 2) : 128 * j, Lseq = lat ? SEQ : CTXL, rowbase = lat ? b * SEQ : ML + b * CTXL;
        *(LAS v4u*)(Us + (tid >> 2) * 40 + (tid & 3) * 8) = pu;
        LBAR();
        if (j + 1 < 34) S5_PREFETCH(j + 1);
        if (ypend) { *(v2u*)yptr[0] = yout[0]; *(v2u*)yptr[1] = yout[1]; ypend = false; }
        { const int gg = w >> 2, tm = w & 3, r = lane & 31, hh = lane >> 5;
            const bf16x8 a = *(const LAS bf16x8*)(Us + (32 * tm + r) * 40 + gg * 16 + 8 * hh);
            LAS bf16* bp = BHt + (gg * 128 + r) * 136 + 32 * tm + 4 * hh;
#pragma unroll
            for (int tn = 0; tn < 4; ++tn) { f32x16 acc;
#pragma unroll
                for (int reg = 0; reg < 16; ++reg) acc[reg] = 0.f;
                const bf16x8 bb = *(const LAS bf16x8*)(BBs + (gg * 128 + 32 * tn + r) * 24 + 8 * hh);
                acc = __builtin_amdgcn_mfma_f32_32x32x16_bf16(a, bb, acc, 0, 0, 0);
#pragma unroll
                for (int rg = 0; rg < 4; ++rg) *(LAS v2u*)(bp + 32 * tn * 136 + 8 * rg) = (v2u){cvtpk(acc[4 * rg], acc[4 * rg + 1]), cvtpk(acc[4 * rg + 2], acc[4 * rg + 3])}; } }
        LBAR();
        v4u xr[4], xi[4];
#pragma unroll
        for (int q = 0; q < 4; ++q) { xr[q] = *(const LAS v4u*)(rowre + 8 * q); xi[q] = *(const LAS v4u*)(rowre + 64 * 136 + 8 * q); }
        { float hr = 0.f, hi = 0.f;
#pragma unroll
            for (int q = 0; q < 4; ++q)
#pragma unroll
                for (int e = 0; e < 4; ++e) { const unsigned wr_ = xr[q][e], wi_ = xi[q][e];
                    { const float br = bflo(wr_), bi = bflo(wi_); const float nr = ar * hr - ai * hi + br, ni = ar * hi + ai * hr + bi; hr = nr; hi = ni; }
                    { const float br = bfhi(wr_), bi = bfhi(wi_); const float nr = ar * hr - ai * hi + br, ni = ar * hi + ai * hr + bi; hr = nr; hi = ni; } }
            Eb[(seg * 128 + sg) * 2] = hr; Eb[(seg * 128 + sg) * 2 + 1] = hi; }
        LBAR();
        { float hcr = h0r, hci = h0i, hr = 0.f, hi = 0.f;
#pragma unroll
            for (int s2 = 0; s2 < 4; ++s2) { if (s2 == seg) { hr = hcr; hi = hci; } const float er = Eb[(s2 * 128 + sg) * 2], ei = Eb[(s2 * 128 + sg) * 2 + 1];
                const float nr = a32r * hcr - a32i * hci + er, ni = a32r * hci + a32i * hcr + ei; hcr = nr; hci = ni; }
            h0r = hcr; h0i = hci;
#pragma unroll
            for (int q = 0; q < 4; ++q) { v4u orr, oi;
#pragma unroll
                for (int e = 0; e < 4; ++e) { const unsigned wr_ = xr[q][e], wi_ = xi[q][e]; float r0, i0, r1, i1;
                    { const float br = bflo(wr_), bi = bflo(wi_); const float nr = ar * hr - ai * hi + br, ni = ar * hi + ai * hr + bi; hr = nr; hi = ni; r0 = hr; i0 = hi; }
                    { const float br = bfhi(wr_), bi = bfhi(wi_); const float nr = ar * hr - ai * hi + br, ni = ar * hi + ai * hr + bi; hr = nr; hi = ni; r1 = hr; i1 = hi; }
                    orr[e] = cvtpk(r0, r1); oi[e] = cvtpk(i0, i1); }
                *(LAS v4u*)(rowre + 8 * q) = orr; *(LAS v4u*)(rowre + 64 * 136 + 8 * q) = oi; } }
        LBAR();
        if (lat) { const int gg = w >> 2;
#pragma unroll
            for (int jj = 0; jj < 2; ++jj) { const int tm = 2 * (w & 3) + jj; f32x4 acc = (f32x4){0.f, 0.f, 0.f, 0.f};
#pragma unroll
                for (int st4 = 0; st4 < 4; ++st4) { const bf16x8 af = *(const LAS bf16x8*)(Cm + (gg * 16 + (lane & 15)) * 136 + 32 * st4 + 8 * (lane >> 4));
                    const bf16x8 bfr = tr_frag16(BHt + gg * 128 * 136, 136, 32 * st4, 16 * tm, lane);
                    acc = __builtin_amdgcn_mfma_f32_16x16x32_bf16(af, bfr, acc, 0, 0, 0); }
                const int t = 16 * tm + (lane & 15); const int tt = d ? (Lseq - 1 - (p0 + t)) : (p0 + t);
                yptr[jj] = YDIR + (size_t)(rowbase + tt) * 512 + (2 * gp + gg) * 16 + 4 * (lane >> 4); yout[jj] = (v2u){pk2(acc[0], acc[1]), pk2(acc[2], acc[3])}; }
            ypend = true; }
    }
    if (ypend) { *(v2u*)yptr[0] = yout[0]; *(v2u*)yptr[1] = yout[1]; }
#undef S5_PREFETCH
    __syncthreads();
}

__device__ __forceinline__ float gelu_tanh(float x) { const float u = 0.7978845608028654f * (x + 0.044715f * x * x * x); const float e = __expf(2.0f * u); const float th = 1.0f - 2.0f * frcp(e + 1.0f); return 0.5f * x * (1.0f + th); }
__device__ __forceinline__ void p5a_prep(Frame& F, const float* const* __restrict__ INP) {
    const int gw = F.vcu * NWAVES + F.wave, NGW = F.G * NWAVES, lane = F.lane;
    const bf16* PROJ = (const bf16*)(F.ws + WS_PROJ); const bf16* HD0 = (const bf16*)(F.ws + WS_HDIR); const bf16* HD1 = HD0 + (size_t)ML * 1024;
    const bf16* YD0 = (const bf16*)(F.ws + WS_YDIR); const bf16* YD1 = YD0 + (size_t)ML * 512;
    bf16* A1 = (bf16*)(F.ws + WS_A1); bf16* A2 = (bf16*)(F.ws + WS_A2); const unsigned char* P8 = F.ws + WS_PROJ8;
    for (int m0 = 2 * gw; m0 < ML; m0 += 2 * NGW) {
        v4u ha[2][2], hb[2][2], ho[2][2], ya[2], yb[2], yu[2];
#pragma unroll
        for (int r = 0; r < 2; ++r) { const size_t m = (size_t)(m0 + r);
#pragma unroll
            for (int q = 0; q < 2; ++q) { ha[r][q] = *(const v4u*)(HD0 + m * 1024 + 16 * lane + 8 * q); hb[r][q] = *(const v4u*)(HD1 + m * 1024 + 16 * lane + 8 * q); ho[r][q] = (v4u){0u, 0u, 0u, 0u}; }
            { const v4u o16 = *(const v4u*)(P8 + m * 3072 + 16 * lane); ho[r][0].x = o16.x; ho[r][0].y = o16.y; ho[r][1].x = o16.z; ho[r][1].y = o16.w; }
            ya[r] = *(const v4u*)(YD0 + m * 512 + 8 * lane); yb[r] = *(const v4u*)(YD1 + m * 512 + 8 * lane); yu[r] = *(const v4u*)(PROJ + m * LDP + PC_U + 8 * lane); }
        __builtin_amdgcn_sched_barrier(0);
#pragma unroll
        for (int r = 0; r < 2; ++r) { const size_t m = (size_t)(m0 + r);
            float hm[16]; float ss = 0.f;
#pragma unroll
            for (int q = 0; q < 2; ++q) { const v4u a = ha[r][q], bq = hb[r][q];
                hm[8 * q + 0] = bflo(a.x) + bflo(bq.x); hm[8 * q + 1] = bfhi(a.x) + bfhi(bq.x); hm[8 * q + 2] = bflo(a.y) + bflo(bq.y); hm[8 * q + 3] = bfhi(a.y) + bfhi(bq.y);
                hm[8 * q + 4] = bflo(a.z) + bflo(bq.z); hm[8 * q + 5] = bfhi(a.z) + bfhi(bq.z); hm[8 * q + 6] = bflo(a.w) + bflo(bq.w); hm[8 * q + 7] = bfhi(a.w) + bfhi(bq.w); }
#pragma unroll
            for (int q = 0; q < 16; ++q) ss += hm[q] * hm[q];
            ss += __shfl_xor(ss, 1); ss += __shfl_xor(ss, 2); ss += __shfl_xor(ss, 4);
            const float rs = 1.0f / sqrtf(ss * (1.0f / 128.0f) + EPS);
#pragma unroll
            for (int q = 0; q < 2; ++q) { const float* gm = INP[11] + 16 * lane + 8 * q; f32x4 og0, og1; unpack8_fp8((v2u){ho[r][q].x, ho[r][q].y}, og0, og1);
                float rr[8]; const float og[8] = {og0[0], og0[1], og0[2], og0[3], og1[0], og1[1], og1[2], og1[3]};
#pragma unroll
                for (int e = 0; e < 8; ++e) rr[e] = hm[8 * q + e] * rs * gm[e] * sigmoidf_(og[e]);
                *(v2u*)((unsigned char*)A1 + m * 1024 + 16 * lane + 8 * q) = (v2u){pk4_fp8(rr[0], rr[1], rr[2], rr[3]), pk4_fp8(rr[4], rr[5], rr[6], rr[7])}; }
            { const v4u a = ya[r], bq = yb[r], u8 = yu[r]; const float* dd = INP[20] + 8 * lane;
                float rr[8] = {bflo(a.x) + bflo(bq.x) + dd[0] * bflo(u8.x), bfhi(a.x) + bfhi(bq.x) + dd[1] * bfhi(u8.x), bflo(a.y) + bflo(bq.y) + dd[2] * bflo(u8.y), bfhi(a.y) + bfhi(bq.y) + dd[3] * bfhi(u8.y),
                               bflo(a.z) + bflo(bq.z) + dd[4] * bflo(u8.z), bfhi(a.z) + bfhi(bq.z) + dd[5] * bfhi(u8.z), bflo(a.w) + bflo(bq.w) + dd[6] * bflo(u8.w), bfhi(a.w) + bfhi(bq.w) + dd[7] * bfhi(u8.w)};
#pragma unroll
                for (int e = 0; e < 8; ++e) rr[e] = gelu_tanh(rr[e]);
                *(v2u*)((unsigned char*)A2 + m * 512 + 8 * lane) = (v2u){pk4_fp8(rr[0], rr[1], rr[2], rr[3]), pk4_fp8(rr[4], rr[5], rr[6], rr[7])}; }
        }
    }
}

__device__ __forceinline__ void route_reduce_top4(float (&acc)[32], const float* br, int lane, float (&tv)[4], int (&ti)[4]) {
#pragma unroll
    for (int i = 0; i < 16; ++i) { const float send = (lane & 32) ? acc[i] : acc[i + 16]; const float keep = (lane & 32) ? acc[i + 16] : acc[i]; acc[i] = keep + __shfl_xor(send, 32); }
#pragma unroll
    for (int i = 0; i < 8; ++i) { const float send = (lane & 16) ? acc[i] : acc[i + 8]; const float keep = (lane & 16) ? acc[i + 8] : acc[i]; acc[i] = keep + __shfl_xor(send, 16); }
#pragma unroll
    for (int i = 0; i < 4; ++i) { const float send = (lane & 8) ? acc[i] : acc[i + 4]; const float keep = (lane & 8) ? acc[i + 4] : acc[i]; acc[i] = keep + __shfl_xor(send, 8); }
#pragma unroll
    for (int i = 0; i < 2; ++i) { const float send = (lane & 4) ? acc[i] : acc[i + 2]; const float keep = (lane & 4) ? acc[i + 2] : acc[i]; acc[i] = keep + __shfl_xor(send, 4); }
    { const float send = (lane & 2) ? acc[0] : acc[1]; const float keep = (lane & 2) ? acc[1] : acc[0]; acc[0] = keep + __shfl_xor(send, 2); }
    acc[0] += __shfl_xor(acc[0], 1);
    float val = acc[0] + br[lane >> 1];
    if (lane & 1) val = -INFINITY;
#pragma unroll
    for (int r = 0; r < 4; ++r) { float mx = val;
#pragma unroll
        for (int o = 1; o < 64; o <<= 1) mx = fmaxf(mx, __shfl_xor(mx, o));
        const unsigned long long bal = __ballot(val == mx); const int wl = __ffsll((long long)bal) - 1;
        tv[r] = mx; ti[r] = wl >> 1; if (lane == wl) val = -INFINITY; }
}
__device__ __forceinline__ void p6_route(Frame& F, const float* const* __restrict__ INP) {
    const bf16* X1 = (const bf16*)(F.ws + WS_X1); const float* mod = (const float*)(F.ws + WS_MOD); bf16* H2 = (bf16*)(F.ws + WS_H2);
    int* TOPE = (int*)(F.ws + WS_TOPE); int* POS = (int*)(F.ws + WS_POS); float* TOPP = (float*)(F.ws + WS_TOPP); int* LIST = (int*)(F.ws + WS_LIST);
    LAS float* Wt = (LAS float*)(F.lds);
    LAS int* pe = (LAS int*)(F.lds + LDSCTL_OFF + 1024); LAS int* hist = pe + 512; LAS int* base = hist + 32; LAS int* rank = base + 32;
    const float* wr = INP[26]; const float* br = INP[27];
    const int lane = F.lane, w = F.wave;
    for (int idx = F.tid; idx < 32768; idx += NWAVES * 64) { const int e = idx >> 10, k = idx & 1023; Wt[((((k >> 8) * 4 + (k & 3)) * 32 + e) << 6) + ((k >> 2) & 63)] = wr[k * 32 + e]; }
    __syncthreads();
    for (int tg = blockIdx.x; tg < ML / 128; tg += F.G) {
        if (F.tid < 32) hist[F.tid] = 0;
        __syncthreads();
#pragma unroll 1
        for (int q = 0; q < 16; q += 2) {
            const int tl = w * 16 + q, m = tg * 128 + tl, b = m / SEQ;
            const float* sh = mod + b * 6144 + 3 * D; const float* scl = sh + D;
            float s0 = 0.f, s1 = 0.f;
#pragma unroll
            for (int j = 0; j < 4; ++j) { const v2u w0 = *(const v2u*)(X1 + (size_t)m * D + 256 * j + 4 * lane), w1 = *(const v2u*)(X1 + (size_t)(m + 1) * D + 256 * j + 4 * lane);
                const f32x4 x0 = (f32x4){bflo(w0.x), bfhi(w0.x), bflo(w0.y), bfhi(w0.y)}, x1 = (f32x4){bflo(w1.x), bfhi(w1.x), bflo(w1.y), bfhi(w1.y)};
                s0 += (x0[0] * x0[0] + x0[1] * x0[1]) + (x0[2] * x0[2] + x0[3] * x0[3]); s1 += (x1[0] * x1[0] + x1[1] * x1[1]) + (x1[2] * x1[2] + x1[3] * x1[3]); }
            const float r0 = 1.0f / sqrtf(wave_sum(s0) * (1.0f / D) + EPS), r1 = 1.0f / sqrtf(wave_sum(s1) * (1.0f / D) + EPS);
            float a0[32], a1[32];
#pragma unroll
            for (int e = 0; e < 32; ++e) { a0[e] = 0.f; a1[e] = 0.f; }
#pragma unroll 1
            for (int j = 0; j < 4; ++j) { const int c = 256 * j + 4 * lane; const f32x4 g = *(const f32x4*)(INP[7] + c), a = *(const f32x4*)(scl + c), bb = *(const f32x4*)(sh + c);
                const v2u w0 = *(const v2u*)(X1 + (size_t)m * D + c), w1 = *(const v2u*)(X1 + (size_t)(m + 1) * D + c);
                const f32x4 x0 = (f32x4){bflo(w0.x), bfhi(w0.x), bflo(w0.y), bfhi(w0.y)}, x1 = (f32x4){bflo(w1.x), bfhi(w1.x), bflo(w1.y), bfhi(w1.y)};
                const f32x4 gs = g * (a + 1.0f); const f32x4 y0 = x0 * r0 * gs + bb, y1 = x1 * r1 * gs + bb;
                *(unsigned*)((unsigned char*)H2 + (size_t)m * D + c) = pk4_fp8(y0[0], y0[1], y0[2], y0[3]); *(unsigned*)((unsigned char*)H2 + (size_t)(m + 1) * D + c) = pk4_fp8(y1[0], y1[1], y1[2], y1[3]);
                const LAS float* wj = Wt + j * 8192 + lane;
#pragma unroll
                for (int qq = 0; qq < 4; ++qq) { const LAS float* wp = wj + qq * 2048; const float ya = y0[qq], yb = y1[qq];
#pragma unroll
                    for (int e = 0; e < 32; ++e) { const float wv = wp[e * 64]; a0[e] += ya * wv; a1[e] += yb * wv; }
                    asm volatile("" ::: "memory"); } }
            float tv[4]; int ti[4];
#pragma unroll
            for (int tk = 0; tk < 2; ++tk) {
                if (tk == 0) route_reduce_top4(a0, br, lane, tv, ti); else route_reduce_top4(a1, br, lane, tv, ti);
                const float e1 = __expf(tv[1] - tv[0]), e2 = __expf(tv[2] - tv[0]), e3 = __expf(tv[3] - tv[0]); const float inv = 1.0f / (1.0f + e1 + e2 + e3);
                if (lane < 4) { const float p = lane == 0 ? inv : (lane == 1 ? e1 * inv : (lane == 2 ? e2 * inv : e3 * inv)); const int ee = lane == 0 ? ti[0] : (lane == 1 ? ti[1] : (lane == 2 ? ti[2] : ti[3]));
                    TOPP[(m + tk) * 4 + lane] = p; TOPE[(m + tk) * 4 + lane] = ee; pe[(tl + tk) * 4 + lane] = ee; }
            }
        }
        __syncthreads();
        { const int e = pe[F.tid]; rank[F.tid] = __hip_atomic_fetch_add(&hist[e], 1, __ATOMIC_RELAXED, __HIP_MEMORY_SCOPE_WORKGROUP); }
        __syncthreads();
        if (F.tid < 32) base[F.tid] = (int)__hip_atomic_fetch_add(F.ctl + CW_CNT + 64 * F.tid, (unsigned)hist[F.tid], RLX_AGENT);
        __syncthreads();
        { const int e = pe[F.tid]; const int pos = base[e] + rank[F.tid]; const int m = tg * 128 + (F.tid >> 2); LIST[e * ML + pos] = m; POS[m * 4 + (F.tid & 3)] = pos; }
        __syncthreads();
    }
}

typedef int i32x4 __attribute__((ext_vector_type(4)));
__device__ __forceinline__ void p10_combine(Frame& F, const float* const* __restrict__ INP) {
    moe_tables(F);
    const LAS int* tab = (const LAS int*)(F.lds + TAB_OFF);
    const bf16* X1 = (const bf16*)(F.ws + WS_X1); float* OUT = F.out; const float* mod = (const float*)(F.ws + WS_MOD); const unsigned char* Y = (const unsigned char*)(F.ws + WS_Y);
    const int* TOPE = (const int*)(F.ws + WS_TOPE); const int* POS = (const int*)(F.ws + WS_POS); const float* TOPP = (const float*)(F.ws + WS_TOPP);
    const int gw = F.vcu * NWAVES + F.wave, NGW = F.G * NWAVES, lane = F.lane;
    i32x4 te[2], tp[2]; f32x4 tw[2];
    int m0 = 2 * gw;
    if (m0 < ML) {
#pragma unroll
        for (int r = 0; r < 2; ++r) { te[r] = *(const i32x4*)(TOPE + (m0 + r) * 4); tp[r] = *(const i32x4*)(POS + (m0 + r) * 4); tw[r] = *(const f32x4*)(TOPP + (m0 + r) * 4); } }
    for (; m0 < ML; m0 += 2 * NGW) {
        unsigned yv[2][4][4]; v2u xv[2][4];
#pragma unroll
        for (int r = 0; r < 2; ++r) {
#pragma unroll
            for (int k = 0; k < 4; ++k) { const size_t slot = (size_t)256 * tab[te[r][k]] + tp[r][k];
#pragma unroll
                for (int j = 0; j < 4; ++j) yv[r][k][j] = *(const unsigned*)(Y + slot * 1024 + 256 * j + 4 * lane); }
#pragma unroll
            for (int j = 0; j < 4; ++j) xv[r][j] = *(const v2u*)(X1 + (size_t)(m0 + r) * D + 256 * j + 4 * lane); }
        const f32x4 cw[2] = {tw[0], tw[1]};
        const int mn = m0 + 2 * NGW;
        if (mn < ML) {
#pragma unroll
            for (int r = 0; r < 2; ++r) { te[r] = *(const i32x4*)(TOPE + (mn + r) * 4); tp[r] = *(const i32x4*)(POS + (mn + r) * 4); tw[r] = *(const f32x4*)(TOPP + (mn + r) * 4); } }
        __builtin_amdgcn_sched_barrier(0);
#pragma unroll
        for (int r = 0; r < 2; ++r) { const int m = m0 + r, b = m / SEQ; const float* gt2 = mod + b * 6144 + 5 * D;
            f32x4 v[4]; float s = 0.f;
#pragma unroll
            for (int j = 0; j < 4; ++j) { const int c = 256 * j + 4 * lane; f32x4 mo = (f32x4){0.f, 0.f, 0.f, 0.f};
#pragma unroll
                for (int k = 0; k < 4; ++k) { const unsigned y = yv[r][k][j]; const auto lo = __builtin_amdgcn_cvt_pk_f32_fp8((int)y, false), hi = __builtin_amdgcn_cvt_pk_f32_fp8((int)y, true);
                    mo += (f32x4){lo[0], lo[1], hi[0], hi[1]} * (cw[r][k] * 0.0625f); }
                const v2u xw = xv[r][j]; v[j] = (f32x4){bflo(xw.x), bfhi(xw.x), bflo(xw.y), bfhi(xw.y)} + *(const f32x4*)(gt2 + c) * mo;
                s += (v[j][0] * v[j][0] + v[j][1] * v[j][1]) + (v[j][2] * v[j][2] + v[j][3] * v[j][3]); }
            const float rstd = 1.0f / sqrtf(wave_sum(s) * (1.0f / D) + EPS);
#pragma unroll
            for (int j = 0; j < 4; ++j) { const int c = 256 * j + 4 * lane; *(f32x4*)(OUT + (size_t)m * D + c) = v[j] * rstd * *(const f32x4*)(INP[32] + c); }
        }
    }
}

struct Args { const float* in[33]; float* out; unsigned char* ws; int ph_lo, ph_hi, li, pad; };
__global__ void __launch_bounds__(NWAVES * 64, 2) fwd_kernel(Args args) {
    extern __shared__ __attribute__((aligned(16))) unsigned char lds[];
    Frame F;
    F.lds = (LAS unsigned char*)lds;
    F.tid = threadIdx.x; F.lane = F.tid & 63; F.wave = __builtin_amdgcn_readfirstlane(F.tid >> 6);
    F.G = gridDim.x; { const int bx = blockIdx.x; F.vcu = (F.G % 8 == 0) ? (bx % 8) * (F.G / 8) + bx / 8 : bx; }
    F.ws = args.ws; F.ctl = (gu32*)(args.ws + WS_CTL); F.out = args.out;
    for (int u = F.tid; u < (LDS_BYTES - LDSCTL_OFF) / 4; u += NWAVES * 64) ((LAS unsigned*)(F.lds + LDSCTL_OFF))[u] = 0u;
    __syncthreads();
    XcdBarrier bar; bar.bar = (unsigned*)(F.ctl + CW_BAR); bar.x = 0; bar.st = nullptr;
    if (N_LAUNCHES == 1) bar = xcd_barrier_post((unsigned*)(F.ctl + CW_BAR), (volatile LAS unsigned*)(F.lds + MISC_OFF) + 8);
    const int lo = args.ph_lo, hi = args.ph_hi;
    const float* const* __restrict__ INP = args.in;
#ifndef PH_MASK
#define PH_MASK 0x3fff
#endif
#define IN(k) ((((PH_MASK) >> (k)) & 1) && lo <= (k) && (k) < hi)
#define SEAM(k) do { if (IN(k) && IN((k) + 1)) xcd_barrier(bar); } while (0)
    const bf16* WIN = (const bf16*)(F.ws + WS_WIN);

    if (IN(0)) { p0_prologue(F, INP); } SEAM(0);
    if (IN(1)) { p1_norm1(F, INP); } SEAM(1);
    if (IN(2)) {
        pg8::Gemm g{(const bf16*)(F.ws + WS_H1), WIN, 512, nullptr, 0x7f7f7f7f, 0x7a7a7a7a}; InProjOrder S{F.G, (int)blockIdx.x};
        EpiStore E{(bf16*)(F.ws + WS_PROJ), LDP, F.ws + WS_PROJ8};
        pg8::gemm_phase<EpiStore, InProjOrder, false, true>(F.lds, g, S, E);
    } SEAM(2);
    if (IN(3)) { p3_conv(F, INP); } SEAM(3);
    if (IN(4)) { for (int u = blockIdx.x; u < 256; u += F.G) { p4_mlstm<0>(F, INP, u); if (P4_REP_M > 1) p4_mlstm<P4_MODE>(F, INP, u); for (int r_ = 0; r_ < P4_REP_S; ++r_) p4_s5(F, INP, u); } } SEAM(4);
    if (IN(5)) { p5a_prep(F, INP); } SEAM(5);
    if (IN(6)) {
        pg8::Gemm g{(const bf16*)(F.ws + WS_A2), (const bf16*)(F.ws + WS_WGLU), 256, nullptr, 0x7f7f7f7f, 0x7a7a7a7a}; pg8::StaticOrder S; S.init(ML, 512, F.G, (int)blockIdx.x);
        EpiGlu E{(const bf16*)(F.ws + WS_A2), (bf16*)(F.ws + WS_A3), INP[22]};
        pg8::gemm_phase<EpiGlu, pg8::StaticOrder, false, true>(F.lds, g, S, E);
    }
    if (IN(7)) {
        pg8::Gemm g{(const bf16*)(F.ws + WS_A1), (const bf16*)(F.ws + WS_WA), 512, nullptr, 0x7f7f7f7f, 0x7a7a7a7a}; pg8::StaticOrder S; S.init(ML, 1024, F.G, (int)blockIdx.x);
        EpiGate<false> E{F.ws + WS_PROJ8, 1024, INP[24], nullptr, (bf16*)(F.ws + WS_YA)};
        pg8::gemm_phase<EpiGate<false>, pg8::StaticOrder, false, true>(F.lds, g, S, E);
    } SEAM(7);
    if (IN(8)) {
        pg8::Gemm g{(const bf16*)(F.ws + WS_A3), (const bf16*)(F.ws + WS_WB), 256, nullptr, 0x7f7f7f7f, 0x7a7a7a7a}; pg8::StaticOrder S; S.init(ML, 1024, F.G, (int)blockIdx.x);
        EpiGate<true> E{F.ws + WS_PROJ8, 2048, INP[24] + 1024, (const bf16*)(F.ws + WS_YA), (bf16*)(F.ws + WS_MERGED)};
        pg8::gemm_phase<EpiGate<true>, pg8::StaticOrder, false, true>(F.lds, g, S, E);
    } SEAM(8);
    if (IN(9)) {
        pg8::Gemm g{(const bf16*)(F.ws + WS_MERGED), (const bf16*)(F.ws + WS_WO), 512, nullptr, 0x7d7d7d7d, 0x7a7a7a7a}; pg8::StaticOrder S; S.init(ML, 1024, F.G, (int)blockIdx.x);
        EpiX1 E{INP[0], (const float*)(F.ws + WS_MOD), (bf16*)(F.ws + WS_X1)};
        pg8::gemm_phase<EpiX1, pg8::StaticOrder, false, true>(F.lds, g, S, E);
    } SEAM(9);
    if (IN(10)) { p6_route(F, INP); } SEAM(10);
    if (IN(11)) {
        moe_tables(F);
        MoeOrder S{F.G, (int)blockIdx.x, 8, (const LAS int*)(F.lds + TAB_OFF)};
        LAS unsigned short* ridx = (LAS unsigned short*)(F.lds + LDSCTL_OFF + 1024);
        { const int* LIST = (const int*)(F.ws + WS_LIST);
            for (int i = 0; i < 30; ++i) { pg8::Unit u; if (!S.next(i, u)) break;
                if (F.tid < 256) { const int rc = F.tid < u.nvalid ? F.tid : u.nvalid - 1; ridx[i * 256 + F.tid] = (unsigned short)LIST[u.lbase + rc]; } }
            __syncthreads(); }
        pg8::Gemm g{(const bf16*)(F.ws + WS_H2), (const bf16*)(F.ws + WS_WEIN), 512, ridx, 0x7f7f7f7f, 0x7a7a7a7a};
        EpiSwiglu E{INP[29], (bf16*)(F.ws + WS_ACT)};
        pg8::gemm_phase<EpiSwiglu, MoeOrder, true, true>(F.lds, g, S, E);
    } SEAM(11);
    if (IN(12)) {
        moe_tables(F);
        pg8::Gemm g{(const bf16*)(F.ws + WS_ACT), (const bf16*)(F.ws + WS_WEOUT), 512, nullptr, 0x7c7c7c7c, 0x7a7a7a7a}; MoeOrder S{F.G, (int)blockIdx.x, 4, (const LAS int*)(F.lds + TAB_OFF)};
        EpiY E{INP[31], (bf16*)(F.ws + WS_Y)};
        pg8::gemm_phase<EpiY, MoeOrder, false, true>(F.lds, g, S, E);
    } SEAM(12);
    if (IN(13)) { p10_combine(F, INP); }
#undef IN
#undef SEAM
}

extern "C" void kernel_launch(void* const* d_in, const int* in_sizes, int n_in, void* d_out, int out_size, void* d_ws, size_t ws_size, hipStream_t stream) {
    static int grid = 0;
    if (grid == 0) {
        if (n_in != 33 || out_size != ML * D || ws_size < WS_END2) { fprintf(stderr, "kernel_launch: unexpected shapes (n_in %d, out %d, ws %zu)\n", n_in, out_size, ws_size); grid = -1; return; }
        int dev = 0, cus = 0, per_cu = 0;
        if (hipGetDevice(&dev) != hipSuccess || hipDeviceGetAttribute(&cus, hipDeviceAttributeMultiprocessorCount, dev) != hipSuccess) { grid = -1; return; }
        if (hipFuncSetAttribute((const void*)fwd_kernel, hipFuncAttributeMaxDynamicSharedMemorySize, LDS_BYTES) != hipSuccess) { fprintf(stderr, "kernel_launch: hipFuncSetAttribute failed\n"); grid = -1; return; }
        if (hipOccupancyMaxActiveBlocksPerMultiprocessor(&per_cu, (const void*)fwd_kernel, NWAVES * 64, LDS_BYTES) != hipSuccess || per_cu < 1) fprintf(stderr, "kernel_launch: occupancy query reports %d\n", per_cu);
        (void)hipGetLastError();
        grid = cus;
    }
    if (grid < 0) return;
    if (hipMemsetAsync((char*)d_ws + WS_CTL, 0, CTL_ZERO_BYTES, stream) != hipSuccess) return;
    Args a{};
    for (int i = 0; i < 33; ++i) a.in[i] = (const float*)d_in[i];
    a.out = (float*)d_out; a.ws = (unsigned char*)d_ws;
    for (int li = 0; li < N_LAUNCHES; ++li) {
        a.ph_lo = (N_LAUNCHES == 1) ? 0 : li; a.ph_hi = (N_LAUNCHES == 1) ? NPH : li + 1; a.li = li;
        const int nrep = (N_LAUNCHES != 1 && (((PROBE_DUP_MASK) >> li) & 1)) ? 2 : 1;
        for (int r = 0; r < nrep; ++r) hipLaunchKernelGGL(fwd_kernel, dim3(grid), dim3(NWAVES * 64), LDS_BYTES, stream, a);
    }
}
```

```cpp
#include <hip/hip_runtime.h>
#include <cstdio>
#include <cstdint>

#ifndef MK_N_LAUNCHES
#define MK_N_LAUNCHES 1
#endif
#ifndef PROBE_DUP_MASK
#define PROBE_DUP_MASK 0
#endif
#ifndef P4_REP_M
#define P4_REP_M 1
#endif
#ifndef P4_MODE
#define P4_MODE 0
#endif
#ifndef P4_REP_S
#define P4_REP_S 1
#endif

namespace pg8 {
#define PG8_LAS __attribute__((address_space(3)))
typedef unsigned short bf16_t;
typedef short bf16x8 __attribute__((ext_vector_type(8)));
typedef float f32x4 __attribute__((ext_vector_type(4)));
typedef unsigned u32x4 __attribute__((ext_vector_type(4)));
constexpr int BM = 256, BK = 64, HALF = 128, HTB = HALF * BK * 2, STAGE_BYTES = 8 * HTB, NXCD = 8, WGM = 8;

__host__ __device__ __forceinline__ int lds_byte(int r, int c) { const int st = (r >> 4) * 2 + (c >> 5), rr = r & 15, cc = c & 31, ob = rr * 64 + cc * 2; return st * 1024 + (ob ^ (((ob >> 9) & 1) << 5)); }
__host__ __device__ __forceinline__ void stage_rc(int b, int& R, int& C) { const int st = b / 1024, sb = b % 1024, swz = sb ^ (((sb >> 9) & 1) << 5); R = (st >> 1) * 16 + swz / 64; C = (st & 1) * 32 + (swz % 64) / 2; }
__host__ __device__ __forceinline__ int perm32(int rho) { const int n = rho >> 4, i = rho & 15; return 8 * (i >> 2) + 4 * n + (i & 3); }

struct Unit { int pm, pn, lbase, nvalid; };
struct Gemm { const bf16_t* A; const bf16_t* Bt; int K; const PG8_LAS unsigned short* ridx; int sa, sb; };

__device__ __forceinline__ int xcd_remap(int L, int nwg) { const int q = nwg / NXCD, r = nwg % NXCD, xcd = L % NXCD, off = L / NXCD; return (xcd < r ? xcd * (q + 1) : r * (q + 1) + (xcd - r) * q) + off; }

struct StaticOrder {
    int nM, nN, nwg, G, c;
    __device__ void init(int M, int N, int G_, int c_) { nM = M / BM; nN = N / BM; nwg = nM * nN; G = G_; c = c_; }
    __device__ __forceinline__ bool next(int i, Unit& u) const {
        const long L = (long)i * G + c; if (L >= nwg) return false;
        const int wgid = xcd_remap((int)L, nwg);
        const int nig = WGM * nN, gid = wgid / nig, fm = gid * WGM, gsz = (nM - fm) < WGM ? (nM - fm) : WGM;
        u.pm = fm + ((wgid % nig) % gsz); u.pn = (wgid % nig) / gsz; u.lbase = 0; u.nvalid = 0; return true;
    }
};

__device__ __forceinline__ unsigned cvt_pk_bf16(float lo, float hi) { unsigned r; asm volatile("v_cvt_pk_bf16_f32 %0, %1, %2" : "=v"(r) : "v"(lo), "v"(hi)); return r; }

typedef int v8i __attribute__((ext_vector_type(8)));
typedef short s16x16 __attribute__((ext_vector_type(16)));
template <class Epi, class Sched, bool GATHER, bool FP8 = false>
__device__ __forceinline__ void gemm_phase(PG8_LAS unsigned char* lds, const Gemm g, const Sched& S, const Epi& E) {
    const int tid = threadIdx.x, wid = __builtin_amdgcn_readfirstlane(tid >> 6), lane = tid & 63, wr = wid >> 2, wc = wid & 3, fr = lane & 15, fq = lane >> 4;
    const int K = g.K, nt = K / BK;
    int Rr[2]; unsigned cby[2], voffB[2];
#pragma unroll
    for (int i = 0; i < 2; ++i) { int R, C; stage_rc(tid * 16 + i * 8192, R, C); const int Rb = Epi::PERM ? ((R & ~31) + perm32(R & 31)) : R;
        Rr[i] = R; cby[i] = (unsigned)C * 2u; voffB[i] = (unsigned)(Rb * K + C) * 2u; }
    const size_t kstep = (size_t)(BK * 2);
    const size_t hstep = (size_t)HALF * K * 2;
    const size_t tstep = 2 * hstep;
    const unsigned ldsw = (unsigned)wid * 1024u;
    const int aoff = lds_byte(wr * 64 + fr, FP8 ? fq * 16 : fq * 8), boff = lds_byte(wc * 32 + fr, FP8 ? fq * 16 : fq * 8);

#define PG8_SA(b, h) (((b) * 2 + (h)) * HTB)
#define PG8_SB(b, h) ((4 + (b) * 2 + (h)) * HTB)
#define PG8_STAGE(bufoff, gbase, voff) do { _Pragma("unroll") for (int _i = 0; _i < 2; ++_i) \
        __builtin_amdgcn_global_load_lds((const unsigned*)((const char*)(gbase) + (voff)[_i]), (PG8_LAS unsigned*)(lds + (bufoff) + ldsw + _i * 8192), 16, 0, 0); } while (0)
#define PG8_LDA(dst, b, h) do { if constexpr (FP8) { _Pragma("unroll") for (int m = 0; m < 4; ++m) { const bf16x8 _lo = *(const PG8_LAS bf16x8*)(lds + PG8_SA(b, h) + aoff + m * 2048), _hi = *(const PG8_LAS bf16x8*)(lds + PG8_SA(b, h) + aoff + m * 2048 + 16); dst##8[m] = __builtin_bit_cast(v8i, __builtin_shufflevector(_lo, _hi, 0, 1, 2, 3, 4, 5, 6, 7, 8, 9, 10, 11, 12, 13, 14, 15)); } } \
        else { _Pragma("unroll") for (int m = 0; m < 4; ++m) _Pragma("unroll") for (int k = 0; k < 2; ++k) dst[m][k] = *(const PG8_LAS bf16x8*)(lds + PG8_SA(b, h) + aoff + m * 2048 + k * 1024); } } while (0)
#define PG8_LDB(dst, b, h) do { if constexpr (FP8) { _Pragma("unroll") for (int n = 0; n < 2; ++n) { const bf16x8 _lo = *(const PG8_LAS bf16x8*)(lds + PG8_SB(b, h) + boff + n * 2048), _hi = *(const PG8_LAS bf16x8*)(lds + PG8_SB(b, h) + boff + n * 2048 + 16); dst##8[n] = __builtin_bit_cast(v8i, __builtin_shufflevector(_lo, _hi, 0, 1, 2, 3, 4, 5, 6, 7, 8, 9, 10, 11, 12, 13, 14, 15)); } } \
        else { _Pragma("unroll") for (int n = 0; n < 2; ++n) _Pragma("unroll") for (int k = 0; k < 2; ++k) dst[n][k] = *(const PG8_LAS bf16x8*)(lds + PG8_SB(b, h) + boff + n * 2048 + k * 1024); } } while (0)
#define PG8_MMA(ai, bj, At, Bt) do { __builtin_amdgcn_s_setprio(1); _Pragma("unroll") for (int m = 0; m < 4; ++m) _Pragma("unroll") for (int n = 0; n < 2; ++n) { \
        if constexpr (FP8) asm volatile("v_mfma_scale_f32_16x16x128_f8f6f4 %0, %1, %2, %0, %3, %4 op_sel_hi:[0,0,0]" : "+v"(acc[ai][bj][m][n]) : "v"(Bt##8[n]), "v"(At##8[m]), "v"(vsb), "v"(vsa));   \
        else { _Pragma("unroll") for (int k = 0; k < 2; ++k) acc[ai][bj][m][n] = __builtin_amdgcn_mfma_f32_16x16x32_bf16(Bt[n][k], At[m][k], acc[ai][bj][m][n], 0, 0, 0); } } \
        __builtin_amdgcn_s_setprio(0); } while (0)
#define PG8_WAIT_V(n) asm volatile("s_waitcnt vmcnt(" #n ")" ::: "memory")
#define PG8_WAIT_L(n) asm volatile("s_waitcnt lgkmcnt(" #n ")" ::: "memory")
#define PG8_BAR __builtin_amdgcn_s_barrier()
#define PG8_SCHED __builtin_amdgcn_sched_barrier(0)
#define PG8_AOFF(dst, u, uord) do { _Pragma("unroll") for (int _h = 0; _h < 2; ++_h) _Pragma("unroll") for (int _i = 0; _i < 2; ++_i) { const int _r = _h * HALF + Rr[_i]; \
        if constexpr (GATHER) { const int _idx = g.ridx[(uord) * 256 + _r]; dst[_h][_i] = (unsigned)_idx * (unsigned)(K * 2) + cby[_i]; } \
        else { dst[_h][_i] = (unsigned)(_r * K * 2) + cby[_i]; } } } while (0)
    Unit cur, nxt; int ui = 0;
    if (!S.next(0, cur)) return;
    f32x4 acc[2][2][4][2];
#pragma unroll
    for (int a = 0; a < 2; ++a)
#pragma unroll
        for (int b = 0; b < 2; ++b)
#pragma unroll
            for (int m = 0; m < 4; ++m)
#pragma unroll
                for (int n = 0; n < 2; ++n) acc[a][b][m][n] = (f32x4){0.f, 0.f, 0.f, 0.f};
    const int vsa = g.sa, vsb = g.sb;
    bf16x8 At[4][2], B0[2][2], B1[2][2];
    v8i At8[4], B08[2], B18[2];
    unsigned vc[2][2], vn[2][2];
    PG8_AOFF(vc, cur, 0);
    const char* cA = GATHER ? (const char*)g.A : (const char*)g.A + (size_t)cur.pm * tstep; const char* cB = (const char*)g.Bt + (size_t)cur.pn * tstep;
    PG8_STAGE(PG8_SB(0, 0), cB, voffB); PG8_STAGE(PG8_SB(0, 1), cB + hstep, voffB); PG8_STAGE(PG8_SA(0, 0), cA, vc[0]); PG8_STAGE(PG8_SA(0, 1), cA, vc[1]);
    if (wr == 1) PG8_BAR;
    PG8_WAIT_V(2); PG8_BAR;
    PG8_STAGE(PG8_SB(1, 0), cB + kstep, voffB); PG8_STAGE(PG8_SA(1, 0), cA + kstep, vc[0]); PG8_STAGE(PG8_SB(1, 1), cB + hstep + kstep, voffB);
    PG8_WAIT_V(6); PG8_BAR;
    for (;;) {
        const bool has_next = S.next(ui + 1, nxt);
        const char* nA = (has_next && !GATHER) ? (const char*)g.A + (size_t)nxt.pm * tstep : cA; const char* nB = has_next ? (const char*)g.Bt + (size_t)nxt.pn * tstep : cB;
        if constexpr (GATHER) { if (has_next) { PG8_AOFF(vn, nxt, ui + 1); } else {
#pragma unroll
            for (int h = 0; h < 2; ++h) { vn[h][0] = vc[h][0]; vn[h][1] = vc[h][1]; } } }
#pragma unroll 1
        for (int t = 0; t < nt; t += 2) {
            const bool last = (t == nt - 2);
            const char* a1 = cA + (size_t)(t + 1) * kstep;
            const char* a2 = last ? nA : cA + (size_t)(t + 2) * kstep; const char* b2 = last ? nB : cB + (size_t)(t + 2) * kstep;
            const char* a3 = a2 + kstep; const char* b3 = b2 + kstep;
            unsigned v2[2][2];
#pragma unroll
            for (int h = 0; h < 2; ++h)
#pragma unroll
                for (int i = 0; i < 2; ++i) v2[h][i] = GATHER ? (last ? vn[h][i] : vc[h][i]) : vc[h][i];
            PG8_LDB(B0, 0, 0); PG8_LDB(B1, 0, 1); PG8_SCHED; PG8_LDA(At, 0, 0); PG8_STAGE(PG8_SA(1, 1), a1, vc[1]);
            PG8_WAIT_V(8); PG8_WAIT_L(0); PG8_BAR; PG8_MMA(0, 0, At, B0); PG8_MMA(0, 1, At, B1); PG8_BAR; PG8_SCHED;
            PG8_LDA(At, 0, 1); PG8_STAGE(PG8_SB(0, 0), b2, voffB); PG8_STAGE(PG8_SB(0, 1), b2 + hstep, voffB); PG8_STAGE(PG8_SA(0, 0), a2, v2[0]);
            PG8_WAIT_V(8); PG8_WAIT_L(0); PG8_BAR; PG8_MMA(1, 0, At, B0); PG8_MMA(1, 1, At, B1); PG8_BAR; PG8_SCHED;
            PG8_LDB(B0, 1, 0); PG8_LDB(B1, 1, 1); PG8_SCHED; PG8_LDA(At, 1, 0); PG8_STAGE(PG8_SA(0, 1), a2, v2[1]);
            PG8_WAIT_V(8); PG8_WAIT_L(0); PG8_BAR; PG8_MMA(0, 0, At, B0); PG8_MMA(0, 1, At, B1); PG8_BAR; PG8_SCHED;
            PG8_LDA(At, 1, 1); PG8_STAGE(PG8_SB(1, 0), b3, voffB); PG8_STAGE(PG8_SB(1, 1), b3 + hstep, voffB); PG8_STAGE(PG8_SA(1, 0), a3, v2[0]);
            PG8_WAIT_V(8); PG8_WAIT_L(0); PG8_BAR; PG8_MMA(1, 0, At, B0); PG8_MMA(1, 1, At, B1); PG8_BAR; PG8_SCHED;
        }
        if (wr == 0) PG8_BAR;
        if constexpr (FP8) asm volatile("s_nop 15\n\ts_nop 15" ::: "memory");
        E(acc, cur, wr, wc, fr, fq);
        if (!has_next) break;
#pragma unroll
        for (int a = 0; a < 2; ++a)
#pragma unroll
            for (int b = 0; b < 2; ++b)
#pragma unroll
                for (int m = 0; m < 4; ++m)
#pragma unroll
                    for (int n = 0; n < 2; ++n) acc[a][b][m][n] = (f32x4){0.f, 0.f, 0.f, 0.f};
        cur = nxt; cA = nA; cB = nB; ++ui;
        if constexpr (GATHER) {
#pragma unroll
            for (int h = 0; h < 2; ++h) { vc[h][0] = vn[h][0]; vc[h][1] = vn[h][1]; } }
        if (wr == 1) PG8_BAR;
    }
    PG8_WAIT_V(0);
    PG8_BAR;
#undef PG8_SA
#undef PG8_SB
#undef PG8_STAGE
#undef PG8_LDA
#undef PG8_LDB
#undef PG8_MMA
#undef PG8_WAIT_V
#undef PG8_WAIT_L
#undef PG8_BAR
#undef PG8_SCHED
#undef PG8_AOFF
}
}

constexpr int NWAVES = 8;
constexpr int D = 1024, NB = 8, SEQ = 4096, CTXL = 256;
constexpr int ML = NB * SEQ, MC = NB * CTXL, MT = ML + MC;
constexpr int LDP = 5888;
constexpr int PC_QK = 0, PC_V = 1024, PC_U = 2048, PC_O = 2560, PC_G = 3584, PC_IF = 5632;
constexpr int NEXP = 32, TOPK = 4;
constexpr int MAXTILES = (ML * TOPK + NEXP * 256) / 256;
constexpr float EPS = 1e-6f;
constexpr int NPH = 14;
constexpr int N_LAUNCHES = MK_N_LAUNCHES;

constexpr size_t MiB = 1u << 20;
constexpr size_t WS_CTL = 0, CTL_ZERO_BYTES = 1 * MiB;
constexpr size_t WS_MOD = 1 * MiB;
constexpr size_t WS_TOPE = 2 * MiB, WS_POS = 2 * MiB + 512 * 1024, WS_TOPP = 3 * MiB, WS_LIST = 4 * MiB;
constexpr size_t WS_WIN = 8 * MiB, WS_WGLU = 20 * MiB, WS_WA = 21 * MiB, WS_WB = 23 * MiB, WS_WO = 24 * MiB, WS_WEIN = 26 * MiB, WS_WEOUT = 90 * MiB, WS_PROJ8 = 122 * MiB;
constexpr size_t WS_R0 = 218 * MiB;
constexpr size_t WS_PROJ = WS_R0, WS_H1 = 609 * MiB, WS_QKC = 677 * MiB, WS_HDIR = 745 * MiB, WS_YDIR = 873 * MiB, WS_END = 937 * MiB;
constexpr size_t WS_A1 = WS_H1, WS_A2 = WS_QKC, WS_A3 = WS_QKC + 32 * MiB, WS_YA = WS_HDIR, WS_MERGED = WS_HDIR + 64 * MiB;
constexpr size_t WS_GS = 940 * MiB, WS_X1 = 940 * MiB, WS_END2 = 1004 * MiB;
constexpr size_t WS_H2 = WS_R0, WS_ACT = 282 * MiB, WS_Y = 554 * MiB;
static_assert(WS_PROJ + (size_t)MT * LDP * 2 <= WS_H1 && WS_Y + (size_t)MAXTILES * 256 * 1024 * 2 <= WS_END, "ws map");
constexpr int CW_BAR = 4096, CW_CNT = 16384;

constexpr int RING_BYTES = 131072;
constexpr int LDSCTL_OFF = RING_BYTES, MISC_OFF = LDSCTL_OFF + 320, TAB_OFF = LDSCTL_OFF + 512;
constexpr int LDS_BYTES = 147456;

#define GAS __attribute__((address_space(1)))
#define LAS __attribute__((address_space(3)))
typedef unsigned short bf16;
typedef unsigned v4u __attribute__((ext_vector_type(4)));
typedef unsigned v2u __attribute__((ext_vector_type(2)));
typedef float f32x4 __attribute__((ext_vector_type(4)));
typedef float f32x16 __attribute__((ext_vector_type(16)));
typedef short bf16x8 __attribute__((ext_vector_type(8)));
typedef GAS unsigned gu32;
#define RLX_AGENT __ATOMIC_RELAXED, __HIP_MEMORY_SCOPE_AGENT
#define LDS_WAIT() asm volatile("s_waitcnt lgkmcnt(0)" ::: "memory")
#define LBAR() do { asm volatile("s_waitcnt lgkmcnt(0)" ::: "memory"); __builtin_amdgcn_s_barrier(); asm volatile("" ::: "memory"); } while (0)
__device__ __forceinline__ unsigned f2bf(float f) { unsigned u = __builtin_bit_cast(unsigned, f); return (u + 0x7fffu + ((u >> 16) & 1u)) >> 16; }
typedef __bf16 bf16x2_t __attribute__((ext_vector_type(2)));
__device__ __forceinline__ unsigned cvtpk(float lo, float hi) { const bf16x2_t v = {(__bf16)lo, (__bf16)hi}; return __builtin_bit_cast(unsigned, v); }
__device__ __forceinline__ unsigned pk2(float lo, float hi) { return cvtpk(lo, hi); }
__device__ __forceinline__ float clamp448(float x) { return fminf(fmaxf(x, -448.0f), 448.0f); }
__device__ __forceinline__ unsigned pk4_fp8(float a, float b, float c, float d) {
    unsigned w = 0; w = __builtin_amdgcn_cvt_pk_fp8_f32(clamp448(a), clamp448(b), w, false); w = __builtin_amdgcn_cvt_pk_fp8_f32(clamp448(c), clamp448(d), w, true); return w; }
__device__ __forceinline__ float bf2f(unsigned b) { return __builtin_bit_cast(float, b << 16); }
__device__ __forceinline__ float bflo(unsigned w) { return __builtin_bit_cast(float, w << 16); }
__device__ __forceinline__ float bfhi(unsigned w) { return __builtin_bit_cast(float, w & 0xffff0000u); }
__device__ __forceinline__ float frcp(float x) { return __builtin_amdgcn_rcpf(x); }
__device__ __forceinline__ float sigmoidf_(float x) { return frcp(1.0f + __expf(-x)); }

#define XB_TMO      128
#define XB_XCNT(j)  (256  + 64 * (j))
#define XB_XSUB(j)  (1280 + 64 * (j))
#define XB_XGEN(j)  (2304 + 64 * (j))
#define XB_TOP      3328
#define XB_TOPGEN   3392
#define XCD_BAR_WORDS 3456
#define XB_SPIN_CAP (1u << 22)
__device__ __forceinline__ unsigned xb_ld(unsigned* p)              { return __hip_atomic_load(p, __ATOMIC_RELAXED, __HIP_MEMORY_SCOPE_AGENT); }
__device__ __forceinline__ unsigned xb_add(unsigned* p, unsigned v) { return __hip_atomic_fetch_add(p, v, __ATOMIC_RELAXED, __HIP_MEMORY_SCOPE_AGENT); }
__device__ __forceinline__ unsigned xb_xcc_id() { return (unsigned)__builtin_amdgcn_s_getreg((3 << 11) | 20) & 0xFu; }
#define XB_SPIN(cond, bar) do { unsigned _sp = 0; while (cond) { __builtin_amdgcn_s_sleep(1); \
    if ((++_sp & 255u) == 0u) { if (xb_ld(&(bar)[XB_TMO])) break; if (_sp > XB_SPIN_CAP) { atomicAdd(&(bar)[XB_TMO], 1u); break; } } } } while (0)
struct XcdBarrier { unsigned* bar; unsigned x; volatile LAS unsigned* st; };
__device__ __forceinline__ XcdBarrier xcd_barrier_post(unsigned* bar, volatile LAS unsigned* st) {
    XcdBarrier b; b.bar = bar; b.x = xb_xcc_id(); b.st = st;
    if (threadIdx.x == 0) (void)xb_add(&bar[XB_XCNT(b.x)], 1u);
    return b;
}
__device__ __forceinline__ void xcd_barrier_complete(unsigned* bar, unsigned x, unsigned& nloc, unsigned& nx) {
    const unsigned G = gridDim.x * gridDim.y * gridDim.z;
    unsigned sum, cnt, mine, sp = 0u;
    for (;;) {
        sum = 0u; cnt = 0u; mine = 0u;
#pragma unroll
        for (unsigned j = 0; j < 16; ++j) { const unsigned c = xb_ld(&bar[XB_XCNT(j)]); sum += c; cnt += (c > 0u) ? 1u : 0u; mine = (j == x) ? c : mine; }
        if (sum == G) break;
        __builtin_amdgcn_s_sleep(1);
        if ((++sp & 255u) == 0u) { if (xb_ld(&bar[XB_TMO])) break; if (sp > XB_SPIN_CAP) { atomicAdd(&bar[XB_TMO], 1u); break; } }
    }
    nloc = mine > 0u ? mine : 1u; nx = cnt > 0u ? cnt : 1u;
}
__device__ __forceinline__ void xcd_barrier(const XcdBarrier& b) {
    asm volatile("s_waitcnt vmcnt(0)" ::: "memory");
    __syncthreads();
    if (threadIdx.x == 0) {
        unsigned* bar = b.bar;
        __builtin_amdgcn_s_waitcnt(0);
        unsigned nloc = b.st[0], nx = b.st[1];
        if (nloc == 0u) { xcd_barrier_complete(bar, b.x, nloc, nx); b.st[0] = nloc; b.st[1] = nx; }
        const unsigned old = xb_add(&bar[XB_XSUB(b.x)], 1u);
        const unsigned gen = old / nloc;
        if (old + 1u == (gen + 1u) * nloc) {
            __builtin_amdgcn_fence(__ATOMIC_RELEASE, "agent");
            asm volatile("s_waitcnt vmcnt(0)" ::: "memory");
            const unsigned og = xb_add(&bar[XB_TOP], 1u);
            const unsigned tg = og / nx;
            if (og + 1u == (tg + 1u) * nx) xb_add(&bar[XB_TOPGEN], 1u);
            else XB_SPIN(xb_ld(&bar[XB_TOPGEN]) == tg, bar);
            __builtin_amdgcn_fence(__ATOMIC_ACQUIRE, "agent");
            xb_add(&bar[XB_XGEN(b.x)], 1u);
            asm volatile("s_waitcnt vmcnt(0)" ::: "memory");
        } else {
            XB_SPIN(xb_ld(&bar[XB_XGEN(b.x)]) == gen, bar);
            __builtin_amdgcn_fence(__ATOMIC_ACQUIRE, "agent");
            asm volatile("s_waitcnt vmcnt(0)" ::: "memory");
        }
    }
    __syncthreads();
}

struct Frame {
    LAS unsigned char* lds;
    gu32* ctl;
    int tid, lane, wave, vcu, G;
    float* out; unsigned char* ws;
};
__device__ __forceinline__ float wave_sum(float v) {
#pragma unroll
    for (int o = 1; o < 64; o <<= 1) v += __shfl_xor(v, o);
    return v;
}

struct InProjOrder {
    int G, c;
    __device__ __forceinline__ bool next(int i, pg8::Unit& u) const {
        const int NL = 128 * 23, NC = 8 * 11;
        const long L = (long)i * G + c; if (L >= NL + NC) return false;
        u.lbase = 0; u.nvalid = 0;
        if (L < NL) { const int wgid = pg8::xcd_remap((int)L, NL); const int nig = 8 * 23, gid = wgid / nig, fm = gid * 8; u.pm = fm + ((wgid % nig) % 8); u.pn = (wgid % nig) / 8; }
        else { const int r = (int)L - NL; u.pm = 128 + r / 11; const int q = r % 11; u.pn = q < 10 ? q : 22; }
        return true;
    }
};
struct MoeOrder {
    int G, c, npn; const LAS int* tab;
    __device__ __forceinline__ bool next(int i, pg8::Unit& u) const {
        const int nT = __builtin_amdgcn_readfirstlane(tab[32]); const int nU = nT * npn;
        const long L = (long)i * G + c; if (L >= nU) return false;
        const int wgid = pg8::xcd_remap((int)L, nU);
        const int tau = wgid / npn, pl = wgid % npn;
        int e = 0;
        for (int k = 1; k < 32; ++k) e += (__builtin_amdgcn_readfirstlane(tab[k]) <= tau) ? 1 : 0;
        const int il = tau - __builtin_amdgcn_readfirstlane(tab[e]);
        u.pm = tau; u.pn = e * npn + pl; u.lbase = e * ML + 256 * il; u.nvalid = __builtin_amdgcn_readfirstlane(tab[33 + e]) - 256 * il;
        return true;
    }
};
__device__ __forceinline__ void moe_tables(Frame& F) {
    LAS int* tab = (LAS int*)(F.lds + TAB_OFF);
    __syncthreads();
    if (F.tid < 32) tab[33 + F.tid] = (int)__hip_atomic_load(F.ctl + CW_CNT + 64 * F.tid, RLX_AGENT);
    __syncthreads();
    if (F.tid == 0) {
        int acc = 0;
        for (int e = 0; e < 32; ++e) { tab[e] = acc; acc += (tab[33 + e] + 255) >> 8; }
        tab[32] = acc;
    }
    __syncthreads();
}

using pg8::f32x4; using pg8::u32x4; using pg8::cvt_pk_bf16;
#define EPI_ROWS(u) const int row0 = (u).pm * 256 + wr * 64 + fr
#define EPI_LOOP _Pragma("unroll") for (int ai = 0; ai < 2; ++ai) _Pragma("unroll") for (int m = 0; m < 4; ++m)
__device__ __forceinline__ u32x4 pack8(const f32x4 a, const f32x4 b) { u32x4 w; w.x = cvt_pk_bf16(a[0], a[1]); w.y = cvt_pk_bf16(a[2], a[3]); w.z = cvt_pk_bf16(b[0], b[1]); w.w = cvt_pk_bf16(b[2], b[3]); return w; }
__device__ __forceinline__ void unpack8(const u32x4 w, f32x4& a, f32x4& b) { a = (f32x4){bflo(w.x), bfhi(w.x), bflo(w.y), bfhi(w.y)}; b = (f32x4){bflo(w.z), bfhi(w.z), bflo(w.w), bfhi(w.w)}; }
__device__ __forceinline__ void unpack8_fp8(const v2u w, f32x4& a, f32x4& b) {
    const auto l0 = __builtin_amdgcn_cvt_pk_f32_fp8((int)w.x, false), h0 = __builtin_amdgcn_cvt_pk_f32_fp8((int)w.x, true), l1 = __builtin_amdgcn_cvt_pk_f32_fp8((int)w.y, false), h1 = __builtin_amdgcn_cvt_pk_f32_fp8((int)w.y, true);
    a = (f32x4){l0[0], l0[1], h0[0], h0[1]}; b = (f32x4){l1[0], l1[1], h1[0], h1[1]}; }
__device__ __forceinline__ v2u pack8_fp8(const f32x4 a, const f32x4 b) { return (v2u){pk4_fp8(a[0], a[1], a[2], a[3]), pk4_fp8(b[0], b[1], b[2], b[3])}; }
__device__ __forceinline__ f32x4 sig4(f32x4 x) { return (f32x4){sigmoidf_(x[0]), sigmoidf_(x[1]), sigmoidf_(x[2]), sigmoidf_(x[3])}; }

struct EpiStore {
    static constexpr bool PERM = true; bf16* O; int ldc; unsigned char* P8;
    __device__ __forceinline__ void operator()(const f32x4 (&acc)[2][2][4][2], const pg8::Unit& u, int wr, int wc, int fr, int fq) const {
        EPI_ROWS(u); const int col0 = u.pn * 256 + wc * 32 + 8 * fq;
        if (u.pn == 22 && wc != 0) return;
        if (u.pn >= 10 && u.pn < 22) {
            EPI_LOOP { unsigned char* rowp = P8 + (size_t)(row0 + ai * 128 + m * 16) * 3072 + (col0 - PC_O);
#pragma unroll
                for (int bj = 0; bj < 2; ++bj) *(v2u*)(rowp + bj * 128) = pack8_fp8(acc[ai][bj][m][0], acc[ai][bj][m][1]); }
            return; }
        EPI_LOOP { bf16* rowp = O + (size_t)(row0 + ai * 128 + m * 16) * ldc + col0;
#pragma unroll
            for (int bj = 0; bj < 2; ++bj) if (u.pn != 22 || bj == 0) *(u32x4*)(rowp + bj * 128) = pack8(acc[ai][bj][m][0], acc[ai][bj][m][1]); }
    }
};
struct EpiGlu {
    static constexpr bool PERM = true; const bf16* A2; bf16* A3; const float* bias;
    __device__ __forceinline__ void operator()(const f32x4 (&acc)[2][2][4][2], const pg8::Unit& u, int wr, int wc, int fr, int fq) const {
        EPI_ROWS(u); const int col0 = u.pn * 256 + wc * 32 + 8 * fq;
        f32x4 bv[2][2];
#pragma unroll
        for (int bj = 0; bj < 2; ++bj)
#pragma unroll
            for (int n = 0; n < 2; ++n) bv[bj][n] = *(const f32x4*)(bias + col0 + bj * 128 + 4 * n);
#pragma unroll
        for (int ai = 0; ai < 2; ++ai) {
            v2u ld[4][2];
#pragma unroll
            for (int m = 0; m < 4; ++m)
#pragma unroll
                for (int bj = 0; bj < 2; ++bj) ld[m][bj] = *(const v2u*)((const unsigned char*)A2 + (size_t)(row0 + ai * 128 + m * 16) * 512 + col0 + bj * 128);
            __builtin_amdgcn_sched_barrier(0);
#pragma unroll
            for (int m = 0; m < 4; ++m)
#pragma unroll
                for (int bj = 0; bj < 2; ++bj) { f32x4 a0, a1; unpack8_fp8(ld[m][bj], a0, a1);
                    const f32x4 v0 = a0 * sig4(acc[ai][bj][m][0] + bv[bj][0]), v1 = a1 * sig4(acc[ai][bj][m][1] + bv[bj][1]);
                    *(v2u*)((unsigned char*)A3 + (size_t)(row0 + ai * 128 + m * 16) * 512 + col0 + bj * 128) = pack8_fp8(v0, v1); }
        }
    }
};
template <bool ADD> struct EpiGate {
    static constexpr bool PERM = true; const unsigned char* proj; int gc0; const float* bg; const bf16* Prev; bf16* O;
    __device__ __forceinline__ void operator()(const f32x4 (&acc)[2][2][4][2], const pg8::Unit& u, int wr, int wc, int fr, int fq) const {
        EPI_ROWS(u); const int col0 = u.pn * 256 + wc * 32 + 8 * fq;
        f32x4 bv[2][2];
#pragma unroll
        for (int bj = 0; bj < 2; ++bj)
#pragma unroll
            for (int n = 0; n < 2; ++n) bv[bj][n] = *(const f32x4*)(bg + col0 + bj * 128 + 4 * n);
        constexpr int MB = ADD ? 2 : 4;
#pragma unroll
        for (int g = 0; g < 8 / MB; ++g) {
            v2u lg[MB][2]; u32x4 lp[MB][2];
#pragma unroll
            for (int mm = 0; mm < MB; ++mm)
#pragma unroll
                for (int bj = 0; bj < 2; ++bj) { const int q = g * MB + mm, row = row0 + (q >> 2) * 128 + (q & 3) * 16; lg[mm][bj] = *(const v2u*)(proj + (size_t)row * 3072 + gc0 + col0 + bj * 128);
                    if (ADD) lp[mm][bj] = *(const u32x4*)(Prev + (size_t)row * 1024 + col0 + bj * 128); }
            __builtin_amdgcn_sched_barrier(0);
#pragma unroll
            for (int mm = 0; mm < MB; ++mm)
#pragma unroll
                for (int bj = 0; bj < 2; ++bj) { const int q = g * MB + mm, ai = q >> 2, m = q & 3; f32x4 g0, g1; unpack8_fp8(lg[mm][bj], g0, g1);
                    f32x4 v0 = sig4(g0 + bv[bj][0]) * acc[ai][bj][m][0], v1 = sig4(g1 + bv[bj][1]) * acc[ai][bj][m][1];
                    if (ADD) { f32x4 p0, p1; unpack8(lp[mm][bj], p0, p1); v0 += p0; v1 += p1; }
                    if (ADD) *(v2u*)((unsigned char*)O + (size_t)(row0 + ai * 128 + m * 16) * 1024 + col0 + bj * 128) = pack8_fp8(v0 * 4.0f, v1 * 4.0f);
                    else *(u32x4*)(O + (size_t)(row0 + ai * 128 + m * 16) * 1024 + col0 + bj * 128) = pack8(v0, v1); }
            __builtin_amdgcn_sched_barrier(0);
        }
    }
};
struct EpiX1 {
    static constexpr bool PERM = true; const float* x; const float* mod; bf16* X1;
    __device__ __forceinline__ void operator()(const f32x4 (&acc)[2][2][4][2], const pg8::Unit& u, int wr, int wc, int fr, int fq) const {
        EPI_ROWS(u); const int col0 = u.pn * 256 + wc * 32 + 8 * fq; const int b = (u.pm * 256) / SEQ;
        f32x4 gv[2][2];
#pragma unroll
        for (int bj = 0; bj < 2; ++bj)
#pragma unroll
            for (int n = 0; n < 2; ++n) gv[bj][n] = *(const f32x4*)(mod + b * 6144 + 2 * D + col0 + bj * 128 + 4 * n);
#pragma unroll
        for (int g = 0; g < 4; ++g) {
            f32x4 lx[2][2][2];
#pragma unroll
            for (int mm = 0; mm < 2; ++mm)
#pragma unroll
                for (int bj = 0; bj < 2; ++bj) { const int q = g * 2 + mm; const size_t off = (size_t)(row0 + (q >> 2) * 128 + (q & 3) * 16) * D + col0 + bj * 128; lx[mm][bj][0] = *(const f32x4*)(x + off); lx[mm][bj][1] = *(const f32x4*)(x + off + 4); }
            __builtin_amdgcn_sched_barrier(0);
#pragma unroll
            for (int mm = 0; mm < 2; ++mm)
#pragma unroll
                for (int bj = 0; bj < 2; ++bj) { const int q = g * 2 + mm, ai = q >> 2, m = q & 3; const size_t off = (size_t)(row0 + ai * 128 + m * 16) * D + col0 + bj * 128;
                    *(u32x4*)(X1 + off) = pack8(lx[mm][bj][0] + gv[bj][0] * acc[ai][bj][m][0], lx[mm][bj][1] + gv[bj][1] * acc[ai][bj][m][1]); }
            __builtin_amdgcn_sched_barrier(0);
        }
    }
};
struct EpiSwiglu {
    static constexpr bool PERM = true; const float* bin; bf16* ACT;
    __device__ __forceinline__ void operator()(const f32x4 (&acc)[2][2][4][2], const pg8::Unit& u, int wr, int wc, int fr, int fq) const {
        EPI_ROWS(u); const int e = u.pn >> 3, pl = u.pn & 7; const int f0 = pl * 128 + wc * 32 + 8 * fq;
        f32x4 bg[2], bl[2];
#pragma unroll
        for (int n = 0; n < 2; ++n) { bg[n] = *(const f32x4*)(bin + e * 2048 + f0 + 4 * n); bl[n] = *(const f32x4*)(bin + e * 2048 + 1024 + f0 + 4 * n); }
        EPI_LOOP { f32x4 o[2];
#pragma unroll
            for (int n = 0; n < 2; ++n) { const f32x4 zg = acc[ai][0][m][n] + bg[n], zl = acc[ai][1][m][n] + bl[n];
#pragma unroll
                for (int j = 0; j < 4; ++j) { const float gl = fminf(zg[j], 7.0f); const float li = fminf(fmaxf(zl[j], -7.0f), 7.0f); o[n][j] = gl * sigmoidf_(1.702f * gl) * (li + 1.0f); } }
            *(v2u*)((unsigned char*)ACT + (size_t)(row0 + ai * 128 + m * 16) * 1024 + f0) = (v2u){pk4_fp8(8.f * o[0][0], 8.f * o[0][1], 8.f * o[0][2], 8.f * o[0][3]), pk4_fp8(8.f * o[1][0], 8.f * o[1][1], 8.f * o[1][2], 8.f * o[1][3])}; }
    }
};
struct EpiY {
    static constexpr bool PERM = true; const float* bout; bf16* Y;
    __device__ __forceinline__ void operator()(const f32x4 (&acc)[2][2][4][2], const pg8::Unit& u, int wr, int wc, int fr, int fq) const {
        EPI_ROWS(u); const int e = u.pn >> 2, pl = u.pn & 3; const int col0 = pl * 256 + wc * 32 + 8 * fq;
        f32x4 bv[2][2];
#pragma unroll
        for (int bj = 0; bj < 2; ++bj)
#pragma unroll
            for (int n = 0; n < 2; ++n) bv[bj][n] = *(const f32x4*)(bout + e * 1024 + col0 + bj * 128 + 4 * n);
        EPI_LOOP { unsigned char* rowp = (unsigned char*)Y + (size_t)(row0 + ai * 128 + m * 16) * 1024 + col0;
#pragma unroll
            for (int bj = 0; bj < 2; ++bj) { const f32x4 v0 = (acc[ai][bj][m][0] + bv[bj][0]) * 16.0f, v1 = (acc[ai][bj][m][1] + bv[bj][1]) * 16.0f;
                *(v2u*)(rowp + bj * 128) = (v2u){pk4_fp8(v0[0], v0[1], v0[2], v0[3]), pk4_fp8(v1[0], v1[1], v1[2], v1[3])}; } }
    }
};

struct TItem { const float* src; bf16* dst; int ld, ldk; int f8; };
__device__ __forceinline__ void titem_load(const TItem& t, int lane, f32x4 (&r)[8]) {
#pragma unroll
    for (int i = 0; i < 8; ++i) r[i] = *(const f32x4*)(t.src + (size_t)(8 * i + (lane >> 3)) * t.ld + 4 * (lane & 7));
}
__device__ __forceinline__ void titem_store(const TItem& t, int lane, const f32x4 (&r)[8], LAS float* scr) {
#pragma unroll
    for (int i = 0; i < 8; ++i) { LAS float* p = scr + (8 * i + (lane >> 3)) * 33 + 4 * (lane & 7); p[0] = r[i][0]; p[1] = r[i][1]; p[2] = r[i][2]; p[3] = r[i][3]; }
    LDS_WAIT(); asm volatile("" ::: "memory");
    const int c = lane & 7;
#pragma unroll
    for (int j = 0; j < 4; ++j) { const int n = (lane >> 3) + 8 * j; const LAS float* s = scr + (8 * c) * 33 + n;
        if (t.f8) { *(GAS v2u*)((unsigned char*)t.dst + (size_t)n * t.ldk + 8 * c) = (v2u){pk4_fp8(32.f * s[0 * 33], 32.f * s[1 * 33], 32.f * s[2 * 33], 32.f * s[3 * 33]), pk4_fp8(32.f * s[4 * 33], 32.f * s[5 * 33], 32.f * s[6 * 33], 32.f * s[7 * 33])}; }
        else { v4u o; o.x = pk2(s[0 * 33], s[1 * 33]); o.y = pk2(s[2 * 33], s[3 * 33]); o.z = pk2(s[4 * 33], s[5 * 33]); o.w = pk2(s[6 * 33], s[7 * 33]);
            *(GAS v4u*)(t.dst + (size_t)n * t.ldk + 8 * c) = o; } }
    LDS_WAIT(); asm volatile("" ::: "memory");
}
__device__ __forceinline__ void p0_prologue(Frame& F, const float* const* __restrict__ INP) {
    {
        LAS float* sc = (LAS float*)(F.lds);
        LAS float* red = (LAS float*)(F.lds + 9 * 1024 * 4);
        for (int i = F.tid; i < 9 * 1024; i += NWAVES * 64) { const int r = i >> 10, k = i & 1023; const float v = r < 8 ? INP[1][r * 1024 + k] : INP[3][k]; sc[i] = v / (1.0f + expf(-v)); }
        __syncthreads();
        const float* wada = INP[4]; const float* bada = INP[5];
        float* mod = (float*)(F.ws + WS_MOD);
        for (int cg = blockIdx.x; cg < 256; cg += F.G) {
            const int j0 = cg * 24, col = F.lane & 31, kp = F.lane >> 5;
            float a[9];
#pragma unroll
            for (int r = 0; r < 9; ++r) a[r] = 0.f;
            if (col < 24) {
#pragma unroll 16
                for (int i = 0; i < 64; ++i) { const int k = F.wave * 128 + 2 * i + kp; const float wv = wada[(size_t)k * 6144 + j0 + col];
#pragma unroll
                    for (int r = 0; r < 9; ++r) a[r] += sc[r * 1024 + k] * wv; }
            }
#pragma unroll
            for (int r = 0; r < 9; ++r) red[((F.wave * 2 + kp) * 9 + r) * 32 + col] = a[r];
            __syncthreads();
            if (F.tid < 9 * 32) { const int r = F.tid >> 5, cc = F.tid & 31;
                if (cc < 24) { float s = 0.f; for (int p = 0; p < 16; ++p) s += red[(p * 9 + r) * 32 + cc]; const int j = j0 + cc; s += bada[j];
                    if (r < 8) mod[r * 6144 + j] = s; else if (j < 2048) mod[8 * 6144 + j] = s; } }
            __syncthreads();
        }
    }
    LAS float* scr = (LAS float*)(F.lds + F.wave * 16384);
    const int gw = F.vcu * NWAVES + F.wave, NGW = F.G * NWAVES;
    bf16* WIN = (bf16*)(F.ws + WS_WIN); bf16* WGLU = (bf16*)(F.ws + WS_WGLU); bf16* WA = (bf16*)(F.ws + WS_WA); bf16* WB = (bf16*)(F.ws + WS_WB); bf16* WO = (bf16*)(F.ws + WS_WO);
    bf16* WEIN = (bf16*)(F.ws + WS_WEIN); bf16* WEOUT = (bf16*)(F.ws + WS_WEOUT);
    constexpr int I_IN = 177 * 16, I_GLU = 16 * 8, I_A = 32 * 16, I_B = 32 * 8, I_O = 32 * 16, I_EIN = 32 * 64 * 16, I_EOUT = 32 * 32 * 16;
    constexpr int NITEMS = I_IN + I_GLU + I_A + I_B + I_O + I_EIN + I_EOUT;
#define P0_DECODE(it_, T) do { int r = (it_); \
        if (r < I_IN) { const int kb = r / 177, nb = r % 177, n0 = nb * 32; const int sc0 = n0 < 2048 ? n0 : (n0 < 5632 ? n0 + 32 : 2048); \
            T.src = INP[8] + (size_t)kb * 64 * 5664 + sc0; T.ld = 5664; T.dst = (bf16*)((unsigned char*)WIN + (size_t)n0 * 1024 + kb * 64); T.ldk = 1024; T.f8 = 1; break; } r -= I_IN; \
        if (r < I_GLU) { const int kb = r / 16, nb = r % 16; T.src = INP[21] + (size_t)kb * 64 * 512 + nb * 32; T.ld = 512; T.dst = (bf16*)((unsigned char*)WGLU + (size_t)nb * 32 * 512 + kb * 64); T.ldk = 512; T.f8 = 1; break; } r -= I_GLU; \
        if (r < I_A) { const int kb = r / 32, nb = r % 32; T.src = INP[12] + (size_t)kb * 64 * 1024 + nb * 32; T.ld = 1024; T.dst = (bf16*)((unsigned char*)WA + (size_t)nb * 32 * 1024 + kb * 64); T.ldk = 1024; T.f8 = 1; break; } r -= I_A; \
        if (r < I_B) { const int kb = r / 32, nb = r % 32; T.src = INP[23] + (size_t)kb * 64 * 1024 + nb * 32; T.ld = 1024; T.dst = (bf16*)((unsigned char*)WB + (size_t)nb * 32 * 512 + kb * 64); T.ldk = 512; T.f8 = 1; break; } r -= I_B; \
        if (r < I_O) { const int kb = r / 32, nb = r % 32; T.src = INP[25] + (size_t)kb * 64 * 1024 + nb * 32; T.ld = 1024; T.dst = (bf16*)((unsigned char*)WO + (size_t)nb * 32 * 1024 + kb * 64); T.ldk = 1024; T.f8 = 1; break; } r -= I_O; \
        if (r < I_EIN) { const int e = r / 1024, q = r % 1024, kb = q / 64, nb = q % 64; const int dr = nb * 32, pn = dr >> 8, bj = (dr >> 7) & 1, xx = dr & 127; \
            T.src = INP[28] + (size_t)e * 1024 * 2048 + (size_t)kb * 64 * 2048 + bj * 1024 + pn * 128 + xx; T.ld = 2048; T.dst = (bf16*)((unsigned char*)WEIN + (size_t)e * 2048 * 1024 + (size_t)dr * 1024 + kb * 64); T.ldk = 1024; T.f8 = 1; break; } r -= I_EIN; \
        { const int e = r / 512, q = r % 512, kb = q / 32, nb = q % 32; \
            T.src = INP[30] + (size_t)e * 1024 * 1024 + (size_t)kb * 64 * 1024 + nb * 32; T.ld = 1024; T.dst = (bf16*)((unsigned char*)WEOUT + (size_t)e * 1024 * 1024 + (size_t)nb * 32 * 1024 + kb * 64); T.ldk = 1024; T.f8 = 1; } } while (0)
    {
        TItem ta, tb; f32x4 ra[8], rb[8];
        int it = gw;
        if (it < NITEMS - I_EIN - I_EOUT) { P0_DECODE(it, ta); titem_load(ta, F.lane, ra); }
        constexpr int NITEMS0 = NITEMS - I_EIN - I_EOUT;
        while (it < NITEMS0) {
            const int nx = it + NGW;
            if (nx < NITEMS0) { P0_DECODE(nx, tb); titem_load(tb, F.lane, rb); }
            titem_store(ta, F.lane, ra, scr);
            ta = tb;
#pragma unroll
            for (int i = 0; i < 8; ++i) ra[i] = rb[i];
            it = nx;
        }
    }
#undef P0_DECODE
    { const int gt = blockIdx.x * (NWAVES * 64) + F.tid, NT = F.G * NWAVES * 64; GAS v4u* z = (GAS v4u*)((unsigned char*)WIN + (size_t)5664 * 1024);
        for (int i = gt; i < 224 * 1024 / 16; i += NT) z[i] = (v4u){0u, 0u, 0u, 0u}; }
}

__device__ __forceinline__ void p1_norm1(Frame& F, const float* const* __restrict__ INP) {
    const int gw = F.vcu * NWAVES + F.wave, NGW = F.G * NWAVES;
    const float* mod = (const float*)(F.ws + WS_MOD); bf16* H1 = (bf16*)(F.ws + WS_H1);
    for (int m = gw; m < MT; m += NGW) {
        const float* xr; const float* sh; const float* scl;
        if (m < ML) { const int b = m / SEQ; xr = INP[0] + (size_t)m * D; sh = mod + b * 6144; scl = sh + D; }
        else { xr = INP[2] + (size_t)(m - ML) * D; sh = mod + 8 * 6144; scl = sh + D; }
        f32x4 v[4]; float s = 0.f;
#pragma unroll
        for (int j = 0; j < 4; ++j) { v[j] = *(const f32x4*)(xr + 256 * j + 4 * F.lane); s += (v[j][0] * v[j][0] + v[j][1] * v[j][1]) + (v[j][2] * v[j][2] + v[j][3] * v[j][3]); }
        const float rstd = 1.0f / sqrtf(wave_sum(s) * (1.0f / D) + EPS);
#pragma unroll
        for (int j = 0; j < 4; ++j) { const int c = 256 * j + 4 * F.lane; const f32x4 g = *(const f32x4*)(INP[6] + c), a = *(const f32x4*)(scl + c), bb = *(const f32x4*)(sh + c);
            const f32x4 y = v[j] * rstd * g * (a + 1.0f) + bb;
            *(unsigned*)((unsigned char*)H1 + (size_t)m * D + c) = pk4_fp8(y[0], y[1], y[2], y[3]); }
    }
}

__device__ __forceinline__ void conv_fma8(float (&a)[8], const v4u x, const float* wp) {
    const f32x4 w0 = *(const f32x4*)(wp), w1 = *(const f32x4*)(wp + 4);
    a[0] += bflo(x.x) * w0[0]; a[1] += bfhi(x.x) * w0[1]; a[2] += bflo(x.y) * w0[2]; a[3] += bfhi(x.y) * w0[3];
    a[4] += bflo(x.z) * w1[0]; a[5] += bfhi(x.z) * w1[1]; a[6] += bflo(x.w) * w1[2]; a[7] += bfhi(x.w) * w1[3];
}
__device__ __forceinline__ void p3_conv(Frame& F, const float* const* __restrict__ INP) {
    const bf16* PROJ = (const bf16*)(F.ws + WS_PROJ); bf16* QKC = (bf16*)(F.ws + WS_QKC); const float* wc = INP[9];
    const int NT = F.G * NWAVES * 64;
    for (int it = F.vcu * (NWAVES * 64) + F.tid; it < NB * 64 * 16 * 128; it += NT) {
        const int ch0 = (it & 127) * 8, seg = (it >> 7) & 15, gr = (it >> 11) & 63, b = it >> 17, c0 = seg * 4;
        const bf16* base = PROJ + (size_t)(b * SEQ) * LDP + ch0;
        const float scale = ch0 < 512 ? 0.125f : 1.0f;
        v4u win[6][3];
        const v4u z = (v4u){0u, 0u, 0u, 0u};
#pragma unroll
        for (int cc = 0; cc < 6; ++cc)
#pragma unroll
            for (int ky = 0; ky < 3; ++ky) { const int rr = gr + ky - 1, c = c0 + cc - 1;
                win[cc][ky] = (rr >= 0 && rr < 64 && c >= 0 && c < 64) ? *(const v4u*)(base + (size_t)(rr * 64 + c) * LDP) : z; }
        __builtin_amdgcn_sched_barrier(0);
        float a[4][8];
#pragma unroll
        for (int cc = 0; cc < 4; ++cc)
#pragma unroll
            for (int j = 0; j < 8; ++j) a[cc][j] = 0.f;
#pragma unroll
        for (int ky = 0; ky < 3; ++ky)
#pragma unroll
            for (int kx = 0; kx < 3; ++kx) {
                const f32x4 w0 = *(const f32x4*)(wc + (ky * 3 + kx) * 1024 + ch0), w1 = *(const f32x4*)(wc + (ky * 3 + kx) * 1024 + ch0 + 4);
#pragma unroll
                for (int cc = 0; cc < 4; ++cc) { const v4u x = win[cc + kx][ky];
                    a[cc][0] += bflo(x.x) * w0[0]; a[cc][1] += bfhi(x.x) * w0[1]; a[cc][2] += bflo(x.y) * w0[2]; a[cc][3] += bfhi(x.y) * w0[3];
                    a[cc][4] += bflo(x.z) * w1[0]; a[cc][5] += bfhi(x.z) * w1[1]; a[cc][6] += bflo(x.w) * w1[2]; a[cc][7] += bfhi(x.w) * w1[3]; }
                asm volatile("" ::: "memory");
            }
#pragma unroll
        for (int cc = 0; cc < 4; ++cc) {
#pragma unroll
            for (int j = 0; j < 8; ++j) a[cc][j] = a[cc][j] * frcp(1.0f + __expf(-a[cc][j])) * scale;
            *(v4u*)(QKC + (size_t)(b * SEQ + gr * 64 + c0 + cc) * 1024 + ch0) = (v4u){pk2(a[cc][0], a[cc][1]), pk2(a[cc][2], a[cc][3]), pk2(a[cc][4], a[cc][5]), pk2(a[cc][6], a[cc][7])};
        }
    }
    for (int w = F.vcu * (NWAVES * 64) + F.tid; w < MC * 128; w += NT) {
        const int row = ML + (w >> 7), ch0 = (w & 127) * 8, t = (w >> 7) % CTXL;
        float a[8];
#pragma unroll
        for (int j = 0; j < 8; ++j) a[j] = 0.f;
#pragma unroll
        for (int kx = 0; kx < 3; ++kx) { const int tt = t + kx - 1;
            if (tt >= 0 && tt < CTXL) conv_fma8(a, *(const v4u*)(PROJ + (size_t)(row + kx - 1) * LDP + ch0), wc + (3 + kx) * 1024 + ch0); }
        const float scale = ch0 < 512 ? 0.125f : 1.0f;
#pragma unroll
        for (int j = 0; j < 8; ++j) a[j] = a[j] * frcp(1.0f + __expf(-a[j])) * scale;
        *(v4u*)(QKC + (size_t)row * 1024 + ch0) = (v4u){pk2(a[0], a[1]), pk2(a[2], a[3]), pk2(a[4], a[5]), pk2(a[6], a[7])};
    }
    {
        float* GB = (float*)(F.ws + WS_GS); float* GG = GB + 128 * 4352; float* GP = GG + 128 * 4352;
        const int gw = F.vcu * NWAVES + F.wave, NGW = F.G * NWAVES, lane = F.lane;
        for (int it = gw; it < 128 * 34; it += NGW) {
            const int jc = it % 34, dbh = it / 34, h = dbh & 7, b = (dbh >> 3) & 7, d = dbh >> 6;
            const bool lat = jc >= 2; const int p0 = lat ? 128 * (jc - 2) : 128 * jc, Lseq = lat ? SEQ : CTXL, rowbase = lat ? b * SEQ : ML + b * CTXL;
            const float bi_ = INP[10][d * 16 + h], bf_ = INP[10][d * 16 + 8 + h];
            float li2[2], lf2[2];
#pragma unroll
            for (int e = 0; e < 2; ++e) { const int sp = 2 * lane + e; const int tt = d ? (Lseq - 1 - (p0 + sp)) : (p0 + sp); const size_t row = (size_t)(rowbase + tt);
                li2[e] = bf2f(PROJ[row * LDP + PC_IF + d * 16 + h]) + bi_; const float xf = bf2f(PROJ[row * LDP + PC_IF + d * 16 + 8 + h]) + bf_;
                lf2[e] = fminf(xf, 0.f) - log1pf(expf(-fabsf(xf))); }
            const float c1 = lf2[0] + lf2[1]; float inc = c1;
#pragma unroll
            for (int o = 1; o < 64; o <<= 1) { const float t = __shfl_up(inc, o); if (lane >= o) inc += t; }
            const float exc = inc - c1, b0 = exc + lf2[0], b1 = exc + c1, g0 = li2[0] - b0, g1 = li2[1] - b1;
            float pmx = fmaxf(g0, g1);
#pragma unroll
            for (int o = 1; o < 64; o <<= 1) { const float t = __shfl_up(pmx, o); if (lane >= o) pmx = fmaxf(pmx, t); }
            float pex = __shfl_up(pmx, 1); if (lane == 0) pex = -INFINITY;
            const size_t o = (size_t)dbh * 4352 + 128 * jc + 2 * lane;
            *(float2*)(GB + o) = make_float2(b0, b1); *(float2*)(GG + o) = make_float2(g0, g1); *(float2*)(GP + o) = make_float2(fmaxf(pex, g0), pmx);
        }
    }
}

__device__ __forceinline__ void mma32_nt(f32x16& acc, const LAS bf16* A, int lda, const LAS bf16* Bt, int ldb, int K, int lane) {
    const int r = lane & 31, h = lane >> 5;
#pragma unroll
    for (int k0 = 0; k0 < K; k0 += 16) {
        const bf16x8 a = *(const LAS bf16x8*)(A + r * lda + k0 + 8 * h);
        const bf16x8 b = *(const LAS bf16x8*)(Bt + r * ldb + k0 + 8 * h);
        acc = __builtin_amdgcn_mfma_f32_32x32x16_bf16(a, b, acc, 0, 0, 0);
        if ((k0 & 63) == 48) __builtin_amdgcn_sched_barrier(0);
    }
}
__device__ __forceinline__ void mma16_nt(f32x4& acc, const LAS bf16* A, int lda, const LAS bf16* Bt, int ldb, int K, int lane) {
    const int r = lane & 15, q = lane >> 4;
    for (int k0 = 0; k0 < K; k0 += 32) {
        const bf16x8 a = *(const LAS bf16x8*)(A + r * lda + k0 + 8 * q);
        const bf16x8 b = *(const LAS bf16x8*)(Bt + r * ldb + k0 + 8 * q);
        acc = __builtin_amdgcn_mfma_f32_16x16x32_bf16(a, b, acc, 0, 0, 0);
    }
}
__device__ __forceinline__ int row32(int reg, int lane) { return (reg & 3) + 8 * (reg >> 2) + 4 * (lane >> 5); }
__device__ __forceinline__ float logsigmoidf_(float x) { return fminf(x, 0.f) - log1pf(expf(-fabsf(x))); }

typedef short s16x4 __attribute__((ext_vector_type(4)));
__device__ __forceinline__ s16x4 tr_read(const LAS bf16* p) { return __builtin_amdgcn_ds_read_tr16_b64_v4i16((LAS s16x4*)p); }
__device__ __forceinline__ bf16x8 tr_frag32_perm(const LAS bf16* T, int ld, int k0, int x0, int lane) {
    const int h = lane >> 5, i = lane & 15, q = i >> 2, p = i & 3, xb = 16 * ((lane >> 4) & 1);
    const LAS bf16* a = T + (k0 + 4 * h + q) * ld + x0 + xb + 4 * p;
    const s16x4 lo = tr_read(a), hi = tr_read(a + 8 * ld);
    return (bf16x8){lo[0], lo[1], lo[2], lo[3], hi[0], hi[1], hi[2], hi[3]};
}
__device__ __forceinline__ bf16x8 tr_frag16(const LAS bf16* T, int ld, int k0, int x0, int lane) {
    const int q4 = lane >> 4, i = lane & 15, q = i >> 2, p = i & 3;
    const LAS bf16* a = T + (k0 + 8 * q4 + q) * ld + x0 + 4 * p;
    const s16x4 lo = tr_read(a), hi = tr_read(a + 4 * ld);
    return (bf16x8){lo[0], lo[1], lo[2], lo[3], hi[0], hi[1], hi[2], hi[3]};
}
__device__ __forceinline__ v4u scale8(const v4u k8, float ww) {
    return (v4u){pk2(ww * bflo(k8.x), ww * bfhi(k8.x)), pk2(ww * bflo(k8.y), ww * bfhi(k8.y)), pk2(ww * bflo(k8.z), ww * bfhi(k8.z)), pk2(ww * bflo(k8.w), ww * bfhi(k8.w))};
}

constexpr int XI_EIN = 32 * 64 * 16, XI_EOUT = 32 * 32 * 16, XI_PER_UNIT = (XI_EIN + XI_EOUT) / 256;
__device__ __forceinline__ void xitem_decode(const float* const* __restrict__ INP, unsigned char* ws, int r, const float*& src, int& ld, unsigned char*& dst) {
    if (r < XI_EIN) { const int e = r / 1024, q = r % 1024, kb = q / 64, nb = q % 64; const int dr = nb * 32, pn = dr >> 8, bj = (dr >> 7) & 1, xx = dr & 127;
        src = INP[28] + (size_t)e * 1024 * 2048 + (size_t)kb * 64 * 2048 + bj * 1024 + pn * 128 + xx; ld = 2048; dst = ws + WS_WEIN + (size_t)e * 2048 * 1024 + (size_t)dr * 1024 + kb * 64; }
    else { r -= XI_EIN; const int e = r / 512, q = r % 512, kb = q / 32, nb = q % 32;
        src = INP[30] + (size_t)e * 1024 * 1024 + (size_t)kb * 64 * 1024 + nb * 32; ld = 1024; dst = ws + WS_WEOUT + (size_t)e * 1024 * 1024 + (size_t)nb * 32 * 1024 + kb * 64; }
}
template <int MODE>
__device__ __forceinline__ void p4_mlstm(Frame& F, const float* const* __restrict__ INP, int unit) {
    const int vh = unit & 1, h = (unit >> 1) & 7, b = (unit >> 4) & 7, d = unit >> 7;
    LAS bf16* Qs = (LAS bf16*)(F.lds + 0);
    LAS bf16* Ks = (LAS bf16*)(F.lds + 18432);
    LAS bf16* Kw = (LAS bf16*)(F.lds + 36864);
    LAS bf16* Vs = (LAS bf16*)(F.lds + 55296);
    LAS bf16* Cb = (LAS bf16*)(F.lds + 73728);
    LAS float* vec = (LAS float*)(F.lds + 82944);
    LAS float *rowt = vec, *colt = vec + 128, *iev = vec + 256, *emt = vec + 384, *nv = vec + 512, *npart = vec + 576;
    const bf16* PROJ = (const bf16*)(F.ws + WS_PROJ); const bf16* QKC = (const bf16*)(F.ws + WS_QKC); bf16* HDIR = (bf16*)(F.ws + WS_HDIR) + (size_t)d * ML * 1024;
    const float* GB = (const float*)(F.ws + WS_GS) + (size_t)((d * 8 + b) * 8 + h) * 4352; const float* GG = GB + 128 * 4352; const float* GP = GG + 128 * 4352;
    int tid = F.tid; asm volatile("" : "+v"(tid));
    const int lane = tid & 63, w = F.wave;
    for (int i = tid; i < 64 * 72; i += 512) Cb[i] = 0;
    if (tid < 64) nv[tid] = 0.f;
    f32x4 accC[2] = {(f32x4){0.f, 0.f, 0.f, 0.f}, (f32x4){0.f, 0.f, 0.f, 0.f}};
    float m_old = 0.f, dec_prev = 0.f;
    v4u pq[2], pk[2], pv[2]; float pgb = 0.f, pgp = 0.f, pgc = 0.f, pgg[2], pbend, pgmax; v2u hout[4]; bf16* hptr = nullptr; bool hpend = false;
    f32x4 xr[8]; v2u xo[4]; unsigned char* xdst = nullptr; unsigned char* xodst = nullptr; bool xload = false, xout = false;
    const int xw = w - 2;
    LAS float* xscr = (LAS float*)(F.lds + (xw < 5 ? 87296 + (xw < 0 ? 0 : xw) * 8448 : 132096));
    const int zl = tid >> 9;
#define ML_PREFETCH(jn) do { const bool lat_ = (jn) >= 2; const int p0_ = lat_ ? 128 * ((jn) - 2) : 128 * (jn), L_ = lat_ ? SEQ : CTXL, rb_ = lat_ ? b * SEQ : ML + b * CTXL; \
        _Pragma("unroll") for (int i = 0; i < 2; ++i) { const int id = tid + 512 * i, s_ = id >> 3, c_ = id & 7; const int tt = d ? (L_ - 1 - (p0_ + s_)) : (p0_ + s_); const size_t row = (size_t)(rb_ + tt); \
            pq[i] = *(const v4u*)(QKC + row * 1024 + h * 64 + c_ * 8); pk[i] = *(const v4u*)(QKC + row * 1024 + 512 + h * 64 + c_ * 8); pv[i] = *(const v4u*)(PROJ + row * LDP + PC_V + h * 128 + vh * 64 + c_ * 8); \
            pgg[i] = GG[128 * (jn) + s_]; } \
        if (tid < 128) { pgb = GB[128 * (jn) + tid]; pgp = GP[128 * (jn) + tid]; pgc = GG[128 * (jn) + tid]; } \
        pbend = GB[128 * (jn) + 127 + zl]; pgmax = GP[128 * (jn) + 127 + zl]; } while (0)
    ML_PREFETCH(0);
    __syncthreads();
    for (int j = 0; j < 34; ++j) {
        const bool lat = j >= 2;
        const int p0 = lat ? 128 * (j - 2) : 128 * j, Lseq = lat ? SEQ : CTXL, rowbase = lat ? b * SEQ : ML + b * CTXL;
        const float bend = pbend, gmax = pgmax;
        const float mnew = fmaxf(bend + m_old, bend + gmax), dec = __expf(bend + m_old - mnew);
#pragma unroll
        for (int i = 0; i < 2; ++i) { const int id = tid + 512 * i, s = id >> 3, c = id & 7;
            *(LAS v4u*)(Qs + s * 72 + c * 8) = pq[i]; *(LAS v4u*)(Ks + s * 72 + c * 8) = pk[i]; *(LAS v4u*)(Vs + s * 72 + c * 8) = pv[i];
            *(LAS v4u*)(Kw + s * 72 + c * 8) = scale8(pk[i], __expf(bend + pgg[i] - mnew)); }
        if (tid < 128) { const float r = fmaxf(m_old, pgp); rowt[tid] = -r * 1.44269504089f; colt[tid] = pgc * 1.44269504089f; iev[tid] = __expf(m_old - r); emt[tid] = __expf(-pgb - r); }
        if (j > 0) {
            const int vi = w >> 1;
#pragma unroll
            for (int jj = 0; jj < 2; ++jj) { const int ki = 2 * (w & 1) + jj;
#pragma unroll
                for (int reg = 0; reg < 4; ++reg) Cb[(16 * vi + (lane >> 4) * 4 + reg) * 72 + 16 * ki + (lane & 15)] = (bf16)f2bf(accC[jj][reg]); }
            if (tid < 64) { float sacc = 0.f;
#pragma unroll
                for (int p = 0; p < 8; ++p) sacc += npart[p * 64 + tid];
                nv[tid] = dec_prev * nv[tid] + sacc; }
        }
        LBAR();
        if (j + 1 < 34 && !(MODE & 4)) ML_PREFETCH(j + 1);
        if (hpend) {
#pragma unroll
            for (int rg = 0; rg < 4; ++rg) *(v2u*)(hptr + 8 * rg) = hout[rg];
            hpend = false; }
        if (MODE == 0 && xw >= 0) {
            if (xout) {
#pragma unroll
                for (int q = 0; q < 4; ++q) *(GAS v2u*)(xodst + (size_t)(8 * q) * 1024) = xo[q];
                xout = false; }
            const int sl = j * 6 + xw;
            if (sl < XI_PER_UNIT) { const float* xsrc; int xld; xitem_decode(INP, F.ws, unit * XI_PER_UNIT + sl, xsrc, xld, xdst);
#pragma unroll
                for (int i = 0; i < 8; ++i) xr[i] = *(const f32x4*)(xsrc + (size_t)(8 * i + (lane >> 3)) * xld + 4 * (lane & 7));
                xload = true; }
        }
        if (lat && !(MODE & 1)) { const int tm = ((w >> 1) == 0 ? 3 : (w >> 1) == 1 ? 2 : (w >> 1) == 2 ? 0 : 1), vt = w & 1, tl = lane & 31, t = 32 * tm + tl, hh = lane >> 5; f32x16 acc;
#pragma unroll
            for (int reg = 0; reg < 16; ++reg) acc[reg] = 0.f;
            mma32_nt(acc, Cb + 32 * vt * 72, 72, Qs + 32 * tm * 72, 72, 64, lane);
            const float ie = iev[t], rt = rowt[t];
#pragma unroll
            for (int reg = 0; reg < 16; ++reg) acc[reg] *= ie;
            float rs = 0.f;
            for (int st = (MODE & 8) ? tm : 0; st <= tm; ++st) {
                f32x16 X;
#pragma unroll
                for (int reg = 0; reg < 16; ++reg) X[reg] = 0.f;
                mma32_nt(X, Ks + 32 * st * 72, 72, Qs + 32 * tm * 72, 72, 64, lane);
                const LAS float* cp = colt + 32 * st + 4 * hh;
                if (st == tm) { const int dlim = tl - 4 * hh;
#pragma unroll
                    for (int rg = 0; rg < 4; ++rg) { const f32x4 c4 = *(const LAS f32x4*)(cp + 8 * rg);
#pragma unroll
                        for (int e = 0; e < 4; ++e) { const float arg = (8 * rg + e <= dlim) ? c4[e] + rt : -INFINITY; const float pvv = X[4 * rg + e] * __builtin_amdgcn_exp2f(arg); X[4 * rg + e] = pvv; rs += pvv; } }
                } else {
#pragma unroll
                    for (int rg = 0; rg < 4; ++rg) { const f32x4 c4 = *(const LAS f32x4*)(cp + 8 * rg);
#pragma unroll
                        for (int e = 0; e < 4; ++e) { const float pvv = X[4 * rg + e] * __builtin_amdgcn_exp2f(c4[e] + rt); X[4 * rg + e] = pvv; rs += pvv; } }
                }
#pragma unroll
                for (int ks = 0; ks < 2; ++ks) {
                    const v4u bw = (v4u){cvtpk(X[8 * ks], X[8 * ks + 1]), cvtpk(X[8 * ks + 2], X[8 * ks + 3]), cvtpk(X[8 * ks + 4], X[8 * ks + 5]), cvtpk(X[8 * ks + 6], X[8 * ks + 7])};
                    const bf16x8 af = tr_frag32_perm(Vs, 72, 32 * st + 16 * ks, 32 * vt, lane);
                    acc = __builtin_amdgcn_mfma_f32_32x32x16_bf16(af, __builtin_bit_cast(bf16x8, bw), acc, 0, 0, 0); }
            }
            float nq = 0.f;
#pragma unroll
            for (int q = 0; q < 4; ++q) { const v4u q8 = *(const LAS v4u*)(Qs + t * 72 + 32 * hh + 8 * q); const LAS float* nn = nv + 32 * hh + 8 * q;
                nq += bflo(q8.x) * nn[0] + bfhi(q8.x) * nn[1] + bflo(q8.y) * nn[2] + bfhi(q8.y) * nn[3] + bflo(q8.z) * nn[4] + bfhi(q8.z) * nn[5] + bflo(q8.w) * nn[6] + bfhi(q8.w) * nn[7]; }
            rs += __shfl_xor(rs, 32); nq += __shfl_xor(nq, 32);
            const float rd = 1.0f / fmaxf(fabsf(ie * nq + rs), emt[t]);
            const int tt = d ? (Lseq - 1 - (p0 + t)) : (p0 + t);
            hptr = HDIR + (size_t)(rowbase + tt) * 1024 + h * 128 + vh * 64 + 32 * vt + 4 * hh;
#pragma unroll
            for (int rg = 0; rg < 4; ++rg) hout[rg] = (v2u){pk2(acc[4 * rg] * rd, acc[4 * rg + 1] * rd), pk2(acc[4 * rg + 2] * rd, acc[4 * rg + 3] * rd)};
            hpend = true; }
        if (!(MODE & 2)) { const int vi = w >> 1;
            accC[0] *= dec; accC[1] *= dec;
#pragma unroll
            for (int st4 = 0; st4 < 4; ++st4) { const bf16x8 af = tr_frag16(Vs, 72, 32 * st4, 16 * vi, lane);
#pragma unroll
                for (int jj = 0; jj < 2; ++jj) { const bf16x8 bfr = tr_frag16(Kw, 72, 32 * st4, 16 * (2 * (w & 1) + jj), lane); accC[jj] = __builtin_amdgcn_mfma_f32_16x16x32_bf16(af, bfr, accC[jj], 0, 0, 0); } } }
        { const int k = tid & 63, part = tid >> 6; float sacc = 0.f;
#pragma unroll
            for (int q = 0; q < 16; ++q) sacc += bf2f(Kw[(16 * part + q) * 72 + k]);
            npart[part * 64 + k] = sacc; }
        if (MODE == 0 && xw >= 0 && xload) {
#pragma unroll
            for (int i = 0; i < 8; ++i) { LAS float* p = xscr + (8 * i + (lane >> 3)) * 33 + 4 * (lane & 7); p[0] = xr[i][0]; p[1] = xr[i][1]; p[2] = xr[i][2]; p[3] = xr[i][3]; }
            LDS_WAIT(); asm volatile("" ::: "memory");
            const int c = lane & 7;
#pragma unroll
            for (int q = 0; q < 4; ++q) { const LAS float* sp = xscr + (8 * c) * 33 + (lane >> 3) + 8 * q;
                xo[q] = (v2u){pk4_fp8(32.f * sp[0 * 33], 32.f * sp[1 * 33], 32.f * sp[2 * 33], 32.f * sp[3 * 33]), pk4_fp8(32.f * sp[4 * 33], 32.f * sp[5 * 33], 32.f * sp[6 * 33], 32.f * sp[7 * 33])}; }
            xodst = xdst + (size_t)(lane >> 3) * 1024 + 8 * c; xout = true; xload = false;
        }
        m_old = mnew; dec_prev = dec;
        LBAR();
    }
    if (MODE == 0 && xw >= 0 && xout) {
#pragma unroll
        for (int q = 0; q < 4; ++q) *(GAS v2u*)(xodst + (size_t)(8 * q) * 1024) = xo[q]; }
    if (hpend) {
#pragma unroll
        for (int rg = 0; rg < 4; ++rg) *(v2u*)(hptr + 8 * rg) = hout[rg]; }
#undef ML_PREFETCH
}

__device__ __forceinline__ void s5_disc(const float* const* __restrict__ INP, int d, int g, int p, float& ar, float& ai, float& cfr, float& cfi) {
    const float dt = expf(INP[15][d * 32 + g]); const float are = INP[13][(d * 32 + g) * 64 + p], aim = INP[14][(d * 32 + g) * 64 + p];
    const float mag = expf(dt * are), ang = dt * aim; ar = mag * cosf(ang); ai = mag * sinf(ang);
    const float den = are * are + aim * aim, xr = ar - 1.0f; cfr = (xr * are + ai * aim) / den; cfi = (ai * are - xr * aim) / den;
}
__device__ __forceinline__ void p4_s5(Frame& F, const float* const* __restrict__ INP, int unit) {
    const int gp = unit & 15, b = (unit >> 4) & 7, d = unit >> 7;
    LAS bf16* BHt = (LAS bf16*)(F.lds + 0);
    LAS bf16* Cm = (LAS bf16*)(F.lds + 69632);
    LAS float* Eb = (LAS float*)(F.lds + 78336);
    LAS bf16* Us = (LAS bf16*)(F.lds + 82432);
    LAS bf16* BBs = (LAS bf16*)(F.lds + 92672);
    const bf16* PROJ = (const bf16*)(F.ws + WS_PROJ); bf16* YDIR = (bf16*)(F.ws + WS_YDIR) + (size_t)d * ML * 512;
    int tid = F.tid; asm volatile("" : "+v"(tid));
    const int lane = tid & 63, w = F.wave;
    const int sg = tid & 127, seg = tid >> 7;
    float ar, ai, a32r, a32i;
    { float cfr, cfi; s5_disc(INP, d, 2 * gp + (sg >> 6), sg & 63, ar, ai, cfr, cfi); a32r = ar; a32i = ai;
#pragma unroll
        for (int q = 0; q < 5; ++q) { const float nr = a32r * a32r - a32i * a32i, ni = 2.0f * a32r * a32i; a32r = nr; a32i = ni; } }
    for (int idx = tid; idx < 4096; idx += 512) {
        { const int gg = idx >> 11, pp = (idx >> 4) & 127, c = idx & 15, g = 2 * gp + gg, p = pp & 63; float xr_, xi_, cfr, cfi; s5_disc(INP, d, g, p, xr_, xi_, cfr, cfi);
            const float bre = INP[16][((size_t)(d * 32 + g) * 64 + p) * 16 + c], bim = INP[17][((size_t)(d * 32 + g) * 64 + p) * 16 + c];
            BBs[(gg * 128 + pp) * 24 + c] = (bf16)f2bf(pp < 64 ? cfr * bre - cfi * bim : cfr * bim + cfi * bre); }
        { const int gg = idx >> 11, c = (idx >> 7) & 15, pp = idx & 127, g = 2 * gp + gg, p = pp & 63;
            const float v = pp < 64 ? INP[18][((size_t)(d * 32 + g) * 16 + c) * 64 + p] : -INP[19][((size_t)(d * 32 + g) * 16 + c) * 64 + p];
            Cm[(gg * 16 + c) * 136 + pp] = (bf16)f2bf(v); }
    }
    float h0r = 0.f, h0i = 0.f;
    LAS bf16* rowre = BHt + ((sg >> 6) * 128 + (sg & 63)) * 136 + 32 * seg;
    v4u pu; v2u yout[2]; bf16* yptr[2]; bool ypend = false;
#define S5_PREFETCH(jn) do { const bool lat_ = (jn) >= 2; const int p0_ = lat_ ? 128 * ((jn) - 2) : 128 * (jn), L_ = lat_ ? SEQ : CTXL, rb_ = lat_ ? b * SEQ : ML + b * CTXL; \
        const int s_ = tid >> 2, c_ = tid & 3; const int tt = d ? (L_ - 1 - (p0_ + s_)) : (p0_ + s_); pu = *(const v4u*)(PROJ + (size_t)(rb_ + tt) * LDP + PC_U + gp * 32 + c_ * 8); } while (0)
    S5_PREFETCH(0);
    __syncthreads();
    for (int j = 0; j < 34; ++j) {
        const bool lat = j >= 2;
        const int p0 = lat ? 128 * (j - 2) : 128 * j, Lseq = lat ? SEQ : CTXL, rowbase = lat ? b * SEQ : ML + b * CTXL;
        *(LAS v4u*)(Us + (tid >> 2) * 40 + (tid & 3) * 8) = pu;
        LBAR();
        if (j + 1 < 34) S5_PREFETCH(j + 1);
        if (ypend) { *(v2u*)yptr[0] = yout[0]; *(v2u*)yptr[1] = yout[1]; ypend = false; }
        { const int gg = w >> 2, tm = w & 3, r = lane & 31, hh = lane >> 5;
            const bf16x8 a = *(const LAS bf16x8*)(Us + (32 * tm + r) * 40 + gg * 16 + 8 * hh);
            LAS bf16* bp = BHt + (gg * 128 + r) * 136 + 32 * tm + 4 * hh;
#pragma unroll
            for (int tn = 0; tn < 4; ++tn) { f32x16 acc;
#pragma unroll
                for (int reg = 0; reg < 16; ++reg) acc[reg] = 0.f;
                const bf16x8 bb = *(const LAS bf16x8*)(BBs + (gg * 128 + 32 * tn + r) * 24 + 8 * hh);
                acc = __builtin_amdgcn_mfma_f32_32x32x16_bf16(a, bb, acc, 0, 0, 0);
#pragma unroll
                for (int rg = 0; rg < 4; ++rg) *(LAS v2u*)(bp + 32 * tn * 136 + 8 * rg) = (v2u){cvtpk(acc[4 * rg], acc[4 * rg + 1]), cvtpk(acc[4 * rg + 2], acc[4 * rg + 3])}; } }
        LBAR();
        v4u xr[4], xi[4];
#pragma unroll
        for (int q = 0; q < 4; ++q) { xr[q] = *(const LAS v4u*)(rowre + 8 * q); xi[q] = *(const LAS v4u*)(rowre + 64 * 136 + 8 * q); }
        { float hr = 0.f, hi = 0.f;
#pragma unroll
            for (int q = 0; q < 4; ++q)
#pragma unroll
                for (int e = 0; e < 4; ++e) { const unsigned wr_ = xr[q][e], wi_ = xi[q][e];
                    { const float br = bflo(wr_), bi = bflo(wi_); const float nr = ar * hr - ai * hi + br, ni = ar * hi + ai * hr + bi; hr = nr; hi = ni; }
                    { const float br = bfhi(wr_), bi = bfhi(wi_); const float nr = ar * hr - ai * hi + br, ni = ar * hi + ai * hr + bi; hr = nr; hi = ni; } }
            Eb[(seg * 128 + sg) * 2] = hr; Eb[(seg * 128 + sg) * 2 + 1] = hi; }
        LBAR();
        { float hcr = h0r, hci = h0i, hr = 0.f, hi = 0.f;
#pragma unroll
            for (int s2 = 0; s2 < 4; ++s2) { if (s2 == seg) { hr = hcr; hi = hci; } const float er = Eb[(s2 * 128 + sg) * 2], ei = Eb[(s2 * 128 + sg) * 2 + 1];
                const float nr = a32r * hcr - a32i * hci + er, ni = a32r * hci + a32i * hcr + ei; hcr = nr; hci = ni; }
            h0r = hcr; h0i = hci;
#pragma unroll
            for (int q = 0; q < 4; ++q) { v4u orr, oi;
#pragma unroll
                for (int e = 0; e < 4; ++e) { const unsigned wr_ = xr[q][e], wi_ = xi[q][e]; float r0, i0, r1, i1;
                    { const float br = bflo(wr_), bi = bflo(wi_); const float nr = ar * hr - ai * hi + br, ni = ar * hi + ai * hr + bi; hr = nr; hi = ni; r0 = hr; i0 = hi; }
                    { const float br = bfhi(wr_), bi = bfhi(wi_); const float nr = ar * hr - ai * hi + br, ni = ar * hi + ai * hr + bi; hr = nr; hi = ni; r1 = hr; i1 = hi; }
                    orr[e] = cvtpk(r0, r1); oi[e] = cvtpk(i0, i1); }
                *(LAS v4u*)(rowre + 8 * q) = orr; *(LAS v4u*)(rowre + 64 * 136 + 8 * q) = oi; } }
        LBAR();
        if (lat) { const int gg = w >> 2;
#pragma unroll
            for (int jj = 0; jj < 2; ++jj) { const int tm = 2 * (w & 3) + jj; f32x4 acc = (f32x4){0.f, 0.f, 0.f, 0.f};
#pragma unroll
                for (int st4 = 0; st4 < 4; ++st4) { const bf16x8 af = *(const LAS bf16x8*)(Cm + (gg * 16 + (lane & 15)) * 136 + 32 * st4 + 8 * (lane >> 4));
                    const bf16x8 bfr = tr_frag16(BHt + gg * 128 * 136, 136, 32 * st4, 16 * tm, lane);
                    acc = __builtin_amdgcn_mfma_f32_16x16x32_bf16(af, bfr, acc, 0, 0, 0); }
                const int t = 16 * tm + (lane & 15); const int tt = d ? (Lseq - 1 - (p0 + t)) : (p0 + t);
                yptr[jj] = YDIR + (size_t)(rowbase + tt) * 512 + (2 * gp + gg) * 16 + 4 * (lane >> 4); yout[jj] = (v2u){pk2(acc[0], acc[1]), pk2(acc[2], acc[3])}; }
            ypend = true; }
    }
    if (ypend) { *(v2u*)yptr[0] = yout[0]; *(v2u*)yptr[1] = yout[1]; }
#undef S5_PREFETCH
    __syncthreads();
}

__device__ __forceinline__ float gelu_tanh(float x) { const float u = 0.7978845608028654f * (x + 0.044715f * x * x * x); const float e = __expf(2.0f * u); const float th = 1.0f - 2.0f * frcp(e + 1.0f); return 0.5f * x * (1.0f + th); }
__device__ __forceinline__ void p5a_prep(Frame& F, const float* const* __restrict__ INP) {
    const int gw = F.vcu * NWAVES + F.wave, NGW = F.G * NWAVES, lane = F.lane;
    const bf16* PROJ = (const bf16*)(F.ws + WS_PROJ); const bf16* HD0 = (const bf16*)(F.ws + WS_HDIR); const bf16* HD1 = HD0 + (size_t)ML * 1024;
    const bf16* YD0 = (const bf16*)(F.ws + WS_YDIR); const bf16* YD1 = YD0 + (size_t)ML * 512;
    bf16* A1 = (bf16*)(F.ws + WS_A1); bf16* A2 = (bf16*)(F.ws + WS_A2); const unsigned char* P8 = F.ws + WS_PROJ8;
    for (int m0 = 2 * gw; m0 < ML; m0 += 2 * NGW) {
        v4u ha[2][2], hb[2][2], ho[2][2], ya[2], yb[2], yu[2];
#pragma unroll
        for (int r = 0; r < 2; ++r) { const size_t m = (size_t)(m0 + r);
#pragma unroll
            for (int q = 0; q < 2; ++q) { ha[r][q] = *(const v4u*)(HD0 + m * 1024 + 16 * lane + 8 * q); hb[r][q] = *(const v4u*)(HD1 + m * 1024 + 16 * lane + 8 * q); ho[r][q] = (v4u){0u, 0u, 0u, 0u}; }
            { const v4u o16 = *(const v4u*)(P8 + m * 3072 + 16 * lane); ho[r][0].x = o16.x; ho[r][0].y = o16.y; ho[r][1].x = o16.z; ho[r][1].y = o16.w; }
            ya[r] = *(const v4u*)(YD0 + m * 512 + 8 * lane); yb[r] = *(const v4u*)(YD1 + m * 512 + 8 * lane); yu[r] = *(const v4u*)(PROJ + m * LDP + PC_U + 8 * lane); }
        __builtin_amdgcn_sched_barrier(0);
#pragma unroll
        for (int r = 0; r < 2; ++r) { const size_t m = (size_t)(m0 + r);
            float hm[16]; float ss = 0.f;
#pragma unroll
            for (int q = 0; q < 2; ++q) { const v4u a = ha[r][q], bq = hb[r][q];
                hm[8 * q + 0] = bflo(a.x) + bflo(bq.x); hm[8 * q + 1] = bfhi(a.x) + bfhi(bq.x); hm[8 * q + 2] = bflo(a.y) + bflo(bq.y); hm[8 * q + 3] = bfhi(a.y) + bfhi(bq.y);
                hm[8 * q + 4] = bflo(a.z) + bflo(bq.z); hm[8 * q + 5] = bfhi(a.z) + bfhi(bq.z); hm[8 * q + 6] = bflo(a.w) + bflo(bq.w); hm[8 * q + 7] = bfhi(a.w) + bfhi(bq.w); }
#pragma unroll
            for (int q = 0; q < 16; ++q) ss += hm[q] * hm[q];
            ss += __shfl_xor(ss, 1); ss += __shfl_xor(ss, 2); ss += __shfl_xor(ss, 4);
            const float rs = 1.0f / sqrtf(ss * (1.0f / 128.0f) + EPS);
#pragma unroll
            for (int q = 0; q < 2; ++q) { const float* gm = INP[11] + 16 * lane + 8 * q; f32x4 og0, og1; unpack8_fp8((v2u){ho[r][q].x, ho[r][q].y}, og0, og1);
                float rr[8]; const float og[8] = {og0[0], og0[1], og0[2], og0[3], og1[0], og1[1], og1[2], og1[3]};
#pragma unroll
                for (int e = 0; e < 8; ++e) rr[e] = hm[8 * q + e] * rs * gm[e] * sigmoidf_(og[e]);
                *(v2u*)((unsigned char*)A1 + m * 1024 + 16 * lane + 8 * q) = (v2u){pk4_fp8(rr[0], rr[1], rr[2], rr[3]), pk4_fp8(rr[4], rr[5], rr[6], rr[7])}; }
            { const v4u a = ya[r], bq = yb[r], u8 = yu[r]; const float* dd = INP[20] + 8 * lane;
                float rr[8] = {bflo(a.x) + bflo(bq.x) + dd[0] * bflo(u8.x), bfhi(a.x) + bfhi(bq.x) + dd[1] * bfhi(u8.x), bflo(a.y) + bflo(bq.y) + dd[2] * bflo(u8.y), bfhi(a.y) + bfhi(bq.y) + dd[3] * bfhi(u8.y),
                               bflo(a.z) + bflo(bq.z) + dd[4] * bflo(u8.z), bfhi(a.z) + bfhi(bq.z) + dd[5] * bfhi(u8.z), bflo(a.w) + bflo(bq.w) + dd[6] * bflo(u8.w), bfhi(a.w) + bfhi(bq.w) + dd[7] * bfhi(u8.w)};
#pragma unroll
                for (int e = 0; e < 8; ++e) rr[e] = gelu_tanh(rr[e]);
                *(v2u*)((unsigned char*)A2 + m * 512 + 8 * lane) = (v2u){pk4_fp8(rr[0], rr[1], rr[2], rr[3]), pk4_fp8(rr[4], rr[5], rr[6], rr[7])}; }
        }
    }
}

__device__ __forceinline__ void route_reduce_top4(float (&acc)[32], const float* br, int lane, float (&tv)[4], int (&ti)[4]) {
#pragma unroll
    for (int i = 0; i < 16; ++i) { const float send = (lane & 32) ? acc[i] : acc[i + 16]; const float keep = (lane & 32) ? acc[i + 16] : acc[i]; acc[i] = keep + __shfl_xor(send, 32); }
#pragma unroll
    for (int i = 0; i < 8; ++i) { const float send = (lane & 16) ? acc[i] : acc[i + 8]; const float keep = (lane & 16) ? acc[i + 8] : acc[i]; acc[i] = keep + __shfl_xor(send, 16); }
#pragma unroll
    for (int i = 0; i < 4; ++i) { const float send = (lane & 8) ? acc[i] : acc[i + 4]; const float keep = (lane & 8) ? acc[i + 4] : acc[i]; acc[i] = keep + __shfl_xor(send, 8); }
#pragma unroll
    for (int i = 0; i < 2; ++i) { const float send = (lane & 4) ? acc[i] : acc[i + 2]; const float keep = (lane & 4) ? acc[i + 2] : acc[i]; acc[i] = keep + __shfl_xor(send, 4); }
    { const float send = (lane & 2) ? acc[0] : acc[1]; const float keep = (lane & 2) ? acc[1] : acc[0]; acc[0] = keep + __shfl_xor(send, 2); }
    acc[0] += __shfl_xor(acc[0], 1);
    float val = acc[0] + br[lane >> 1];
    if (lane & 1) val = -INFINITY;
#pragma unroll
    for (int r = 0; r < 4; ++r) { float mx = val;
#pragma unroll
        for (int o = 1; o < 64; o <<= 1) mx = fmaxf(mx, __shfl_xor(mx, o));
        const unsigned long long bal = __ballot(val == mx); const int wl = __ffsll((long long)bal) - 1;
        tv[r] = mx; ti[r] = wl >> 1; if (lane == wl) val = -INFINITY; }
}
__device__ __forceinline__ void p6_route(Frame& F, const float* const* __restrict__ INP) {
    const bf16* X1 = (const bf16*)(F.ws + WS_X1); const float* mod = (const float*)(F.ws + WS_MOD); bf16* H2 = (bf16*)(F.ws + WS_H2);
    int* TOPE = (int*)(F.ws + WS_TOPE); int* POS = (int*)(F.ws + WS_POS); float* TOPP = (float*)(F.ws + WS_TOPP); int* LIST = (int*)(F.ws + WS_LIST);
    LAS float* Wt = (LAS float*)(F.lds);
    LAS int* pe = (LAS int*)(F.lds + LDSCTL_OFF + 1024); LAS int* hist = pe + 512; LAS int* base = hist + 32; LAS int* rank = base + 32;
    const float* wr = INP[26]; const float* br = INP[27];
    const int lane = F.lane, w = F.wave;
    for (int idx = F.tid; idx < 32768; idx += NWAVES * 64) { const int e = idx >> 10, k = idx & 1023; Wt[((((k >> 8) * 4 + (k & 3)) * 32 + e) << 6) + ((k >> 2) & 63)] = wr[k * 32 + e]; }
    __syncthreads();
    for (int tg = blockIdx.x; tg < ML / 128; tg += F.G) {
        if (F.tid < 32) hist[F.tid] = 0;
        __syncthreads();
#pragma unroll 1
        for (int q = 0; q < 16; q += 2) {
            const int tl = w * 16 + q, m = tg * 128 + tl, b = m / SEQ;
            const float* sh = mod + b * 6144 + 3 * D; const float* scl = sh + D;
            float s0 = 0.f, s1 = 0.f;
#pragma unroll
            for (int j = 0; j < 4; ++j) { const v2u w0 = *(const v2u*)(X1 + (size_t)m * D + 256 * j + 4 * lane), w1 = *(const v2u*)(X1 + (size_t)(m + 1) * D + 256 * j + 4 * lane);
                const f32x4 x0 = (f32x4){bflo(w0.x), bfhi(w0.x), bflo(w0.y), bfhi(w0.y)}, x1 = (f32x4){bflo(w1.x), bfhi(w1.x), bflo(w1.y), bfhi(w1.y)};
                s0 += (x0[0] * x0[0] + x0[1] * x0[1]) + (x0[2] * x0[2] + x0[3] * x0[3]); s1 += (x1[0] * x1[0] + x1[1] * x1[1]) + (x1[2] * x1[2] + x1[3] * x1[3]); }
            const float r0 = 1.0f / sqrtf(wave_sum(s0) * (1.0f / D) + EPS), r1 = 1.0f / sqrtf(wave_sum(s1) * (1.0f / D) + EPS);
            float a0[32], a1[32];
#pragma unroll
            for (int e = 0; e < 32; ++e) { a0[e] = 0.f; a1[e] = 0.f; }
#pragma unroll 1
            for (int j = 0; j < 4; ++j) { const int c = 256 * j + 4 * lane; const f32x4 g = *(const f32x4*)(INP[7] + c), a = *(const f32x4*)(scl + c), bb = *(const f32x4*)(sh + c);
                const v2u w0 = *(const v2u*)(X1 + (size_t)m * D + c), w1 = *(const v2u*)(X1 + (size_t)(m + 1) * D + c);
                const f32x4 x0 = (f32x4){bflo(w0.x), bfhi(w0.x), bflo(w0.y), bfhi(w0.y)}, x1 = (f32x4){bflo(w1.x), bfhi(w1.x), bflo(w1.y), bfhi(w1.y)};
                const f32x4 gs = g * (a + 1.0f); const f32x4 y0 = x0 * r0 * gs + bb, y1 = x1 * r1 * gs + bb;
                *(unsigned*)((unsigned char*)H2 + (size_t)m * D + c) = pk4_fp8(y0[0], y0[1], y0[2], y0[3]); *(unsigned*)((unsigned char*)H2 + (size_t)(m + 1) * D + c) = pk4_fp8(y1[0], y1[1], y1[2], y1[3]);
                const LAS float* wj = Wt + j * 8192 + lane;
#pragma unroll
                for (int qq = 0; qq < 4; ++qq) { const LAS float* wp = wj + qq * 2048; const float ya = y0[qq], yb = y1[qq];
#pragma unroll
                    for (int e = 0; e < 32; ++e) { const float wv = wp[e * 64]; a0[e] += ya * wv; a1[e] += yb * wv; }
                    asm volatile("" ::: "memory"); } }
            float tv[4]; int ti[4];
#pragma unroll
            for (int tk = 0; tk < 2; ++tk) {
                if (tk == 0) route_reduce_top4(a0, br, lane, tv, ti); else route_reduce_top4(a1, br, lane, tv, ti);
                const float e1 = __expf(tv[1] - tv[0]), e2 = __expf(tv[2] - tv[0]), e3 = __expf(tv[3] - tv[0]); const float inv = 1.0f / (1.0f + e1 + e2 + e3);
                if (lane < 4) { const float p = lane == 0 ? inv : (lane == 1 ? e1 * inv : (lane == 2 ? e2 * inv : e3 * inv)); const int ee = lane == 0 ? ti[0] : (lane == 1 ? ti[1] : (lane == 2 ? ti[2] : ti[3]));
                    TOPP[(m + tk) * 4 + lane] = p; TOPE[(m + tk) * 4 + lane] = ee; pe[(tl + tk) * 4 + lane] = ee; }
            }
        }
        __syncthreads();
        { const int e = pe[F.tid]; rank[F.tid] = __hip_atomic_fetch_add(&hist[e], 1, __ATOMIC_RELAXED, __HIP_MEMORY_SCOPE_WORKGROUP); }
        __syncthreads();
        if (F.tid < 32) base[F.tid] = (int)__hip_atomic_fetch_add(F.ctl + CW_CNT + 64 * F.tid, (unsigned)hist[F.tid], RLX_AGENT);
        __syncthreads();
        { const int e = pe[F.tid]; const int pos = base[e] + rank[F.tid]; const int m = tg * 128 + (F.tid >> 2); LIST[e * ML + pos] = m; POS[m * 4 + (F.tid & 3)] = pos; }
        __syncthreads();
    }
}

typedef int i32x4 __attribute__((ext_vector_type(4)));
__device__ __forceinline__ void p10_combine(Frame& F, const float* const* __restrict__ INP) {
    moe_tables(F);
    const LAS int* tab = (const LAS int*)(F.lds + TAB_OFF);
    const bf16* X1 = (const bf16*)(F.ws + WS_X1); float* OUT = F.out; const float* mod = (const float*)(F.ws + WS_MOD); const unsigned char* Y = (const unsigned char*)(F.ws + WS_Y);
    const int* TOPE = (const int*)(F.ws + WS_TOPE); const int* POS = (const int*)(F.ws + WS_POS); const float* TOPP = (const float*)(F.ws + WS_TOPP);
    const int gw = F.vcu * NWAVES + F.wave, NGW = F.G * NWAVES, lane = F.lane;
    i32x4 te[2], tp[2]; f32x4 tw[2];
    int m0 = 2 * gw;
    if (m0 < ML) {
#pragma unroll
        for (int r = 0; r < 2; ++r) { te[r] = *(const i32x4*)(TOPE + (m0 + r) * 4); tp[r] = *(const i32x4*)(POS + (m0 + r) * 4); tw[r] = *(const f32x4*)(TOPP + (m0 + r) * 4); } }
    for (; m0 < ML; m0 += 2 * NGW) {
        unsigned yv[2][4][4]; v2u xv[2][4];
#pragma unroll
        for (int r = 0; r < 2; ++r) {
#pragma unroll
            for (int k = 0; k < 4; ++k) { const size_t slot = (size_t)256 * tab[te[r][k]] + tp[r][k];
#pragma unroll
                for (int j = 0; j < 4; ++j) yv[r][k][j] = *(const unsigned*)(Y + slot * 1024 + 256 * j + 4 * lane); }
#pragma unroll
            for (int j = 0; j < 4; ++j) xv[r][j] = *(const v2u*)(X1 + (size_t)(m0 + r) * D + 256 * j + 4 * lane); }
        const f32x4 cw[2] = {tw[0], tw[1]};
        const int mn = m0 + 2 * NGW;
        if (mn < ML) {
#pragma unroll
            for (int r = 0; r < 2; ++r) { te[r] = *(const i32x4*)(TOPE + (mn + r) * 4); tp[r] = *(const i32x4*)(POS + (mn + r) * 4); tw[r] = *(const f32x4*)(TOPP + (mn + r) * 4); } }
        __builtin_amdgcn_sched_barrier(0);
#pragma unroll
        for (int r = 0; r < 2; ++r) { const int m = m0 + r, b = m / SEQ; const float* gt2 = mod + b * 6144 + 5 * D;
            f32x4 v[4]; float s = 0.f;
#pragma unroll
            for (int j = 0; j < 4; ++j) { const int c = 256 * j + 4 * lane; f32x4 mo = (f32x4){0.f, 0.f, 0.f, 0.f};
#pragma unroll
                for (int k = 0; k < 4; ++k) { const unsigned y = yv[r][k][j]; const auto lo = __builtin_amdgcn_cvt_pk_f32_fp8((int)y, false), hi = __builtin_amdgcn_cvt_pk_f32_fp8((int)y, true);
                    mo += (f32x4){lo[0], lo[1], hi[0], hi[1]} * (cw[r][k] * 0.0625f); }
                const v2u xw = xv[r][j]; v[j] = (f32x4){bflo(xw.x), bfhi(xw.x), bflo(xw.y), bfhi(xw.y)} + *(const f32x4*)(gt2 + c) * mo;
                s += (v[j][0] * v[j][0] + v[j][1] * v[j][1]) + (v[j][2] * v[j][2] + v[j][3] * v[j][3]); }
            const float rstd = 1.0f / sqrtf(wave_sum(s) * (1.0f / D) + EPS);
#pragma unroll
            for (int j = 0; j < 4; ++j) { const int c = 256 * j + 4 * lane; *(f32x4*)(OUT + (size_t)m * D + c) = v[j] * rstd * *(const f32x4*)(INP[32] + c); }
        }
    }
}

struct Args { const float* in[33]; float* out; unsigned char* ws; int ph_lo, ph_hi, li, pad; };
__global__ void __launch_bounds__(NWAVES * 64, 2) fwd_kernel(Args args) {
    extern __shared__ __attribute__((aligned(16))) unsigned char lds[];
    Frame F;
    F.lds = (LAS unsigned char*)lds;
    F.tid = threadIdx.x; F.lane = F.tid & 63; F.wave = __builtin_amdgcn_readfirstlane(F.tid >> 6);
    F.G = gridDim.x; { const int bx = blockIdx.x; F.vcu = (F.G % 8 == 0) ? (bx % 8) * (F.G / 8) + bx / 8 : bx; }
    F.ws = args.ws; F.ctl = (gu32*)(args.ws + WS_CTL); F.out = args.out;
    for (int u = F.tid; u < (LDS_BYTES - LDSCTL_OFF) / 4; u += NWAVES * 64) ((LAS unsigned*)(F.lds + LDSCTL_OFF))[u] = 0u;
    __syncthreads();
    XcdBarrier bar; bar.bar = (unsigned*)(F.ctl + CW_BAR); bar.x = 0; bar.st = nullptr;
    if (N_LAUNCHES == 1) bar = xcd_barrier_post((unsigned*)(F.ctl + CW_BAR), (volatile LAS unsigned*)(F.lds + MISC_OFF) + 8);
    const int lo = args.ph_lo, hi = args.ph_hi;
    const float* const* __restrict__ INP = args.in;
#ifndef PH_MASK
#define PH_MASK 0x3fff
#endif
#define IN(k) ((((PH_MASK) >> (k)) & 1) && lo <= (k) && (k) < hi)
#define SEAM(k) do { if (IN(k) && IN((k) + 1)) xcd_barrier(bar); } while (0)
    const bf16* WIN = (const bf16*)(F.ws + WS_WIN);

    if (IN(0)) { p0_prologue(F, INP); } SEAM(0);
    if (IN(1)) { p1_norm1(F, INP); } SEAM(1);
    if (IN(2)) {
        pg8::Gemm g{(const bf16*)(F.ws + WS_H1), WIN, 512, nullptr, 0x7f7f7f7f, 0x7a7a7a7a}; InProjOrder S{F.G, (int)blockIdx.x};
        EpiStore E{(bf16*)(F.ws + WS_PROJ), LDP, F.ws + WS_PROJ8};
        pg8::gemm_phase<EpiStore, InProjOrder, false, true>(F.lds, g, S, E);
    } SEAM(2);
    if (IN(3)) { p3_conv(F, INP); } SEAM(3);
    if (IN(4)) { for (int u = blockIdx.x; u < 256; u += F.G) { p4_mlstm<0>(F, INP, u); if (P4_REP_M > 1) p4_mlstm<P4_MODE>(F, INP, u); for (int r_ = 0; r_ < P4_REP_S; ++r_) p4_s5(F, INP, u); } } SEAM(4);
    if (IN(5)) { p5a_prep(F, INP); } SEAM(5);
    if (IN(6)) {
        pg8::Gemm g{(const bf16*)(F.ws + WS_A2), (const bf16*)(F.ws + WS_WGLU), 256, nullptr, 0x7f7f7f7f, 0x7a7a7a7a}; pg8::StaticOrder S; S.init(ML, 512, F.G, (int)blockIdx.x);
        EpiGlu E{(const bf16*)(F.ws + WS_A2), (bf16*)(F.ws + WS_A3), INP[22]};
        pg8::gemm_phase<EpiGlu, pg8::StaticOrder, false, true>(F.lds, g, S, E);
    }
    if (IN(7)) {
        pg8::Gemm g{(const bf16*)(F.ws + WS_A1), (const bf16*)(F.ws + WS_WA), 512, nullptr, 0x7f7f7f7f, 0x7a7a7a7a}; pg8::StaticOrder S; S.init(ML, 1024, F.G, (int)blockIdx.x);
        EpiGate<false> E{F.ws + WS_PROJ8, 1024, INP[24], nullptr, (bf16*)(F.ws + WS_YA)};
        pg8::gemm_phase<EpiGate<false>, pg8::StaticOrder, false, true>(F.lds, g, S, E);
    } SEAM(7);
    if (IN(8)) {
        pg8::Gemm g{(const bf16*)(F.ws + WS_A3), (const bf16*)(F.ws + WS_WB), 256, nullptr, 0x7f7f7f7f, 0x7a7a7a7a}; pg8::StaticOrder S; S.init(ML, 1024, F.G, (int)blockIdx.x);
        EpiGate<true> E{F.ws + WS_PROJ8, 2048, INP[24] + 1024, (const bf16*)(F.ws + WS_YA), (bf16*)(F.ws + WS_MERGED)};
        pg8::gemm_phase<EpiGate<true>, pg8::StaticOrder, false, true>(F.lds, g, S, E);
    } SEAM(8);
    if (IN(9)) {
        pg8::Gemm g{(const bf16*)(F.ws + WS_MERGED), (const bf16*)(F.ws + WS_WO), 512, nullptr, 0x7d7d7d7d, 0x7a7a7a7a}; pg8::StaticOrder S; S.init(ML, 1024, F.G, (int)blockIdx.x);
        EpiX1 E{INP[0], (const float*)(F.ws + WS_MOD), (bf16*)(F.ws + WS_X1)};
        pg8::gemm_phase<EpiX1, pg8::StaticOrder, false, true>(F.lds, g, S, E);
    } SEAM(9);
    if (IN(10)) { p6_route(F, INP); } SEAM(10);
    if (IN(11)) {
        moe_tables(F);
        MoeOrder S{F.G, (int)blockIdx.x, 8, (const LAS int*)(F.lds + TAB_OFF)};
        LAS unsigned short* ridx = (LAS unsigned short*)(F.lds + LDSCTL_OFF + 1024);
        { const int* LIST = (const int*)(F.ws + WS_LIST);
            for (int i = 0; i < 30; ++i) { pg8::Unit u; if (!S.next(i, u)) break;
                if (F.tid < 256) { const int rc = F.tid < u.nvalid ? F.tid : u.nvalid - 1; ridx[i * 256 + F.tid] = (unsigned short)LIST[u.lbase + rc]; } }
            __syncthreads(); }
        pg8::Gemm g{(const bf16*)(F.ws + WS_H2), (const bf16*)(F.ws + WS_WEIN), 512, ridx, 0x7f7f7f7f, 0x7a7a7a7a};
        EpiSwiglu E{INP[29], (bf16*)(F.ws + WS_ACT)};
        pg8::gemm_phase<EpiSwiglu, MoeOrder, true, true>(F.lds, g, S, E);
    } SEAM(11);
    if (IN(12)) {
        moe_tables(F);
        pg8::Gemm g{(const bf16*)(F.ws + WS_ACT), (const bf16*)(F.ws + WS_WEOUT), 512, nullptr, 0x7c7c7c7c, 0x7a7a7a7a}; MoeOrder S{F.G, (int)blockIdx.x, 4, (const LAS int*)(F.lds + TAB_OFF)};
        EpiY E{INP[31], (bf16*)(F.ws + WS_Y)};
        pg8::gemm_phase<EpiY, MoeOrder, false, true>(F.lds, g, S, E);
    } SEAM(12);
    if (IN(13)) { p10_combine(F, INP); }
#undef IN
#undef SEAM
}

extern "C" void kernel_launch(void* const* d_in, const int* in_sizes, int n_in, void* d_out, int out_size, void* d_ws, size_t ws_size, hipStream_t stream) {
    static int grid = 0;
    if (grid == 0) {
        if (n_in != 33 || out_size != ML * D || ws_size < WS_END2) { fprintf(stderr, "kernel_launch: unexpected shapes (n_in %d, out %d, ws %zu)\n", n_in, out_size, ws_size); grid = -1; return; }
        int dev = 0, cus = 0, per_cu = 0;
        if (hipGetDevice(&dev) != hipSuccess || hipDeviceGetAttribute(&cus, hipDeviceAttributeMultiprocessorCount, dev) != hipSuccess) { grid = -1; return; }
        if (hipFuncSetAttribute((const void*)fwd_kernel, hipFuncAttributeMaxDynamicSharedMemorySize, LDS_BYTES) != hipSuccess) { fprintf(stderr, "kernel_launch: hipFuncSetAttribute failed\n"); grid = -1; return; }
        if (hipOccupancyMaxActiveBlocksPerMultiprocessor(&per_cu, (const void*)fwd_kernel, NWAVES * 64, LDS_BYTES) != hipSuccess || per_cu < 1) fprintf(stderr, "kernel_launch: occupancy query reports %d\n", per_cu);
        (void)hipGetLastError();
        grid = cus;
    }
    if (grid < 0) return;
    if (hipMemsetAsync((char*)d_ws + WS_CTL, 0, CTL_ZERO_BYTES, stream) != hipSuccess) return;
    Args a{};
    for (int i = 0; i < 33; ++i) a.in[i] = (const float*)d_in[i];
    a.out = (float*)d_out; a.ws = (unsigned char*)d_ws;
    for (int li = 0; li < N_LAUNCHES; ++li) {
        a.ph_lo = (N_LAUNCHES == 1) ? 0 : li; a.ph_hi = (N_LAUNCHES == 1) ? NPH : li + 1; a.li = li;
        const int nrep = (N_LAUNCHES != 1 && (((PROBE_DUP_MASK) >> li) & 1)) ? 2 : 1;
        for (int r = 0; r < nrep; ++r) hipLaunchKernelGGL(fwd_kernel, dim3(grid), dim3(NWAVES * 64), LDS_BYTES, stream, a);
    }
}
```

```cpp
#include <hip/hip_runtime.h>
#include <cstdio>
#include <cstdint>

#ifndef MK_N_LAUNCHES
#define MK_N_LAUNCHES 1
#endif
#ifndef PROBE_DUP_MASK
#define PROBE_DUP_MASK 0
#endif
#ifndef P4_REP_M
#define P4_REP_M 1
#endif
#ifndef P4_MODE
#define P4_MODE 0
#endif
#ifndef P4_REP_S
#define P4_REP_S 1
#endif

namespace pg8 {
#define PG8_LAS __attribute__((address_space(3)))
typedef unsigned short bf16_t;
typedef short bf16x8 __attribute__((ext_vector_type(8)));
typedef float f32x4 __attribute__((ext_vector_type(4)));
typedef unsigned u32x4 __attribute__((ext_vector_type(4)));
constexpr int BM = 256, BK = 64, HALF = 128, HTB = HALF * BK * 2, STAGE_BYTES = 8 * HTB, NXCD = 8, WGM = 8;

__host__ __device__ __forceinline__ int lds_byte(int r, int c) { const int st = (r >> 4) * 2 + (c >> 5), rr = r & 15, cc = c & 31, ob = rr * 64 + cc * 2; return st * 1024 + (ob ^ (((ob >> 9) & 1) << 5)); }
__host__ __device__ __forceinline__ void stage_rc(int b, int& R, int& C) { const int st = b / 1024, sb = b % 1024, swz = sb ^ (((sb >> 9) & 1) << 5); R = (st >> 1) * 16 + swz / 64; C = (st & 1) * 32 + (swz % 64) / 2; }
__host__ __device__ __forceinline__ int perm32(int rho) { const int n = rho >> 4, i = rho & 15; return 8 * (i >> 2) + 4 * n + (i & 3); }

struct Unit { int pm, pn, lbase, nvalid; };
struct Gemm { const bf16_t* A; const bf16_t* Bt; int K; const PG8_LAS unsigned short* ridx; int sa, sb; };

__device__ __forceinline__ int xcd_remap(int L, int nwg) { const int q = nwg / NXCD, r = nwg % NXCD, xcd = L % NXCD, off = L / NXCD; return (xcd < r ? xcd * (q + 1) : r * (q + 1) + (xcd - r) * q) + off; }

struct StaticOrder {
    int nM, nN, nwg, G, c;
    __device__ void init(int M, int N, int G_, int c_) { nM = M / BM; nN = N / BM; nwg = nM * nN; G = G_; c = c_; }
    __device__ __forceinline__ bool next(int i, Unit& u) const {
        const long L = (long)i * G + c; if (L >= nwg) return false;
        const int wgid = xcd_remap((int)L, nwg);
        const int nig = WGM * nN, gid = wgid / nig, fm = gid * WGM, gsz = (nM - fm) < WGM ? (nM - fm) : WGM;
        u.pm = fm + ((wgid % nig) % gsz); u.pn = (wgid % nig) / gsz; u.lbase = 0; u.nvalid = 0; return true;
    }
};

__device__ __forceinline__ unsigned cvt_pk_bf16(float lo, float hi) { unsigned r; asm volatile("v_cvt_pk_bf16_f32 %0, %1, %2" : "=v"(r) : "v"(lo), "v"(hi)); return r; }

typedef int v8i __attribute__((ext_vector_type(8)));
typedef short s16x16 __attribute__((ext_vector_type(16)));
template <class Epi, class Sched, bool GATHER, bool FP8 = false>
__device__ __forceinline__ void gemm_phase(PG8_LAS unsigned char* lds, const Gemm g, const Sched& S, const Epi& E) {
    const int tid = threadIdx.x, wid = __builtin_amdgcn_readfirstlane(tid >> 6), lane = tid & 63, wr = wid >> 2, wc = wid & 3, fr = lane & 15, fq = lane >> 4;
    const int K = g.K, nt = K / BK;
    int Rr[2]; unsigned cby[2], voffB[2];
#pragma unroll
    for (int i = 0; i < 2; ++i) { int R, C; stage_rc(tid * 16 + i * 8192, R, C); const int Rb = Epi::PERM ? ((R & ~31) + perm32(R & 31)) : R;
        Rr[i] = R; cby[i] = (unsigned)C * 2u; voffB[i] = (unsigned)(Rb * K + C) * 2u; }
    const size_t kstep = (size_t)(BK * 2);
    const size_t hstep = (size_t)HALF * K * 2;
    const size_t tstep = 2 * hstep;
    const unsigned ldsw = (unsigned)wid * 1024u;
    const int aoff = lds_byte(wr * 64 + fr, FP8 ? fq * 16 : fq * 8), boff = lds_byte(wc * 32 + fr, FP8 ? fq * 16 : fq * 8);

#define PG8_SA(b, h) (((b) * 2 + (h)) * HTB)
#define PG8_SB(b, h) ((4 + (b) * 2 + (h)) * HTB)
#define PG8_STAGE(bufoff, gbase, voff) do { _Pragma("unroll") for (int _i = 0; _i < 2; ++_i) \
        __builtin_amdgcn_global_load_lds((const unsigned*)((const char*)(gbase) + (voff)[_i]), (PG8_LAS unsigned*)(lds + (bufoff) + ldsw + _i * 8192), 16, 0, 0); } while (0)
#define PG8_LDA(dst, b, h) do { if constexpr (FP8) { _Pragma("unroll") for (int m = 0; m < 4; ++m) { const bf16x8 _lo = *(const PG8_LAS bf16x8*)(lds + PG8_SA(b, h) + aoff + m * 2048), _hi = *(const PG8_LAS bf16x8*)(lds + PG8_SA(b, h) + aoff + m * 2048 + 16); dst##8[m] = __builtin_bit_cast(v8i, __builtin_shufflevector(_lo, _hi, 0, 1, 2, 3, 4, 5, 6, 7, 8, 9, 10, 11, 12, 13, 14, 15)); } } \
        else { _Pragma("unroll") for (int m = 0; m < 4; ++m) _Pragma("unroll") for (int k = 0; k < 2; ++k) dst[m][k] = *(const PG8_LAS bf16x8*)(lds + PG8_SA(b, h) + aoff + m * 2048 + k * 1024); } } while (0)
#define PG8_LDB(dst, b, h) do { if constexpr (FP8) { _Pragma("unroll") for (int n = 0; n < 2; ++n) { const bf16x8 _lo = *(const PG8_LAS bf16x8*)(lds + PG8_SB(b, h) + boff + n * 2048), _hi = *(const PG8_LAS bf16x8*)(lds + PG8_SB(b, h) + boff + n * 2048 + 16); dst##8[n] = __builtin_bit_cast(v8i, __builtin_shufflevector(_lo, _hi, 0, 1, 2, 3, 4, 5, 6, 7, 8, 9, 10, 11, 12, 13, 14, 15)); } } \
        else { _Pragma("unroll") for (int n = 0; n < 2; ++n) _Pragma("unroll") for (int k = 0; k < 2; ++k) dst[n][k] = *(const PG8_LAS bf16x8*)(lds + PG8_SB(b, h) + boff + n * 2048 + k * 1024); } } while (0)
#define PG8_MMA(ai, bj, At, Bt) do { __builtin_amdgcn_s_setprio(1); _Pragma("unroll") for (int m = 0; m < 4; ++m) _Pragma("unroll") for (int n = 0; n < 2; ++n) { \
        if constexpr (FP8) asm volatile("v_mfma_scale_f32_16x16x128_f8f6f4 %0, %1, %2, %0, %3, %4 op_sel_hi:[0,0,0]" : "+v"(acc[ai][bj][m][n]) : "v"(Bt##8[n]), "v"(At##8[m]), "v"(vsb), "v"(vsa));   \
        else { _Pragma("unroll") for (int k = 0; k < 2; ++k) acc[ai][bj][m][n] = __builtin_amdgcn_mfma_f32_16x16x32_bf16(Bt[n][k], At[m][k], acc[ai][bj][m][n], 0, 0, 0); } } \
        __builtin_amdgcn_s_setprio(0); } while (0)
#define PG8_WAIT_V(n) asm volatile("s_waitcnt vmcnt(" #n ")" ::: "memory")
#define PG8_WAIT_L(n) asm volatile("s_waitcnt lgkmcnt(" #n ")" ::: "memory")
#define PG8_BAR __builtin_amdgcn_s_barrier()
#define PG8_SCHED __builtin_amdgcn_sched_barrier(0)
#define PG8_AOFF(dst, u, uord) do { _Pragma("unroll") for (int _h = 0; _h < 2; ++_h) _Pragma("unroll") for (int _i = 0; _i < 2; ++_i) { const int _r = _h * HALF + Rr[_i]; \
        if constexpr (GATHER) { const int _idx = g.ridx[(uord) * 256 + _r]; dst[_h][_i] = (unsigned)_idx * (unsigned)(K * 2) + cby[_i]; } \
        else { dst[_h][_i] = (unsigned)(_r * K * 2) + cby[_i]; } } } while (0)
    Unit cur, nxt; int ui = 0;
    if (!S.next(0, cur)) return;
    f32x4 acc[2][2][4][2];
#pragma unroll
    for (int a = 0; a < 2; ++a)
#pragma unroll
        for (int b = 0; b < 2; ++b)
#pragma unroll
            for (int m = 0; m < 4; ++m)
#pragma unroll
                for (int n = 0; n < 2; ++n) acc[a][b][m][n] = (f32x4){0.f, 0.f, 0.f, 0.f};
    const int vsa = g.sa, vsb = g.sb;
    bf16x8 At[4][2], B0[2][2], B1[2][2];
    v8i At8[4], B08[2], B18[2];
    unsigned vc[2][2], vn[2][2];
    PG8_AOFF(vc, cur, 0);
    const char* cA = GATHER ? (const char*)g.A : (const char*)g.A + (size_t)cur.pm * tstep; const char* cB = (const char*)g.Bt + (size_t)cur.pn * tstep;
    PG8_STAGE(PG8_SB(0, 0), cB, voffB); PG8_STAGE(PG8_SB(0, 1), cB + hstep, voffB); PG8_STAGE(PG8_SA(0, 0), cA, vc[0]); PG8_STAGE(PG8_SA(0, 1), cA, vc[1]);
    if (wr == 1) PG8_BAR;
    PG8_WAIT_V(2); PG8_BAR;
    PG8_STAGE(PG8_SB(1, 0), cB + kstep, voffB); PG8_STAGE(PG8_SA(1, 0), cA + kstep, vc[0]); PG8_STAGE(PG8_SB(1, 1), cB + hstep + kstep, voffB);
    PG8_WAIT_V(6); PG8_BAR;
    for (;;) {
        const bool has_next = S.next(ui + 1, nxt);
        const char* nA = (has_next && !GATHER) ? (const char*)g.A + (size_t)nxt.pm * tstep : cA; const char* nB = has_next ? (const char*)g.Bt + (size_t)nxt.pn * tstep : cB;
        if constexpr (GATHER) { if (has_next) { PG8_AOFF(vn, nxt, ui + 1); } else {
#pragma unroll
            for (int h = 0; h < 2; ++h) { vn[h][0] = vc[h][0]; vn[h][1] = vc[h][1]; } } }
#pragma unroll 1
        for (int t = 0; t < nt; t += 2) {
            const bool last = (t == nt - 2);
            const char* a1 = cA + (size_t)(t + 1) * kstep;
            const char* a2 = last ? nA : cA + (size_t)(t + 2) * kstep; const char* b2 = last ? nB : cB + (size_t)(t + 2) * kstep;
            const char* a3 = a2 + kstep; const char* b3 = b2 + kstep;
            unsigned v2[2][2];
#pragma unroll
            for (int h = 0; h < 2; ++h)
#pragma unroll
                for (int i = 0; i < 2; ++i) v2[h][i] = GATHER ? (last ? vn[h][i] : vc[h][i]) : vc[h][i];
            PG8_LDB(B0, 0, 0); PG8_LDB(B1, 0, 1); PG8_SCHED; PG8_LDA(At, 0, 0); PG8_STAGE(PG8_SA(1, 1), a1, vc[1]);
            PG8_WAIT_V(8); PG8_WAIT_L(0); PG8_BAR; PG8_MMA(0, 0, At, B0); PG8_MMA(0, 1, At, B1); PG8_BAR; PG8_SCHED;
            PG8_LDA(At, 0, 1); PG8_STAGE(PG8_SB(0, 0), b2, voffB); PG8_STAGE(PG8_SB(0, 1), b2 + hstep, voffB); PG8_STAGE(PG8_SA(0, 0), a2, v2[0]);
            PG8_WAIT_V(8); PG8_WAIT_L(0); PG8_BAR; PG8_MMA(1, 0, At, B0); PG8_MMA(1, 1, At, B1); PG8_BAR; PG8_SCHED;
            PG8_LDB(B0, 1, 0); PG8_LDB(B1, 1, 1); PG8_SCHED; PG8_LDA(At, 1, 0); PG8_STAGE(PG8_SA(0, 1), a2, v2[1]);
            PG8_WAIT_V(8); PG8_WAIT_L(0); PG8_BAR; PG8_MMA(0, 0, At, B0); PG8_MMA(0, 1, At, B1); PG8_BAR; PG8_SCHED;
            PG8_LDA(At, 1, 1); PG8_STAGE(PG8_SB(1, 0), b3, voffB); PG8_STAGE(PG8_SB(1, 1), b3 + hstep, voffB); PG8_STAGE(PG8_SA(1, 0), a3, v2[0]);
            PG8_WAIT_V(8); PG8_WAIT_L(0); PG8_BAR; PG8_MMA(1, 0, At, B0); PG8_MMA(1, 1, At, B1); PG8_BAR; PG8_SCHED;
        }
        if (wr == 0) PG8_BAR;
        if constexpr (FP8) asm volatile("s_nop 15\n\ts_nop 15" ::: "memory");
        E(acc, cur, wr, wc, fr, fq);
        if (!has_next) break;
#pragma unroll
        for (int a = 0; a < 2; ++a)
#pragma unroll
            for (int b = 0; b < 2; ++b)
#pragma unroll
                for (int m = 0; m < 4; ++m)
#pragma unroll
                    for (int n = 0; n < 2; ++n) acc[a][b][m][n] = (f32x4){0.f, 0.f, 0.f, 0.f};
        cur = nxt; cA = nA; cB = nB; ++ui;
        if constexpr (GATHER) {
#pragma unroll
            for (int h = 0; h < 2; ++h) { vc[h][0] = vn[h][0]; vc[h][1] = vn[h][1]; } }
        if (wr == 1) PG8_BAR;
    }
    PG8_WAIT_V(0);
    PG8_BAR;
#undef PG8_SA
#undef PG8_SB
#undef PG8_STAGE
#undef PG8_LDA
#undef PG8_LDB
#undef PG8_MMA
#undef PG8_WAIT_V
#undef PG8_WAIT_L
#undef PG8_BAR
#undef PG8_SCHED
#undef PG8_AOFF
}
}

constexpr int NWAVES = 8;
constexpr int D = 1024, NB = 8, SEQ = 4096, CTXL = 256;
constexpr int ML = NB * SEQ, MC = NB * CTXL, MT = ML + MC;
constexpr int LDP = 5888;
constexpr int PC_QK = 0, PC_V = 1024, PC_U = 2048, PC_O = 2560, PC_G = 3584, PC_IF = 5632;
constexpr int NEXP = 32, TOPK = 4;
constexpr int MAXTILES = (ML * TOPK + NEXP * 256) / 256;
constexpr float EPS = 1e-6f;
constexpr int NPH = 14;
constexpr int N_LAUNCHES = MK_N_LAUNCHES;

constexpr size_t MiB = 1u << 20;
constexpr size_t WS_CTL = 0, CTL_ZERO_BYTES = 1 * MiB;
constexpr size_t WS_MOD = 1 * MiB;
constexpr size_t WS_TOPE = 2 * MiB, WS_POS = 2 * MiB + 512 * 1024, WS_TOPP = 3 * MiB, WS_LIST = 4 * MiB;
constexpr size_t WS_WIN = 8 * MiB, WS_WGLU = 20 * MiB, WS_WA = 21 * MiB, WS_WB = 23 * MiB, WS_WO = 24 * MiB, WS_WEIN = 26 * MiB, WS_WEOUT = 90 * MiB, WS_PROJ8 = 122 * MiB;
constexpr size_t WS_R0 = 218 * MiB;
constexpr size_t WS_PROJ = WS_R0, WS_H1 = 609 * MiB, WS_QKC = 677 * MiB, WS_HDIR = 745 * MiB, WS_YDIR = 873 * MiB, WS_END = 937 * MiB;
constexpr size_t WS_A1 = WS_H1, WS_A2 = WS_QKC, WS_A3 = WS_QKC + 32 * MiB, WS_YA = WS_HDIR, WS_MERGED = WS_HDIR + 64 * MiB;
constexpr size_t WS_GS = 940 * MiB, WS_X1 = 940 * MiB, WS_END2 = 1004 * MiB;
constexpr size_t WS_H2 = WS_R0, WS_ACT = 282 * MiB, WS_Y = 554 * MiB;
static_assert(WS_PROJ + (size_t)MT * LDP * 2 <= WS_H1 && WS_Y + (size_t)MAXTILES * 256 * 1024 * 2 <= WS_END, "ws map");
constexpr int CW_BAR = 4096, CW_CNT = 16384;

constexpr int RING_BYTES = 131072;
constexpr int LDSCTL_OFF = RING_BYTES, MISC_OFF = LDSCTL_OFF + 320, TAB_OFF = LDSCTL_OFF + 512;
constexpr int LDS_BYTES = 163840;

#define GAS __attribute__((address_space(1)))
#define LAS __attribute__((address_space(3)))
typedef unsigned short bf16;
typedef unsigned v4u __attribute__((ext_vector_type(4)));
typedef unsigned v2u __attribute__((ext_vector_type(2)));
typedef float f32x4 __attribute__((ext_vector_type(4)));
typedef float f32x16 __attribute__((ext_vector_type(16)));
typedef short bf16x8 __attribute__((ext_vector_type(8)));
typedef GAS unsigned gu32;
#define RLX_AGENT __ATOMIC_RELAXED, __HIP_MEMORY_SCOPE_AGENT
#define LDS_WAIT() asm volatile("s_waitcnt lgkmcnt(0)" ::: "memory")
#define LBAR() do { asm volatile("s_waitcnt lgkmcnt(0)" ::: "memory"); __builtin_amdgcn_s_barrier(); asm volatile("" ::: "memory"); } while (0)
__device__ __forceinline__ unsigned f2bf(float f) { unsigned u = __builtin_bit_cast(unsigned, f); return (u + 0x7fffu + ((u >> 16) & 1u)) >> 16; }
typedef __bf16 bf16x2_t __attribute__((ext_vector_type(2)));
__device__ __forceinline__ unsigned cvtpk(float lo, float hi) { const bf16x2_t v = {(__bf16)lo, (__bf16)hi}; return __builtin_bit_cast(unsigned, v); }
__device__ __forceinline__ unsigned pk2(float lo, float hi) { return cvtpk(lo, hi); }
__device__ __forceinline__ float clamp448(float x) { return fminf(fmaxf(x, -448.0f), 448.0f); }
__device__ __forceinline__ unsigned pk4_fp8(float a, float b, float c, float d) {
    unsigned w = 0; w = __builtin_amdgcn_cvt_pk_fp8_f32(clamp448(a), clamp448(b), w, false); w = __builtin_amdgcn_cvt_pk_fp8_f32(clamp448(c), clamp448(d), w, true); return w; }
__device__ __forceinline__ float bf2f(unsigned b) { return __builtin_bit_cast(float, b << 16); }
__device__ __forceinline__ float bflo(unsigned w) { return __builtin_bit_cast(float, w << 16); }
__device__ __forceinline__ float bfhi(unsigned w) { return __builtin_bit_cast(float, w & 0xffff0000u); }
__device__ __forceinline__ float frcp(float x) { return __builtin_amdgcn_rcpf(x); }
__device__ __forceinline__ float sigmoidf_(float x) { return frcp(1.0f + __expf(-x)); }

#define XB_TMO      128
#define XB_XCNT(j)  (256  + 64 * (j))
#define XB_XSUB(j)  (1280 + 64 * (j))
#define XB_XGEN(j)  (2304 + 64 * (j))
#define XB_TOP      3328
#define XB_TOPGEN   3392
#define XCD_BAR_WORDS 3456
#define XB_SPIN_CAP (1u << 22)
__device__ __forceinline__ unsigned xb_ld(unsigned* p)              { return __hip_atomic_load(p, __ATOMIC_RELAXED, __HIP_MEMORY_SCOPE_AGENT); }
__device__ __forceinline__ unsigned xb_add(unsigned* p, unsigned v) { return __hip_atomic_fetch_add(p, v, __ATOMIC_RELAXED, __HIP_MEMORY_SCOPE_AGENT); }
__device__ __forceinline__ unsigned xb_xcc_id() { return (unsigned)__builtin_amdgcn_s_getreg((3 << 11) | 20) & 0xFu; }
#define XB_SPIN(cond, bar) do { unsigned _sp = 0; while (cond) { __builtin_amdgcn_s_sleep(1); \
    if ((++_sp & 255u) == 0u) { if (xb_ld(&(bar)[XB_TMO])) break; if (_sp > XB_SPIN_CAP) { atomicAdd(&(bar)[XB_TMO], 1u); break; } } } } while (0)
struct XcdBarrier { unsigned* bar; unsigned x; volatile LAS unsigned* st; };
__device__ __forceinline__ XcdBarrier xcd_barrier_post(unsigned* bar, volatile LAS unsigned* st) {
    XcdBarrier b; b.bar = bar; b.x = xb_xcc_id(); b.st = st;
    if (threadIdx.x == 0) (void)xb_add(&bar[XB_XCNT(b.x)], 1u);
    return b;
}
__device__ __forceinline__ void xcd_barrier_complete(unsigned* bar, unsigned x, unsigned& nloc, unsigned& nx) {
    const unsigned G = gridDim.x * gridDim.y * gridDim.z;
    unsigned sum, cnt, mine, sp = 0u;
    for (;;) {
        sum = 0u; cnt = 0u; mine = 0u;
#pragma unroll
        for (unsigned j = 0; j < 16; ++j) { const unsigned c = xb_ld(&bar[XB_XCNT(j)]); sum += c; cnt += (c > 0u) ? 1u : 0u; mine = (j == x) ? c : mine; }
        if (sum == G) break;
        __builtin_amdgcn_s_sleep(1);
        if ((++sp & 255u) == 0u) { if (xb_ld(&bar[XB_TMO])) break; if (sp > XB_SPIN_CAP) { atomicAdd(&bar[XB_TMO], 1u); break; } }
    }
    nloc = mine > 0u ? mine : 1u; nx = cnt > 0u ? cnt : 1u;
}
__device__ __forceinline__ void xcd_barrier(const XcdBarrier& b) {
    asm volatile("s_waitcnt vmcnt(0)" ::: "memory");
    __syncthreads();
    if (threadIdx.x == 0) {
        unsigned* bar = b.bar;
        __builtin_amdgcn_s_waitcnt(0);
        unsigned nloc = b.st[0], nx = b.st[1];
        if (nloc == 0u) { xcd_barrier_complete(bar, b.x, nloc, nx); b.st[0] = nloc; b.st[1] = nx; }
        const unsigned old = xb_add(&bar[XB_XSUB(b.x)], 1u);
        const unsigned gen = old / nloc;
        if (old + 1u == (gen + 1u) * nloc) {
            __builtin_amdgcn_fence(__ATOMIC_RELEASE, "agent");
            asm volatile("s_waitcnt vmcnt(0)" ::: "memory");
            const unsigned og = xb_add(&bar[XB_TOP], 1u);
            const unsigned tg = og / nx;
            if (og + 1u == (tg + 1u) * nx) xb_add(&bar[XB_TOPGEN], 1u);
            else XB_SPIN(xb_ld(&bar[XB_TOPGEN]) == tg, bar);
            __builtin_amdgcn_fence(__ATOMIC_ACQUIRE, "agent");
            xb_add(&bar[XB_XGEN(b.x)], 1u);
            asm volatile("s_waitcnt vmcnt(0)" ::: "memory");
        } else {
            XB_SPIN(xb_ld(&bar[XB_XGEN(b.x)]) == gen, bar);
            __builtin_amdgcn_fence(__ATOMIC_ACQUIRE, "agent");
            asm volatile("s_waitcnt vmcnt(0)" ::: "memory");
        }
    }
    __syncthreads();
}

struct Frame {
    LAS unsigned char* lds;
    gu32* ctl;
    int tid, lane, wave, vcu, G;
    float* out; unsigned char* ws;
};
__device__ __forceinline__ float wave_sum(float v) {
#pragma unroll
    for (int o = 1; o < 64; o <<= 1) v += __shfl_xor(v, o);
    return v;
}

struct InProjOrder {
    int G, c;
    __device__ __forceinline__ bool next(int i, pg8::Unit& u) const {
        const int NL = 128 * 23, NC = 8 * 11;
        const long L = (long)i * G + c; if (L >= NL + NC) return false;
        u.lbase = 0; u.nvalid = 0;
        if (L < NL) { const int wgid = pg8::xcd_remap((int)L, NL); const int nig = 8 * 23, gid = wgid / nig, fm = gid * 8; u.pm = fm + ((wgid % nig) % 8); u.pn = (wgid % nig) / 8; }
        else { const int r = (int)L - NL; u.pm = 128 + r / 11; const int q = r % 11; u.pn = q < 10 ? q : 22; }
        return true;
    }
};
struct MoeOrder {
    int G, c, npn; const LAS int* tab;
    __device__ __forceinline__ bool next(int i, pg8::Unit& u) const {
        const int nT = __builtin_amdgcn_readfirstlane(tab[32]); const int nU = nT * npn;
        const long L = (long)i * G + c; if (L >= nU) return false;
        const int wgid = pg8::xcd_remap((int)L, nU);
        const int tau = wgid / npn, pl = wgid % npn;
        int e = 0;
        for (int k = 1; k < 32; ++k) e += (__builtin_amdgcn_readfirstlane(tab[k]) <= tau) ? 1 : 0;
        const int il = tau - __builtin_amdgcn_readfirstlane(tab[e]);
        u.pm = tau; u.pn = e * npn + pl; u.lbase = e * ML + 256 * il; u.nvalid = __builtin_amdgcn_readfirstlane(tab[33 + e]) - 256 * il;
        return true;
    }
};
__device__ __forceinline__ void moe_tables(Frame& F) {
    LAS int* tab = (LAS int*)(F.lds + TAB_OFF);
    __syncthreads();
    if (F.tid < 32) tab[33 + F.tid] = (int)__hip_atomic_load(F.ctl + CW_CNT + 64 * F.tid, RLX_AGENT);
    __syncthreads();
    if (F.tid == 0) {
        int acc = 0;
        for (int e = 0; e < 32; ++e) { tab[e] = acc; acc += (tab[33 + e] + 255) >> 8; }
        tab[32] = acc;
    }
    __syncthreads();
}

using pg8::f32x4; using pg8::u32x4; using pg8::cvt_pk_bf16;
#define EPI_ROWS(u) const int row0 = (u).pm * 256 + wr * 64 + fr
#define EPI_LOOP _Pragma("unroll") for (int ai = 0; ai < 2; ++ai) _Pragma("unroll") for (int m = 0; m < 4; ++m)
__device__ __forceinline__ u32x4 pack8(const f32x4 a, const f32x4 b) { u32x4 w; w.x = cvt_pk_bf16(a[0], a[1]); w.y = cvt_pk_bf16(a[2], a[3]); w.z = cvt_pk_bf16(b[0], b[1]); w.w = cvt_pk_bf16(b[2], b[3]); return w; }
__device__ __forceinline__ void unpack8(const u32x4 w, f32x4& a, f32x4& b) { a = (f32x4){bflo(w.x), bfhi(w.x), bflo(w.y), bfhi(w.y)}; b = (f32x4){bflo(w.z), bfhi(w.z), bflo(w.w), bfhi(w.w)}; }
__device__ __forceinline__ void unpack8_fp8(const v2u w, f32x4& a, f32x4& b) {
    const auto l0 = __builtin_amdgcn_cvt_pk_f32_fp8((int)w.x, false), h0 = __builtin_amdgcn_cvt_pk_f32_fp8((int)w.x, true), l1 = __builtin_amdgcn_cvt_pk_f32_fp8((int)w.y, false), h1 = __builtin_amdgcn_cvt_pk_f32_fp8((int)w.y, true);
    a = (f32x4){l0[0], l0[1], h0[0], h0[1]}; b = (f32x4){l1[0], l1[1], h1[0], h1[1]}; }
__device__ __forceinline__ v2u pack8_fp8(const f32x4 a, const f32x4 b) { return (v2u){pk4_fp8(a[0], a[1], a[2], a[3]), pk4_fp8(b[0], b[1], b[2], b[3])}; }
__device__ __forceinline__ f32x4 sig4(f32x4 x) { return (f32x4){sigmoidf_(x[0]), sigmoidf_(x[1]), sigmoidf_(x[2]), sigmoidf_(x[3])}; }

struct EpiStore {
    static constexpr bool PERM = true; bf16* O; int ldc; unsigned char* P8;
    __device__ __forceinline__ void operator()(const f32x4 (&acc)[2][2][4][2], const pg8::Unit& u, int wr, int wc, int fr, int fq) const {
        EPI_ROWS(u); const int col0 = u.pn * 256 + wc * 32 + 8 * fq;
        if (u.pn == 22 && wc != 0) return;
        if (u.pn >= 10 && u.pn < 22) {
            EPI_LOOP { unsigned char* rowp = P8 + (size_t)(row0 + ai * 128 + m * 16) * 3072 + (col0 - PC_O);
#pragma unroll
                for (int bj = 0; bj < 2; ++bj) *(v2u*)(rowp + bj * 128) = pack8_fp8(acc[ai][bj][m][0], acc[ai][bj][m][1]); }
            return; }
        EPI_LOOP { bf16* rowp = O + (size_t)(row0 + ai * 128 + m * 16) * ldc + col0;
#pragma unroll
            for (int bj = 0; bj < 2; ++bj) if (u.pn != 22 || bj == 0) *(u32x4*)(rowp + bj * 128) = pack8(acc[ai][bj][m][0], acc[ai][bj][m][1]); }
    }
};
struct EpiGlu {
    static constexpr bool PERM = true; const bf16* A2; bf16* A3; const float* bias;
    __device__ __forceinline__ void operator()(const f32x4 (&acc)[2][2][4][2], const pg8::Unit& u, int wr, int wc, int fr, int fq) const {
        EPI_ROWS(u); const int col0 = u.pn * 256 + wc * 32 + 8 * fq;
        f32x4 bv[2][2];
#pragma unroll
        for (int bj = 0; bj < 2; ++bj)
#pragma unroll
            for (int n = 0; n < 2; ++n) bv[bj][n] = *(const f32x4*)(bias + col0 + bj * 128 + 4 * n);
#pragma unroll
        for (int ai = 0; ai < 2; ++ai) {
            v2u ld[4][2];
#pragma unroll
            for (int m = 0; m < 4; ++m)
#pragma unroll
                for (int bj = 0; bj < 2; ++bj) ld[m][bj] = *(const v2u*)((const unsigned char*)A2 + (size_t)(row0 + ai * 128 + m * 16) * 512 + col0 + bj * 128);
            __builtin_amdgcn_sched_barrier(0);
#pragma unroll
            for (int m = 0; m < 4; ++m)
#pragma unroll
                for (int bj = 0; bj < 2; ++bj) { f32x4 a0, a1; unpack8_fp8(ld[m][bj], a0, a1);
                    const f32x4 v0 = a0 * sig4(acc[ai][bj][m][0] + bv[bj][0]), v1 = a1 * sig4(acc[ai][bj][m][1] + bv[bj][1]);
                    *(v2u*)((unsigned char*)A3 + (size_t)(row0 + ai * 128 + m * 16) * 512 + col0 + bj * 128) = pack8_fp8(v0, v1); }
        }
    }
};
template <bool ADD> struct EpiGate {
    static constexpr bool PERM = true; const unsigned char* proj; int gc0; const float* bg; const bf16* Prev; bf16* O;
    __device__ __forceinline__ void operator()(const f32x4 (&acc)[2][2][4][2], const pg8::Unit& u, int wr, int wc, int fr, int fq) const {
        EPI_ROWS(u); const int col0 = u.pn * 256 + wc * 32 + 8 * fq;
        f32x4 bv[2][2];
#pragma unroll
        for (int bj = 0; bj < 2; ++bj)
#pragma unroll
            for (int n = 0; n < 2; ++n) bv[bj][n] = *(const f32x4*)(bg + col0 + bj * 128 + 4 * n);
        constexpr int MB = ADD ? 2 : 4;
#pragma unroll
        for (int g = 0; g < 8 / MB; ++g) {
            v2u lg[MB][2]; u32x4 lp[MB][2];
#pragma unroll
            for (int mm = 0; mm < MB; ++mm)
#pragma unroll
                for (int bj = 0; bj < 2; ++bj) { const int q = g * MB + mm, row = row0 + (q >> 2) * 128 + (q & 3) * 16; lg[mm][bj] = *(const v2u*)(proj + (size_t)row * 3072 + gc0 + col0 + bj * 128);
                    if (ADD) lp[mm][bj] = *(const u32x4*)(Prev + (size_t)row * 1024 + col0 + bj * 128); }
            __builtin_amdgcn_sched_barrier(0);
#pragma unroll
            for (int mm = 0; mm < MB; ++mm)
#pragma unroll
                for (int bj = 0; bj < 2; ++bj) { const int q = g * MB + mm, ai = q >> 2, m = q & 3; f32x4 g0, g1; unpack8_fp8(lg[mm][bj], g0, g1);
                    f32x4 v0 = sig4(g0 + bv[bj][0]) * acc[ai][bj][m][0], v1 = sig4(g1 + bv[bj][1]) * acc[ai][bj][m][1];
                    if (ADD) { f32x4 p0, p1; unpack8(lp[mm][bj], p0, p1); v0 += p0; v1 += p1; }
                    if (ADD) *(v2u*)((unsigned char*)O + (size_t)(row0 + ai * 128 + m * 16) * 1024 + col0 + bj * 128) = pack8_fp8(v0 * 4.0f, v1 * 4.0f);
                    else *(u32x4*)(O + (size_t)(row0 + ai * 128 + m * 16) * 1024 + col0 + bj * 128) = pack8(v0, v1); }
            __builtin_amdgcn_sched_barrier(0);
        }
    }
};
struct EpiX1 {
    static constexpr bool PERM = true; const float* x; const float* mod; bf16* X1;
    __device__ __forceinline__ void operator()(const f32x4 (&acc)[2][2][4][2], const pg8::Unit& u, int wr, int wc, int fr, int fq) const {
        EPI_ROWS(u); const int col0 = u.pn * 256 + wc * 32 + 8 * fq; const int b = (u.pm * 256) / SEQ;
        f32x4 gv[2][2];
#pragma unroll
        for (int bj = 0; bj < 2; ++bj)
#pragma unroll
            for (int n = 0; n < 2; ++n) gv[bj][n] = *(const f32x4*)(mod + b * 6144 + 2 * D + col0 + bj * 128 + 4 * n);
#pragma unroll
        for (int g = 0; g < 4; ++g) {
            f32x4 lx[2][2][2];
#pragma unroll
            for (int mm = 0; mm < 2; ++mm)
#pragma unroll
                for (int bj = 0; bj < 2; ++bj) { const int q = g * 2 + mm; const size_t off = (size_t)(row0 + (q >> 2) * 128 + (q & 3) * 16) * D + col0 + bj * 128; lx[mm][bj][0] = *(const f32x4*)(x + off); lx[mm][bj][1] = *(const f32x4*)(x + off + 4); }
            __builtin_amdgcn_sched_barrier(0);
#pragma unroll
            for (int mm = 0; mm < 2; ++mm)
#pragma unroll
                for (int bj = 0; bj < 2; ++bj) { const int q = g * 2 + mm, ai = q >> 2, m = q & 3; const size_t off = (size_t)(row0 + ai * 128 + m * 16) * D + col0 + bj * 128;
                    *(u32x4*)(X1 + off) = pack8(lx[mm][bj][0] + gv[bj][0] * acc[ai][bj][m][0], lx[mm][bj][1] + gv[bj][1] * acc[ai][bj][m][1]); }
            __builtin_amdgcn_sched_barrier(0);
        }
    }
};
struct EpiSwiglu {
    static constexpr bool PERM = true; const float* bin; bf16* ACT;
    __device__ __forceinline__ void operator()(const f32x4 (&acc)[2][2][4][2], const pg8::Unit& u, int wr, int wc, int fr, int fq) const {
        EPI_ROWS(u); const int e = u.pn >> 3, pl = u.pn & 7; const int f0 = pl * 128 + wc * 32 + 8 * fq;
        f32x4 bg[2], bl[2];
#pragma unroll
        for (int n = 0; n < 2; ++n) { bg[n] = *(const f32x4*)(bin + e * 2048 + f0 + 4 * n); bl[n] = *(const f32x4*)(bin + e * 2048 + 1024 + f0 + 4 * n); }
        EPI_LOOP { f32x4 o[2];
#pragma unroll
            for (int n = 0; n < 2; ++n) { const f32x4 zg = acc[ai][0][m][n] + bg[n], zl = acc[ai][1][m][n] + bl[n];
#pragma unroll
                for (int j = 0; j < 4; ++j) { const float gl = fminf(zg[j], 7.0f); const float li = fminf(fmaxf(zl[j], -7.0f), 7.0f); o[n][j] = gl * sigmoidf_(1.702f * gl) * (li + 1.0f); } }
            *(v2u*)((unsigned char*)ACT + (size_t)(row0 + ai * 128 + m * 16) * 1024 + f0) = (v2u){pk4_fp8(8.f * o[0][0], 8.f * o[0][1], 8.f * o[0][2], 8.f * o[0][3]), pk4_fp8(8.f * o[1][0], 8.f * o[1][1], 8.f * o[1][2], 8.f * o[1][3])}; }
    }
};
struct EpiY {
    static constexpr bool PERM = true; const float* bout; bf16* Y;
    __device__ __forceinline__ void operator()(const f32x4 (&acc)[2][2][4][2], const pg8::Unit& u, int wr, int wc, int fr, int fq) const {
        EPI_ROWS(u); const int e = u.pn >> 2, pl = u.pn & 3; const int col0 = pl * 256 + wc * 32 + 8 * fq;
        f32x4 bv[2][2];
#pragma unroll
        for (int bj = 0; bj < 2; ++bj)
#pragma unroll
            for (int n = 0; n < 2; ++n) bv[bj][n] = *(const f32x4*)(bout + e * 1024 + col0 + bj * 128 + 4 * n);
        EPI_LOOP { unsigned char* rowp = (unsigned char*)Y + (size_t)(row0 + ai * 128 + m * 16) * 1024 + col0;
#pragma unroll
            for (int bj = 0; bj < 2; ++bj) { const f32x4 v0 = (acc[ai][bj][m][0] + bv[bj][0]) * 16.0f, v1 = (acc[ai][bj][m][1] + bv[bj][1]) * 16.0f;
                *(v2u*)(rowp + bj * 128) = (v2u){pk4_fp8(v0[0], v0[1], v0[2], v0[3]), pk4_fp8(v1[0], v1[1], v1[2], v1[3])}; } }
    }
};

struct TItem { const float* src; bf16* dst; int ld, ldk; int f8; };
__device__ __forceinline__ void titem_load(const TItem& t, int lane, f32x4 (&r)[8]) {
#pragma unroll
    for (int i = 0; i < 8; ++i) r[i] = *(const f32x4*)(t.src + (size_t)(8 * i + (lane >> 3)) * t.ld + 4 * (lane & 7));
}
__device__ __forceinline__ void titem_store(const TItem& t, int lane, const f32x4 (&r)[8], LAS float* scr) {
#pragma unroll
    for (int i = 0; i < 8; ++i) { LAS float* p = scr + (8 * i + (lane >> 3)) * 33 + 4 * (lane & 7); p[0] = r[i][0]; p[1] = r[i][1]; p[2] = r[i][2]; p[3] = r[i][3]; }
    LDS_WAIT(); asm volatile("" ::: "memory");
    const int c = lane & 7;
#pragma unroll
    for (int j = 0; j < 4; ++j) { const int n = (lane >> 3) + 8 * j; const LAS float* s = scr + (8 * c) * 33 + n;
        if (t.f8) { *(GAS v2u*)((unsigned char*)t.dst + (size_t)n * t.ldk + 8 * c) = (v2u){pk4_fp8(32.f * s[0 * 33], 32.f * s[1 * 33], 32.f * s[2 * 33], 32.f * s[3 * 33]), pk4_fp8(32.f * s[4 * 33], 32.f * s[5 * 33], 32.f * s[6 * 33], 32.f * s[7 * 33])}; }
        else { v4u o; o.x = pk2(s[0 * 33], s[1 * 33]); o.y = pk2(s[2 * 33], s[3 * 33]); o.z = pk2(s[4 * 33], s[5 * 33]); o.w = pk2(s[6 * 33], s[7 * 33]);
            *(GAS v4u*)(t.dst + (size_t)n * t.ldk + 8 * c) = o; } }
    LDS_WAIT(); asm volatile("" ::: "memory");
}
__device__ __forceinline__ void p0_prologue(Frame& F, const float* const* __restrict__ INP) {
    {
        LAS float* sc = (LAS float*)(F.lds);
        LAS float* red = (LAS float*)(F.lds + 9 * 1024 * 4);
        for (int i = F.tid; i < 9 * 1024; i += NWAVES * 64) { const int r = i >> 10, k = i & 1023; const float v = r < 8 ? INP[1][r * 1024 + k] : INP[3][k]; sc[i] = v / (1.0f + expf(-v)); }
        __syncthreads();
        const float* wada = INP[4]; const float* bada = INP[5];
        float* mod = (float*)(F.ws + WS_MOD);
        for (int cg = blockIdx.x; cg < 256; cg += F.G) {
            const int j0 = cg * 24, col = F.lane & 31, kp = F.lane >> 5;
            float a[9];
#pragma unroll
            for (int r = 0; r < 9; ++r) a[r] = 0.f;
            if (col < 24) {
#pragma unroll 16
                for (int i = 0; i < 64; ++i) { const int k = F.wave * 128 + 2 * i + kp; const float wv = wada[(size_t)k * 6144 + j0 + col];
#pragma unroll
                    for (int r = 0; r < 9; ++r) a[r] += sc[r * 1024 + k] * wv; }
            }
#pragma unroll
            for (int r = 0; r < 9; ++r) red[((F.wave * 2 + kp) * 9 + r) * 32 + col] = a[r];
            __syncthreads();
            if (F.tid < 9 * 32) { const int r = F.tid >> 5, cc = F.tid & 31;
                if (cc < 24) { float s = 0.f; for (int p = 0; p < 16; ++p) s += red[(p * 9 + r) * 32 + cc]; const int j = j0 + cc; s += bada[j];
                    if (r < 8) mod[r * 6144 + j] = s; else if (j < 2048) mod[8 * 6144 + j] = s; } }
            __syncthreads();
        }
    }
    LAS float* scr = (LAS float*)(F.lds + F.wave * 16384);
    const int gw = F.vcu * NWAVES + F.wave, NGW = F.G * NWAVES;
    bf16* WIN = (bf16*)(F.ws + WS_WIN); bf16* WGLU = (bf16*)(F.ws + WS_WGLU); bf16* WA = (bf16*)(F.ws + WS_WA); bf16* WB = (bf16*)(F.ws + WS_WB); bf16* WO = (bf16*)(F.ws + WS_WO);
    bf16* WEIN = (bf16*)(F.ws + WS_WEIN); bf16* WEOUT = (bf16*)(F.ws + WS_WEOUT);
    constexpr int I_IN = 177 * 16, I_GLU = 16 * 8, I_A = 32 * 16, I_B = 32 * 8, I_O = 32 * 16, I_EIN = 32 * 64 * 16, I_EOUT = 32 * 32 * 16;
    constexpr int NITEMS = I_IN + I_GLU + I_A + I_B + I_O + I_EIN + I_EOUT;
#define P0_DECODE(it_, T) do { int r = (it_); \
        if (r < I_IN) { const int kb = r / 177, nb = r % 177, n0 = nb * 32; const int sc0 = n0 < 2048 ? n0 : (n0 < 5632 ? n0 + 32 : 2048); \
            T.src = INP[8] + (size_t)kb * 64 * 5664 + sc0; T.ld = 5664; T.dst = (bf16*)((unsigned char*)WIN + (size_t)n0 * 1024 + kb * 64); T.ldk = 1024; T.f8 = 1; break; } r -= I_IN; \
        if (r < I_GLU) { const int kb = r / 16, nb = r % 16; T.src = INP[21] + (size_t)kb * 64 * 512 + nb * 32; T.ld = 512; T.dst = (bf16*)((unsigned char*)WGLU + (size_t)nb * 32 * 512 + kb * 64); T.ldk = 512; T.f8 = 1; break; } r -= I_GLU; \
        if (r < I_A) { const int kb = r / 32, nb = r % 32; T.src = INP[12] + (size_t)kb * 64 * 1024 + nb * 32; T.ld = 1024; T.dst = (bf16*)((unsigned char*)WA + (size_t)nb * 32 * 1024 + kb * 64); T.ldk = 1024; T.f8 = 1; break; } r -= I_A; \
        if (r < I_B) { const int kb = r / 32, nb = r % 32; T.src = INP[23] + (size_t)kb * 64 * 1024 + nb * 32; T.ld = 1024; T.dst = (bf16*)((unsigned char*)WB + (size_t)nb * 32 * 512 + kb * 64); T.ldk = 512; T.f8 = 1; break; } r -= I_B; \
        if (r < I_O) { const int kb = r / 32, nb = r % 32; T.src = INP[25] + (size_t)kb * 64 * 1024 + nb * 32; T.ld = 1024; T.dst = (bf16*)((unsigned char*)WO + (size_t)nb * 32 * 1024 + kb * 64); T.ldk = 1024; T.f8 = 1; break; } r -= I_O; \
        if (r < I_EIN) { const int e = r / 1024, q = r % 1024, kb = q / 64, nb = q % 64; const int dr = nb * 32, pn = dr >> 8, bj = (dr >> 7) & 1, xx = dr & 127; \
            T.src = INP[28] + (size_t)e * 1024 * 2048 + (size_t)kb * 64 * 2048 + bj * 1024 + pn * 128 + xx; T.ld = 2048; T.dst = (bf16*)((unsigned char*)WEIN + (size_t)e * 2048 * 1024 + (size_t)dr * 1024 + kb * 64); T.ldk = 1024; T.f8 = 1; break; } r -= I_EIN; \
        { const int e = r / 512, q = r % 512, kb = q / 32, nb = q % 32; \
            T.src = INP[30] + (size_t)e * 1024 * 1024 + (size_t)kb * 64 * 1024 + nb * 32; T.ld = 1024; T.dst = (bf16*)((unsigned char*)WEOUT + (size_t)e * 1024 * 1024 + (size_t)nb * 32 * 1024 + kb * 64); T.ldk = 1024; T.f8 = 1; } } while (0)
    {
        TItem ta, tb; f32x4 ra[8], rb[8];
        int it = gw;
        if (it < NITEMS - I_EIN - I_EOUT) { P0_DECODE(it, ta); titem_load(ta, F.lane, ra); }
        constexpr int NITEMS0 = NITEMS - I_EIN - I_EOUT;
        while (it < NITEMS0) {
            const int nx = it + NGW;
            if (nx < NITEMS0) { P0_DECODE(nx, tb); titem_load(tb, F.lane, rb); }
            titem_store(ta, F.lane, ra, scr);
            ta = tb;
#pragma unroll
            for (int i = 0; i < 8; ++i) ra[i] = rb[i];
            it = nx;
        }
    }
#undef P0_DECODE
    { const int gt = blockIdx.x * (NWAVES * 64) + F.tid, NT = F.G * NWAVES * 64; GAS v4u* z = (GAS v4u*)((unsigned char*)WIN + (size_t)5664 * 1024);
        for (int i = gt; i < 224 * 1024 / 16; i += NT) z[i] = (v4u){0u, 0u, 0u, 0u}; }
}

__device__ __forceinline__ void p1_norm1(Frame& F, const float* const* __restrict__ INP) {
    const int gw = F.vcu * NWAVES + F.wave, NGW = F.G * NWAVES;
    const float* mod = (const float*)(F.ws + WS_MOD); bf16* H1 = (bf16*)(F.ws + WS_H1);
    for (int m = gw; m < MT; m += NGW) {
        const float* xr; const float* sh; const float* scl;
        if (m < ML) { const int b = m / SEQ; xr = INP[0] + (size_t)m * D; sh = mod + b * 6144; scl = sh + D; }
        else { xr = INP[2] + (size_t)(m - ML) * D; sh = mod + 8 * 6144; scl = sh + D; }
        f32x4 v[4]; float s = 0.f;
#pragma unroll
        for (int j = 0; j < 4; ++j) { v[j] = *(const f32x4*)(xr + 256 * j + 4 * F.lane); s += (v[j][0] * v[j][0] + v[j][1] * v[j][1]) + (v[j][2] * v[j][2] + v[j][3] * v[j][3]); }
        const float rstd = 1.0f / sqrtf(wave_sum(s) * (1.0f / D) + EPS);
#pragma unroll
        for (int j = 0; j < 4; ++j) { const int c = 256 * j + 4 * F.lane; const f32x4 g = *(const f32x4*)(INP[6] + c), a = *(const f32x4*)(scl + c), bb = *(const f32x4*)(sh + c);
            const f32x4 y = v[j] * rstd * g * (a + 1.0f) + bb;
            *(unsigned*)((unsigned char*)H1 + (size_t)m * D + c) = pk4_fp8(y[0], y[1], y[2], y[3]); }
    }
}

__device__ __forceinline__ void conv_fma8(float (&a)[8], const v4u x, const float* wp) {
    const f32x4 w0 = *(const f32x4*)(wp), w1 = *(const f32x4*)(wp + 4);
    a[0] += bflo(x.x) * w0[0]; a[1] += bfhi(x.x) * w0[1]; a[2] += bflo(x.y) * w0[2]; a[3] += bfhi(x.y) * w0[3];
    a[4] += bflo(x.z) * w1[0]; a[5] += bfhi(x.z) * w1[1]; a[6] += bflo(x.w) * w1[2]; a[7] += bfhi(x.w) * w1[3];
}
__device__ __forceinline__ void p3_conv(Frame& F, const float* const* __restrict__ INP) {
    const bf16* PROJ = (const bf16*)(F.ws + WS_PROJ); bf16* QKC = (bf16*)(F.ws + WS_QKC); const float* wc = INP[9];
    const int NT = F.G * NWAVES * 64;
    for (int it = F.vcu * (NWAVES * 64) + F.tid; it < NB * 64 * 16 * 128; it += NT) {
        const int ch0 = (it & 127) * 8, seg = (it >> 7) & 15, gr = (it >> 11) & 63, b = it >> 17, c0 = seg * 4;
        const bf16* base = PROJ + (size_t)(b * SEQ) * LDP + ch0;
        const float scale = ch0 < 512 ? 0.125f : 1.0f;
        v4u win[6][3];
        const v4u z = (v4u){0u, 0u, 0u, 0u};
#pragma unroll
        for (int cc = 0; cc < 6; ++cc)
#pragma unroll
            for (int ky = 0; ky < 3; ++ky) { const int rr = gr + ky - 1, c = c0 + cc - 1;
                win[cc][ky] = (rr >= 0 && rr < 64 && c >= 0 && c < 64) ? *(const v4u*)(base + (size_t)(rr * 64 + c) * LDP) : z; }
        __builtin_amdgcn_sched_barrier(0);
        float a[4][8];
#pragma unroll
        for (int cc = 0; cc < 4; ++cc)
#pragma unroll
            for (int j = 0; j < 8; ++j) a[cc][j] = 0.f;
#pragma unroll
        for (int ky = 0; ky < 3; ++ky)
#pragma unroll
            for (int kx = 0; kx < 3; ++kx) {
                const f32x4 w0 = *(const f32x4*)(wc + (ky * 3 + kx) * 1024 + ch0), w1 = *(const f32x4*)(wc + (ky * 3 + kx) * 1024 + ch0 + 4);
#pragma unroll
                for (int cc = 0; cc < 4; ++cc) { const v4u x = win[cc + kx][ky];
                    a[cc][0] += bflo(x.x) * w0[0]; a[cc][1] += bfhi(x.x) * w0[1]; a[cc][2] += bflo(x.y) * w0[2]; a[cc][3] += bfhi(x.y) * w0[3];
                    a[cc][4] += bflo(x.z) * w1[0]; a[cc][5] += bfhi(x.z) * w1[1]; a[cc][6] += bflo(x.w) * w1[2]; a[cc][7] += bfhi(x.w) * w1[3]; }
                asm volatile("" ::: "memory");
            }
#pragma unroll
        for (int cc = 0; cc < 4; ++cc) {
#pragma unroll
            for (int j = 0; j < 8; ++j) a[cc][j] = a[cc][j] * frcp(1.0f + __expf(-a[cc][j])) * scale;
            *(v4u*)(QKC + (size_t)(b * SEQ + gr * 64 + c0 + cc) * 1024 + ch0) = (v4u){pk2(a[cc][0], a[cc][1]), pk2(a[cc][2], a[cc][3]), pk2(a[cc][4], a[cc][5]), pk2(a[cc][6], a[cc][7])};
        }
    }
    for (int w = F.vcu * (NWAVES * 64) + F.tid; w < MC * 128; w += NT) {
        const int row = ML + (w >> 7), ch0 = (w & 127) * 8, t = (w >> 7) % CTXL;
        float a[8];
#pragma unroll
        for (int j = 0; j < 8; ++j) a[j] = 0.f;
#pragma unroll
        for (int kx = 0; kx < 3; ++kx) { const int tt = t + kx - 1;
            if (tt >= 0 && tt < CTXL) conv_fma8(a, *(const v4u*)(PROJ + (size_t)(row + kx - 1) * LDP + ch0), wc + (3 + kx) * 1024 + ch0); }
        const float scale = ch0 < 512 ? 0.125f : 1.0f;
#pragma unroll
        for (int j = 0; j < 8; ++j) a[j] = a[j] * frcp(1.0f + __expf(-a[j])) * scale;
        *(v4u*)(QKC + (size_t)row * 1024 + ch0) = (v4u){pk2(a[0], a[1]), pk2(a[2], a[3]), pk2(a[4], a[5]), pk2(a[6], a[7])};
    }
    {
        float* GB = (float*)(F.ws + WS_GS); float* GG = GB + 128 * 4352; float* GP = GG + 128 * 4352;
        const int gw = F.vcu * NWAVES + F.wave, NGW = F.G * NWAVES, lane = F.lane;
        for (int it = gw; it < 128 * 34; it += NGW) {
            const int jc = it % 34, dbh = it / 34, h = dbh & 7, b = (dbh >> 3) & 7, d = dbh >> 6;
            const bool lat = jc >= 2; const int p0 = lat ? 128 * (jc - 2) : 128 * jc, Lseq = lat ? SEQ : CTXL, rowbase = lat ? b * SEQ : ML + b * CTXL;
            const float bi_ = INP[10][d * 16 + h], bf_ = INP[10][d * 16 + 8 + h];
            float li2[2], lf2[2];
#pragma unroll
            for (int e = 0; e < 2; ++e) { const int sp = 2 * lane + e; const int tt = d ? (Lseq - 1 - (p0 + sp)) : (p0 + sp); const size_t row = (size_t)(rowbase + tt);
                li2[e] = bf2f(PROJ[row * LDP + PC_IF + d * 16 + h]) + bi_; const float xf = bf2f(PROJ[row * LDP + PC_IF + d * 16 + 8 + h]) + bf_;
                lf2[e] = fminf(xf, 0.f) - log1pf(expf(-fabsf(xf))); }
            const float c1 = lf2[0] + lf2[1]; float inc = c1;
#pragma unroll
            for (int o = 1; o < 64; o <<= 1) { const float t = __shfl_up(inc, o); if (lane >= o) inc += t; }
            const float exc = inc - c1, b0 = exc + lf2[0], b1 = exc + c1, g0 = li2[0] - b0, g1 = li2[1] - b1;
            float pmx = fmaxf(g0, g1);
#pragma unroll
            for (int o = 1; o < 64; o <<= 1) { const float t = __shfl_up(pmx, o); if (lane >= o) pmx = fmaxf(pmx, t); }
            float pex = __shfl_up(pmx, 1); if (lane == 0) pex = -INFINITY;
            const size_t o = (size_t)dbh * 4352 + 128 * jc + 2 * lane;
            *(float2*)(GB + o) = make_float2(b0, b1); *(float2*)(GG + o) = make_float2(g0, g1); *(float2*)(GP + o) = make_float2(fmaxf(pex, g0), pmx);
        }
    }
}

__device__ __forceinline__ void mma32_nt(f32x16& acc, const LAS bf16* A, int lda, const LAS bf16* Bt, int ldb, int K, int lane) {
    const int r = lane & 31, h = lane >> 5;
#pragma unroll
    for (int k0 = 0; k0 < K; k0 += 16) {
        const bf16x8 a = *(const LAS bf16x8*)(A + r * lda + k0 + 8 * h);
        const bf16x8 b = *(const LAS bf16x8*)(Bt + r * ldb + k0 + 8 * h);
        acc = __builtin_amdgcn_mfma_f32_32x32x16_bf16(a, b, acc, 0, 0, 0);
        if ((k0 & 63) == 48) __builtin_amdgcn_sched_barrier(0);
    }
}
__device__ __forceinline__ void mma16_nt(f32x4& acc, const LAS bf16* A, int lda, const LAS bf16* Bt, int ldb, int K, int lane) {
    const int r = lane & 15, q = lane >> 4;
    for (int k0 = 0; k0 < K; k0 += 32) {
        const bf16x8 a = *(const LAS bf16x8*)(A + r * lda + k0 + 8 * q);
        const bf16x8 b = *(const LAS bf16x8*)(Bt + r * ldb + k0 + 8 * q);
        acc = __builtin_amdgcn_mfma_f32_16x16x32_bf16(a, b, acc, 0, 0, 0);
    }
}
__device__ __forceinline__ int row32(int reg, int lane) { return (reg & 3) + 8 * (reg >> 2) + 4 * (lane >> 5); }
__device__ __forceinline__ float logsigmoidf_(float x) { return fminf(x, 0.f) - log1pf(expf(-fabsf(x))); }

typedef short s16x4 __attribute__((ext_vector_type(4)));
__device__ __forceinline__ s16x4 tr_read(const LAS bf16* p) { return __builtin_amdgcn_ds_read_tr16_b64_v4i16((LAS s16x4*)p); }
__device__ __forceinline__ bf16x8 tr_frag32_perm(const LAS bf16* T, int ld, int k0, int x0, int lane) {
    const int h = lane >> 5, i = lane & 15, q = i >> 2, p = i & 3, xb = 16 * ((lane >> 4) & 1);
    const LAS bf16* a = T + (k0 + 4 * h + q) * ld + x0 + xb + 4 * p;
    const s16x4 lo = tr_read(a), hi = tr_read(a + 8 * ld);
    return (bf16x8){lo[0], lo[1], lo[2], lo[3], hi[0], hi[1], hi[2], hi[3]};
}
__device__ __forceinline__ bf16x8 tr_frag16(const LAS bf16* T, int ld, int k0, int x0, int lane) {
    const int q4 = lane >> 4, i = lane & 15, q = i >> 2, p = i & 3;
    const LAS bf16* a = T + (k0 + 8 * q4 + q) * ld + x0 + 4 * p;
    const s16x4 lo = tr_read(a), hi = tr_read(a + 4 * ld);
    return (bf16x8){lo[0], lo[1], lo[2], lo[3], hi[0], hi[1], hi[2], hi[3]};
}
__device__ __forceinline__ v4u scale8(const v4u k8, float ww) {
    return (v4u){pk2(ww * bflo(k8.x), ww * bfhi(k8.x)), pk2(ww * bflo(k8.y), ww * bfhi(k8.y)), pk2(ww * bflo(k8.z), ww * bfhi(k8.z)), pk2(ww * bflo(k8.w), ww * bfhi(k8.w))};
}

constexpr int XI_EIN = 32 * 64 * 16, XI_EOUT = 32 * 32 * 16, XI_PER_UNIT = (XI_EIN + XI_EOUT) / 256;
__device__ __forceinline__ void xitem_decode(const float* const* __restrict__ INP, unsigned char* ws, int r, const float*& src, int& ld, unsigned char*& dst) {
    if (r < XI_EIN) { const int e = r / 1024, q = r % 1024, kb = q / 64, nb = q % 64; const int dr = nb * 32, pn = dr >> 8, bj = (dr >> 7) & 1, xx = dr & 127;
        src = INP[28] + (size_t)e * 1024 * 2048 + (size_t)kb * 64 * 2048 + bj * 1024 + pn * 128 + xx; ld = 2048; dst = ws + WS_WEIN + (size_t)e * 2048 * 1024 + (size_t)dr * 1024 + kb * 64; }
    else { r -= XI_EIN; const int e = r / 512, q = r % 512, kb = q / 32, nb = q % 32;
        src = INP[30] + (size_t)e * 1024 * 1024 + (size_t)kb * 64 * 1024 + nb * 32; ld = 1024; dst = ws + WS_WEOUT + (size_t)e * 1024 * 1024 + (size_t)nb * 32 * 1024 + kb * 64; }
}
template <int MODE>
__device__ __forceinline__ void p4_mlstm(Frame& F, const float* const* __restrict__ INP, int unit) {
    const int vh = unit & 1, h = (unit >> 1) & 7, b = (unit >> 4) & 7, d = unit >> 7;
    LAS bf16* Qs = (LAS bf16*)(F.lds + 0);
    LAS bf16* Ks = (LAS bf16*)(F.lds + 18432);
    LAS bf16* Kw = (LAS bf16*)(F.lds + 36864);
    LAS bf16* Vs = (LAS bf16*)(F.lds + 55296);
    LAS bf16* Cb = (LAS bf16*)(F.lds + 73728);
    LAS float* vec = (LAS float*)(F.lds + 82944);
    LAS float *rowt = vec, *colt = vec + 128, *iev = vec + 256, *emt = vec + 384, *nv = vec + 512, *npart = vec + 576;
    const bf16* PROJ = (const bf16*)(F.ws + WS_PROJ); const bf16* QKC = (const bf16*)(F.ws + WS_QKC); unsigned char* HDIR = F.ws + WS_HDIR + (size_t)((((d * 8 + b) * 8 + h) * 2 + vh)) * SEQ * 64;
    const float* GB = (const float*)(F.ws + WS_GS) + (size_t)((d * 8 + b) * 8 + h) * 4352; const float* GG = GB + 128 * 4352; const float* GP = GG + 128 * 4352;
    int tid = F.tid; asm volatile("" : "+v"(tid));
    const int lane = tid & 63, w = F.wave;
    for (int i = tid; i < 64 * 72; i += 512) Cb[i] = 0;
    if (tid < 64) nv[tid] = 0.f;
    f32x4 accC[2] = {(f32x4){0.f, 0.f, 0.f, 0.f}, (f32x4){0.f, 0.f, 0.f, 0.f}};
    float m_old = 0.f, dec_prev = 0.f;
    v4u pq[2], pk[2], pv[2]; float pgb = 0.f, pgp = 0.f, pgc = 0.f, pgg[2], pbend, pgmax; bool hpend = false; int hp0 = 0, hrb = 0, hL = 0;
    LAS bf16* Hst = (LAS bf16*)(F.lds + 140544);
    f32x4 xr[8]; v2u xo[4]; unsigned char* xdst = nullptr; unsigned char* xodst = nullptr; bool xload = false, xout = false;
    const int xw = w - 2;
    LAS float* xscr = (LAS float*)(F.lds + (xw < 5 ? 87296 + (xw < 0 ? 0 : xw) * 8448 : 132096));
    const int zl = tid >> 9;
#define ML_PREFETCH(jn) do { const bool lat_ = (jn) >= 2; const int p0_ = lat_ ? 128 * ((jn) - 2) : 128 * (jn), L_ = lat_ ? SEQ : CTXL, rb_ = lat_ ? b * SEQ : ML + b * CTXL; \
        _Pragma("unroll") for (int i = 0; i < 2; ++i) { const int id = tid + 512 * i, s_ = id >> 3, c_ = id & 7; const int tt = d ? (L_ - 1 - (p0_ + s_)) : (p0_ + s_); const size_t row = (size_t)(rb_ + tt); \
            pq[i] = *(const v4u*)(QKC + row * 1024 + h * 64 + c_ * 8); pk[i] = *(const v4u*)(QKC + row * 1024 + 512 + h * 64 + c_ * 8); pv[i] = *(const v4u*)(PROJ + row * LDP + PC_V + h * 128 + vh * 64 + c_ * 8); \
            pgg[i] = GG[128 * (jn) + s_]; } \
        if (tid < 128) { pgb = GB[128 * (jn) + tid]; pgp = GP[128 * (jn) + tid]; pgc = GG[128 * (jn) + tid]; } \
        pbend = GB[128 * (jn) + 127 + zl]; pgmax = GP[128 * (jn) + 127 + zl]; } while (0)
    ML_PREFETCH(0);
    __syncthreads();
    for (int j = 0; j < 34; ++j) {
        const bool lat = j >= 2;
        const int p0 = lat ? 128 * (j - 2) : 128 * j, Lseq = lat ? SEQ : CTXL, rowbase = lat ? b * SEQ : ML + b * CTXL;
        const float bend = pbend, gmax = pgmax;
        const float mnew = fmaxf(bend + m_old, bend + gmax), dec = __expf(bend + m_old - mnew);
#pragma unroll
        for (int i = 0; i < 2; ++i) { const int id = tid + 512 * i, s = id >> 3, c = id & 7;
            *(LAS v4u*)(Qs + s * 72 + c * 8) = pq[i]; *(LAS v4u*)(Ks + s * 72 + c * 8) = pk[i]; *(LAS v4u*)(Vs + s * 72 + c * 8) = pv[i];
            *(LAS v4u*)(Kw + s * 72 + c * 8) = scale8(pk[i], __expf(bend + pgg[i] - mnew)); }
        if (tid < 128) { colt[tid] = __expf(pgc - gmax); emt[tid] = __expf(-pgb - gmax); }
        const float s0 = __expf(m_old - gmax);
        if (hpend) {
            { const int r = tid >> 2, c = tid & 3; const int tt = d ? (hL - 1 - (hp0 + r)) : (hp0 + r);
                f32x4 a0, a1, b0, b1; unpack8(*(const LAS v4u*)(Hst + r * 72 + 16 * c), a0, a1); unpack8(*(const LAS v4u*)(Hst + r * 72 + 16 * c + 8), b0, b1);
                *(v4u*)(HDIR + (size_t)tt * 64 + 16 * c) = (v4u){pk4_fp8(8.f * a0[0], 8.f * a0[1], 8.f * a0[2], 8.f * a0[3]), pk4_fp8(8.f * a1[0], 8.f * a1[1], 8.f * a1[2], 8.f * a1[3]), pk4_fp8(8.f * b0[0], 8.f * b0[1], 8.f * b0[2], 8.f * b0[3]), pk4_fp8(8.f * b1[0], 8.f * b1[1], 8.f * b1[2], 8.f * b1[3])}; }
            hpend = false; }
        if (j > 0) {
            const int vi = w >> 1;
#pragma unroll
            for (int jj = 0; jj < 2; ++jj) { const int ki = 2 * (w & 1) + jj;
#pragma unroll
                for (int reg = 0; reg < 4; ++reg) Cb[(16 * vi + (lane >> 4) * 4 + reg) * 72 + 16 * ki + (lane & 15)] = (bf16)f2bf(accC[jj][reg]); }
            if (tid < 64) { float sacc = 0.f;
#pragma unroll
                for (int p = 0; p < 8; ++p) sacc += npart[p * 64 + tid];
                nv[tid] = dec_prev * nv[tid] + sacc; }
        }
        LBAR();
        if (j + 1 < 34 && !(MODE & 4)) ML_PREFETCH(j + 1);
        if (MODE == 0 && xw >= 0) {
            if (xout) {
#pragma unroll
                for (int q = 0; q < 4; ++q) *(GAS v2u*)(xodst + (size_t)(8 * q) * 1024) = xo[q];
                xout = false; }
            const int sl = j * 6 + xw;
            if (sl < XI_PER_UNIT) { const float* xsrc; int xld; xitem_decode(INP, F.ws, unit * XI_PER_UNIT + sl, xsrc, xld, xdst);
#pragma unroll
                for (int i = 0; i < 8; ++i) xr[i] = *(const f32x4*)(xsrc + (size_t)(8 * i + (lane >> 3)) * xld + 4 * (lane & 7));
                xload = true; }
        }
        if (lat && !(MODE & 1)) { const int tm = ((w >> 1) == 0 ? 3 : (w >> 1) == 1 ? 2 : (w >> 1) == 2 ? 0 : 1), vt = w & 1, tl = lane & 31, t = 32 * tm + tl, hh = lane >> 5; f32x16 acc;
#pragma unroll
            for (int reg = 0; reg < 16; ++reg) acc[reg] = 0.f;
            mma32_nt(acc, Cb + 32 * vt * 72, 72, Qs + 32 * tm * 72, 72, 64, lane);
#pragma unroll
            for (int reg = 0; reg < 16; ++reg) acc[reg] *= s0;
            float rs = 0.f;
            for (int st = (MODE & 8) ? tm : 0; st <= tm; ++st) {
                f32x16 X;
#pragma unroll
                for (int reg = 0; reg < 16; ++reg) X[reg] = 0.f;
                mma32_nt(X, Ks + 32 * st * 72, 72, Qs + 32 * tm * 72, 72, 64, lane);
                const LAS float* cp = colt + 32 * st + 4 * hh;
                if (st == tm) { const int dlim = tl - 4 * hh;
#pragma unroll
                    for (int rg = 0; rg < 4; ++rg) { const f32x4 c4 = *(const LAS f32x4*)(cp + 8 * rg);
#pragma unroll
                        for (int e = 0; e < 4; ++e) { const float pvv = (8 * rg + e <= dlim) ? X[4 * rg + e] * c4[e] : 0.f; X[4 * rg + e] = pvv; rs += pvv; } }
                } else {
#pragma unroll
                    for (int rg = 0; rg < 4; ++rg) { const f32x4 c4 = *(const LAS f32x4*)(cp + 8 * rg);
#pragma unroll
                        for (int e = 0; e < 4; ++e) { const float pvv = X[4 * rg + e] * c4[e]; X[4 * rg + e] = pvv; rs += pvv; } }
                }
#pragma unroll
                for (int ks = 0; ks < 2; ++ks) {
                    const v4u bw = (v4u){cvtpk(X[8 * ks], X[8 * ks + 1]), cvtpk(X[8 * ks + 2], X[8 * ks + 3]), cvtpk(X[8 * ks + 4], X[8 * ks + 5]), cvtpk(X[8 * ks + 6], X[8 * ks + 7])};
                    const bf16x8 af = tr_frag32_perm(Vs, 72, 32 * st + 16 * ks, 32 * vt, lane);
                    acc = __builtin_amdgcn_mfma_f32_32x32x16_bf16(af, __builtin_bit_cast(bf16x8, bw), acc, 0, 0, 0); }
            }
            float nq = 0.f;
#pragma unroll
            for (int q = 0; q < 4; ++q) { const v4u q8 = *(const LAS v4u*)(Qs + t * 72 + 32 * hh + 8 * q); const LAS float* nn = nv + 32 * hh + 8 * q;
                nq += bflo(q8.x) * nn[0] + bfhi(q8.x) * nn[1] + bflo(q8.y) * nn[2] + bfhi(q8.y) * nn[3] + bflo(q8.z) * nn[4] + bfhi(q8.z) * nn[5] + bflo(q8.w) * nn[6] + bfhi(q8.w) * nn[7]; }
            rs += __shfl_xor(rs, 32); nq += __shfl_xor(nq, 32);
            const float rd = 1.0f / fmaxf(fabsf(s0 * nq + rs), emt[t]);
            LAS bf16* hs = Hst + t * 72 + 32 * vt + 4 * hh;
#pragma unroll
            for (int rg = 0; rg < 4; ++rg) *(LAS v2u*)(hs + 8 * rg) = (v2u){pk2(acc[4 * rg] * rd, acc[4 * rg + 1] * rd), pk2(acc[4 * rg + 2] * rd, acc[4 * rg + 3] * rd)}; }
        if (lat && !(MODE & 1)) { hpend = true; hp0 = p0; hrb = rowbase; hL = Lseq; }
        if (!(MODE & 2)) { const int vi = w >> 1;
            accC[0] *= dec; accC[1] *= dec;
#pragma unroll
            for (int st4 = 0; st4 < 4; ++st4) { const bf16x8 af = tr_frag16(Vs, 72, 32 * st4, 16 * vi, lane);
#pragma unroll
                for (int jj = 0; jj < 2; ++jj) { const bf16x8 bfr = tr_frag16(Kw, 72, 32 * st4, 16 * (2 * (w & 1) + jj), lane); accC[jj] = __builtin_amdgcn_mfma_f32_16x16x32_bf16(af, bfr, accC[jj], 0, 0, 0); } } }
        { const int k = tid & 63, part = tid >> 6; float sacc = 0.f;
#pragma unroll
            for (int q = 0; q < 16; ++q) sacc += bf2f(Kw[(16 * part + q) * 72 + k]);
            npart[part * 64 + k] = sacc; }
        if (MODE == 0 && xw >= 0 && xload) {
#pragma unroll
            for (int i = 0; i < 8; ++i) { LAS float* p = xscr + (8 * i + (lane >> 3)) * 33 + 4 * (lane & 7); p[0] = xr[i][0]; p[1] = xr[i][1]; p[2] = xr[i][2]; p[3] = xr[i][3]; }
            LDS_WAIT(); asm volatile("" ::: "memory");
            const int c = lane & 7;
#pragma unroll
            for (int q = 0; q < 4; ++q) { const LAS float* sp = xscr + (8 * c) * 33 + (lane >> 3) + 8 * q;
                xo[q] = (v2u){pk4_fp8(32.f * sp[0 * 33], 32.f * sp[1 * 33], 32.f * sp[2 * 33], 32.f * sp[3 * 33]), pk4_fp8(32.f * sp[4 * 33], 32.f * sp[5 * 33], 32.f * sp[6 * 33], 32.f * sp[7 * 33])}; }
            xodst = xdst + (size_t)(lane >> 3) * 1024 + 8 * c; xout = true; xload = false;
        }
        m_old = mnew; dec_prev = dec;
        LBAR();
    }
    if (MODE == 0 && xw >= 0 && xout) {
#pragma unroll
        for (int q = 0; q < 4; ++q) *(GAS v2u*)(xodst + (size_t)(8 * q) * 1024) = xo[q]; }
    if (hpend) {
        { const int r = tid >> 2, c = tid & 3; const int tt = d ? (hL - 1 - (hp0 + r)) : (hp0 + r);
            f32x4 a0, a1, b0, b1; unpack8(*(const LAS v4u*)(Hst + r * 72 + 16 * c), a0, a1); unpack8(*(const LAS v4u*)(Hst + r * 72 + 16 * c + 8), b0, b1);
            *(v4u*)(HDIR + (size_t)tt * 64 + 16 * c) = (v4u){pk4_fp8(8.f * a0[0], 8.f * a0[1], 8.f * a0[2], 8.f * a0[3]), pk4_fp8(8.f * a1[0], 8.f * a1[1], 8.f * a1[2], 8.f * a1[3]), pk4_fp8(8.f * b0[0], 8.f * b0[1], 8.f * b0[2], 8.f * b0[3]), pk4_fp8(8.f * b1[0], 8.f * b1[1], 8.f * b1[2], 8.f * b1[3])}; } }
#undef ML_PREFETCH
}

__device__ __forceinline__ void s5_disc(const float* const* __restrict__ INP, int d, int g, int p, float& ar, float& ai, float& cfr, float& cfi) {
    const float dt = expf(INP[15][d * 32 + g]); const float are = INP[13][(d * 32 + g) * 64 + p], aim = INP[14][(d * 32 + g) * 64 + p];
    const float mag = expf(dt * are), ang = dt * aim; ar = mag * cosf(ang); ai = mag * sinf(ang);
    const float den = are * are + aim * aim, xr = ar - 1.0f; cfr = (xr * are + ai * aim) / den; cfi = (ai * are - xr * aim) / den;
}
template <int SMODE>
__device__ __forceinline__ void p4_s5(Frame& F, const float* const* __restrict__ INP, int unit) {
    const int gp = unit & 15, b = (unit >> 4) & 7, d = unit >> 7;
    LAS bf16* BHt = (LAS bf16*)(F.lds + 0);
    LAS bf16* Cm = (LAS bf16*)(F.lds + 69632);
    LAS float* Eb = (LAS float*)(F.lds + 78336);
    LAS bf16* Us = (LAS bf16*)(F.lds + 82432);
    LAS bf16* BBs = (LAS bf16*)(F.lds + 92672);
    const bf16* PROJ = (const bf16*)(F.ws + WS_PROJ); bf16* YDIR = (bf16*)(F.ws + WS_YDIR) + (size_t)(((d * 8 + b) * 16 + gp)) * SEQ * 32;
    LAS bf16* Yst = (LAS bf16*)(F.lds + 104960);
    int tid = F.tid; asm volatile("" : "+v"(tid));
    const int lane = tid & 63, w = F.wave;
    const int sg = tid & 127, seg = tid >> 7;
    float ar, ai, a32r, a32i;
    { float cfr, cfi; s5_disc(INP, d, 2 * gp + (sg >> 6), sg & 63, ar, ai, cfr, cfi); a32r = ar; a32i = ai;
#pragma unroll
        for (int q = 0; q < 5; ++q) { const float nr = a32r * a32r - a32i * a32i, ni = 2.0f * a32r * a32i; a32r = nr; a32i = ni; } }
    for (int idx = tid; idx < 4096; idx += 512) {
        { const int gg = idx >> 11, pp = (idx >> 4) & 127, c = idx & 15, g = 2 * gp + gg, p = pp & 63; float xr_, xi_, cfr, cfi; s5_disc(INP, d, g, p, xr_, xi_, cfr, cfi);
            const float bre = INP[16][((size_t)(d * 32 + g) * 64 + p) * 16 + c], bim = INP[17][((size_t)(d * 32 + g) * 64 + p) * 16 + c];
            BBs[(gg * 128 + pp) * 24 + c] = (bf16)f2bf(pp < 64 ? cfr * bre - cfi * bim : cfr * bim + cfi * bre); }
        { const int gg = idx >> 11, c = (idx >> 7) & 15, pp = idx & 127, g = 2 * gp + gg, p = pp & 63;
            const float v = pp < 64 ? INP[18][((size_t)(d * 32 + g) * 16 + c) * 64 + p] : -INP[19][((size_t)(d * 32 + g) * 16 + c) * 64 + p];
            Cm[(gg * 16 + c) * 136 + pp] = (bf16)f2bf(v); }
    }
    float h0r = 0.f, h0i = 0.f;
    LAS bf16* rowre = BHt + ((sg >> 6) * 128 + (sg & 63)) * 136 + 32 * seg;
    v4u pu; bool ypend = false; int yp0 = 0, yL = 0;
#define S5_PREFETCH(jn) do { const bool lat_ = (jn) >= 2; const int p0_ = lat_ ? 128 * ((jn) - 2) : 128 * (jn), L_ = lat_ ? SEQ : CTXL, rb_ = lat_ ? b * SEQ : ML + b * CTXL; \
        const int s_ = tid >> 2, c_ = tid & 3; const int tt = d ? (L_ - 1 - (p0_ + s_)) : (p0_ + s_); pu = *(const v4u*)(PROJ + (size_t)(rb_ + tt) * LDP + PC_U + gp * 32 + c_ * 8); } while (0)
    S5_PREFETCH(0);
    __syncthreads();
    for (int j = 0; j < 34; ++j) {
        const bool lat = j >= 2;
        const int p0 = lat ? 128 * (j - 2) : 128 * j, Lseq = lat ? SEQ : CTXL, rowbase = lat ? b * SEQ : ML + b * CTXL;
        *(LAS v4u*)(Us + (tid >> 2) * 40 + (tid & 3) * 8) = pu;
        LBAR();
        if (j + 1 < 34) S5_PREFETCH(j + 1);
        if (ypend) { if (!(SMODE & 1)) { const int r = tid >> 2, c = tid & 3; const int tt = d ? (yL - 1 - (yp0 + r)) : (yp0 + r); *(v4u*)(YDIR + (size_t)tt * 32 + 8 * c) = *(const LAS v4u*)(Yst + r * 40 + 8 * c); } ypend = false; }
        { const int gg = w >> 2, tm = w & 3, r = lane & 31, hh = lane >> 5;
            const bf16x8 a = *(const LAS bf16x8*)(Us + (32 * tm + r) * 40 + gg * 16 + 8 * hh);
            LAS bf16* bp = BHt + (gg * 128 + r) * 136 + 32 * tm + 4 * hh;
#pragma unroll
            for (int tn = 0; tn < 4; ++tn) { f32x16 acc;
#pragma unroll
                for (int reg = 0; reg < 16; ++reg) acc[reg] = 0.f;
                const bf16x8 bb = *(const LAS bf16x8*)(BBs + (gg * 128 + 32 * tn + r) * 24 + 8 * hh);
                acc = __builtin_amdgcn_mfma_f32_32x32x16_bf16(a, bb, acc, 0, 0, 0);
#pragma unroll
                for (int rg = 0; rg < 4; ++rg) *(LAS v2u*)(bp + 32 * tn * 136 + 8 * rg) = (v2u){cvtpk(acc[4 * rg], acc[4 * rg + 1]), cvtpk(acc[4 * rg + 2], acc[4 * rg + 3])}; } }
        LBAR();
        v4u xr[4], xi[4];
#pragma unroll
        for (int q = 0; q < 4; ++q) { xr[q] = *(const LAS v4u*)(rowre + 8 * q); xi[q] = *(const LAS v4u*)(rowre + 64 * 136 + 8 * q); }
        { float hr = 0.f, hi = 0.f;
#pragma unroll
            for (int q = 0; q < 4; ++q)
#pragma unroll
                for (int e = 0; e < 4; ++e) { const unsigned wr_ = xr[q][e], wi_ = xi[q][e];
                    { const float br = bflo(wr_), bi = bflo(wi_); const float nr = ar * hr - ai * hi + br, ni = ar * hi + ai * hr + bi; hr = nr; hi = ni; }
                    { const float br = bfhi(wr_), bi = bfhi(wi_); const float nr = ar * hr - ai * hi + br, ni = ar * hi + ai * hr + bi; hr = nr; hi = ni; } }
            Eb[(seg * 128 + sg) * 2] = hr; Eb[(seg * 128 + sg) * 2 + 1] = hi; }
        LBAR();
        { float hcr = h0r, hci = h0i, hr = 0.f, hi = 0.f;
#pragma unroll
            for (int s2 = 0; s2 < 4; ++s2) { if (s2 == seg) { hr = hcr; hi = hci; } const float er = Eb[(s2 * 128 + sg) * 2], ei = Eb[(s2 * 128 + sg) * 2 + 1];
                const float nr = a32r * hcr - a32i * hci + er, ni = a32r * hci + a32i * hcr + ei; hcr = nr; hci = ni; }
            h0r = hcr; h0i = hci;
#pragma unroll
            for (int q = 0; q < 4; ++q) { v4u orr, oi;
#pragma unroll
                for (int e = 0; e < 4; ++e) { const unsigned wr_ = xr[q][e], wi_ = xi[q][e]; float r0, i0, r1, i1;
                    { const float br = bflo(wr_), bi = bflo(wi_); const float nr = ar * hr - ai * hi + br, ni = ar * hi + ai * hr + bi; hr = nr; hi = ni; r0 = hr; i0 = hi; }
                    { const float br = bfhi(wr_), bi = bfhi(wi_); const float nr = ar * hr - ai * hi + br, ni = ar * hi + ai * hr + bi; hr = nr; hi = ni; r1 = hr; i1 = hi; }
                    orr[e] = cvtpk(r0, r1); oi[e] = cvtpk(i0, i1); }
                *(LAS v4u*)(rowre + 8 * q) = orr; *(LAS v4u*)(rowre + 64 * 136 + 8 * q) = oi; } }
        LBAR();
        if (lat) { const int gg = w >> 2;
#pragma unroll
            for (int jj = 0; jj < 2; ++jj) { const int tm = 2 * (w & 3) + jj; f32x4 acc = (f32x4){0.f, 0.f, 0.f, 0.f};
#pragma unroll
                for (int st4 = 0; st4 < 4; ++st4) { const bf16x8 af = *(const LAS bf16x8*)(Cm + (gg * 16 + (lane & 15)) * 136 + 32 * st4 + 8 * (lane >> 4));
                    const bf16x8 bfr = tr_frag16(BHt + gg * 128 * 136, 136, 32 * st4, 16 * tm, lane);
                    acc = __builtin_amdgcn_mfma_f32_16x16x32_bf16(af, bfr, acc, 0, 0, 0); }
                const int t = 16 * tm + (lane & 15);
                *(LAS v2u*)(Yst + t * 40 + gg * 16 + 4 * (lane >> 4)) = (v2u){pk2(acc[0], acc[1]), pk2(acc[2], acc[3])}; }
            ypend = true; yp0 = p0; yL = Lseq; }
    }
    if (ypend && !(SMODE & 1)) { LBAR(); const int r = tid >> 2, c = tid & 3; const int tt = d ? (yL - 1 - (yp0 + r)) : (yp0 + r); *(v4u*)(YDIR + (size_t)tt * 32 + 8 * c) = *(const LAS v4u*)(Yst + r * 40 + 8 * c); }
#undef S5_PREFETCH
    __syncthreads();
}

__device__ __forceinline__ float gelu_tanh(float x) { const float u = 0.7978845608028654f * (x + 0.044715f * x * x * x); const float e = __expf(2.0f * u); const float th = 1.0f - 2.0f * frcp(e + 1.0f); return 0.5f * x * (1.0f + th); }
__device__ __forceinline__ void p5a_prep(Frame& F, const float* const* __restrict__ INP) {
    const int gw = F.vcu * NWAVES + F.wave, NGW = F.G * NWAVES, lane = F.lane;
    const bf16* PROJ = (const bf16*)(F.ws + WS_PROJ); const unsigned char* HB0 = F.ws + WS_HDIR; const unsigned char* HB1 = HB0 + (size_t)ML * 1024;
    const bf16* YD0 = (const bf16*)(F.ws + WS_YDIR); const bf16* YD1 = YD0 + (size_t)ML * 512;
    bf16* A1 = (bf16*)(F.ws + WS_A1); bf16* A2 = (bf16*)(F.ws + WS_A2); const unsigned char* P8 = F.ws + WS_PROJ8;
    for (int m0 = 2 * gw; m0 < ML; m0 += 2 * NGW) {
        v4u ha[2][2], hb[2][2], ho[2][2], ya[2], yb[2], yu[2];
#pragma unroll
        for (int r = 0; r < 2; ++r) { const size_t m = (size_t)(m0 + r); const int bb = (int)(m / SEQ), tq = (int)(m % SEQ);
            const size_t hoff = ((size_t)((bb * 8 + (lane >> 3)) * 2 + ((lane >> 2) & 1)) * SEQ + tq) * 64 + (lane & 3) * 16;
            const size_t yoff = ((size_t)(bb * 16 + (lane >> 2)) * SEQ + tq) * 32 + (lane & 3) * 8;
#pragma unroll
            for (int q = 0; q < 2; ++q) { ha[r][q] = (v4u){0u, 0u, 0u, 0u}; hb[r][q] = (v4u){0u, 0u, 0u, 0u}; ho[r][q] = (v4u){0u, 0u, 0u, 0u}; }
            { const v4u a16 = *(const v4u*)(HB0 + hoff), b16 = *(const v4u*)(HB1 + hoff); ha[r][0].x = a16.x; ha[r][0].y = a16.y; ha[r][1].x = a16.z; ha[r][1].y = a16.w; hb[r][0].x = b16.x; hb[r][0].y = b16.y; hb[r][1].x = b16.z; hb[r][1].y = b16.w; }
            { const v4u o16 = *(const v4u*)(P8 + m * 3072 + 16 * lane); ho[r][0].x = o16.x; ho[r][0].y = o16.y; ho[r][1].x = o16.z; ho[r][1].y = o16.w; }
            ya[r] = *(const v4u*)(YD0 + yoff); yb[r] = *(const v4u*)(YD1 + yoff); yu[r] = *(const v4u*)(PROJ + m * LDP + PC_U + 8 * lane); }
        __builtin_amdgcn_sched_barrier(0);
#pragma unroll
        for (int r = 0; r < 2; ++r) { const size_t m = (size_t)(m0 + r);
            float hm[16]; float ss = 0.f;
#pragma unroll
            for (int q = 0; q < 2; ++q) { f32x4 a0, a1, b0, b1; unpack8_fp8((v2u){ha[r][q].x, ha[r][q].y}, a0, a1); unpack8_fp8((v2u){hb[r][q].x, hb[r][q].y}, b0, b1);
#pragma unroll
                for (int e = 0; e < 4; ++e) { hm[8 * q + e] = (a0[e] + b0[e]) * 0.125f; hm[8 * q + 4 + e] = (a1[e] + b1[e]) * 0.125f; } }
#pragma unroll
            for (int q = 0; q < 16; ++q) ss += hm[q] * hm[q];
            ss += __shfl_xor(ss, 1); ss += __shfl_xor(ss, 2); ss += __shfl_xor(ss, 4);
            const float rs = 1.0f / sqrtf(ss * (1.0f / 128.0f) + EPS);
#pragma unroll
            for (int q = 0; q < 2; ++q) { const float* gm = INP[11] + 16 * lane + 8 * q; f32x4 og0, og1; unpack8_fp8((v2u){ho[r][q].x, ho[r][q].y}, og0, og1);
                float rr[8]; const float og[8] = {og0[0], og0[1], og0[2], og0[3], og1[0], og1[1], og1[2], og1[3]};
#pragma unroll
                for (int e = 0; e < 8; ++e) rr[e] = hm[8 * q + e] * rs * gm[e] * sigmoidf_(og[e]);
                *(v2u*)((unsigned char*)A1 + m * 1024 + 16 * lane + 8 * q) = (v2u){pk4_fp8(rr[0], rr[1], rr[2], rr[3]), pk4_fp8(rr[4], rr[5], rr[6], rr[7])}; }
            { const v4u a = ya[r], bq = yb[r], u8 = yu[r]; const float* dd = INP[20] + 8 * lane;
                float rr[8] = {bflo(a.x) + bflo(bq.x) + dd[0] * bflo(u8.x), bfhi(a.x) + bfhi(bq.x) + dd[1] * bfhi(u8.x), bflo(a.y) + bflo(bq.y) + dd[2] * bflo(u8.y), bfhi(a.y) + bfhi(bq.y) + dd[3] * bfhi(u8.y),
                               bflo(a.z) + bflo(bq.z) + dd[4] * bflo(u8.z), bfhi(a.z) + bfhi(bq.z) + dd[5] * bfhi(u8.z), bflo(a.w) + bflo(bq.w) + dd[6] * bflo(u8.w), bfhi(a.w) + bfhi(bq.w) + dd[7] * bfhi(u8.w)};
#pragma unroll
                for (int e = 0; e < 8; ++e) rr[e] = gelu_tanh(rr[e]);
                *(v2u*)((unsigned char*)A2 + m * 512 + 8 * lane) = (v2u){pk4_fp8(rr[0], rr[1], rr[2], rr[3]), pk4_fp8(rr[4], rr[5], rr[6], rr[7])}; }
        }
    }
}

__device__ __forceinline__ void route_reduce_top4(float (&acc)[32], const float* br, int lane, float (&tv)[4], int (&ti)[4]) {
#pragma unroll
    for (int i = 0; i < 16; ++i) { const float send = (lane & 32) ? acc[i] : acc[i + 16]; const float keep = (lane & 32) ? acc[i + 16] : acc[i]; acc[i] = keep + __shfl_xor(send, 32); }
#pragma unroll
    for (int i = 0; i < 8; ++i) { const float send = (lane & 16) ? acc[i] : acc[i + 8]; const float keep = (lane & 16) ? acc[i + 8] : acc[i]; acc[i] = keep + __shfl_xor(send, 16); }
#pragma unroll
    for (int i = 0; i < 4; ++i) { const float send = (lane & 8) ? acc[i] : acc[i + 4]; const float keep = (lane & 8) ? acc[i + 4] : acc[i]; acc[i] = keep + __shfl_xor(send, 8); }
#pragma unroll
    for (int i = 0; i < 2; ++i) { const float send = (lane & 4) ? acc[i] : acc[i + 2]; const float keep = (lane & 4) ? acc[i + 2] : acc[i]; acc[i] = keep + __shfl_xor(send, 4); }
    { const float send = (lane & 2) ? acc[0] : acc[1]; const float keep = (lane & 2) ? acc[1] : acc[0]; acc[0] = keep + __shfl_xor(send, 2); }
    acc[0] += __shfl_xor(acc[0], 1);
    float val = acc[0] + br[lane >> 1];
    if (lane & 1) val = -INFINITY;
#pragma unroll
    for (int r = 0; r < 4; ++r) { float mx = val;
#pragma unroll
        for (int o = 1; o < 64; o <<= 1) mx = fmaxf(mx, __shfl_xor(mx, o));
        const unsigned long long bal = __ballot(val == mx); const int wl = __ffsll((long long)bal) - 1;
        tv[r] = mx; ti[r] = wl >> 1; if (lane == wl) val = -INFINITY; }
}
__device__ __forceinline__ void p6_route(Frame& F, const float* const* __restrict__ INP) {
    const bf16* X1 = (const bf16*)(F.ws + WS_X1); const float* mod = (const float*)(F.ws + WS_MOD); bf16* H2 = (bf16*)(F.ws + WS_H2);
    int* TOPE = (int*)(F.ws + WS_TOPE); int* POS = (int*)(F.ws + WS_POS); float* TOPP = (float*)(F.ws + WS_TOPP); int* LIST = (int*)(F.ws + WS_LIST);
    LAS float* Wt = (LAS float*)(F.lds);
    LAS int* pe = (LAS int*)(F.lds + LDSCTL_OFF + 1024); LAS int* hist = pe + 512; LAS int* base = hist + 32; LAS int* rank = base + 32;
    const float* wr = INP[26]; const float* br = INP[27];
    const int lane = F.lane, w = F.wave;
    for (int idx = F.tid; idx < 32768; idx += NWAVES * 64) { const int e = idx >> 10, k = idx & 1023; Wt[((((k >> 8) * 4 + (k & 3)) * 32 + e) << 6) + ((k >> 2) & 63)] = wr[k * 32 + e]; }
    __syncthreads();
    for (int tg = blockIdx.x; tg < ML / 128; tg += F.G) {
        if (F.tid < 32) hist[F.tid] = 0;
        __syncthreads();
#pragma unroll 1
        for (int q = 0; q < 16; q += 2) {
            const int tl = w * 16 + q, m = tg * 128 + tl, b = m / SEQ;
            const float* sh = mod + b * 6144 + 3 * D; const float* scl = sh + D;
            float s0 = 0.f, s1 = 0.f;
#pragma unroll
            for (int j = 0; j < 4; ++j) { const v2u w0 = *(const v2u*)(X1 + (size_t)m * D + 256 * j + 4 * lane), w1 = *(const v2u*)(X1 + (size_t)(m + 1) * D + 256 * j + 4 * lane);
                const f32x4 x0 = (f32x4){bflo(w0.x), bfhi(w0.x), bflo(w0.y), bfhi(w0.y)}, x1 = (f32x4){bflo(w1.x), bfhi(w1.x), bflo(w1.y), bfhi(w1.y)};
                s0 += (x0[0] * x0[0] + x0[1] * x0[1]) + (x0[2] * x0[2] + x0[3] * x0[3]); s1 += (x1[0] * x1[0] + x1[1] * x1[1]) + (x1[2] * x1[2] + x1[3] * x1[3]); }
            const float r0 = 1.0f / sqrtf(wave_sum(s0) * (1.0f / D) + EPS), r1 = 1.0f / sqrtf(wave_sum(s1) * (1.0f / D) + EPS);
            float a0[32], a1[32];
#pragma unroll
            for (int e = 0; e < 32; ++e) { a0[e] = 0.f; a1[e] = 0.f; }
#pragma unroll 1
            for (int j = 0; j < 4; ++j) { const int c = 256 * j + 4 * lane; const f32x4 g = *(const f32x4*)(INP[7] + c), a = *(const f32x4*)(scl + c), bb = *(const f32x4*)(sh + c);
                const v2u w0 = *(const v2u*)(X1 + (size_t)m * D + c), w1 = *(const v2u*)(X1 + (size_t)(m + 1) * D + c);
                const f32x4 x0 = (f32x4){bflo(w0.x), bfhi(w0.x), bflo(w0.y), bfhi(w0.y)}, x1 = (f32x4){bflo(w1.x), bfhi(w1.x), bflo(w1.y), bfhi(w1.y)};
                const f32x4 gs = g * (a + 1.0f); const f32x4 y0 = x0 * r0 * gs + bb, y1 = x1 * r1 * gs + bb;
                *(unsigned*)((unsigned char*)H2 + (size_t)m * D + c) = pk4_fp8(y0[0], y0[1], y0[2], y0[3]); *(unsigned*)((unsigned char*)H2 + (size_t)(m + 1) * D + c) = pk4_fp8(y1[0], y1[1], y1[2], y1[3]);
                const LAS float* wj = Wt + j * 8192 + lane;
#pragma unroll
                for (int qq = 0; qq < 4; ++qq) { const LAS float* wp = wj + qq * 2048; const float ya = y0[qq], yb = y1[qq];
#pragma unroll
                    for (int e = 0; e < 32; ++e) { const float wv = wp[e * 64]; a0[e] += ya * wv; a1[e] += yb * wv; }
                    asm volatile("" ::: "memory"); } }
            float tv[4]; int ti[4];
#pragma unroll
            for (int tk = 0; tk < 2; ++tk) {
                if (tk == 0) route_reduce_top4(a0, br, lane, tv, ti); else route_reduce_top4(a1, br, lane, tv, ti);
                const float e1 = __expf(tv[1] - tv[0]), e2 = __expf(tv[2] - tv[0]), e3 = __expf(tv[3] - tv[0]); const float inv = 1.0f / (1.0f + e1 + e2 + e3);
                if (lane < 4) { const float p = lane == 0 ? inv : (lane == 1 ? e1 * inv : (lane == 2 ? e2 * inv : e3 * inv)); const int ee = lane == 0 ? ti[0] : (lane == 1 ? ti[1] : (lane == 2 ? ti[2] : ti[3]));
                    TOPP[(m + tk) * 4 + lane] = p; TOPE[(m + tk) * 4 + lane] = ee; pe[(tl + tk) * 4 + lane] = ee; }
            }
        }
        __syncthreads();
        { const int e = pe[F.tid]; rank[F.tid] = __hip_atomic_fetch_add(&hist[e], 1, __ATOMIC_RELAXED, __HIP_MEMORY_SCOPE_WORKGROUP); }
        __syncthreads();
        if (F.tid < 32) base[F.tid] = (int)__hip_atomic_fetch_add(F.ctl + CW_CNT + 64 * F.tid, (unsigned)hist[F.tid], RLX_AGENT);
        __syncthreads();
        { const int e = pe[F.tid]; const int pos = base[e] + rank[F.tid]; const int m = tg * 128 + (F.tid >> 2); LIST[e * ML + pos] = m; POS[m * 4 + (F.tid & 3)] = pos; }
        __syncthreads();
    }
}

typedef int i32x4 __attribute__((ext_vector_type(4)));
__device__ __forceinline__ void p10_combine(Frame& F, const float* const* __restrict__ INP) {
    moe_tables(F);
    const LAS int* tab = (const LAS int*)(F.lds + TAB_OFF);
    const bf16* X1 = (const bf16*)(F.ws + WS_X1); float* OUT = F.out; const float* mod = (const float*)(F.ws + WS_MOD); const unsigned char* Y = (const unsigned char*)(F.ws + WS_Y);
    const int* TOPE = (const int*)(F.ws + WS_TOPE); const int* POS = (const int*)(F.ws + WS_POS); const float* TOPP = (const float*)(F.ws + WS_TOPP);
    const int gw = F.vcu * NWAVES + F.wave, NGW = F.G * NWAVES, lane = F.lane;
    i32x4 te[2], tp[2]; f32x4 tw[2];
    int m0 = 2 * gw;
    if (m0 < ML) {
#pragma unroll
        for (int r = 0; r < 2; ++r) { te[r] = *(const i32x4*)(TOPE + (m0 + r) * 4); tp[r] = *(const i32x4*)(POS + (m0 + r) * 4); tw[r] = *(const f32x4*)(TOPP + (m0 + r) * 4); } }
    for (; m0 < ML; m0 += 2 * NGW) {
        unsigned yv[2][4][4]; v2u xv[2][4];
#pragma unroll
        for (int r = 0; r < 2; ++r) {
#pragma unroll
            for (int k = 0; k < 4; ++k) { const size_t slot = (size_t)256 * tab[te[r][k]] + tp[r][k];
#pragma unroll
                for (int j = 0; j < 4; ++j) yv[r][k][j] = *(const unsigned*)(Y + slot * 1024 + 256 * j + 4 * lane); }
#pragma unroll
            for (int j = 0; j < 4; ++j) xv[r][j] = *(const v2u*)(X1 + (size_t)(m0 + r) * D + 256 * j + 4 * lane); }
        const f32x4 cw[2] = {tw[0], tw[1]};
        const int mn = m0 + 2 * NGW;
        if (mn < ML) {
#pragma unroll
            for (int r = 0; r < 2; ++r) { te[r] = *(const i32x4*)(TOPE + (mn + r) * 4); tp[r] = *(const i32x4*)(POS + (mn + r) * 4); tw[r] = *(const f32x4*)(TOPP + (mn + r) * 4); } }
        __builtin_amdgcn_sched_barrier(0);
#pragma unroll
        for (int r = 0; r < 2; ++r) { const int m = m0 + r, b = m / SEQ; const float* gt2 = mod + b * 6144 + 5 * D;
            f32x4 v[4]; float s = 0.f;
#pragma unroll
            for (int j = 0; j < 4; ++j) { const int c = 256 * j + 4 * lane; f32x4 mo = (f32x4){0.f, 0.f, 0.f, 0.f};
#pragma unroll
                for (int k = 0; k < 4; ++k) { const unsigned y = yv[r][k][j]; const auto lo = __builtin_amdgcn_cvt_pk_f32_fp8((int)y, false), hi = __builtin_amdgcn_cvt_pk_f32_fp8((int)y, true);
                    mo += (f32x4){lo[0], lo[1], hi[0], hi[1]} * (cw[r][k] * 0.0625f); }
                const v2u xw = xv[r][j]; v[j] = (f32x4){bflo(xw.x), bfhi(xw.x), bflo(xw.y), bfhi(xw.y)} + *(const f32x4*)(gt2 + c) * mo;
                s += (v[j][0] * v[j][0] + v[j][1] * v[j][1]) + (v[j][2] * v[j][2] + v[j][3] * v[j][3]); }
            const float rstd = 1.0f / sqrtf(wave_sum(s) * (1.0f / D) + EPS);
#pragma unroll
            for (int j = 0; j < 4; ++j) { const int c = 256 * j + 4 * lane; *(f32x4*)(OUT + (size_t)m * D + c) = v[j] * rstd * *(const f32x4*)(INP[32] + c); }
        }
    }
}

struct Args { const float* in[33]; float* out; unsigned char* ws; int ph_lo, ph_hi, li, pad; };
__global__ void __launch_bounds__(NWAVES * 64, 2) fwd_kernel(Args args) {
    extern __shared__ __attribute__((aligned(16))) unsigned char lds[];
    Frame F;
    F.lds = (LAS unsigned char*)lds;
    F.tid = threadIdx.x; F.lane = F.tid & 63; F.wave = __builtin_amdgcn_readfirstlane(F.tid >> 6);
    F.G = gridDim.x; { const int bx = blockIdx.x; F.vcu = (F.G % 8 == 0) ? (bx % 8) * (F.G / 8) + bx / 8 : bx; }
    F.ws = args.ws; F.ctl = (gu32*)(args.ws + WS_CTL); F.out = args.out;
    for (int u = F.tid; u < (LDS_BYTES - LDSCTL_OFF) / 4; u += NWAVES * 64) ((LAS unsigned*)(F.lds + LDSCTL_OFF))[u] = 0u;
    __syncthreads();
    XcdBarrier bar; bar.bar = (unsigned*)(F.ctl + CW_BAR); bar.x = 0; bar.st = nullptr;
    if (N_LAUNCHES == 1) bar = xcd_barrier_post((unsigned*)(F.ctl + CW_BAR), (volatile LAS unsigned*)(F.lds + MISC_OFF) + 8);
    const int lo = args.ph_lo, hi = args.ph_hi;
    const float* const* __restrict__ INP = args.in;
#ifndef PH_MASK
#define PH_MASK 0x3fff
#endif
#define IN(k) ((((PH_MASK) >> (k)) & 1) && lo <= (k) && (k) < hi)
#define SEAM(k) do { if (IN(k) && IN((k) + 1)) xcd_barrier(bar); } while (0)
    const bf16* WIN = (const bf16*)(F.ws + WS_WIN);

    if (IN(0)) { p0_prologue(F, INP); } SEAM(0);
    if (IN(1)) { p1_norm1(F, INP); } SEAM(1);
    if (IN(2)) {
        pg8::Gemm g{(const bf16*)(F.ws + WS_H1), WIN, 512, nullptr, 0x7f7f7f7f, 0x7a7a7a7a}; InProjOrder S{F.G, (int)blockIdx.x};
        EpiStore E{(bf16*)(F.ws + WS_PROJ), LDP, F.ws + WS_PROJ8};
        pg8::gemm_phase<EpiStore, InProjOrder, false, true>(F.lds, g, S, E);
    } SEAM(2);
    if (IN(3)) { p3_conv(F, INP); } SEAM(3);
    if (IN(4)) { for (int u = blockIdx.x; u < 256; u += F.G) { p4_mlstm<0>(F, INP, u); if (P4_REP_M > 1) p4_mlstm<P4_MODE>(F, INP, u); p4_s5<0>(F, INP, u); if (P4_REP_S > 1) p4_s5<1>(F, INP, u); } } SEAM(4);
    if (IN(5)) { p5a_prep(F, INP); } SEAM(5);
    if (IN(6)) {
        pg8::Gemm g{(const bf16*)(F.ws + WS_A2), (const bf16*)(F.ws + WS_WGLU), 256, nullptr, 0x7f7f7f7f, 0x7a7a7a7a}; pg8::StaticOrder S; S.init(ML, 512, F.G, (int)blockIdx.x);
        EpiGlu E{(const bf16*)(F.ws + WS_A2), (bf16*)(F.ws + WS_A3), INP[22]};
        pg8::gemm_phase<EpiGlu, pg8::StaticOrder, false, true>(F.lds, g, S, E);
    }
    if (IN(7)) {
        pg8::Gemm g{(const bf16*)(F.ws + WS_A1), (const bf16*)(F.ws + WS_WA), 512, nullptr, 0x7f7f7f7f, 0x7a7a7a7a}; pg8::StaticOrder S; S.init(ML, 1024, F.G, (int)blockIdx.x);
        EpiGate<false> E{F.ws + WS_PROJ8, 1024, INP[24], nullptr, (bf16*)(F.ws + WS_YA)};
        pg8::gemm_phase<EpiGate<false>, pg8::StaticOrder, false, true>(F.lds, g, S, E);
    } SEAM(7);
    if (IN(8)) {
        pg8::Gemm g{(const bf16*)(F.ws + WS_A3), (const bf16*)(F.ws + WS_WB), 256, nullptr, 0x7f7f7f7f, 0x7a7a7a7a}; pg8::StaticOrder S; S.init(ML, 1024, F.G, (int)blockIdx.x);
        EpiGate<true> E{F.ws + WS_PROJ8, 2048, INP[24] + 1024, (const bf16*)(F.ws + WS_YA), (bf16*)(F.ws + WS_MERGED)};
        pg8::gemm_phase<EpiGate<true>, pg8::StaticOrder, false, true>(F.lds, g, S, E);
    } SEAM(8);
    if (IN(9)) {
        pg8::Gemm g{(const bf16*)(F.ws + WS_MERGED), (const bf16*)(F.ws + WS_WO), 512, nullptr, 0x7d7d7d7d, 0x7a7a7a7a}; pg8::StaticOrder S; S.init(ML, 1024, F.G, (int)blockIdx.x);
        EpiX1 E{INP[0], (const float*)(F.ws + WS_MOD), (bf16*)(F.ws + WS_X1)};
        pg8::gemm_phase<EpiX1, pg8::StaticOrder, false, true>(F.lds, g, S, E);
    } SEAM(9);
    if (IN(10)) { p6_route(F, INP); } SEAM(10);
    if (IN(11)) {
        moe_tables(F);
        MoeOrder S{F.G, (int)blockIdx.x, 8, (const LAS int*)(F.lds + TAB_OFF)};
        LAS unsigned short* ridx = (LAS unsigned short*)(F.lds + LDSCTL_OFF + 1024);
        { const int* LIST = (const int*)(F.ws + WS_LIST);
            for (int i = 0; i < 30; ++i) { pg8::Unit u; if (!S.next(i, u)) break;
                if (F.tid < 256) { const int rc = F.tid < u.nvalid ? F.tid : u.nvalid - 1; ridx[i * 256 + F.tid] = (unsigned short)LIST[u.lbase + rc]; } }
            __syncthreads(); }
        pg8::Gemm g{(const bf16*)(F.ws + WS_H2), (const bf16*)(F.ws + WS_WEIN), 512, ridx, 0x7f7f7f7f, 0x7a7a7a7a};
        EpiSwiglu E{INP[29], (bf16*)(F.ws + WS_ACT)};
        pg8::gemm_phase<EpiSwiglu, MoeOrder, true, true>(F.lds, g, S, E);
    } SEAM(11);
    if (IN(12)) {
        moe_tables(F);
        pg8::Gemm g{(const bf16*)(F.ws + WS_ACT), (const bf16*)(F.ws + WS_WEOUT), 512, nullptr, 0x7c7c7c7c, 0x7a7a7a7a}; MoeOrder S{F.G, (int)blockIdx.x, 4, (const LAS int*)(F.lds + TAB_OFF)};
        EpiY E{INP[31], (bf16*)(F.ws + WS_Y)};
        pg8::gemm_phase<EpiY, MoeOrder, false, true>(F.lds, g, S, E);
    } SEAM(12);
    if (IN(13)) { p10_combine(F, INP); }
#undef IN
#undef SEAM
}

extern "C" void kernel_launch(void* const* d_in, const int* in_sizes, int n_in, void* d_out, int out_size, void* d_ws, size_t ws_size, hipStream_t stream) {
    static int grid = 0;
    if (grid == 0) {
        if (n_in != 33 || out_size != ML * D || ws_size < WS_END2) { fprintf(stderr, "kernel_launch: unexpected shapes (n_in %d, out %d, ws %zu)\n", n_in, out_size, ws_size); grid = -1; return; }
        int dev = 0, cus = 0, per_cu = 0;
        if (hipGetDevice(&dev) != hipSuccess || hipDeviceGetAttribute(&cus, hipDeviceAttributeMultiprocessorCount, dev) != hipSuccess) { grid = -1; return; }
        if (hipFuncSetAttribute((const void*)fwd_kernel, hipFuncAttributeMaxDynamicSharedMemorySize, LDS_BYTES) != hipSuccess) { fprintf(stderr, "kernel_launch: hipFuncSetAttribute failed\n"); grid = -1; return; }
        if (hipOccupancyMaxActiveBlocksPerMultiprocessor(&per_cu, (const void*)fwd_kernel, NWAVES * 64, LDS_BYTES) != hipSuccess || per_cu < 1) fprintf(stderr, "kernel_launch: occupancy query reports %d\n", per_cu);
        (void)hipGetLastError();
        grid = cus;
    }
    if (grid < 0) return;
    if (hipMemsetAsync((char*)d_ws + WS_CTL, 0, CTL_ZERO_BYTES, stream) != hipSuccess) return;
    Args a{};
    for (int i = 0; i < 33; ++i) a.in[i] = (const float*)d_in[i];
    a.out = (float*)d_out; a.ws = (unsigned char*)d_ws;
    for (int li = 0; li < N_LAUNCHES; ++li) {
        a.ph_lo = (N_LAUNCHES == 1) ? 0 : li; a.ph_hi = (N_LAUNCHES == 1) ? NPH : li + 1; a.li = li;
        const int nrep = (N_LAUNCHES != 1 && (((PROBE_DUP_MASK) >> li) & 1)) ? 2 : 1;
        for (int r = 0; r < nrep; ++r) hipLaunchKernelGGL(fwd_kernel, dim3(grid), dim3(NWAVES * 64), LDS_BYTES, stream, a);
    }
}
```

```cpp
#include <hip/hip_runtime.h>
#include <cstdio>
#include <cstdint>

#ifndef MK_N_LAUNCHES
#define MK_N_LAUNCHES 1
#endif
#ifndef PROBE_DUP_MASK
#define PROBE_DUP_MASK 0
#endif
#ifndef P4_REP_M
#define P4_REP_M 1
#endif
#ifndef P4_MODE
#define P4_MODE 0
#endif
#ifndef P4_REP_S
#define P4_REP_S 1
#endif

namespace pg8 {
#define PG8_LAS __attribute__((address_space(3)))
typedef unsigned short bf16_t;
typedef short bf16x8 __attribute__((ext_vector_type(8)));
typedef float f32x4 __attribute__((ext_vector_type(4)));
typedef unsigned u32x4 __attribute__((ext_vector_type(4)));
constexpr int BM = 256, BK = 64, HALF = 128, HTB = HALF * BK * 2, STAGE_BYTES = 8 * HTB, NXCD = 8, WGM = 8;

__host__ __device__ __forceinline__ int lds_byte(int r, int c) { const int st = (r >> 4) * 2 + (c >> 5), rr = r & 15, cc = c & 31, ob = rr * 64 + cc * 2; return st * 1024 + (ob ^ (((ob >> 9) & 1) << 5)); }
__host__ __device__ __forceinline__ void stage_rc(int b, int& R, int& C) { const int st = b / 1024, sb = b % 1024, swz = sb ^ (((sb >> 9) & 1) << 5); R = (st >> 1) * 16 + swz / 64; C = (st & 1) * 32 + (swz % 64) / 2; }
__host__ __device__ __forceinline__ int perm32(int rho) { const int n = rho >> 4, i = rho & 15; return 8 * (i >> 2) + 4 * n + (i & 3); }

struct Unit { int pm, pn, lbase, nvalid; };
struct Gemm { const bf16_t* A; const bf16_t* Bt; int K; const PG8_LAS unsigned short* ridx; int sa, sb; };

__device__ __forceinline__ int xcd_remap(int L, int nwg) { const int q = nwg / NXCD, r = nwg % NXCD, xcd = L % NXCD, off = L / NXCD; return (xcd < r ? xcd * (q + 1) : r * (q + 1) + (xcd - r) * q) + off; }

struct StaticOrder {
    int nM, nN, nwg, G, c;
    __device__ void init(int M, int N, int G_, int c_) { nM = M / BM; nN = N / BM; nwg = nM * nN; G = G_; c = c_; }
    __device__ __forceinline__ bool next(int i, Unit& u) const {
        const long L = (long)i * G + c; if (L >= nwg) return false;
        const int wgid = xcd_remap((int)L, nwg);
        const int nig = WGM * nN, gid = wgid / nig, fm = gid * WGM, gsz = (nM - fm) < WGM ? (nM - fm) : WGM;
        u.pm = fm + ((wgid % nig) % gsz); u.pn = (wgid % nig) / gsz; u.lbase = 0; u.nvalid = 0; return true;
    }
};

__device__ __forceinline__ unsigned cvt_pk_bf16(float lo, float hi) { unsigned r; asm volatile("v_cvt_pk_bf16_f32 %0, %1, %2" : "=v"(r) : "v"(lo), "v"(hi)); return r; }

typedef int v8i __attribute__((ext_vector_type(8)));
typedef short s16x16 __attribute__((ext_vector_type(16)));
template <class Epi, class Sched, bool GATHER, bool FP8 = false>
__device__ __forceinline__ void gemm_phase(PG8_LAS unsigned char* lds, const Gemm g, const Sched& S, const Epi& E) {
    const int tid = threadIdx.x, wid = __builtin_amdgcn_readfirstlane(tid >> 6), lane = tid & 63, wr = wid >> 2, wc = wid & 3, fr = lane & 15, fq = lane >> 4;
    const int K = g.K, nt = K / BK;
    int Rr[2]; unsigned cby[2], voffB[2];
#pragma unroll
    for (int i = 0; i < 2; ++i) { int R, C; stage_rc(tid * 16 + i * 8192, R, C); const int Rb = Epi::PERM ? ((R & ~31) + perm32(R & 31)) : R;
        Rr[i] = R; cby[i] = (unsigned)C * 2u; voffB[i] = (unsigned)(Rb * K + C) * 2u; }
    const size_t kstep = (size_t)(BK * 2);
    const size_t hstep = (size_t)HALF * K * 2;
    const size_t tstep = 2 * hstep;
    const unsigned ldsw = (unsigned)wid * 1024u;
    const int aoff = lds_byte(wr * 64 + fr, FP8 ? fq * 16 : fq * 8), boff = lds_byte(wc * 32 + fr, FP8 ? fq * 16 : fq * 8);

#define PG8_SA(b, h) (((b) * 2 + (h)) * HTB)
#define PG8_SB(b, h) ((4 + (b) * 2 + (h)) * HTB)
#define PG8_STAGE(bufoff, gbase, voff) do { _Pragma("unroll") for (int _i = 0; _i < 2; ++_i) \
        __builtin_amdgcn_global_load_lds((const unsigned*)((const char*)(gbase) + (voff)[_i]), (PG8_LAS unsigned*)(lds + (bufoff) + ldsw + _i * 8192), 16, 0, 0); } while (0)
#define PG8_LDA(dst, b, h) do { if constexpr (FP8) { _Pragma("unroll") for (int m = 0; m < 4; ++m) { const bf16x8 _lo = *(const PG8_LAS bf16x8*)(lds + PG8_SA(b, h) + aoff + m * 2048), _hi = *(const PG8_LAS bf16x8*)(lds + PG8_SA(b, h) + aoff + m * 2048 + 16); dst##8[m] = __builtin_bit_cast(v8i, __builtin_shufflevector(_lo, _hi, 0, 1, 2, 3, 4, 5, 6, 7, 8, 9, 10, 11, 12, 13, 14, 15)); } } \
        else { _Pragma("unroll") for (int m = 0; m < 4; ++m) _Pragma("unroll") for (int k = 0; k < 2; ++k) dst[m][k] = *(const PG8_LAS bf16x8*)(lds + PG8_SA(b, h) + aoff + m * 2048 + k * 1024); } } while (0)
#define PG8_LDB(dst, b, h) do { if constexpr (FP8) { _Pragma("unroll") for (int n = 0; n < 2; ++n) { const bf16x8 _lo = *(const PG8_LAS bf16x8*)(lds + PG8_SB(b, h) + boff + n * 2048), _hi = *(const PG8_LAS bf16x8*)(lds + PG8_SB(b, h) + boff + n * 2048 + 16); dst##8[n] = __builtin_bit_cast(v8i, __builtin_shufflevector(_lo, _hi, 0, 1, 2, 3, 4, 5, 6, 7, 8, 9, 10, 11, 12, 13, 14, 15)); } } \
        else { _Pragma("unroll") for (int n = 0; n < 2; ++n) _Pragma("unroll") for (int k = 0; k < 2; ++k) dst[n][k] = *(const PG8_LAS bf16x8*)(lds + PG8_SB(b, h) + boff + n * 2048 + k * 1024); } } while (0)
#define PG8_MMA(ai, bj, At, Bt) do { __builtin_amdgcn_s_setprio(1); _Pragma("unroll") for (int m = 0; m < 4; ++m) _Pragma("unroll") for (int n = 0; n < 2; ++n) { \
        if constexpr (FP8) asm volatile("v_mfma_scale_f32_16x16x128_f8f6f4 %0, %1, %2, %0, %3, %4 op_sel_hi:[0,0,0]" : "+v"(acc[ai][bj][m][n]) : "v"(Bt##8[n]), "v"(At##8[m]), "v"(vsb), "v"(vsa));   \
        else { _Pragma("unroll") for (int k = 0; k < 2; ++k) acc[ai][bj][m][n] = __builtin_amdgcn_mfma_f32_16x16x32_bf16(Bt[n][k], At[m][k], acc[ai][bj][m][n], 0, 0, 0); } } \
        __builtin_amdgcn_s_setprio(0); } while (0)
#define PG8_WAIT_V(n) asm volatile("s_waitcnt vmcnt(" #n ")" ::: "memory")
#define PG8_WAIT_L(n) asm volatile("s_waitcnt lgkmcnt(" #n ")" ::: "memory")
#define PG8_BAR __builtin_amdgcn_s_barrier()
#define PG8_SCHED __builtin_amdgcn_sched_barrier(0)
#define PG8_AOFF(dst, u, uord) do { _Pragma("unroll") for (int _h = 0; _h < 2; ++_h) _Pragma("unroll") for (int _i = 0; _i < 2; ++_i) { const int _r = _h * HALF + Rr[_i]; \
        if constexpr (GATHER) { const int _idx = g.ridx[(uord) * 256 + _r]; dst[_h][_i] = (unsigned)_idx * (unsigned)(K * 2) + cby[_i]; } \
        else { dst[_h][_i] = (unsigned)(_r * K * 2) + cby[_i]; } } } while (0)
    Unit cur, nxt; int ui = 0;
    if (!S.next(0, cur)) return;
    f32x4 acc[2][2][4][2];
#pragma unroll
    for (int a = 0; a < 2; ++a)
#pragma unroll
        for (int b = 0; b < 2; ++b)
#pragma unroll
            for (int m = 0; m < 4; ++m)
#pragma unroll
                for (int n = 0; n < 2; ++n) acc[a][b][m][n] = (f32x4){0.f, 0.f, 0.f, 0.f};
    const int vsa = g.sa, vsb = g.sb;
    bf16x8 At[4][2], B0[2][2], B1[2][2];
    v8i At8[4], B08[2], B18[2];
    unsigned vc[2][2], vn[2][2];
    PG8_AOFF(vc, cur, 0);
    const char* cA = GATHER ? (const char*)g.A : (const char*)g.A + (size_t)cur.pm * tstep; const char* cB = (const char*)g.Bt + (size_t)cur.pn * tstep;
    PG8_STAGE(PG8_SB(0, 0), cB, voffB); PG8_STAGE(PG8_SB(0, 1), cB + hstep, voffB); PG8_STAGE(PG8_SA(0, 0), cA, vc[0]); PG8_STAGE(PG8_SA(0, 1), cA, vc[1]);
    if (wr == 1) PG8_BAR;
    PG8_WAIT_V(2); PG8_BAR;
    PG8_STAGE(PG8_SB(1, 0), cB + kstep, voffB); PG8_STAGE(PG8_SA(1, 0), cA + kstep, vc[0]); PG8_STAGE(PG8_SB(1, 1), cB + hstep + kstep, voffB);
    PG8_WAIT_V(6); PG8_BAR;
    for (;;) {
        const bool has_next = S.next(ui + 1, nxt);
        const char* nA = (has_next && !GATHER) ? (const char*)g.A + (size_t)nxt.pm * tstep : cA; const char* nB = has_next ? (const char*)g.Bt + (size_t)nxt.pn * tstep : cB;
        if constexpr (GATHER) { if (has_next) { PG8_AOFF(vn, nxt, ui + 1); } else {
#pragma unroll
            for (int h = 0; h < 2; ++h) { vn[h][0] = vc[h][0]; vn[h][1] = vc[h][1]; } } }
#pragma unroll 1
        for (int t = 0; t < nt; t += 2) {
            const bool last = (t == nt - 2);
            const char* a1 = cA + (size_t)(t + 1) * kstep;
            const char* a2 = last ? nA : cA + (size_t)(t + 2) * kstep; const char* b2 = last ? nB : cB + (size_t)(t + 2) * kstep;
            const char* a3 = a2 + kstep; const char* b3 = b2 + kstep;
            unsigned v2[2][2];
#pragma unroll
            for (int h = 0; h < 2; ++h)
#pragma unroll
                for (int i = 0; i < 2; ++i) v2[h][i] = GATHER ? (last ? vn[h][i] : vc[h][i]) : vc[h][i];
            PG8_LDB(B0, 0, 0); PG8_LDB(B1, 0, 1); PG8_SCHED; PG8_LDA(At, 0, 0); PG8_STAGE(PG8_SA(1, 1), a1, vc[1]);
            PG8_WAIT_V(8); PG8_WAIT_L(0); PG8_BAR; PG8_MMA(0, 0, At, B0); PG8_MMA(0, 1, At, B1); PG8_BAR; PG8_SCHED;
            PG8_LDA(At, 0, 1); PG8_STAGE(PG8_SB(0, 0), b2, voffB); PG8_STAGE(PG8_SB(0, 1), b2 + hstep, voffB); PG8_STAGE(PG8_SA(0, 0), a2, v2[0]);
            PG8_WAIT_V(8); PG8_WAIT_L(0); PG8_BAR; PG8_MMA(1, 0, At, B0); PG8_MMA(1, 1, At, B1); PG8_BAR; PG8_SCHED;
            PG8_LDB(B0, 1, 0); PG8_LDB(B1, 1, 1); PG8_SCHED; PG8_LDA(At, 1, 0); PG8_STAGE(PG8_SA(0, 1), a2, v2[1]);
            PG8_WAIT_V(8); PG8_WAIT_L(0); PG8_BAR; PG8_MMA(0, 0, At, B0); PG8_MMA(0, 1, At, B1); PG8_BAR; PG8_SCHED;
            PG8_LDA(At, 1, 1); PG8_STAGE(PG8_SB(1, 0), b3, voffB); PG8_STAGE(PG8_SB(1, 1), b3 + hstep, voffB); PG8_STAGE(PG8_SA(1, 0), a3, v2[0]);
            PG8_WAIT_V(8); PG8_WAIT_L(0); PG8_BAR; PG8_MMA(1, 0, At, B0); PG8_MMA(1, 1, At, B1); PG8_BAR; PG8_SCHED;
        }
        if (wr == 0) PG8_BAR;
        if constexpr (FP8) asm volatile("s_nop 15\n\ts_nop 15" ::: "memory");
        E(acc, cur, wr, wc, fr, fq);
        if (!has_next) break;
#pragma unroll
        for (int a = 0; a < 2; ++a)
#pragma unroll
            for (int b = 0; b < 2; ++b)
#pragma unroll
                for (int m = 0; m < 4; ++m)
#pragma unroll
                    for (int n = 0; n < 2; ++n) acc[a][b][m][n] = (f32x4){0.f, 0.f, 0.f, 0.f};
        cur = nxt; cA = nA; cB = nB; ++ui;
        if constexpr (GATHER) {
#pragma unroll
            for (int h = 0; h < 2; ++h) { vc[h][0] = vn[h][0]; vc[h][1] = vn[h][1]; } }
        if (wr == 1) PG8_BAR;
    }
    PG8_WAIT_V(0);
    PG8_BAR;
#undef PG8_SA
#undef PG8_SB
#undef PG8_STAGE
#undef PG8_LDA
#undef PG8_LDB
#undef PG8_MMA
#undef PG8_WAIT_V
#undef PG8_WAIT_L
#undef PG8_BAR
#undef PG8_SCHED
#undef PG8_AOFF
}
}

constexpr int NWAVES = 8;
constexpr int D = 1024, NB = 8, SEQ = 4096, CTXL = 256;
constexpr int ML = NB * SEQ, MC = NB * CTXL, MT = ML + MC;
constexpr int LDP = 5888;
constexpr int PC_QK = 0, PC_V = 1024, PC_U = 2048, PC_O = 2560, PC_G = 3584, PC_IF = 5632;
constexpr int NEXP = 32, TOPK = 4;
constexpr int MAXTILES = (ML * TOPK + NEXP * 256) / 256;
constexpr float EPS = 1e-6f;
constexpr int NPH = 14;
constexpr int N_LAUNCHES = MK_N_LAUNCHES;

constexpr size_t MiB = 1u << 20;
constexpr size_t WS_CTL = 0, CTL_ZERO_BYTES = 1 * MiB;
constexpr size_t WS_MOD = 1 * MiB;
constexpr size_t WS_TOPE = 2 * MiB, WS_POS = 2 * MiB + 512 * 1024, WS_TOPP = 3 * MiB, WS_LIST = 4 * MiB;
constexpr size_t WS_WIN = 8 * MiB, WS_WGLU = 20 * MiB, WS_WA = 21 * MiB, WS_WB = 23 * MiB, WS_WO = 24 * MiB, WS_WEIN = 26 * MiB, WS_WEOUT = 90 * MiB, WS_PROJ8 = 122 * MiB;
constexpr size_t WS_R0 = 218 * MiB;
constexpr size_t WS_PROJ = WS_R0, WS_H1 = 609 * MiB, WS_QKC = 677 * MiB, WS_HDIR = 745 * MiB, WS_YDIR = 873 * MiB, WS_END = 937 * MiB;
constexpr size_t WS_A1 = WS_H1, WS_A2 = WS_QKC, WS_A3 = WS_QKC + 32 * MiB, WS_YA = WS_HDIR, WS_MERGED = WS_HDIR + 64 * MiB;
constexpr size_t WS_GS = 940 * MiB, WS_X1 = 940 * MiB, WS_END2 = 1004 * MiB;
constexpr size_t WS_H2 = WS_R0, WS_ACT = 282 * MiB, WS_Y = 554 * MiB;
static_assert(WS_PROJ + (size_t)MT * LDP * 2 <= WS_H1 && WS_Y + (size_t)MAXTILES * 256 * 1024 * 2 <= WS_END, "ws map");
constexpr int CW_BAR = 4096, CW_CNT = 16384;

constexpr int RING_BYTES = 131072;
constexpr int LDSCTL_OFF = RING_BYTES, MISC_OFF = LDSCTL_OFF + 320, TAB_OFF = LDSCTL_OFF + 512;
constexpr int LDS_BYTES = 163840;

#define GAS __attribute__((address_space(1)))
#define LAS __attribute__((address_space(3)))
typedef unsigned short bf16;
typedef unsigned v4u __attribute__((ext_vector_type(4)));
typedef unsigned v2u __attribute__((ext_vector_type(2)));
typedef float f32x4 __attribute__((ext_vector_type(4)));
typedef float f32x16 __attribute__((ext_vector_type(16)));
typedef short bf16x8 __attribute__((ext_vector_type(8)));
typedef GAS unsigned gu32;
#define RLX_AGENT __ATOMIC_RELAXED, __HIP_MEMORY_SCOPE_AGENT
#define LDS_WAIT() asm volatile("s_waitcnt lgkmcnt(0)" ::: "memory")
#define LBAR() do { asm volatile("s_waitcnt lgkmcnt(0)" ::: "memory"); __builtin_amdgcn_s_barrier(); asm volatile("" ::: "memory"); } while (0)
__device__ __forceinline__ unsigned f2bf(float f) { unsigned u = __builtin_bit_cast(unsigned, f); return (u + 0x7fffu + ((u >> 16) & 1u)) >> 16; }
typedef __bf16 bf16x2_t __attribute__((ext_vector_type(2)));
__device__ __forceinline__ unsigned cvtpk(float lo, float hi) { const bf16x2_t v = {(__bf16)lo, (__bf16)hi}; return __builtin_bit_cast(unsigned, v); }
__device__ __forceinline__ unsigned pk2(float lo, float hi) { return cvtpk(lo, hi); }
__device__ __forceinline__ float clamp448(float x) { return fminf(fmaxf(x, -448.0f), 448.0f); }
__device__ __forceinline__ unsigned pk4_fp8(float a, float b, float c, float d) {
    unsigned w = 0; w = __builtin_amdgcn_cvt_pk_fp8_f32(clamp448(a), clamp448(b), w, false); w = __builtin_amdgcn_cvt_pk_fp8_f32(clamp448(c), clamp448(d), w, true); return w; }
__device__ __forceinline__ float bf2f(unsigned b) { return __builtin_bit_cast(float, b << 16); }
__device__ __forceinline__ float bflo(unsigned w) { return __builtin_bit_cast(float, w << 16); }
__device__ __forceinline__ float bfhi(unsigned w) { return __builtin_bit_cast(float, w & 0xffff0000u); }
__device__ __forceinline__ float frcp(float x) { return __builtin_amdgcn_rcpf(x); }
__device__ __forceinline__ float sigmoidf_(float x) { return frcp(1.0f + __expf(-x)); }

#define XB_TMO      128
#define XB_XCNT(j)  (256  + 64 * (j))
#define XB_XSUB(j)  (1280 + 64 * (j))
#define XB_XGEN(j)  (2304 + 64 * (j))
#define XB_TOP      3328
#define XB_TOPGEN   3392
#define XCD_BAR_WORDS 3456
#define XB_SPIN_CAP (1u << 22)
__device__ __forceinline__ unsigned xb_ld(unsigned* p)              { return __hip_atomic_load(p, __ATOMIC_RELAXED, __HIP_MEMORY_SCOPE_AGENT); }
__device__ __forceinline__ unsigned xb_add(unsigned* p, unsigned v) { return __hip_atomic_fetch_add(p, v, __ATOMIC_RELAXED, __HIP_MEMORY_SCOPE_AGENT); }
__device__ __forceinline__ unsigned xb_xcc_id() { return (unsigned)__builtin_amdgcn_s_getreg((3 << 11) | 20) & 0xFu; }
#define XB_SPIN(cond, bar) do { unsigned _sp = 0; while (cond) { __builtin_amdgcn_s_sleep(1); \
    if ((++_sp & 255u) == 0u) { if (xb_ld(&(bar)[XB_TMO])) break; if (_sp > XB_SPIN_CAP) { atomicAdd(&(bar)[XB_TMO], 1u); break; } } } } while (0)
struct XcdBarrier { unsigned* bar; unsigned x; volatile LAS unsigned* st; };
__device__ __forceinline__ XcdBarrier xcd_barrier_post(unsigned* bar, volatile LAS unsigned* st) {
    XcdBarrier b; b.bar = bar; b.x = xb_xcc_id(); b.st = st;
    if (threadIdx.x == 0) (void)xb_add(&bar[XB_XCNT(b.x)], 1u);
    return b;
}
__device__ __forceinline__ void xcd_barrier_complete(unsigned* bar, unsigned x, unsigned& nloc, unsigned& nx) {
    const unsigned G = gridDim.x * gridDim.y * gridDim.z;
    unsigned sum, cnt, mine, sp = 0u;
    for (;;) {
        sum = 0u; cnt = 0u; mine = 0u;
#pragma unroll
        for (unsigned j = 0; j < 16; ++j) { const unsigned c = xb_ld(&bar[XB_XCNT(j)]); sum += c; cnt += (c > 0u) ? 1u : 0u; mine = (j == x) ? c : mine; }
        if (sum == G) break;
        __builtin_amdgcn_s_sleep(1);
        if ((++sp & 255u) == 0u) { if (xb_ld(&bar[XB_TMO])) break; if (sp > XB_SPIN_CAP) { atomicAdd(&bar[XB_TMO], 1u); break; } }
    }
    nloc = mine > 0u ? mine : 1u; nx = cnt > 0u ? cnt : 1u;
}
__device__ __forceinline__ void xcd_barrier(const XcdBarrier& b) {
    asm volatile("s_waitcnt vmcnt(0)" ::: "memory");
    __syncthreads();
    if (threadIdx.x == 0) {
        unsigned* bar = b.bar;
        __builtin_amdgcn_s_waitcnt(0);
        unsigned nloc = b.st[0], nx = b.st[1];
        if (nloc == 0u) { xcd_barrier_complete(bar, b.x, nloc, nx); b.st[0] = nloc; b.st[1] = nx; }
        const unsigned old = xb_add(&bar[XB_XSUB(b.x)], 1u);
        const unsigned gen = old / nloc;
        if (old + 1u == (gen + 1u) * nloc) {
            __builtin_amdgcn_fence(__ATOMIC_RELEASE, "agent");
            asm volatile("s_waitcnt vmcnt(0)" ::: "memory");
            const unsigned og = xb_add(&bar[XB_TOP], 1u);
            const unsigned tg = og / nx;
            if (og + 1u == (tg + 1u) * nx) xb_add(&bar[XB_TOPGEN], 1u);
            else XB_SPIN(xb_ld(&bar[XB_TOPGEN]) == tg, bar);
            __builtin_amdgcn_fence(__ATOMIC_ACQUIRE, "agent");
            xb_add(&bar[XB_XGEN(b.x)], 1u);
            asm volatile("s_waitcnt vmcnt(0)" ::: "memory");
        } else {
            XB_SPIN(xb_ld(&bar[XB_XGEN(b.x)]) == gen, bar);
            __builtin_amdgcn_fence(__ATOMIC_ACQUIRE, "agent");
            asm volatile("s_waitcnt vmcnt(0)" ::: "memory");
        }
    }
    __syncthreads();
}

struct Frame {
    LAS unsigned char* lds;
    gu32* ctl;
    int tid, lane, wave, vcu, G;
    float* out; unsigned char* ws;
};
__device__ __forceinline__ float wave_sum(float v) {
#pragma unroll
    for (int o = 1; o < 64; o <<= 1) v += __shfl_xor(v, o);
    return v;
}

struct InProjOrder {
    int G, c;
    __device__ __forceinline__ bool next(int i, pg8::Unit& u) const {
        const int NL = 128 * 23, NC = 8 * 11;
        const long L = (long)i * G + c; if (L >= NL + NC) return false;
        u.lbase = 0; u.nvalid = 0;
        if (L < NL) { const int wgid = pg8::xcd_remap((int)L, NL); const int nig = 8 * 23, gid = wgid / nig, fm = gid * 8; u.pm = fm + ((wgid % nig) % 8); u.pn = (wgid % nig) / 8; }
        else { const int r = (int)L - NL; u.pm = 128 + r / 11; const int q = r % 11; u.pn = q < 10 ? q : 22; }
        return true;
    }
};
struct MoeOrder {
    int G, c, npn; const LAS int* tab;
    __device__ __forceinline__ bool next(int i, pg8::Unit& u) const {
        const int nT = __builtin_amdgcn_readfirstlane(tab[32]); const int nU = nT * npn;
        const long L = (long)i * G + c; if (L >= nU) return false;
        const int wgid = pg8::xcd_remap((int)L, nU);
        const int tau = wgid / npn, pl = wgid % npn;
        int e = 0;
        for (int k = 1; k < 32; ++k) e += (__builtin_amdgcn_readfirstlane(tab[k]) <= tau) ? 1 : 0;
        const int il = tau - __builtin_amdgcn_readfirstlane(tab[e]);
        u.pm = tau; u.pn = e * npn + pl; u.lbase = e * ML + 256 * il; u.nvalid = __builtin_amdgcn_readfirstlane(tab[33 + e]) - 256 * il;
        return true;
    }
};
__device__ __forceinline__ void moe_tables(Frame& F) {
    LAS int* tab = (LAS int*)(F.lds + TAB_OFF);
    __syncthreads();
    if (F.tid < 32) tab[33 + F.tid] = (int)__hip_atomic_load(F.ctl + CW_CNT + 64 * F.tid, RLX_AGENT);
    __syncthreads();
    if (F.tid == 0) {
        int acc = 0;
        for (int e = 0; e < 32; ++e) { tab[e] = acc; acc += (tab[33 + e] + 255) >> 8; }
        tab[32] = acc;
    }
    __syncthreads();
}

using pg8::f32x4; using pg8::u32x4; using pg8::cvt_pk_bf16;
#define EPI_ROWS(u) const int row0 = (u).pm * 256 + wr * 64 + fr
#define EPI_LOOP _Pragma("unroll") for (int ai = 0; ai < 2; ++ai) _Pragma("unroll") for (int m = 0; m < 4; ++m)
__device__ __forceinline__ u32x4 pack8(const f32x4 a, const f32x4 b) { u32x4 w; w.x = cvt_pk_bf16(a[0], a[1]); w.y = cvt_pk_bf16(a[2], a[3]); w.z = cvt_pk_bf16(b[0], b[1]); w.w = cvt_pk_bf16(b[2], b[3]); return w; }
__device__ __forceinline__ void unpack8(const u32x4 w, f32x4& a, f32x4& b) { a = (f32x4){bflo(w.x), bfhi(w.x), bflo(w.y), bfhi(w.y)}; b = (f32x4){bflo(w.z), bfhi(w.z), bflo(w.w), bfhi(w.w)}; }
__device__ __forceinline__ void unpack8_fp8(const v2u w, f32x4& a, f32x4& b) {
    const auto l0 = __builtin_amdgcn_cvt_pk_f32_fp8((int)w.x, false), h0 = __builtin_amdgcn_cvt_pk_f32_fp8((int)w.x, true), l1 = __builtin_amdgcn_cvt_pk_f32_fp8((int)w.y, false), h1 = __builtin_amdgcn_cvt_pk_f32_fp8((int)w.y, true);
    a = (f32x4){l0[0], l0[1], h0[0], h0[1]}; b = (f32x4){l1[0], l1[1], h1[0], h1[1]}; }
__device__ __forceinline__ v2u pack8_fp8(const f32x4 a, const f32x4 b) { return (v2u){pk4_fp8(a[0], a[1], a[2], a[3]), pk4_fp8(b[0], b[1], b[2], b[3])}; }
__device__ __forceinline__ f32x4 sig4(f32x4 x) { return (f32x4){sigmoidf_(x[0]), sigmoidf_(x[1]), sigmoidf_(x[2]), sigmoidf_(x[3])}; }

struct EpiStore {
    static constexpr bool PERM = true; bf16* O; int ldc; unsigned char* P8;
    __device__ __forceinline__ void operator()(const f32x4 (&acc)[2][2][4][2], const pg8::Unit& u, int wr, int wc, int fr, int fq) const {
        EPI_ROWS(u); const int col0 = u.pn * 256 + wc * 32 + 8 * fq;
        if (u.pn == 22 && wc != 0) return;
        if (u.pn >= 10 && u.pn < 22) {
            EPI_LOOP { unsigned char* rowp = P8 + (size_t)(row0 + ai * 128 + m * 16) * 3072 + (col0 - PC_O);
#pragma unroll
                for (int bj = 0; bj < 2; ++bj) *(v2u*)(rowp + bj * 128) = pack8_fp8(acc[ai][bj][m][0], acc[ai][bj][m][1]); }
            return; }
        EPI_LOOP { bf16* rowp = O + (size_t)(row0 + ai * 128 + m * 16) * ldc + col0;
#pragma unroll
            for (int bj = 0; bj < 2; ++bj) if (u.pn != 22 || bj == 0) *(u32x4*)(rowp + bj * 128) = pack8(acc[ai][bj][m][0], acc[ai][bj][m][1]); }
    }
};
struct EpiGlu {
    static constexpr bool PERM = true; const bf16* A2; bf16* A3; const float* bias;
    __device__ __forceinline__ void operator()(const f32x4 (&acc)[2][2][4][2], const pg8::Unit& u, int wr, int wc, int fr, int fq) const {
        EPI_ROWS(u); const int col0 = u.pn * 256 + wc * 32 + 8 * fq;
        f32x4 bv[2][2];
#pragma unroll
        for (int bj = 0; bj < 2; ++bj)
#pragma unroll
            for (int n = 0; n < 2; ++n) bv[bj][n] = *(const f32x4*)(bias + col0 + bj * 128 + 4 * n);
#pragma unroll
        for (int ai = 0; ai < 2; ++ai) {
            v2u ld[4][2];
#pragma unroll
            for (int m = 0; m < 4; ++m)
#pragma unroll
                for (int bj = 0; bj < 2; ++bj) ld[m][bj] = *(const v2u*)((const unsigned char*)A2 + (size_t)(row0 + ai * 128 + m * 16) * 512 + col0 + bj * 128);
            __builtin_amdgcn_sched_barrier(0);
#pragma unroll
            for (int m = 0; m < 4; ++m)
#pragma unroll
                for (int bj = 0; bj < 2; ++bj) { f32x4 a0, a1; unpack8_fp8(ld[m][bj], a0, a1);
                    const f32x4 v0 = a0 * sig4(acc[ai][bj][m][0] + bv[bj][0]), v1 = a1 * sig4(acc[ai][bj][m][1] + bv[bj][1]);
                    *(v2u*)((unsigned char*)A3 + (size_t)(row0 + ai * 128 + m * 16) * 512 + col0 + bj * 128) = pack8_fp8(v0, v1); }
        }
    }
};
template <bool ADD> struct EpiGate {
    static constexpr bool PERM = true; const unsigned char* proj; int gc0; const float* bg; const bf16* Prev; bf16* O;
    __device__ __forceinline__ void operator()(const f32x4 (&acc)[2][2][4][2], const pg8::Unit& u, int wr, int wc, int fr, int fq) const {
        EPI_ROWS(u); const int col0 = u.pn * 256 + wc * 32 + 8 * fq;
        f32x4 bv[2][2];
#pragma unroll
        for (int bj = 0; bj < 2; ++bj)
#pragma unroll
            for (int n = 0; n < 2; ++n) bv[bj][n] = *(const f32x4*)(bg + col0 + bj * 128 + 4 * n);
        constexpr int MB = ADD ? 2 : 4;
#pragma unroll
        for (int g = 0; g < 8 / MB; ++g) {
            v2u lg[MB][2]; u32x4 lp[MB][2];
#pragma unroll
            for (int mm = 0; mm < MB; ++mm)
#pragma unroll
                for (int bj = 0; bj < 2; ++bj) { const int q = g * MB + mm, row = row0 + (q >> 2) * 128 + (q & 3) * 16; lg[mm][bj] = *(const v2u*)(proj + (size_t)row * 3072 + gc0 + col0 + bj * 128);
                    if (ADD) lp[mm][bj] = *(const u32x4*)(Prev + (size_t)row * 1024 + col0 + bj * 128); }
            __builtin_amdgcn_sched_barrier(0);
#pragma unroll
            for (int mm = 0; mm < MB; ++mm)
#pragma unroll
                for (int bj = 0; bj < 2; ++bj) { const int q = g * MB + mm, ai = q >> 2, m = q & 3; f32x4 g0, g1; unpack8_fp8(lg[mm][bj], g0, g1);
                    f32x4 v0 = sig4(g0 + bv[bj][0]) * acc[ai][bj][m][0], v1 = sig4(g1 + bv[bj][1]) * acc[ai][bj][m][1];
                    if (ADD) { f32x4 p0, p1; unpack8(lp[mm][bj], p0, p1); v0 += p0; v1 += p1; }
                    if (ADD) *(v2u*)((unsigned char*)O + (size_t)(row0 + ai * 128 + m * 16) * 1024 + col0 + bj * 128) = pack8_fp8(v0 * 4.0f, v1 * 4.0f);
                    else *(u32x4*)(O + (size_t)(row0 + ai * 128 + m * 16) * 1024 + col0 + bj * 128) = pack8(v0, v1); }
            __builtin_amdgcn_sched_barrier(0);
        }
    }
};
struct EpiX1 {
    static constexpr bool PERM = true; const float* x; const float* mod; bf16* X1;
    __device__ __forceinline__ void operator()(const f32x4 (&acc)[2][2][4][2], const pg8::Unit& u, int wr, int wc, int fr, int fq) const {
        EPI_ROWS(u); const int col0 = u.pn * 256 + wc * 32 + 8 * fq; const int b = (u.pm * 256) / SEQ;
        f32x4 gv[2][2];
#pragma unroll
        for (int bj = 0; bj < 2; ++bj)
#pragma unroll
            for (int n = 0; n < 2; ++n) gv[bj][n] = *(const f32x4*)(mod + b * 6144 + 2 * D + col0 + bj * 128 + 4 * n);
#pragma unroll
        for (int g = 0; g < 4; ++g) {
            f32x4 lx[2][2][2];
#pragma unroll
            for (int mm = 0; mm < 2; ++mm)
#pragma unroll
                for (int bj = 0; bj < 2; ++bj) { const int q = g * 2 + mm; const size_t off = (size_t)(row0 + (q >> 2) * 128 + (q & 3) * 16) * D + col0 + bj * 128; lx[mm][bj][0] = *(const f32x4*)(x + off); lx[mm][bj][1] = *(const f32x4*)(x + off + 4); }
            __builtin_amdgcn_sched_barrier(0);
#pragma unroll
            for (int mm = 0; mm < 2; ++mm)
#pragma unroll
                for (int bj = 0; bj < 2; ++bj) { const int q = g * 2 + mm, ai = q >> 2, m = q & 3; const size_t off = (size_t)(row0 + ai * 128 + m * 16) * D + col0 + bj * 128;
                    *(u32x4*)(X1 + off) = pack8(lx[mm][bj][0] + gv[bj][0] * acc[ai][bj][m][0], lx[mm][bj][1] + gv[bj][1] * acc[ai][bj][m][1]); }
            __builtin_amdgcn_sched_barrier(0);
        }
    }
};
struct EpiSwiglu {
    static constexpr bool PERM = true; const float* bin; bf16* ACT;
    __device__ __forceinline__ void operator()(const f32x4 (&acc)[2][2][4][2], const pg8::Unit& u, int wr, int wc, int fr, int fq) const {
        EPI_ROWS(u); const int e = u.pn >> 3, pl = u.pn & 7; const int f0 = pl * 128 + wc * 32 + 8 * fq;
        f32x4 bg[2], bl[2];
#pragma unroll
        for (int n = 0; n < 2; ++n) { bg[n] = *(const f32x4*)(bin + e * 2048 + f0 + 4 * n); bl[n] = *(const f32x4*)(bin + e * 2048 + 1024 + f0 + 4 * n); }
        EPI_LOOP { f32x4 o[2];
#pragma unroll
            for (int n = 0; n < 2; ++n) { const f32x4 zg = acc[ai][0][m][n] + bg[n], zl = acc[ai][1][m][n] + bl[n];
#pragma unroll
                for (int j = 0; j < 4; ++j) { const float gl = fminf(zg[j], 7.0f); const float li8 = __builtin_fmaf(__builtin_amdgcn_fmed3f(zl[j], -7.0f, 7.0f), 8.0f, 8.0f);
                    o[n][j] = gl * frcp(1.0f + __builtin_amdgcn_exp2f(gl * -2.45546696f)) * li8; } }
            unsigned w0 = 0, w1 = 0;
            w0 = __builtin_amdgcn_cvt_pk_fp8_f32(o[0][0], o[0][1], w0, false); w0 = __builtin_amdgcn_cvt_pk_fp8_f32(o[0][2], o[0][3], w0, true);
            w1 = __builtin_amdgcn_cvt_pk_fp8_f32(o[1][0], o[1][1], w1, false); w1 = __builtin_amdgcn_cvt_pk_fp8_f32(o[1][2], o[1][3], w1, true);
            *(v2u*)((unsigned char*)ACT + (size_t)(row0 + ai * 128 + m * 16) * 1024 + f0) = (v2u){w0, w1}; }
    }
};
struct EpiY {
    static constexpr bool PERM = true; const float* bout; bf16* Y;
    __device__ __forceinline__ void operator()(const f32x4 (&acc)[2][2][4][2], const pg8::Unit& u, int wr, int wc, int fr, int fq) const {
        EPI_ROWS(u); const int e = u.pn >> 2, pl = u.pn & 3; const int col0 = pl * 256 + wc * 32 + 8 * fq;
        f32x4 bv[2][2];
#pragma unroll
        for (int bj = 0; bj < 2; ++bj)
#pragma unroll
            for (int n = 0; n < 2; ++n) bv[bj][n] = *(const f32x4*)(bout + e * 1024 + col0 + bj * 128 + 4 * n);
        EPI_LOOP { unsigned char* rowp = (unsigned char*)Y + (size_t)(row0 + ai * 128 + m * 16) * 1024 + col0;
#pragma unroll
            for (int bj = 0; bj < 2; ++bj) { const f32x4 v0 = (acc[ai][bj][m][0] + bv[bj][0]) * 16.0f, v1 = (acc[ai][bj][m][1] + bv[bj][1]) * 16.0f;
                *(v2u*)(rowp + bj * 128) = (v2u){pk4_fp8(v0[0], v0[1], v0[2], v0[3]), pk4_fp8(v1[0], v1[1], v1[2], v1[3])}; } }
    }
};

struct TItem { const float* src; bf16* dst; int ld, ldk; int f8; };
__device__ __forceinline__ void titem_load(const TItem& t, int lane, f32x4 (&r)[8]) {
#pragma unroll
    for (int i = 0; i < 8; ++i) r[i] = *(const f32x4*)(t.src + (size_t)(8 * i + (lane >> 3)) * t.ld + 4 * (lane & 7));
}
__device__ __forceinline__ void titem_store(const TItem& t, int lane, const f32x4 (&r)[8], LAS float* scr) {
#pragma unroll
    for (int i = 0; i < 8; ++i) { LAS float* p = scr + (8 * i + (lane >> 3)) * 33 + 4 * (lane & 7); p[0] = r[i][0]; p[1] = r[i][1]; p[2] = r[i][2]; p[3] = r[i][3]; }
    LDS_WAIT(); asm volatile("" ::: "memory");
    const int c = lane & 7;
#pragma unroll
    for (int j = 0; j < 4; ++j) { const int n = (lane >> 3) + 8 * j; const LAS float* s = scr + (8 * c) * 33 + n;
        if (t.f8) { *(GAS v2u*)((unsigned char*)t.dst + (size_t)n * t.ldk + 8 * c) = (v2u){pk4_fp8(32.f * s[0 * 33], 32.f * s[1 * 33], 32.f * s[2 * 33], 32.f * s[3 * 33]), pk4_fp8(32.f * s[4 * 33], 32.f * s[5 * 33], 32.f * s[6 * 33], 32.f * s[7 * 33])}; }
        else { v4u o; o.x = pk2(s[0 * 33], s[1 * 33]); o.y = pk2(s[2 * 33], s[3 * 33]); o.z = pk2(s[4 * 33], s[5 * 33]); o.w = pk2(s[6 * 33], s[7 * 33]);
            *(GAS v4u*)(t.dst + (size_t)n * t.ldk + 8 * c) = o; } }
    LDS_WAIT(); asm volatile("" ::: "memory");
}
__device__ __forceinline__ void p0_prologue(Frame& F, const float* const* __restrict__ INP) {
    {
        LAS float* sc = (LAS float*)(F.lds);
        LAS float* red = (LAS float*)(F.lds + 9 * 1024 * 4);
        for (int i = F.tid; i < 9 * 1024; i += NWAVES * 64) { const int r = i >> 10, k = i & 1023; const float v = r < 8 ? INP[1][r * 1024 + k] : INP[3][k]; sc[i] = v / (1.0f + expf(-v)); }
        __syncthreads();
        const float* wada = INP[4]; const float* bada = INP[5];
        float* mod = (float*)(F.ws + WS_MOD);
        for (int cg = blockIdx.x; cg < 256; cg += F.G) {
            const int j0 = cg * 24, col = F.lane & 31, kp = F.lane >> 5;
            float a[9];
#pragma unroll
            for (int r = 0; r < 9; ++r) a[r] = 0.f;
            if (col < 24) {
#pragma unroll 16
                for (int i = 0; i < 64; ++i) { const int k = F.wave * 128 + 2 * i + kp; const float wv = wada[(size_t)k * 6144 + j0 + col];
#pragma unroll
                    for (int r = 0; r < 9; ++r) a[r] += sc[r * 1024 + k] * wv; }
            }
#pragma unroll
            for (int r = 0; r < 9; ++r) red[((F.wave * 2 + kp) * 9 + r) * 32 + col] = a[r];
            __syncthreads();
            if (F.tid < 9 * 32) { const int r = F.tid >> 5, cc = F.tid & 31;
                if (cc < 24) { float s = 0.f; for (int p = 0; p < 16; ++p) s += red[(p * 9 + r) * 32 + cc]; const int j = j0 + cc; s += bada[j];
                    if (r < 8) mod[r * 6144 + j] = s; else if (j < 2048) mod[8 * 6144 + j] = s; } }
            __syncthreads();
        }
    }
    LAS float* scr = (LAS float*)(F.lds + F.wave * 16384);
    const int gw = F.vcu * NWAVES + F.wave, NGW = F.G * NWAVES;
    bf16* WIN = (bf16*)(F.ws + WS_WIN); bf16* WGLU = (bf16*)(F.ws + WS_WGLU); bf16* WA = (bf16*)(F.ws + WS_WA); bf16* WB = (bf16*)(F.ws + WS_WB); bf16* WO = (bf16*)(F.ws + WS_WO);
    bf16* WEIN = (bf16*)(F.ws + WS_WEIN); bf16* WEOUT = (bf16*)(F.ws + WS_WEOUT);
    constexpr int I_IN = 177 * 16, I_GLU = 16 * 8, I_A = 32 * 16, I_B = 32 * 8, I_O = 32 * 16, I_EIN = 32 * 64 * 16, I_EOUT = 32 * 32 * 16;
    constexpr int NITEMS = I_IN + I_GLU + I_A + I_B + I_O + I_EIN + I_EOUT;
#define P0_DECODE(it_, T) do { int r = (it_); \
        if (r < I_IN) { const int kb = r / 177, nb = r % 177, n0 = nb * 32; const int sc0 = n0 < 2048 ? n0 : (n0 < 5632 ? n0 + 32 : 2048); \
            T.src = INP[8] + (size_t)kb * 64 * 5664 + sc0; T.ld = 5664; T.dst = (bf16*)((unsigned char*)WIN + (size_t)n0 * 1024 + kb * 64); T.ldk = 1024; T.f8 = 1; break; } r -= I_IN; \
        if (r < I_GLU) { const int kb = r / 16, nb = r % 16; T.src = INP[21] + (size_t)kb * 64 * 512 + nb * 32; T.ld = 512; T.dst = (bf16*)((unsigned char*)WGLU + (size_t)nb * 32 * 512 + kb * 64); T.ldk = 512; T.f8 = 1; break; } r -= I_GLU; \
        if (r < I_A) { const int kb = r / 32, nb = r % 32; T.src = INP[12] + (size_t)kb * 64 * 1024 + nb * 32; T.ld = 1024; T.dst = (bf16*)((unsigned char*)WA + (size_t)nb * 32 * 1024 + kb * 64); T.ldk = 1024; T.f8 = 1; break; } r -= I_A; \
        if (r < I_B) { const int kb = r / 32, nb = r % 32; T.src = INP[23] + (size_t)kb * 64 * 1024 + nb * 32; T.ld = 1024; T.dst = (bf16*)((unsigned char*)WB + (size_t)nb * 32 * 512 + kb * 64); T.ldk = 512; T.f8 = 1; break; } r -= I_B; \
        if (r < I_O) { const int kb = r / 32, nb = r % 32; T.src = INP[25] + (size_t)kb * 64 * 1024 + nb * 32; T.ld = 1024; T.dst = (bf16*)((unsigned char*)WO + (size_t)nb * 32 * 1024 + kb * 64); T.ldk = 1024; T.f8 = 1; break; } r -= I_O; \
        if (r < I_EIN) { const int e = r / 1024, q = r % 1024, kb = q / 64, nb = q % 64; const int dr = nb * 32, pn = dr >> 8, bj = (dr >> 7) & 1, xx = dr & 127; \
            T.src = INP[28] + (size_t)e * 1024 * 2048 + (size_t)kb * 64 * 2048 + bj * 1024 + pn * 128 + xx; T.ld = 2048; T.dst = (bf16*)((unsigned char*)WEIN + (size_t)e * 2048 * 1024 + (size_t)dr * 1024 + kb * 64); T.ldk = 1024; T.f8 = 1; break; } r -= I_EIN; \
        { const int e = r / 512, q = r % 512, kb = q / 32, nb = q % 32; \
            T.src = INP[30] + (size_t)e * 1024 * 1024 + (size_t)kb * 64 * 1024 + nb * 32; T.ld = 1024; T.dst = (bf16*)((unsigned char*)WEOUT + (size_t)e * 1024 * 1024 + (size_t)nb * 32 * 1024 + kb * 64); T.ldk = 1024; T.f8 = 1; } } while (0)
    {
        TItem ta, tb; f32x4 ra[8], rb[8];
        int it = gw;
        if (it < NITEMS - I_EIN - I_EOUT) { P0_DECODE(it, ta); titem_load(ta, F.lane, ra); }
        constexpr int NITEMS0 = NITEMS - I_EIN - I_EOUT;
        while (it < NITEMS0) {
            const int nx = it + NGW;
            if (nx < NITEMS0) { P0_DECODE(nx, tb); titem_load(tb, F.lane, rb); }
            titem_store(ta, F.lane, ra, scr);
            ta = tb;
#pragma unroll
            for (int i = 0; i < 8; ++i) ra[i] = rb[i];
            it = nx;
        }
    }
#undef P0_DECODE
    { const int gt = blockIdx.x * (NWAVES * 64) + F.tid, NT = F.G * NWAVES * 64; GAS v4u* z = (GAS v4u*)((unsigned char*)WIN + (size_t)5664 * 1024);
        for (int i = gt; i < 224 * 1024 / 16; i += NT) z[i] = (v4u){0u, 0u, 0u, 0u}; }
}

__device__ __forceinline__ void p1_norm1(Frame& F, const float* const* __restrict__ INP) {
    const int gw = F.vcu * NWAVES + F.wave, NGW = F.G * NWAVES;
    const float* mod = (const float*)(F.ws + WS_MOD); bf16* H1 = (bf16*)(F.ws + WS_H1);
    for (int m = gw; m < MT; m += NGW) {
        const float* xr; const float* sh; const float* scl;
        if (m < ML) { const int b = m / SEQ; xr = INP[0] + (size_t)m * D; sh = mod + b * 6144; scl = sh + D; }
        else { xr = INP[2] + (size_t)(m - ML) * D; sh = mod + 8 * 6144; scl = sh + D; }
        f32x4 v[4]; float s = 0.f;
#pragma unroll
        for (int j = 0; j < 4; ++j) { v[j] = *(const f32x4*)(xr + 256 * j + 4 * F.lane); s += (v[j][0] * v[j][0] + v[j][1] * v[j][1]) + (v[j][2] * v[j][2] + v[j][3] * v[j][3]); }
        const float rstd = 1.0f / sqrtf(wave_sum(s) * (1.0f / D) + EPS);
#pragma unroll
        for (int j = 0; j < 4; ++j) { const int c = 256 * j + 4 * F.lane; const f32x4 g = *(const f32x4*)(INP[6] + c), a = *(const f32x4*)(scl + c), bb = *(const f32x4*)(sh + c);
            const f32x4 y = v[j] * rstd * g * (a + 1.0f) + bb;
            *(unsigned*)((unsigned char*)H1 + (size_t)m * D + c) = pk4_fp8(y[0], y[1], y[2], y[3]); }
    }
}

__device__ __forceinline__ void conv_fma8(float (&a)[8], const v4u x, const float* wp) {
    const f32x4 w0 = *(const f32x4*)(wp), w1 = *(const f32x4*)(wp + 4);
    a[0] += bflo(x.x) * w0[0]; a[1] += bfhi(x.x) * w0[1]; a[2] += bflo(x.y) * w0[2]; a[3] += bfhi(x.y) * w0[3];
    a[4] += bflo(x.z) * w1[0]; a[5] += bfhi(x.z) * w1[1]; a[6] += bflo(x.w) * w1[2]; a[7] += bfhi(x.w) * w1[3];
}
__device__ __forceinline__ void p3_conv(Frame& F, const float* const* __restrict__ INP) {
    const bf16* PROJ = (const bf16*)(F.ws + WS_PROJ); bf16* QKC = (bf16*)(F.ws + WS_QKC); const float* wc = INP[9];
    const int NT = F.G * NWAVES * 64;
    for (int it = F.vcu * (NWAVES * 64) + F.tid; it < NB * 64 * 16 * 128; it += NT) {
        const int ch0 = (it & 127) * 8, seg = (it >> 7) & 15, gr = (it >> 11) & 63, b = it >> 17, c0 = seg * 4;
        const bf16* base = PROJ + (size_t)(b * SEQ) * LDP + ch0;
        const float scale = ch0 < 512 ? 0.125f : 1.0f;
        v4u win[6][3];
        const v4u z = (v4u){0u, 0u, 0u, 0u};
#pragma unroll
        for (int cc = 0; cc < 6; ++cc)
#pragma unroll
            for (int ky = 0; ky < 3; ++ky) { const int rr = gr + ky - 1, c = c0 + cc - 1;
                win[cc][ky] = (rr >= 0 && rr < 64 && c >= 0 && c < 64) ? *(const v4u*)(base + (size_t)(rr * 64 + c) * LDP) : z; }
        __builtin_amdgcn_sched_barrier(0);
        float a[4][8];
#pragma unroll
        for (int cc = 0; cc < 4; ++cc)
#pragma unroll
            for (int j = 0; j < 8; ++j) a[cc][j] = 0.f;
#pragma unroll
        for (int ky = 0; ky < 3; ++ky)
#pragma unroll
            for (int kx = 0; kx < 3; ++kx) {
                const f32x4 w0 = *(const f32x4*)(wc + (ky * 3 + kx) * 1024 + ch0), w1 = *(const f32x4*)(wc + (ky * 3 + kx) * 1024 + ch0 + 4);
#pragma unroll
                for (int cc = 0; cc < 4; ++cc) { const v4u x = win[cc + kx][ky];
                    a[cc][0] += bflo(x.x) * w0[0]; a[cc][1] += bfhi(x.x) * w0[1]; a[cc][2] += bflo(x.y) * w0[2]; a[cc][3] += bfhi(x.y) * w0[3];
                    a[cc][4] += bflo(x.z) * w1[0]; a[cc][5] += bfhi(x.z) * w1[1]; a[cc][6] += bflo(x.w) * w1[2]; a[cc][7] += bfhi(x.w) * w1[3]; }
                asm volatile("" ::: "memory");
            }
#pragma unroll
        for (int cc = 0; cc < 4; ++cc) {
#pragma unroll
            for (int j = 0; j < 8; ++j) a[cc][j] = a[cc][j] * frcp(1.0f + __expf(-a[cc][j])) * scale;
            *(v4u*)(QKC + (size_t)(b * SEQ + gr * 64 + c0 + cc) * 1024 + ch0) = (v4u){pk2(a[cc][0], a[cc][1]), pk2(a[cc][2], a[cc][3]), pk2(a[cc][4], a[cc][5]), pk2(a[cc][6], a[cc][7])};
        }
    }
    for (int w = F.vcu * (NWAVES * 64) + F.tid; w < MC * 128; w += NT) {
        const int row = ML + (w >> 7), ch0 = (w & 127) * 8, t = (w >> 7) % CTXL;
        float a[8];
#pragma unroll
        for (int j = 0; j < 8; ++j) a[j] = 0.f;
#pragma unroll
        for (int kx = 0; kx < 3; ++kx) { const int tt = t + kx - 1;
            if (tt >= 0 && tt < CTXL) conv_fma8(a, *(const v4u*)(PROJ + (size_t)(row + kx - 1) * LDP + ch0), wc + (3 + kx) * 1024 + ch0); }
        const float scale = ch0 < 512 ? 0.125f : 1.0f;
#pragma unroll
        for (int j = 0; j < 8; ++j) a[j] = a[j] * frcp(1.0f + __expf(-a[j])) * scale;
        *(v4u*)(QKC + (size_t)row * 1024 + ch0) = (v4u){pk2(a[0], a[1]), pk2(a[2], a[3]), pk2(a[4], a[5]), pk2(a[6], a[7])};
    }
    {
        float* GB = (float*)(F.ws + WS_GS); float* GG = GB + 128 * 4352; float* GP = GG + 128 * 4352;
        const int gw = F.vcu * NWAVES + F.wave, NGW = F.G * NWAVES, lane = F.lane;
        for (int it = gw; it < 128 * 34; it += NGW) {
            const int jc = it % 34, dbh = it / 34, h = dbh & 7, b = (dbh >> 3) & 7, d = dbh >> 6;
            const bool lat = jc >= 2; const int p0 = lat ? 128 * (jc - 2) : 128 * jc, Lseq = lat ? SEQ : CTXL, rowbase = lat ? b * SEQ : ML + b * CTXL;
            const float bi_ = INP[10][d * 16 + h], bf_ = INP[10][d * 16 + 8 + h];
            float li2[2], lf2[2];
#pragma unroll
            for (int e = 0; e < 2; ++e) { const int sp = 2 * lane + e; const int tt = d ? (Lseq - 1 - (p0 + sp)) : (p0 + sp); const size_t row = (size_t)(rowbase + tt);
                li2[e] = bf2f(PROJ[row * LDP + PC_IF + d * 16 + h]) + bi_; const float xf = bf2f(PROJ[row * LDP + PC_IF + d * 16 + 8 + h]) + bf_;
                lf2[e] = fminf(xf, 0.f) - log1pf(expf(-fabsf(xf))); }
            const float c1 = lf2[0] + lf2[1]; float inc = c1;
#pragma unroll
            for (int o = 1; o < 64; o <<= 1) { const float t = __shfl_up(inc, o); if (lane >= o) inc += t; }
            const float exc = inc - c1, b0 = exc + lf2[0], b1 = exc + c1, g0 = li2[0] - b0, g1 = li2[1] - b1;
            float pmx = fmaxf(g0, g1);
#pragma unroll
            for (int o = 1; o < 64; o <<= 1) { const float t = __shfl_up(pmx, o); if (lane >= o) pmx = fmaxf(pmx, t); }
            float pex = __shfl_up(pmx, 1); if (lane == 0) pex = -INFINITY;
            const size_t o = (size_t)dbh * 4352 + 128 * jc + 2 * lane;
            *(float2*)(GB + o) = make_float2(b0, b1); *(float2*)(GG + o) = make_float2(g0, g1); *(float2*)(GP + o) = make_float2(fmaxf(pex, g0), pmx);
        }
    }
}

__device__ __forceinline__ void mma32_nt(f32x16& acc, const LAS bf16* A, int lda, const LAS bf16* Bt, int ldb, int K, int lane) {
    const int r = lane & 31, h = lane >> 5;
#pragma unroll
    for (int k0 = 0; k0 < K; k0 += 16) {
        const bf16x8 a = *(const LAS bf16x8*)(A + r * lda + k0 + 8 * h);
        const bf16x8 b = *(const LAS bf16x8*)(Bt + r * ldb + k0 + 8 * h);
        acc = __builtin_amdgcn_mfma_f32_32x32x16_bf16(a, b, acc, 0, 0, 0);
        if ((k0 & 63) == 48) __builtin_amdgcn_sched_barrier(0);
    }
}
__device__ __forceinline__ void mma16_nt(f32x4& acc, const LAS bf16* A, int lda, const LAS bf16* Bt, int ldb, int K, int lane) {
    const int r = lane & 15, q = lane >> 4;
    for (int k0 = 0; k0 < K; k0 += 32) {
        const bf16x8 a = *(const LAS bf16x8*)(A + r * lda + k0 + 8 * q);
        const bf16x8 b = *(const LAS bf16x8*)(Bt + r * ldb + k0 + 8 * q);
        acc = __builtin_amdgcn_mfma_f32_16x16x32_bf16(a, b, acc, 0, 0, 0);
    }
}
__device__ __forceinline__ int row32(int reg, int lane) { return (reg & 3) + 8 * (reg >> 2) + 4 * (lane >> 5); }
__device__ __forceinline__ float logsigmoidf_(float x) { return fminf(x, 0.f) - log1pf(expf(-fabsf(x))); }

typedef short s16x4 __attribute__((ext_vector_type(4)));
__device__ __forceinline__ s16x4 tr_read(const LAS bf16* p) { return __builtin_amdgcn_ds_read_tr16_b64_v4i16((LAS s16x4*)p); }
__device__ __forceinline__ bf16x8 tr_frag32_perm(const LAS bf16* T, int ld, int k0, int x0, int lane) {
    const int h = lane >> 5, i = lane & 15, q = i >> 2, p = i & 3, xb = 16 * ((lane >> 4) & 1);
    const LAS bf16* a = T + (k0 + 4 * h + q) * ld + x0 + xb + 4 * p;
    const s16x4 lo = tr_read(a), hi = tr_read(a + 8 * ld);
    return (bf16x8){lo[0], lo[1], lo[2], lo[3], hi[0], hi[1], hi[2], hi[3]};
}
__device__ __forceinline__ bf16x8 tr_frag16(const LAS bf16* T, int ld, int k0, int x0, int lane) {
    const int q4 = lane >> 4, i = lane & 15, q = i >> 2, p = i & 3;
    const LAS bf16* a = T + (k0 + 8 * q4 + q) * ld + x0 + 4 * p;
    const s16x4 lo = tr_read(a), hi = tr_read(a + 4 * ld);
    return (bf16x8){lo[0], lo[1], lo[2], lo[3], hi[0], hi[1], hi[2], hi[3]};
}
__device__ __forceinline__ v4u scale8(const v4u k8, float ww) {
    return (v4u){pk2(ww * bflo(k8.x), ww * bfhi(k8.x)), pk2(ww * bflo(k8.y), ww * bfhi(k8.y)), pk2(ww * bflo(k8.z), ww * bfhi(k8.z)), pk2(ww * bflo(k8.w), ww * bfhi(k8.w))};
}

constexpr int XI_EIN = 32 * 64 * 16, XI_EOUT = 32 * 32 * 16, XI_PER_UNIT = (XI_EIN + XI_EOUT) / 256;
__device__ __forceinline__ void xitem_decode(const float* const* __restrict__ INP, unsigned char* ws, int r, const float*& src, int& ld, unsigned char*& dst) {
    if (r < XI_EIN) { const int e = r / 1024, q = r % 1024, kb = q / 64, nb = q % 64; const int dr = nb * 32, pn = dr >> 8, bj = (dr >> 7) & 1, xx = dr & 127;
        src = INP[28] + (size_t)e * 1024 * 2048 + (size_t)kb * 64 * 2048 + bj * 1024 + pn * 128 + xx; ld = 2048; dst = ws + WS_WEIN + (size_t)e * 2048 * 1024 + (size_t)dr * 1024 + kb * 64; }
    else { r -= XI_EIN; const int e = r / 512, q = r % 512, kb = q / 32, nb = q % 32;
        src = INP[30] + (size_t)e * 1024 * 1024 + (size_t)kb * 64 * 1024 + nb * 32; ld = 1024; dst = ws + WS_WEOUT + (size_t)e * 1024 * 1024 + (size_t)nb * 32 * 1024 + kb * 64; }
}
template <int MODE>
__device__ __forceinline__ void p4_mlstm(Frame& F, const float* const* __restrict__ INP, int unit) {
    const int vh = unit & 1, h = (unit >> 1) & 7, b = (unit >> 4) & 7, d = unit >> 7;
    LAS bf16* Qs = (LAS bf16*)(F.lds + 0);
    LAS bf16* Ks = (LAS bf16*)(F.lds + 18432);
    LAS bf16* Kw = (LAS bf16*)(F.lds + 36864);
    LAS bf16* Vs = (LAS bf16*)(F.lds + 55296);
    LAS bf16* Cb = (LAS bf16*)(F.lds + 73728);
    LAS float* vec = (LAS float*)(F.lds + 82944);
    LAS float *rowt = vec, *colt = vec + 128, *iev = vec + 256, *emt = vec + 384, *nv = vec + 512, *npart = vec + 576;
    const bf16* PROJ = (const bf16*)(F.ws + WS_PROJ); const bf16* QKC = (const bf16*)(F.ws + WS_QKC); unsigned char* HDIR = F.ws + WS_HDIR + (size_t)((((d * 8 + b) * 8 + h) * 2 + vh)) * SEQ * 64;
    const float* GB = (const float*)(F.ws + WS_GS) + (size_t)((d * 8 + b) * 8 + h) * 4352; const float* GG = GB + 128 * 4352; const float* GP = GG + 128 * 4352;
    int tid = F.tid; asm volatile("" : "+v"(tid));
    const int lane = tid & 63, w = F.wave;
    for (int i = tid; i < 64 * 72; i += 512) Cb[i] = 0;
    if (tid < 64) nv[tid] = 0.f;
    f32x4 accC[2] = {(f32x4){0.f, 0.f, 0.f, 0.f}, (f32x4){0.f, 0.f, 0.f, 0.f}};
    float m_old = 0.f, dec_prev = 0.f;
    v4u pq[2], pk[2], pv[2]; float pgb = 0.f, pgp = 0.f, pgc = 0.f, pgg[2], pbend, pgmax; bool hpend = false; int hp0 = 0, hrb = 0, hL = 0;
    LAS bf16* Hst = (LAS bf16*)(F.lds + 140544);
    f32x4 xr[8]; v2u xo[4]; unsigned char* xdst = nullptr; unsigned char* xodst = nullptr; bool xload = false, xout = false;
    const int xw = w - 2;
    LAS float* xscr = (LAS float*)(F.lds + (xw < 5 ? 87296 + (xw < 0 ? 0 : xw) * 8448 : 132096));
    const int zl = tid >> 9;
#define ML_PREFETCH(jn) do { const bool lat_ = (jn) >= 2; const int p0_ = lat_ ? 128 * ((jn) - 2) : 128 * (jn), L_ = lat_ ? SEQ : CTXL, rb_ = lat_ ? b * SEQ : ML + b * CTXL; \
        _Pragma("unroll") for (int i = 0; i < 2; ++i) { const int id = tid + 512 * i, s_ = id >> 3, c_ = id & 7; const int tt = d ? (L_ - 1 - (p0_ + s_)) : (p0_ + s_); const size_t row = (size_t)(rb_ + tt); \
            pq[i] = *(const v4u*)(QKC + row * 1024 + h * 64 + c_ * 8); pk[i] = *(const v4u*)(QKC + row * 1024 + 512 + h * 64 + c_ * 8); pv[i] = *(const v4u*)(PROJ + row * LDP + PC_V + h * 128 + vh * 64 + c_ * 8); \
            pgg[i] = GG[128 * (jn) + s_]; } \
        if (tid < 128) { pgb = GB[128 * (jn) + tid]; pgp = GP[128 * (jn) + tid]; pgc = GG[128 * (jn) + tid]; } \
        pbend = GB[128 * (jn) + 127 + zl]; pgmax = GP[128 * (jn) + 127 + zl]; } while (0)
    ML_PREFETCH(0);
    __syncthreads();
    for (int j = 0; j < 34; ++j) {
        const bool lat = j >= 2;
        const int p0 = lat ? 128 * (j - 2) : 128 * j, Lseq = lat ? SEQ : CTXL, rowbase = lat ? b * SEQ : ML + b * CTXL;
        const float bend = pbend, gmax = pgmax;
        const float mnew = fmaxf(bend + m_old, bend + gmax), dec = __expf(bend + m_old - mnew);
#pragma unroll
        for (int i = 0; i < 2; ++i) { const int id = tid + 512 * i, s = id >> 3, c = id & 7;
            *(LAS v4u*)(Qs + s * 72 + c * 8) = pq[i]; *(LAS v4u*)(Ks + s * 72 + c * 8) = pk[i]; *(LAS v4u*)(Vs + s * 72 + c * 8) = pv[i];
            *(LAS v4u*)(Kw + s * 72 + c * 8) = scale8(pk[i], __expf(bend + pgg[i] - mnew)); }
        if (tid < 128) { colt[tid] = __expf(pgc - gmax); emt[tid] = __expf(-pgb - gmax); }
        const float s0 = __expf(m_old - gmax);
        if (hpend) {
            { const int r = tid >> 2, c = tid & 3; const int tt = d ? (hL - 1 - (hp0 + r)) : (hp0 + r);
                f32x4 a0, a1, b0, b1; unpack8(*(const LAS v4u*)(Hst + r * 72 + 16 * c), a0, a1); unpack8(*(const LAS v4u*)(Hst + r * 72 + 16 * c + 8), b0, b1);
                *(v4u*)(HDIR + (size_t)tt * 64 + 16 * c) = (v4u){pk4_fp8(8.f * a0[0], 8.f * a0[1], 8.f * a0[2], 8.f * a0[3]), pk4_fp8(8.f * a1[0], 8.f * a1[1], 8.f * a1[2], 8.f * a1[3]), pk4_fp8(8.f * b0[0], 8.f * b0[1], 8.f * b0[2], 8.f * b0[3]), pk4_fp8(8.f * b1[0], 8.f * b1[1], 8.f * b1[2], 8.f * b1[3])}; }
            hpend = false; }
        if (j > 0) {
            const int vi = w >> 1;
#pragma unroll
            for (int jj = 0; jj < 2; ++jj) { const int ki = 2 * (w & 1) + jj;
#pragma unroll
                for (int reg = 0; reg < 4; ++reg) Cb[(16 * vi + (lane >> 4) * 4 + reg) * 72 + 16 * ki + (lane & 15)] = (bf16)f2bf(accC[jj][reg]); }
            if (tid < 64) { float sacc = 0.f;
#pragma unroll
                for (int p = 0; p < 8; ++p) sacc += npart[p * 64 + tid];
                nv[tid] = dec_prev * nv[tid] + sacc; }
        }
        LBAR();
        if (j + 1 < 34 && !(MODE & 4)) ML_PREFETCH(j + 1);
        if (MODE == 0 && xw >= 0) {
            if (xout) {
#pragma unroll
                for (int q = 0; q < 4; ++q) *(GAS v2u*)(xodst + (size_t)(8 * q) * 1024) = xo[q];
                xout = false; }
            const int sl = j * 6 + xw;
            if (sl < XI_PER_UNIT) { const float* xsrc; int xld; xitem_decode(INP, F.ws, unit * XI_PER_UNIT + sl, xsrc, xld, xdst);
#pragma unroll
                for (int i = 0; i < 8; ++i) xr[i] = *(const f32x4*)(xsrc + (size_t)(8 * i + (lane >> 3)) * xld + 4 * (lane & 7));
                xload = true; }
        }
        if (lat && !(MODE & 1)) { const int tm = ((w >> 1) == 0 ? 3 : (w >> 1) == 1 ? 2 : (w >> 1) == 2 ? 0 : 1), vt = w & 1, tl = lane & 31, t = 32 * tm + tl, hh = lane >> 5; f32x16 acc;
#pragma unroll
            for (int reg = 0; reg < 16; ++reg) acc[reg] = 0.f;
            mma32_nt(acc, Cb + 32 * vt * 72, 72, Qs + 32 * tm * 72, 72, 64, lane);
#pragma unroll
            for (int reg = 0; reg < 16; ++reg) acc[reg] *= s0;
            float rs = 0.f;
            for (int st = (MODE & 8) ? tm : 0; st <= tm; ++st) {
                f32x16 X;
#pragma unroll
                for (int reg = 0; reg < 16; ++reg) X[reg] = 0.f;
                mma32_nt(X, Ks + 32 * st * 72, 72, Qs + 32 * tm * 72, 72, 64, lane);
                const LAS float* cp = colt + 32 * st + 4 * hh;
                if (st == tm) { const int dlim = tl - 4 * hh;
#pragma unroll
                    for (int rg = 0; rg < 4; ++rg) { const f32x4 c4 = *(const LAS f32x4*)(cp + 8 * rg);
#pragma unroll
                        for (int e = 0; e < 4; ++e) { const float pvv = (8 * rg + e <= dlim) ? X[4 * rg + e] * c4[e] : 0.f; X[4 * rg + e] = pvv; rs += pvv; } }
                } else {
#pragma unroll
                    for (int rg = 0; rg < 4; ++rg) { const f32x4 c4 = *(const LAS f32x4*)(cp + 8 * rg);
#pragma unroll
                        for (int e = 0; e < 4; ++e) { const float pvv = X[4 * rg + e] * c4[e]; X[4 * rg + e] = pvv; rs += pvv; } }
                }
#pragma unroll
                for (int ks = 0; ks < 2; ++ks) {
                    const v4u bw = (v4u){cvtpk(X[8 * ks], X[8 * ks + 1]), cvtpk(X[8 * ks + 2], X[8 * ks + 3]), cvtpk(X[8 * ks + 4], X[8 * ks + 5]), cvtpk(X[8 * ks + 6], X[8 * ks + 7])};
                    const bf16x8 af = tr_frag32_perm(Vs, 72, 32 * st + 16 * ks, 32 * vt, lane);
                    acc = __builtin_amdgcn_mfma_f32_32x32x16_bf16(af, __builtin_bit_cast(bf16x8, bw), acc, 0, 0, 0); }
            }
            float nq = 0.f;
#pragma unroll
            for (int q = 0; q < 4; ++q) { const v4u q8 = *(const LAS v4u*)(Qs + t * 72 + 32 * hh + 8 * q); const LAS float* nn = nv + 32 * hh + 8 * q;
                nq += bflo(q8.x) * nn[0] + bfhi(q8.x) * nn[1] + bflo(q8.y) * nn[2] + bfhi(q8.y) * nn[3] + bflo(q8.z) * nn[4] + bfhi(q8.z) * nn[5] + bflo(q8.w) * nn[6] + bfhi(q8.w) * nn[7]; }
            rs += __shfl_xor(rs, 32); nq += __shfl_xor(nq, 32);
            const float rd = 1.0f / fmaxf(fabsf(s0 * nq + rs), emt[t]);
            LAS bf16* hs = Hst + t * 72 + 32 * vt + 4 * hh;
#pragma unroll
            for (int rg = 0; rg < 4; ++rg) *(LAS v2u*)(hs + 8 * rg) = (v2u){pk2(acc[4 * rg] * rd, acc[4 * rg + 1] * rd), pk2(acc[4 * rg + 2] * rd, acc[4 * rg + 3] * rd)}; }
        if (lat && !(MODE & 1)) { hpend = true; hp0 = p0; hrb = rowbase; hL = Lseq; }
        if (!(MODE & 2)) { const int vi = w >> 1;
            accC[0] *= dec; accC[1] *= dec;
#pragma unroll
            for (int st4 = 0; st4 < 4; ++st4) { const bf16x8 af = tr_frag16(Vs, 72, 32 * st4, 16 * vi, lane);
#pragma unroll
                for (int jj = 0; jj < 2; ++jj) { const bf16x8 bfr = tr_frag16(Kw, 72, 32 * st4, 16 * (2 * (w & 1) + jj), lane); accC[jj] = __builtin_amdgcn_mfma_f32_16x16x32_bf16(af, bfr, accC[jj], 0, 0, 0); } } }
        { const int k = tid & 63, part = tid >> 6; float sacc = 0.f;
#pragma unroll
            for (int q = 0; q < 16; ++q) sacc += bf2f(Kw[(16 * part + q) * 72 + k]);
            npart[part * 64 + k] = sacc; }
        if (MODE == 0 && xw >= 0 && xload) {
#pragma unroll
            for (int i = 0; i < 8; ++i) { LAS float* p = xscr + (8 * i + (lane >> 3)) * 33 + 4 * (lane & 7); p[0] = xr[i][0]; p[1] = xr[i][1]; p[2] = xr[i][2]; p[3] = xr[i][3]; }
            LDS_WAIT(); asm volatile("" ::: "memory");
            const int c = lane & 7;
#pragma unroll
            for (int q = 0; q < 4; ++q) { const LAS float* sp = xscr + (8 * c) * 33 + (lane >> 3) + 8 * q;
                xo[q] = (v2u){pk4_fp8(32.f * sp[0 * 33], 32.f * sp[1 * 33], 32.f * sp[2 * 33], 32.f * sp[3 * 33]), pk4_fp8(32.f * sp[4 * 33], 32.f * sp[5 * 33], 32.f * sp[6 * 33], 32.f * sp[7 * 33])}; }
            xodst = xdst + (size_t)(lane >> 3) * 1024 + 8 * c; xout = true; xload = false;
        }
        m_old = mnew; dec_prev = dec;
        LBAR();
    }
    if (MODE == 0 && xw >= 0 && xout) {
#pragma unroll
        for (int q = 0; q < 4; ++q) *(GAS v2u*)(xodst + (size_t)(8 * q) * 1024) = xo[q]; }
    if (hpend) {
        { const int r = tid >> 2, c = tid & 3; const int tt = d ? (hL - 1 - (hp0 + r)) : (hp0 + r);
            f32x4 a0, a1, b0, b1; unpack8(*(const LAS v4u*)(Hst + r * 72 + 16 * c), a0, a1); unpack8(*(const LAS v4u*)(Hst + r * 72 + 16 * c + 8), b0, b1);
            *(v4u*)(HDIR + (size_t)tt * 64 + 16 * c) = (v4u){pk4_fp8(8.f * a0[0], 8.f * a0[1], 8.f * a0[2], 8.f * a0[3]), pk4_fp8(8.f * a1[0], 8.f * a1[1], 8.f * a1[2], 8.f * a1[3]), pk4_fp8(8.f * b0[0], 8.f * b0[1], 8.f * b0[2], 8.f * b0[3]), pk4_fp8(8.f * b1[0], 8.f * b1[1], 8.f * b1[2], 8.f * b1[3])}; } }
#undef ML_PREFETCH
}

__device__ __forceinline__ void s5_disc(const float* const* __restrict__ INP, int d, int g, int p, float& ar, float& ai, float& cfr, float& cfi) {
    const float dt = expf(INP[15][d * 32 + g]); const float are = INP[13][(d * 32 + g) * 64 + p], aim = INP[14][(d * 32 + g) * 64 + p];
    const float mag = expf(dt * are), ang = dt * aim; ar = mag * cosf(ang); ai = mag * sinf(ang);
    const float den = are * are + aim * aim, xr = ar - 1.0f; cfr = (xr * are + ai * aim) / den; cfi = (ai * are - xr * aim) / den;
}
template <int SMODE>
__device__ __forceinline__ void p4_s5(Frame& F, const float* const* __restrict__ INP, int unit) {
    const int gp = unit & 15, b = (unit >> 4) & 7, d = unit >> 7;
    LAS bf16* BHt = (LAS bf16*)(F.lds + 0);
    LAS bf16* Cm = (LAS bf16*)(F.lds + 69632);
    LAS float* Eb = (LAS float*)(F.lds + 78336);
    LAS bf16* Us = (LAS bf16*)(F.lds + 82432);
    LAS bf16* BBs = (LAS bf16*)(F.lds + 92672);
    const bf16* PROJ = (const bf16*)(F.ws + WS_PROJ); bf16* YDIR = (bf16*)(F.ws + WS_YDIR) + (size_t)(((d * 8 + b) * 16 + gp)) * SEQ * 32;
    LAS bf16* Yst = (LAS bf16*)(F.lds + 104960);
    int tid = F.tid; asm volatile("" : "+v"(tid));
    const int lane = tid & 63, w = F.wave;
    const int sg = tid & 127, seg = tid >> 7;
    float ar, ai, a32r, a32i;
    { float cfr, cfi; s5_disc(INP, d, 2 * gp + (sg >> 6), sg & 63, ar, ai, cfr, cfi); a32r = ar; a32i = ai;
#pragma unroll
        for (int q = 0; q < 5; ++q) { const float nr = a32r * a32r - a32i * a32i, ni = 2.0f * a32r * a32i; a32r = nr; a32i = ni; } }
    for (int idx = tid; idx < 4096; idx += 512) {
        { const int gg = idx >> 11, pp = (idx >> 4) & 127, c = idx & 15, g = 2 * gp + gg, p = pp & 63; float xr_, xi_, cfr, cfi; s5_disc(INP, d, g, p, xr_, xi_, cfr, cfi);
            const float bre = INP[16][((size_t)(d * 32 + g) * 64 + p) * 16 + c], bim = INP[17][((size_t)(d * 32 + g) * 64 + p) * 16 + c];
            BBs[(gg * 128 + pp) * 24 + c] = (bf16)f2bf(pp < 64 ? cfr * bre - cfi * bim : cfr * bim + cfi * bre); }
        { const int gg = idx >> 11, c = (idx >> 7) & 15, pp = idx & 127, g = 2 * gp + gg, p = pp & 63;
            const float v = pp < 64 ? INP[18][((size_t)(d * 32 + g) * 16 + c) * 64 + p] : -INP[19][((size_t)(d * 32 + g) * 16 + c) * 64 + p];
            Cm[(gg * 16 + c) * 136 + pp] = (bf16)f2bf(v); }
    }
    float h0r = 0.f, h0i = 0.f;
    LAS bf16* rowre = BHt + ((sg >> 6) * 128 + (sg & 63)) * 136 + 32 * seg;
    v4u pu; bool ypend = false; int yp0 = 0, yL = 0;
#define S5_PREFETCH(jn) do { const bool lat_ = (jn) >= 2; const int p0_ = lat_ ? 128 * ((jn) - 2) : 128 * (jn), L_ = lat_ ? SEQ : CTXL, rb_ = lat_ ? b * SEQ : ML + b * CTXL; \
        const int s_ = tid >> 2, c_ = tid & 3; const int tt = d ? (L_ - 1 - (p0_ + s_)) : (p0_ + s_); pu = *(const v4u*)(PROJ + (size_t)(rb_ + tt) * LDP + PC_U + gp * 32 + c_ * 8); } while (0)
    S5_PREFETCH(0);
    __syncthreads();
    for (int j = 0; j < 34; ++j) {
        const bool lat = j >= 2;
        const int p0 = lat ? 128 * (j - 2) : 128 * j, Lseq = lat ? SEQ : CTXL, rowbase = lat ? b * SEQ : ML + b * CTXL;
        *(LAS v4u*)(Us + (tid >> 2) * 40 + (tid & 3) * 8) = pu;
        LBAR();
        if (j + 1 < 34) S5_PREFETCH(j + 1);
        if (ypend) { if (!(SMODE & 1)) { const int r = tid >> 2, c = tid & 3; const int tt = d ? (yL - 1 - (yp0 + r)) : (yp0 + r); *(v4u*)(YDIR + (size_t)tt * 32 + 8 * c) = *(const LAS v4u*)(Yst + r * 40 + 8 * c); } ypend = false; }
        { const int gg = w >> 2, tm = w & 3, r = lane & 31, hh = lane >> 5;
            const bf16x8 a = *(const LAS bf16x8*)(Us + (32 * tm + r) * 40 + gg * 16 + 8 * hh);
            LAS bf16* bp = BHt + (gg * 128 + r) * 136 + 32 * tm + 4 * hh;
#pragma unroll
            for (int tn = 0; tn < 4; ++tn) { f32x16 acc;
#pragma unroll
                for (int reg = 0; reg < 16; ++reg) acc[reg] = 0.f;
                const bf16x8 bb = *(const LAS bf16x8*)(BBs + (gg * 128 + 32 * tn + r) * 24 + 8 * hh);
                acc = __builtin_amdgcn_mfma_f32_32x32x16_bf16(a, bb, acc, 0, 0, 0);
#pragma unroll
                for (int rg = 0; rg < 4; ++rg) *(LAS v2u*)(bp + 32 * tn * 136 + 8 * rg) = (v2u){cvtpk(acc[4 * rg], acc[4 * rg + 1]), cvtpk(acc[4 * rg + 2], acc[4 * rg + 3])}; } }
        LBAR();
        v4u xr[4], xi[4];
#pragma unroll
        for (int q = 0; q < 4; ++q) { xr[q] = *(const LAS v4u*)(rowre + 8 * q); xi[q] = *(const LAS v4u*)(rowre + 64 * 136 + 8 * q); }
        { float hr = 0.f, hi = 0.f;
#pragma unroll
            for (int q = 0; q < 4; ++q)
#pragma unroll
                for (int e = 0; e < 4; ++e) { const unsigned wr_ = xr[q][e], wi_ = xi[q][e];
                    { const float br = bflo(wr_), bi = bflo(wi_); const float nr = ar * hr - ai * hi + br, ni = ar * hi + ai * hr + bi; hr = nr; hi = ni; }
                    { const float br = bfhi(wr_), bi = bfhi(wi_); const float nr = ar * hr - ai * hi + br, ni = ar * hi + ai * hr + bi; hr = nr; hi = ni; } }
            Eb[(seg * 128 + sg) * 2] = hr; Eb[(seg * 128 + sg) * 2 + 1] = hi; }
        LBAR();
        { float hcr = h0r, hci = h0i, hr = 0.f, hi = 0.f;
#pragma unroll
            for (int s2 = 0; s2 < 4; ++s2) { if (s2 == seg) { hr = hcr; hi = hci; } const float er = Eb[(s2 * 128 + sg) * 2], ei = Eb[(s2 * 128 + sg) * 2 + 1];
                const float nr = a32r * hcr - a32i * hci + er, ni = a32r * hci + a32i * hcr + ei; hcr = nr; hci = ni; }
            h0r = hcr; h0i = hci;
#pragma unroll
            for (int q = 0; q < 4; ++q) { v4u orr, oi;
#pragma unroll
                for (int e = 0; e < 4; ++e) { const unsigned wr_ = xr[q][e], wi_ = xi[q][e]; float r0, i0, r1, i1;
                    { const float br = bflo(wr_), bi = bflo(wi_); const float nr = ar * hr - ai * hi + br, ni = ar * hi + ai * hr + bi; hr = nr; hi = ni; r0 = hr; i0 = hi; }
                    { const float br = bfhi(wr_), bi = bfhi(wi_); const float nr = ar * hr - ai * hi + br, ni = ar * hi + ai * hr + bi; hr = nr; hi = ni; r1 = hr; i1 = hi; }
                    orr[e] = cvtpk(r0, r1); oi[e] = cvtpk(i0, i1); }
                *(LAS v4u*)(rowre + 8 * q) = orr; *(LAS v4u*)(rowre + 64 * 136 + 8 * q) = oi; } }
        LBAR();
        if (lat) { const int gg = w >> 2;
#pragma unroll
            for (int jj = 0; jj < 2; ++jj) { const int tm = 2 * (w & 3) + jj; f32x4 acc = (f32x4){0.f, 0.f, 0.f, 0.f};
#pragma unroll
                for (int st4 = 0; st4 < 4; ++st4) { const bf16x8 af = *(const LAS bf16x8*)(Cm + (gg * 16 + (lane & 15)) * 136 + 32 * st4 + 8 * (lane >> 4));
                    const bf16x8 bfr = tr_frag16(BHt + gg * 128 * 136, 136, 32 * st4, 16 * tm, lane);
                    acc = __builtin_amdgcn_mfma_f32_16x16x32_bf16(af, bfr, acc, 0, 0, 0); }
                const int t = 16 * tm + (lane & 15);
                *(LAS v2u*)(Yst + t * 40 + gg * 16 + 4 * (lane >> 4)) = (v2u){pk2(acc[0], acc[1]), pk2(acc[2], acc[3])}; }
            ypend = true; yp0 = p0; yL = Lseq; }
    }
    if (ypend && !(SMODE & 1)) { LBAR(); const int r = tid >> 2, c = tid & 3; const int tt = d ? (yL - 1 - (yp0 + r)) : (yp0 + r); *(v4u*)(YDIR + (size_t)tt * 32 + 8 * c) = *(const LAS v4u*)(Yst + r * 40 + 8 * c); }
#undef S5_PREFETCH
    __syncthreads();
}

__device__ __forceinline__ float gelu_tanh(float x) { const float u = 0.7978845608028654f * (x + 0.044715f * x * x * x); const float e = __expf(2.0f * u); const float th = 1.0f - 2.0f * frcp(e + 1.0f); return 0.5f * x * (1.0f + th); }
__device__ __forceinline__ void p5a_prep(Frame& F, const float* const* __restrict__ INP) {
    const int gw = F.vcu * NWAVES + F.wave, NGW = F.G * NWAVES, lane = F.lane;
    const bf16* PROJ = (const bf16*)(F.ws + WS_PROJ); const unsigned char* HB0 = F.ws + WS_HDIR; const unsigned char* HB1 = HB0 + (size_t)ML * 1024;
    const bf16* YD0 = (const bf16*)(F.ws + WS_YDIR); const bf16* YD1 = YD0 + (size_t)ML * 512;
    bf16* A1 = (bf16*)(F.ws + WS_A1); bf16* A2 = (bf16*)(F.ws + WS_A2); const unsigned char* P8 = F.ws + WS_PROJ8;
    for (int m0 = 2 * gw; m0 < ML; m0 += 2 * NGW) {
        v4u ha[2][2], hb[2][2], ho[2][2], ya[2], yb[2], yu[2];
#pragma unroll
        for (int r = 0; r < 2; ++r) { const size_t m = (size_t)(m0 + r); const int bb = (int)(m / SEQ), tq = (int)(m % SEQ);
            const size_t hoff = ((size_t)((bb * 8 + (lane >> 3)) * 2 + ((lane >> 2) & 1)) * SEQ + tq) * 64 + (lane & 3) * 16;
            const size_t yoff = ((size_t)(bb * 16 + (lane >> 2)) * SEQ + tq) * 32 + (lane & 3) * 8;
#pragma unroll
            for (int q = 0; q < 2; ++q) { ha[r][q] = (v4u){0u, 0u, 0u, 0u}; hb[r][q] = (v4u){0u, 0u, 0u, 0u}; ho[r][q] = (v4u){0u, 0u, 0u, 0u}; }
            { const v4u a16 = *(const v4u*)(HB0 + hoff), b16 = *(const v4u*)(HB1 + hoff); ha[r][0].x = a16.x; ha[r][0].y = a16.y; ha[r][1].x = a16.z; ha[r][1].y = a16.w; hb[r][0].x = b16.x; hb[r][0].y = b16.y; hb[r][1].x = b16.z; hb[r][1].y = b16.w; }
            { const v4u o16 = *(const v4u*)(P8 + m * 3072 + 16 * lane); ho[r][0].x = o16.x; ho[r][0].y = o16.y; ho[r][1].x = o16.z; ho[r][1].y = o16.w; }
            ya[r] = *(const v4u*)(YD0 + yoff); yb[r] = *(const v4u*)(YD1 + yoff); yu[r] = *(const v4u*)(PROJ + m * LDP + PC_U + 8 * lane); }
        __builtin_amdgcn_sched_barrier(0);
#pragma unroll
        for (int r = 0; r < 2; ++r) { const size_t m = (size_t)(m0 + r);
            float hm[16]; float ss = 0.f;
#pragma unroll
            for (int q = 0; q < 2; ++q) { f32x4 a0, a1, b0, b1; unpack8_fp8((v2u){ha[r][q].x, ha[r][q].y}, a0, a1); unpack8_fp8((v2u){hb[r][q].x, hb[r][q].y}, b0, b1);
#pragma unroll
                for (int e = 0; e < 4; ++e) { hm[8 * q + e] = (a0[e] + b0[e]) * 0.125f; hm[8 * q + 4 + e] = (a1[e] + b1[e]) * 0.125f; } }
#pragma unroll
            for (int q = 0; q < 16; ++q) ss += hm[q] * hm[q];
            ss += __shfl_xor(ss, 1); ss += __shfl_xor(ss, 2); ss += __shfl_xor(ss, 4);
            const float rs = 1.0f / sqrtf(ss * (1.0f / 128.0f) + EPS);
#pragma unroll
            for (int q = 0; q < 2; ++q) { const float* gm = INP[11] + 16 * lane + 8 * q; f32x4 og0, og1; unpack8_fp8((v2u){ho[r][q].x, ho[r][q].y}, og0, og1);
                float rr[8]; const float og[8] = {og0[0], og0[1], og0[2], og0[3], og1[0], og1[1], og1[2], og1[3]};
#pragma unroll
                for (int e = 0; e < 8; ++e) rr[e] = hm[8 * q + e] * rs * gm[e] * sigmoidf_(og[e]);
                *(v2u*)((unsigned char*)A1 + m * 1024 + 16 * lane + 8 * q) = (v2u){pk4_fp8(rr[0], rr[1], rr[2], rr[3]), pk4_fp8(rr[4], rr[5], rr[6], rr[7])}; }
            { const v4u a = ya[r], bq = yb[r], u8 = yu[r]; const float* dd = INP[20] + 8 * lane;
                float rr[8] = {bflo(a.x) + bflo(bq.x) + dd[0] * bflo(u8.x), bfhi(a.x) + bfhi(bq.x) + dd[1] * bfhi(u8.x), bflo(a.y) + bflo(bq.y) + dd[2] * bflo(u8.y), bfhi(a.y) + bfhi(bq.y) + dd[3] * bfhi(u8.y),
                               bflo(a.z) + bflo(bq.z) + dd[4] * bflo(u8.z), bfhi(a.z) + bfhi(bq.z) + dd[5] * bfhi(u8.z), bflo(a.w) + bflo(bq.w) + dd[6] * bflo(u8.w), bfhi(a.w) + bfhi(bq.w) + dd[7] * bfhi(u8.w)};
#pragma unroll
                for (int e = 0; e < 8; ++e) rr[e] = gelu_tanh(rr[e]);
                *(v2u*)((unsigned char*)A2 + m * 512 + 8 * lane) = (v2u){pk4_fp8(rr[0], rr[1], rr[2], rr[3]), pk4_fp8(rr[4], rr[5], rr[6], rr[7])}; }
        }
    }
}

__device__ __forceinline__ void route_reduce_top4(float (&acc)[32], const float* br, int lane, float (&tv)[4], int (&ti)[4]) {
#pragma unroll
    for (int i = 0; i < 16; ++i) { const float send = (lane & 32) ? acc[i] : acc[i + 16]; const float keep = (lane & 32) ? acc[i + 16] : acc[i]; acc[i] = keep + __shfl_xor(send, 32); }
#pragma unroll
    for (int i = 0; i < 8; ++i) { const float send = (lane & 16) ? acc[i] : acc[i + 8]; const float keep = (lane & 16) ? acc[i + 8] : acc[i]; acc[i] = keep + __shfl_xor(send, 16); }
#pragma unroll
    for (int i = 0; i < 4; ++i) { const float send = (lane & 8) ? acc[i] : acc[i + 4]; const float keep = (lane & 8) ? acc[i + 4] : acc[i]; acc[i] = keep + __shfl_xor(send, 8); }
#pragma unroll
    for (int i = 0; i < 2; ++i) { const float send = (lane & 4) ? acc[i] : acc[i + 2]; const float keep = (lane & 4) ? acc[i + 2] : acc[i]; acc[i] = keep + __shfl_xor(send, 4); }
    { const float send = (lane & 2) ? acc[0] : acc[1]; const float keep = (lane & 2) ? acc[1] : acc[0]; acc[0] = keep + __shfl_xor(send, 2); }
    acc[0] += __shfl_xor(acc[0], 1);
    float val = acc[0] + br[lane >> 1];
    if (lane & 1) val = -INFINITY;
#pragma unroll
    for (int r = 0; r < 4; ++r) { float mx = val;
#pragma unroll
        for (int o = 1; o < 64; o <<= 1) mx = fmaxf(mx, __shfl_xor(mx, o));
        const unsigned long long bal = __ballot(val == mx); const int wl = __ffsll((long long)bal) - 1;
        tv[r] = mx; ti[r] = wl >> 1; if (lane == wl) val = -INFINITY; }
}
__device__ __forceinline__ void p6_route(Frame& F, const float* const* __restrict__ INP) {
    const bf16* X1 = (const bf16*)(F.ws + WS_X1); const float* mod = (const float*)(F.ws + WS_MOD); bf16* H2 = (bf16*)(F.ws + WS_H2);
    int* TOPE = (int*)(F.ws + WS_TOPE); int* POS = (int*)(F.ws + WS_POS); float* TOPP = (float*)(F.ws + WS_TOPP); int* LIST = (int*)(F.ws + WS_LIST);
    LAS float* Wt = (LAS float*)(F.lds);
    LAS int* pe = (LAS int*)(F.lds + LDSCTL_OFF + 1024); LAS int* hist = pe + 512; LAS int* base = hist + 32; LAS int* rank = base + 32;
    const float* wr = INP[26]; const float* br = INP[27];
    const int lane = F.lane, w = F.wave;
    for (int idx = F.tid; idx < 32768; idx += NWAVES * 64) { const int e = idx >> 10, k = idx & 1023; Wt[((((k >> 8) * 4 + (k & 3)) * 32 + e) << 6) + ((k >> 2) & 63)] = wr[k * 32 + e]; }
    __syncthreads();
    for (int tg = blockIdx.x; tg < ML / 128; tg += F.G) {
        if (F.tid < 32) hist[F.tid] = 0;
        __syncthreads();
#pragma unroll 1
        for (int q = 0; q < 16; q += 2) {
            const int tl = w * 16 + q, m = tg * 128 + tl, b = m / SEQ;
            const float* sh = mod + b * 6144 + 3 * D; const float* scl = sh + D;
            float s0 = 0.f, s1 = 0.f;
#pragma unroll
            for (int j = 0; j < 4; ++j) { const v2u w0 = *(const v2u*)(X1 + (size_t)m * D + 256 * j + 4 * lane), w1 = *(const v2u*)(X1 + (size_t)(m + 1) * D + 256 * j + 4 * lane);
                const f32x4 x0 = (f32x4){bflo(w0.x), bfhi(w0.x), bflo(w0.y), bfhi(w0.y)}, x1 = (f32x4){bflo(w1.x), bfhi(w1.x), bflo(w1.y), bfhi(w1.y)};
                s0 += (x0[0] * x0[0] + x0[1] * x0[1]) + (x0[2] * x0[2] + x0[3] * x0[3]); s1 += (x1[0] * x1[0] + x1[1] * x1[1]) + (x1[2] * x1[2] + x1[3] * x1[3]); }
            const float r0 = 1.0f / sqrtf(wave_sum(s0) * (1.0f / D) + EPS), r1 = 1.0f / sqrtf(wave_sum(s1) * (1.0f / D) + EPS);
            float a0[32], a1[32];
#pragma unroll
            for (int e = 0; e < 32; ++e) { a0[e] = 0.f; a1[e] = 0.f; }
#pragma unroll 1
            for (int j = 0; j < 4; ++j) { const int c = 256 * j + 4 * lane; const f32x4 g = *(const f32x4*)(INP[7] + c), a = *(const f32x4*)(scl + c), bb = *(const f32x4*)(sh + c);
                const v2u w0 = *(const v2u*)(X1 + (size_t)m * D + c), w1 = *(const v2u*)(X1 + (size_t)(m + 1) * D + c);
                const f32x4 x0 = (f32x4){bflo(w0.x), bfhi(w0.x), bflo(w0.y), bfhi(w0.y)}, x1 = (f32x4){bflo(w1.x), bfhi(w1.x), bflo(w1.y), bfhi(w1.y)};
                const f32x4 gs = g * (a + 1.0f); const f32x4 y0 = x0 * r0 * gs + bb, y1 = x1 * r1 * gs + bb;
                *(unsigned*)((unsigned char*)H2 + (size_t)m * D + c) = pk4_fp8(y0[0], y0[1], y0[2], y0[3]); *(unsigned*)((unsigned char*)H2 + (size_t)(m + 1) * D + c) = pk4_fp8(y1[0], y1[1], y1[2], y1[3]);
                const LAS float* wj = Wt + j * 8192 + lane;
#pragma unroll
                for (int qq = 0; qq < 4; ++qq) { const LAS float* wp = wj + qq * 2048; const float ya = y0[qq], yb = y1[qq];
#pragma unroll
                    for (int e = 0; e < 32; ++e) { const float wv = wp[e * 64]; a0[e] += ya * wv; a1[e] += yb * wv; }
                    asm volatile("" ::: "memory"); } }
            float tv[4]; int ti[4];
#pragma unroll
            for (int tk = 0; tk < 2; ++tk) {
                if (tk == 0) route_reduce_top4(a0, br, lane, tv, ti); else route_reduce_top4(a1, br, lane, tv, ti);
                const float e1 = __expf(tv[1] - tv[0]), e2 = __expf(tv[2] - tv[0]), e3 = __expf(tv[3] - tv[0]); const float inv = 1.0f / (1.0f + e1 + e2 + e3);
                if (lane < 4) { const float p = lane == 0 ? inv : (lane == 1 ? e1 * inv : (lane == 2 ? e2 * inv : e3 * inv)); const int ee = lane == 0 ? ti[0] : (lane == 1 ? ti[1] : (lane == 2 ? ti[2] : ti[3]));
                    TOPP[(m + tk) * 4 + lane] = p; TOPE[(m + tk) * 4 + lane] = ee; pe[(tl + tk) * 4 + lane] = ee; }
            }
        }
        __syncthreads();
        { const int e = pe[F.tid]; rank[F.tid] = __hip_atomic_fetch_add(&hist[e], 1, __ATOMIC_RELAXED, __HIP_MEMORY_SCOPE_WORKGROUP); }
        __syncthreads();
        if (F.tid < 32) base[F.tid] = (int)__hip_atomic_fetch_add(F.ctl + CW_CNT + 64 * F.tid, (unsigned)hist[F.tid], RLX_AGENT);
        __syncthreads();
        { const int e = pe[F.tid]; const int pos = base[e] + rank[F.tid]; const int m = tg * 128 + (F.tid >> 2); LIST[e * ML + pos] = m; POS[m * 4 + (F.tid & 3)] = pos; }
        __syncthreads();
    }
}

typedef int i32x4 __attribute__((ext_vector_type(4)));
__device__ __forceinline__ void p10_combine(Frame& F, const float* const* __restrict__ INP) {
    moe_tables(F);
    const LAS int* tab = (const LAS int*)(F.lds + TAB_OFF);
    const bf16* X1 = (const bf16*)(F.ws + WS_X1); float* OUT = F.out; const float* mod = (const float*)(F.ws + WS_MOD); const unsigned char* Y = (const unsigned char*)(F.ws + WS_Y);
    const int* TOPE = (const int*)(F.ws + WS_TOPE); const int* POS = (const int*)(F.ws + WS_POS); const float* TOPP = (const float*)(F.ws + WS_TOPP);
    const int gw = F.vcu * NWAVES + F.wave, NGW = F.G * NWAVES, lane = F.lane;
    i32x4 te[2], tp[2]; f32x4 tw[2];
    int m0 = 2 * gw;
    if (m0 < ML) {
#pragma unroll
        for (int r = 0; r < 2; ++r) { te[r] = *(const i32x4*)(TOPE + (m0 + r) * 4); tp[r] = *(const i32x4*)(POS + (m0 + r) * 4); tw[r] = *(const f32x4*)(TOPP + (m0 + r) * 4); } }
    for (; m0 < ML; m0 += 2 * NGW) {
        unsigned yv[2][4][4]; v2u xv[2][4];
#pragma unroll
        for (int r = 0; r < 2; ++r) {
#pragma unroll
            for (int k = 0; k < 4; ++k) { const size_t slot = (size_t)256 * tab[te[r][k]] + tp[r][k];
#pragma unroll
                for (int j = 0; j < 4; ++j) yv[r][k][j] = *(const unsigned*)(Y + slot * 1024 + 256 * j + 4 * lane); }
#pragma unroll
            for (int j = 0; j < 4; ++j) xv[r][j] = *(const v2u*)(X1 + (size_t)(m0 + r) * D + 256 * j + 4 * lane); }
        const f32x4 cw[2] = {tw[0], tw[1]};
        const int mn = m0 + 2 * NGW;
        if (mn < ML) {
#pragma unroll
            for (int r = 0; r < 2; ++r) { te[r] = *(const i32x4*)(TOPE + (mn + r) * 4); tp[r] = *(const i32x4*)(POS + (mn + r) * 4); tw[r] = *(const f32x4*)(TOPP + (mn + r) * 4); } }
        __builtin_amdgcn_sched_barrier(0);
#pragma unroll
        for (int r = 0; r < 2; ++r) { const int m = m0 + r, b = m / SEQ; const float* gt2 = mod + b * 6144 + 5 * D;
            f32x4 v[4]; float s = 0.f;
#pragma unroll
            for (int j = 0; j < 4; ++j) { const int c = 256 * j + 4 * lane; f32x4 mo = (f32x4){0.f, 0.f, 0.f, 0.f};
#pragma unroll
                for (int k = 0; k < 4; ++k) { const unsigned y = yv[r][k][j]; const auto lo = __builtin_amdgcn_cvt_pk_f32_fp8((int)y, false), hi = __builtin_amdgcn_cvt_pk_f32_fp8((int)y, true);
                    mo += (f32x4){lo[0], lo[1], hi[0], hi[1]} * (cw[r][k] * 0.0625f); }
                const v2u xw = xv[r][j]; v[j] = (f32x4){bflo(xw.x), bfhi(xw.x), bflo(xw.y), bfhi(xw.y)} + *(const f32x4*)(gt2 + c) * mo;
                s += (v[j][0] * v[j][0] + v[j][1] * v[j][1]) + (v[j][2] * v[j][2] + v[j][3] * v[j][3]); }
            const float rstd = 1.0f / sqrtf(wave_sum(s) * (1.0f / D) + EPS);
#pragma unroll
            for (int j = 0; j < 4; ++j) { const int c = 256 * j + 4 * lane; *(f32x4*)(OUT + (size_t)m * D + c) = v[j] * rstd * *(const f32x4*)(INP[32] + c); }
        }
    }
}

struct Args { const float* in[33]; float* out; unsigned char* ws; int ph_lo, ph_hi, li, pad; };
__global__ void __launch_bounds__(NWAVES * 64, 2) fwd_kernel(Args args) {
    extern __shared__ __attribute__((aligned(16))) unsigned char lds[];
    Frame F;
    F.lds = (LAS unsigned char*)lds;
    F.tid = threadIdx.x; F.lane = F.tid & 63; F.wave = __builtin_amdgcn_readfirstlane(F.tid >> 6);
    F.G = gridDim.x; { const int bx = blockIdx.x; F.vcu = (F.G % 8 == 0) ? (bx % 8) * (F.G / 8) + bx / 8 : bx; }
    F.ws = args.ws; F.ctl = (gu32*)(args.ws + WS_CTL); F.out = args.out;
    for (int u = F.tid; u < (LDS_BYTES - LDSCTL_OFF) / 4; u += NWAVES * 64) ((LAS unsigned*)(F.lds + LDSCTL_OFF))[u] = 0u;
    __syncthreads();
    XcdBarrier bar; bar.bar = (unsigned*)(F.ctl + CW_BAR); bar.x = 0; bar.st = nullptr;
    if (N_LAUNCHES == 1) bar = xcd_barrier_post((unsigned*)(F.ctl + CW_BAR), (volatile LAS unsigned*)(F.lds + MISC_OFF) + 8);
    const int lo = args.ph_lo, hi = args.ph_hi;
    const float* const* __restrict__ INP = args.in;
#ifndef PH_MASK
#define PH_MASK 0x3fff
#endif
#define IN(k) ((((PH_MASK) >> (k)) & 1) && lo <= (k) && (k) < hi)
#define SEAM(k) do { if (IN(k) && IN((k) + 1)) xcd_barrier(bar); } while (0)
    const bf16* WIN = (const bf16*)(F.ws + WS_WIN);

    if (IN(0)) { p0_prologue(F, INP); } SEAM(0);
    if (IN(1)) { p1_norm1(F, INP); } SEAM(1);
    if (IN(2)) {
        pg8::Gemm g{(const bf16*)(F.ws + WS_H1), WIN, 512, nullptr, 0x7f7f7f7f, 0x7a7a7a7a}; InProjOrder S{F.G, (int)blockIdx.x};
        EpiStore E{(bf16*)(F.ws + WS_PROJ), LDP, F.ws + WS_PROJ8};
        pg8::gemm_phase<EpiStore, InProjOrder, false, true>(F.lds, g, S, E);
    } SEAM(2);
    if (IN(3)) { p3_conv(F, INP); } SEAM(3);
    if (IN(4)) { for (int u = blockIdx.x; u < 256; u += F.G) { p4_mlstm<0>(F, INP, u); if (P4_REP_M > 1) p4_mlstm<P4_MODE>(F, INP, u); p4_s5<0>(F, INP, u); if (P4_REP_S > 1) p4_s5<1>(F, INP, u); } } SEAM(4);
    if (IN(5)) { p5a_prep(F, INP); } SEAM(5);
    if (IN(6)) {
        pg8::Gemm g{(const bf16*)(F.ws + WS_A2), (const bf16*)(F.ws + WS_WGLU), 256, nullptr, 0x7f7f7f7f, 0x7a7a7a7a}; pg8::StaticOrder S; S.init(ML, 512, F.G, (int)blockIdx.x);
        EpiGlu E{(const bf16*)(F.ws + WS_A2), (bf16*)(F.ws + WS_A3), INP[22]};
        pg8::gemm_phase<EpiGlu, pg8::StaticOrder, false, true>(F.lds, g, S, E);
    }
    if (IN(7)) {
        pg8::Gemm g{(const bf16*)(F.ws + WS_A1), (const bf16*)(F.ws + WS_WA), 512, nullptr, 0x7f7f7f7f, 0x7a7a7a7a}; pg8::StaticOrder S; S.init(ML, 1024, F.G, (int)blockIdx.x);
        EpiGate<false> E{F.ws + WS_PROJ8, 1024, INP[24], nullptr, (bf16*)(F.ws + WS_YA)};
        pg8::gemm_phase<EpiGate<false>, pg8::StaticOrder, false, true>(F.lds, g, S, E);
    } SEAM(7);
    if (IN(8)) {
        pg8::Gemm g{(const bf16*)(F.ws + WS_A3), (const bf16*)(F.ws + WS_WB), 256, nullptr, 0x7f7f7f7f, 0x7a7a7a7a}; pg8::StaticOrder S; S.init(ML, 1024, F.G, (int)blockIdx.x);
        EpiGate<true> E{F.ws + WS_PROJ8, 2048, INP[24] + 1024, (const bf16*)(F.ws + WS_YA), (bf16*)(F.ws + WS_MERGED)};
        pg8::gemm_phase<EpiGate<true>, pg8::StaticOrder, false, true>(F.lds, g, S, E);
    } SEAM(8);
    if (IN(9)) {
        pg8::Gemm g{(const bf16*)(F.ws + WS_MERGED), (const bf16*)(F.ws + WS_WO), 512, nullptr, 0x7d7d7d7d, 0x7a7a7a7a}; pg8::StaticOrder S; S.init(ML, 1024, F.G, (int)blockIdx.x);
        EpiX1 E{INP[0], (const float*)(F.ws + WS_MOD), (bf16*)(F.ws + WS_X1)};
        pg8::gemm_phase<EpiX1, pg8::StaticOrder, false, true>(F.lds, g, S, E);
    } SEAM(9);
    if (IN(10)) { p6_route(F, INP); } SEAM(10);
    if (IN(11)) {
        moe_tables(F);
        MoeOrder S{F.G, (int)blockIdx.x, 8, (const LAS int*)(F.lds + TAB_OFF)};
        LAS unsigned short* ridx = (LAS unsigned short*)(F.lds + LDSCTL_OFF + 1024);
        { const int* LIST = (const int*)(F.ws + WS_LIST);
            for (int i = 0; i < 30; ++i) { pg8::Unit u; if (!S.next(i, u)) break;
                if (F.tid < 256) { const int rc = F.tid < u.nvalid ? F.tid : u.nvalid - 1; ridx[i * 256 + F.tid] = (unsigned short)LIST[u.lbase + rc]; } }
            __syncthreads(); }
        pg8::Gemm g{(const bf16*)(F.ws + WS_H2), (const bf16*)(F.ws + WS_WEIN), 512, ridx, 0x7f7f7f7f, 0x7a7a7a7a};
        EpiSwiglu E{INP[29], (bf16*)(F.ws + WS_ACT)};
        pg8::gemm_phase<EpiSwiglu, MoeOrder, true, true>(F.lds, g, S, E);
    } SEAM(11);
    if (IN(12)) {
        moe_tables(F);
        pg8::Gemm g{(const bf16*)(F.ws + WS_ACT), (const bf16*)(F.ws + WS_WEOUT), 512, nullptr, 0x7c7c7c7c, 0x7a7a7a7a}; MoeOrder S{F.G, (int)blockIdx.x, 4, (const LAS int*)(F.lds + TAB_OFF)};
        EpiY E{INP[31], (bf16*)(F.ws + WS_Y)};
        pg8::gemm_phase<EpiY, MoeOrder, false, true>(F.lds, g, S, E);
    } SEAM(12);
    if (IN(13)) { p10_combine(F, INP); }
#undef IN
#undef SEAM
}

extern "C" void kernel_launch(void* const* d_in, const int* in_sizes, int n_in, void* d_out, int out_size, void* d_ws, size_t ws_size, hipStream_t stream) {
    static int grid = 0;
    if (grid == 0) {
        if (n_in != 33 || out_size != ML * D || ws_size < WS_END2) { fprintf(stderr, "kernel_launch: unexpected shapes (n_in %d, out %d, ws %zu)\n", n_in, out_size, ws_size); grid = -1; return; }
        int dev = 0, cus = 0, per_cu = 0;
        if (hipGetDevice(&dev) != hipSuccess || hipDeviceGetAttribute(&cus, hipDeviceAttributeMultiprocessorCount, dev) != hipSuccess) { grid = -1; return; }
        if (hipFuncSetAttribute((const void*)fwd_kernel, hipFuncAttributeMaxDynamicSharedMemorySize, LDS_BYTES) != hipSuccess) { fprintf(stderr, "kernel_launch: hipFuncSetAttribute failed\n"); grid = -1; return; }
        if (hipOccupancyMaxActiveBlocksPerMultiprocessor(&per_cu, (const void*)fwd_kernel, NWAVES * 64, LDS_BYTES) != hipSuccess || per_cu < 1) fprintf(stderr, "kernel_launch: occupancy query reports %d\n", per_cu);
        (void)hipGetLastError();
        grid = cus;
    }
    if (grid < 0) return;
    if (hipMemsetAsync((char*)d_ws + WS_CTL, 0, CTL_ZERO_BYTES, stream) != hipSuccess) return;
    Args a{};
    for (int i = 0; i < 33; ++i) a.in[i] = (const float*)d_in[i];
    a.out = (float*)d_out; a.ws = (unsigned char*)d_ws;
    for (int li = 0; li < N_LAUNCHES; ++li) {
        a.ph_lo = (N_LAUNCHES == 1) ? 0 : li; a.ph_hi = (N_LAUNCHES == 1) ? NPH : li + 1; a.li = li;
        const int nrep = (N_LAUNCHES != 1 && (((PROBE_DUP_MASK) >> li) & 1)) ? 2 : 1;
        for (int r = 0; r < nrep; ++r) hipLaunchKernelGGL(fwd_kernel, dim3(grid), dim3(NWAVES * 64), LDS_BYTES, stream, a);
    }
}
```

```cpp
#include <hip/hip_runtime.h>
#include <cstdio>
#include <cstdint>

#ifndef MK_N_LAUNCHES
#define MK_N_LAUNCHES 1
#endif
#ifndef PROBE_DUP_MASK
#define PROBE_DUP_MASK 0
#endif
#ifndef P4_REP_M
#define P4_REP_M 1
#endif
#ifndef P4_MODE
#define P4_MODE 0
#endif
#ifndef P4_REP_S
#define P4_REP_S 1
#endif

namespace pg8 {
#define PG8_LAS __attribute__((address_space(3)))
typedef unsigned short bf16_t;
typedef short bf16x8 __attribute__((ext_vector_type(8)));
typedef float f32x4 __attribute__((ext_vector_type(4)));
typedef unsigned u32x4 __attribute__((ext_vector_type(4)));
constexpr int BM = 256, BK = 64, HALF = 128, HTB = HALF * BK * 2, STAGE_BYTES = 8 * HTB, NXCD = 8, WGM = 8;

__host__ __device__ __forceinline__ int lds_byte(int r, int c) { const int st = (r >> 4) * 2 + (c >> 5), rr = r & 15, cc = c & 31, ob = rr * 64 + cc * 2; return st * 1024 + (ob ^ (((ob >> 9) & 1) << 5)); }
__host__ __device__ __forceinline__ void stage_rc(int b, int& R, int& C) { const int st = b / 1024, sb = b % 1024, swz = sb ^ (((sb >> 9) & 1) << 5); R = (st >> 1) * 16 + swz / 64; C = (st & 1) * 32 + (swz % 64) / 2; }
__host__ __device__ __forceinline__ int perm32(int rho) { const int n = rho >> 4, i = rho & 15; return 8 * (i >> 2) + 4 * n + (i & 3); }

struct Unit { int pm, pn, lbase, nvalid; };
struct Gemm { const bf16_t* A; const bf16_t* Bt; int K; const PG8_LAS unsigned short* ridx; int sa, sb; };

__device__ __forceinline__ int xcd_remap(int L, int nwg) { const int q = nwg / NXCD, r = nwg % NXCD, xcd = L % NXCD, off = L / NXCD; return (xcd < r ? xcd * (q + 1) : r * (q + 1) + (xcd - r) * q) + off; }

struct StaticOrder {
    int nM, nN, nwg, G, c;
    __device__ void init(int M, int N, int G_, int c_) { nM = M / BM; nN = N / BM; nwg = nM * nN; G = G_; c = c_; }
    __device__ __forceinline__ bool next(int i, Unit& u) const {
        const long L = (long)i * G + c; if (L >= nwg) return false;
        const int wgid = xcd_remap((int)L, nwg);
        const int nig = WGM * nN, gid = wgid / nig, fm = gid * WGM, gsz = (nM - fm) < WGM ? (nM - fm) : WGM;
        u.pm = fm + ((wgid % nig) % gsz); u.pn = (wgid % nig) / gsz; u.lbase = 0; u.nvalid = 0; return true;
    }
};

__device__ __forceinline__ unsigned cvt_pk_bf16(float lo, float hi) { unsigned r; asm volatile("v_cvt_pk_bf16_f32 %0, %1, %2" : "=v"(r) : "v"(lo), "v"(hi)); return r; }

typedef int v8i __attribute__((ext_vector_type(8)));
typedef short s16x16 __attribute__((ext_vector_type(16)));
template <class Epi, class Sched, bool GATHER, bool FP8 = false>
__device__ __forceinline__ void gemm_phase(PG8_LAS unsigned char* lds, const Gemm g, const Sched& S, const Epi& E) {
    const int tid = threadIdx.x, wid = __builtin_amdgcn_readfirstlane(tid >> 6), lane = tid & 63, wr = wid >> 2, wc = wid & 3, fr = lane & 15, fq = lane >> 4;
    const int K = g.K, nt = K / BK;
    int Rr[2]; unsigned cby[2], voffB[2];
#pragma unroll
    for (int i = 0; i < 2; ++i) { int R, C; stage_rc(tid * 16 + i * 8192, R, C); const int Rb = Epi::PERM ? ((R & ~31) + perm32(R & 31)) : R;
        Rr[i] = R; cby[i] = (unsigned)C * 2u; voffB[i] = (unsigned)(Rb * K + C) * 2u; }
    const size_t kstep = (size_t)(BK * 2);
    const size_t hstep = (size_t)HALF * K * 2;
    const size_t tstep = 2 * hstep;
    const unsigned ldsw = (unsigned)wid * 1024u;
    const int aoff = lds_byte(wr * 64 + fr, fq * 8), boff = lds_byte(wc * 32 + fr, fq * 8);

#define PG8_SA(b, h) (((b) * 2 + (h)) * HTB)
#define PG8_SB(b, h) ((4 + (b) * 2 + (h)) * HTB)
#define PG8_STAGE(bufoff, gbase, voff) do { _Pragma("unroll") for (int _i = 0; _i < 2; ++_i) \
        __builtin_amdgcn_global_load_lds((const unsigned*)((const char*)(gbase) + (voff)[_i]), (PG8_LAS unsigned*)(lds + (bufoff) + ldsw + _i * 8192), 16, 0, 0); } while (0)
#define PG8_LDA(dst, b, h) do { if constexpr (FP8) { _Pragma("unroll") for (int m = 0; m < 4; ++m) { const bf16x8 _lo = *(const PG8_LAS bf16x8*)(lds + PG8_SA(b, h) + aoff + m * 2048), _hi = *(const PG8_LAS bf16x8*)(lds + PG8_SA(b, h) + aoff + m * 2048 + 1024); dst##8[m] = __builtin_bit_cast(v8i, __builtin_shufflevector(_lo, _hi, 0, 1, 2, 3, 4, 5, 6, 7, 8, 9, 10, 11, 12, 13, 14, 15)); } } \
        else { _Pragma("unroll") for (int m = 0; m < 4; ++m) _Pragma("unroll") for (int k = 0; k < 2; ++k) dst[m][k] = *(const PG8_LAS bf16x8*)(lds + PG8_SA(b, h) + aoff + m * 2048 + k * 1024); } } while (0)
#define PG8_LDB(dst, b, h) do { if constexpr (FP8) { _Pragma("unroll") for (int n = 0; n < 2; ++n) { const bf16x8 _lo = *(const PG8_LAS bf16x8*)(lds + PG8_SB(b, h) + boff + n * 2048), _hi = *(const PG8_LAS bf16x8*)(lds + PG8_SB(b, h) + boff + n * 2048 + 1024); dst##8[n] = __builtin_bit_cast(v8i, __builtin_shufflevector(_lo, _hi, 0, 1, 2, 3, 4, 5, 6, 7, 8, 9, 10, 11, 12, 13, 14, 15)); } } \
        else { _Pragma("unroll") for (int n = 0; n < 2; ++n) _Pragma("unroll") for (int k = 0; k < 2; ++k) dst[n][k] = *(const PG8_LAS bf16x8*)(lds + PG8_SB(b, h) + boff + n * 2048 + k * 1024); } } while (0)
#define PG8_MMA(ai, bj, At, Bt) do { __builtin_amdgcn_s_setprio(1); _Pragma("unroll") for (int m = 0; m < 4; ++m) _Pragma("unroll") for (int n = 0; n < 2; ++n) { \
        if constexpr (FP8) asm volatile("v_mfma_scale_f32_16x16x128_f8f6f4 %0, %1, %2, %0, %3, %4 op_sel_hi:[0,0,0]" : "+v"(acc[ai][bj][m][n]) : "v"(Bt##8[n]), "v"(At##8[m]), "v"(vsb), "v"(vsa));   \
        else { _Pragma("unroll") for (int k = 0; k < 2; ++k) acc[ai][bj][m][n] = __builtin_amdgcn_mfma_f32_16x16x32_bf16(Bt[n][k], At[m][k], acc[ai][bj][m][n], 0, 0, 0); } } \
        __builtin_amdgcn_s_setprio(0); } while (0)
#define PG8_WAIT_V(n) asm volatile("s_waitcnt vmcnt(" #n ")" ::: "memory")
#define PG8_WAIT_L(n) asm volatile("s_waitcnt lgkmcnt(" #n ")" ::: "memory")
#define PG8_BAR __builtin_amdgcn_s_barrier()
#define PG8_SCHED __builtin_amdgcn_sched_barrier(0)
#define PG8_AOFF(dst, u, uord) do { _Pragma("unroll") for (int _h = 0; _h < 2; ++_h) _Pragma("unroll") for (int _i = 0; _i < 2; ++_i) { const int _r = _h * HALF + Rr[_i]; \
        if constexpr (GATHER) { const int _idx = g.ridx[(uord) * 256 + _r]; dst[_h][_i] = (unsigned)_idx * (unsigned)(K * 2) + cby[_i]; } \
        else { dst[_h][_i] = (unsigned)(_r * K * 2) + cby[_i]; } } } while (0)
    Unit cur, nxt; int ui = 0;
    if (!S.next(0, cur)) return;
    f32x4 acc[2][2][4][2];
#pragma unroll
    for (int a = 0; a < 2; ++a)
#pragma unroll
        for (int b = 0; b < 2; ++b)
#pragma unroll
            for (int m = 0; m < 4; ++m)
#pragma unroll
                for (int n = 0; n < 2; ++n) acc[a][b][m][n] = (f32x4){0.f, 0.f, 0.f, 0.f};
    const int vsa = g.sa, vsb = g.sb;
    bf16x8 At[4][2], B0[2][2], B1[2][2];
    v8i At8[4], B08[2], B18[2];
    unsigned vc[2][2], vn[2][2];
    PG8_AOFF(vc, cur, 0);
    const char* cA = GATHER ? (const char*)g.A : (const char*)g.A + (size_t)cur.pm * tstep; const char* cB = (const char*)g.Bt + (size_t)cur.pn * tstep;
    PG8_STAGE(PG8_SB(0, 0), cB, voffB); PG8_STAGE(PG8_SB(0, 1), cB + hstep, voffB); PG8_STAGE(PG8_SA(0, 0), cA, vc[0]); PG8_STAGE(PG8_SA(0, 1), cA, vc[1]);
    if (wr == 1) PG8_BAR;
    PG8_WAIT_V(2); PG8_BAR;
    PG8_STAGE(PG8_SB(1, 0), cB + kstep, voffB); PG8_STAGE(PG8_SA(1, 0), cA + kstep, vc[0]); PG8_STAGE(PG8_SB(1, 1), cB + hstep + kstep, voffB);
    PG8_WAIT_V(6); PG8_BAR;
    for (;;) {
        const bool has_next = S.next(ui + 1, nxt);
        const char* nA = (has_next && !GATHER) ? (const char*)g.A + (size_t)nxt.pm * tstep : cA; const char* nB = has_next ? (const char*)g.Bt + (size_t)nxt.pn * tstep : cB;
        if constexpr (GATHER) { if (has_next) { PG8_AOFF(vn, nxt, ui + 1); } else {
#pragma unroll
            for (int h = 0; h < 2; ++h) { vn[h][0] = vc[h][0]; vn[h][1] = vc[h][1]; } } }
#pragma unroll 1
        for (int t = 0; t < nt; t += 2) {
            const bool last = (t == nt - 2);
            const char* a1 = cA + (size_t)(t + 1) * kstep;
            const char* a2 = last ? nA : cA + (size_t)(t + 2) * kstep; const char* b2 = last ? nB : cB + (size_t)(t + 2) * kstep;
            const char* a3 = a2 + kstep; const char* b3 = b2 + kstep;
            unsigned v2[2][2];
#pragma unroll
            for (int h = 0; h < 2; ++h)
#pragma unroll
                for (int i = 0; i < 2; ++i) v2[h][i] = GATHER ? (last ? vn[h][i] : vc[h][i]) : vc[h][i];
            PG8_LDB(B0, 0, 0); PG8_LDB(B1, 0, 1); PG8_SCHED; PG8_LDA(At, 0, 0); PG8_STAGE(PG8_SA(1, 1), a1, vc[1]);
            PG8_WAIT_V(8); PG8_WAIT_L(0); PG8_BAR; PG8_MMA(0, 0, At, B0); PG8_MMA(0, 1, At, B1); PG8_BAR; PG8_SCHED;
            PG8_LDA(At, 0, 1); PG8_STAGE(PG8_SB(0, 0), b2, voffB); PG8_STAGE(PG8_SB(0, 1), b2 + hstep, voffB); PG8_STAGE(PG8_SA(0, 0), a2, v2[0]);
            PG8_WAIT_V(8); PG8_WAIT_L(0); PG8_BAR; PG8_MMA(1, 0, At, B0); PG8_MMA(1, 1, At, B1); PG8_BAR; PG8_SCHED;
            PG8_LDB(B0, 1, 0); PG8_LDB(B1, 1, 1); PG8_SCHED; PG8_LDA(At, 1, 0); PG8_STAGE(PG8_SA(0, 1), a2, v2[1]);
            PG8_WAIT_V(8); PG8_WAIT_L(0); PG8_BAR; PG8_MMA(0, 0, At, B0); PG8_MMA(0, 1, At, B1); PG8_BAR; PG8_SCHED;
            PG8_LDA(At, 1, 1); PG8_STAGE(PG8_SB(1, 0), b3, voffB); PG8_STAGE(PG8_SB(1, 1), b3 + hstep, voffB); PG8_STAGE(PG8_SA(1, 0), a3, v2[0]);
            PG8_WAIT_V(8); PG8_WAIT_L(0); PG8_BAR; PG8_MMA(1, 0, At, B0); PG8_MMA(1, 1, At, B1); PG8_BAR; PG8_SCHED;
        }
        if (wr == 0) PG8_BAR;
        if constexpr (FP8) asm volatile("s_nop 15\n\ts_nop 15" ::: "memory");
        E(acc, cur, wr, wc, fr, fq);
        if (!has_next) break;
#pragma unroll
        for (int a = 0; a < 2; ++a)
#pragma unroll
            for (int b = 0; b < 2; ++b)
#pragma unroll
                for (int m = 0; m < 4; ++m)
#pragma unroll
                    for (int n = 0; n < 2; ++n) acc[a][b][m][n] = (f32x4){0.f, 0.f, 0.f, 0.f};
        cur = nxt; cA = nA; cB = nB; ++ui;
        if constexpr (GATHER) {
#pragma unroll
            for (int h = 0; h < 2; ++h) { vc[h][0] = vn[h][0]; vc[h][1] = vn[h][1]; } }
        if (wr == 1) PG8_BAR;
    }
    PG8_WAIT_V(0);
    PG8_BAR;
#undef PG8_SA
#undef PG8_SB
#undef PG8_STAGE
#undef PG8_LDA
#undef PG8_LDB
#undef PG8_MMA
#undef PG8_WAIT_V
#undef PG8_WAIT_L
#undef PG8_BAR
#undef PG8_SCHED
#undef PG8_AOFF
}
}

constexpr int NWAVES = 8;
constexpr int D = 1024, NB = 8, SEQ = 4096, CTXL = 256;
constexpr int ML = NB * SEQ, MC = NB * CTXL, MT = ML + MC;
constexpr int LDP = 5888;
constexpr int PC_QK = 0, PC_V = 1024, PC_U = 2048, PC_O = 2560, PC_G = 3584, PC_IF = 5632;
constexpr int NEXP = 32, TOPK = 4;
constexpr int MAXTILES = (ML * TOPK + NEXP * 256) / 256;
constexpr float EPS = 1e-6f;
constexpr int NPH = 14;
constexpr int N_LAUNCHES = MK_N_LAUNCHES;

constexpr size_t MiB = 1u << 20;
constexpr size_t WS_CTL = 0, CTL_ZERO_BYTES = 1 * MiB;
constexpr size_t WS_MOD = 1 * MiB;
constexpr size_t WS_TOPE = 2 * MiB, WS_POS = 2 * MiB + 512 * 1024, WS_TOPP = 3 * MiB, WS_LIST = 4 * MiB;
constexpr size_t WS_WIN = 8 * MiB, WS_WGLU = 20 * MiB, WS_WA = 21 * MiB, WS_WB = 23 * MiB, WS_WO = 24 * MiB, WS_WEIN = 26 * MiB, WS_WEOUT = 90 * MiB, WS_PROJ8 = 122 * MiB;
constexpr size_t WS_R0 = 218 * MiB;
constexpr size_t WS_PROJ = WS_R0, WS_H1 = 609 * MiB, WS_QKC = 677 * MiB, WS_HDIR = 745 * MiB, WS_YDIR = 873 * MiB, WS_END = 937 * MiB;
constexpr size_t WS_A1 = WS_H1, WS_A2 = WS_QKC, WS_A3 = WS_QKC + 32 * MiB, WS_YA = WS_HDIR, WS_MERGED = WS_HDIR + 64 * MiB;
constexpr size_t WS_GS = 940 * MiB, WS_X1 = 940 * MiB, WS_END2 = 1004 * MiB;
constexpr size_t WS_H2 = WS_R0, WS_ACT = 282 * MiB, WS_Y = 554 * MiB;
static_assert(WS_PROJ + (size_t)MT * LDP * 2 <= WS_H1 && WS_Y + (size_t)MAXTILES * 256 * 1024 * 2 <= WS_END, "ws map");
constexpr int CW_BAR = 4096, CW_CNT = 16384;

constexpr int RING_BYTES = 131072;
constexpr int LDSCTL_OFF = RING_BYTES, MISC_OFF = LDSCTL_OFF + 320, TAB_OFF = LDSCTL_OFF + 512;
constexpr int LDS_BYTES = 163840;

#define GAS __attribute__((address_space(1)))
#define LAS __attribute__((address_space(3)))
typedef unsigned short bf16;
typedef unsigned v4u __attribute__((ext_vector_type(4)));
typedef unsigned v2u __attribute__((ext_vector_type(2)));
typedef float f32x4 __attribute__((ext_vector_type(4)));
typedef float f32x16 __attribute__((ext_vector_type(16)));
typedef short bf16x8 __attribute__((ext_vector_type(8)));
typedef GAS unsigned gu32;
#define RLX_AGENT __ATOMIC_RELAXED, __HIP_MEMORY_SCOPE_AGENT
#define LDS_WAIT() asm volatile("s_waitcnt lgkmcnt(0)" ::: "memory")
#define LBAR() do { asm volatile("s_waitcnt lgkmcnt(0)" ::: "memory"); __builtin_amdgcn_s_barrier(); asm volatile("" ::: "memory"); } while (0)
__device__ __forceinline__ unsigned f2bf(float f) { unsigned u = __builtin_bit_cast(unsigned, f); return (u + 0x7fffu + ((u >> 16) & 1u)) >> 16; }
typedef __bf16 bf16x2_t __attribute__((ext_vector_type(2)));
__device__ __forceinline__ unsigned cvtpk(float lo, float hi) { const bf16x2_t v = {(__bf16)lo, (__bf16)hi}; return __builtin_bit_cast(unsigned, v); }
__device__ __forceinline__ unsigned pk2(float lo, float hi) { return cvtpk(lo, hi); }
__device__ __forceinline__ float clamp448(float x) { return fminf(fmaxf(x, -448.0f), 448.0f); }
__device__ __forceinline__ unsigned pk4_fp8(float a, float b, float c, float d) {
    unsigned w = 0; w = __builtin_amdgcn_cvt_pk_fp8_f32(clamp448(a), clamp448(b), w, false); w = __builtin_amdgcn_cvt_pk_fp8_f32(clamp448(c), clamp448(d), w, true); return w; }
__device__ __forceinline__ float bf2f(unsigned b) { return __builtin_bit_cast(float, b << 16); }
__device__ __forceinline__ float bflo(unsigned w) { return __builtin_bit_cast(float, w << 16); }
__device__ __forceinline__ float bfhi(unsigned w) { return __builtin_bit_cast(float, w & 0xffff0000u); }
__device__ __forceinline__ float frcp(float x) { return __builtin_amdgcn_rcpf(x); }
__device__ __forceinline__ float sigmoidf_(float x) { return frcp(1.0f + __expf(-x)); }

#define XB_TMO      128
#define XB_XCNT(j)  (256  + 64 * (j))
#define XB_XSUB(j)  (1280 + 64 * (j))
#define XB_XGEN(j)  (2304 + 64 * (j))
#define XB_TOP      3328
#define XB_TOPGEN   3392
#define XCD_BAR_WORDS 3456
#define XB_SPIN_CAP (1u << 22)
__device__ __forceinline__ unsigned xb_ld(unsigned* p)              { return __hip_atomic_load(p, __ATOMIC_RELAXED, __HIP_MEMORY_SCOPE_AGENT); }
__device__ __forceinline__ unsigned xb_add(unsigned* p, unsigned v) { return __hip_atomic_fetch_add(p, v, __ATOMIC_RELAXED, __HIP_MEMORY_SCOPE_AGENT); }
__device__ __forceinline__ unsigned xb_xcc_id() { return (unsigned)__builtin_amdgcn_s_getreg((3 << 11) | 20) & 0xFu; }
#define XB_SPIN(cond, bar) do { unsigned _sp = 0; while (cond) { __builtin_amdgcn_s_sleep(1); \
    if ((++_sp & 255u) == 0u) { if (xb_ld(&(bar)[XB_TMO])) break; if (_sp > XB_SPIN_CAP) { atomicAdd(&(bar)[XB_TMO], 1u); break; } } } } while (0)
struct XcdBarrier { unsigned* bar; unsigned x; volatile LAS unsigned* st; };
__device__ __forceinline__ XcdBarrier xcd_barrier_post(unsigned* bar, volatile LAS unsigned* st) {
    XcdBarrier b; b.bar = bar; b.x = xb_xcc_id(); b.st = st;
    if (threadIdx.x == 0) (void)xb_add(&bar[XB_XCNT(b.x)], 1u);
    return b;
}
__device__ __forceinline__ void xcd_barrier_complete(unsigned* bar, unsigned x, unsigned& nloc, unsigned& nx) {
    const unsigned G = gridDim.x * gridDim.y * gridDim.z;
    unsigned sum, cnt, mine, sp = 0u;
    for (;;) {
        sum = 0u; cnt = 0u; mine = 0u;
#pragma unroll
        for (unsigned j = 0; j < 16; ++j) { const unsigned c = xb_ld(&bar[XB_XCNT(j)]); sum += c; cnt += (c > 0u) ? 1u : 0u; mine = (j == x) ? c : mine; }
        if (sum == G) break;
        __builtin_amdgcn_s_sleep(1);
        if ((++sp & 255u) == 0u) { if (xb_ld(&bar[XB_TMO])) break; if (sp > XB_SPIN_CAP) { atomicAdd(&bar[XB_TMO], 1u); break; } }
    }
    nloc = mine > 0u ? mine : 1u; nx = cnt > 0u ? cnt : 1u;
}
__device__ __forceinline__ void xcd_barrier(const XcdBarrier& b) {
    asm volatile("s_waitcnt vmcnt(0)" ::: "memory");
    __syncthreads();
    if (threadIdx.x == 0) {
        unsigned* bar = b.bar;
        __builtin_amdgcn_s_waitcnt(0);
        unsigned nloc = b.st[0], nx = b.st[1];
        if (nloc == 0u) { xcd_barrier_complete(bar, b.x, nloc, nx); b.st[0] = nloc; b.st[1] = nx; }
        const unsigned old = xb_add(&bar[XB_XSUB(b.x)], 1u);
        const unsigned gen = old / nloc;
        if (old + 1u == (gen + 1u) * nloc) {
            __builtin_amdgcn_fence(__ATOMIC_RELEASE, "agent");
            asm volatile("s_waitcnt vmcnt(0)" ::: "memory");
            const unsigned og = xb_add(&bar[XB_TOP], 1u);
            const unsigned tg = og / nx;
            if (og + 1u == (tg + 1u) * nx) xb_add(&bar[XB_TOPGEN], 1u);
            else XB_SPIN(xb_ld(&bar[XB_TOPGEN]) == tg, bar);
            __builtin_amdgcn_fence(__ATOMIC_ACQUIRE, "agent");
            xb_add(&bar[XB_XGEN(b.x)], 1u);
            asm volatile("s_waitcnt vmcnt(0)" ::: "memory");
        } else {
            XB_SPIN(xb_ld(&bar[XB_XGEN(b.x)]) == gen, bar);
            __builtin_amdgcn_fence(__ATOMIC_ACQUIRE, "agent");
            asm volatile("s_waitcnt vmcnt(0)" ::: "memory");
        }
    }
    __syncthreads();
}

struct Frame {
    LAS unsigned char* lds;
    gu32* ctl;
    int tid, lane, wave, vcu, G;
    float* out; unsigned char* ws;
};
__device__ __forceinline__ float wave_sum(float v) {
#pragma unroll
    for (int o = 1; o < 64; o <<= 1) v += __shfl_xor(v, o);
    return v;
}

struct InProjOrder {
    int G, c;
    __device__ __forceinline__ bool next(int i, pg8::Unit& u) const {
        const int NL = 128 * 23, NC = 8 * 11;
        const long L = (long)i * G + c; if (L >= NL + NC) return false;
        u.lbase = 0; u.nvalid = 0;
        if (L < NL) { const int wgid = pg8::xcd_remap((int)L, NL); const int nig = 8 * 23, gid = wgid / nig, fm = gid * 8; u.pm = fm + ((wgid % nig) % 8); u.pn = (wgid % nig) / 8; }
        else { const int r = (int)L - NL; u.pm = 128 + r / 11; const int q = r % 11; u.pn = q < 10 ? q : 22; }
        return true;
    }
};
struct MoeOrder {
    int G, c, npn; const LAS int* tab;
    __device__ __forceinline__ bool next(int i, pg8::Unit& u) const {
        const int nT = __builtin_amdgcn_readfirstlane(tab[32]); const int nU = nT * npn;
        const long L = (long)i * G + c; if (L >= nU) return false;
        const int wgid = pg8::xcd_remap((int)L, nU);
        const int tau = wgid / npn, pl = wgid % npn;
        int e = 0;
        for (int k = 1; k < 32; ++k) e += (__builtin_amdgcn_readfirstlane(tab[k]) <= tau) ? 1 : 0;
        const int il = tau - __builtin_amdgcn_readfirstlane(tab[e]);
        u.pm = tau; u.pn = e * npn + pl; u.lbase = e * ML + 256 * il; u.nvalid = __builtin_amdgcn_readfirstlane(tab[33 + e]) - 256 * il;
        return true;
    }
};
__device__ __forceinline__ void moe_tables(Frame& F) {
    LAS int* tab = (LAS int*)(F.lds + TAB_OFF);
    __syncthreads();
    if (F.tid < 32) tab[33 + F.tid] = (int)__hip_atomic_load(F.ctl + CW_CNT + 64 * F.tid, RLX_AGENT);
    __syncthreads();
    if (F.tid == 0) {
        int acc = 0;
        for (int e = 0; e < 32; ++e) { tab[e] = acc; acc += (tab[33 + e] + 255) >> 8; }
        tab[32] = acc;
    }
    __syncthreads();
}

using pg8::f32x4; using pg8::u32x4; using pg8::cvt_pk_bf16;
#define EPI_ROWS(u) const int row0 = (u).pm * 256 + wr * 64 + fr
#define EPI_LOOP _Pragma("unroll") for (int ai = 0; ai < 2; ++ai) _Pragma("unroll") for (int m = 0; m < 4; ++m)
__device__ __forceinline__ u32x4 pack8(const f32x4 a, const f32x4 b) { u32x4 w; w.x = cvt_pk_bf16(a[0], a[1]); w.y = cvt_pk_bf16(a[2], a[3]); w.z = cvt_pk_bf16(b[0], b[1]); w.w = cvt_pk_bf16(b[2], b[3]); return w; }
__device__ __forceinline__ void unpack8(const u32x4 w, f32x4& a, f32x4& b) { a = (f32x4){bflo(w.x), bfhi(w.x), bflo(w.y), bfhi(w.y)}; b = (f32x4){bflo(w.z), bfhi(w.z), bflo(w.w), bfhi(w.w)}; }
__device__ __forceinline__ void unpack8_fp8(const v2u w, f32x4& a, f32x4& b) {
    const auto l0 = __builtin_amdgcn_cvt_pk_f32_fp8((int)w.x, false), h0 = __builtin_amdgcn_cvt_pk_f32_fp8((int)w.x, true), l1 = __builtin_amdgcn_cvt_pk_f32_fp8((int)w.y, false), h1 = __builtin_amdgcn_cvt_pk_f32_fp8((int)w.y, true);
    a = (f32x4){l0[0], l0[1], h0[0], h0[1]}; b = (f32x4){l1[0], l1[1], h1[0], h1[1]}; }
__device__ __forceinline__ v2u pack8_fp8(const f32x4 a, const f32x4 b) { return (v2u){pk4_fp8(a[0], a[1], a[2], a[3]), pk4_fp8(b[0], b[1], b[2], b[3])}; }
__device__ __forceinline__ f32x4 sig4(f32x4 x) { return (f32x4){sigmoidf_(x[0]), sigmoidf_(x[1]), sigmoidf_(x[2]), sigmoidf_(x[3])}; }

struct EpiStore {
    static constexpr bool PERM = true; bf16* O; int ldc; unsigned char* P8;
    __device__ __forceinline__ void operator()(const f32x4 (&acc)[2][2][4][2], const pg8::Unit& u, int wr, int wc, int fr, int fq) const {
        EPI_ROWS(u); const int col0 = u.pn * 256 + wc * 32 + 8 * fq;
        if (u.pn == 22 && wc != 0) return;
        if (u.pn >= 10 && u.pn < 22) {
            EPI_LOOP { unsigned char* rowp = P8 + (size_t)(row0 + ai * 128 + m * 16) * 3072 + (col0 - PC_O);
#pragma unroll
                for (int bj = 0; bj < 2; ++bj) *(v2u*)(rowp + bj * 128) = pack8_fp8(acc[ai][bj][m][0], acc[ai][bj][m][1]); }
            return; }
        EPI_LOOP { bf16* rowp = O + (size_t)(row0 + ai * 128 + m * 16) * ldc + col0;
#pragma unroll
            for (int bj = 0; bj < 2; ++bj) if (u.pn != 22 || bj == 0) *(u32x4*)(rowp + bj * 128) = pack8(acc[ai][bj][m][0], acc[ai][bj][m][1]); }
    }
};
struct EpiGlu {
    static constexpr bool PERM = true; const bf16* A2; bf16* A3; const float* bias;
    __device__ __forceinline__ void operator()(const f32x4 (&acc)[2][2][4][2], const pg8::Unit& u, int wr, int wc, int fr, int fq) const {
        EPI_ROWS(u); const int col0 = u.pn * 256 + wc * 32 + 8 * fq;
        f32x4 bv[2][2];
#pragma unroll
        for (int bj = 0; bj < 2; ++bj)
#pragma unroll
            for (int n = 0; n < 2; ++n) bv[bj][n] = *(const f32x4*)(bias + col0 + bj * 128 + 4 * n);
#pragma unroll
        for (int ai = 0; ai < 2; ++ai) {
            v2u ld[4][2];
#pragma unroll
            for (int m = 0; m < 4; ++m)
#pragma unroll
                for (int bj = 0; bj < 2; ++bj) ld[m][bj] = *(const v2u*)((const unsigned char*)A2 + (size_t)(row0 + ai * 128 + m * 16) * 512 + col0 + bj * 128);
            __builtin_amdgcn_sched_barrier(0);
#pragma unroll
            for (int m = 0; m < 4; ++m)
#pragma unroll
                for (int bj = 0; bj < 2; ++bj) { f32x4 a0, a1; unpack8_fp8(ld[m][bj], a0, a1);
                    const f32x4 v0 = a0 * sig4(acc[ai][bj][m][0] + bv[bj][0]), v1 = a1 * sig4(acc[ai][bj][m][1] + bv[bj][1]);
                    *(v2u*)((unsigned char*)A3 + (size_t)(row0 + ai * 128 + m * 16) * 512 + col0 + bj * 128) = pack8_fp8(v0, v1); }
        }
    }
};
template <bool ADD> struct EpiGate {
    static constexpr bool PERM = true; const unsigned char* proj; int gc0; const float* bg; const bf16* Prev; bf16* O;
    __device__ __forceinline__ void operator()(const f32x4 (&acc)[2][2][4][2], const pg8::Unit& u, int wr, int wc, int fr, int fq) const {
        EPI_ROWS(u); const int col0 = u.pn * 256 + wc * 32 + 8 * fq;
        f32x4 bv[2][2];
#pragma unroll
        for (int bj = 0; bj < 2; ++bj)
#pragma unroll
            for (int n = 0; n < 2; ++n) bv[bj][n] = *(const f32x4*)(bg + col0 + bj * 128 + 4 * n);
        constexpr int MB = ADD ? 2 : 4;
#pragma unroll
        for (int g = 0; g < 8 / MB; ++g) {
            v2u lg[MB][2]; u32x4 lp[MB][2];
#pragma unroll
            for (int mm = 0; mm < MB; ++mm)
#pragma unroll
                for (int bj = 0; bj < 2; ++bj) { const int q = g * MB + mm, row = row0 + (q >> 2) * 128 + (q & 3) * 16; lg[mm][bj] = *(const v2u*)(proj + (size_t)row * 3072 + gc0 + col0 + bj * 128);
                    if (ADD) lp[mm][bj] = *(const u32x4*)(Prev + (size_t)row * 1024 + col0 + bj * 128); }
            __builtin_amdgcn_sched_barrier(0);
#pragma unroll
            for (int mm = 0; mm < MB; ++mm)
#pragma unroll
                for (int bj = 0; bj < 2; ++bj) { const int q = g * MB + mm, ai = q >> 2, m = q & 3; f32x4 g0, g1; unpack8_fp8(lg[mm][bj], g0, g1);
                    f32x4 v0 = sig4(g0 + bv[bj][0]) * acc[ai][bj][m][0], v1 = sig4(g1 + bv[bj][1]) * acc[ai][bj][m][1];
                    if (ADD) { f32x4 p0, p1; unpack8(lp[mm][bj], p0, p1); v0 += p0; v1 += p1; }
                    if (ADD) *(v2u*)((unsigned char*)O + (size_t)(row0 + ai * 128 + m * 16) * 1024 + col0 + bj * 128) = pack8_fp8(v0 * 4.0f, v1 * 4.0f);
                    else *(u32x4*)(O + (size_t)(row0 + ai * 128 + m * 16) * 1024 + col0 + bj * 128) = pack8(v0, v1); }
            __builtin_amdgcn_sched_barrier(0);
        }
    }
};
struct EpiX1 {
    static constexpr bool PERM = true; const float* x; const float* mod; bf16* X1;
    __device__ __forceinline__ void operator()(const f32x4 (&acc)[2][2][4][2], const pg8::Unit& u, int wr, int wc, int fr, int fq) const {
        EPI_ROWS(u); const int col0 = u.pn * 256 + wc * 32 + 8 * fq; const int b = (u.pm * 256) / SEQ;
        f32x4 gv[2][2];
#pragma unroll
        for (int bj = 0; bj < 2; ++bj)
#pragma unroll
            for (int n = 0; n < 2; ++n) gv[bj][n] = *(const f32x4*)(mod + b * 6144 + 2 * D + col0 + bj * 128 + 4 * n);
#pragma unroll
        for (int g = 0; g < 4; ++g) {
            f32x4 lx[2][2][2];
#pragma unroll
            for (int mm = 0; mm < 2; ++mm)
#pragma unroll
                for (int bj = 0; bj < 2; ++bj) { const int q = g * 2 + mm; const size_t off = (size_t)(row0 + (q >> 2) * 128 + (q & 3) * 16) * D + col0 + bj * 128; lx[mm][bj][0] = *(const f32x4*)(x + off); lx[mm][bj][1] = *(const f32x4*)(x + off + 4); }
            __builtin_amdgcn_sched_barrier(0);
#pragma unroll
            for (int mm = 0; mm < 2; ++mm)
#pragma unroll
                for (int bj = 0; bj < 2; ++bj) { const int q = g * 2 + mm, ai = q >> 2, m = q & 3; const size_t off = (size_t)(row0 + ai * 128 + m * 16) * D + col0 + bj * 128;
                    *(u32x4*)(X1 + off) = pack8(lx[mm][bj][0] + gv[bj][0] * acc[ai][bj][m][0], lx[mm][bj][1] + gv[bj][1] * acc[ai][bj][m][1]); }
            __builtin_amdgcn_sched_barrier(0);
        }
    }
};
struct EpiSwiglu {
    static constexpr bool PERM = true; const float* bin; bf16* ACT;
    __device__ __forceinline__ void operator()(const f32x4 (&acc)[2][2][4][2], const pg8::Unit& u, int wr, int wc, int fr, int fq) const {
        EPI_ROWS(u); const int e = u.pn >> 3, pl = u.pn & 7; const int f0 = pl * 128 + wc * 32 + 8 * fq;
        f32x4 bg[2], bl[2];
#pragma unroll
        for (int n = 0; n < 2; ++n) { bg[n] = *(const f32x4*)(bin + e * 2048 + f0 + 4 * n); bl[n] = *(const f32x4*)(bin + e * 2048 + 1024 + f0 + 4 * n); }
        EPI_LOOP { f32x4 o[2];
#pragma unroll
            for (int n = 0; n < 2; ++n) { const f32x4 zg = acc[ai][0][m][n] + bg[n], zl = acc[ai][1][m][n] + bl[n];
#pragma unroll
                for (int j = 0; j < 4; ++j) { const float gl = fminf(zg[j], 7.0f); const float li8 = __builtin_fmaf(__builtin_amdgcn_fmed3f(zl[j], -7.0f, 7.0f), 8.0f, 8.0f);
                    o[n][j] = gl * frcp(1.0f + __builtin_amdgcn_exp2f(gl * -2.45546696f)) * li8; } }
            unsigned w0 = 0, w1 = 0;
            w0 = __builtin_amdgcn_cvt_pk_fp8_f32(o[0][0], o[0][1], w0, false); w0 = __builtin_amdgcn_cvt_pk_fp8_f32(o[0][2], o[0][3], w0, true);
            w1 = __builtin_amdgcn_cvt_pk_fp8_f32(o[1][0], o[1][1], w1, false); w1 = __builtin_amdgcn_cvt_pk_fp8_f32(o[1][2], o[1][3], w1, true);
            *(v2u*)((unsigned char*)ACT + (size_t)(row0 + ai * 128 + m * 16) * 1024 + f0) = (v2u){w0, w1}; }
    }
};
struct EpiY {
    static constexpr bool PERM = true; const float* bout; bf16* Y;
    __device__ __forceinline__ void operator()(const f32x4 (&acc)[2][2][4][2], const pg8::Unit& u, int wr, int wc, int fr, int fq) const {
        EPI_ROWS(u); const int e = u.pn >> 2, pl = u.pn & 3; const int col0 = pl * 256 + wc * 32 + 8 * fq;
        f32x4 bv[2][2];
#pragma unroll
        for (int bj = 0; bj < 2; ++bj)
#pragma unroll
            for (int n = 0; n < 2; ++n) bv[bj][n] = *(const f32x4*)(bout + e * 1024 + col0 + bj * 128 + 4 * n);
        EPI_LOOP { unsigned char* rowp = (unsigned char*)Y + (size_t)(row0 + ai * 128 + m * 16) * 1024 + col0;
#pragma unroll
            for (int bj = 0; bj < 2; ++bj) { const f32x4 v0 = (acc[ai][bj][m][0] + bv[bj][0]) * 16.0f, v1 = (acc[ai][bj][m][1] + bv[bj][1]) * 16.0f;
                *(v2u*)(rowp + bj * 128) = (v2u){pk4_fp8(v0[0], v0[1], v0[2], v0[3]), pk4_fp8(v1[0], v1[1], v1[2], v1[3])}; } }
    }
};

struct TItem { const float* src; bf16* dst; int ld, ldk; int f8; };
__device__ __forceinline__ void titem_load(const TItem& t, int lane, f32x4 (&r)[8]) {
#pragma unroll
    for (int i = 0; i < 8; ++i) r[i] = *(const f32x4*)(t.src + (size_t)(8 * i + (lane >> 3)) * t.ld + 4 * (lane & 7));
}
__device__ __forceinline__ void titem_store(const TItem& t, int lane, const f32x4 (&r)[8], LAS float* scr) {
#pragma unroll
    for (int i = 0; i < 8; ++i) { LAS float* p = scr + (8 * i + (lane >> 3)) * 33 + 4 * (lane & 7); p[0] = r[i][0]; p[1] = r[i][1]; p[2] = r[i][2]; p[3] = r[i][3]; }
    LDS_WAIT(); asm volatile("" ::: "memory");
    const int c = lane & 7;
#pragma unroll
    for (int j = 0; j < 4; ++j) { const int n = (lane >> 3) + 8 * j; const LAS float* s = scr + (8 * c) * 33 + n;
        if (t.f8) { *(GAS v2u*)((unsigned char*)t.dst + (size_t)n * t.ldk + 8 * c) = (v2u){pk4_fp8(32.f * s[0 * 33], 32.f * s[1 * 33], 32.f * s[2 * 33], 32.f * s[3 * 33]), pk4_fp8(32.f * s[4 * 33], 32.f * s[5 * 33], 32.f * s[6 * 33], 32.f * s[7 * 33])}; }
        else { v4u o; o.x = pk2(s[0 * 33], s[1 * 33]); o.y = pk2(s[2 * 33], s[3 * 33]); o.z = pk2(s[4 * 33], s[5 * 33]); o.w = pk2(s[6 * 33], s[7 * 33]);
            *(GAS v4u*)(t.dst + (size_t)n * t.ldk + 8 * c) = o; } }
    LDS_WAIT(); asm volatile("" ::: "memory");
}
__device__ __forceinline__ void p0_prologue(Frame& F, const float* const* __restrict__ INP) {
    {
        LAS float* sc = (LAS float*)(F.lds);
        LAS float* red = (LAS float*)(F.lds + 9 * 1024 * 4);
        for (int i = F.tid; i < 9 * 1024; i += NWAVES * 64) { const int r = i >> 10, k = i & 1023; const float v = r < 8 ? INP[1][r * 1024 + k] : INP[3][k]; sc[i] = v / (1.0f + expf(-v)); }
        __syncthreads();
        const float* wada = INP[4]; const float* bada = INP[5];
        float* mod = (float*)(F.ws + WS_MOD);
        for (int cg = blockIdx.x; cg < 256; cg += F.G) {
            const int j0 = cg * 24, col = F.lane & 31, kp = F.lane >> 5;
            float a[9];
#pragma unroll
            for (int r = 0; r < 9; ++r) a[r] = 0.f;
            if (col < 24) {
#pragma unroll 16
                for (int i = 0; i < 64; ++i) { const int k = F.wave * 128 + 2 * i + kp; const float wv = wada[(size_t)k * 6144 + j0 + col];
#pragma unroll
                    for (int r = 0; r < 9; ++r) a[r] += sc[r * 1024 + k] * wv; }
            }
#pragma unroll
            for (int r = 0; r < 9; ++r) red[((F.wave * 2 + kp) * 9 + r) * 32 + col] = a[r];
            __syncthreads();
            if (F.tid < 9 * 32) { const int r = F.tid >> 5, cc = F.tid & 31;
                if (cc < 24) { float s = 0.f; for (int p = 0; p < 16; ++p) s += red[(p * 9 + r) * 32 + cc]; const int j = j0 + cc; s += bada[j];
                    if (r < 8) mod[r * 6144 + j] = s; else if (j < 2048) mod[8 * 6144 + j] = s; } }
            __syncthreads();
        }
    }
    LAS float* scr = (LAS float*)(F.lds + F.wave * 16384);
    const int gw = F.vcu * NWAVES + F.wave, NGW = F.G * NWAVES;
    bf16* WIN = (bf16*)(F.ws + WS_WIN); bf16* WGLU = (bf16*)(F.ws + WS_WGLU); bf16* WA = (bf16*)(F.ws + WS_WA); bf16* WB = (bf16*)(F.ws + WS_WB); bf16* WO = (bf16*)(F.ws + WS_WO);
    bf16* WEIN = (bf16*)(F.ws + WS_WEIN); bf16* WEOUT = (bf16*)(F.ws + WS_WEOUT);
    constexpr int I_IN = 177 * 16, I_GLU = 16 * 8, I_A = 32 * 16, I_B = 32 * 8, I_O = 32 * 16, I_EIN = 32 * 64 * 16, I_EOUT = 32 * 32 * 16;
    constexpr int NITEMS = I_IN + I_GLU + I_A + I_B + I_O + I_EIN + I_EOUT;
#define P0_DECODE(it_, T) do { int r = (it_); \
        if (r < I_IN) { const int kb = r / 177, nb = r % 177, n0 = nb * 32; const int sc0 = n0 < 2048 ? n0 : (n0 < 5632 ? n0 + 32 : 2048); \
            T.src = INP[8] + (size_t)kb * 64 * 5664 + sc0; T.ld = 5664; T.dst = (bf16*)((unsigned char*)WIN + (size_t)n0 * 1024 + kb * 64); T.ldk = 1024; T.f8 = 1; break; } r -= I_IN; \
        if (r < I_GLU) { const int kb = r / 16, nb = r % 16; T.src = INP[21] + (size_t)kb * 64 * 512 + nb * 32; T.ld = 512; T.dst = (bf16*)((unsigned char*)WGLU + (size_t)nb * 32 * 512 + kb * 64); T.ldk = 512; T.f8 = 1; break; } r -= I_GLU; \
        if (r < I_A) { const int kb = r / 32, nb = r % 32; T.src = INP[12] + (size_t)kb * 64 * 1024 + nb * 32; T.ld = 1024; T.dst = (bf16*)((unsigned char*)WA + (size_t)nb * 32 * 1024 + kb * 64); T.ldk = 1024; T.f8 = 1; break; } r -= I_A; \
        if (r < I_B) { const int kb = r / 32, nb = r % 32; T.src = INP[23] + (size_t)kb * 64 * 1024 + nb * 32; T.ld = 1024; T.dst = (bf16*)((unsigned char*)WB + (size_t)nb * 32 * 512 + kb * 64); T.ldk = 512; T.f8 = 1; break; } r -= I_B; \
        if (r < I_O) { const int kb = r / 32, nb = r % 32; T.src = INP[25] + (size_t)kb * 64 * 1024 + nb * 32; T.ld = 1024; T.dst = (bf16*)((unsigned char*)WO + (size_t)nb * 32 * 1024 + kb * 64); T.ldk = 1024; T.f8 = 1; break; } r -= I_O; \
        if (r < I_EIN) { const int e = r / 1024, q = r % 1024, kb = q / 64, nb = q % 64; const int dr = nb * 32, pn = dr >> 8, bj = (dr >> 7) & 1, xx = dr & 127; \
            T.src = INP[28] + (size_t)e * 1024 * 2048 + (size_t)kb * 64 * 2048 + bj * 1024 + pn * 128 + xx; T.ld = 2048; T.dst = (bf16*)((unsigned char*)WEIN + (size_t)e * 2048 * 1024 + (size_t)dr * 1024 + kb * 64); T.ldk = 1024; T.f8 = 1; break; } r -= I_EIN; \
        { const int e = r / 512, q = r % 512, kb = q / 32, nb = q % 32; \
            T.src = INP[30] + (size_t)e * 1024 * 1024 + (size_t)kb * 64 * 1024 + nb * 32; T.ld = 1024; T.dst = (bf16*)((unsigned char*)WEOUT + (size_t)e * 1024 * 1024 + (size_t)nb * 32 * 1024 + kb * 64); T.ldk = 1024; T.f8 = 1; } } while (0)
    {
        TItem ta, tb; f32x4 ra[8], rb[8];
        int it = gw;
        if (it < NITEMS - I_EIN - I_EOUT) { P0_DECODE(it, ta); titem_load(ta, F.lane, ra); }
        constexpr int NITEMS0 = NITEMS - I_EIN - I_EOUT;
        while (it < NITEMS0) {
            const int nx = it + NGW;
            if (nx < NITEMS0) { P0_DECODE(nx, tb); titem_load(tb, F.lane, rb); }
            titem_store(ta, F.lane, ra, scr);
            ta = tb;
#pragma unroll
            for (int i = 0; i < 8; ++i) ra[i] = rb[i];
            it = nx;
        }
    }
#undef P0_DECODE
    { const int gt = blockIdx.x * (NWAVES * 64) + F.tid, NT = F.G * NWAVES * 64; GAS v4u* z = (GAS v4u*)((unsigned char*)WIN + (size_t)5664 * 1024);
        for (int i = gt; i < 224 * 1024 / 16; i += NT) z[i] = (v4u){0u, 0u, 0u, 0u}; }
}

__device__ __forceinline__ void p1_norm1(Frame& F, const float* const* __restrict__ INP) {
    const int gw = F.vcu * NWAVES + F.wave, NGW = F.G * NWAVES;
    const float* mod = (const float*)(F.ws + WS_MOD); bf16* H1 = (bf16*)(F.ws + WS_H1);
    for (int m = gw; m < MT; m += NGW) {
        const float* xr; const float* sh; const float* scl;
        if (m < ML) { const int b = m / SEQ; xr = INP[0] + (size_t)m * D; sh = mod + b * 6144; scl = sh + D; }
        else { xr = INP[2] + (size_t)(m - ML) * D; sh = mod + 8 * 6144; scl = sh + D; }
        f32x4 v[4]; float s = 0.f;
#pragma unroll
        for (int j = 0; j < 4; ++j) { v[j] = *(const f32x4*)(xr + 256 * j + 4 * F.lane); s += (v[j][0] * v[j][0] + v[j][1] * v[j][1]) + (v[j][2] * v[j][2] + v[j][3] * v[j][3]); }
        const float rstd = 1.0f / sqrtf(wave_sum(s) * (1.0f / D) + EPS);
#pragma unroll
        for (int j = 0; j < 4; ++j) { const int c = 256 * j + 4 * F.lane; const f32x4 g = *(const f32x4*)(INP[6] + c), a = *(const f32x4*)(scl + c), bb = *(const f32x4*)(sh + c);
            const f32x4 y = v[j] * rstd * g * (a + 1.0f) + bb;
            *(unsigned*)((unsigned char*)H1 + (size_t)m * D + c) = pk4_fp8(y[0], y[1], y[2], y[3]); }
    }
}

__device__ __forceinline__ void conv_fma8(float (&a)[8], const v4u x, const float* wp) {
    const f32x4 w0 = *(const f32x4*)(wp), w1 = *(const f32x4*)(wp + 4);
    a[0] += bflo(x.x) * w0[0]; a[1] += bfhi(x.x) * w0[1]; a[2] += bflo(x.y) * w0[2]; a[3] += bfhi(x.y) * w0[3];
    a[4] += bflo(x.z) * w1[0]; a[5] += bfhi(x.z) * w1[1]; a[6] += bflo(x.w) * w1[2]; a[7] += bfhi(x.w) * w1[3];
}
__device__ __forceinline__ void p3_conv(Frame& F, const float* const* __restrict__ INP) {
    const bf16* PROJ = (const bf16*)(F.ws + WS_PROJ); bf16* QKC = (bf16*)(F.ws + WS_QKC); const float* wc = INP[9];
    const int NT = F.G * NWAVES * 64;
    for (int it = F.vcu * (NWAVES * 64) + F.tid; it < NB * 64 * 16 * 128; it += NT) {
        const int ch0 = (it & 127) * 8, seg = (it >> 7) & 15, gr = (it >> 11) & 63, b = it >> 17, c0 = seg * 4;
        const bf16* base = PROJ + (size_t)(b * SEQ) * LDP + ch0;
        const float scale = ch0 < 512 ? 0.125f : 1.0f;
        v4u win[6][3];
        const v4u z = (v4u){0u, 0u, 0u, 0u};
#pragma unroll
        for (int cc = 0; cc < 6; ++cc)
#pragma unroll
            for (int ky = 0; ky < 3; ++ky) { const int rr = gr + ky - 1, c = c0 + cc - 1;
                win[cc][ky] = (rr >= 0 && rr < 64 && c >= 0 && c < 64) ? *(const v4u*)(base + (size_t)(rr * 64 + c) * LDP) : z; }
        __builtin_amdgcn_sched_barrier(0);
        float a[4][8];
#pragma unroll
        for (int cc = 0; cc < 4; ++cc)
#pragma unroll
            for (int j = 0; j < 8; ++j) a[cc][j] = 0.f;
#pragma unroll
        for (int ky = 0; ky < 3; ++ky)
#pragma unroll
            for (int kx = 0; kx < 3; ++kx) {
                const f32x4 w0 = *(const f32x4*)(wc + (ky * 3 + kx) * 1024 + ch0), w1 = *(const f32x4*)(wc + (ky * 3 + kx) * 1024 + ch0 + 4);
#pragma unroll
                for (int cc = 0; cc < 4; ++cc) { const v4u x = win[cc + kx][ky];
                    a[cc][0] += bflo(x.x) * w0[0]; a[cc][1] += bfhi(x.x) * w0[1]; a[cc][2] += bflo(x.y) * w0[2]; a[cc][3] += bfhi(x.y) * w0[3];
                    a[cc][4] += bflo(x.z) * w1[0]; a[cc][5] += bfhi(x.z) * w1[1]; a[cc][6] += bflo(x.w) * w1[2]; a[cc][7] += bfhi(x.w) * w1[3]; }
                asm volatile("" ::: "memory");
            }
#pragma unroll
        for (int cc = 0; cc < 4; ++cc) {
#pragma unroll
            for (int j = 0; j < 8; ++j) a[cc][j] = a[cc][j] * frcp(1.0f + __expf(-a[cc][j])) * scale;
            *(v4u*)(QKC + (size_t)(b * SEQ + gr * 64 + c0 + cc) * 1024 + ch0) = (v4u){pk2(a[cc][0], a[cc][1]), pk2(a[cc][2], a[cc][3]), pk2(a[cc][4], a[cc][5]), pk2(a[cc][6], a[cc][7])};
        }
    }
    for (int w = F.vcu * (NWAVES * 64) + F.tid; w < MC * 128; w += NT) {
        const int row = ML + (w >> 7), ch0 = (w & 127) * 8, t = (w >> 7) % CTXL;
        float a[8];
#pragma unroll
        for (int j = 0; j < 8; ++j) a[j] = 0.f;
#pragma unroll
        for (int kx = 0; kx < 3; ++kx) { const int tt = t + kx - 1;
            if (tt >= 0 && tt < CTXL) conv_fma8(a, *(const v4u*)(PROJ + (size_t)(row + kx - 1) * LDP + ch0), wc + (3 + kx) * 1024 + ch0); }
        const float scale = ch0 < 512 ? 0.125f : 1.0f;
#pragma unroll
        for (int j = 0; j < 8; ++j) a[j] = a[j] * frcp(1.0f + __expf(-a[j])) * scale;
        *(v4u*)(QKC + (size_t)row * 1024 + ch0) = (v4u){pk2(a[0], a[1]), pk2(a[2], a[3]), pk2(a[4], a[5]), pk2(a[6], a[7])};
    }
    {
        float* GB = (float*)(F.ws + WS_GS); float* GG = GB + 128 * 4352; float* GP = GG + 128 * 4352;
        const int gw = F.vcu * NWAVES + F.wave, NGW = F.G * NWAVES, lane = F.lane;
        for (int it = gw; it < 128 * 34; it += NGW) {
            const int jc = it % 34, dbh = it / 34, h = dbh & 7, b = (dbh >> 3) & 7, d = dbh >> 6;
            const bool lat = jc >= 2; const int p0 = lat ? 128 * (jc - 2) : 128 * jc, Lseq = lat ? SEQ : CTXL, rowbase = lat ? b * SEQ : ML + b * CTXL;
            const float bi_ = INP[10][d * 16 + h], bf_ = INP[10][d * 16 + 8 + h];
            float li2[2], lf2[2];
#pragma unroll
            for (int e = 0; e < 2; ++e) { const int sp = 2 * lane + e; const int tt = d ? (Lseq - 1 - (p0 + sp)) : (p0 + sp); const size_t row = (size_t)(rowbase + tt);
                li2[e] = bf2f(PROJ[row * LDP + PC_IF + d * 16 + h]) + bi_; const float xf = bf2f(PROJ[row * LDP + PC_IF + d * 16 + 8 + h]) + bf_;
                lf2[e] = fminf(xf, 0.f) - log1pf(expf(-fabsf(xf))); }
            const float c1 = lf2[0] + lf2[1]; float inc = c1;
#pragma unroll
            for (int o = 1; o < 64; o <<= 1) { const float t = __shfl_up(inc, o); if (lane >= o) inc += t; }
            const float exc = inc - c1, b0 = exc + lf2[0], b1 = exc + c1, g0 = li2[0] - b0, g1 = li2[1] - b1;
            float pmx = fmaxf(g0, g1);
#pragma unroll
            for (int o = 1; o < 64; o <<= 1) { const float t = __shfl_up(pmx, o); if (lane >= o) pmx = fmaxf(pmx, t); }
            float pex = __shfl_up(pmx, 1); if (lane == 0) pex = -INFINITY;
            const size_t o = (size_t)dbh * 4352 + 128 * jc + 2 * lane;
            *(float2*)(GB + o) = make_float2(b0, b1); *(float2*)(GG + o) = make_float2(g0, g1); *(float2*)(GP + o) = make_float2(fmaxf(pex, g0), pmx);
        }
    }
}

__device__ __forceinline__ void mma32_nt(f32x16& acc, const LAS bf16* A, int lda, const LAS bf16* Bt, int ldb, int K, int lane) {
    const int r = lane & 31, h = lane >> 5;
#pragma unroll
    for (int k0 = 0; k0 < K; k0 += 16) {
        const bf16x8 a = *(const LAS bf16x8*)(A + r * lda + k0 + 8 * h);
        const bf16x8 b = *(const LAS bf16x8*)(Bt + r * ldb + k0 + 8 * h);
        acc = __builtin_amdgcn_mfma_f32_32x32x16_bf16(a, b, acc, 0, 0, 0);
        if ((k0 & 63) == 48) __builtin_amdgcn_sched_barrier(0);
    }
}
__device__ __forceinline__ void mma16_nt(f32x4& acc, const LAS bf16* A, int lda, const LAS bf16* Bt, int ldb, int K, int lane) {
    const int r = lane & 15, q = lane >> 4;
    for (int k0 = 0; k0 < K; k0 += 32) {
        const bf16x8 a = *(const LAS bf16x8*)(A + r * lda + k0 + 8 * q);
        const bf16x8 b = *(const LAS bf16x8*)(Bt + r * ldb + k0 + 8 * q);
        acc = __builtin_amdgcn_mfma_f32_16x16x32_bf16(a, b, acc, 0, 0, 0);
    }
}
__device__ __forceinline__ int row32(int reg, int lane) { return (reg & 3) + 8 * (reg >> 2) + 4 * (lane >> 5); }
__device__ __forceinline__ float logsigmoidf_(float x) { return fminf(x, 0.f) - log1pf(expf(-fabsf(x))); }

typedef short s16x4 __attribute__((ext_vector_type(4)));
__device__ __forceinline__ s16x4 tr_read(const LAS bf16* p) { return __builtin_amdgcn_ds_read_tr16_b64_v4i16((LAS s16x4*)p); }
__device__ __forceinline__ bf16x8 tr_frag32_perm(const LAS bf16* T, int ld, int k0, int x0, int lane) {
    const int h = lane >> 5, i = lane & 15, q = i >> 2, p = i & 3, xb = 16 * ((lane >> 4) & 1);
    const LAS bf16* a = T + (k0 + 4 * h + q) * ld + x0 + xb + 4 * p;
    const s16x4 lo = tr_read(a), hi = tr_read(a + 8 * ld);
    return (bf16x8){lo[0], lo[1], lo[2], lo[3], hi[0], hi[1], hi[2], hi[3]};
}
__device__ __forceinline__ bf16x8 tr_frag16(const LAS bf16* T, int ld, int k0, int x0, int lane) {
    const int q4 = lane >> 4, i = lane & 15, q = i >> 2, p = i & 3;
    const LAS bf16* a = T + (k0 + 8 * q4 + q) * ld + x0 + 4 * p;
    const s16x4 lo = tr_read(a), hi = tr_read(a + 4 * ld);
    return (bf16x8){lo[0], lo[1], lo[2], lo[3], hi[0], hi[1], hi[2], hi[3]};
}
__device__ __forceinline__ v4u scale8(const v4u k8, float ww) {
    return (v4u){pk2(ww * bflo(k8.x), ww * bfhi(k8.x)), pk2(ww * bflo(k8.y), ww * bfhi(k8.y)), pk2(ww * bflo(k8.z), ww * bfhi(k8.z)), pk2(ww * bflo(k8.w), ww * bfhi(k8.w))};
}

constexpr int XI_EIN = 32 * 64 * 16, XI_EOUT = 32 * 32 * 16, XI_PER_UNIT = (XI_EIN + XI_EOUT) / 256;
__device__ __forceinline__ void xitem_decode(const float* const* __restrict__ INP, unsigned char* ws, int r, const float*& src, int& ld, unsigned char*& dst) {
    if (r < XI_EIN) { const int e = r / 1024, q = r % 1024, kb = q / 64, nb = q % 64; const int dr = nb * 32, pn = dr >> 8, bj = (dr >> 7) & 1, xx = dr & 127;
        src = INP[28] + (size_t)e * 1024 * 2048 + (size_t)kb * 64 * 2048 + bj * 1024 + pn * 128 + xx; ld = 2048; dst = ws + WS_WEIN + (size_t)e * 2048 * 1024 + (size_t)dr * 1024 + kb * 64; }
    else { r -= XI_EIN; const int e = r / 512, q = r % 512, kb = q / 32, nb = q % 32;
        src = INP[30] + (size_t)e * 1024 * 1024 + (size_t)kb * 64 * 1024 + nb * 32; ld = 1024; dst = ws + WS_WEOUT + (size_t)e * 1024 * 1024 + (size_t)nb * 32 * 1024 + kb * 64; }
}
template <int MODE>
__device__ __forceinline__ void p4_mlstm(Frame& F, const float* const* __restrict__ INP, int unit) {
    const int vh = unit & 1, h = (unit >> 1) & 7, b = (unit >> 4) & 7, d = unit >> 7;
    LAS bf16* Qs = (LAS bf16*)(F.lds + 0);
    LAS bf16* Kw = (LAS bf16*)(F.lds + 36864);
    LAS bf16* Vs = (LAS bf16*)(F.lds + 55296);
    LAS bf16* Cb = (LAS bf16*)(F.lds + 73728);
    LAS float* vec = (LAS float*)(F.lds + 82944);
    LAS float *rowt = vec, *colt = vec + 128, *iev = vec + 256, *emt = vec + 384, *nv = vec + 512, *npart = vec + 576;
    const bf16* PROJ = (const bf16*)(F.ws + WS_PROJ); const bf16* QKC = (const bf16*)(F.ws + WS_QKC); unsigned char* HDIR = F.ws + WS_HDIR + (size_t)((((d * 8 + b) * 8 + h) * 2 + vh)) * SEQ * 64;
    const float* GB = (const float*)(F.ws + WS_GS) + (size_t)((d * 8 + b) * 8 + h) * 4352; const float* GG = GB + 128 * 4352; const float* GP = GG + 128 * 4352;
    int tid = F.tid; asm volatile("" : "+v"(tid));
    const int lane = tid & 63, w = F.wave;
    for (int i = tid; i < 64 * 72; i += 512) Cb[i] = 0;
    if (tid < 64) nv[tid] = 0.f;
    f32x4 accC[2] = {(f32x4){0.f, 0.f, 0.f, 0.f}, (f32x4){0.f, 0.f, 0.f, 0.f}};
    float m_old = 0.f, dec_prev = 0.f, sc_prev = 0.f;
    v4u pq[2], pk[2], pv[2]; float pgb = 0.f, pgp = 0.f, pgc = 0.f, pgg[2], pbend, pgmax; bool hpend = false; int hp0 = 0, hrb = 0, hL = 0;
    LAS unsigned char* Hst = F.lds + 140544;
    f32x4 xr[8]; v2u xo[4]; unsigned char* xdst = nullptr; unsigned char* xodst = nullptr; bool xload = false, xout = false;
    const int xw = w - 2;
    LAS float* xscr = (LAS float*)(F.lds + (xw < 5 ? 87296 + (xw < 0 ? 0 : xw) * 8448 : 132096));
    const int zl = tid >> 9;
#define ML_PREFETCH(jn) do { const bool lat_ = (jn) >= 2; const int p0_ = lat_ ? 128 * ((jn) - 2) : 128 * (jn), L_ = lat_ ? SEQ : CTXL, rb_ = lat_ ? b * SEQ : ML + b * CTXL; \
        _Pragma("unroll") for (int i = 0; i < 2; ++i) { const int id = tid + 512 * i, s_ = id >> 3, c_ = id & 7; const int tt = d ? (L_ - 1 - (p0_ + s_)) : (p0_ + s_); const size_t row = (size_t)(rb_ + tt); \
            pq[i] = *(const v4u*)(QKC + row * 1024 + h * 64 + c_ * 8); pk[i] = *(const v4u*)(QKC + row * 1024 + 512 + h * 64 + c_ * 8); pv[i] = *(const v4u*)(PROJ + row * LDP + PC_V + h * 128 + vh * 64 + c_ * 8); \
            pgg[i] = GG[128 * (jn) + s_]; } \
        if (tid < 128) { pgb = GB[128 * (jn) + tid]; pgp = GP[128 * (jn) + tid]; pgc = GG[128 * (jn) + tid]; } \
        pbend = GB[128 * (jn) + 127 + zl]; pgmax = GP[128 * (jn) + 127 + zl]; } while (0)
    ML_PREFETCH(0);
    __syncthreads();
    for (int j = 0; j < 34; ++j) {
        const bool lat = j >= 2;
        const int p0 = lat ? 128 * (j - 2) : 128 * j, Lseq = lat ? SEQ : CTXL, rowbase = lat ? b * SEQ : ML + b * CTXL;
        const float bend = pbend, gmax = pgmax;
        const float mnew = fmaxf(bend + m_old, bend + gmax), dec = __expf(bend + m_old - mnew);
#pragma unroll
        for (int i = 0; i < 2; ++i) { const int id = tid + 512 * i, s = id >> 3, c = id & 7;
            *(LAS v4u*)(Qs + s * 72 + c * 8) = pq[i]; *(LAS v4u*)(Vs + s * 72 + c * 8) = pv[i];
            *(LAS v4u*)(Kw + s * 72 + c * 8) = scale8(pk[i], __expf(pgg[i] - gmax)); }
        if (tid < 128) emt[tid] = __expf(-pgb - gmax);
        const float s0 = __expf(m_old - gmax), sc = __expf(bend + gmax - mnew);
        if (hpend) {
            { const int r = tid >> 2, c = tid & 3; const int tt = d ? (hL - 1 - (hp0 + r)) : (hp0 + r);
                *(v4u*)(HDIR + (size_t)tt * 64 + 16 * c) = *(const LAS v4u*)(Hst + r * 80 + 16 * c); }
            hpend = false; }
        if (j > 0) {
            const int vi = w >> 1;
#pragma unroll
            for (int jj = 0; jj < 2; ++jj) { const int ki = 2 * (w & 1) + jj;
#pragma unroll
                for (int reg = 0; reg < 4; ++reg) Cb[(16 * vi + (lane >> 4) * 4 + reg) * 72 + 16 * ki + (lane & 15)] = (bf16)cvtpk(accC[jj][reg], 0.f); }
            if (tid < 64) { float sacc = 0.f;
#pragma unroll
                for (int p = 0; p < 8; ++p) sacc += npart[p * 64 + tid];
                nv[tid] = dec_prev * nv[tid] + sc_prev * sacc; }
        }
        LBAR();
        if (j + 1 < 34 && !(MODE & 4)) ML_PREFETCH(j + 1);
        if (MODE == 0 && xw >= 0) {
            if (xout) {
#pragma unroll
                for (int q = 0; q < 4; ++q) *(GAS v2u*)(xodst + (size_t)(8 * q) * 1024) = xo[q];
                xout = false; }
            const int sl = j * 6 + xw;
            if (sl < XI_PER_UNIT) { const float* xsrc; int xld; xitem_decode(INP, F.ws, unit * XI_PER_UNIT + sl, xsrc, xld, xdst);
#pragma unroll
                for (int i = 0; i < 8; ++i) xr[i] = *(const f32x4*)(xsrc + (size_t)(8 * i + (lane >> 3)) * xld + 4 * (lane & 7));
                xload = true; }
        }
        if (lat && !(MODE & 1)) { const int tm = ((w >> 1) == 0 ? 3 : (w >> 1) == 1 ? 2 : (w >> 1) == 2 ? 0 : 1), vt = w & 1, tl = lane & 31, t = 32 * tm + tl, hh = lane >> 5; f32x16 acc;
#pragma unroll
            for (int reg = 0; reg < 16; ++reg) acc[reg] = 0.f;
            mma32_nt(acc, Cb + 32 * vt * 72, 72, Qs + 32 * tm * 72, 72, 64, lane);
#pragma unroll
            for (int reg = 0; reg < 16; ++reg) acc[reg] *= s0;
            float rs = 0.f;
            for (int st = (MODE & 8) ? tm : 0; st <= tm; ++st) {
                f32x16 X;
#pragma unroll
                for (int reg = 0; reg < 16; ++reg) X[reg] = 0.f;
                mma32_nt(X, Kw + 32 * st * 72, 72, Qs + 32 * tm * 72, 72, 64, lane);
                if (st == tm) { const int dlim = tl - 4 * hh;
#pragma unroll
                    for (int rg = 0; rg < 4; ++rg)
#pragma unroll
                        for (int e = 0; e < 4; ++e) { const float pvv = (8 * rg + e <= dlim) ? X[4 * rg + e] : 0.f; X[4 * rg + e] = pvv; rs += pvv; }
                } else {
#pragma unroll
                    for (int reg = 0; reg < 16; ++reg) rs += X[reg];
                }
#pragma unroll
                for (int ks = 0; ks < 2; ++ks) {
                    const v4u bw = (v4u){cvtpk(X[8 * ks], X[8 * ks + 1]), cvtpk(X[8 * ks + 2], X[8 * ks + 3]), cvtpk(X[8 * ks + 4], X[8 * ks + 5]), cvtpk(X[8 * ks + 6], X[8 * ks + 7])};
                    const bf16x8 af = tr_frag32_perm(Vs, 72, 32 * st + 16 * ks, 32 * vt, lane);
                    acc = __builtin_amdgcn_mfma_f32_32x32x16_bf16(af, __builtin_bit_cast(bf16x8, bw), acc, 0, 0, 0); }
            }
            float nq = 0.f;
#pragma unroll
            for (int q = 0; q < 4; ++q) { const v4u q8 = *(const LAS v4u*)(Qs + t * 72 + 32 * hh + 8 * q); const LAS float* nn = nv + 32 * hh + 8 * q;
                nq += bflo(q8.x) * nn[0] + bfhi(q8.x) * nn[1] + bflo(q8.y) * nn[2] + bfhi(q8.y) * nn[3] + bflo(q8.z) * nn[4] + bfhi(q8.z) * nn[5] + bflo(q8.w) * nn[6] + bfhi(q8.w) * nn[7]; }
            rs += __shfl_xor(rs, 32); nq += __shfl_xor(nq, 32);
            const float rd = 1.0f / fmaxf(fabsf(s0 * nq + rs), emt[t]);
            LAS unsigned char* hs = Hst + t * 80 + 32 * vt + 4 * hh; const float rd8 = rd * 8.0f;
#pragma unroll
            for (int rg = 0; rg < 4; ++rg) *(LAS unsigned*)(hs + 8 * rg) = pk4_fp8(acc[4 * rg] * rd8, acc[4 * rg + 1] * rd8, acc[4 * rg + 2] * rd8, acc[4 * rg + 3] * rd8); }
        if (lat && !(MODE & 1)) { hpend = true; hp0 = p0; hrb = rowbase; hL = Lseq; }
        if (!(MODE & 2)) { const int vi = w >> 1;
            f32x4 upd[2] = {(f32x4){0.f, 0.f, 0.f, 0.f}, (f32x4){0.f, 0.f, 0.f, 0.f}};
#pragma unroll
            for (int st4 = 0; st4 < 4; ++st4) { const bf16x8 af = tr_frag16(Vs, 72, 32 * st4, 16 * vi, lane);
#pragma unroll
                for (int jj = 0; jj < 2; ++jj) { const bf16x8 bfr = tr_frag16(Kw, 72, 32 * st4, 16 * (2 * (w & 1) + jj), lane); upd[jj] = __builtin_amdgcn_mfma_f32_16x16x32_bf16(af, bfr, upd[jj], 0, 0, 0); } }
            accC[0] = accC[0] * dec + upd[0] * sc; accC[1] = accC[1] * dec + upd[1] * sc; }
        { const int k = tid & 63, part = tid >> 6; float sacc = 0.f;
#pragma unroll
            for (int q = 0; q < 16; ++q) sacc += bf2f(Kw[(16 * part + q) * 72 + k]);
            npart[part * 64 + k] = sacc; }
        if (MODE == 0 && xw >= 0 && xload) {
#pragma unroll
            for (int i = 0; i < 8; ++i) { LAS float* p = xscr + (8 * i + (lane >> 3)) * 33 + 4 * (lane & 7); p[0] = xr[i][0]; p[1] = xr[i][1]; p[2] = xr[i][2]; p[3] = xr[i][3]; }
            LDS_WAIT(); asm volatile("" ::: "memory");
            const int c = lane & 7;
#pragma unroll
            for (int q = 0; q < 4; ++q) { const LAS float* sp = xscr + (8 * c) * 33 + (lane >> 3) + 8 * q;
                xo[q] = (v2u){pk4_fp8(32.f * sp[0 * 33], 32.f * sp[1 * 33], 32.f * sp[2 * 33], 32.f * sp[3 * 33]), pk4_fp8(32.f * sp[4 * 33], 32.f * sp[5 * 33], 32.f * sp[6 * 33], 32.f * sp[7 * 33])}; }
            xodst = xdst + (size_t)(lane >> 3) * 1024 + 8 * c; xout = true; xload = false;
        }
        m_old = mnew; dec_prev = dec; sc_prev = sc;
        LBAR();
    }
    if (MODE == 0 && xw >= 0 && xout) {
#pragma unroll
        for (int q = 0; q < 4; ++q) *(GAS v2u*)(xodst + (size_t)(8 * q) * 1024) = xo[q]; }
    if (hpend) {
        { const int r = tid >> 2, c = tid & 3; const int tt = d ? (hL - 1 - (hp0 + r)) : (hp0 + r);
            *(v4u*)(HDIR + (size_t)tt * 64 + 16 * c) = *(const LAS v4u*)(Hst + r * 80 + 16 * c); } }
#undef ML_PREFETCH
}

__device__ __forceinline__ void s5_disc(const float* const* __restrict__ INP, int d, int g, int p, float& ar, float& ai, float& cfr, float& cfi) {
    const float dt = expf(INP[15][d * 32 + g]); const float are = INP[13][(d * 32 + g) * 64 + p], aim = INP[14][(d * 32 + g) * 64 + p];
    const float mag = expf(dt * are), ang = dt * aim; ar = mag * cosf(ang); ai = mag * sinf(ang);
    const float den = are * are + aim * aim, xr = ar - 1.0f; cfr = (xr * are + ai * aim) / den; cfi = (ai * are - xr * aim) / den;
}
template <int SMODE>
__device__ __forceinline__ void p4_s5(Frame& F, const float* const* __restrict__ INP, int unit) {
    const int gp = unit & 15, b = (unit >> 4) & 7, d = unit >> 7;
    LAS bf16* BHt = (LAS bf16*)(F.lds + 0);
    LAS bf16* Cm = (LAS bf16*)(F.lds + 69632);
    LAS float* Eb = (LAS float*)(F.lds + 78336);
    LAS bf16* Us = (LAS bf16*)(F.lds + 82432);
    LAS bf16* BBs = (LAS bf16*)(F.lds + 92672);
    const bf16* PROJ = (const bf16*)(F.ws + WS_PROJ); bf16* YDIR = (bf16*)(F.ws + WS_YDIR) + (size_t)(((d * 8 + b) * 16 + gp)) * SEQ * 32;
    LAS bf16* Yst = (LAS bf16*)(F.lds + 104960);
    int tid = F.tid; asm volatile("" : "+v"(tid));
    const int lane = tid & 63, w = F.wave;
    const int sg = tid & 127, seg = tid >> 7;
    float ar, ai, a32r, a32i;
    { float cfr, cfi; s5_disc(INP, d, 2 * gp + (sg >> 6), sg & 63, ar, ai, cfr, cfi); a32r = ar; a32i = ai;
#pragma unroll
        for (int q = 0; q < 5; ++q) { const float nr = a32r * a32r - a32i * a32i, ni = 2.0f * a32r * a32i; a32r = nr; a32i = ni; } }
    for (int idx = tid; idx < 4096; idx += 512) {
        { const int gg = idx >> 11, pp = (idx >> 4) & 127, c = idx & 15, g = 2 * gp + gg, p = pp & 63; float xr_, xi_, cfr, cfi; s5_disc(INP, d, g, p, xr_, xi_, cfr, cfi);
            const float bre = INP[16][((size_t)(d * 32 + g) * 64 + p) * 16 + c], bim = INP[17][((size_t)(d * 32 + g) * 64 + p) * 16 + c];
            BBs[(gg * 128 + pp) * 24 + c] = (bf16)f2bf(pp < 64 ? cfr * bre - cfi * bim : cfr * bim + cfi * bre); }
        { const int gg = idx >> 11, c = (idx >> 7) & 15, pp = idx & 127, g = 2 * gp + gg, p = pp & 63;
            const float v = pp < 64 ? INP[18][((size_t)(d * 32 + g) * 16 + c) * 64 + p] : -INP[19][((size_t)(d * 32 + g) * 16 + c) * 64 + p];
            Cm[(gg * 16 + c) * 136 + pp] = (bf16)f2bf(v); }
    }
    float h0r = 0.f, h0i = 0.f;
    LAS bf16* rowre = BHt + ((sg >> 6) * 128 + (sg & 63)) * 136 + 32 * seg;
    v4u pu; bool ypend = false; int yp0 = 0, yL = 0;
#define S5_PREFETCH(jn) do { const bool lat_ = (jn) >= 2; const int p0_ = lat_ ? 128 * ((jn) - 2) : 128 * (jn), L_ = lat_ ? SEQ : CTXL, rb_ = lat_ ? b * SEQ : ML + b * CTXL; \
        const int s_ = tid >> 2, c_ = tid & 3; const int tt = d ? (L_ - 1 - (p0_ + s_)) : (p0_ + s_); pu = *(const v4u*)(PROJ + (size_t)(rb_ + tt) * LDP + PC_U + gp * 32 + c_ * 8); } while (0)
    S5_PREFETCH(0);
    __syncthreads();
    for (int j = 0; j < 34; ++j) {
        const bool lat = j >= 2;
        const int p0 = lat ? 128 * (j - 2) : 128 * j, Lseq = lat ? SEQ : CTXL, rowbase = lat ? b * SEQ : ML + b * CTXL;
        *(LAS v4u*)(Us + (tid >> 2) * 40 + (tid & 3) * 8) = pu;
        LBAR();
        if (j + 1 < 34) S5_PREFETCH(j + 1);
        if (ypend) { if (!(SMODE & 1)) { const int r = tid >> 2, c = tid & 3; const int tt = d ? (yL - 1 - (yp0 + r)) : (yp0 + r); *(v4u*)(YDIR + (size_t)tt * 32 + 8 * c) = *(const LAS v4u*)(Yst + r * 40 + 8 * c); } ypend = false; }
        { const int gg = w >> 2, tm = w & 3, r = lane & 31, hh = lane >> 5;
            const bf16x8 a = *(const LAS bf16x8*)(Us + (32 * tm + r) * 40 + gg * 16 + 8 * hh);
            LAS bf16* bp = BHt + (gg * 128 + r) * 136 + 32 * tm + 4 * hh;
#pragma unroll
            for (int tn = 0; tn < 4; ++tn) { f32x16 acc;
#pragma unroll
                for (int reg = 0; reg < 16; ++reg) acc[reg] = 0.f;
                const bf16x8 bb = *(const LAS bf16x8*)(BBs + (gg * 128 + 32 * tn + r) * 24 + 8 * hh);
                acc = __builtin_amdgcn_mfma_f32_32x32x16_bf16(a, bb, acc, 0, 0, 0);
#pragma unroll
                for (int rg = 0; rg < 4; ++rg) *(LAS v2u*)(bp + 32 * tn * 136 + 8 * rg) = (v2u){cvtpk(acc[4 * rg], acc[4 * rg + 1]), cvtpk(acc[4 * rg + 2], acc[4 * rg + 3])}; } }
        LBAR();
        v4u xr[4], xi[4];
#pragma unroll
        for (int q = 0; q < 4; ++q) { xr[q] = *(const LAS v4u*)(rowre + 8 * q); xi[q] = *(const LAS v4u*)(rowre + 64 * 136 + 8 * q); }
        { float hr = 0.f, hi = 0.f;
#pragma unroll
            for (int q = 0; q < 4; ++q)
#pragma unroll
                for (int e = 0; e < 4; ++e) { const unsigned wr_ = xr[q][e], wi_ = xi[q][e];
                    { const float br = bflo(wr_), bi = bflo(wi_); const float nr = ar * hr - ai * hi + br, ni = ar * hi + ai * hr + bi; hr = nr; hi = ni; }
                    { const float br = bfhi(wr_), bi = bfhi(wi_); const float nr = ar * hr - ai * hi + br, ni = ar * hi + ai * hr + bi; hr = nr; hi = ni; } }
            Eb[(seg * 128 + sg) * 2] = hr; Eb[(seg * 128 + sg) * 2 + 1] = hi; }
        LBAR();
        { float hcr = h0r, hci = h0i, hr = 0.f, hi = 0.f;
#pragma unroll
            for (int s2 = 0; s2 < 4; ++s2) { if (s2 == seg) { hr = hcr; hi = hci; } const float er = Eb[(s2 * 128 + sg) * 2], ei = Eb[(s2 * 128 + sg) * 2 + 1];
                const float nr = a32r * hcr - a32i * hci + er, ni = a32r * hci + a32i * hcr + ei; hcr = nr; hci = ni; }
            h0r = hcr; h0i = hci;
#pragma unroll
            for (int q = 0; q < 4; ++q) { v4u orr, oi;
#pragma unroll
                for (int e = 0; e < 4; ++e) { const unsigned wr_ = xr[q][e], wi_ = xi[q][e]; float r0, i0, r1, i1;
                    { const float br = bflo(wr_), bi = bflo(wi_); const float nr = ar * hr - ai * hi + br, ni = ar * hi + ai * hr + bi; hr = nr; hi = ni; r0 = hr; i0 = hi; }
                    { const float br = bfhi(wr_), bi = bfhi(wi_); const float nr = ar * hr - ai * hi + br, ni = ar * hi + ai * hr + bi; hr = nr; hi = ni; r1 = hr; i1 = hi; }
                    orr[e] = cvtpk(r0, r1); oi[e] = cvtpk(i0, i1); }
                *(LAS v4u*)(rowre + 8 * q) = orr; *(LAS v4u*)(rowre + 64 * 136 + 8 * q) = oi; } }
        LBAR();
        if (lat) { const int gg = w >> 2;
#pragma unroll
            for (int jj = 0; jj < 2; ++jj) { const int tm = 2 * (w & 3) + jj; f32x4 acc = (f32x4){0.f, 0.f, 0.f, 0.f};
#pragma unroll
                for (int st4 = 0; st4 < 4; ++st4) { const bf16x8 af = *(const LAS bf16x8*)(Cm + (gg * 16 + (lane & 15)) * 136 + 32 * st4 + 8 * (lane >> 4));
                    const bf16x8 bfr = tr_frag16(BHt + gg * 128 * 136, 136, 32 * st4, 16 * tm, lane);
                    acc = __builtin_amdgcn_mfma_f32_16x16x32_bf16(af, bfr, acc, 0, 0, 0); }
                const int t = 16 * tm + (lane & 15);
                *(LAS v2u*)(Yst + t * 40 + gg * 16 + 4 * (lane >> 4)) = (v2u){pk2(acc[0], acc[1]), pk2(acc[2], acc[3])}; }
            ypend = true; yp0 = p0; yL = Lseq; }
    }
    if (ypend && !(SMODE & 1)) { LBAR(); const int r = tid >> 2, c = tid & 3; const int tt = d ? (yL - 1 - (yp0 + r)) : (yp0 + r); *(v4u*)(YDIR + (size_t)tt * 32 + 8 * c) = *(const LAS v4u*)(Yst + r * 40 + 8 * c); }
#undef S5_PREFETCH
    __syncthreads();
}

__device__ __forceinline__ float gelu_tanh(float x) { const float u = 0.7978845608028654f * (x + 0.044715f * x * x * x); const float e = __expf(2.0f * u); const float th = 1.0f - 2.0f * frcp(e + 1.0f); return 0.5f * x * (1.0f + th); }
__device__ __forceinline__ void p5a_prep(Frame& F, const float* const* __restrict__ INP) {
    const int gw = F.vcu * NWAVES + F.wave, NGW = F.G * NWAVES, lane = F.lane;
    const bf16* PROJ = (const bf16*)(F.ws + WS_PROJ); const unsigned char* HB0 = F.ws + WS_HDIR; const unsigned char* HB1 = HB0 + (size_t)ML * 1024;
    const bf16* YD0 = (const bf16*)(F.ws + WS_YDIR); const bf16* YD1 = YD0 + (size_t)ML * 512;
    bf16* A1 = (bf16*)(F.ws + WS_A1); bf16* A2 = (bf16*)(F.ws + WS_A2); const unsigned char* P8 = F.ws + WS_PROJ8;
    for (int m0 = 2 * gw; m0 < ML; m0 += 2 * NGW) {
        v4u ha[2][2], hb[2][2], ho[2][2], ya[2], yb[2], yu[2];
#pragma unroll
        for (int r = 0; r < 2; ++r) { const size_t m = (size_t)(m0 + r); const int bb = (int)(m / SEQ), tq = (int)(m % SEQ);
            const size_t hoff = ((size_t)((bb * 8 + (lane >> 3)) * 2 + ((lane >> 2) & 1)) * SEQ + tq) * 64 + (lane & 3) * 16;
            const size_t yoff = ((size_t)(bb * 16 + (lane >> 2)) * SEQ + tq) * 32 + (lane & 3) * 8;
#pragma unroll
            for (int q = 0; q < 2; ++q) { ha[r][q] = (v4u){0u, 0u, 0u, 0u}; hb[r][q] = (v4u){0u, 0u, 0u, 0u}; ho[r][q] = (v4u){0u, 0u, 0u, 0u}; }
            { const v4u a16 = *(const v4u*)(HB0 + hoff), b16 = *(const v4u*)(HB1 + hoff); ha[r][0].x = a16.x; ha[r][0].y = a16.y; ha[r][1].x = a16.z; ha[r][1].y = a16.w; hb[r][0].x = b16.x; hb[r][0].y = b16.y; hb[r][1].x = b16.z; hb[r][1].y = b16.w; }
            { const v4u o16 = *(const v4u*)(P8 + m * 3072 + 16 * lane); ho[r][0].x = o16.x; ho[r][0].y = o16.y; ho[r][1].x = o16.z; ho[r][1].y = o16.w; }
            ya[r] = *(const v4u*)(YD0 + yoff); yb[r] = *(const v4u*)(YD1 + yoff); yu[r] = *(const v4u*)(PROJ + m * LDP + PC_U + 8 * lane); }
        __builtin_amdgcn_sched_barrier(0);
#pragma unroll
        for (int r = 0; r < 2; ++r) { const size_t m = (size_t)(m0 + r);
            float hm[16]; float ss = 0.f;
#pragma unroll
            for (int q = 0; q < 2; ++q) { f32x4 a0, a1, b0, b1; unpack8_fp8((v2u){ha[r][q].x, ha[r][q].y}, a0, a1); unpack8_fp8((v2u){hb[r][q].x, hb[r][q].y}, b0, b1);
#pragma unroll
                for (int e = 0; e < 4; ++e) { hm[8 * q + e] = (a0[e] + b0[e]) * 0.125f; hm[8 * q + 4 + e] = (a1[e] + b1[e]) * 0.125f; } }
#pragma unroll
            for (int q = 0; q < 16; ++q) ss += hm[q] * hm[q];
            ss += __shfl_xor(ss, 1); ss += __shfl_xor(ss, 2); ss += __shfl_xor(ss, 4);
            const float rs = 1.0f / sqrtf(ss * (1.0f / 128.0f) + EPS);
#pragma unroll
            for (int q = 0; q < 2; ++q) { const float* gm = INP[11] + 16 * lane + 8 * q; f32x4 og0, og1; unpack8_fp8((v2u){ho[r][q].x, ho[r][q].y}, og0, og1);
                float rr[8]; const float og[8] = {og0[0], og0[1], og0[2], og0[3], og1[0], og1[1], og1[2], og1[3]};
#pragma unroll
                for (int e = 0; e < 8; ++e) rr[e] = hm[8 * q + e] * rs * gm[e] * sigmoidf_(og[e]);
                *(v2u*)((unsigned char*)A1 + m * 1024 + 16 * lane + 8 * q) = (v2u){pk4_fp8(rr[0], rr[1], rr[2], rr[3]), pk4_fp8(rr[4], rr[5], rr[6], rr[7])}; }
            { const v4u a = ya[r], bq = yb[r], u8 = yu[r]; const float* dd = INP[20] + 8 * lane;
                float rr[8] = {bflo(a.x) + bflo(bq.x) + dd[0] * bflo(u8.x), bfhi(a.x) + bfhi(bq.x) + dd[1] * bfhi(u8.x), bflo(a.y) + bflo(bq.y) + dd[2] * bflo(u8.y), bfhi(a.y) + bfhi(bq.y) + dd[3] * bfhi(u8.y),
                               bflo(a.z) + bflo(bq.z) + dd[4] * bflo(u8.z), bfhi(a.z) + bfhi(bq.z) + dd[5] * bfhi(u8.z), bflo(a.w) + bflo(bq.w) + dd[6] * bflo(u8.w), bfhi(a.w) + bfhi(bq.w) + dd[7] * bfhi(u8.w)};
#pragma unroll
                for (int e = 0; e < 8; ++e) rr[e] = gelu_tanh(rr[e]);
                *(v2u*)((unsigned char*)A2 + m * 512 + 8 * lane) = (v2u){pk4_fp8(rr[0], rr[1], rr[2], rr[3]), pk4_fp8(rr[4], rr[5], rr[6], rr[7])}; }
        }
    }
}

__device__ __forceinline__ void route_reduce_top4(float (&acc)[32], const float* br, int lane, float (&tv)[4], int (&ti)[4]) {
#pragma unroll
    for (int i = 0; i < 16; ++i) { const float send = (lane & 32) ? acc[i] : acc[i + 16]; const float keep = (lane & 32) ? acc[i + 16] : acc[i]; acc[i] = keep + __shfl_xor(send, 32); }
#pragma unroll
    for (int i = 0; i < 8; ++i) { const float send = (lane & 16) ? acc[i] : acc[i + 8]; const float keep = (lane & 16) ? acc[i + 8] : acc[i]; acc[i] = keep + __shfl_xor(send, 16); }
#pragma unroll
    for (int i = 0; i < 4; ++i) { const float send = (lane & 8) ? acc[i] : acc[i + 4]; const float keep = (lane & 8) ? acc[i + 4] : acc[i]; acc[i] = keep + __shfl_xor(send, 8); }
#pragma unroll
    for (int i = 0; i < 2; ++i) { const float send = (lane & 4) ? acc[i] : acc[i + 2]; const float keep = (lane & 4) ? acc[i + 2] : acc[i]; acc[i] = keep + __shfl_xor(send, 4); }
    { const float send = (lane & 2) ? acc[0] : acc[1]; const float keep = (lane & 2) ? acc[1] : acc[0]; acc[0] = keep + __shfl_xor(send, 2); }
    acc[0] += __shfl_xor(acc[0], 1);
    float val = acc[0] + br[lane >> 1];
    if (lane & 1) val = -INFINITY;
#pragma unroll
    for (int r = 0; r < 4; ++r) { float mx = val;
#pragma unroll
        for (int o = 1; o < 64; o <<= 1) mx = fmaxf(mx, __shfl_xor(mx, o));
        const unsigned long long bal = __ballot(val == mx); const int wl = __ffsll((long long)bal) - 1;
        tv[r] = mx; ti[r] = wl >> 1; if (lane == wl) val = -INFINITY; }
}
__device__ __forceinline__ void p6_route(Frame& F, const float* const* __restrict__ INP) {
    const bf16* X1 = (const bf16*)(F.ws + WS_X1); const float* mod = (const float*)(F.ws + WS_MOD); bf16* H2 = (bf16*)(F.ws + WS_H2);
    int* TOPE = (int*)(F.ws + WS_TOPE); int* POS = (int*)(F.ws + WS_POS); float* TOPP = (float*)(F.ws + WS_TOPP); int* LIST = (int*)(F.ws + WS_LIST);
    LAS float* Wt = (LAS float*)(F.lds);
    LAS int* pe = (LAS int*)(F.lds + LDSCTL_OFF + 1024); LAS int* hist = pe + 512; LAS int* base = hist + 32; LAS int* rank = base + 32;
    const float* wr = INP[26]; const float* br = INP[27];
    const int lane = F.lane, w = F.wave;
    for (int idx = F.tid; idx < 32768; idx += NWAVES * 64) { const int e = idx >> 10, k = idx & 1023; Wt[(((((k >> 8) * 4 + (k & 3)) * 8 + (e >> 2)) * 64 + ((k >> 2) & 63)) << 2) + (e & 3)] = wr[k * 32 + e]; }
    __syncthreads();
    for (int tg = blockIdx.x; tg < ML / 128; tg += F.G) {
        if (F.tid < 32) hist[F.tid] = 0;
        __syncthreads();
#pragma unroll 1
        for (int q = 0; q < 16; q += 2) {
            const int tl = w * 16 + q, m = tg * 128 + tl, b = m / SEQ;
            const float* sh = mod + b * 6144 + 3 * D; const float* scl = sh + D;
            float s0 = 0.f, s1 = 0.f;
#pragma unroll
            for (int j = 0; j < 4; ++j) { const v2u w0 = *(const v2u*)(X1 + (size_t)m * D + 256 * j + 4 * lane), w1 = *(const v2u*)(X1 + (size_t)(m + 1) * D + 256 * j + 4 * lane);
                const f32x4 x0 = (f32x4){bflo(w0.x), bfhi(w0.x), bflo(w0.y), bfhi(w0.y)}, x1 = (f32x4){bflo(w1.x), bfhi(w1.x), bflo(w1.y), bfhi(w1.y)};
                s0 += (x0[0] * x0[0] + x0[1] * x0[1]) + (x0[2] * x0[2] + x0[3] * x0[3]); s1 += (x1[0] * x1[0] + x1[1] * x1[1]) + (x1[2] * x1[2] + x1[3] * x1[3]); }
            const float r0 = 1.0f / sqrtf(wave_sum(s0) * (1.0f / D) + EPS), r1 = 1.0f / sqrtf(wave_sum(s1) * (1.0f / D) + EPS);
            float a0[32], a1[32];
#pragma unroll
            for (int e = 0; e < 32; ++e) { a0[e] = 0.f; a1[e] = 0.f; }
#pragma unroll 1
            for (int j = 0; j < 4; ++j) { const int c = 256 * j + 4 * lane; const f32x4 g = *(const f32x4*)(INP[7] + c), a = *(const f32x4*)(scl + c), bb = *(const f32x4*)(sh + c);
                const v2u w0 = *(const v2u*)(X1 + (size_t)m * D + c), w1 = *(const v2u*)(X1 + (size_t)(m + 1) * D + c);
                const f32x4 x0 = (f32x4){bflo(w0.x), bfhi(w0.x), bflo(w0.y), bfhi(w0.y)}, x1 = (f32x4){bflo(w1.x), bfhi(w1.x), bflo(w1.y), bfhi(w1.y)};
                const f32x4 gs = g * (a + 1.0f); const f32x4 y0 = x0 * r0 * gs + bb, y1 = x1 * r1 * gs + bb;
                *(unsigned*)((unsigned char*)H2 + (size_t)m * D + c) = pk4_fp8(y0[0], y0[1], y0[2], y0[3]); *(unsigned*)((unsigned char*)H2 + (size_t)(m + 1) * D + c) = pk4_fp8(y1[0], y1[1], y1[2], y1[3]);
                const LAS float* wj = Wt + j * 8192 + lane * 4;
#pragma unroll
                for (int qq = 0; qq < 4; ++qq) { const LAS float* wp = wj + qq * 2048; const float ya = y0[qq], yb = y1[qq];
#pragma unroll
                    for (int e4 = 0; e4 < 8; ++e4) { const f32x4 wv = *(const LAS f32x4*)(wp + e4 * 256);
#pragma unroll
                        for (int i = 0; i < 4; ++i) { a0[4 * e4 + i] += ya * wv[i]; a1[4 * e4 + i] += yb * wv[i]; } }
                    asm volatile("" ::: "memory"); } }
            float tv[4]; int ti[4];
#pragma unroll
            for (int tk = 0; tk < 2; ++tk) {
                if (tk == 0) route_reduce_top4(a0, br, lane, tv, ti); else route_reduce_top4(a1, br, lane, tv, ti);
                const float e1 = __expf(tv[1] - tv[0]), e2 = __expf(tv[2] - tv[0]), e3 = __expf(tv[3] - tv[0]); const float inv = 1.0f / (1.0f + e1 + e2 + e3);
                if (lane < 4) { const float p = lane == 0 ? inv : (lane == 1 ? e1 * inv : (lane == 2 ? e2 * inv : e3 * inv)); const int ee = lane == 0 ? ti[0] : (lane == 1 ? ti[1] : (lane == 2 ? ti[2] : ti[3]));
                    TOPP[(m + tk) * 4 + lane] = p; TOPE[(m + tk) * 4 + lane] = ee; pe[(tl + tk) * 4 + lane] = ee; }
            }
        }
        __syncthreads();
        { const int e = pe[F.tid]; rank[F.tid] = __hip_atomic_fetch_add(&hist[e], 1, __ATOMIC_RELAXED, __HIP_MEMORY_SCOPE_WORKGROUP); }
        __syncthreads();
        if (F.tid < 32) base[F.tid] = (int)__hip_atomic_fetch_add(F.ctl + CW_CNT + 64 * F.tid, (unsigned)hist[F.tid], RLX_AGENT);
        __syncthreads();
        { const int e = pe[F.tid]; const int pos = base[e] + rank[F.tid]; const int m = tg * 128 + (F.tid >> 2); LIST[e * ML + pos] = m; POS[m * 4 + (F.tid & 3)] = pos; }
        __syncthreads();
    }
}

typedef int i32x4 __attribute__((ext_vector_type(4)));
__device__ __forceinline__ void p10_combine(Frame& F, const float* const* __restrict__ INP) {
    moe_tables(F);
    const LAS int* tab = (const LAS int*)(F.lds + TAB_OFF);
    const bf16* X1 = (const bf16*)(F.ws + WS_X1); float* OUT = F.out; const float* mod = (const float*)(F.ws + WS_MOD); const unsigned char* Y = (const unsigned char*)(F.ws + WS_Y);
    const int* TOPE = (const int*)(F.ws + WS_TOPE); const int* POS = (const int*)(F.ws + WS_POS); const float* TOPP = (const float*)(F.ws + WS_TOPP);
    const int gw = F.vcu * NWAVES + F.wave, NGW = F.G * NWAVES, lane = F.lane;
    i32x4 te[2], tp[2]; f32x4 tw[2];
    int m0 = 2 * gw;
    if (m0 < ML) {
#pragma unroll
        for (int r = 0; r < 2; ++r) { te[r] = *(const i32x4*)(TOPE + (m0 + r) * 4); tp[r] = *(const i32x4*)(POS + (m0 + r) * 4); tw[r] = *(const f32x4*)(TOPP + (m0 + r) * 4); } }
    for (; m0 < ML; m0 += 2 * NGW) {
        unsigned yv[2][4][4]; v2u xv[2][4];
#pragma unroll
        for (int r = 0; r < 2; ++r) {
#pragma unroll
            for (int k = 0; k < 4; ++k) { const size_t slot = (size_t)256 * tab[te[r][k]] + tp[r][k];
#pragma unroll
                for (int j = 0; j < 4; ++j) yv[r][k][j] = *(const unsigned*)(Y + slot * 1024 + 256 * j + 4 * lane); }
#pragma unroll
            for (int j = 0; j < 4; ++j) xv[r][j] = *(const v2u*)(X1 + (size_t)(m0 + r) * D + 256 * j + 4 * lane); }
        const f32x4 cw[2] = {tw[0], tw[1]};
        const int mn = m0 + 2 * NGW;
        if (mn < ML) {
#pragma unroll
            for (int r = 0; r < 2; ++r) { te[r] = *(const i32x4*)(TOPE + (mn + r) * 4); tp[r] = *(const i32x4*)(POS + (mn + r) * 4); tw[r] = *(const f32x4*)(TOPP + (mn + r) * 4); } }
        __builtin_amdgcn_sched_barrier(0);
#pragma unroll
        for (int r = 0; r < 2; ++r) { const int m = m0 + r, b = m / SEQ; const float* gt2 = mod + b * 6144 + 5 * D;
            f32x4 v[4]; float s = 0.f;
#pragma unroll
            for (int j = 0; j < 4; ++j) { const int c = 256 * j + 4 * lane; f32x4 mo = (f32x4){0.f, 0.f, 0.f, 0.f};
#pragma unroll
                for (int k = 0; k < 4; ++k) { const unsigned y = yv[r][k][j]; const auto lo = __builtin_amdgcn_cvt_pk_f32_fp8((int)y, false), hi = __builtin_amdgcn_cvt_pk_f32_fp8((int)y, true);
                    mo += (f32x4){lo[0], lo[1], hi[0], hi[1]} * (cw[r][k] * 0.0625f); }
                const v2u xw = xv[r][j]; v[j] = (f32x4){bflo(xw.x), bfhi(xw.x), bflo(xw.y), bfhi(xw.y)} + *(const f32x4*)(gt2 + c) * mo;
                s += (v[j][0] * v[j][0] + v[j][1] * v[j][1]) + (v[j][2] * v[j][2] + v[j][3] * v[j][3]); }
            const float rstd = 1.0f / sqrtf(wave_sum(s) * (1.0f / D) + EPS);
#pragma unroll
            for (int j = 0; j < 4; ++j) { const int c = 256 * j + 4 * lane; *(f32x4*)(OUT + (size_t)m * D + c) = v[j] * rstd * *(const f32x4*)(INP[32] + c); }
        }
    }
}

struct Args { const float* in[33]; float* out; unsigned char* ws; int ph_lo, ph_hi, li, pad; };
__global__ void __launch_bounds__(NWAVES * 64, 2) fwd_kernel(Args args) {
    extern __shared__ __attribute__((aligned(16))) unsigned char lds[];
    Frame F;
    F.lds = (LAS unsigned char*)lds;
    F.tid = threadIdx.x; F.lane = F.tid & 63; F.wave = __builtin_amdgcn_readfirstlane(F.tid >> 6);
    F.G = gridDim.x; { const int bx = blockIdx.x; F.vcu = (F.G % 8 == 0) ? (bx % 8) * (F.G / 8) + bx / 8 : bx; }
    F.ws = args.ws; F.ctl = (gu32*)(args.ws + WS_CTL); F.out = args.out;
    for (int u = F.tid; u < (LDS_BYTES - LDSCTL_OFF) / 4; u += NWAVES * 64) ((LAS unsigned*)(F.lds + LDSCTL_OFF))[u] = 0u;
    __syncthreads();
    XcdBarrier bar; bar.bar = (unsigned*)(F.ctl + CW_BAR); bar.x = 0; bar.st = nullptr;
    if (N_LAUNCHES == 1) bar = xcd_barrier_post((unsigned*)(F.ctl + CW_BAR), (volatile LAS unsigned*)(F.lds + MISC_OFF) + 8);
    const int lo = args.ph_lo, hi = args.ph_hi;
    const float* const* __restrict__ INP = args.in;
#ifndef PH_MASK
#define PH_MASK 0x3fff
#endif
#define IN(k) ((((PH_MASK) >> (k)) & 1) && lo <= (k) && (k) < hi)
#define SEAM(k) do { if (IN(k) && IN((k) + 1)) xcd_barrier(bar); } while (0)
    const bf16* WIN = (const bf16*)(F.ws + WS_WIN);

    if (IN(0)) { p0_prologue(F, INP); } SEAM(0);
    if (IN(1)) { p1_norm1(F, INP); } SEAM(1);
    if (IN(2)) {
        pg8::Gemm g{(const bf16*)(F.ws + WS_H1), WIN, 512, nullptr, 0x7f7f7f7f, 0x7a7a7a7a}; InProjOrder S{F.G, (int)blockIdx.x};
        EpiStore E{(bf16*)(F.ws + WS_PROJ), LDP, F.ws + WS_PROJ8};
        pg8::gemm_phase<EpiStore, InProjOrder, false, true>(F.lds, g, S, E);
    } SEAM(2);
    if (IN(3)) { p3_conv(F, INP); } SEAM(3);
    if (IN(4)) { for (int u = blockIdx.x; u < 256; u += F.G) { p4_mlstm<0>(F, INP, u); if (P4_REP_M > 1) p4_mlstm<P4_MODE>(F, INP, u); p4_s5<0>(F, INP, u); if (P4_REP_S > 1) p4_s5<1>(F, INP, u); } } SEAM(4);
    if (IN(5)) { p5a_prep(F, INP); } SEAM(5);
    if (IN(6)) {
        pg8::Gemm g{(const bf16*)(F.ws + WS_A2), (const bf16*)(F.ws + WS_WGLU), 256, nullptr, 0x7f7f7f7f, 0x7a7a7a7a}; pg8::StaticOrder S; S.init(ML, 512, F.G, (int)blockIdx.x);
        EpiGlu E{(const bf16*)(F.ws + WS_A2), (bf16*)(F.ws + WS_A3), INP[22]};
        pg8::gemm_phase<EpiGlu, pg8::StaticOrder, false, true>(F.lds, g, S, E);
    }
    if (IN(7)) {
        pg8::Gemm g{(const bf16*)(F.ws + WS_A1), (const bf16*)(F.ws + WS_WA), 512, nullptr, 0x7f7f7f7f, 0x7a7a7a7a}; pg8::StaticOrder S; S.init(ML, 1024, F.G, (int)blockIdx.x);
        EpiGate<false> E{F.ws + WS_PROJ8, 1024, INP[24], nullptr, (bf16*)(F.ws + WS_YA)};
        pg8::gemm_phase<EpiGate<false>, pg8::StaticOrder, false, true>(F.lds, g, S, E);
    } SEAM(7);
    if (IN(8)) {
        pg8::Gemm g{(const bf16*)(F.ws + WS_A3), (const bf16*)(F.ws + WS_WB), 256, nullptr, 0x7f7f7f7f, 0x7a7a7a7a}; pg8::StaticOrder S; S.init(ML, 1024, F.G, (int)blockIdx.x);
        EpiGate<true> E{F.ws + WS_PROJ8, 2048, INP[24] + 1024, (const bf16*)(F.ws + WS_YA), (bf16*)(F.ws + WS_MERGED)};
        pg8::gemm_phase<EpiGate<true>, pg8::StaticOrder, false, true>(F.lds, g, S, E);
    } SEAM(8);
    if (IN(9)) {
        pg8::Gemm g{(const bf16*)(F.ws + WS_MERGED), (const bf16*)(F.ws + WS_WO), 512, nullptr, 0x7d7d7d7d, 0x7a7a7a7a}; pg8::StaticOrder S; S.init(ML, 1024, F.G, (int)blockIdx.x);
        EpiX1 E{INP[0], (const float*)(F.ws + WS_MOD), (bf16*)(F.ws + WS_X1)};
        pg8::gemm_phase<EpiX1, pg8::StaticOrder, false, true>(F.lds, g, S, E);
    } SEAM(9);
    if (IN(10)) { p6_route(F, INP); } SEAM(10);
    if (IN(11)) {
        moe_tables(F);
        MoeOrder S{F.G, (int)blockIdx.x, 8, (const LAS int*)(F.lds + TAB_OFF)};
        LAS unsigned short* ridx = (LAS unsigned short*)(F.lds + LDSCTL_OFF + 1024);
        { const int* LIST = (const int*)(F.ws + WS_LIST);
            for (int i = 0; i < 30; ++i) { pg8::Unit u; if (!S.next(i, u)) break;
                if (F.tid < 256) { const int rc = F.tid < u.nvalid ? F.tid : u.nvalid - 1; ridx[i * 256 + F.tid] = (unsigned short)LIST[u.lbase + rc]; } }
            __syncthreads(); }
        pg8::Gemm g{(const bf16*)(F.ws + WS_H2), (const bf16*)(F.ws + WS_WEIN), 512, ridx, 0x7f7f7f7f, 0x7a7a7a7a};
        EpiSwiglu E{INP[29], (bf16*)(F.ws + WS_ACT)};
        pg8::gemm_phase<EpiSwiglu, MoeOrder, true, true>(F.lds, g, S, E);
    } SEAM(11);
    if (IN(12)) {
        moe_tables(F);
        pg8::Gemm g{(const bf16*)(F.ws + WS_ACT), (const bf16*)(F.ws + WS_WEOUT), 512, nullptr, 0x7c7c7c7c, 0x7a7a7a7a}; MoeOrder S{F.G, (int)blockIdx.x, 4, (const LAS int*)(F.lds + TAB_OFF)};
        EpiY E{INP[31], (bf16*)(F.ws + WS_Y)};
        pg8::gemm_phase<EpiY, MoeOrder, false, true>(F.lds, g, S, E);
    } SEAM(12);
    if (IN(13)) { p10_combine(F, INP); }
#undef IN
#undef SEAM
}

extern "C" void kernel_launch(void* const* d_in, const int* in_sizes, int n_in, void* d_out, int out_size, void* d_ws, size_t ws_size, hipStream_t stream) {
    static int grid = 0;
    if (grid == 0) {
        if (n_in != 33 || out_size != ML * D || ws_size < WS_END2) { fprintf(stderr, "kernel_launch: unexpected shapes (n_in %d, out %d, ws %zu)\n", n_in, out_size, ws_size); grid = -1; return; }
        int dev = 0, cus = 0, per_cu = 0;
        if (hipGetDevice(&dev) != hipSuccess || hipDeviceGetAttribute(&cus, hipDeviceAttributeMultiprocessorCount, dev) != hipSuccess) { grid = -1; return; }
        if (hipFuncSetAttribute((const void*)fwd_kernel, hipFuncAttributeMaxDynamicSharedMemorySize, LDS_BYTES) != hipSuccess) { fprintf(stderr, "kernel_launch: hipFuncSetAttribute failed\n"); grid = -1; return; }
        if (hipOccupancyMaxActiveBlocksPerMultiprocessor(&per_cu, (const void*)fwd_kernel, NWAVES * 64, LDS_BYTES) != hipSuccess || per_cu < 1) fprintf(stderr, "kernel_launch: occupancy query reports %d\n", per_cu);
        (void)hipGetLastError();
        grid = cus;
    }
    if (grid < 0) return;
    if (hipMemsetAsync((char*)d_ws + WS_CTL, 0, CTL_ZERO_BYTES, stream) != hipSuccess) return;
    Args a{};
    for (int i = 0; i < 33; ++i) a.in[i] = (const float*)d_in[i];
    a.out = (float*)d_out; a.ws = (unsigned char*)d_ws;
    for (int li = 0; li < N_LAUNCHES; ++li) {
        a.ph_lo = (N_LAUNCHES == 1) ? 0 : li; a.ph_hi = (N_LAUNCHES == 1) ? NPH : li + 1; a.li = li;
        const int nrep = (N_LAUNCHES != 1 && (((PROBE_DUP_MASK) >> li) & 1)) ? 2 : 1;
        for (int r = 0; r < nrep; ++r) hipLaunchKernelGGL(fwd_kernel, dim3(grid), dim3(NWAVES * 64), LDS_BYTES, stream, a);
    }
}
```

```cpp
#include <hip/hip_runtime.h>
#include <cstdio>
#include <cstdint>

#ifndef MK_N_LAUNCHES
#define MK_N_LAUNCHES 1
#endif
#ifndef PROBE_DUP_MASK
#define PROBE_DUP_MASK 0
#endif
#ifndef P4_REP_M
#define P4_REP_M 1
#endif
#ifndef P4_MODE
#define P4_MODE 0
#endif
#ifndef P4_REP_S
#define P4_REP_S 1
#endif

namespace pg8 {
#define PG8_LAS __attribute__((address_space(3)))
typedef unsigned short bf16_t;
typedef short bf16x8 __attribute__((ext_vector_type(8)));
typedef float f32x4 __attribute__((ext_vector_type(4)));
typedef unsigned u32x4 __attribute__((ext_vector_type(4)));
constexpr int BM = 256, BK = 64, HALF = 128, HTB = HALF * BK * 2, STAGE_BYTES = 8 * HTB, NXCD = 8, WGM = 8;

__host__ __device__ __forceinline__ int lds_byte(int r, int c) { const int st = (r >> 4) * 2 + (c >> 5), rr = r & 15, cc = c & 31, ob = rr * 64 + cc * 2; return st * 1024 + (ob ^ (((ob >> 9) & 1) << 5)); }
__host__ __device__ __forceinline__ void stage_rc(int b, int& R, int& C) { const int st = b / 1024, sb = b % 1024, swz = sb ^ (((sb >> 9) & 1) << 5); R = (st >> 1) * 16 + swz / 64; C = (st & 1) * 32 + (swz % 64) / 2; }
__host__ __device__ __forceinline__ int perm32(int rho) { const int n = rho >> 4, i = rho & 15; return 8 * (i >> 2) + 4 * n + (i & 3); }

struct Unit { int pm, pn, lbase, nvalid; };
struct Gemm { const bf16_t* A; const bf16_t* Bt; int K; const PG8_LAS unsigned short* ridx; int sa, sb; int pfa; };

__device__ __forceinline__ int xcd_remap(int L, int nwg) { const int q = nwg / NXCD, r = nwg % NXCD, xcd = L % NXCD, off = L / NXCD; return (xcd < r ? xcd * (q + 1) : r * (q + 1) + (xcd - r) * q) + off; }

struct StaticOrder {
    int nM, nN, nwg, G, c;
    __device__ void init(int M, int N, int G_, int c_) { nM = M / BM; nN = N / BM; nwg = nM * nN; G = G_; c = c_; }
    __device__ __forceinline__ bool next(int i, Unit& u) const {
        const long L = (long)i * G + c; if (L >= nwg) return false;
        const int wgid = xcd_remap((int)L, nwg);
        const int nig = WGM * nN, gid = wgid / nig, fm = gid * WGM, gsz = (nM - fm) < WGM ? (nM - fm) : WGM;
        u.pm = fm + ((wgid % nig) % gsz); u.pn = (wgid % nig) / gsz; u.lbase = 0; u.nvalid = 0; return true;
    }
};

__device__ __forceinline__ unsigned cvt_pk_bf16(float lo, float hi) { unsigned r; asm volatile("v_cvt_pk_bf16_f32 %0, %1, %2" : "=v"(r) : "v"(lo), "v"(hi)); return r; }

typedef int v8i __attribute__((ext_vector_type(8)));
typedef short s16x16 __attribute__((ext_vector_type(16)));
template <class Epi, class Sched, bool GATHER, bool FP8 = false>
__device__ __forceinline__ void gemm_phase(PG8_LAS unsigned char* lds, const Gemm g, const Sched& S, const Epi& E) {
    const int tid = threadIdx.x, wid = __builtin_amdgcn_readfirstlane(tid >> 6), lane = tid & 63, wr = wid >> 2, wc = wid & 3, fr = lane & 15, fq = lane >> 4;
    const int K = g.K, nt = K / BK;
    int Rr[2]; unsigned cby[2], voffB[2];
#pragma unroll
    for (int i = 0; i < 2; ++i) { int R, C; stage_rc(tid * 16 + i * 8192, R, C); const int Rb = Epi::PERM ? ((R & ~31) + perm32(R & 31)) : R;
        Rr[i] = R; cby[i] = (unsigned)C * 2u; voffB[i] = (unsigned)(Rb * K + C) * 2u; }
    const size_t kstep = (size_t)(BK * 2);
    const size_t hstep = (size_t)HALF * K * 2;
    const size_t tstep = 2 * hstep;
    const unsigned ldsw = (unsigned)wid * 1024u;
    const int aoff = lds_byte(wr * 64 + fr, fq * 8), boff = lds_byte(wc * 32 + fr, fq * 8);

#define PG8_SA(b, h) (((b) * 2 + (h)) * HTB)
#define PG8_SB(b, h) ((4 + (b) * 2 + (h)) * HTB)
#define PG8_STAGE(bufoff, gbase, voff) do { _Pragma("unroll") for (int _i = 0; _i < 2; ++_i) \
        __builtin_amdgcn_global_load_lds((const unsigned*)((const char*)(gbase) + (voff)[_i]), (PG8_LAS unsigned*)(lds + (bufoff) + ldsw + _i * 8192), 16, 0, 0); } while (0)
#define PG8_LDA(dst, b, h) do { if constexpr (FP8) { _Pragma("unroll") for (int m = 0; m < 4; ++m) { const bf16x8 _lo = *(const PG8_LAS bf16x8*)(lds + PG8_SA(b, h) + aoff + m * 2048), _hi = *(const PG8_LAS bf16x8*)(lds + PG8_SA(b, h) + aoff + m * 2048 + 1024); dst##8[m] = __builtin_bit_cast(v8i, __builtin_shufflevector(_lo, _hi, 0, 1, 2, 3, 4, 5, 6, 7, 8, 9, 10, 11, 12, 13, 14, 15)); } } \
        else { _Pragma("unroll") for (int m = 0; m < 4; ++m) _Pragma("unroll") for (int k = 0; k < 2; ++k) dst[m][k] = *(const PG8_LAS bf16x8*)(lds + PG8_SA(b, h) + aoff + m * 2048 + k * 1024); } } while (0)
#define PG8_LDB(dst, b, h) do { if constexpr (FP8) { _Pragma("unroll") for (int n = 0; n < 2; ++n) { const bf16x8 _lo = *(const PG8_LAS bf16x8*)(lds + PG8_SB(b, h) + boff + n * 2048), _hi = *(const PG8_LAS bf16x8*)(lds + PG8_SB(b, h) + boff + n * 2048 + 1024); dst##8[n] = __builtin_bit_cast(v8i, __builtin_shufflevector(_lo, _hi, 0, 1, 2, 3, 4, 5, 6, 7, 8, 9, 10, 11, 12, 13, 14, 15)); } } \
        else { _Pragma("unroll") for (int n = 0; n < 2; ++n) _Pragma("unroll") for (int k = 0; k < 2; ++k) dst[n][k] = *(const PG8_LAS bf16x8*)(lds + PG8_SB(b, h) + boff + n * 2048 + k * 1024); } } while (0)
#define PG8_MMA(ai, bj, At, Bt) do { __builtin_amdgcn_s_setprio(1); _Pragma("unroll") for (int m = 0; m < 4; ++m) _Pragma("unroll") for (int n = 0; n < 2; ++n) { \
        if constexpr (FP8) asm volatile("v_mfma_scale_f32_16x16x128_f8f6f4 %0, %1, %2, %0, %3, %4 op_sel_hi:[0,0,0]" : "+v"(acc[ai][bj][m][n]) : "v"(Bt##8[n]), "v"(At##8[m]), "v"(vsb), "v"(vsa));   \
        else { _Pragma("unroll") for (int k = 0; k < 2; ++k) acc[ai][bj][m][n] = __builtin_amdgcn_mfma_f32_16x16x32_bf16(Bt[n][k], At[m][k], acc[ai][bj][m][n], 0, 0, 0); } } \
        __builtin_amdgcn_s_setprio(0); } while (0)
#define PG8_WAIT_V(n) asm volatile("s_waitcnt vmcnt(" #n ")" ::: "memory")
#define PG8_WAIT_L(n) asm volatile("s_waitcnt lgkmcnt(" #n ")" ::: "memory")
#define PG8_BAR __builtin_amdgcn_s_barrier()
#define PG8_SCHED __builtin_amdgcn_sched_barrier(0)
#define PG8_AOFF(dst, u, uord) do { _Pragma("unroll") for (int _h = 0; _h < 2; ++_h) _Pragma("unroll") for (int _i = 0; _i < 2; ++_i) { const int _r = _h * HALF + Rr[_i]; \
        if constexpr (GATHER) { const int _idx = g.ridx[(uord) * 256 + _r]; dst[_h][_i] = (unsigned)_idx * (unsigned)(K * 2) + cby[_i]; } \
        else { dst[_h][_i] = (unsigned)(_r * K * 2) + cby[_i]; } } } while (0)
    Unit cur, nxt; int ui = 0;
    if (!S.next(0, cur)) return;
    f32x4 acc[2][2][4][2]; f32x4 nb[2][2];
#pragma unroll
    for (int b = 0; b < 2; ++b)
#pragma unroll
        for (int n = 0; n < 2; ++n) nb[b][n] = (f32x4){0.f, 0.f, 0.f, 0.f};
    if constexpr (Epi::ACC_BIAS) E.bias(cur, wc, fq, nb);
#pragma unroll
    for (int a = 0; a < 2; ++a)
#pragma unroll
        for (int b = 0; b < 2; ++b)
#pragma unroll
            for (int m = 0; m < 4; ++m)
#pragma unroll
                for (int n = 0; n < 2; ++n) acc[a][b][m][n] = nb[b][n];
    const int vsa = g.sa, vsb = g.sb;
    bf16x8 At[4][2], B0[2][2], B1[2][2];
    v8i At8[4], B08[2], B18[2];
    unsigned vc[2][2], vn[2][2];
    PG8_AOFF(vc, cur, 0);
    const char* cA = GATHER ? (const char*)g.A : (const char*)g.A + (size_t)cur.pm * tstep; const char* cB = (const char*)g.Bt + (size_t)cur.pn * tstep;
    PG8_STAGE(PG8_SB(0, 0), cB, voffB); PG8_STAGE(PG8_SB(0, 1), cB + hstep, voffB); PG8_STAGE(PG8_SA(0, 0), cA, vc[0]); PG8_STAGE(PG8_SA(0, 1), cA, vc[1]);
    if (wr == 1) PG8_BAR;
    PG8_WAIT_V(2); PG8_BAR;
    PG8_STAGE(PG8_SB(1, 0), cB + kstep, voffB); PG8_STAGE(PG8_SA(1, 0), cA + kstep, vc[0]); PG8_STAGE(PG8_SB(1, 1), cB + hstep + kstep, voffB);
    PG8_WAIT_V(6); PG8_BAR;
    for (;;) {
        const bool has_next = S.next(ui + 1, nxt);
        const char* nA = (has_next && !GATHER) ? (const char*)g.A + (size_t)nxt.pm * tstep : cA; const char* nB = has_next ? (const char*)g.Bt + (size_t)nxt.pn * tstep : cB;
        if constexpr (GATHER) { if (has_next) { PG8_AOFF(vn, nxt, ui + 1); } else {
#pragma unroll
            for (int h = 0; h < 2; ++h) { vn[h][0] = vc[h][0]; vn[h][1] = vc[h][1]; } } }
#pragma unroll 1
        for (int t = 0; t < nt; t += 2) {
            const bool last = (t == nt - 2);
            const char* a1 = cA + (size_t)(t + 1) * kstep;
            const char* a2 = last ? nA : cA + (size_t)(t + 2) * kstep; const char* b2 = last ? nB : cB + (size_t)(t + 2) * kstep;
            const char* a3 = a2 + kstep; const char* b3 = b2 + kstep;
            unsigned v2[2][2];
#pragma unroll
            for (int h = 0; h < 2; ++h)
#pragma unroll
                for (int i = 0; i < 2; ++i) v2[h][i] = GATHER ? (last ? vn[h][i] : vc[h][i]) : vc[h][i];
            PG8_LDB(B0, 0, 0); PG8_LDB(B1, 0, 1); PG8_SCHED; PG8_LDA(At, 0, 0); PG8_STAGE(PG8_SA(1, 1), a1, vc[1]);
            PG8_WAIT_V(8); PG8_WAIT_L(0); PG8_BAR; PG8_MMA(0, 0, At, B0); PG8_MMA(0, 1, At, B1); PG8_BAR; PG8_SCHED;
            PG8_LDA(At, 0, 1); PG8_STAGE(PG8_SB(0, 0), b2, voffB); PG8_STAGE(PG8_SB(0, 1), b2 + hstep, voffB); PG8_STAGE(PG8_SA(0, 0), a2, v2[0]);
            PG8_WAIT_V(8); PG8_WAIT_L(0); PG8_BAR; PG8_MMA(1, 0, At, B0); PG8_MMA(1, 1, At, B1); PG8_BAR; PG8_SCHED;
            PG8_LDB(B0, 1, 0); PG8_LDB(B1, 1, 1); PG8_SCHED; PG8_LDA(At, 1, 0); PG8_STAGE(PG8_SA(0, 1), a2, v2[1]);
            PG8_WAIT_V(8); PG8_WAIT_L(0); PG8_BAR; PG8_MMA(0, 0, At, B0); PG8_MMA(0, 1, At, B1); PG8_BAR; PG8_SCHED;
            PG8_LDA(At, 1, 1); PG8_STAGE(PG8_SB(1, 0), b3, voffB); PG8_STAGE(PG8_SB(1, 1), b3 + hstep, voffB); PG8_STAGE(PG8_SA(1, 0), a3, v2[0]);
            PG8_WAIT_V(8); PG8_WAIT_L(0); PG8_BAR; PG8_MMA(1, 0, At, B0); PG8_MMA(1, 1, At, B1); PG8_BAR; PG8_SCHED;
        }
        if (wr == 0) PG8_BAR;
        if constexpr (!GATHER) { if (g.pfa && has_next && nxt.pm != cur.pm) {
#pragma unroll
            for (int i = 0; i < 3; ++i) __builtin_amdgcn_global_load_lds((const unsigned*)(nA + (size_t)(tid >> 1) * (K * 2) + (2 + (tid & 1) + 2 * i) * 128), (PG8_LAS unsigned*)(lds + 162816), 4, 0, 0); } }
        if constexpr (FP8) asm volatile("s_nop 15\n\ts_nop 15" ::: "memory");
        E(acc, cur, wr, wc, fr, fq);
        if (!has_next) break;
        if constexpr (Epi::ACC_BIAS) E.bias(nxt, wc, fq, nb);
#pragma unroll
        for (int a = 0; a < 2; ++a)
#pragma unroll
            for (int b = 0; b < 2; ++b)
#pragma unroll
                for (int m = 0; m < 4; ++m)
#pragma unroll
                    for (int n = 0; n < 2; ++n) acc[a][b][m][n] = nb[b][n];
        cur = nxt; cA = nA; cB = nB; ++ui;
        if constexpr (GATHER) {
#pragma unroll
            for (int h = 0; h < 2; ++h) { vc[h][0] = vn[h][0]; vc[h][1] = vn[h][1]; } }
        if (wr == 1) PG8_BAR;
    }
    PG8_WAIT_V(0);
    PG8_BAR;
#undef PG8_SA
#undef PG8_SB
#undef PG8_STAGE
#undef PG8_LDA
#undef PG8_LDB
#undef PG8_MMA
#undef PG8_WAIT_V
#undef PG8_WAIT_L
#undef PG8_BAR
#undef PG8_SCHED
#undef PG8_AOFF
}
}

constexpr int NWAVES = 8;
constexpr int D = 1024, NB = 8, SEQ = 4096, CTXL = 256;
constexpr int ML = NB * SEQ, MC = NB * CTXL, MT = ML + MC;
constexpr int LDP = 5888;
constexpr int PC_QK = 0, PC_V = 1024, PC_U = 2048, PC_O = 2560, PC_G = 3584, PC_IF = 5632;
constexpr int NEXP = 32, TOPK = 4;
constexpr int MAXTILES = (ML * TOPK + NEXP * 256) / 256;
constexpr float EPS = 1e-6f;
constexpr int NPH = 14;
constexpr int N_LAUNCHES = MK_N_LAUNCHES;

constexpr size_t MiB = 1u << 20;
constexpr size_t WS_CTL = 0, CTL_ZERO_BYTES = 1 * MiB;
constexpr size_t WS_MOD = 1 * MiB;
constexpr size_t WS_TOPE = 2 * MiB, WS_POS = 2 * MiB + 512 * 1024, WS_TOPP = 3 * MiB, WS_LIST = 4 * MiB;
constexpr size_t WS_WIN = 8 * MiB, WS_WGLU = 20 * MiB, WS_WA = 21 * MiB, WS_WB = 23 * MiB, WS_WO = 24 * MiB, WS_WEIN = 26 * MiB, WS_WEOUT = 90 * MiB, WS_PROJ8 = 122 * MiB;
constexpr size_t WS_R0 = 218 * MiB;
constexpr size_t WS_PROJ = WS_R0, WS_H1 = 609 * MiB, WS_QKC = 677 * MiB, WS_HDIR = 745 * MiB, WS_YDIR = 873 * MiB, WS_END = 937 * MiB;
constexpr size_t WS_A1 = WS_H1, WS_A2 = WS_QKC, WS_A3 = WS_QKC + 32 * MiB, WS_YA = WS_HDIR, WS_MERGED = WS_HDIR + 64 * MiB;
constexpr size_t WS_GS = 940 * MiB, WS_X1 = 940 * MiB, WS_END2 = 1004 * MiB;
constexpr size_t WS_H2 = WS_R0, WS_ACT = 282 * MiB, WS_Y = 554 * MiB;
static_assert(WS_PROJ + (size_t)MT * LDP * 2 <= WS_H1 && WS_Y + (size_t)MAXTILES * 256 * 1024 * 2 <= WS_END, "ws map");
constexpr int CW_BAR = 4096, CW_CNT = 16384;

constexpr int RING_BYTES = 131072;
constexpr int LDSCTL_OFF = RING_BYTES, MISC_OFF = LDSCTL_OFF + 320, TAB_OFF = LDSCTL_OFF + 512;
constexpr int LDS_BYTES = 163840;

#define GAS __attribute__((address_space(1)))
#define LAS __attribute__((address_space(3)))
typedef unsigned short bf16;
typedef unsigned v4u __attribute__((ext_vector_type(4)));
typedef unsigned v2u __attribute__((ext_vector_type(2)));
typedef float f32x4 __attribute__((ext_vector_type(4)));
typedef float f32x2 __attribute__((ext_vector_type(2)));
typedef float f32x16 __attribute__((ext_vector_type(16)));
typedef short bf16x8 __attribute__((ext_vector_type(8)));
typedef GAS unsigned gu32;
#define RLX_AGENT __ATOMIC_RELAXED, __HIP_MEMORY_SCOPE_AGENT
#define LDS_WAIT() asm volatile("s_waitcnt lgkmcnt(0)" ::: "memory")
#define LBAR() do { asm volatile("s_waitcnt lgkmcnt(0)" ::: "memory"); __builtin_amdgcn_s_barrier(); asm volatile("" ::: "memory"); } while (0)
__device__ __forceinline__ unsigned f2bf(float f) { unsigned u = __builtin_bit_cast(unsigned, f); return (u + 0x7fffu + ((u >> 16) & 1u)) >> 16; }
typedef __bf16 bf16x2_t __attribute__((ext_vector_type(2)));
__device__ __forceinline__ unsigned cvtpk(float lo, float hi) { const bf16x2_t v = {(__bf16)lo, (__bf16)hi}; return __builtin_bit_cast(unsigned, v); }
__device__ __forceinline__ unsigned pk2(float lo, float hi) { return cvtpk(lo, hi); }
__device__ __forceinline__ float clamp448(float x) { return __builtin_amdgcn_fmed3f(x, -448.0f, 448.0f); }
__device__ __forceinline__ unsigned pk4_fp8(float a, float b, float c, float d) {
    unsigned w = 0; w = __builtin_amdgcn_cvt_pk_fp8_f32(clamp448(a), clamp448(b), w, false); w = __builtin_amdgcn_cvt_pk_fp8_f32(clamp448(c), clamp448(d), w, true); return w; }
__device__ __forceinline__ float bf2f(unsigned b) { return __builtin_bit_cast(float, b << 16); }
__device__ __forceinline__ float bflo(unsigned w) { return __builtin_bit_cast(float, w << 16); }
__device__ __forceinline__ float bfhi(unsigned w) { return __builtin_bit_cast(float, w & 0xffff0000u); }
__device__ __forceinline__ float frcp(float x) { return __builtin_amdgcn_rcpf(x); }
__device__ __forceinline__ float sigmoidf_(float x) { return frcp(1.0f + __expf(-x)); }

#define XB_TMO      128
#define XB_XCNT(j)  (256  + 64 * (j))
#define XB_XSUB(j)  (1280 + 64 * (j))
#define XB_XGEN(j)  (2304 + 64 * (j))
#define XB_TOP      3328
#define XB_TOPGEN   3392
#define XCD_BAR_WORDS 3456
#define XB_SPIN_CAP (1u << 22)
__device__ __forceinline__ unsigned xb_ld(unsigned* p)              { return __hip_atomic_load(p, __ATOMIC_RELAXED, __HIP_MEMORY_SCOPE_AGENT); }
__device__ __forceinline__ unsigned xb_add(unsigned* p, unsigned v) { return __hip_atomic_fetch_add(p, v, __ATOMIC_RELAXED, __HIP_MEMORY_SCOPE_AGENT); }
__device__ __forceinline__ unsigned xb_xcc_id() { return (unsigned)__builtin_amdgcn_s_getreg((3 << 11) | 20) & 0xFu; }
#define XB_SPIN(cond, bar) do { unsigned _sp = 0; while (cond) { __builtin_amdgcn_s_sleep(1); \
    if ((++_sp & 255u) == 0u) { if (xb_ld(&(bar)[XB_TMO])) break; if (_sp > XB_SPIN_CAP) { atomicAdd(&(bar)[XB_TMO], 1u); break; } } } } while (0)
struct XcdBarrier { unsigned* bar; unsigned x; volatile LAS unsigned* st; };
__device__ __forceinline__ XcdBarrier xcd_barrier_post(unsigned* bar, volatile LAS unsigned* st) {
    XcdBarrier b; b.bar = bar; b.x = xb_xcc_id(); b.st = st;
    if (threadIdx.x == 0) (void)xb_add(&bar[XB_XCNT(b.x)], 1u);
    return b;
}
__device__ __forceinline__ void xcd_barrier_complete(unsigned* bar, unsigned x, unsigned& nloc, unsigned& nx) {
    const unsigned G = gridDim.x * gridDim.y * gridDim.z;
    unsigned sum, cnt, mine, sp = 0u;
    for (;;) {
        sum = 0u; cnt = 0u; mine = 0u;
#pragma unroll
        for (unsigned j = 0; j < 16; ++j) { const unsigned c = xb_ld(&bar[XB_XCNT(j)]); sum += c; cnt += (c > 0u) ? 1u : 0u; mine = (j == x) ? c : mine; }
        if (sum == G) break;
        __builtin_amdgcn_s_sleep(1);
        if ((++sp & 255u) == 0u) { if (xb_ld(&bar[XB_TMO])) break; if (sp > XB_SPIN_CAP) { atomicAdd(&bar[XB_TMO], 1u); break; } }
    }
    nloc = mine > 0u ? mine : 1u; nx = cnt > 0u ? cnt : 1u;
}
__device__ __forceinline__ void xcd_barrier(const XcdBarrier& b) {
    asm volatile("s_waitcnt vmcnt(0)" ::: "memory");
    __syncthreads();
    if (threadIdx.x == 0) {
        unsigned* bar = b.bar;
        __builtin_amdgcn_s_waitcnt(0);
        unsigned nloc = b.st[0], nx = b.st[1];
        if (nloc == 0u) { xcd_barrier_complete(bar, b.x, nloc, nx); b.st[0] = nloc; b.st[1] = nx; }
        const unsigned old = xb_add(&bar[XB_XSUB(b.x)], 1u);
        const unsigned gen = old / nloc;
        if (old + 1u == (gen + 1u) * nloc) {
            __builtin_amdgcn_fence(__ATOMIC_RELEASE, "agent");
            asm volatile("s_waitcnt vmcnt(0)" ::: "memory");
            const unsigned og = xb_add(&bar[XB_TOP], 1u);
            const unsigned tg = og / nx;
            if (og + 1u == (tg + 1u) * nx) xb_add(&bar[XB_TOPGEN], 1u);
            else XB_SPIN(xb_ld(&bar[XB_TOPGEN]) == tg, bar);
            __builtin_amdgcn_fence(__ATOMIC_ACQUIRE, "agent");
            xb_add(&bar[XB_XGEN(b.x)], 1u);
            asm volatile("s_waitcnt vmcnt(0)" ::: "memory");
        } else {
            XB_SPIN(xb_ld(&bar[XB_XGEN(b.x)]) == gen, bar);
            __builtin_amdgcn_fence(__ATOMIC_ACQUIRE, "agent");
            asm volatile("s_waitcnt vmcnt(0)" ::: "memory");
        }
    }
    __syncthreads();
}

struct Frame {
    LAS unsigned char* lds;
    gu32* ctl;
    int tid, lane, wave, vcu, G;
    float* out; unsigned char* ws;
};
#define DPPF(old_, x_, ctrl_, rmask_) __builtin_bit_cast(float, __builtin_amdgcn_update_dpp(__builtin_bit_cast(int, (float)(old_)), __builtin_bit_cast(int, (float)(x_)), (ctrl_), (rmask_), 0xf, false))
__device__ __forceinline__ float wave_sum(float v) {
    v += DPPF(0.f, v, 0x111, 0xf);
    v += DPPF(0.f, v, 0x112, 0xf);
    v += DPPF(0.f, v, 0x114, 0xf);
    v += DPPF(0.f, v, 0x118, 0xf);
    v += DPPF(0.f, v, 0x142, 0xa);
    v += DPPF(0.f, v, 0x143, 0xc);
    return __builtin_bit_cast(float, __builtin_amdgcn_readlane(__builtin_bit_cast(int, v), 63));
}
__device__ __forceinline__ float wave_scan_sum(float v) {
    v += DPPF(0.f, v, 0x111, 0xf); v += DPPF(0.f, v, 0x112, 0xf); v += DPPF(0.f, v, 0x114, 0xf); v += DPPF(0.f, v, 0x118, 0xf);
    v += DPPF(0.f, v, 0x142, 0xa); v += DPPF(0.f, v, 0x143, 0xc); return v; }
__device__ __forceinline__ float wave_scan_max(float v) {
    const float ninf = -INFINITY;
    v = fmaxf(v, DPPF(ninf, v, 0x111, 0xf)); v = fmaxf(v, DPPF(ninf, v, 0x112, 0xf)); v = fmaxf(v, DPPF(ninf, v, 0x114, 0xf)); v = fmaxf(v, DPPF(ninf, v, 0x118, 0xf));
    v = fmaxf(v, DPPF(ninf, v, 0x142, 0xa)); v = fmaxf(v, DPPF(ninf, v, 0x143, 0xc)); return v; }
__device__ __forceinline__ float wave_max(float v) {
    const float ninf = -INFINITY;
    v = fmaxf(v, DPPF(ninf, v, 0x111, 0xf));
    v = fmaxf(v, DPPF(ninf, v, 0x112, 0xf));
    v = fmaxf(v, DPPF(ninf, v, 0x114, 0xf));
    v = fmaxf(v, DPPF(ninf, v, 0x118, 0xf));
    v = fmaxf(v, DPPF(ninf, v, 0x142, 0xa));
    v = fmaxf(v, DPPF(ninf, v, 0x143, 0xc));
    return __builtin_bit_cast(float, __builtin_amdgcn_readlane(__builtin_bit_cast(int, v), 63));
}

struct InProjOrder {
    int G, c;
    __device__ __forceinline__ bool next(int i, pg8::Unit& u) const {
        const int NL = 128 * 23, NC = 8 * 11;
        const long L = (long)i * G + c; if (L >= NL + NC) return false;
        u.lbase = 0; u.nvalid = 0;
        if (L < NL) { const int wgid = pg8::xcd_remap((int)L, NL); const int nig = 8 * 23, gid = wgid / nig, fm = gid * 8; u.pm = fm + ((wgid % nig) % 8); u.pn = 22 - (wgid % nig) / 8; }
        else { const int r = (int)L - NL; u.pm = 128 + r / 11; const int q = r % 11; u.pn = q < 10 ? q : 22; }
        return true;
    }
};
struct MoeOrder {
    int G, c, npn; const LAS int* tab; int rev;
    __device__ __forceinline__ bool next(int i, pg8::Unit& u) const {
        const int nT = __builtin_amdgcn_readfirstlane(tab[32]); const int nU = nT * npn;
        const long L = (long)i * G + c; if (L >= nU) return false;
        int wgid;
        if (rev) { const int q = nU / pg8::NXCD, r = nU % pg8::NXCD, xcd = (int)(L % pg8::NXCD), off = (int)(L / pg8::NXCD), cntx = q + (xcd < r ? 1 : 0);
            wgid = (xcd < r ? xcd * (q + 1) : r * (q + 1) + (xcd - r) * q) + (cntx - 1 - off); }
        else wgid = pg8::xcd_remap((int)L, nU);
        const int tau = wgid / npn, pl = wgid % npn;
        int e = 0;
        for (int k = 1; k < 32; ++k) e += (__builtin_amdgcn_readfirstlane(tab[k]) <= tau) ? 1 : 0;
        const int il = tau - __builtin_amdgcn_readfirstlane(tab[e]);
        u.pm = tau; u.pn = e * npn + pl; u.lbase = e * ML + 256 * il; u.nvalid = __builtin_amdgcn_readfirstlane(tab[33 + e]) - 256 * il;
        return true;
    }
};
__device__ __forceinline__ void moe_tables(Frame& F) {
    LAS int* tab = (LAS int*)(F.lds + TAB_OFF);
    __syncthreads();
    if (F.tid < 64) {
        const int cnt = F.tid < 32 ? (int)__hip_atomic_load(F.ctl + CW_CNT + 64 * F.tid, RLX_AGENT) : 0;
        const int tiles = (cnt + 255) >> 8; int inc = tiles;
#pragma unroll
        for (int o = 1; o < 32; o <<= 1) { const int t = __shfl_up(inc, o); if ((F.tid & 63) >= o) inc += t; }
        if (F.tid < 32) { tab[33 + F.tid] = cnt; tab[F.tid] = inc - tiles; }
        if (F.tid == 31) tab[32] = inc;
    }
    __syncthreads();
}

using pg8::f32x4; using pg8::u32x4; using pg8::cvt_pk_bf16;
#define EPI_ROWS(u) const int row0 = (u).pm * 256 + wr * 64 + fr
#define EPI_LOOP _Pragma("unroll") for (int ai = 0; ai < 2; ++ai) _Pragma("unroll") for (int m = 0; m < 4; ++m)
__device__ __forceinline__ u32x4 pack8(const f32x4 a, const f32x4 b) { u32x4 w; w.x = cvt_pk_bf16(a[0], a[1]); w.y = cvt_pk_bf16(a[2], a[3]); w.z = cvt_pk_bf16(b[0], b[1]); w.w = cvt_pk_bf16(b[2], b[3]); return w; }
__device__ __forceinline__ void unpack8(const u32x4 w, f32x4& a, f32x4& b) { a = (f32x4){bflo(w.x), bfhi(w.x), bflo(w.y), bfhi(w.y)}; b = (f32x4){bflo(w.z), bfhi(w.z), bflo(w.w), bfhi(w.w)}; }
__device__ __forceinline__ void unpack8_fp8(const v2u w, f32x4& a, f32x4& b) {
    const auto l0 = __builtin_amdgcn_cvt_pk_f32_fp8((int)w.x, false), h0 = __builtin_amdgcn_cvt_pk_f32_fp8((int)w.x, true), l1 = __builtin_amdgcn_cvt_pk_f32_fp8((int)w.y, false), h1 = __builtin_amdgcn_cvt_pk_f32_fp8((int)w.y, true);
    a = (f32x4){l0[0], l0[1], h0[0], h0[1]}; b = (f32x4){l1[0], l1[1], h1[0], h1[1]}; }
__device__ __forceinline__ v2u pack8_fp8(const f32x4 a, const f32x4 b) { return (v2u){pk4_fp8(a[0], a[1], a[2], a[3]), pk4_fp8(b[0], b[1], b[2], b[3])}; }
__device__ __forceinline__ f32x4 sig4(f32x4 x) { return (f32x4){sigmoidf_(x[0]), sigmoidf_(x[1]), sigmoidf_(x[2]), sigmoidf_(x[3])}; }

struct EpiStore {
    static constexpr bool ACC_BIAS = false; static constexpr bool PERM = true; bf16* O; int ldc; unsigned char* P8;
    __device__ __forceinline__ void operator()(const f32x4 (&acc)[2][2][4][2], const pg8::Unit& u, int wr, int wc, int fr, int fq) const {
        EPI_ROWS(u); const int col0 = u.pn * 256 + wc * 32 + 8 * fq;
        if (u.pn == 22 && wc != 0) return;
        if (u.pn >= 10 && u.pn < 22) {
            EPI_LOOP { unsigned char* rowp = P8 + (size_t)(row0 + ai * 128 + m * 16) * 3072 + (col0 - PC_O);
#pragma unroll
                for (int bj = 0; bj < 2; ++bj) *(v2u*)(rowp + bj * 128) = pack8_fp8(acc[ai][bj][m][0], acc[ai][bj][m][1]); }
            return; }
        EPI_LOOP { bf16* rowp = O + (size_t)(row0 + ai * 128 + m * 16) * ldc + col0;
#pragma unroll
            for (int bj = 0; bj < 2; ++bj) if (u.pn != 22 || bj == 0) *(u32x4*)(rowp + bj * 128) = pack8(acc[ai][bj][m][0], acc[ai][bj][m][1]); }
    }
};
struct EpiGlu {
    static constexpr bool ACC_BIAS = false; static constexpr bool PERM = true; const bf16* A2; bf16* A3; const float* bias;
    __device__ __forceinline__ void operator()(const f32x4 (&acc)[2][2][4][2], const pg8::Unit& u, int wr, int wc, int fr, int fq) const {
        EPI_ROWS(u); const int col0 = u.pn * 256 + wc * 32 + 8 * fq;
        f32x4 bv[2][2];
#pragma unroll
        for (int bj = 0; bj < 2; ++bj)
#pragma unroll
            for (int n = 0; n < 2; ++n) bv[bj][n] = *(const f32x4*)(bias + col0 + bj * 128 + 4 * n);
#pragma unroll
        for (int ai = 0; ai < 2; ++ai) {
            v2u ld[4][2];
#pragma unroll
            for (int m = 0; m < 4; ++m)
#pragma unroll
                for (int bj = 0; bj < 2; ++bj) ld[m][bj] = *(const v2u*)((const unsigned char*)A2 + (size_t)(row0 + ai * 128 + m * 16) * 512 + col0 + bj * 128);
            __builtin_amdgcn_sched_barrier(0);
#pragma unroll
            for (int m = 0; m < 4; ++m)
#pragma unroll
                for (int bj = 0; bj < 2; ++bj) { f32x4 a0, a1; unpack8_fp8(ld[m][bj], a0, a1);
                    const f32x4 v0 = a0 * sig4(acc[ai][bj][m][0] + bv[bj][0]), v1 = a1 * sig4(acc[ai][bj][m][1] + bv[bj][1]);
                    *(v2u*)((unsigned char*)A3 + (size_t)(row0 + ai * 128 + m * 16) * 512 + col0 + bj * 128) = pack8_fp8(v0, v1); }
        }
    }
};
template <bool ADD> struct EpiGate {
    static constexpr bool ACC_BIAS = false; static constexpr bool PERM = true; const unsigned char* proj; int gc0; const float* bg; const bf16* Prev; bf16* O;
    __device__ __forceinline__ void operator()(const f32x4 (&acc)[2][2][4][2], const pg8::Unit& u, int wr, int wc, int fr, int fq) const {
        EPI_ROWS(u); const int col0 = u.pn * 256 + wc * 32 + 8 * fq;
        f32x4 bv[2][2];
#pragma unroll
        for (int bj = 0; bj < 2; ++bj)
#pragma unroll
            for (int n = 0; n < 2; ++n) bv[bj][n] = *(const f32x4*)(bg + col0 + bj * 128 + 4 * n);
        constexpr int MB = ADD ? 2 : 4;
#pragma unroll
        for (int g = 0; g < 8 / MB; ++g) {
            v2u lg[MB][2]; u32x4 lp[MB][2];
#pragma unroll
            for (int mm = 0; mm < MB; ++mm)
#pragma unroll
                for (int bj = 0; bj < 2; ++bj) { const int q = g * MB + mm, row = row0 + (q >> 2) * 128 + (q & 3) * 16; lg[mm][bj] = *(const v2u*)(proj + (size_t)row * 3072 + gc0 + col0 + bj * 128);
                    if (ADD) lp[mm][bj] = *(const u32x4*)(Prev + (size_t)row * 1024 + col0 + bj * 128); }
            __builtin_amdgcn_sched_barrier(0);
#pragma unroll
            for (int mm = 0; mm < MB; ++mm)
#pragma unroll
                for (int bj = 0; bj < 2; ++bj) { const int q = g * MB + mm, ai = q >> 2, m = q & 3; f32x4 g0, g1; unpack8_fp8(lg[mm][bj], g0, g1);
                    f32x4 v0 = sig4(g0 + bv[bj][0]) * acc[ai][bj][m][0], v1 = sig4(g1 + bv[bj][1]) * acc[ai][bj][m][1];
                    if (ADD) { f32x4 p0, p1; unpack8(lp[mm][bj], p0, p1); v0 += p0; v1 += p1; }
                    if (ADD) *(v2u*)((unsigned char*)O + (size_t)(row0 + ai * 128 + m * 16) * 1024 + col0 + bj * 128) = pack8_fp8(v0 * 4.0f, v1 * 4.0f);
                    else *(u32x4*)(O + (size_t)(row0 + ai * 128 + m * 16) * 1024 + col0 + bj * 128) = pack8(v0, v1); }
            __builtin_amdgcn_sched_barrier(0);
        }
    }
};
struct EpiX1 {
    static constexpr bool ACC_BIAS = false; static constexpr bool PERM = true; const float* x; const float* mod; bf16* X1;
    __device__ __forceinline__ void operator()(const f32x4 (&acc)[2][2][4][2], const pg8::Unit& u, int wr, int wc, int fr, int fq) const {
        EPI_ROWS(u); const int col0 = u.pn * 256 + wc * 32 + 8 * fq; const int b = (u.pm * 256) / SEQ;
        f32x4 gv[2][2];
#pragma unroll
        for (int bj = 0; bj < 2; ++bj)
#pragma unroll
            for (int n = 0; n < 2; ++n) gv[bj][n] = *(const f32x4*)(mod + b * 6144 + 2 * D + col0 + bj * 128 + 4 * n);
#pragma unroll
        for (int g = 0; g < 4; ++g) {
            f32x4 lx[2][2][2];
#pragma unroll
            for (int mm = 0; mm < 2; ++mm)
#pragma unroll
                for (int bj = 0; bj < 2; ++bj) { const int q = g * 2 + mm; const size_t off = (size_t)(row0 + (q >> 2) * 128 + (q & 3) * 16) * D + col0 + bj * 128; lx[mm][bj][0] = __builtin_nontemporal_load((const f32x4*)(x + off)); lx[mm][bj][1] = __builtin_nontemporal_load((const f32x4*)(x + off + 4)); }
            __builtin_amdgcn_sched_barrier(0);
#pragma unroll
            for (int mm = 0; mm < 2; ++mm)
#pragma unroll
                for (int bj = 0; bj < 2; ++bj) { const int q = g * 2 + mm, ai = q >> 2, m = q & 3; const size_t off = (size_t)(row0 + ai * 128 + m * 16) * D + col0 + bj * 128;
                    *(u32x4*)(X1 + off) = pack8(lx[mm][bj][0] + gv[bj][0] * acc[ai][bj][m][0], lx[mm][bj][1] + gv[bj][1] * acc[ai][bj][m][1]); }
            __builtin_amdgcn_sched_barrier(0);
        }
    }
};
struct EpiSwiglu {
    static constexpr bool ACC_BIAS = true; static constexpr bool PERM = true; const float* bin; bf16* ACT;
    __device__ __forceinline__ void bias(const pg8::Unit& u, int wc, int fq, f32x4 (&b)[2][2]) const { const int e = u.pn >> 3, pl = u.pn & 7; const int f0 = pl * 128 + wc * 32 + 8 * fq;
#pragma unroll
        for (int n = 0; n < 2; ++n) { b[0][n] = *(const f32x4*)(bin + e * 2048 + f0 + 4 * n); b[1][n] = *(const f32x4*)(bin + e * 2048 + 1024 + f0 + 4 * n); } }
    __device__ __forceinline__ void operator()(const f32x4 (&acc)[2][2][4][2], const pg8::Unit& u, int wr, int wc, int fr, int fq) const {
        EPI_ROWS(u); const int pl = u.pn & 7; const int f0 = pl * 128 + wc * 32 + 8 * fq;
        EPI_LOOP { f32x4 o[2];
#pragma unroll
            for (int n = 0; n < 2; ++n) { const f32x4 zg = acc[ai][0][m][n], zl = acc[ai][1][m][n];
#pragma unroll
                for (int j = 0; j < 4; ++j) { const float gl = fminf(zg[j], 7.0f); const float li8 = __builtin_fmaf(__builtin_amdgcn_fmed3f(zl[j], -7.0f, 7.0f), 8.0f, 8.0f);
                    o[n][j] = gl * frcp(1.0f + __builtin_amdgcn_exp2f(gl * -2.45546696f)) * li8; } }
            unsigned w0 = 0, w1 = 0;
            w0 = __builtin_amdgcn_cvt_pk_fp8_f32(o[0][0], o[0][1], w0, false); w0 = __builtin_amdgcn_cvt_pk_fp8_f32(o[0][2], o[0][3], w0, true);
            w1 = __builtin_amdgcn_cvt_pk_fp8_f32(o[1][0], o[1][1], w1, false); w1 = __builtin_amdgcn_cvt_pk_fp8_f32(o[1][2], o[1][3], w1, true);
            *(v2u*)((unsigned char*)ACT + (size_t)(row0 + ai * 128 + m * 16) * 1024 + f0) = (v2u){w0, w1}; }
    }
};
struct EpiY {
    static constexpr bool ACC_BIAS = true; static constexpr bool PERM = true; const float* bout; bf16* Y;
    __device__ __forceinline__ void bias(const pg8::Unit& u, int wc, int fq, f32x4 (&b)[2][2]) const { const int e = u.pn >> 2, pl = u.pn & 3; const int col0 = pl * 256 + wc * 32 + 8 * fq;
#pragma unroll
        for (int bj = 0; bj < 2; ++bj)
#pragma unroll
            for (int n = 0; n < 2; ++n) b[bj][n] = *(const f32x4*)(bout + e * 1024 + col0 + bj * 128 + 4 * n); }
    __device__ __forceinline__ void operator()(const f32x4 (&acc)[2][2][4][2], const pg8::Unit& u, int wr, int wc, int fr, int fq) const {
        EPI_ROWS(u); const int pl = u.pn & 3; const int col0 = pl * 256 + wc * 32 + 8 * fq;
        EPI_LOOP { unsigned char* rowp = (unsigned char*)Y + (size_t)(row0 + ai * 128 + m * 16) * 1024 + col0;
#pragma unroll
            for (int bj = 0; bj < 2; ++bj) { const f32x4 v0 = acc[ai][bj][m][0] * 16.0f, v1 = acc[ai][bj][m][1] * 16.0f;
                *(v2u*)(rowp + bj * 128) = (v2u){pk4_fp8(v0[0], v0[1], v0[2], v0[3]), pk4_fp8(v1[0], v1[1], v1[2], v1[3])}; } }
    }
};

struct TItem { const float* src; bf16* dst; int ld, ldk; int f8; };
__device__ __forceinline__ void titem_load(const TItem& t, int lane, f32x4 (&r)[8]) {
#pragma unroll
    for (int i = 0; i < 8; ++i) r[i] = *(const f32x4*)(t.src + (size_t)(8 * i + (lane >> 3)) * t.ld + 4 * (lane & 7));
}
__device__ __forceinline__ void titem_store(const TItem& t, int lane, const f32x4 (&r)[8], LAS float* scr) {
#pragma unroll
    for (int i = 0; i < 8; ++i) { LAS float* p = scr + (8 * i + (lane >> 3)) * 33 + 4 * (lane & 7); p[0] = r[i][0]; p[1] = r[i][1]; p[2] = r[i][2]; p[3] = r[i][3]; }
    LDS_WAIT(); asm volatile("" ::: "memory");
    const int c = lane & 7;
#pragma unroll
    for (int j = 0; j < 4; ++j) { const int n = (lane >> 3) + 8 * j; const LAS float* s = scr + (8 * c) * 33 + n;
        if (t.f8) { *(GAS v2u*)((unsigned char*)t.dst + (size_t)n * t.ldk + 8 * c) = (v2u){pk4_fp8(32.f * s[0 * 33], 32.f * s[1 * 33], 32.f * s[2 * 33], 32.f * s[3 * 33]), pk4_fp8(32.f * s[4 * 33], 32.f * s[5 * 33], 32.f * s[6 * 33], 32.f * s[7 * 33])}; }
        else { v4u o; o.x = pk2(s[0 * 33], s[1 * 33]); o.y = pk2(s[2 * 33], s[3 * 33]); o.z = pk2(s[4 * 33], s[5 * 33]); o.w = pk2(s[6 * 33], s[7 * 33]);
            *(GAS v4u*)(t.dst + (size_t)n * t.ldk + 8 * c) = o; } }
    LDS_WAIT(); asm volatile("" ::: "memory");
}
__device__ __forceinline__ void p0_prologue(Frame& F, const float* const* __restrict__ INP) {
    LAS float* scr = (LAS float*)(F.lds + F.wave * 16384);
    const int gw = F.vcu * NWAVES + F.wave, NGW = F.G * NWAVES;
    bf16* WIN = (bf16*)(F.ws + WS_WIN); bf16* WGLU = (bf16*)(F.ws + WS_WGLU); bf16* WA = (bf16*)(F.ws + WS_WA); bf16* WB = (bf16*)(F.ws + WS_WB); bf16* WO = (bf16*)(F.ws + WS_WO);
    bf16* WEIN = (bf16*)(F.ws + WS_WEIN); bf16* WEOUT = (bf16*)(F.ws + WS_WEOUT);
    constexpr int I_IN = 177 * 16, I_GLU = 16 * 8, I_A = 32 * 16, I_B = 32 * 8, I_O = 32 * 16, I_EIN = 32 * 64 * 16, I_EOUT = 32 * 32 * 16;
    constexpr int NITEMS = I_IN + I_GLU + I_A + I_B + I_O + I_EIN + I_EOUT;
#define P0_DECODE(it_, T) do { int r = (it_); \
        if (r < I_IN) { const int kb = r / 177, nb = r % 177, n0 = nb * 32; const int sc0 = n0 < 2048 ? n0 : (n0 < 5632 ? n0 + 32 : 2048); \
            T.src = INP[8] + (size_t)kb * 64 * 5664 + sc0; T.ld = 5664; T.dst = (bf16*)((unsigned char*)WIN + (size_t)n0 * 1024 + kb * 64); T.ldk = 1024; T.f8 = 1; break; } r -= I_IN; \
        if (r < I_GLU) { const int kb = r / 16, nb = r % 16; T.src = INP[21] + (size_t)kb * 64 * 512 + nb * 32; T.ld = 512; T.dst = (bf16*)((unsigned char*)WGLU + (size_t)nb * 32 * 512 + kb * 64); T.ldk = 512; T.f8 = 1; break; } r -= I_GLU; \
        if (r < I_A) { const int kb = r / 32, nb = r % 32; T.src = INP[12] + (size_t)kb * 64 * 1024 + nb * 32; T.ld = 1024; T.dst = (bf16*)((unsigned char*)WA + (size_t)nb * 32 * 1024 + kb * 64); T.ldk = 1024; T.f8 = 1; break; } r -= I_A; \
        if (r < I_B) { const int kb = r / 32, nb = r % 32; T.src = INP[23] + (size_t)kb * 64 * 1024 + nb * 32; T.ld = 1024; T.dst = (bf16*)((unsigned char*)WB + (size_t)nb * 32 * 512 + kb * 64); T.ldk = 512; T.f8 = 1; break; } r -= I_B; \
        if (r < I_O) { const int kb = r / 32, nb = r % 32; T.src = INP[25] + (size_t)kb * 64 * 1024 + nb * 32; T.ld = 1024; T.dst = (bf16*)((unsigned char*)WO + (size_t)nb * 32 * 1024 + kb * 64); T.ldk = 1024; T.f8 = 1; break; } r -= I_O; \
        if (r < I_EIN) { const int e = r / 1024, q = r % 1024, kb = q / 64, nb = q % 64; const int dr = nb * 32, pn = dr >> 8, bj = (dr >> 7) & 1, xx = dr & 127; \
            T.src = INP[28] + (size_t)e * 1024 * 2048 + (size_t)kb * 64 * 2048 + bj * 1024 + pn * 128 + xx; T.ld = 2048; T.dst = (bf16*)((unsigned char*)WEIN + (size_t)e * 2048 * 1024 + (size_t)dr * 1024 + kb * 64); T.ldk = 1024; T.f8 = 1; break; } r -= I_EIN; \
        { const int e = r / 512, q = r % 512, kb = q / 32, nb = q % 32; \
            T.src = INP[30] + (size_t)e * 1024 * 1024 + (size_t)kb * 64 * 1024 + nb * 32; T.ld = 1024; T.dst = (bf16*)((unsigned char*)WEOUT + (size_t)e * 1024 * 1024 + (size_t)nb * 32 * 1024 + kb * 64); T.ldk = 1024; T.f8 = 1; } } while (0)
    TItem ta, tb; f32x4 ra[8], rb[8];
    int it = gw;
    if (it < NITEMS - I_EIN - I_EOUT) { P0_DECODE(it, ta); titem_load(ta, F.lane, ra); }
    {
        LAS float* sc = (LAS float*)(F.lds);
        LAS float* red = (LAS float*)(F.lds + 9 * 1024 * 4);
        { float cv[18];
#pragma unroll
            for (int j = 0; j < 18; ++j) cv[j] = j < 16 ? INP[1][F.tid + 512 * j] : INP[3][F.tid + 512 * (j - 16)];
#pragma unroll
            for (int j = 0; j < 18; ++j) { const float v = cv[j]; sc[F.tid + 512 * j] = v * frcp(1.0f + __expf(-v)); } }
        __syncthreads();
        const float* wada = INP[4]; const float* bada = INP[5];
        float* mod = (float*)(F.ws + WS_MOD);
        for (int cg = blockIdx.x; cg < 256; cg += F.G) {
            const int j0 = cg * 24, col = F.lane & 31, kp = F.lane >> 5;
            float a[9];
#pragma unroll
            for (int r = 0; r < 9; ++r) a[r] = 0.f;
            if (col < 24) {
#pragma unroll 1
                for (int ib = 0; ib < 64; ib += 32) { float wv[32];
#pragma unroll
                    for (int i = 0; i < 32; ++i) wv[i] = wada[(size_t)(F.wave * 128 + 2 * (ib + i) + kp) * 6144 + j0 + col];
                    __builtin_amdgcn_sched_barrier(0);
#pragma unroll
                    for (int i = 0; i < 32; ++i) { const int k = F.wave * 128 + 2 * (ib + i) + kp;
#pragma unroll
                        for (int r = 0; r < 9; ++r) a[r] += sc[r * 1024 + k] * wv[i]; } }
            }
#pragma unroll
            for (int r = 0; r < 9; ++r) red[((F.wave * 2 + kp) * 9 + r) * 32 + col] = a[r];
            __syncthreads();
            if (F.tid < 9 * 32) { const int r = F.tid >> 5, cc = F.tid & 31;
                if (cc < 24) { float s = 0.f; for (int p = 0; p < 16; ++p) s += red[(p * 9 + r) * 32 + cc]; const int j = j0 + cc; s += bada[j];
                    if (r < 8) mod[r * 6144 + j] = s; else if (j < 2048) mod[8 * 6144 + j] = s; } }
            __syncthreads();
        }
    }
    {
        constexpr int NITEMS0 = NITEMS - I_EIN - I_EOUT;
        while (it < NITEMS0) {
            const int nx = it + NGW;
            if (nx < NITEMS0) { P0_DECODE(nx, tb); titem_load(tb, F.lane, rb); }
            titem_store(ta, F.lane, ra, scr);
            ta = tb;
#pragma unroll
            for (int i = 0; i < 8; ++i) ra[i] = rb[i];
            it = nx;
        }
    }
#undef P0_DECODE
    { const int gt = blockIdx.x * (NWAVES * 64) + F.tid, NT = F.G * NWAVES * 64; GAS v4u* z = (GAS v4u*)((unsigned char*)WIN + (size_t)5664 * 1024);
        for (int i = gt; i < 224 * 1024 / 16; i += NT) z[i] = (v4u){0u, 0u, 0u, 0u}; }
}

__device__ __forceinline__ void p1_norm1(Frame& F, const float* const* __restrict__ INP) {
    const int gw = F.vcu * NWAVES + F.wave, NGW = F.G * NWAVES;
    const float* mod = (const float*)(F.ws + WS_MOD); bf16* H1 = (bf16*)(F.ws + WS_H1);
    f32x4 g1v[4];
#pragma unroll
    for (int j = 0; j < 4; ++j) g1v[j] = *(const f32x4*)(INP[6] + 256 * j + 4 * F.lane);
    for (int m = gw; m < MT; m += NGW) {
        const float* xr; const float* sh; const float* scl;
        if (m < ML) { const int b = m / SEQ; xr = INP[0] + (size_t)m * D; sh = mod + b * 6144; scl = sh + D; }
        else { xr = INP[2] + (size_t)(m - ML) * D; sh = mod + 8 * 6144; scl = sh + D; }
        f32x4 v[4], av[4], bv[4]; float s = 0.f;
#pragma unroll
        for (int j = 0; j < 4; ++j) { v[j] = __builtin_nontemporal_load((const f32x4*)(xr + 256 * j + 4 * F.lane)); av[j] = *(const f32x4*)(scl + 256 * j + 4 * F.lane); bv[j] = *(const f32x4*)(sh + 256 * j + 4 * F.lane); }
        __builtin_amdgcn_sched_barrier(0);
#pragma unroll
        for (int j = 0; j < 4; ++j) s += (v[j][0] * v[j][0] + v[j][1] * v[j][1]) + (v[j][2] * v[j][2] + v[j][3] * v[j][3]);
        const float rstd = __builtin_amdgcn_rsqf(wave_sum(s) * (1.0f / D) + EPS);
#pragma unroll
        for (int j = 0; j < 4; ++j) { const int c = 256 * j + 4 * F.lane; const f32x4 g = g1v[j], a = av[j], bb = bv[j];
            const f32x4 y = v[j] * rstd * g * (a + 1.0f) + bb;
            *(unsigned*)((unsigned char*)H1 + (size_t)m * D + c) = pk4_fp8(y[0], y[1], y[2], y[3]); }
    }
}

__device__ __forceinline__ void conv_fma8(float (&a)[8], const v4u x, const float* wp) {
    const f32x4 w0 = *(const f32x4*)(wp), w1 = *(const f32x4*)(wp + 4);
    a[0] += bflo(x.x) * w0[0]; a[1] += bfhi(x.x) * w0[1]; a[2] += bflo(x.y) * w0[2]; a[3] += bfhi(x.y) * w0[3];
    a[4] += bflo(x.z) * w1[0]; a[5] += bfhi(x.z) * w1[1]; a[6] += bflo(x.w) * w1[2]; a[7] += bfhi(x.w) * w1[3];
}
__device__ __forceinline__ void p3_conv(Frame& F, const float* const* __restrict__ INP) {
    const bf16* PROJ = (const bf16*)(F.ws + WS_PROJ); bf16* QKC = (bf16*)(F.ws + WS_QKC); const float* wc = INP[9];
    const int NT = F.G * NWAVES * 64;
    f32x4 wq[9][2];
    { const int chw = ((F.vcu * (NWAVES * 64) + F.tid) & 127) * 8;
#pragma unroll
        for (int tap = 0; tap < 9; ++tap) { wq[tap][0] = *(const f32x4*)(wc + tap * 1024 + chw); wq[tap][1] = *(const f32x4*)(wc + tap * 1024 + chw + 4); } }
    for (int it = F.vcu * (NWAVES * 64) + F.tid; it < NB * 64 * 16 * 128; it += NT) {
        const int ch0 = (it & 127) * 8, seg = (it >> 7) & 15, gr = (it >> 11) & 63, b = it >> 17, c0 = seg * 4;
        const bf16* base = PROJ + (size_t)(b * SEQ) * LDP + ch0;
        const float scale = ch0 < 512 ? 0.125f : 1.0f;
        v4u win[6][3];
        const v4u z = (v4u){0u, 0u, 0u, 0u};
#pragma unroll
        for (int cc = 0; cc < 6; ++cc)
#pragma unroll
            for (int ky = 0; ky < 3; ++ky) { const int rr = gr + ky - 1, c = c0 + cc - 1;
                win[cc][ky] = (rr >= 0 && rr < 64 && c >= 0 && c < 64) ? *(const v4u*)(base + (size_t)(rr * 64 + c) * LDP) : z; }
        __builtin_amdgcn_sched_barrier(0);
        float a[4][8];
#pragma unroll
        for (int cc = 0; cc < 4; ++cc)
#pragma unroll
            for (int j = 0; j < 8; ++j) a[cc][j] = 0.f;
#pragma unroll
        for (int ky = 0; ky < 3; ++ky) {
            float xf[6][8];
#pragma unroll
            for (int cc = 0; cc < 6; ++cc) { const v4u x = win[cc][ky];
                xf[cc][0] = bflo(x.x); xf[cc][1] = bfhi(x.x); xf[cc][2] = bflo(x.y); xf[cc][3] = bfhi(x.y); xf[cc][4] = bflo(x.z); xf[cc][5] = bfhi(x.z); xf[cc][6] = bflo(x.w); xf[cc][7] = bfhi(x.w); }
#pragma unroll
            for (int kx = 0; kx < 3; ++kx) { const f32x4 w0 = wq[ky * 3 + kx][0], w1 = wq[ky * 3 + kx][1];
#pragma unroll
                for (int cc = 0; cc < 4; ++cc) {
#pragma unroll
                    for (int j = 0; j < 4; ++j) { a[cc][j] += xf[cc + kx][j] * w0[j]; a[cc][4 + j] += xf[cc + kx][4 + j] * w1[j]; } } }
            asm volatile("" ::: "memory");
        }
#pragma unroll
        for (int cc = 0; cc < 4; ++cc) {
#pragma unroll
            for (int j = 0; j < 8; ++j) a[cc][j] = a[cc][j] * frcp(1.0f + __expf(-a[cc][j])) * scale;
            *(v4u*)(QKC + (size_t)(b * SEQ + gr * 64 + c0 + cc) * 1024 + ch0) = (v4u){pk2(a[cc][0], a[cc][1]), pk2(a[cc][2], a[cc][3]), pk2(a[cc][4], a[cc][5]), pk2(a[cc][6], a[cc][7])};
        }
    }
    for (int w = F.vcu * (NWAVES * 64) + F.tid; w < MC * 128; w += NT) {
        const int row = ML + (w >> 7), ch0 = (w & 127) * 8, t = (w >> 7) % CTXL;
        float a[8];
#pragma unroll
        for (int j = 0; j < 8; ++j) a[j] = 0.f;
#pragma unroll
        for (int kx = 0; kx < 3; ++kx) { const int tt = t + kx - 1;
            if (tt >= 0 && tt < CTXL) conv_fma8(a, *(const v4u*)(PROJ + (size_t)(row + kx - 1) * LDP + ch0), wc + (3 + kx) * 1024 + ch0); }
        const float scale = ch0 < 512 ? 0.125f : 1.0f;
#pragma unroll
        for (int j = 0; j < 8; ++j) a[j] = a[j] * frcp(1.0f + __expf(-a[j])) * scale;
        *(v4u*)(QKC + (size_t)row * 1024 + ch0) = (v4u){pk2(a[0], a[1]), pk2(a[2], a[3]), pk2(a[4], a[5]), pk2(a[6], a[7])};
    }
    {
        float* GB = (float*)(F.ws + WS_GS); float* GG = GB + 128 * 4352; float* GP = GG + 128 * 4352;
        const int gw = F.vcu * NWAVES + F.wave, NGW = F.G * NWAVES, lane = F.lane;
        for (int it = gw; it < 128 * 34; it += NGW) {
            const int jc = it % 34, dbh = it / 34, h = dbh & 7, b = (dbh >> 3) & 7, d = dbh >> 6;
            const bool lat = jc >= 2; const int p0 = lat ? 128 * (jc - 2) : 128 * jc, Lseq = lat ? SEQ : CTXL, rowbase = lat ? b * SEQ : ML + b * CTXL;
            const float bi_ = INP[10][d * 16 + h], bf_ = INP[10][d * 16 + 8 + h];
            float li2[2], lf2[2];
#pragma unroll
            for (int e = 0; e < 2; ++e) { const int sp = 2 * lane + e; const int tt = d ? (Lseq - 1 - (p0 + sp)) : (p0 + sp); const size_t row = (size_t)(rowbase + tt);
                li2[e] = bf2f(PROJ[row * LDP + PC_IF + d * 16 + h]) + bi_; const float xf = bf2f(PROJ[row * LDP + PC_IF + d * 16 + 8 + h]) + bf_;
                lf2[e] = fminf(xf, 0.f) - __logf(1.0f + __expf(-fabsf(xf))); }
            const float c1 = lf2[0] + lf2[1]; const float inc = wave_scan_sum(c1);
            const float exc = inc - c1, b0 = exc + lf2[0], b1 = exc + c1, g0 = li2[0] - b0, g1 = li2[1] - b1;
            const float pmx = wave_scan_max(fmaxf(g0, g1));
            const float pex = DPPF(-INFINITY, pmx, 0x138, 0xf);
            const size_t o = (size_t)dbh * 4352 + 128 * jc + 2 * lane;
            *(float2*)(GB + o) = make_float2(b0, b1); *(float2*)(GG + o) = make_float2(g0, g1); *(float2*)(GP + o) = make_float2(fmaxf(pex, g0), pmx);
        }
    }
}

__device__ __forceinline__ void mma32_nt(f32x16& acc, const LAS bf16* A, int lda, const LAS bf16* Bt, int ldb, int K, int lane) {
    const int r = lane & 31, h = lane >> 5;
#pragma unroll
    for (int k0 = 0; k0 < K; k0 += 16) {
        const bf16x8 a = *(const LAS bf16x8*)(A + r * lda + k0 + 8 * h);
        const bf16x8 b = *(const LAS bf16x8*)(Bt + r * ldb + k0 + 8 * h);
        acc = __builtin_amdgcn_mfma_f32_32x32x16_bf16(a, b, acc, 0, 0, 0);
        if ((k0 & 63) == 48) __builtin_amdgcn_sched_barrier(0);
    }
}
__device__ __forceinline__ void mma16_nt(f32x4& acc, const LAS bf16* A, int lda, const LAS bf16* Bt, int ldb, int K, int lane) {
    const int r = lane & 15, q = lane >> 4;
    for (int k0 = 0; k0 < K; k0 += 32) {
        const bf16x8 a = *(const LAS bf16x8*)(A + r * lda + k0 + 8 * q);
        const bf16x8 b = *(const LAS bf16x8*)(Bt + r * ldb + k0 + 8 * q);
        acc = __builtin_amdgcn_mfma_f32_16x16x32_bf16(a, b, acc, 0, 0, 0);
    }
}
__device__ __forceinline__ int row32(int reg, int lane) { return (reg & 3) + 8 * (reg >> 2) + 4 * (lane >> 5); }
__device__ __forceinline__ float logsigmoidf_(float x) { return fminf(x, 0.f) - log1pf(expf(-fabsf(x))); }

typedef short s16x4 __attribute__((ext_vector_type(4)));
__device__ __forceinline__ s16x4 tr_read(const LAS bf16* p) { return __builtin_amdgcn_ds_read_tr16_b64_v4i16((LAS s16x4*)p); }
__device__ __forceinline__ bf16x8 tr_frag32_perm(const LAS bf16* T, int ld, int k0, int x0, int lane) {
    const int h = lane >> 5, i = lane & 15, q = i >> 2, p = i & 3, xb = 16 * ((lane >> 4) & 1);
    const LAS bf16* a = T + (k0 + 4 * h + q) * ld + x0 + xb + 4 * p;
    const s16x4 lo = tr_read(a), hi = tr_read(a + 8 * ld);
    return (bf16x8){lo[0], lo[1], lo[2], lo[3], hi[0], hi[1], hi[2], hi[3]};
}
__device__ __forceinline__ bf16x8 tr_frag16(const LAS bf16* T, int ld, int k0, int x0, int lane) {
    const int q4 = lane >> 4, i = lane & 15, q = i >> 2, p = i & 3;
    const LAS bf16* a = T + (k0 + 8 * q4 + q) * ld + x0 + 4 * p;
    const s16x4 lo = tr_read(a), hi = tr_read(a + 4 * ld);
    return (bf16x8){lo[0], lo[1], lo[2], lo[3], hi[0], hi[1], hi[2], hi[3]};
}
__device__ __forceinline__ v4u scale8(const v4u k8, float ww) {
    return (v4u){pk2(ww * bflo(k8.x), ww * bfhi(k8.x)), pk2(ww * bflo(k8.y), ww * bfhi(k8.y)), pk2(ww * bflo(k8.z), ww * bfhi(k8.z)), pk2(ww * bflo(k8.w), ww * bfhi(k8.w))};
}

constexpr int XI_EIN = 32 * 64 * 16, XI_EOUT = 32 * 32 * 16, XI_PER_UNIT = (XI_EIN + XI_EOUT) / 256;
__device__ __forceinline__ void xitem_decode(const float* const* __restrict__ INP, unsigned char* ws, int r, const float*& src, int& ld, unsigned char*& dst) {
    if (r < XI_EIN) { const int e = r / 1024, q = r % 1024, kb = q / 64, nb = q % 64; const int dr = nb * 32, pn = dr >> 8, bj = (dr >> 7) & 1, xx = dr & 127;
        src = INP[28] + (size_t)e * 1024 * 2048 + (size_t)kb * 64 * 2048 + bj * 1024 + pn * 128 + xx; ld = 2048; dst = ws + WS_WEIN + (size_t)e * 2048 * 1024 + (size_t)dr * 1024 + kb * 64; }
    else { r -= XI_EIN; const int e = r / 512, q = r % 512, kb = q / 32, nb = q % 32;
        src = INP[30] + (size_t)e * 1024 * 1024 + (size_t)kb * 64 * 1024 + nb * 32; ld = 1024; dst = ws + WS_WEOUT + (size_t)e * 1024 * 1024 + (size_t)nb * 32 * 1024 + kb * 64; }
}
template <int MODE>
__device__ __forceinline__ void p4_mlstm(Frame& F, const float* const* __restrict__ INP, int unit) {
    const int vh = unit & 1, h = (unit >> 1) & 7, b = (unit >> 4) & 7, d = unit >> 7;
    LAS bf16* Qs = (LAS bf16*)(F.lds + 0);
    LAS bf16* Kw = (LAS bf16*)(F.lds + 36864);
    LAS bf16* Vs = (LAS bf16*)(F.lds + 55296);
    LAS bf16* Cb = (LAS bf16*)(F.lds + 73728);
    LAS float* vec = (LAS float*)(F.lds + 82944);
    LAS float *rowt = vec, *colt = vec + 128, *iev = vec + 256, *emt = vec + 384, *nv = vec + 512, *npart = vec + 576;
    const bf16* PROJ = (const bf16*)(F.ws + WS_PROJ); const bf16* QKC = (const bf16*)(F.ws + WS_QKC); unsigned char* HDIR = F.ws + WS_HDIR + (size_t)((((d * 8 + b) * 8 + h) * 2 + vh)) * SEQ * 64;
    const float* GB = (const float*)(F.ws + WS_GS) + (size_t)((d * 8 + b) * 8 + h) * 4352; const float* GG = GB + 128 * 4352; const float* GP = GG + 128 * 4352;
    int tid = F.tid; asm volatile("" : "+v"(tid));
    const int lane = tid & 63, w = F.wave;
    for (int i = tid; i < 64 * 72; i += 512) Cb[i] = 0;
    if (tid < 64) nv[tid] = 0.f;
    f32x4 accC[2] = {(f32x4){0.f, 0.f, 0.f, 0.f}, (f32x4){0.f, 0.f, 0.f, 0.f}};
    float m_old = 0.f, dec_prev = 0.f, sc_prev = 0.f;
    v4u pq[2], pk[2], pv[2]; float pgb = 0.f, pgp = 0.f, pgc = 0.f, pgg[2], pbend, pgmax; bool hpend = false; int hp0 = 0, hrb = 0, hL = 0;
    LAS unsigned char* Hst = F.lds + 140544;
    f32x4 xr[8]; v2u xo[4]; unsigned char* xdst = nullptr; unsigned char* xodst = nullptr; bool xload = false;
    const int xw = w - 2;
    LAS float* xscr = (LAS float*)(F.lds + (xw < 5 ? 87296 + (xw < 0 ? 0 : xw) * 8448 : 132096));
    const int zl = tid >> 9;
#define ML_PREFETCH(jn) do { const bool lat_ = (jn) >= 2; const int p0_ = lat_ ? 128 * ((jn) - 2) : 128 * (jn), L_ = lat_ ? SEQ : CTXL, rb_ = lat_ ? b * SEQ : ML + b * CTXL; \
        _Pragma("unroll") for (int i = 0; i < 2; ++i) { const int id = tid + 512 * i, s_ = id >> 3, c_ = id & 7; const int tt = d ? (L_ - 1 - (p0_ + s_)) : (p0_ + s_); const size_t row = (size_t)(rb_ + tt); \
            pq[i] = *(const v4u*)(QKC + row * 1024 + h * 64 + c_ * 8); pk[i] = *(const v4u*)(QKC + row * 1024 + 512 + h * 64 + c_ * 8); pv[i] = *(const v4u*)(PROJ + row * LDP + PC_V + h * 128 + vh * 64 + c_ * 8); \
            pgg[i] = GG[128 * (jn) + s_]; } \
        if (tid < 128) { pgb = GB[128 * (jn) + tid]; pgp = GP[128 * (jn) + tid]; pgc = GG[128 * (jn) + tid]; } \
        pbend = GB[128 * (jn) + 127 + zl]; pgmax = GP[128 * (jn) + 127 + zl]; } while (0)
    ML_PREFETCH(0);
    __syncthreads();
    for (int j = 0; j < 34; ++j) {
        const bool lat = j >= 2;
        const int p0 = lat ? 128 * (j - 2) : 128 * j, Lseq = lat ? SEQ : CTXL, rowbase = lat ? b * SEQ : ML + b * CTXL;
        const float bend = pbend, gmax = pgmax;
        const float mnew = fmaxf(bend + m_old, bend + gmax), dec = __expf(bend + m_old - mnew);
#pragma unroll
        for (int i = 0; i < 2; ++i) { const int id = tid + 512 * i, s = id >> 3, c = id & 7;
            *(LAS v4u*)(Qs + s * 72 + c * 8) = pq[i]; *(LAS v4u*)(Vs + s * 72 + c * 8) = pv[i];
            *(LAS v4u*)(Kw + s * 72 + c * 8) = scale8(pk[i], __expf(pgg[i] - gmax)); }
        if (tid < 128) emt[tid] = __expf(-pgb - gmax);
        const float s0 = __expf(m_old - gmax), sc = __expf(bend + gmax - mnew);
        if (hpend) {
            { const int r = tid >> 2, c = tid & 3; const int tt = d ? (hL - 1 - (hp0 + r)) : (hp0 + r);
                *(v4u*)(HDIR + (size_t)tt * 64 + 16 * c) = *(const LAS v4u*)(Hst + r * 80 + 16 * c); }
            hpend = false; }
        if (j > 0) {
            const int vi = w >> 1;
#pragma unroll
            for (int jj = 0; jj < 2; ++jj) { const int ki = 2 * (w & 1) + jj;
#pragma unroll
                for (int reg = 0; reg < 4; ++reg) Cb[(16 * vi + (lane >> 4) * 4 + reg) * 72 + 16 * ki + (lane & 15)] = (bf16)cvtpk(accC[jj][reg], 0.f); }
            if (tid < 64) { float sacc = 0.f;
#pragma unroll
                for (int p = 0; p < 8; ++p) sacc += npart[p * 64 + tid];
                nv[tid] = dec_prev * nv[tid] + sc_prev * sacc; }
        }
        LBAR();
        if (MODE == 0 && xw >= 0) {
            if (xload) {
#pragma unroll
                for (int i = 0; i < 8; ++i) { LAS float* p = xscr + (8 * i + (lane >> 3)) * 33 + 4 * (lane & 7); p[0] = xr[i][0]; p[1] = xr[i][1]; p[2] = xr[i][2]; p[3] = xr[i][3]; }
                LDS_WAIT(); asm volatile("" ::: "memory");
                const int c = lane & 7;
#pragma unroll
                for (int q = 0; q < 4; ++q) { const LAS float* sp = xscr + (8 * c) * 33 + (lane >> 3) + 8 * q;
                    xo[q] = (v2u){pk4_fp8(32.f * sp[0 * 33], 32.f * sp[1 * 33], 32.f * sp[2 * 33], 32.f * sp[3 * 33]), pk4_fp8(32.f * sp[4 * 33], 32.f * sp[5 * 33], 32.f * sp[6 * 33], 32.f * sp[7 * 33])}; }
                xodst = xdst + (size_t)(lane >> 3) * 1024 + 8 * c;
#pragma unroll
                for (int q = 0; q < 4; ++q) __builtin_nontemporal_store(xo[q], (GAS v2u*)(xodst + (size_t)(8 * q) * 1024));
                xload = false; }
            const int sl = j * 6 + xw;
            if (sl < XI_PER_UNIT) { const float* xsrc; int xld; xitem_decode(INP, F.ws, unit * XI_PER_UNIT + sl, xsrc, xld, xdst);
#pragma unroll
                for (int i = 0; i < 8; ++i) xr[i] = __builtin_nontemporal_load((const f32x4*)(xsrc + (size_t)(8 * i + (lane >> 3)) * xld + 4 * (lane & 7)));
                xload = true; }
        }
        if (j + 1 < 34 && !(MODE & 4)) ML_PREFETCH(j + 1);
        if (lat && !(MODE & 1)) { const int tm = ((w >> 1) == 0 ? 3 : (w >> 1) == 1 ? 2 : (w >> 1) == 2 ? 0 : 1), vt = w & 1, tl = lane & 31, t = 32 * tm + tl, hh = lane >> 5; f32x16 acc;
#pragma unroll
            for (int reg = 0; reg < 16; ++reg) acc[reg] = 0.f;
            mma32_nt(acc, Cb + 32 * vt * 72, 72, Qs + 32 * tm * 72, 72, 64, lane);
#pragma unroll
            for (int reg = 0; reg < 16; ++reg) acc[reg] *= s0;
            float rs = 0.f;
            for (int st = (MODE & 8) ? tm : 0; st <= tm; ++st) {
                f32x16 X;
#pragma unroll
                for (int reg = 0; reg < 16; ++reg) X[reg] = 0.f;
                mma32_nt(X, Kw + 32 * st * 72, 72, Qs + 32 * tm * 72, 72, 64, lane);
                if (st == tm) { const int dlim = tl - 4 * hh;
#pragma unroll
                    for (int rg = 0; rg < 4; ++rg)
#pragma unroll
                        for (int e = 0; e < 4; ++e) { const float pvv = (8 * rg + e <= dlim) ? X[4 * rg + e] : 0.f; X[4 * rg + e] = pvv; rs += pvv; }
                } else {
#pragma unroll
                    for (int reg = 0; reg < 16; ++reg) rs += X[reg];
                }
#pragma unroll
                for (int ks = 0; ks < 2; ++ks) {
                    const v4u bw = (v4u){cvtpk(X[8 * ks], X[8 * ks + 1]), cvtpk(X[8 * ks + 2], X[8 * ks + 3]), cvtpk(X[8 * ks + 4], X[8 * ks + 5]), cvtpk(X[8 * ks + 6], X[8 * ks + 7])};
                    const bf16x8 af = tr_frag32_perm(Vs, 72, 32 * st + 16 * ks, 32 * vt, lane);
                    acc = __builtin_amdgcn_mfma_f32_32x32x16_bf16(af, __builtin_bit_cast(bf16x8, bw), acc, 0, 0, 0); }
            }
            float nq = 0.f;
#pragma unroll
            for (int q = 0; q < 4; ++q) { const v4u q8 = *(const LAS v4u*)(Qs + t * 72 + 32 * hh + 8 * q); const LAS float* nn = nv + 32 * hh + 8 * q;
                nq += bflo(q8.x) * nn[0] + bfhi(q8.x) * nn[1] + bflo(q8.y) * nn[2] + bfhi(q8.y) * nn[3] + bflo(q8.z) * nn[4] + bfhi(q8.z) * nn[5] + bflo(q8.w) * nn[6] + bfhi(q8.w) * nn[7]; }
            rs += __shfl_xor(rs, 32); nq += __shfl_xor(nq, 32);
            const float rd = frcp(fmaxf(fabsf(s0 * nq + rs), emt[t]));
            LAS unsigned char* hs = Hst + t * 80 + 32 * vt + 4 * hh; const float rd8 = rd * 8.0f;
#pragma unroll
            for (int rg = 0; rg < 4; ++rg) *(LAS unsigned*)(hs + 8 * rg) = pk4_fp8(acc[4 * rg] * rd8, acc[4 * rg + 1] * rd8, acc[4 * rg + 2] * rd8, acc[4 * rg + 3] * rd8); }
        if (lat && !(MODE & 1)) { hpend = true; hp0 = p0; hrb = rowbase; hL = Lseq; }
        if (!(MODE & 2)) { const int vi = w >> 1;
            f32x4 upd[2] = {(f32x4){0.f, 0.f, 0.f, 0.f}, (f32x4){0.f, 0.f, 0.f, 0.f}};
#pragma unroll
            for (int st4 = 0; st4 < 4; ++st4) { const bf16x8 af = tr_frag16(Vs, 72, 32 * st4, 16 * vi, lane);
#pragma unroll
                for (int jj = 0; jj < 2; ++jj) { const bf16x8 bfr = tr_frag16(Kw, 72, 32 * st4, 16 * (2 * (w & 1) + jj), lane); upd[jj] = __builtin_amdgcn_mfma_f32_16x16x32_bf16(af, bfr, upd[jj], 0, 0, 0); } }
            accC[0] = accC[0] * dec + upd[0] * sc; accC[1] = accC[1] * dec + upd[1] * sc; }
        { const int k = tid & 63, part = tid >> 6; float sacc = 0.f;
#pragma unroll
            for (int q = 0; q < 16; ++q) sacc += bf2f(Kw[(16 * part + q) * 72 + k]);
            npart[part * 64 + k] = sacc; }
        m_old = mnew; dec_prev = dec; sc_prev = sc;
        LBAR();
    }
    if (hpend) {
        { const int r = tid >> 2, c = tid & 3; const int tt = d ? (hL - 1 - (hp0 + r)) : (hp0 + r);
            *(v4u*)(HDIR + (size_t)tt * 64 + 16 * c) = *(const LAS v4u*)(Hst + r * 80 + 16 * c); } }
#undef ML_PREFETCH
}

__device__ __forceinline__ void s5_disc(const float* const* __restrict__ INP, int d, int g, int p, float& ar, float& ai, float& cfr, float& cfi) {
    const float dt = expf(INP[15][d * 32 + g]); const float are = INP[13][(d * 32 + g) * 64 + p], aim = INP[14][(d * 32 + g) * 64 + p];
    const float mag = expf(dt * are), ang = dt * aim; ar = mag * cosf(ang); ai = mag * sinf(ang);
    const float den = are * are + aim * aim, xr = ar - 1.0f; cfr = (xr * are + ai * aim) / den; cfi = (ai * are - xr * aim) / den;
}
template <int SMODE>
__device__ __forceinline__ void p4_s5(Frame& F, const float* const* __restrict__ INP, int unit) {
    const int gp = unit & 15, b = (unit >> 4) & 7, d = unit >> 7;
    LAS bf16* BHt = (LAS bf16*)(F.lds + 0);
    LAS bf16* Cm = (LAS bf16*)(F.lds + 69632);
    LAS float* Eb = (LAS float*)(F.lds + 78336);
    LAS bf16* Us = (LAS bf16*)(F.lds + 82432);
    LAS bf16* UsB = (LAS bf16*)(F.lds + 116224);
    LAS bf16* BBs = (LAS bf16*)(F.lds + 92672);
    const bf16* PROJ = (const bf16*)(F.ws + WS_PROJ); bf16* YDIR = (bf16*)(F.ws + WS_YDIR) + (size_t)(((d * 8 + b) * 16 + gp)) * SEQ * 32;
    LAS bf16* Yst = (LAS bf16*)(F.lds + 104960);
    int tid = F.tid; asm volatile("" : "+v"(tid));
    const int lane = tid & 63, w = F.wave;
    const int sg = tid & 127, seg = tid >> 7;
    float ar, ai, a32r, a32i;
    float a8r = 0.f, a8i = 0.f;
    LAS float* cfs = (LAS float*)(F.lds + 115200);
    { float cfr, cfi; s5_disc(INP, d, 2 * gp + (sg >> 6), sg & 63, ar, ai, cfr, cfi); a32r = ar; a32i = ai;
        if (tid < 128) { cfs[2 * tid] = cfr; cfs[2 * tid + 1] = cfi; }
#pragma unroll
        for (int q = 0; q < 5; ++q) { const float nr = a32r * a32r - a32i * a32i, ni = 2.0f * a32r * a32i; a32r = nr; a32i = ni; if (q == 2) { a8r = nr; a8i = ni; } } }
    { float bre[8], bim[8], cv[8];
#pragma unroll
        for (int q = 0; q < 8; ++q) { const int idx = tid + 512 * q;
            { const int gg = idx >> 11, pp = (idx >> 4) & 127, c = idx & 15, g = 2 * gp + gg, p = pp & 63; bre[q] = INP[16][((size_t)(d * 32 + g) * 64 + p) * 16 + c]; bim[q] = INP[17][((size_t)(d * 32 + g) * 64 + p) * 16 + c]; }
            { const int gg = idx >> 11, c = (idx >> 7) & 15, pp = idx & 127, g = 2 * gp + gg, p = pp & 63; cv[q] = pp < 64 ? INP[18][((size_t)(d * 32 + g) * 16 + c) * 64 + p] : -INP[19][((size_t)(d * 32 + g) * 16 + c) * 64 + p]; } }
        __syncthreads();
#pragma unroll
        for (int q = 0; q < 8; ++q) { const int idx = tid + 512 * q;
            { const int gg = idx >> 11, pp = (idx >> 4) & 127, c = idx & 15, p = pp & 63; const float cfr = cfs[2 * (gg * 64 + p)], cfi = cfs[2 * (gg * 64 + p) + 1];
                BBs[(gg * 128 + pp) * 24 + c] = (bf16)f2bf(pp < 64 ? cfr * bre[q] - cfi * bim[q] : cfr * bim[q] + cfi * bre[q]); }
            { const int gg = idx >> 11, c = (idx >> 7) & 15, pp = idx & 127; Cm[(gg * 16 + c) * 136 + pp] = (bf16)f2bf(cv[q]); } } }
    float h0r = 0.f, h0i = 0.f;
    LAS bf16* rowre = BHt + ((sg >> 6) * 128 + (sg & 63)) * 136 + 32 * seg;
    v4u pu; bool ypend = false; int yp0 = 0, yL = 0;
#define S5_PREFETCH(jn) do { const bool lat_ = (jn) >= 2; const int p0_ = lat_ ? 128 * ((jn) - 2) : 128 * (jn), L_ = lat_ ? SEQ : CTXL, rb_ = lat_ ? b * SEQ : ML + b * CTXL; \
        const int s_ = tid >> 2, c_ = tid & 3; const int tt = d ? (L_ - 1 - (p0_ + s_)) : (p0_ + s_); pu = *(const v4u*)(PROJ + (size_t)(rb_ + tt) * LDP + PC_U + gp * 32 + c_ * 8); } while (0)
    S5_PREFETCH(0);
    *(LAS v4u*)(Us + (tid >> 2) * 40 + (tid & 3) * 8) = pu;
    S5_PREFETCH(1);
    __syncthreads();
    for (int j = 0; j < 34; ++j) {
        const bool lat = j >= 2;
        const int p0 = lat ? 128 * (j - 2) : 128 * j, Lseq = lat ? SEQ : CTXL, rowbase = lat ? b * SEQ : ML + b * CTXL;
        const LAS bf16* Uc = (j & 1) ? UsB : Us;
        { const int gg = w >> 2, tm = w & 3, r = lane & 31, hh = lane >> 5;
            const bf16x8 a = *(const LAS bf16x8*)(Uc + (32 * tm + r) * 40 + gg * 16 + 8 * hh);
            LAS bf16* bp = BHt + (gg * 128 + r) * 136 + 32 * tm + 4 * hh;
#pragma unroll
            for (int tn = 0; tn < 4; ++tn) { f32x16 acc;
#pragma unroll
                for (int reg = 0; reg < 16; ++reg) acc[reg] = 0.f;
                const bf16x8 bb = *(const LAS bf16x8*)(BBs + (gg * 128 + 32 * tn + r) * 24 + 8 * hh);
                acc = __builtin_amdgcn_mfma_f32_32x32x16_bf16(a, bb, acc, 0, 0, 0);
#pragma unroll
                for (int rg = 0; rg < 4; ++rg) *(LAS v2u*)(bp + 32 * tn * 136 + 8 * rg) = (v2u){cvtpk(acc[4 * rg], acc[4 * rg + 1]), cvtpk(acc[4 * rg + 2], acc[4 * rg + 3])}; } }
        LBAR();
        if (ypend) { if (!(SMODE & 1)) { const int r = tid >> 2, c = tid & 3; const int tt = d ? (yL - 1 - (yp0 + r)) : (yp0 + r); *(v4u*)(YDIR + (size_t)tt * 32 + 8 * c) = *(const LAS v4u*)(Yst + r * 40 + 8 * c); } ypend = false; }
        v4u xr[4], xi[4];
#pragma unroll
        for (int q = 0; q < 4; ++q) { xr[q] = *(const LAS v4u*)(rowre + 8 * q); xi[q] = *(const LAS v4u*)(rowre + 64 * 136 + 8 * q); }
        const f32x2 A1 = {ar, ar}, A2 = {-ai, ai}, B1 = {a8r, a8r}, B2 = {-a8i, a8i};
#define S5_CFMA(P1, P2, h, b) __builtin_elementwise_fma(P2, __builtin_shufflevector(h, h, 1, 0), __builtin_elementwise_fma(P1, h, b))
        f32x2 ec[4];
        {
#pragma unroll
            for (int c = 0; c < 4; ++c) ec[c] = (f32x2){0.f, 0.f};
#pragma unroll
            for (int e = 0; e < 4; ++e) {
#pragma unroll
                for (int c = 0; c < 4; ++c) { const f32x2 b_ = {bflo(xr[c][e]), bflo(xi[c][e])}; ec[c] = S5_CFMA(A1, A2, ec[c], b_); }
#pragma unroll
                for (int c = 0; c < 4; ++c) { const f32x2 b_ = {bfhi(xr[c][e]), bfhi(xi[c][e])}; ec[c] = S5_CFMA(A1, A2, ec[c], b_); } }
            f32x2 E = ec[0];
#pragma unroll
            for (int c = 1; c < 4; ++c) E = S5_CFMA(B1, B2, E, ec[c]);
            *(LAS f32x2*)(Eb + (seg * 128 + sg) * 2) = E; }
        LBAR();
        { float hcr = h0r, hci = h0i, hr = 0.f, hi = 0.f;
#pragma unroll
            for (int s2 = 0; s2 < 4; ++s2) { if (s2 == seg) { hr = hcr; hi = hci; } const float er = Eb[(s2 * 128 + sg) * 2], ei = Eb[(s2 * 128 + sg) * 2 + 1];
                const float nr = a32r * hcr - a32i * hci + er, ni = a32r * hci + a32i * hcr + ei; hcr = nr; hci = ni; }
            h0r = hcr; h0i = hci;
            f32x2 sc4[4]; sc4[0] = (f32x2){hr, hi};
#pragma unroll
            for (int c = 1; c < 4; ++c) sc4[c] = S5_CFMA(B1, B2, sc4[c - 1], ec[c - 1]);
            v4u orr[4], oi[4];
#pragma unroll
            for (int e = 0; e < 4; ++e) { f32x2 ha[4];
#pragma unroll
                for (int c = 0; c < 4; ++c) { const f32x2 b_ = {bflo(xr[c][e]), bflo(xi[c][e])}; sc4[c] = S5_CFMA(A1, A2, sc4[c], b_); ha[c] = sc4[c]; }
#pragma unroll
                for (int c = 0; c < 4; ++c) { const f32x2 b_ = {bfhi(xr[c][e]), bfhi(xi[c][e])}; sc4[c] = S5_CFMA(A1, A2, sc4[c], b_); orr[c][e] = cvtpk(ha[c][0], sc4[c][0]); oi[c][e] = cvtpk(ha[c][1], sc4[c][1]); } }
#pragma unroll
            for (int q = 0; q < 4; ++q) { *(LAS v4u*)(rowre + 8 * q) = orr[q]; *(LAS v4u*)(rowre + 64 * 136 + 8 * q) = oi[q]; } }
        if (j + 1 < 34) { *(LAS v4u*)(((j & 1) ? Us : UsB) + (tid >> 2) * 40 + (tid & 3) * 8) = pu; if (j + 2 < 34) S5_PREFETCH(j + 2); }
        LBAR();
        if (lat) { const int gg = w >> 2;
#pragma unroll
            for (int jj = 0; jj < 2; ++jj) { const int tm = 2 * (w & 3) + jj; f32x4 acc = (f32x4){0.f, 0.f, 0.f, 0.f};
#pragma unroll
                for (int st4 = 0; st4 < 4; ++st4) { const bf16x8 af = *(const LAS bf16x8*)(Cm + (gg * 16 + (lane & 15)) * 136 + 32 * st4 + 8 * (lane >> 4));
                    const bf16x8 bfr = tr_frag16(BHt + gg * 128 * 136, 136, 32 * st4, 16 * tm, lane);
                    acc = __builtin_amdgcn_mfma_f32_16x16x32_bf16(af, bfr, acc, 0, 0, 0); }
                const int t = 16 * tm + (lane & 15);
                *(LAS v2u*)(Yst + t * 40 + gg * 16 + 4 * (lane >> 4)) = (v2u){pk2(acc[0], acc[1]), pk2(acc[2], acc[3])}; }
            ypend = true; yp0 = p0; yL = Lseq; }
    }
    if (ypend && !(SMODE & 1)) { LBAR(); const int r = tid >> 2, c = tid & 3; const int tt = d ? (yL - 1 - (yp0 + r)) : (yp0 + r); *(v4u*)(YDIR + (size_t)tt * 32 + 8 * c) = *(const LAS v4u*)(Yst + r * 40 + 8 * c); }
#undef S5_PREFETCH
#undef S5_CFMA
    __syncthreads();
}

__device__ __forceinline__ float gelu_tanh(float x) { const float u = 0.7978845608028654f * (x + 0.044715f * x * x * x); const float e = __expf(2.0f * u); const float th = 1.0f - 2.0f * frcp(e + 1.0f); return 0.5f * x * (1.0f + th); }
__device__ __forceinline__ void p5a_prep(Frame& F, const float* const* __restrict__ INP) {
    const int gw = F.vcu * NWAVES + F.wave, NGW = F.G * NWAVES, lane = F.lane;
    const bf16* PROJ = (const bf16*)(F.ws + WS_PROJ); const unsigned char* HB0 = F.ws + WS_HDIR; const unsigned char* HB1 = HB0 + (size_t)ML * 1024;
    const bf16* YD0 = (const bf16*)(F.ws + WS_YDIR); const bf16* YD1 = YD0 + (size_t)ML * 512;
    bf16* A1 = (bf16*)(F.ws + WS_A1); bf16* A2 = (bf16*)(F.ws + WS_A2); const unsigned char* P8 = F.ws + WS_PROJ8;
    float gmv[16], ddv[8];
#pragma unroll
    for (int q = 0; q < 16; ++q) gmv[q] = INP[11][16 * lane + q];
#pragma unroll
    for (int q = 0; q < 8; ++q) ddv[q] = INP[20][8 * lane + q];
    for (int m0 = 2 * gw; m0 < ML; m0 += 2 * NGW) {
        v4u ha[2][2], hb[2][2], ho[2][2], ya[2], yb[2], yu[2];
#pragma unroll
        for (int r = 0; r < 2; ++r) { const size_t m = (size_t)(m0 + r); const int bb = (int)(m / SEQ), tq = (int)(m % SEQ);
            const size_t hoff = ((size_t)((bb * 8 + (lane >> 3)) * 2 + ((lane >> 2) & 1)) * SEQ + tq) * 64 + (lane & 3) * 16;
            const size_t yoff = ((size_t)(bb * 16 + (lane >> 2)) * SEQ + tq) * 32 + (lane & 3) * 8;
#pragma unroll
            for (int q = 0; q < 2; ++q) { ha[r][q] = (v4u){0u, 0u, 0u, 0u}; hb[r][q] = (v4u){0u, 0u, 0u, 0u}; ho[r][q] = (v4u){0u, 0u, 0u, 0u}; }
            { const v4u a16 = *(const v4u*)(HB0 + hoff), b16 = *(const v4u*)(HB1 + hoff); ha[r][0].x = a16.x; ha[r][0].y = a16.y; ha[r][1].x = a16.z; ha[r][1].y = a16.w; hb[r][0].x = b16.x; hb[r][0].y = b16.y; hb[r][1].x = b16.z; hb[r][1].y = b16.w; }
            { const v4u o16 = *(const v4u*)(P8 + m * 3072 + 16 * lane); ho[r][0].x = o16.x; ho[r][0].y = o16.y; ho[r][1].x = o16.z; ho[r][1].y = o16.w; }
            ya[r] = *(const v4u*)(YD0 + yoff); yb[r] = *(const v4u*)(YD1 + yoff); yu[r] = *(const v4u*)(PROJ + m * LDP + PC_U + 8 * lane); }
        __builtin_amdgcn_sched_barrier(0);
#pragma unroll
        for (int r = 0; r < 2; ++r) { const size_t m = (size_t)(m0 + r);
            float hm[16]; float ss = 0.f;
#pragma unroll
            for (int q = 0; q < 2; ++q) { f32x4 a0, a1, b0, b1; unpack8_fp8((v2u){ha[r][q].x, ha[r][q].y}, a0, a1); unpack8_fp8((v2u){hb[r][q].x, hb[r][q].y}, b0, b1);
#pragma unroll
                for (int e = 0; e < 4; ++e) { hm[8 * q + e] = (a0[e] + b0[e]) * 0.125f; hm[8 * q + 4 + e] = (a1[e] + b1[e]) * 0.125f; } }
#pragma unroll
            for (int q = 0; q < 16; ++q) ss += hm[q] * hm[q];
            ss += DPPF(0.f, ss, 0xb1, 0xf); ss += DPPF(0.f, ss, 0x4e, 0xf); ss += DPPF(0.f, ss, 0x141, 0xf);
            const float rs = __builtin_amdgcn_rsqf(ss * (1.0f / 128.0f) + EPS);
#pragma unroll
            for (int q = 0; q < 2; ++q) { const float* gm = gmv + 8 * q; f32x4 og0, og1; unpack8_fp8((v2u){ho[r][q].x, ho[r][q].y}, og0, og1);
                float rr[8]; const float og[8] = {og0[0], og0[1], og0[2], og0[3], og1[0], og1[1], og1[2], og1[3]};
#pragma unroll
                for (int e = 0; e < 8; ++e) rr[e] = hm[8 * q + e] * rs * gm[e] * sigmoidf_(og[e]);
                *(v2u*)((unsigned char*)A1 + m * 1024 + 16 * lane + 8 * q) = (v2u){pk4_fp8(rr[0], rr[1], rr[2], rr[3]), pk4_fp8(rr[4], rr[5], rr[6], rr[7])}; }
            { const v4u a = ya[r], bq = yb[r], u8 = yu[r]; const float* dd = ddv;
                float rr[8] = {bflo(a.x) + bflo(bq.x) + dd[0] * bflo(u8.x), bfhi(a.x) + bfhi(bq.x) + dd[1] * bfhi(u8.x), bflo(a.y) + bflo(bq.y) + dd[2] * bflo(u8.y), bfhi(a.y) + bfhi(bq.y) + dd[3] * bfhi(u8.y),
                               bflo(a.z) + bflo(bq.z) + dd[4] * bflo(u8.z), bfhi(a.z) + bfhi(bq.z) + dd[5] * bfhi(u8.z), bflo(a.w) + bflo(bq.w) + dd[6] * bflo(u8.w), bfhi(a.w) + bfhi(bq.w) + dd[7] * bfhi(u8.w)};
#pragma unroll
                for (int e = 0; e < 8; ++e) rr[e] = gelu_tanh(rr[e]);
                *(v2u*)((unsigned char*)A2 + m * 512 + 8 * lane) = (v2u){pk4_fp8(rr[0], rr[1], rr[2], rr[3]), pk4_fp8(rr[4], rr[5], rr[6], rr[7])}; }
        }
    }
}

__device__ __forceinline__ void route_reduce_top4(float (&acc)[32], const float* br, int lane, float (&tv)[4], int (&ti)[4]) {
#pragma unroll
    for (int i = 0; i < 16; ++i) { const float send = (lane & 32) ? acc[i] : acc[i + 16]; const float keep = (lane & 32) ? acc[i + 16] : acc[i]; acc[i] = keep + __shfl_xor(send, 32); }
#pragma unroll
    for (int i = 0; i < 8; ++i) { const float send = (lane & 16) ? acc[i] : acc[i + 8]; const float keep = (lane & 16) ? acc[i + 8] : acc[i]; acc[i] = keep + __shfl_xor(send, 16); }
#pragma unroll
    for (int i = 0; i < 4; ++i) { const float send = (lane & 8) ? acc[i] : acc[i + 4]; const float keep = (lane & 8) ? acc[i + 4] : acc[i]; acc[i] = keep + __shfl_xor(send, 8); }
#pragma unroll
    for (int i = 0; i < 2; ++i) { const float send = (lane & 4) ? acc[i] : acc[i + 2]; const float keep = (lane & 4) ? acc[i + 2] : acc[i]; acc[i] = keep + __shfl_xor(send, 4); }
    { const float send = (lane & 2) ? acc[0] : acc[1]; const float keep = (lane & 2) ? acc[1] : acc[0]; acc[0] = keep + __shfl_xor(send, 2); }
    acc[0] += __shfl_xor(acc[0], 1);
    float val = acc[0] + br[lane >> 1];
    if (lane & 1) val = -INFINITY;
#pragma unroll
    for (int r = 0; r < 4; ++r) { const float mx = wave_max(val);
        const unsigned long long bal = __ballot(val == mx); const int wl = __ffsll((long long)bal) - 1;
        tv[r] = mx; ti[r] = wl >> 1; if (lane == wl) val = -INFINITY; }
}
__device__ __forceinline__ void p6_route(Frame& F, const float* const* __restrict__ INP) {
    const bf16* X1 = (const bf16*)(F.ws + WS_X1); const float* mod = (const float*)(F.ws + WS_MOD); bf16* H2 = (bf16*)(F.ws + WS_H2);
    int* TOPE = (int*)(F.ws + WS_TOPE); int* POS = (int*)(F.ws + WS_POS); float* TOPP = (float*)(F.ws + WS_TOPP); int* LIST = (int*)(F.ws + WS_LIST);
    LAS float* Wt = (LAS float*)(F.lds);
    LAS int* pe = (LAS int*)(F.lds + LDSCTL_OFF + 1024); LAS int* hist = pe + 512; LAS int* base = hist + 32; LAS int* rank = base + 32;
    const float* wr = INP[26]; const float* br = INP[27];
    const int lane = F.lane, w = F.wave;
    {
        f32x4 wv[16];
#pragma unroll
        for (int q = 0; q < 16; ++q) { const int id = F.tid + 512 * q, k = id >> 3, e4 = id & 7; wv[q] = *(const f32x4*)(wr + k * 32 + 4 * e4); }
#pragma unroll
        for (int q = 0; q < 16; ++q) { const int id = F.tid + 512 * q, k = id >> 3, e4 = id & 7; *(LAS f32x4*)(Wt + (((((k >> 8) * 4 + (k & 3)) * 8 + e4) * 64 + ((k >> 2) & 63)) << 2)) = wv[q]; }
    }
    __syncthreads();
    for (int tg = blockIdx.x; tg < ML / 128; tg += F.G) {
        if (F.tid < 32) hist[F.tid] = 0;
        __syncthreads();
#pragma unroll 1
        for (int q = 0; q < 16; q += 2) {
            const int tl = w * 16 + q, m = tg * 128 + tl, b = m / SEQ;
            const float* sh = mod + b * 6144 + 3 * D; const float* scl = sh + D;
            float s0 = 0.f, s1 = 0.f;
#pragma unroll
            for (int j = 0; j < 4; ++j) { const v2u w0 = *(const v2u*)(X1 + (size_t)m * D + 256 * j + 4 * lane), w1 = *(const v2u*)(X1 + (size_t)(m + 1) * D + 256 * j + 4 * lane);
                const f32x4 x0 = (f32x4){bflo(w0.x), bfhi(w0.x), bflo(w0.y), bfhi(w0.y)}, x1 = (f32x4){bflo(w1.x), bfhi(w1.x), bflo(w1.y), bfhi(w1.y)};
                s0 += (x0[0] * x0[0] + x0[1] * x0[1]) + (x0[2] * x0[2] + x0[3] * x0[3]); s1 += (x1[0] * x1[0] + x1[1] * x1[1]) + (x1[2] * x1[2] + x1[3] * x1[3]); }
            const float r0 = __builtin_amdgcn_rsqf(wave_sum(s0) * (1.0f / D) + EPS), r1 = __builtin_amdgcn_rsqf(wave_sum(s1) * (1.0f / D) + EPS);
            float a0[32], a1[32];
#pragma unroll
            for (int e = 0; e < 32; ++e) { a0[e] = 0.f; a1[e] = 0.f; }
            f32x4 g_n = *(const f32x4*)(INP[7] + 4 * lane), a_n = *(const f32x4*)(scl + 4 * lane), bb_n = *(const f32x4*)(sh + 4 * lane);
            v2u w0_n = *(const v2u*)(X1 + (size_t)m * D + 4 * lane), w1_n = *(const v2u*)(X1 + (size_t)(m + 1) * D + 4 * lane);
#pragma unroll 1
            for (int j = 0; j < 4; ++j) { const int c = 256 * j + 4 * lane; const f32x4 g = g_n, a = a_n, bb = bb_n; const v2u w0 = w0_n, w1 = w1_n;
                { const int cn = (j < 3 ? c + 256 : c); g_n = *(const f32x4*)(INP[7] + cn); a_n = *(const f32x4*)(scl + cn); bb_n = *(const f32x4*)(sh + cn);
                    w0_n = *(const v2u*)(X1 + (size_t)m * D + cn); w1_n = *(const v2u*)(X1 + (size_t)(m + 1) * D + cn); }
                const f32x4 x0 = (f32x4){bflo(w0.x), bfhi(w0.x), bflo(w0.y), bfhi(w0.y)}, x1 = (f32x4){bflo(w1.x), bfhi(w1.x), bflo(w1.y), bfhi(w1.y)};
                const f32x4 gs = g * (a + 1.0f); const f32x4 y0 = x0 * r0 * gs + bb, y1 = x1 * r1 * gs + bb;
                *(unsigned*)((unsigned char*)H2 + (size_t)m * D + c) = pk4_fp8(y0[0], y0[1], y0[2], y0[3]); *(unsigned*)((unsigned char*)H2 + (size_t)(m + 1) * D + c) = pk4_fp8(y1[0], y1[1], y1[2], y1[3]);
                const LAS float* wj = Wt + j * 8192 + lane * 4;
#pragma unroll
                for (int qq = 0; qq < 4; ++qq) { const LAS float* wp = wj + qq * 2048; const float ya = y0[qq], yb = y1[qq];
#pragma unroll
                    for (int e4 = 0; e4 < 8; ++e4) { const f32x4 wv = *(const LAS f32x4*)(wp + e4 * 256);
#pragma unroll
                        for (int i = 0; i < 4; ++i) { a0[4 * e4 + i] += ya * wv[i]; a1[4 * e4 + i] += yb * wv[i]; } }
                    asm volatile("" ::: "memory"); } }
            float tv[4]; int ti[4];
#pragma unroll
            for (int tk = 0; tk < 2; ++tk) {
                if (tk == 0) route_reduce_top4(a0, br, lane, tv, ti); else route_reduce_top4(a1, br, lane, tv, ti);
                const float e1 = __expf(tv[1] - tv[0]), e2 = __expf(tv[2] - tv[0]), e3 = __expf(tv[3] - tv[0]); const float inv = frcp(1.0f + e1 + e2 + e3);
                if (lane < 4) { const float p = lane == 0 ? inv : (lane == 1 ? e1 * inv : (lane == 2 ? e2 * inv : e3 * inv)); const int ee = lane == 0 ? ti[0] : (lane == 1 ? ti[1] : (lane == 2 ? ti[2] : ti[3]));
                    TOPP[(m + tk) * 4 + lane] = p; TOPE[(m + tk) * 4 + lane] = ee; pe[(tl + tk) * 4 + lane] = ee; }
            }
        }
        __syncthreads();
        { const int e = pe[F.tid]; rank[F.tid] = __hip_atomic_fetch_add(&hist[e], 1, __ATOMIC_RELAXED, __HIP_MEMORY_SCOPE_WORKGROUP); }
        __syncthreads();
        if (F.tid < 32) base[F.tid] = (int)__hip_atomic_fetch_add(F.ctl + CW_CNT + 64 * F.tid, (unsigned)hist[F.tid], RLX_AGENT);
        __syncthreads();
        { const int e = pe[F.tid]; const int pos = base[e] + rank[F.tid]; const int m = tg * 128 + (F.tid >> 2); LIST[e * ML + pos] = m; POS[m * 4 + (F.tid & 3)] = pos; }
        __syncthreads();
    }
}

typedef int i32x4 __attribute__((ext_vector_type(4)));
__device__ __forceinline__ void p10_combine(Frame& F, const float* const* __restrict__ INP) {
    if (N_LAUNCHES != 1) moe_tables(F);
    const LAS int* tab = (const LAS int*)(F.lds + TAB_OFF);
    const bf16* X1 = (const bf16*)(F.ws + WS_X1); float* OUT = F.out; const float* mod = (const float*)(F.ws + WS_MOD); const unsigned char* Y = (const unsigned char*)(F.ws + WS_Y);
    const int* TOPE = (const int*)(F.ws + WS_TOPE); const int* POS = (const int*)(F.ws + WS_POS); const float* TOPP = (const float*)(F.ws + WS_TOPP);
    const int gw = F.vcu * NWAVES + F.wave, NGW = F.G * NWAVES, lane = F.lane;
    f32x4 gfin[4];
#pragma unroll
    for (int j = 0; j < 4; ++j) gfin[j] = *(const f32x4*)(INP[32] + 256 * j + 4 * lane);
    i32x4 te[2], tp[2]; f32x4 tw[2];
    int m0 = 2 * gw;
    if (m0 < ML) {
#pragma unroll
        for (int r = 0; r < 2; ++r) { te[r] = *(const i32x4*)(TOPE + (m0 + r) * 4); tp[r] = *(const i32x4*)(POS + (m0 + r) * 4); tw[r] = *(const f32x4*)(TOPP + (m0 + r) * 4); } }
    for (; m0 < ML; m0 += 2 * NGW) {
        unsigned yv[2][4][4]; v2u xv[2][4];
#pragma unroll
        for (int r = 0; r < 2; ++r) {
#pragma unroll
            for (int k = 0; k < 4; ++k) { const size_t slot = (size_t)256 * tab[te[r][k]] + tp[r][k];
#pragma unroll
                for (int j = 0; j < 4; ++j) yv[r][k][j] = *(const unsigned*)(Y + slot * 1024 + 256 * j + 4 * lane); }
#pragma unroll
            for (int j = 0; j < 4; ++j) xv[r][j] = *(const v2u*)(X1 + (size_t)(m0 + r) * D + 256 * j + 4 * lane); }
        const f32x4 cw[2] = {tw[0], tw[1]};
        f32x4 gtv[2][4];
#pragma unroll
        for (int r = 0; r < 2; ++r) { const float* gt2 = mod + ((m0 + r) / SEQ) * 6144 + 5 * D;
#pragma unroll
            for (int j = 0; j < 4; ++j) gtv[r][j] = *(const f32x4*)(gt2 + 256 * j + 4 * lane); }
        const int mn = m0 + 2 * NGW;
        if (mn < ML) {
#pragma unroll
            for (int r = 0; r < 2; ++r) { te[r] = *(const i32x4*)(TOPE + (mn + r) * 4); tp[r] = *(const i32x4*)(POS + (mn + r) * 4); tw[r] = *(const f32x4*)(TOPP + (mn + r) * 4); } }
        __builtin_amdgcn_sched_barrier(0);
#pragma unroll
        for (int r = 0; r < 2; ++r) { const int m = m0 + r, b = m / SEQ; const float* gt2 = mod + b * 6144 + 5 * D;
            f32x4 v[4]; float s = 0.f;
#pragma unroll
            for (int j = 0; j < 4; ++j) { const int c = 256 * j + 4 * lane; f32x4 mo = (f32x4){0.f, 0.f, 0.f, 0.f};
#pragma unroll
                for (int k = 0; k < 4; ++k) { const unsigned y = yv[r][k][j]; const auto lo = __builtin_amdgcn_cvt_pk_f32_fp8((int)y, false), hi = __builtin_amdgcn_cvt_pk_f32_fp8((int)y, true);
                    mo += (f32x4){lo[0], lo[1], hi[0], hi[1]} * (cw[r][k] * 0.0625f); }
                const v2u xw = xv[r][j]; v[j] = (f32x4){bflo(xw.x), bfhi(xw.x), bflo(xw.y), bfhi(xw.y)} + gtv[r][j] * mo;
                s += (v[j][0] * v[j][0] + v[j][1] * v[j][1]) + (v[j][2] * v[j][2] + v[j][3] * v[j][3]); }
            const float rstd = __builtin_amdgcn_rsqf(wave_sum(s) * (1.0f / D) + EPS);
#pragma unroll
            for (int j = 0; j < 4; ++j) { const int c = 256 * j + 4 * lane; __builtin_nontemporal_store(v[j] * rstd * gfin[j], (f32x4*)(OUT + (size_t)m * D + c)); }
        }
    }
}

struct Args { const float* in[33]; float* out; unsigned char* ws; int ph_lo, ph_hi, li, pad; };
__global__ void __launch_bounds__(NWAVES * 64, 2) fwd_kernel(Args args) {
    extern __shared__ __attribute__((aligned(16))) unsigned char lds[];
    Frame F;
    F.lds = (LAS unsigned char*)lds;
    F.tid = threadIdx.x; F.lane = F.tid & 63; F.wave = __builtin_amdgcn_readfirstlane(F.tid >> 6);
    F.G = gridDim.x; { const int bx = blockIdx.x; F.vcu = (F.G % 8 == 0) ? (bx % 8) * (F.G / 8) + bx / 8 : bx; }
    F.ws = args.ws; F.ctl = (gu32*)(args.ws + WS_CTL); F.out = args.out;
    for (int u = F.tid; u < (LDS_BYTES - LDSCTL_OFF) / 4; u += NWAVES * 64) ((LAS unsigned*)(F.lds + LDSCTL_OFF))[u] = 0u;
    __syncthreads();
    XcdBarrier bar; bar.bar = (unsigned*)(F.ctl + CW_BAR); bar.x = 0; bar.st = nullptr;
    if (N_LAUNCHES == 1) bar = xcd_barrier_post((unsigned*)(F.ctl + CW_BAR), (volatile LAS unsigned*)(F.lds + MISC_OFF) + 8);
    const int lo = args.ph_lo, hi = args.ph_hi;
    const float* const* __restrict__ INP = args.in;
#ifndef PH_MASK
#define PH_MASK 0x3fff
#endif
#define IN(k) ((((PH_MASK) >> (k)) & 1) && lo <= (k) && (k) < hi)
#define SEAM(k) do { if (IN(k) && IN((k) + 1)) xcd_barrier(bar); } while (0)
    const bf16* WIN = (const bf16*)(F.ws + WS_WIN);

    if (IN(0)) { p0_prologue(F, INP); } SEAM(0);
    if (IN(1)) { p1_norm1(F, INP); } SEAM(1);
    if (IN(2)) {
        pg8::Gemm g{(const bf16*)(F.ws + WS_H1), WIN, 512, nullptr, 0x7f7f7f7f, 0x7a7a7a7a}; InProjOrder S{F.G, (int)blockIdx.x};
        EpiStore E{(bf16*)(F.ws + WS_PROJ), LDP, F.ws + WS_PROJ8};
        pg8::gemm_phase<EpiStore, InProjOrder, false, true>(F.lds, g, S, E);
    } SEAM(2);
    if (IN(3)) { p3_conv(F, INP); } SEAM(3);
    if (IN(4)) { for (int u = blockIdx.x; u < 256; u += F.G) { p4_mlstm<0>(F, INP, u); if (P4_REP_M > 1) p4_mlstm<P4_MODE>(F, INP, u); p4_s5<0>(F, INP, u); if (P4_REP_S > 1) p4_s5<1>(F, INP, u); } } SEAM(4);
    if (IN(5)) { p5a_prep(F, INP); } SEAM(5);
    if (IN(6)) {
        pg8::Gemm g{(const bf16*)(F.ws + WS_A2), (const bf16*)(F.ws + WS_WGLU), 256, nullptr, 0x7f7f7f7f, 0x7a7a7a7a}; pg8::StaticOrder S; S.init(ML, 512, F.G, (int)blockIdx.x);
        EpiGlu E{(const bf16*)(F.ws + WS_A2), (bf16*)(F.ws + WS_A3), INP[22]};
        pg8::gemm_phase<EpiGlu, pg8::StaticOrder, false, true>(F.lds, g, S, E);
    }
    if (IN(7)) {
        pg8::Gemm g{(const bf16*)(F.ws + WS_A1), (const bf16*)(F.ws + WS_WA), 512, nullptr, 0x7f7f7f7f, 0x7a7a7a7a}; pg8::StaticOrder S; S.init(ML, 1024, F.G, (int)blockIdx.x);
        EpiGate<false> E{F.ws + WS_PROJ8, 1024, INP[24], nullptr, (bf16*)(F.ws + WS_YA)};
        pg8::gemm_phase<EpiGate<false>, pg8::StaticOrder, false, true>(F.lds, g, S, E);
    } SEAM(7);
    if (IN(8)) {
        pg8::Gemm g{(const bf16*)(F.ws + WS_A3), (const bf16*)(F.ws + WS_WB), 256, nullptr, 0x7f7f7f7f, 0x7a7a7a7a}; pg8::StaticOrder S; S.init(ML, 1024, F.G, (int)blockIdx.x);
        EpiGate<true> E{F.ws + WS_PROJ8, 2048, INP[24] + 1024, (const bf16*)(F.ws + WS_YA), (bf16*)(F.ws + WS_MERGED)};
        pg8::gemm_phase<EpiGate<true>, pg8::StaticOrder, false, true>(F.lds, g, S, E);
    } SEAM(8);
    if (IN(9)) {
        pg8::Gemm g{(const bf16*)(F.ws + WS_MERGED), (const bf16*)(F.ws + WS_WO), 512, nullptr, 0x7d7d7d7d, 0x7a7a7a7a}; pg8::StaticOrder S; S.init(ML, 1024, F.G, (int)blockIdx.x);
        EpiX1 E{INP[0], (const float*)(F.ws + WS_MOD), (bf16*)(F.ws + WS_X1)};
        pg8::gemm_phase<EpiX1, pg8::StaticOrder, false, true>(F.lds, g, S, E);
    } SEAM(9);
    if (IN(10)) { p6_route(F, INP); } SEAM(10);
    if (IN(11)) {
        moe_tables(F);
        MoeOrder S{F.G, (int)blockIdx.x, 8, (const LAS int*)(F.lds + TAB_OFF), 0};
        LAS unsigned short* ridx = (LAS unsigned short*)(F.lds + LDSCTL_OFF + 1024);
        { const int* LIST = (const int*)(F.ws + WS_LIST);
            int rv[9]; unsigned okm = 0u; const int rr_ = F.tid & 255, ih = F.tid >> 8;
#pragma unroll
            for (int p = 0; p < 9; ++p) { pg8::Unit u; rv[p] = 0;
                if (S.next(2 * p + ih, u)) { okm |= 1u << p; const int rc = rr_ < u.nvalid ? rr_ : u.nvalid - 1; rv[p] = LIST[u.lbase + rc]; } }
            __builtin_amdgcn_sched_barrier(0);
#pragma unroll
            for (int p = 0; p < 9; ++p) if ((okm >> p) & 1u) ridx[(2 * p + ih) * 256 + rr_] = (unsigned short)rv[p];
            for (int i = 18; i < 30; ++i) { pg8::Unit u; if (!S.next(i, u)) break;
                if (F.tid < 256) { const int rc = F.tid < u.nvalid ? F.tid : u.nvalid - 1; ridx[i * 256 + F.tid] = (unsigned short)LIST[u.lbase + rc]; } }
            __syncthreads(); }
        pg8::Gemm g{(const bf16*)(F.ws + WS_H2), (const bf16*)(F.ws + WS_WEIN), 512, ridx, 0x7f7f7f7f, 0x7a7a7a7a};
        EpiSwiglu E{INP[29], (bf16*)(F.ws + WS_ACT)};
        pg8::gemm_phase<EpiSwiglu, MoeOrder, true, true>(F.lds, g, S, E);
    } SEAM(11);
    if (IN(12)) {
        if (N_LAUNCHES != 1) moe_tables(F);
        pg8::Gemm g{(const bf16*)(F.ws + WS_ACT), (const bf16*)(F.ws + WS_WEOUT), 512, nullptr, 0x7c7c7c7c, 0x7a7a7a7a, 1}; MoeOrder S{F.G, (int)blockIdx.x, 4, (const LAS int*)(F.lds + TAB_OFF), 1};
        EpiY E{INP[31], (bf16*)(F.ws + WS_Y)};
        pg8::gemm_phase<EpiY, MoeOrder, false, true>(F.lds, g, S, E);
    } SEAM(12);
    if (IN(13)) { p10_combine(F, INP); }
#undef IN
#undef SEAM
}

extern "C" void kernel_launch(void* const* d_in, const int* in_sizes, int n_in, void* d_out, int out_size, void* d_ws, size_t ws_size, hipStream_t stream) {
    static int grid = 0;
    if (grid == 0) {
        if (n_in != 33 || out_size != ML * D || ws_size < WS_END2) { fprintf(stderr, "kernel_launch: unexpected shapes (n_in %d, out %d, ws %zu)\n", n_in, out_size, ws_size); grid = -1; return; }
        int dev = 0, cus = 0, per_cu = 0;
        if (hipGetDevice(&dev) != hipSuccess || hipDeviceGetAttribute(&cus, hipDeviceAttributeMultiprocessorCount, dev) != hipSuccess) { grid = -1; return; }
        if (hipFuncSetAttribute((const void*)fwd_kernel, hipFuncAttributeMaxDynamicSharedMemorySize, LDS_BYTES) != hipSuccess) { fprintf(stderr, "kernel_launch: hipFuncSetAttribute failed\n"); grid = -1; return; }
        if (hipOccupancyMaxActiveBlocksPerMultiprocessor(&per_cu, (const void*)fwd_kernel, NWAVES * 64, LDS_BYTES) != hipSuccess || per_cu < 1) fprintf(stderr, "kernel_launch: occupancy query reports %d\n", per_cu);
        (void)hipGetLastError();
        grid = cus;
    }
    if (grid < 0) return;
    if (hipMemsetAsync((char*)d_ws + WS_CTL, 0, CTL_ZERO_BYTES, stream) != hipSuccess) return;
    Args a{};
    for (int i = 0; i < 33; ++i) a.in[i] = (const float*)d_in[i];
    a.out = (float*)d_out; a.ws = (unsigned char*)d_ws;
    for (int li = 0; li < N_LAUNCHES; ++li) {
        a.ph_lo = (N_LAUNCHES == 1) ? 0 : li; a.ph_hi = (N_LAUNCHES == 1) ? NPH : li + 1; a.li = li;
        const int nrep = (N_LAUNCHES != 1 && (((PROBE_DUP_MASK) >> li) & 1)) ? 2 : 1;
        for (int r = 0; r < nrep; ++r) hipLaunchKernelGGL(fwd_kernel, dim3(grid), dim3(NWAVES * 64), LDS_BYTES, stream, a);
    }
}
```
